# Optimizing an MI355X kernel written in HIP

```python
import math
import jax, jax.numpy as jnp
from jax import lax
import numpy as np

D_MODEL = 1024
BATCH = 1
SEQ = 16384
DEPTH = 2

HEAD_DIM = 64
SB_HEADS = 4
NSA_HEADS = 8
NSA_GROUPS = 2
NSA_HPG = NSA_HEADS // NSA_GROUPS
NSA_BRANCHES = 3
MLA_HEADS = 4
MLA_NOPE = 64
MLA_ROPE = 32
MLA_V = 64
MLA_QK = MLA_NOPE + MLA_ROPE
MLA_Q_LORA = 256
MLA_KV_LORA = 128
ROPE_THETA = 10000.0
Q_BLOCK = 128
CMP_LEN = 32
CMP_STRIDE = 16
CMP_HIDDEN = 256
SEL_BLOCK = 64
SEL_TOPK = 16
N_LOCAL_BLOCKS = 2
WINDOW = 512
NUM_BUCKETS = 32
MAX_DISTANCE = 1024
N_MIXERS = 3
D_FF = 2816
N_EXPERTS = 8
TOP_K = 2
EXPERT_FF = 3584
N_DENSE_LAYERS = (DEPTH + 1) // 2
N_MOE_LAYERS = DEPTH // 2
EPS = 1e-6
NEG_INF = -1e30
FORCE = 1e30

SB_W = SB_HEADS * HEAD_DIM
NSA_QW = NSA_HEADS * HEAD_DIM
NSA_KVW = NSA_GROUPS * HEAD_DIM
IN_SPLITS = (SB_W, SB_W, SB_W,
             NSA_QW, NSA_KVW, NSA_KVW, NSA_KVW, NSA_KVW, NSA_KVW, NSA_KVW, NSA_HEADS * NSA_BRANCHES,
             MLA_Q_LORA, MLA_KV_LORA, MLA_ROPE,
             N_MIXERS * D_MODEL)
IN_COLS = sum(IN_SPLITS)

kernel_name = 'hybrid_stickbreak_nsa_mla_moe'


def rmsnorm(x, g):
    xf = x.astype(jnp.float32)
    y = xf * lax.rsqrt(jnp.mean(xf * xf, axis=-1, keepdims=True) + EPS)
    return (y * g.astype(jnp.float32)).astype(x.dtype)


def masked_softmax(s, mask):
    p = jax.nn.softmax(jnp.where(mask, s, NEG_INF), axis=-1)
    return jnp.where(mask, p, 0.0)


def t5_bucket(rel):
    n = jnp.maximum(rel, 0)
    max_exact = NUM_BUCKETS // 2
    nf = jnp.maximum(n, 1).astype(jnp.float32)
    large = max_exact + (jnp.log(nf / max_exact) / math.log(MAX_DISTANCE / max_exact)
                         * (NUM_BUCKETS - max_exact)).astype(jnp.int32)
    large = jnp.minimum(large, NUM_BUCKETS - 1)
    return jnp.where(n < max_exact, n, large)


def apply_rope(x, pos):
    half = x.shape[-1] // 2
    inv = ROPE_THETA ** (-jnp.arange(half, dtype=jnp.float32) / half)
    ang = pos.astype(jnp.float32)[:, None] * inv[None, :]
    cos = jnp.cos(ang)[None, :, None, :]
    sin = jnp.sin(ang)[None, :, None, :]
    xf = x.astype(jnp.float32)
    x1, x2 = xf[..., :half], xf[..., half:]
    return jnp.concatenate([x1 * cos - x2 * sin, x2 * cos + x1 * sin], axis=-1).astype(x.dtype)


def stick_breaking_attention(q, k, v):
    B, S, H, D = q.shape
    scale = D ** -0.5
    kpos = jnp.arange(S)

    def block(i):
        start = i * Q_BLOCK
        qb = lax.dynamic_slice_in_dim(q, start, Q_BLOCK, axis=1)
        z = jnp.einsum('bqhd,bkhd->bhqk', qb, k).astype(jnp.float32) * scale
        qpos = start + jnp.arange(Q_BLOCK)
        causal = kpos[None, :] < qpos[:, None]
        log_stay = jnp.where(causal, jax.nn.log_sigmoid(-z), 0.0)
        after = lax.cumsum(log_stay, axis=3, reverse=True) - log_stay
        w = jnp.where(causal, jnp.exp(jax.nn.log_sigmoid(z) + after), 0.0)
        return jnp.einsum('bhqk,bkhd->bqhd', w.astype(v.dtype), v)

    out = lax.map(block, jnp.arange(S // Q_BLOCK))
    return out.transpose(1, 0, 2, 3, 4).reshape(B, S, H * D)


def causal_softmax_attention(q, k, v, scale):
    B, S, H, _ = q.shape
    Dv = v.shape[-1]
    kpos = jnp.arange(S)

    def block(i):
        start = i * Q_BLOCK
        qb = lax.dynamic_slice_in_dim(q, start, Q_BLOCK, axis=1)
        s = jnp.einsum('bqhd,bkhd->bhqk', qb, k).astype(jnp.float32) * scale
        qpos = start + jnp.arange(Q_BLOCK)
        mask = kpos[None, :] <= qpos[:, None]
        p = jax.nn.softmax(jnp.where(mask, s, NEG_INF), axis=-1)
        return jnp.einsum('bhqk,bkhd->bqhd', p.astype(v.dtype), v)

    out = lax.map(block, jnp.arange(S // Q_BLOCK))
    return out.transpose(1, 0, 2, 3, 4).reshape(B, S, H * Dv)


def compress_blocks(x, pos_emb, w1, w2):
    B, S, G, Dh = x.shape
    n_chunk = S // CMP_STRIDE
    r = CMP_LEN // CMP_STRIDE
    n_cmp = n_chunk - r + 1
    chunks = x.reshape(B, n_chunk, CMP_STRIDE, G, Dh)
    blocks = jnp.concatenate([chunks[:, j:j + n_cmp] for j in range(r)], axis=2)
    blocks = blocks + pos_emb[:, None, :]
    flat = blocks.transpose(0, 1, 3, 2, 4).reshape(B, n_cmp, G, CMP_LEN * Dh)
    return jax.nn.silu(flat @ w1) @ w2


def native_sparse_attention(q, k_cmp_in, v_cmp_in, k_sel, v_sel, k_win, v_win, gate_logits,
                            q_norm, k_norms, cmp_pos, cmp_w1, cmp_w2, bias_table):
    B, S, H, Dh = q.shape
    G, R = NSA_GROUPS, NSA_HPG
    scale = Dh ** -0.5
    q = rmsnorm(q, q_norm)
    k_cmp = rmsnorm(compress_blocks(k_cmp_in, cmp_pos[0], cmp_w1[0], cmp_w2[0]), k_norms[0])
    v_cmp = compress_blocks(v_cmp_in, cmp_pos[1], cmp_w1[1], cmp_w2[1])
    k_sel = rmsnorm(k_sel, k_norms[1])
    k_win = rmsnorm(k_win, k_norms[2])
    gates = jax.nn.sigmoid(gate_logits.astype(jnp.float32)).astype(q.dtype).reshape(B, S, G, R, NSA_BRANCHES)

    n_chunk = S // CMP_STRIDE
    r_c = CMP_LEN // CMP_STRIDE
    r_s = SEL_BLOCK // CMP_STRIDE
    n_cmp = n_chunk - r_c + 1
    cmp_end = jnp.arange(n_cmp) * CMP_STRIDE + CMP_LEN - 1
    n_blk = S // SEL_BLOCK
    n_sel = min(SEL_TOPK, n_blk)
    n_keys_sel = n_sel * SEL_BLOCK
    blk_ids = jnp.arange(n_blk)
    ks_blocks = k_sel.reshape(B, n_blk, SEL_BLOCK, G, Dh).transpose(0, 3, 1, 2, 4)
    vs_blocks = v_sel.reshape(B, n_blk, SEL_BLOCK, G, Dh).transpose(0, 3, 1, 2, 4)
    pad = ((0, 0), (WINDOW, 0), (0, 0), (0, 0))
    kw_pad = jnp.pad(k_win, pad)
    vw_pad = jnp.pad(v_win, pad)
    table = bias_table.reshape(NUM_BUCKETS, G, R)
    table_g = table.transpose(1, 0, 2)
    b_ix = jnp.arange(B)[:, None, None, None]
    g_ix = jnp.arange(G)[None, :, None, None]

    def block(i):
        start = i * Q_BLOCK
        qpos = start + jnp.arange(Q_BLOCK)
        qb = lax.dynamic_slice_in_dim(q, start, Q_BLOCK, axis=1).reshape(B, Q_BLOCK, G, R, Dh)
        rel_c = qpos[:, None] - cmp_end[None, :]
        bias_c = table[t5_bucket(rel_c)].transpose(2, 3, 0, 1)
        s_c = jnp.einsum('bqgrd,bngd->bgrqn', qb, k_cmp).astype(jnp.float32) * scale + bias_c
        p_c = masked_softmax(s_c, rel_c >= 0)
        o_c = jnp.einsum('bgrqn,bngd->bqgrd', p_c.astype(v_cmp.dtype), v_cmp)
        imp = jnp.pad(p_c.sum(axis=2), ((0, 0), (0, 0), (0, 0), (r_c - 1, r_c - 1)))
        imp_blk = imp[..., 0:r_s * n_blk:r_s]
        for m in range(1, r_s + r_c - 1):
            imp_blk = imp_blk + imp[..., m:m + r_s * n_blk:r_s]
        qblk = qpos // SEL_BLOCK
        causal_b = blk_ids[None, :] * SEL_BLOCK <= qpos[:, None]
        dist_b = qblk[:, None] - blk_ids[None, :]
        forced = (blk_ids[None, :] == 0) | ((dist_b >= 0) & (dist_b < N_LOCAL_BLOCKS))
        score = jnp.where(causal_b, jnp.where(forced, FORCE, imp_blk), NEG_INF)
        top_val, top_idx = lax.top_k(score, n_sel)
        sel_ok = top_val > 0.5 * NEG_INF
        kg = ks_blocks[b_ix, g_ix, top_idx]
        vg = vs_blocks[b_ix, g_ix, top_idx]
        tok = top_idx[..., None] * SEL_BLOCK + jnp.arange(SEL_BLOCK)
        rel_s = qpos[None, None, :, None, None] - tok
        mask_s = (sel_ok[..., None] & (rel_s >= 0)).reshape(B, G, 1, Q_BLOCK, n_keys_sel)
        bias_s = table_g[g_ix[..., None], t5_bucket(rel_s)]
        s_s = (jnp.einsum('bqgrd,bgqnld->bgrqnl', qb, kg).astype(jnp.float32) * scale
               + bias_s.transpose(0, 1, 5, 2, 3, 4)).reshape(B, G, R, Q_BLOCK, n_keys_sel)
        p_s = masked_softmax(s_s, mask_s)
        o_s = jnp.einsum('bgrqk,bgqkd->bqgrd', p_s.astype(vg.dtype),
                         vg.reshape(B, G, Q_BLOCK, n_keys_sel, Dh))
        kwb = lax.dynamic_slice_in_dim(kw_pad, start, WINDOW + Q_BLOCK, axis=1)
        vwb = lax.dynamic_slice_in_dim(vw_pad, start, WINDOW + Q_BLOCK, axis=1)
        kpos_w = start - WINDOW + jnp.arange(WINDOW + Q_BLOCK)
        rel_w = qpos[:, None] - kpos_w[None, :]
        mask_w = (rel_w >= 0) & (rel_w < WINDOW) & (kpos_w[None, :] >= 0)
        bias_w = table[t5_bucket(rel_w)].transpose(2, 3, 0, 1)
        s_w = jnp.einsum('bqgrd,bkgd->bgrqk', qb, kwb).astype(jnp.float32) * scale + bias_w
        p_w = masked_softmax(s_w, mask_w)
        o_w = jnp.einsum('bgrqk,bkgd->bqgrd', p_w.astype(vwb.dtype), vwb)
        gb = lax.dynamic_slice_in_dim(gates, start, Q_BLOCK, axis=1)
        o = gb[..., 0:1] * o_c + gb[..., 1:2] * o_s + gb[..., 2:3] * o_w
        return o.reshape(B, Q_BLOCK, H * Dh)

    out = lax.map(block, jnp.arange(S // Q_BLOCK))
    return out.transpose(1, 0, 2, 3).reshape(B, S, H * Dh)


def multi_head_latent_attention(c_q, c_kv, k_rope, q_a_norm, kv_a_norm, w_uq, w_ukv, q_norm, k_norm):
    B, S, _ = c_q.shape
    H = MLA_HEADS
    q = (rmsnorm(c_q, q_a_norm) @ w_uq).reshape(B, S, H, MLA_QK)
    kv = (rmsnorm(c_kv, kv_a_norm) @ w_ukv).reshape(B, S, H, MLA_NOPE + MLA_V)
    k = jnp.concatenate([kv[..., :MLA_NOPE],
                         jnp.broadcast_to(k_rope[:, :, None, :], (B, S, H, MLA_ROPE))], axis=-1)
    v = kv[..., MLA_NOPE:]
    q = rmsnorm(q, q_norm)
    k = rmsnorm(k, k_norm)
    pos = jnp.arange(S)
    q = jnp.concatenate([q[..., :MLA_NOPE], apply_rope(q[..., MLA_NOPE:], pos)], axis=-1)
    k = jnp.concatenate([k[..., :MLA_NOPE], apply_rope(k[..., MLA_NOPE:], pos)], axis=-1)
    return causal_softmax_attention(q, k, v, MLA_QK ** -0.5)


def swiglu(h, w_gate, w_up, w_down):
    return (jax.nn.silu(h @ w_gate) * (h @ w_up)) @ w_down


def moe_swiglu(h, w_router, w_gate, w_up, w_down):
    logits = (h @ w_router).astype(jnp.float32)
    top_val, top_idx = lax.top_k(logits, TOP_K)
    weights = jax.nn.softmax(top_val, axis=-1)
    combine = jnp.sum(jax.nn.one_hot(top_idx, N_EXPERTS, dtype=jnp.float32) * weights[..., None],
                      axis=-2).astype(h.dtype)
    y = jnp.zeros_like(h)
    for e in range(N_EXPERTS):
        y = y + combine[..., e:e + 1] * swiglu(h, w_gate[e], w_up[e], w_down[e])
    return y


def setup_inputs(seed: int = 0) -> dict:
    key = jax.random.key(seed)
    keys = iter(jax.random.split(key, 48))

    def w(shape, fan_in):
        return jax.random.normal(next(keys), shape, jnp.float32) * (fan_in ** -0.5)

    def gain(shape):
        return 1.0 + 0.02 * jax.random.normal(next(keys), shape, jnp.float32)

    def small(shape, scale):
        return scale * jax.random.normal(next(keys), shape, jnp.float32)

    L, ND, NM = DEPTH, N_DENSE_LAYERS, N_MOE_LAYERS
    return {
        'x': small((BATCH, SEQ, D_MODEL), 1.0),
        'rel_bias_table': small((NUM_BUCKETS, NSA_HEADS), 0.5),
        'mix_norm': gain((L, D_MODEL)),
        'w_in': w((L, D_MODEL, IN_COLS), D_MODEL),
        'b_gate': small((L, N_MIXERS * D_MODEL), 0.01),
        'sb_w_o': w((L, SB_W, D_MODEL), SB_W),
        'nsa_q_norm': gain((L, HEAD_DIM)),
        'nsa_k_norm': gain((L, NSA_BRANCHES, HEAD_DIM)),
        'nsa_cmp_pos': small((L, 2, CMP_LEN, HEAD_DIM), 0.1),
        'nsa_cmp_w1': w((L, 2, CMP_LEN * HEAD_DIM, CMP_HIDDEN), CMP_LEN * HEAD_DIM),
        'nsa_cmp_w2': w((L, 2, CMP_HIDDEN, HEAD_DIM), CMP_HIDDEN),
        'nsa_w_o': w((L, NSA_QW, D_MODEL), NSA_QW),
        'mla_q_a_norm': gain((L, MLA_Q_LORA)),
        'mla_kv_a_norm': gain((L, MLA_KV_LORA)),
        'mla_w_uq': w((L, MLA_Q_LORA, MLA_HEADS * MLA_QK), MLA_Q_LORA),
        'mla_w_ukv': w((L, MLA_KV_LORA, MLA_HEADS * (MLA_NOPE + MLA_V)), MLA_KV_LORA),
        'mla_q_norm': gain((L, MLA_QK)),
        'mla_k_norm': gain((L, MLA_QK)),
        'mla_w_o': w((L, MLA_HEADS * MLA_V, D_MODEL), MLA_HEADS * MLA_V),
        'w_out': w((L, D_MODEL, D_MODEL), D_MODEL),
        'ffn_norm': gain((L, D_MODEL)),
        'dense_w_gate': w((ND, D_MODEL, D_FF), D_MODEL),
        'dense_w_up': w((ND, D_MODEL, D_FF), D_MODEL),
        'dense_w_down': w((ND, D_FF, D_MODEL), D_FF),
        'moe_router': w((NM, D_MODEL, N_EXPERTS), D_MODEL),
        'moe_w_gate': w((NM, N_EXPERTS, D_MODEL, EXPERT_FF), D_MODEL),
        'moe_w_up': w((NM, N_EXPERTS, D_MODEL, EXPERT_FF), D_MODEL),
        'moe_w_down': w((NM, N_EXPERTS, EXPERT_FF, D_MODEL), EXPERT_FF),
    }


def reference(x, rel_bias_table, mix_norm, w_in, b_gate, sb_w_o, nsa_q_norm, nsa_k_norm,
              nsa_cmp_pos, nsa_cmp_w1, nsa_cmp_w2, nsa_w_o, mla_q_a_norm, mla_kv_a_norm,
              mla_w_uq, mla_w_ukv, mla_q_norm, mla_k_norm, mla_w_o, w_out, ffn_norm,
              dense_w_gate, dense_w_up, dense_w_down, moe_router, moe_w_gate, moe_w_up, moe_w_down):
    B, S, D = x.shape
    split_points = [int(p) for p in np.cumsum(IN_SPLITS)[:-1]]
    for layer in range(DEPTH):
        h = rmsnorm(x, mix_norm[layer])
        proj = h @ w_in[layer]
        (sb_q, sb_k, sb_v, n_q, n_kc, n_vc, n_ks, n_vs, n_kw, n_vw, n_g,
         m_cq, m_ckv, m_kr, gate_logits) = jnp.split(proj, split_points, axis=-1)
        y_sb = stick_breaking_attention(sb_q.reshape(B, S, SB_HEADS, HEAD_DIM),
                                        sb_k.reshape(B, S, SB_HEADS, HEAD_DIM),
                                        sb_v.reshape(B, S, SB_HEADS, HEAD_DIM)) @ sb_w_o[layer]
        kv_shape = (B, S, NSA_GROUPS, HEAD_DIM)
        y_nsa = native_sparse_attention(
            n_q.reshape(B, S, NSA_HEADS, HEAD_DIM),
            n_kc.reshape(kv_shape), n_vc.reshape(kv_shape),
            n_ks.reshape(kv_shape), n_vs.reshape(kv_shape),
            n_kw.reshape(kv_shape), n_vw.reshape(kv_shape), n_g,
            nsa_q_norm[layer], nsa_k_norm[layer], nsa_cmp_pos[layer],
            nsa_cmp_w1[layer], nsa_cmp_w2[layer], rel_bias_table) @ nsa_w_o[layer]
        y_mla = multi_head_latent_attention(
            m_cq, m_ckv, m_kr, mla_q_a_norm[layer], mla_kv_a_norm[layer],
            mla_w_uq[layer], mla_w_ukv[layer], mla_q_norm[layer], mla_k_norm[layer]) @ mla_w_o[layer]
        g = jax.nn.sigmoid((gate_logits + b_gate[layer]).astype(jnp.float32)).astype(x.dtype)
        g = g.reshape(B, S, N_MIXERS, D)
        merged = g[:, :, 0] * y_sb + g[:, :, 1] * y_nsa + g[:, :, 2] * y_mla
        x = x + merged @ w_out[layer]
        h = rmsnorm(x, ffn_norm[layer])
        if layer % 2 == 0:
            j = layer // 2
            x = x + swiglu(h, dense_w_gate[j], dense_w_up[j], dense_w_down[j])
        else:
            j = layer // 2
            x = x + moe_swiglu(h, moe_router[j], moe_w_gate[j], moe_w_up[j], moe_w_down[j])
    return x
```

```cpp
#include <hip/hip_runtime.h>
#include <cstdio>
#include <cstdint>
#include <cmath>

#define LAS __attribute__((address_space(3)))
#define GAS __attribute__((address_space(1)))
typedef unsigned short bf16_t;
typedef short bf16x8 __attribute__((ext_vector_type(8)));
typedef short s16x4 __attribute__((ext_vector_type(4)));
typedef float f32x2 __attribute__((ext_vector_type(2)));
typedef float f32x4 __attribute__((ext_vector_type(4)));
typedef float f32x16 __attribute__((ext_vector_type(16)));
typedef unsigned u32x2 __attribute__((ext_vector_type(2)));
typedef unsigned u32x4 __attribute__((ext_vector_type(4)));
typedef __bf16 bf16x2_t __attribute__((ext_vector_type(2)));
typedef GAS unsigned gu32;
#define RLX_AGENT __ATOMIC_RELAXED, __HIP_MEMORY_SCOPE_AGENT
#define DI __device__ __forceinline__

DI unsigned cvtpk(float lo, float hi) { f32x2 v = {lo, hi}; bf16x2_t b = __builtin_convertvector(v, bf16x2_t); return __builtin_bit_cast(unsigned, b); }
DI float bf2f(bf16_t b) { return __uint_as_float(((unsigned)b) << 16); }
DI float bflo(unsigned w) { return __uint_as_float(w << 16); }
DI float bfhi(unsigned w) { return __uint_as_float(w & 0xffff0000u); }
DI bf16_t f2bf(float f) { return (bf16_t)(cvtpk(f, 0.f) & 0xffffu); }
DI float fast_exp2(float x) { return __builtin_amdgcn_exp2f(x); }
DI float fast_log2(float x) { return __builtin_amdgcn_logf(x); }
DI float fast_rcp(float x) { return __builtin_amdgcn_rcpf(x); }
constexpr float LOG2E = 1.4426950408889634f;
DI float sigmoidf_(float x) { return fast_rcp(1.f + fast_exp2(-x * LOG2E)); }
DI float siluf_(float x) { return x * sigmoidf_(x); }
template <int K> DI unsigned sxu(unsigned v) { return (unsigned)__builtin_amdgcn_ds_swizzle((int)v, (K << 10) | 0x1f); }
template <int K> DI float sx(float v) { return __uint_as_float(sxu<K>(__float_as_uint(v))); }
DI unsigned sx32u(unsigned v, int hi) { auto rr = __builtin_amdgcn_permlane32_swap(v, v, false, false); return hi ? rr[0] : rr[1]; }
DI float sx32(float v, int hi) { return __uint_as_float(sx32u(__float_as_uint(v), hi)); }
DI float sum32sym(float v) { auto rr = __builtin_amdgcn_permlane32_swap(__float_as_uint(v), __float_as_uint(v), false, false); return __uint_as_float(rr[0]) + __uint_as_float(rr[1]); }

namespace pg8 {
constexpr int BM = 256, BK = 64, HALF = 128, HTB = HALF * BK * 2, STAGE_BYTES = 8 * HTB, NXCD = 8, WGM = 8;
__host__ __device__ __forceinline__ int lds_byte(int r, int c) { const int st = (r >> 4) * 2 + (c >> 5), rr = r & 15, cc = c & 31, ob = rr * 64 + cc * 2; return st * 1024 + (ob ^ (((ob >> 9) & 1) << 5)); }
__host__ __device__ __forceinline__ void stage_rc(int b, int& R, int& C) { const int st = b / 1024, sb = b % 1024, swz = sb ^ (((sb >> 9) & 1) << 5); R = (st >> 1) * 16 + swz / 64; C = (st & 1) * 32 + (swz % 64) / 2; }
__host__ __device__ __forceinline__ int perm32(int rho) { const int n = rho >> 4, i = rho & 15; return 8 * (i >> 2) + 4 * n + (i & 3); }

struct Unit { const bf16_t* a; const bf16_t* b; const int* rows; int nvalid, pm, pn; };

struct StaticOrder {
    const bf16_t* A; const bf16_t* Bt; int lda, ldb, nM, nN, nwg, G, c;
    DI void init(const bf16_t* A_, const bf16_t* Bt_, int lda_, int ldb_, int M, int N, int G_, int c_) { A = A_; Bt = Bt_; lda = lda_; ldb = ldb_; nM = M / BM; nN = N / BM; nwg = nM * nN; G = G_; c = c_; }
    DI bool next(int i, Unit& u) const {
        if (c < 0 || c >= G) return false;
        const long L = (long)i * G + c; if (L >= nwg) return false;
        int wgid = (int)L; { const int q = nwg / NXCD, r = nwg % NXCD, xcd = wgid % NXCD, off = wgid / NXCD; wgid = (xcd < r ? xcd * (q + 1) : r * (q + 1) + (xcd - r) * q) + off; }
        const int nig = WGM * nN, gid = wgid / nig, fm = gid * WGM, gsz = (nM - fm) < WGM ? (nM - fm) : WGM;
        u.pm = fm + ((wgid % nig) % gsz); u.pn = (wgid % nig) / gsz;
        u.a = A + (size_t)u.pm * BM * lda; u.b = Bt + (size_t)u.pn * BM * ldb; u.rows = nullptr; u.nvalid = BM; return true;
    }
};

struct EpiStore {
    static constexpr bool PERM = true;
    bf16_t* O; int ldc; const float* bias; float scale0; int act;
    DI void operator()(const f32x4 (&acc)[2][2][4][2], const Unit& u, int wr, int wc, int fr, int fq) const {
        const int row0 = u.pm * BM + wr * 64 + fr, col0 = u.pn * BM + wc * 32 + 8 * fq;
        const float sc = (u.pn == 0) ? scale0 : 1.f;
        f32x4 bv[2][2];
#pragma unroll
        for (int bj = 0; bj < 2; ++bj)
#pragma unroll
            for (int n = 0; n < 2; ++n) bv[bj][n] = bias ? *(const f32x4*)(bias + col0 + bj * HALF + 4 * n) : (f32x4){0.f, 0.f, 0.f, 0.f};
#pragma unroll
        for (int ai = 0; ai < 2; ++ai)
#pragma unroll
            for (int m = 0; m < 4; ++m) { bf16_t* rowp = O + (size_t)(row0 + ai * HALF + m * 16) * ldc + col0;
#pragma unroll
                for (int bj = 0; bj < 2; ++bj) { f32x4 v0 = (acc[ai][bj][m][0] + bv[bj][0]) * sc, v1 = (acc[ai][bj][m][1] + bv[bj][1]) * sc;
                    if (act) {
#pragma unroll
                        for (int e = 0; e < 4; ++e) { v0[e] = siluf_(v0[e]); v1[e] = siluf_(v1[e]); } }
                    u32x4 w; w.x = cvtpk(v0[0], v0[1]); w.y = cvtpk(v0[2], v0[3]); w.z = cvtpk(v1[0], v1[1]); w.w = cvtpk(v1[2], v1[3]);
                    *(u32x4*)(rowp + bj * HALF) = w; } }
    }
};
struct EpiGate {
    static constexpr bool PERM = true;
    bf16_t* Mg; const bf16_t* glog; int ldg; const float* bg; int first;
    DI void operator()(const f32x4 (&acc)[2][2][4][2], const Unit& u, int wr, int wc, int fr, int fq) const {
        const int row0 = u.pm * BM + wr * 64 + fr, col0 = u.pn * BM + wc * 32 + 8 * fq;
        f32x4 bv[2][2];
#pragma unroll
        for (int bj = 0; bj < 2; ++bj)
#pragma unroll
            for (int n = 0; n < 2; ++n) bv[bj][n] = *(const f32x4*)(bg + col0 + bj * HALF + 4 * n);
#pragma unroll
        for (int ai = 0; ai < 2; ++ai)
#pragma unroll
            for (int m = 0; m < 4; ++m) { const size_t row = (size_t)(row0 + ai * HALF + m * 16);
#pragma unroll
                for (int bj = 0; bj < 2; ++bj) { const int col = col0 + bj * HALF;
                    const u32x4 gl = *(const u32x4*)(glog + row * ldg + col);
                    u32x4 old = (u32x4){0u, 0u, 0u, 0u}; if (!first) old = *(const u32x4*)(Mg + row * 1024 + col);
                    float g[8] = {bflo(gl.x), bfhi(gl.x), bflo(gl.y), bfhi(gl.y), bflo(gl.z), bfhi(gl.z), bflo(gl.w), bfhi(gl.w)};
                    float o[8] = {bflo(old.x), bfhi(old.x), bflo(old.y), bfhi(old.y), bflo(old.z), bfhi(old.z), bflo(old.w), bfhi(old.w)};
#pragma unroll
                    for (int e = 0; e < 4; ++e) { o[e] += sigmoidf_(g[e] + bv[bj][0][e]) * acc[ai][bj][m][0][e]; o[4 + e] += sigmoidf_(g[4 + e] + bv[bj][1][e]) * acc[ai][bj][m][1][e]; }
                    u32x4 w; w.x = cvtpk(o[0], o[1]); w.y = cvtpk(o[2], o[3]); w.z = cvtpk(o[4], o[5]); w.w = cvtpk(o[6], o[7]);
                    *(u32x4*)(Mg + row * 1024 + col) = w; } }
    }
};
struct EpiResid {
    static constexpr bool PERM = false;
    const float* xin; float* out;
    DI void operator()(const f32x4 (&acc)[2][2][4][2], const Unit& u, int wr, int wc, int fr, int fq) const {
        const int row0 = u.pm * BM + wr * 64 + fr, col0 = u.pn * BM + wc * 32 + 4 * fq;
#pragma unroll
        for (int ai = 0; ai < 2; ++ai)
#pragma unroll
            for (int m = 0; m < 4; ++m) { const size_t off = (size_t)(row0 + ai * HALF + m * 16) * 1024 + col0;
#pragma unroll
                for (int bj = 0; bj < 2; ++bj)
#pragma unroll
                    for (int n = 0; n < 2; ++n) { const f32x4 b = *(const f32x4*)(xin + off + bj * HALF + n * 16); *(f32x4*)(out + off + bj * HALF + n * 16) = b + acc[ai][bj][m][n]; }
                if (m & 1) asm volatile("" ::: "memory"); }
    }
};
struct EpiSwiglu {
    static constexpr bool PERM = true;
    bf16_t* act; int ldact;
    DI void operator()(const f32x4 (&acc)[2][2][4][2], const Unit& u, int wr, int wc, int fr, int fq) const {
        const int row0 = u.pm * BM + wr * 64 + fr, col0 = u.pn * HALF + wc * 32 + 8 * fq;
#pragma unroll
        for (int ai = 0; ai < 2; ++ai)
#pragma unroll
            for (int m = 0; m < 4; ++m) { bf16_t* rowp = act + (size_t)(row0 + ai * HALF + m * 16) * ldact + col0;
                float o[8];
#pragma unroll
                for (int e = 0; e < 4; ++e) { o[e] = siluf_(acc[ai][0][m][0][e]) * acc[ai][1][m][0][e]; o[4 + e] = siluf_(acc[ai][0][m][1][e]) * acc[ai][1][m][1][e]; }
                u32x4 w; w.x = cvtpk(o[0], o[1]); w.y = cvtpk(o[2], o[3]); w.z = cvtpk(o[4], o[5]); w.w = cvtpk(o[6], o[7]);
                *(u32x4*)rowp = w; }
    }
};

template <class Epi, class Sched, bool ALIGN_EPI, bool GATHER>
__device__ __forceinline__ void gemm_phase(LAS unsigned char* lds, const int lda, const int ldb, const int K, const Sched& S, const Epi& E) {
    int tid_l = threadIdx.x; asm volatile("" : "+v"(tid_l));
    const int tid = tid_l, wid = __builtin_amdgcn_readfirstlane(tid >> 6), lane = tid & 63, wr = wid >> 2, wc = wid & 3, fr = lane & 15, fq = lane >> 4;
    const int nt = K / BK;
    unsigned voffB[2], vc0[2], vc1[2], vn0[2], vn1[2];
#pragma unroll
    for (int i = 0; i < 2; ++i) { int R, C; stage_rc(tid * 16 + i * 8192, R, C); const int Rb = Epi::PERM ? ((R & ~31) + perm32(R & 31)) : R;
        voffB[i] = (unsigned)(Rb * ldb + C) * 2u; vc0[i] = (unsigned)(R * lda + C) * 2u; vc1[i] = vc0[i]; vn0[i] = vc0[i]; vn1[i] = vc0[i]; }
    const size_t hsA = GATHER ? (size_t)0 : (size_t)HALF * lda * 2, hsB = (size_t)HALF * ldb * 2;
    const size_t kstep = (size_t)(BK * 2);
    const unsigned ldsw = (unsigned)wid * 1024u;
    const int aoff = lds_byte(wr * 64 + fr, fq * 8), boff = lds_byte(wc * 32 + fr, fq * 8);
#define PG8_SA(b, h) (((b) * 2 + (h)) * HTB)
#define PG8_SB(b, h) ((4 + (b) * 2 + (h)) * HTB)
#define PG8_STAGE(bufoff, gbase, voff) do { _Pragma("unroll") for (int _i = 0; _i < 2; ++_i) \
        __builtin_amdgcn_global_load_lds((const unsigned*)((const char*)(gbase) + (voff)[_i]), (LAS unsigned*)(lds + (bufoff) + ldsw + _i * 8192), 16, 0, 0); } while (0)
#define PG8_LDA(dst, b, h) do { _Pragma("unroll") for (int m = 0; m < 4; ++m) _Pragma("unroll") for (int k = 0; k < 2; ++k) dst[m][k] = *(const LAS bf16x8*)(lds + PG8_SA(b, h) + aoff + m * 2048 + k * 1024); } while (0)
#define PG8_LDB(dst, b, h) do { _Pragma("unroll") for (int n = 0; n < 2; ++n) _Pragma("unroll") for (int k = 0; k < 2; ++k) dst[n][k] = *(const LAS bf16x8*)(lds + PG8_SB(b, h) + boff + n * 2048 + k * 1024); } while (0)
#define PG8_MMA(ai, bj, At, Bt) do { __builtin_amdgcn_s_setprio(1); _Pragma("unroll") for (int m = 0; m < 4; ++m) _Pragma("unroll") for (int n = 0; n < 2; ++n) _Pragma("unroll") for (int k = 0; k < 2; ++k) \
        acc[ai][bj][m][n] = __builtin_amdgcn_mfma_f32_16x16x32_bf16(Bt[n][k], At[m][k], acc[ai][bj][m][n], 0, 0, 0); __builtin_amdgcn_s_setprio(0); } while (0)
#define PG8_WAIT_V(n) asm volatile("s_waitcnt vmcnt(" #n ")" ::: "memory")
#define PG8_WAIT_L(n) asm volatile("s_waitcnt lgkmcnt(" #n ")" ::: "memory")
#define PG8_BAR __builtin_amdgcn_s_barrier()
#define PG8_SCHED __builtin_amdgcn_sched_barrier(0)
#define PG8_GVOFF(U, o0, o1) do { if constexpr (GATHER) { _Pragma("unroll") for (int _i = 0; _i < 2; ++_i) { int R_, C_; stage_rc(tid * 16 + _i * 8192, R_, C_); \
        const int r0_ = R_, r1_ = R_ + HALF; const int t0_ = (U).rows[r0_ < (U).nvalid ? r0_ : 0], t1_ = (U).rows[r1_ < (U).nvalid ? r1_ : 0]; \
        o0[_i] = (unsigned)(t0_ * lda + C_) * 2u; o1[_i] = (unsigned)(t1_ * lda + C_) * 2u; } } } while (0)
    Unit cur, nxt; int ui = 0;
    if (!S.next(0, cur)) return;
    PG8_GVOFF(cur, vc0, vc1);
    f32x4 acc[2][2][4][2];
#pragma unroll
    for (int a = 0; a < 2; ++a)
#pragma unroll
        for (int b = 0; b < 2; ++b)
#pragma unroll
            for (int m = 0; m < 4; ++m)
#pragma unroll
                for (int n = 0; n < 2; ++n) acc[a][b][m][n] = (f32x4){0.f, 0.f, 0.f, 0.f};
    bf16x8 At[4][2], B0[2][2], B1[2][2];
    const char* cA = (const char*)cur.a; const char* cB = (const char*)cur.b;
    PG8_STAGE(PG8_SB(0, 0), cB, voffB); PG8_STAGE(PG8_SB(0, 1), cB + hsB, voffB); PG8_STAGE(PG8_SA(0, 0), cA, vc0); PG8_STAGE(PG8_SA(0, 1), cA + hsA, vc1);
    if (wr == 1) PG8_BAR;
    PG8_WAIT_V(2); PG8_BAR;
    PG8_STAGE(PG8_SB(1, 0), cB + kstep, voffB); PG8_STAGE(PG8_SA(1, 0), cA + kstep, vc0); PG8_STAGE(PG8_SB(1, 1), cB + hsB + kstep, voffB);
    PG8_WAIT_V(6); PG8_BAR;
    for (;;) {
        const bool has_next = S.next(ui + 1, nxt);
        const char* nA = has_next ? (const char*)nxt.a : cA; const char* nB = has_next ? (const char*)nxt.b : cB;
        if constexpr (GATHER) { if (has_next) { PG8_GVOFF(nxt, vn0, vn1); } else {
#pragma unroll
            for (int i = 0; i < 2; ++i) { vn0[i] = vc0[i]; vn1[i] = vc1[i]; } } }
        for (int t = 0; t < nt; t += 2) {
            const bool last = (t == nt - 2);
            const char* a1 = cA + (size_t)(t + 1) * kstep;
            const char* a2 = last ? nA : cA + (size_t)(t + 2) * kstep; const char* b2 = last ? nB : cB + (size_t)(t + 2) * kstep;
            const char* a3 = a2 + kstep; const char* b3 = b2 + kstep;
            unsigned v20[2], v21[2];
#pragma unroll
            for (int i = 0; i < 2; ++i) { v20[i] = (GATHER && last) ? vn0[i] : vc0[i]; v21[i] = GATHER ? (last ? vn1[i] : vc1[i]) : vc0[i]; }
            PG8_LDB(B0, 0, 0); PG8_LDB(B1, 0, 1); PG8_SCHED; PG8_LDA(At, 0, 0); PG8_STAGE(PG8_SA(1, 1), a1 + hsA, vc1);
            PG8_WAIT_V(8); PG8_WAIT_L(0); PG8_BAR; PG8_MMA(0, 0, At, B0); PG8_MMA(0, 1, At, B1); PG8_BAR; PG8_SCHED;
            PG8_LDA(At, 0, 1); PG8_STAGE(PG8_SB(0, 0), b2, voffB); PG8_STAGE(PG8_SB(0, 1), b2 + hsB, voffB); PG8_STAGE(PG8_SA(0, 0), a2, v20);
            PG8_WAIT_V(8); PG8_WAIT_L(0); PG8_BAR; PG8_MMA(1, 0, At, B0); PG8_MMA(1, 1, At, B1); PG8_BAR; PG8_SCHED;
            PG8_LDB(B0, 1, 0); PG8_LDB(B1, 1, 1); PG8_SCHED; PG8_LDA(At, 1, 0); PG8_STAGE(PG8_SA(0, 1), a2 + hsA, v21);
            PG8_WAIT_V(8); PG8_WAIT_L(0); PG8_BAR; PG8_MMA(0, 0, At, B0); PG8_MMA(0, 1, At, B1); PG8_BAR; PG8_SCHED;
            PG8_LDA(At, 1, 1); PG8_STAGE(PG8_SB(1, 0), b3, voffB); PG8_STAGE(PG8_SB(1, 1), b3 + hsB, voffB); PG8_STAGE(PG8_SA(1, 0), a3, v20);
            PG8_WAIT_V(8); PG8_WAIT_L(0); PG8_BAR; PG8_MMA(1, 0, At, B0); PG8_MMA(1, 1, At, B1); PG8_BAR; PG8_SCHED;
        }
        if constexpr (ALIGN_EPI) { if (wr == 0) PG8_BAR; }
        E(acc, cur, wr, wc, fr, fq);
        if (!has_next) break;
#pragma unroll
        for (int a = 0; a < 2; ++a)
#pragma unroll
            for (int b = 0; b < 2; ++b)
#pragma unroll
                for (int m = 0; m < 4; ++m)
#pragma unroll
                    for (int n = 0; n < 2; ++n) acc[a][b][m][n] = (f32x4){0.f, 0.f, 0.f, 0.f};
        cur = nxt; cA = nA; cB = nB; ++ui;
        if constexpr (GATHER) {
#pragma unroll
            for (int i = 0; i < 2; ++i) { vc0[i] = vn0[i]; vc1[i] = vn1[i]; } }
        if constexpr (ALIGN_EPI) { if (wr == 1) PG8_BAR; }
    }
    PG8_WAIT_V(0);
    if constexpr (!ALIGN_EPI) { if (wr == 0) PG8_BAR; }
    PG8_BAR;
#undef PG8_SA
#undef PG8_SB
#undef PG8_STAGE
#undef PG8_LDA
#undef PG8_LDB
#undef PG8_MMA
#undef PG8_WAIT_V
#undef PG8_WAIT_L
#undef PG8_BAR
#undef PG8_SCHED
#undef PG8_GVOFF
}
}
#define XB_TMO      128
#define XB_XCNT(j)  (256  + 64 * (j))
#define XB_XSUB(j)  (1280 + 64 * (j))
#define XB_XGEN(j)  (2304 + 64 * (j))
#define XB_TOP      3328
#define XB_TOPGEN   3392
#define XCD_BAR_WORDS 3456
#define XB_SPIN_CAP (1u << 18)

__device__ __forceinline__ unsigned xb_ld(unsigned* p)              { return __hip_atomic_load(p, __ATOMIC_RELAXED, __HIP_MEMORY_SCOPE_AGENT); }
__device__ __forceinline__ unsigned xb_add(unsigned* p, unsigned v) { return __hip_atomic_fetch_add(p, v, __ATOMIC_RELAXED, __HIP_MEMORY_SCOPE_AGENT); }
__device__ __forceinline__ unsigned xb_xcc_id() { return (unsigned)__builtin_amdgcn_s_getreg((3 << 11) | 20) & 0xFu; }
#define XB_SPIN(cond, bar) do { unsigned _sp = 0; while (cond) { __builtin_amdgcn_s_sleep(1); \
    if ((++_sp & 255u) == 0u) { if (xb_ld(&(bar)[XB_TMO])) break; if (_sp > XB_SPIN_CAP) { atomicAdd(&(bar)[XB_TMO], 1u); break; } } } } while (0)

struct XcdBarrier {
    unsigned* bar; unsigned x;
    volatile LAS unsigned* st;
};

__device__ __forceinline__ XcdBarrier xcd_barrier_post(unsigned* bar, volatile LAS unsigned* st) {
    XcdBarrier b; b.bar = bar; b.x = xb_xcc_id(); b.st = st;
    if (threadIdx.x == 0) (void)xb_add(&bar[XB_XCNT(b.x)], 1u);
    return b;
}
__device__ __forceinline__ void xcd_barrier_complete(unsigned* bar, unsigned x, unsigned& nloc, unsigned& nx) {
    const unsigned G = gridDim.x * gridDim.y * gridDim.z;
    unsigned sum, cnt, mine, sp = 0u;
    for (;;) {
        sum = 0u; cnt = 0u; mine = 0u;
#pragma unroll
        for (unsigned j = 0; j < 16; ++j) { const unsigned c = xb_ld(&bar[XB_XCNT(j)]); sum += c; cnt += (c > 0u) ? 1u : 0u; mine = (j == x) ? c : mine; }
        if (sum == G) break;
        __builtin_amdgcn_s_sleep(1);
        if ((++sp & 255u) == 0u) { if (xb_ld(&bar[XB_TMO])) break; if (sp > XB_SPIN_CAP) { atomicAdd(&bar[XB_TMO], 1u); break; } }
    }
    nloc = mine > 0u ? mine : 1u; nx = cnt > 0u ? cnt : 1u;
}

__device__ __forceinline__ void xcd_barrier(const XcdBarrier& b) {
    asm volatile("s_waitcnt vmcnt(0)" ::: "memory");
    __syncthreads();
    if (threadIdx.x == 0) {
        unsigned* bar = b.bar;
        __builtin_amdgcn_s_waitcnt(0);
        unsigned nloc = b.st[0], nx = b.st[1];
        if (nloc == 0u) { xcd_barrier_complete(bar, b.x, nloc, nx); b.st[0] = nloc; b.st[1] = nx; }
        const unsigned old = xb_add(&bar[XB_XSUB(b.x)], 1u);
        const unsigned gen = old / nloc;
        if (old + 1u == (gen + 1u) * nloc) {
            __builtin_amdgcn_fence(__ATOMIC_RELEASE, "agent");
            asm volatile("s_waitcnt vmcnt(0)" ::: "memory");
            const unsigned og = xb_add(&bar[XB_TOP], 1u);
            const unsigned tg = og / nx;
            if (og + 1u == (tg + 1u) * nx) xb_add(&bar[XB_TOPGEN], 1u);
            else XB_SPIN(xb_ld(&bar[XB_TOPGEN]) == tg, bar);
            __builtin_amdgcn_fence(__ATOMIC_ACQUIRE, "agent");
            xb_add(&bar[XB_XGEN(b.x)], 1u);
            asm volatile("s_waitcnt vmcnt(0)" ::: "memory");
        } else {
            XB_SPIN(xb_ld(&bar[XB_XGEN(b.x)]) == gen, bar);
            __builtin_amdgcn_fence(__ATOMIC_ACQUIRE, "agent");
            asm volatile("s_waitcnt vmcnt(0)" ::: "memory");
        }
    }
    __syncthreads();
}
namespace att {
typedef short v4i16_t __attribute__((ext_vector_type(4)));
DI f32x16 mfma32(bf16x8 a, bf16x8 b, f32x16 c) { return __builtin_amdgcn_mfma_f32_32x32x16_bf16(a, b, c, 0, 0, 0); }
DI f32x4 mfma16(bf16x8 a, bf16x8 b, f32x4 c) { return __builtin_amdgcn_mfma_f32_16x16x32_bf16(a, b, c, 0, 0, 0); }
DI int crow(int r, int hi) { return (r & 3) + 8 * (r >> 2) + 4 * hi; }
DI s16x4 vtr(const LAS char* p) { return __builtin_bit_cast(s16x4, __builtin_amdgcn_ds_read_tr16_b64_v4i16((LAS v4i16_t*)p)); }
DI int rfl(int x) { return __builtin_amdgcn_readfirstlane(x); }
constexpr float NEGBIG = -1e30f;

template <int D, int KS> DI f32x16 qk32(const LAS char* kp, const bf16x8* qf) {
    f32x16 acc;
#pragma unroll
    for (int i = 0; i < 16; ++i) acc[i] = 0.f;
#pragma unroll
    for (int d0 = 0; d0 < D / 16; ++d0) acc = mfma32(*(const LAS bf16x8*)(kp + d0 * 32), qf[d0], acc);
    return acc;
}
template <int VS> DI void pv32(f32x16 (&o)[2], const LAS char* vp, bf16x8 pf0, bf16x8 pf1) {
#pragma unroll
    for (int dh = 0; dh < 2; ++dh) {
        const s16x4 l0 = vtr(vp + dh * 64), h0 = vtr(vp + 8 * VS + dh * 64), l1 = vtr(vp + 16 * VS + dh * 64), h1 = vtr(vp + 24 * VS + dh * 64);
        const bf16x8 v0 = __builtin_shufflevector(l0, h0, 0, 1, 2, 3, 4, 5, 6, 7), v1 = __builtin_shufflevector(l1, h1, 0, 1, 2, 3, 4, 5, 6, 7);
        o[dh] = mfma32(v0, pf0, o[dh]); o[dh] = mfma32(v1, pf1, o[dh]);
    }
}
DI bf16x8 pack8(const f32x16& p, int s) {
    u32x4 w; w.x = cvtpk(p[8 * s], p[8 * s + 1]); w.y = cvtpk(p[8 * s + 2], p[8 * s + 3]); w.z = cvtpk(p[8 * s + 4], p[8 * s + 5]); w.w = cvtpk(p[8 * s + 6], p[8 * s + 7]);
    return __builtin_bit_cast(bf16x8, w);
}
DI float max16(const f32x16& p) { float a = fmaxf(fmaxf(p[0], p[1]), fmaxf(p[2], p[3]));
#pragma unroll
    for (int r = 4; r < 16; r += 4) a = fmaxf(a, fmaxf(fmaxf(p[r], p[r + 1]), fmaxf(p[r + 2], p[r + 3]))); return a; }
DI void store_ot(bf16_t* dst, const f32x16 (&o)[2], int hi) {
#pragma unroll
    for (int dh = 0; dh < 2; ++dh)
#pragma unroll
        for (int g4 = 0; g4 < 4; ++g4) { u32x2 w; w.x = cvtpk(o[dh][4 * g4], o[dh][4 * g4 + 1]); w.y = cvtpk(o[dh][4 * g4 + 2], o[dh][4 * g4 + 3]); *(u32x2*)(dst + 32 * dh + 8 * g4 + 4 * hi) = w; }
}

constexpr int MLA_KS = 208, MLA_VS = 144, MLA_KB = 128 * MLA_KS, MLA_VB = 128 * MLA_VS, MLA_BUF = MLA_KB + MLA_VB;
DI void mla_unit(LAS char* lds, const bf16_t* QM, const bf16_t* KM, const bf16_t* KV, bf16_t* ATT, int head, int qb) {
    int tid_l = threadIdx.x; asm volatile("" : "+v"(tid_l));
    const int tid = tid_l, lane = tid & 63, wid = rfl(tid >> 6), r32 = lane & 31, hi = lane >> 5, half = wid >> 2, wq = wid & 3;
    const int q0 = qb * 128, qpos = q0 + 32 * wq + r32, nsuper = qb + 1;
    bf16x8 qf[6];
    { const bf16_t* qp = QM + (size_t)qpos * 384 + head * 96 + hi * 8;
#pragma unroll
      for (int d0 = 0; d0 < 6; ++d0) qf[d0] = *(const bf16x8*)(qp + d0 * 16); }
    u32x4 kr[3], vr[2];
#define MLA_LOAD(i) do { _Pragma("unroll") for (int j = 0; j < 3; ++j) { const int c = tid + 512 * j, row = c / 12, ch = c % 12; kr[j] = *(const u32x4*)(KM + (size_t)(128 * (i) + row) * 384 + head * 96 + ch * 8); } \
        _Pragma("unroll") for (int j = 0; j < 2; ++j) { const int c = tid + 512 * j, row = c >> 3, ch = c & 7; vr[j] = *(const u32x4*)(KV + (size_t)(128 * (i) + row) * 512 + head * 128 + 64 + ch * 8); } } while (0)
#define MLA_STORE(b) do { LAS char* kb_ = lds + (b) * MLA_BUF; _Pragma("unroll") for (int j = 0; j < 3; ++j) { const int c = tid + 512 * j, row = c / 12, ch = c % 12; *(LAS u32x4*)(kb_ + row * MLA_KS + ch * 16) = kr[j]; } \
        _Pragma("unroll") for (int j = 0; j < 2; ++j) { const int c = tid + 512 * j, row = c >> 3, ch = c & 7; *(LAS u32x4*)(kb_ + MLA_KB + row * MLA_VS + ch * 16) = vr[j]; } } while (0)
    MLA_LOAD(0); MLA_STORE(0); __syncthreads();
    float m = -INFINITY, l = 0.f; f32x16 o[2];
#pragma unroll
    for (int i = 0; i < 16; ++i) { o[0][i] = 0.f; o[1][i] = 0.f; }
    const int vlane = (4 * hi + ((lane & 15) >> 2)) * MLA_VS + 2 * (16 * ((lane >> 4) & 1) + 4 * (lane & 3));
    for (int i = 0; i < nsuper; ++i) {
        const bool more = i + 1 < nsuper;
        if (more) MLA_LOAD(i + 1);
        const LAS char* kb = lds + (i & 1) * MLA_BUF; const LAS char* vb = kb + MLA_KB;
        const bool diag = (i == nsuper - 1);
        if (!(diag && half == 1 && wq < 2)) {
            const int koff = 64 * half;
            f32x16 p0 = qk32<96, MLA_KS>(kb + (koff + r32) * MLA_KS + hi * 16, qf);
            f32x16 p1 = qk32<96, MLA_KS>(kb + (koff + 32 + r32) * MLA_KS + hi * 16, qf);
            if (diag) { const int kbase = 128 * i + koff;
#pragma unroll
                for (int r = 0; r < 16; ++r) { const int k0 = kbase + crow(r, hi); if (k0 > qpos) p0[r] = -INFINITY; if (k0 + 32 > qpos) p1[r] = -INFINITY; } }
            float mx = fmaxf(max16(p0), max16(p1)); mx = fmaxf(mx, sx32(mx, hi));
            const float mn = fmaxf(m, mx), alpha = fast_exp2(m - mn); m = mn;
            float ls = 0.f;
#pragma unroll
            for (int r = 0; r < 16; ++r) { p0[r] = fast_exp2(p0[r] - mn); p1[r] = fast_exp2(p1[r] - mn); ls += p0[r] + p1[r]; }
            l = l * alpha + ls;
#pragma unroll
            for (int r = 0; r < 16; ++r) { o[0][r] *= alpha; o[1][r] *= alpha; }
            pv32<MLA_VS>(o, vb + koff * MLA_VS + vlane, pack8(p0, 0), pack8(p0, 1));
            pv32<MLA_VS>(o, vb + (koff + 32) * MLA_VS + vlane, pack8(p1, 0), pack8(p1, 1));
        }
        if (more) MLA_STORE((i + 1) & 1);
        __syncthreads();
    }
#undef MLA_LOAD
#undef MLA_STORE
    l = sum32sym(l);
    LAS float* mrg = (LAS float*)lds + (wq * 64 + lane) * 34;
    if (half == 1) { mrg[0] = m; mrg[1] = l;
#pragma unroll
        for (int r = 0; r < 16; ++r) { mrg[2 + r] = o[0][r]; mrg[18 + r] = o[1][r]; } }
    __syncthreads();
    if (half == 0) {
        const float mB = mrg[0], lB = mrg[1], mt = fmaxf(m, mB), fa = fast_exp2(m - mt), fb = fast_exp2(mB - mt), inv = 1.f / (l * fa + lB * fb);
#pragma unroll
        for (int r = 0; r < 16; ++r) { o[0][r] = (o[0][r] * fa + mrg[2 + r] * fb) * inv; o[1][r] = (o[1][r] * fa + mrg[18 + r] * fb) * inv; }
        store_ot(ATT + (size_t)qpos * 1024 + 768 + head * 64, o, hi);
    }
    __syncthreads();
}

constexpr int T_KS = 144, T_KB = 64 * T_KS, T_BUF = 2 * T_KB;
DI void sb_half(f32x16 (&o)[2], float& R, const LAS char* ktile, const LAS char* vtile, const bf16x8* qf, int kb, int hh, int qpos, int r32, int hi, int vlane) {
    f32x16 z = qk32<64, T_KS>(ktile + (32 * hh + r32) * T_KS + hi * 16, qf);
    float ls[16];
#pragma unroll
    for (int r = 0; r < 16; ++r) { const bool valid = (kb + crow(r, hi)) < qpos; const float az = fabsf(z[r]);
        const float sp = fmaxf(z[r], 0.f) + fast_log2(1.f + fast_exp2(-az)); ls[r] = valid ? -sp : 0.f; }
    float T[4], U[4];
#pragma unroll
    for (int g = 0; g < 4; ++g) { ls[4 * g + 2] += ls[4 * g + 3]; ls[4 * g + 1] += ls[4 * g + 2]; ls[4 * g] += ls[4 * g + 1]; T[g] = ls[4 * g]; }
#pragma unroll
    for (int g = 0; g < 4; ++g) U[g] = sx32(T[g], hi);
    float H[4]; float sp = 0.f;
#pragma unroll
    for (int g = 3; g >= 0; --g) { H[g] = sp + (hi == 0 ? U[g] : 0.f); sp += T[g] + U[g]; }
#pragma unroll
    for (int r = 0; r < 16; ++r) { const bool valid = (kb + crow(r, hi)) < qpos; const float lw = z[r] + R + H[r >> 2] + ls[r]; z[r] = valid ? fast_exp2(lw) : 0.f; }
    R += sp;
    pv32<T_KS>(o, vtile + (32 * hh) * T_KS + vlane, pack8(z, 0), pack8(z, 1));
}
DI void sb_unit(LAS char* lds, const bf16_t* PROJ, bf16_t* ATT, int head, int qb) {
    int tid_l = threadIdx.x; asm volatile("" : "+v"(tid_l));
    const int tid = tid_l, lane = tid & 63, wid = rfl(tid >> 6), r32 = lane & 31, hi = lane >> 5;
    const int q0 = qb * 256, wq0 = q0 + 32 * wid, qpos = wq0 + r32;
    bf16x8 qf[4];
    { const bf16_t* qp = PROJ + (size_t)qpos * 5632 + head * 64 + hi * 8;
#pragma unroll
      for (int d0 = 0; d0 < 4; ++d0) qf[d0] = *(const bf16x8*)(qp + d0 * 16); }
    const int srow = tid >> 3, sch = tid & 7;
    u32x4 kr, vr;
#define SB_LOAD(t) do { const bf16_t* p_ = PROJ + (size_t)(64 * (t) + srow) * 5632 + head * 64 + sch * 8; kr = *(const u32x4*)(p_ + 256); vr = *(const u32x4*)(p_ + 512); } while (0)
#define SB_STORE(b) do { LAS char* d_ = lds + (b) * T_BUF + srow * T_KS + sch * 16; *(LAS u32x4*)d_ = kr; *(LAS u32x4*)(d_ + T_KB) = vr; } while (0)
    volatile LAS int* flags = (volatile LAS int*)(lds + 2 * T_BUF);
    int t = 4 * qb + 3;
    SB_LOAD(t); SB_STORE(0); __syncthreads();
    float R = 0.f; f32x16 o[2];
#pragma unroll
    for (int i = 0; i < 16; ++i) { o[0][i] = 0.f; o[1][i] = 0.f; }
    const int vlane = (4 * hi + ((lane & 15) >> 2)) * T_KS + 2 * (16 * ((lane >> 4) & 1) + 4 * (lane & 3));
    bool done = false;
    for (int it = 0;; ++it) {
        const bool more = t > 0;
        if (more) SB_LOAD(t - 1);
        const LAS char* kt = lds + (it & 1) * T_BUF; const LAS char* vt = kt + T_KB;
        if (!done && 64 * t <= wq0 + 30) {
            if (64 * t + 32 <= wq0 + 30) sb_half(o, R, kt, vt, qf, 64 * t + 32, 1, qpos, r32, hi, vlane);
            sb_half(o, R, kt, vt, qf, 64 * t, 0, qpos, r32, hi, vlane);
            done = __all(R < -150.f) != 0;
        }
        if (lane == 0) flags[(it & 1) * 8 + wid] = done ? 0 : 1;
        if (more) SB_STORE((it + 1) & 1);
        __syncthreads();
        int any = 0;
#pragma unroll
        for (int w = 0; w < 8; ++w) any |= flags[(it & 1) * 8 + w];
        if (!more || !any) break;
        --t;
    }
#undef SB_LOAD
#undef SB_STORE
    store_ot(ATT + (size_t)qpos * 1024 + head * 64, o, hi);
    __syncthreads();
}

constexpr int N_LUT = 2 * T_BUF, N_IMP = N_LUT + 16384, N_SEL = N_IMP + 65536, N_END = N_SEL + 4096;
struct NsaT {
    const bf16_t* PROJ;
    const bf16_t* KCMP; const bf16_t* VCMP;
    const bf16_t* KS; const bf16_t* VTS;
    const bf16_t* KW;
    const float* GN;
    const float* LUT8;
    bf16_t* ATT;
};
__host__ __device__ __forceinline__ int vts_slot(int k) { const int k5 = k & 31; return (k & 32) + 8 * ((k5 & 15) >> 2) + (k5 & 3) + 4 * (k5 >> 4); }

DI void nsa_unit(LAS char* lds, const NsaT& T, int g, int qblk) {
    int tid_l = threadIdx.x; asm volatile("" : "+v"(tid_l));
    const int tid = tid_l, lane = tid & 63, wid = rfl(tid >> 6), r32 = lane & 31, hi = lane >> 5;
    const int q0 = qblk * 64;
    LAS float* lut = (LAS float*)(lds + N_LUT);
    LAS float* imp = (LAS float*)(lds + N_IMP);
    LAS int* sel = (LAS int*)(lds + N_SEL);
    for (int i = tid; i < 4096; i += 512) lut[i] = T.LUT8[(i >> 2) * 8 + g * 4 + (i & 3)];
    for (int i = tid; i < 16384; i += 512) imp[i] = 0.f;
    const int ql = r32 >> 2, hd = r32 & 3, h8 = g * 4 + hd, tq = q0 + 8 * wid + ql;
    bf16x8 qf[4];
    { const bf16_t* qp = T.PROJ + (size_t)tq * 5632 + 768 + h8 * 64 + hi * 8;
#pragma unroll
      for (int d0 = 0; d0 < 4; ++d0) qf[d0] = *(const bf16x8*)(qp + d0 * 16); }
    const int srow = tid >> 3, sch = tid & 7;
    const int vlane = (4 * hi + ((lane & 15) >> 2)) * T_KS + 2 * (16 * ((lane >> 4) & 1) + 4 * (lane & 3));
    u32x4 kr, vr;
    __syncthreads();
    const int nmax = (q0 + 32) / 16 + 1;
    const int ntc = (nmax + 63) >> 6;
    const bf16_t* kc = T.KCMP + (size_t)g * 1024 * 64; const bf16_t* vc = T.VCMP + (size_t)g * 1024 * 64;
    const int relq = tq - 31;
    float m = NEGBIG, l = 0.f;
    kr = *(const u32x4*)(kc + (size_t)srow * 64 + sch * 8);
    *(LAS u32x4*)(lds + srow * T_KS + sch * 16) = kr; __syncthreads();
    for (int j = 0; j < ntc; ++j) {
        const bool more = j + 1 < ntc;
        if (more) kr = *(const u32x4*)(kc + (size_t)(64 * (j + 1) + srow) * 64 + sch * 8);
        const LAS char* kt = lds + (j & 1) * T_BUF;
#pragma unroll
        for (int hh = 0; hh < 2; ++hh) {
            f32x16 s = qk32<64, T_KS>(kt + (32 * hh + r32) * T_KS + hi * 16, qf);
            float mx = NEGBIG;
#pragma unroll
            for (int r = 0; r < 16; ++r) { const int rel = relq - 16 * (64 * j + 32 * hh + crow(r, hi)); const bool valid = rel >= 0;
                s[r] = valid ? s[r] + lut[(rel < 1023 ? rel : 1023) * 4 + hd] : NEGBIG; mx = fmaxf(mx, s[r]); }
            const float mn = fmaxf(m, mx); l *= fast_exp2(m - mn); m = mn;
#pragma unroll
            for (int r = 0; r < 16; ++r) l += (s[r] > -1e29f) ? fast_exp2(s[r] - mn) : 0.f;
        }
        if (more) *(LAS u32x4*)(lds + ((j + 1) & 1) * T_BUF + srow * T_KS + sch * 16) = kr;
        __syncthreads();
    }
    { const float mp = sx32(m, hi), lp = sx32(l, hi), mt = fmaxf(m, mp); l = l * fast_exp2(m - mt) + lp * fast_exp2(mp - mt); m = mt; }
    const float inv_l = l > 0.f ? 1.f / l : 0.f;
    f32x16 oc[2];
#pragma unroll
    for (int i = 0; i < 16; ++i) { oc[0][i] = 0.f; oc[1][i] = 0.f; }
    float cprev = 0.f;
    kr = *(const u32x4*)(kc + (size_t)srow * 64 + sch * 8); vr = *(const u32x4*)(vc + (size_t)srow * 64 + sch * 8);
    { LAS char* d_ = lds + srow * T_KS + sch * 16; *(LAS u32x4*)d_ = kr; *(LAS u32x4*)(d_ + T_KB) = vr; } __syncthreads();
    for (int j = 0; j < ntc; ++j) {
        const bool more = j + 1 < ntc;
        if (more) { kr = *(const u32x4*)(kc + (size_t)(64 * (j + 1) + srow) * 64 + sch * 8); vr = *(const u32x4*)(vc + (size_t)(64 * (j + 1) + srow) * 64 + sch * 8); }
        const LAS char* kt = lds + (j & 1) * T_BUF; const LAS char* vt = kt + T_KB;
#pragma unroll
        for (int hh = 0; hh < 2; ++hh) {
            f32x16 s = qk32<64, T_KS>(kt + (32 * hh + r32) * T_KS + hi * 16, qf);
#pragma unroll
            for (int r = 0; r < 16; ++r) { const int rel = relq - 16 * (64 * j + 32 * hh + crow(r, hi)); const bool valid = rel >= 0;
                s[r] = valid ? fast_exp2(s[r] + lut[(rel < 1023 ? rel : 1023) * 4 + hd] - m) * inv_l : 0.f; }
            float gs[4], c3[4], pc3[4];
#pragma unroll
            for (int gi = 0; gi < 4; ++gi) { float a = (s[4 * gi] + s[4 * gi + 1]) + (s[4 * gi + 2] + s[4 * gi + 3]), b = s[4 * gi + 3];
                a += sx<1>(a); a += sx<2>(a); b += sx<1>(b); b += sx<2>(b); gs[gi] = a; c3[gi] = b; }
#pragma unroll
            for (int gi = 0; gi < 4; ++gi) pc3[gi] = sx32(c3[gi], hi);
            const int b0 = 16 * j + 8 * hh + hi;
            if (hd == 0) {
                LAS float* ip = imp + (8 * wid + ql) * 256 + b0;
                if (hi == 1) {
#pragma unroll
                    for (int gi = 0; gi < 4; ++gi) ip[2 * gi] = gs[gi] + pc3[gi];
                } else { ip[0] = gs[0] + cprev; ip[2] = gs[1] + pc3[0]; ip[4] = gs[2] + pc3[1]; ip[6] = gs[3] + pc3[2]; }
            }
            cprev = pc3[3];
            pv32<T_KS>(oc, vt + (32 * hh) * T_KS + vlane, pack8(s, 0), pack8(s, 1));
        }
        if (more) { LAS char* d_ = lds + ((j + 1) & 1) * T_BUF + srow * T_KS + sch * 16; *(LAS u32x4*)d_ = kr; *(LAS u32x4*)(d_ + T_KB) = vr; }
        __syncthreads();
    }
    const int ncnt = qblk + 1 < 16 ? qblk + 1 : 16;
    if (qblk < 16) {
        for (int i = lane; i < 8 * 16; i += 64) sel[(8 * wid + (i >> 4)) * 16 + (i & 15)] = (i & 15) <= qblk ? (i & 15) : 0;
    } else {
        for (int q = 0; q < 8; ++q) {
            const LAS float* ip = imp + (8 * wid + q) * 256;
            unsigned long long key[4];
#pragma unroll
            for (int i = 0; i < 4; ++i) { const int b = lane + 64 * i; key[i] = (b >= 1 && b <= qblk - 2) ? (((unsigned long long)__float_as_uint(ip[b]) << 32) | (unsigned)(~b)) : 0ull; }
            for (int rnd = 0; rnd < 13; ++rnd) {
                unsigned long long best = key[0] > key[1] ? key[0] : key[1]; { const unsigned long long b2 = key[2] > key[3] ? key[2] : key[3]; best = best > b2 ? best : b2; }
#define TK_STEP(K) { const unsigned lo_ = sxu<K>((unsigned)best), hh_ = sxu<K>((unsigned)(best >> 32)); const unsigned long long ot_ = ((unsigned long long)hh_ << 32) | lo_; best = best > ot_ ? best : ot_; }
                TK_STEP(1) TK_STEP(2) TK_STEP(4) TK_STEP(8) TK_STEP(16)
#undef TK_STEP
                { const unsigned lo_ = sx32u((unsigned)best, hi), hh_ = sx32u((unsigned)(best >> 32), hi); const unsigned long long ot_ = ((unsigned long long)hh_ << 32) | lo_; best = best > ot_ ? best : ot_; }
                const int bsel = (int)(~(unsigned)best);
#pragma unroll
                for (int i = 0; i < 4; ++i) if (lane + 64 * i == bsel) key[i] = 0ull;
                if (lane == 0) sel[(8 * wid + q) * 16 + 3 + rnd] = bsel;
            }
            if (lane == 0) { sel[(8 * wid + q) * 16] = 0; sel[(8 * wid + q) * 16 + 1] = qblk; sel[(8 * wid + q) * 16 + 2] = qblk - 1; }
        }
    }
    LAS float* outw = imp + wid * 2048;
    { const float gc = T.GN[(size_t)tq * 24 + 3 * h8];
#pragma unroll
      for (int dh = 0; dh < 2; ++dh)
#pragma unroll
          for (int r = 0; r < 16; ++r) outw[r32 * 64 + 32 * dh + crow(r, hi)] = gc * oc[dh][r]; }
    {
        const int c16 = lane & 15, qi = c16 >> 2, hs = c16 & 3, quad = lane >> 4, hs8 = g * 4 + hs;
        const bf16_t* ksg = T.KS + (size_t)g * 16384 * 64; const bf16_t* vtg = T.VTS + (size_t)g * 256 * 4096;
        const LAS float* lut_h = lut + hs;
        for (int qd = 0; qd < 2; ++qd) {
            const int qloc = 8 * wid + 4 * qd + qi, ts = q0 + qloc;
            bf16x8 bq[4][2];
            { const bf16_t* qp = T.PROJ + (size_t)ts * 5632 + 768 + hs8 * 64 + quad * 8; const bf16x8 q0v = *(const bf16x8*)qp, q1v = *(const bf16x8*)(qp + 32); const bf16x8 zz = {0, 0, 0, 0, 0, 0, 0, 0};
#pragma unroll
              for (int x = 0; x < 4; ++x) { bq[x][0] = (qi == x) ? q0v : zz; bq[x][1] = (qi == x) ? q1v : zz; } }
            float ms = NEGBIG, lsum = 0.f; f32x4 os[4];
#pragma unroll
            for (int dt = 0; dt < 4; ++dt) os[dt] = (f32x4){0.f, 0.f, 0.f, 0.f};
            for (int it = 0; it < ncnt; ++it) {
                const int bown = sel[qloc * 16 + it];
                int bx[4];
#pragma unroll
                for (int x = 0; x < 4; ++x) bx[x] = rfl(sel[(8 * wid + 4 * qd + x) * 16 + it]);
                f32x4 sc[4];
#pragma unroll
                for (int u = 0; u < 4; ++u) { sc[u] = (f32x4){0.f, 0.f, 0.f, 0.f};
#pragma unroll
                    for (int x = 0; x < 4; ++x) { const bf16_t* kp = ksg + (size_t)(bx[x] * 64 + 16 * u + c16) * 64 + quad * 8;
                        sc[u] = mfma16(*(const bf16x8*)kp, bq[x][0], sc[u]); sc[u] = mfma16(*(const bf16x8*)(kp + 32), bq[x][1], sc[u]); } }
                float mx = NEGBIG;
#pragma unroll
                for (int u = 0; u < 4; ++u)
#pragma unroll
                    for (int e = 0; e < 4; ++e) { const int rel = ts - (bown * 64 + 16 * u + 4 * quad + e); const bool valid = rel >= 0;
                        const float v = valid ? sc[u][e] + lut_h[(rel < 1023 ? rel : 1023) * 4] : NEGBIG; sc[u][e] = v; mx = fmaxf(mx, v); }
                mx = fmaxf(mx, sx<16>(mx)); mx = fmaxf(mx, sx32(mx, hi));
                const float mn = fmaxf(ms, mx), alpha = fast_exp2(ms - mn); ms = mn;
                float ls = 0.f;
#pragma unroll
                for (int u = 0; u < 4; ++u)
#pragma unroll
                    for (int e = 0; e < 4; ++e) { const float p = (sc[u][e] > -1e29f) ? fast_exp2(sc[u][e] - mn) : 0.f; sc[u][e] = p; ls += p; }
                lsum = lsum * alpha + ls;
#pragma unroll
                for (int dt = 0; dt < 4; ++dt) os[dt] = os[dt] * alpha;
#pragma unroll
                for (int v = 0; v < 2; ++v) {
                    u32x4 pw; pw.x = cvtpk(sc[2 * v][0], sc[2 * v][1]); pw.y = cvtpk(sc[2 * v][2], sc[2 * v][3]); pw.z = cvtpk(sc[2 * v + 1][0], sc[2 * v + 1][1]); pw.w = cvtpk(sc[2 * v + 1][2], sc[2 * v + 1][3]);
                    const bf16x8 pk = __builtin_bit_cast(bf16x8, pw); const bf16x8 zz = {0, 0, 0, 0, 0, 0, 0, 0};
#pragma unroll
                    for (int x = 0; x < 4; ++x) { const bf16x8 pm = (qi == x) ? pk : zz;
#pragma unroll
                        for (int dt = 0; dt < 4; ++dt) { const bf16_t* vp = vtg + (size_t)(bx[x] * 64 + 16 * dt + c16) * 64 + 32 * v + 8 * quad; os[dt] = mfma16(*(const bf16x8*)vp, pm, os[dt]); } }
                }
            }
            lsum += sx<16>(lsum); lsum = sum32sym(lsum);
            const float gsel = T.GN[(size_t)ts * 24 + 3 * hs8 + 1] / lsum;
            LAS float* op = outw + ((4 * qd + qi) * 4 + hs) * 64;
#pragma unroll
            for (int dt = 0; dt < 4; ++dt)
#pragma unroll
                for (int e = 0; e < 4; ++e) op[16 * dt + 4 * quad + e] += gsel * os[dt][e];
        }
    }
    {
        const bf16_t* kw = T.KW + (size_t)g * 16384 * 64; const bf16_t* vw = T.PROJ + 1920 + g * 64;
        const int kt0 = qblk > 8 ? qblk - 8 : 0, ntw = qblk - kt0 + 1;
        float mw = NEGBIG, lw = 0.f; f32x16 ow[2];
#pragma unroll
        for (int i = 0; i < 16; ++i) { ow[0][i] = 0.f; ow[1][i] = 0.f; }
        __syncthreads();
        kr = *(const u32x4*)(kw + (size_t)(64 * kt0 + srow) * 64 + sch * 8); vr = *(const u32x4*)(vw + (size_t)(64 * kt0 + srow) * 5632 + sch * 8);
        { LAS char* d_ = lds + srow * T_KS + sch * 16; *(LAS u32x4*)d_ = kr; *(LAS u32x4*)(d_ + T_KB) = vr; } __syncthreads();
        for (int j = 0; j < ntw; ++j) {
            const bool more = j + 1 < ntw;
            if (more) { kr = *(const u32x4*)(kw + (size_t)(64 * (kt0 + j + 1) + srow) * 64 + sch * 8); vr = *(const u32x4*)(vw + (size_t)(64 * (kt0 + j + 1) + srow) * 5632 + sch * 8); }
            const LAS char* kt = lds + (j & 1) * T_BUF; const LAS char* vt = kt + T_KB;
            f32x16 p[2]; float mx = NEGBIG;
#pragma unroll
            for (int hh = 0; hh < 2; ++hh) { p[hh] = qk32<64, T_KS>(kt + (32 * hh + r32) * T_KS + hi * 16, qf);
#pragma unroll
                for (int r = 0; r < 16; ++r) { const int rel = tq - (64 * (kt0 + j) + 32 * hh + crow(r, hi)); const bool valid = rel >= 0 && rel < 512;
                    const float v = valid ? p[hh][r] + lut[(rel < 0 ? 0 : rel) * 4 + hd] : NEGBIG; p[hh][r] = v; mx = fmaxf(mx, v); } }
            mx = fmaxf(mx, sx32(mx, hi));
            const float mn = fmaxf(mw, mx), alpha = fast_exp2(mw - mn); mw = mn;
            float ls = 0.f;
#pragma unroll
            for (int hh = 0; hh < 2; ++hh)
#pragma unroll
                for (int r = 0; r < 16; ++r) { const float e = (p[hh][r] > -1e29f) ? fast_exp2(p[hh][r] - mn) : 0.f; p[hh][r] = e; ls += e; }
            lw = lw * alpha + ls;
#pragma unroll
            for (int r = 0; r < 16; ++r) { ow[0][r] *= alpha; ow[1][r] *= alpha; }
            pv32<T_KS>(ow, vt + vlane, pack8(p[0], 0), pack8(p[0], 1));
            pv32<T_KS>(ow, vt + 32 * T_KS + vlane, pack8(p[1], 0), pack8(p[1], 1));
            if (more) { LAS char* d_ = lds + ((j + 1) & 1) * T_BUF + srow * T_KS + sch * 16; *(LAS u32x4*)d_ = kr; *(LAS u32x4*)(d_ + T_KB) = vr; }
            __syncthreads();
        }
        lw = sum32sym(lw);
        const float gw = T.GN[(size_t)tq * 24 + 3 * h8 + 2] / lw;
#pragma unroll
        for (int dh = 0; dh < 2; ++dh)
#pragma unroll
            for (int r = 0; r < 16; ++r) ow[dh][r] = outw[r32 * 64 + 32 * dh + crow(r, hi)] + gw * ow[dh][r];
        store_ot(T.ATT + (size_t)tq * 1024 + 256 + h8 * 64, ow, hi);
    }
    __syncthreads();
}
}
constexpr int S = 16384, DM = 1024, NPROJ = 5632, INC = 5560, DFF = 2816, EFF = 3584, NEXP = 8;
constexpr int NWAVES = 8;
constexpr float EPS = 1e-6f;
constexpr float QK_SCALE64 = 0.125f * LOG2E;
constexpr float QK_SCALE96 = 0.10206207261596575f * LOG2E;
#ifndef MK_MULTI
#define MK_MULTI 0
#endif
constexpr int PC_SBQ = 0, PC_SBK = 256, PC_SBV = 512, PC_NQ = 768, PC_NKC = 1280, PC_NVC = 1408, PC_NKS = 1536, PC_NVS = 1664, PC_NKW = 1792, PC_NVW = 1920,
              PC_CQ = 2048, PC_CKV = 2304, PC_KR = 2432, PC_NG = 2464, PC_GATE = 2560;
__host__ __device__ __forceinline__ int win_oldcol(int c) {
    if (c < 2048) return c; if (c < 2464) return c + 24; if (c < 2488) return 2048 + (c - 2464); if (c < 2560) return -1; return c - 72; }

constexpr size_t MiB = 1u << 20;
constexpr size_t WS_CTL = 0, CTL_ZERO_BYTES = 1 * MiB;
constexpr size_t WS_LW = 1 * MiB, LW_STRIDE = 18 * MiB;
constexpr size_t LW_WIN = 0, LW_SBO = 11 * MiB, LW_NSAO = LW_SBO + MiB / 2, LW_MLAO = LW_NSAO + MiB, LW_WOUT = LW_MLAO + MiB / 2, LW_WUQ = LW_WOUT + 2 * MiB, LW_WUKV = LW_WUQ + MiB / 4, LW_CW1 = LW_WUKV + MiB / 4;
constexpr size_t WS_DGU = 37 * MiB, WS_DDN = 48 * MiB;
constexpr size_t WS_Y = 1 * MiB;
constexpr size_t WS_H = 74 * MiB;
constexpr size_t WS_ROPE = 106 * MiB;
constexpr size_t WS_LUT8 = 108 * MiB, WS_B1P = WS_LUT8 + 256 * 1024, WS_B1 = WS_LUT8 + 512 * 1024, WS_ROUTE = 109 * MiB, WS_ROWTOK = WS_ROUTE + 512 * 1024;
constexpr size_t WS_R1 = 110 * MiB;
constexpr size_t WS_MGU = WS_R1, WS_MDN = WS_R1 + 112 * MiB;
constexpr size_t WS_R2 = 296 * MiB;
constexpr size_t R2_KC = 0, R2_VC = R2_KC + 4 * MiB + MiB / 4, R2_KS = R2_VC + 4 * MiB + MiB / 4, R2_VTS = R2_KS + 4 * MiB, R2_KW = R2_VTS + 4 * MiB, R2_GN = R2_KW + 4 * MiB,
                 R2_QM = R2_GN + 2 * MiB, R2_KM = R2_QM + 12 * MiB, R2_HID = R2_KM + 12 * MiB, R2_KCMP = R2_HID + 2 * MiB, R2_VCMP = R2_KCMP + MiB / 4, R2_ATT = R2_VCMP + MiB / 4 + MiB / 2,
                 R2_MRG = R2_ATT + 32 * MiB, R2_QRAW = R2_MRG, R2_KVRAW = R2_MRG + 16 * MiB, R2_END = R2_MRG + 32 * MiB;
static_assert(R2_END <= 136 * MiB, "attention scratch");
constexpr size_t WS_END = 432 * MiB;
constexpr int KC_ROWS = S + 32;
constexpr int CW_TMO = 0, CW_BAR = 4096, CW_MOECNT = 16384;
constexpr int RING_BYTES = 131072, LDSCTL_OFF = RING_BYTES, MISC_OFF = LDSCTL_OFF + 320, LDS_BYTES = 147456;


#define LDS_WAIT() asm volatile("s_waitcnt lgkmcnt(0)" ::: "memory")
#define VM_WAIT() asm volatile("s_waitcnt vmcnt(0)" ::: "memory")
DI float wave_sum(float v) { v += sx<1>(v); v += sx<2>(v); v += sx<4>(v); v += sx<8>(v); v += sx<16>(v); return sum32sym(v); }

struct TrSrc { const float* a; const float* b; int ldn; int nsrc; int mode; };
DI float tr_fetch(const TrSrc& s, int k, int n) {
    if (s.mode == 0) return n < s.nsrc ? s.a[(size_t)k * s.ldn + n] : 0.f;
    if (s.mode == 1) { const int oc = win_oldcol(n); return oc >= 0 ? s.a[(size_t)k * s.ldn + oc] : 0.f; }
    const int tile = n >> 8, w = n & 255; const long d = (w < 128) ? 0l : (long)((const char*)s.b - (const char*)s.a);
    return ((const float*)((const char*)s.a + d))[(size_t)k * s.ldn + 128 * tile + (w & 127)];
}
DI void tr_item(const TrSrc& s, int K, bf16_t* WT, LAS float* scr, int kb, int nb, int lane) {
    const int k0 = 64 * kb, n0 = 32 * nb;
#pragma unroll 8
    for (int i = 0; i < 32; ++i) { const int kk = 2 * i + (lane >> 5); scr[kk * 33 + (lane & 31)] = tr_fetch(s, k0 + kk, n0 + (lane & 31)); }
    LDS_WAIT(); asm volatile("" ::: "memory");
    const int c = lane & 7;
#pragma unroll
    for (int j = 0; j < 4; ++j) { const int n = (lane >> 3) + 8 * j; const LAS float* p = scr + (8 * c) * 33 + n;
        u32x4 o; o.x = cvtpk(p[0 * 33], p[1 * 33]); o.y = cvtpk(p[2 * 33], p[3 * 33]); o.z = cvtpk(p[4 * 33], p[5 * 33]); o.w = cvtpk(p[6 * 33], p[7 * 33]);
        *(u32x4*)(WT + (size_t)(n0 + n) * K + k0 + 8 * c) = o; }
    LDS_WAIT(); asm volatile("" ::: "memory");
}
DI void tr_matrix(const TrSrc& s, int K, int ndst, bf16_t* WT, LAS float* scr, int gw, int ngw, int lane) {
    const int nblk = ndst / 32, nitems = (K / 64) * nblk;
    for (int it = gw; it < nitems; it += ngw) tr_item(s, K, WT, scr, it / nblk, it % nblk, lane);
}

struct In {
    const float *x, *bias_table, *mix_norm, *w_in, *b_gate, *sb_w_o, *nsa_q_norm, *nsa_k_norm, *nsa_cmp_pos, *nsa_cmp_w1, *nsa_cmp_w2, *nsa_w_o, *mla_q_a_norm, *mla_kv_a_norm,
        *mla_w_uq, *mla_w_ukv, *mla_q_norm, *mla_k_norm, *mla_w_o, *w_out, *ffn_norm, *dense_w_gate, *dense_w_up, *dense_w_down, *moe_router, *moe_w_gate, *moe_w_up, *moe_w_down;
};
struct Args { In in; float* out; unsigned char* ws; int ph_lo, ph_hi; };

DI void rms_row(const float* xrow, const float* gain, bf16_t* orow, int lane, f32x4 (&v)[4]) {
    const f32x4* xr = (const f32x4*)xrow + lane; float s = 0.f;
#pragma unroll
    for (int j = 0; j < 4; ++j) { v[j] = xr[64 * j]; s += (v[j].x * v[j].x + v[j].y * v[j].y) + (v[j].z * v[j].z + v[j].w * v[j].w); }
    const float rstd = 1.f / sqrtf(wave_sum(s) * (1.f / 1024.f) + EPS);
    u32x2* o8 = (u32x2*)orow + lane;
#pragma unroll
    for (int j = 0; j < 4; ++j) { const f32x4 g = ((const f32x4*)gain)[lane + 64 * j]; v[j] = v[j] * rstd * g; u32x2 w; w.x = cvtpk(v[j].x, v[j].y); w.y = cvtpk(v[j].z, v[j].w); o8[64 * j] = w; }
}

DI int t5_bucket(int n) {
    if (n < 16) return n;
    int b = 16;
    b += n >= 21; b += n >= 27; b += n >= 35; b += n >= 46; b += n >= 59; b += n >= 77; b += n >= 99; b += n >= 128; b += n >= 166; b += n >= 216; b += n >= 280; b += n >= 363; b += n >= 470; b += n >= 609; b += n >= 790;
    return b;
}

struct MoeTab { int cnt[8]; int tb[9]; };
struct MoeGU {
    const volatile LAS int* tab; const bf16_t* Hb; const bf16_t* W; const int* rowtok; int t_lo, t_hi, G, c;
    DI bool next(int i, pg8::Unit& u) const {
        const int nrt = t_hi - t_lo; if (nrt <= 0) return false;
        const long L = (long)i * G + c; if (L >= (long)nrt * 28) return false;
        const int rt = t_lo + (int)(L % nrt), pn = (int)(L / nrt);
        int e = 0;
#pragma unroll
        for (int k = 1; k < 8; ++k) e += (tab[8 + k] <= rt) ? 1 : 0;
        const int j = rt - tab[8 + e], cnt = tab[e];
        u.a = Hb; u.b = W + ((size_t)e * 7168 + 256 * pn) * 1024; u.rows = rowtok + e * S + 256 * j; u.nvalid = (cnt - 256 * j) < 256 ? (cnt - 256 * j) : 256; u.pm = rt - t_lo; u.pn = pn; return true;
    }
};
struct MoeDN {
    const volatile LAS int* tab; const bf16_t* ACT; const bf16_t* W; int t_lo, t_hi, G, c;
    DI bool next(int i, pg8::Unit& u) const {
        const int nrt = t_hi - t_lo; if (nrt <= 0) return false;
        const long L = (long)i * G + c; if (L >= (long)nrt * 4) return false;
        const int rt = t_lo + (int)(L % nrt), pn = (int)(L / nrt);
        int e = 0;
#pragma unroll
        for (int k = 1; k < 8; ++k) e += (tab[8 + k] <= rt) ? 1 : 0;
        u.a = ACT + (size_t)(rt - t_lo) * 256 * EFF; u.b = W + ((size_t)e * 1024 + 256 * pn) * EFF; u.rows = nullptr; u.nvalid = 256; u.pm = rt; u.pn = pn; return true;
    }
};
constexpr int PH_PER_LAYER = 16, NPHASES = 1 + 2 * PH_PER_LAYER;
__global__ void __launch_bounds__(NWAVES * 64, 2) fwd_kernel(Args args) {
    extern __shared__ __attribute__((aligned(16))) unsigned char lds_raw[];
    LAS unsigned char* lds = (LAS unsigned char*)lds_raw;
    volatile LAS unsigned* MISC = (volatile LAS unsigned*)(lds + MISC_OFF);
    volatile LAS int* MTAB = (volatile LAS int*)(lds + MISC_OFF + 64);
    const int tid0 = threadIdx.x, wave = __builtin_amdgcn_readfirstlane(tid0 >> 6);
    const int G = gridDim.x, bid = blockIdx.x, vcu = (G % 8 == 0) ? (bid % 8) * (G / 8) + bid / 8 : bid;
    const int gw0 = vcu * NWAVES + wave, NGW = G * NWAVES;
    unsigned char* ws = args.ws; const In in = args.in;
    gu32* ctl = (gu32*)(ws + WS_CTL);
    for (int u = tid0; u < (LDS_BYTES - LDSCTL_OFF) / 4; u += NWAVES * 64) ((LAS unsigned*)(lds + LDSCTL_OFF))[u] = 0u;
    __syncthreads();
#if MK_MULTI
#define GRID_BAR() do { } while (0)
#else
    XcdBarrier bar = xcd_barrier_post((unsigned*)(ctl + CW_BAR), MISC + 8);
#define GRID_BAR() xcd_barrier(bar)
#endif
    const int lo = args.ph_lo, hi = args.ph_hi;
#ifndef ONLY_PHASE
#define ONLY_PHASE -1
#endif
#ifndef PHMASK
#define PHMASK 0x1ffff
#endif
#define PHON(n) ((ONLY_PHASE < 0 || ONLY_PHASE == (n)) && ((PHMASK >> ((n) == 99 ? 16 : (n))) & 1))
#define IN(k) (lo <= (k) && (k) < hi)
#define SEAM(k) do { if (IN((k) + 1)) GRID_BAR(); } while (0)
#define PHASE_LOCALS int tid = tid0; asm volatile("" : "+v"(tid)); const int lane = tid & 63; int gw = gw0; asm volatile("" : "+s"(gw)); unsigned char* wsl = ws; asm volatile("" : "+s"(wsl)); (void)lane; (void)gw; (void)wsl;

#define lw (wsl + WS_LW + (size_t)l * LW_STRIDE)
#define Hb ((bf16_t*)(wsl + WS_H))
#define PROJ ((bf16_t*)(wsl + WS_R1))
#define R2P(off) (wsl + WS_R2 + (off))
#define KC ((bf16_t*)R2P(R2_KC))
#define VC ((bf16_t*)R2P(R2_VC))
#define KS ((bf16_t*)R2P(R2_KS))
#define VTS ((bf16_t*)R2P(R2_VTS))
#define KW ((bf16_t*)R2P(R2_KW))
#define GN ((float*)R2P(R2_GN))
#define QM ((bf16_t*)R2P(R2_QM))
#define KM ((bf16_t*)R2P(R2_KM))
#define HID ((bf16_t*)R2P(R2_HID))
#define KCMP ((bf16_t*)R2P(R2_KCMP))
#define VCMP ((bf16_t*)R2P(R2_VCMP))
#define ATT ((bf16_t*)R2P(R2_ATT))
#define MRG ((bf16_t*)R2P(R2_MRG))
#define QRAW ((bf16_t*)R2P(R2_QRAW))
#define KVRAW ((bf16_t*)R2P(R2_KVRAW))
#define ROPE ((float*)(wsl + WS_ROPE))
#define LUT8 ((float*)(wsl + WS_LUT8))
#define B1P ((float*)(wsl + WS_B1P))
#define B1 ((float*)(wsl + WS_B1))
#define ROUTE ((int*)(wsl + WS_ROUTE))
#define ROWTOK ((int*)(wsl + WS_ROWTOK))
    LAS float* scr = (LAS float*)(lds + wave * 16384);

    if (PHON(99) && IN(0)) { PHASE_LOCALS
        for (int l = 0; l < 2; ++l) {
            tr_matrix(TrSrc{in.w_in + (size_t)l * 1024 * INC, nullptr, INC, INC, 1}, 1024, NPROJ, (bf16_t*)(lw + LW_WIN), scr, gw, NGW, lane);
            tr_matrix(TrSrc{in.sb_w_o + (size_t)l * 256 * 1024, nullptr, 1024, 1024, 0}, 256, 1024, (bf16_t*)(lw + LW_SBO), scr, gw, NGW, lane);
            tr_matrix(TrSrc{in.nsa_w_o + (size_t)l * 512 * 1024, nullptr, 1024, 1024, 0}, 512, 1024, (bf16_t*)(lw + LW_NSAO), scr, gw, NGW, lane);
            tr_matrix(TrSrc{in.mla_w_o + (size_t)l * 256 * 1024, nullptr, 1024, 1024, 0}, 256, 1024, (bf16_t*)(lw + LW_MLAO), scr, gw, NGW, lane);
            tr_matrix(TrSrc{in.w_out + (size_t)l * 1024 * 1024, nullptr, 1024, 1024, 0}, 1024, 1024, (bf16_t*)(lw + LW_WOUT), scr, gw, NGW, lane);
            tr_matrix(TrSrc{in.mla_w_uq + (size_t)l * 256 * 384, nullptr, 384, 384, 0}, 256, 512, (bf16_t*)(lw + LW_WUQ), scr, gw, NGW, lane);
            tr_matrix(TrSrc{in.mla_w_ukv + (size_t)l * 128 * 512, nullptr, 512, 512, 0}, 128, 512, (bf16_t*)(lw + LW_WUKV), scr, gw, NGW, lane);
            for (int kv = 0; kv < 2; ++kv)
                tr_matrix(TrSrc{in.nsa_cmp_w1 + (size_t)(l * 2 + kv) * 2048 * 256, nullptr, 256, 256, 0}, 2048, 256, (bf16_t*)(lw + LW_CW1) + (size_t)kv * 256 * 2048, scr, gw, NGW, lane);
        }
        tr_matrix(TrSrc{in.dense_w_gate, in.dense_w_up, DFF, DFF, 2}, 1024, 2 * DFF, (bf16_t*)(wsl + WS_DGU), scr, gw, NGW, lane);
        tr_matrix(TrSrc{in.dense_w_down, nullptr, 1024, 1024, 0}, DFF, 1024, (bf16_t*)(wsl + WS_DDN), scr, gw, NGW, lane);
        const int gt = vcu * 512 + tid, NT = G * 512;
        for (int i = gt; i < S * 16; i += NT) {
            const int pos = i >> 4, fi = i & 15; const float inv = powf(10000.f, -(float)fi / 16.f); const float ang = (float)pos * inv;
            const double rev = (double)ang * 0.15915494309189535; const float fr = (float)(rev - rint(rev));
            ROPE[i] = __builtin_amdgcn_cosf(fr); ROPE[S * 16 + i] = __builtin_amdgcn_sinf(fr); }
        for (int i = gt; i < 1024 * 8; i += NT) LUT8[i] = in.bias_table[t5_bucket(i >> 3) * 8 + (i & 7)] * LOG2E;
        for (int it = gw; it < 512; it += NGW) {
            const int kc = it & 31, cb = (it >> 5) & 3, lk = it >> 7; const float* pos = in.nsa_cmp_pos + (size_t)lk * 2048; const float* w1 = in.nsa_cmp_w1 + (size_t)lk * 2048 * 256;
            float a = 0.f; for (int k = 64 * kc; k < 64 * kc + 64; ++k) a += pos[k] * w1[(size_t)k * 256 + 64 * cb + lane];
            B1P[(lk * 32 + kc) * 256 + 64 * cb + lane] = a; }
        for (int i = gt; i < 2 * 2 * 32 * 64 / 8; i += NT) { const int z = i / 256, r = i % 256; bf16_t* p = (z >> 1 ? VC : KC) + ((size_t)(z & 1) * KC_ROWS + S) * 64 + r * 8; *(u32x4*)p = (u32x4){0u, 0u, 0u, 0u}; }
        SEAM(0);
    }

    for (int l = 0; l < 2; ++l) {
        const int pb = 1 + PH_PER_LAYER * l;
        const float* x_in = (l == 0) ? in.x : args.out; float* x_out = args.out;
        if (PHON(0) && IN(pb + 0)) { PHASE_LOCALS
            for (int m = gw; m < S; m += NGW) { f32x4 v[4]; rms_row(x_in + (size_t)m * 1024, in.mix_norm + l * 1024, Hb + (size_t)m * 1024, lane, v); }
            if (l == 0 && bid == 0) for (int i = tid; i < 1024; i += 512) { float a = 0.f; for (int kc = 0; kc < 32; ++kc) a += B1P[((i >> 8) * 32 + kc) * 256 + (i & 255)]; B1[i] = a; }
            SEAM(pb + 0);
        }
        if (PHON(1) && IN(pb + 1)) { PHASE_LOCALS
            pg8::StaticOrder So; So.init(Hb, (const bf16_t*)(lw + LW_WIN), 1024, 1024, S, NPROJ, G, bid);
            pg8::EpiStore E{PROJ, NPROJ, nullptr, QK_SCALE64, 0};
            pg8::gemm_phase<pg8::EpiStore, pg8::StaticOrder, true, false>(lds, 1024, 1024, 1024, So, E);
            SEAM(pb + 1);
        }
        if (PHON(2) && IN(pb + 2)) { PHASE_LOCALS
            for (int t = gw; t < S; t += NGW) {
                bf16_t* pr = PROJ + (size_t)t * NPROJ;
                {
                    const u32x4 w = *(const u32x4*)(pr + PC_NQ + lane * 8); float v[8] = {bflo(w.x), bfhi(w.x), bflo(w.y), bfhi(w.y), bflo(w.z), bfhi(w.z), bflo(w.w), bfhi(w.w)};
                    float ss = 0.f;
#pragma unroll
                    for (int e = 0; e < 8; ++e) ss += v[e] * v[e];
                    ss += sx<1>(ss); ss += sx<2>(ss); ss += sx<4>(ss);
                    const float rs = QK_SCALE64 / sqrtf(ss * (1.f / 64.f) + EPS); const float* gq = in.nsa_q_norm + l * 64 + 8 * (lane & 7);
                    u32x4 o; o.x = cvtpk(v[0] * rs * gq[0], v[1] * rs * gq[1]); o.y = cvtpk(v[2] * rs * gq[2], v[3] * rs * gq[3]); o.z = cvtpk(v[4] * rs * gq[4], v[5] * rs * gq[5]); o.w = cvtpk(v[6] * rs * gq[6], v[7] * rs * gq[7]);
                    *(u32x4*)(pr + PC_NQ + lane * 8) = o;
                }
                {
                    const int sec = lane >> 4, gg = (lane >> 3) & 1, d8 = 8 * (lane & 7);
                    const int col = (sec == 0 ? PC_NKS : sec == 1 ? PC_NKW : sec == 2 ? PC_NKC : PC_NVC) + (lane & 15) * 8;
                    const u32x4 w = *(const u32x4*)(pr + col); float v[8] = {bflo(w.x), bfhi(w.x), bflo(w.y), bfhi(w.y), bflo(w.z), bfhi(w.z), bflo(w.w), bfhi(w.w)};
                    float ss = 0.f;
#pragma unroll
                    for (int e = 0; e < 8; ++e) ss += v[e] * v[e];
                    ss += sx<1>(ss); ss += sx<2>(ss); ss += sx<4>(ss);
                    const float rs = 1.f / sqrtf(ss * (1.f / 64.f) + EPS);
                    u32x4 o = w;
                    if (sec < 2) { const float* gk = in.nsa_k_norm + (l * 3 + 1 + sec) * 64 + d8;
                        o.x = cvtpk(v[0] * rs * gk[0], v[1] * rs * gk[1]); o.y = cvtpk(v[2] * rs * gk[2], v[3] * rs * gk[3]); o.z = cvtpk(v[4] * rs * gk[4], v[5] * rs * gk[5]); o.w = cvtpk(v[6] * rs * gk[6], v[7] * rs * gk[7]); }
                    bf16_t* dst = (sec == 0 ? KS + ((size_t)gg * S + t) * 64 : sec == 1 ? KW + ((size_t)gg * S + t) * 64 : sec == 2 ? KC + ((size_t)gg * KC_ROWS + t) * 64 : VC + ((size_t)gg * KC_ROWS + t) * 64) + d8;
                    *(u32x4*)dst = o;
                }
                {
                    const u32x2 w = *(const u32x2*)(pr + PC_CQ + lane * 4); float v[4] = {bflo(w.x), bfhi(w.x), bflo(w.y), bfhi(w.y)};
                    const float rs = 1.f / sqrtf(wave_sum((v[0] * v[0] + v[1] * v[1]) + (v[2] * v[2] + v[3] * v[3])) * (1.f / 256.f) + EPS); const float* ga = in.mla_q_a_norm + l * 256 + lane * 4;
                    u32x2 o; o.x = cvtpk(v[0] * rs * ga[0], v[1] * rs * ga[1]); o.y = cvtpk(v[2] * rs * ga[2], v[3] * rs * ga[3]); *(u32x2*)(pr + PC_CQ + lane * 4) = o;
                    const unsigned w2 = *(const unsigned*)(pr + PC_CKV + lane * 2); const float a = bflo(w2), b = bfhi(w2);
                    const float rs2 = 1.f / sqrtf(wave_sum(a * a + b * b) * (1.f / 128.f) + EPS); const float* gb = in.mla_kv_a_norm + l * 128 + lane * 2;
                    *(unsigned*)(pr + PC_CKV + lane * 2) = cvtpk(a * rs2 * gb[0], b * rs2 * gb[1]);
                }
                if (lane < 24) GN[(size_t)t * 24 + lane] = sigmoidf_(bf2f(pr[PC_NG + lane]));
            }
            for (int it = gw; it < 512; it += NGW) {
                const int gg = it >> 8, blk = it & 255; const bf16_t* src = PROJ + (size_t)(blk * 64) * NPROJ + PC_NVS + gg * 64 + lane; bf16_t* dst = VTS + ((size_t)(gg * 256 + blk) * 64 + lane) * 64;
                for (int s8 = 0; s8 < 8; ++s8) { unsigned short e[8];
#pragma unroll
                    for (int j = 0; j < 8; ++j) { const int s = 8 * s8 + j, s5 = s & 31, quad = s5 >> 3, jj = s5 & 7; const int k = (s & 32) + (jj < 4 ? 4 * quad + jj : 16 + 4 * quad + (jj - 4)); e[j] = src[(size_t)k * NPROJ]; }
                    u32x4 o; o.x = e[0] | ((unsigned)e[1] << 16); o.y = e[2] | ((unsigned)e[3] << 16); o.z = e[4] | ((unsigned)e[5] << 16); o.w = e[6] | ((unsigned)e[7] << 16);
                    *(u32x4*)(dst + 8 * s8) = o; }
            }
            SEAM(pb + 2);
        }
        if (PHON(3) && IN(pb + 3)) { PHASE_LOCALS
            for (int job = 0; job < 6; ++job) {
                pg8::StaticOrder So; pg8::EpiStore E; int lda, ldb, K;
                const bool wide = (G >= 256);
                if (job == 0) { lda = NPROJ; ldb = 256; K = 256; So.init(PROJ + PC_CQ, (const bf16_t*)(lw + LW_WUQ), lda, ldb, S, 512, wide ? 128 : G, wide ? (bid < 128 ? bid : -1) : bid); E = pg8::EpiStore{QRAW, 512, nullptr, 1.f, 0}; }
                else if (job == 1) { lda = NPROJ; ldb = 128; K = 128; So.init(PROJ + PC_CKV, (const bf16_t*)(lw + LW_WUKV), lda, ldb, S, 512, wide ? 128 : G, wide ? (bid >= 128 && bid < 256 ? bid - 128 : -1) : bid); E = pg8::EpiStore{KVRAW, 512, nullptr, 1.f, 0}; }
                else { const int z = job - 2, kv = z >> 1, gg = z & 1; lda = 1024; ldb = 2048; K = 2048;
                    So.init((kv ? VC : KC) + (size_t)gg * KC_ROWS * 64, (const bf16_t*)(lw + LW_CW1) + (size_t)kv * 256 * 2048, lda, ldb, 1024, 256, wide ? 4 : G, wide ? ((bid >= 32 * z && bid < 32 * z + 4) ? bid - 32 * z : -1) : bid);
                    E = pg8::EpiStore{HID + (size_t)z * 1024 * 256, 256, B1 + (l * 2 + kv) * 256, 1.f, 1}; }
                pg8::gemm_phase<pg8::EpiStore, pg8::StaticOrder, true, false>(lds, lda, ldb, K, So, E);
            }
            SEAM(pb + 3);
        }
        if (PHON(4) && IN(pb + 4)) { PHASE_LOCALS
            for (int t = gw; t < S; t += NGW) {
                const int hd = lane >> 4, i = lane & 15; const float c = ROPE[t * 16 + i], s = ROPE[S * 16 + t * 16 + i];
                {   const bf16_t* src = QRAW + (size_t)t * 512 + hd * 96 + i; float v[6]; float ss = 0.f;
#pragma unroll
                    for (int e = 0; e < 6; ++e) { v[e] = bf2f(src[16 * e]); ss += v[e] * v[e]; }
                    ss += sx<1>(ss); ss += sx<2>(ss); ss += sx<4>(ss); ss += sx<8>(ss);
                    const float rs = 1.f / sqrtf(ss * (1.f / 96.f) + EPS); const float* gq = in.mla_q_norm + l * 96 + i;
#pragma unroll
                    for (int e = 0; e < 6; ++e) v[e] = v[e] * rs * gq[16 * e];
                    const float x1 = v[4], x2 = v[5]; v[4] = x1 * c - x2 * s; v[5] = x2 * c + x1 * s;
                    bf16_t* dst = QM + (size_t)t * 384 + hd * 96 + i;
#pragma unroll
                    for (int e = 0; e < 6; ++e) dst[16 * e] = f2bf(v[e] * QK_SCALE96); }
                {   const bf16_t* src = KVRAW + (size_t)t * 512 + hd * 128 + i; const bf16_t* kr = PROJ + (size_t)t * NPROJ + PC_KR + i; float v[6]; float ss = 0.f;
#pragma unroll
                    for (int e = 0; e < 4; ++e) v[e] = bf2f(src[16 * e]);
                    v[4] = bf2f(kr[0]); v[5] = bf2f(kr[16]);
#pragma unroll
                    for (int e = 0; e < 6; ++e) ss += v[e] * v[e];
                    ss += sx<1>(ss); ss += sx<2>(ss); ss += sx<4>(ss); ss += sx<8>(ss);
                    const float rs = 1.f / sqrtf(ss * (1.f / 96.f) + EPS); const float* gk = in.mla_k_norm + l * 96 + i;
#pragma unroll
                    for (int e = 0; e < 6; ++e) v[e] = v[e] * rs * gk[16 * e];
                    const float x1 = v[4], x2 = v[5]; v[4] = x1 * c - x2 * s; v[5] = x2 * c + x1 * s;
                    bf16_t* dst = KM + (size_t)t * 384 + hd * 96 + i;
#pragma unroll
                    for (int e = 0; e < 6; ++e) dst[16 * e] = f2bf(v[e]); }
            }
            for (int it = gw; it < 4096; it += NGW) {
                const int z = it >> 10, n = it & 1023, kv = z >> 1, gg = z & 1; const bf16_t* hrow = HID + ((size_t)z * 1024 + n) * 256; const float* w2 = in.nsa_cmp_w2 + (size_t)(l * 2 + kv) * 256 * 64;
                { const u32x2 w = *(const u32x2*)(hrow + lane * 4); scr[lane * 4] = bflo(w.x); scr[lane * 4 + 1] = bfhi(w.x); scr[lane * 4 + 2] = bflo(w.y); scr[lane * 4 + 3] = bfhi(w.y); }
                LDS_WAIT(); asm volatile("" ::: "memory");
                float a = 0.f;
#pragma unroll 8
                for (int j = 0; j < 256; ++j) a += scr[j] * w2[j * 64 + lane];
                if (kv == 0) { const float rs = 1.f / sqrtf(wave_sum(a * a) * (1.f / 64.f) + EPS); KCMP[((size_t)gg * 1024 + n) * 64 + lane] = f2bf(a * rs * in.nsa_k_norm[(l * 3) * 64 + lane]); }
                else VCMP[((size_t)gg * 1024 + n) * 64 + lane] = f2bf(a);
                LDS_WAIT(); asm volatile("" ::: "memory");
            }
            SEAM(pb + 4);
        }
        if (PHON(5) && IN(pb + 5)) { PHASE_LOCALS
            __syncthreads();
            for (int u = vcu; u < 256; u += G) att::sb_unit((LAS char*)lds, PROJ, ATT, u >> 6, u & 63);
            for (int p = vcu; p < 256; p += G) { att::mla_unit((LAS char*)lds, QM, KM, KVRAW, ATT, p >> 6, 127 - (p & 63)); att::mla_unit((LAS char*)lds, QM, KM, KVRAW, ATT, p >> 6, p & 63); }
            att::NsaT T{PROJ, KCMP, VCMP, KS, VTS, KW, GN, LUT8, ATT};
            for (int p = vcu; p < 256; p += G) { att::nsa_unit((LAS char*)lds, T, p >> 7, 255 - (p & 127)); att::nsa_unit((LAS char*)lds, T, p >> 7, p & 127); }
            SEAM(pb + 5);
        }
        if (PHON(6) && IN(pb + 6)) { PHASE_LOCALS
            for (int mix = 0; mix < 3; ++mix) {
                const int K = (mix == 1) ? 512 : 256; const int acol = (mix == 0) ? 0 : (mix == 1) ? 256 : 768;
                const bf16_t* Bt = (const bf16_t*)(lw + (mix == 0 ? LW_SBO : mix == 1 ? LW_NSAO : LW_MLAO));
                pg8::StaticOrder So; So.init(ATT + acol, Bt, 1024, K, S, 1024, G, bid);
                pg8::EpiGate E{MRG, PROJ + PC_GATE + mix * 1024, NPROJ, in.b_gate + l * 3072 + mix * 1024, mix == 0 ? 1 : 0};
                pg8::gemm_phase<pg8::EpiGate, pg8::StaticOrder, true, false>(lds, 1024, K, K, So, E);
            }
            SEAM(pb + 6);
        }
        if (PHON(7) && IN(pb + 7)) { PHASE_LOCALS
            pg8::StaticOrder So; So.init(MRG, (const bf16_t*)(lw + LW_WOUT), 1024, 1024, S, 1024, G, bid);
            pg8::EpiResid E{x_in, x_out};
            pg8::gemm_phase<pg8::EpiResid, pg8::StaticOrder, true, false>(lds, 1024, 1024, 1024, So, E);
            SEAM(pb + 7);
        }
        if (PHON(8) && IN(pb + 8)) { PHASE_LOCALS
            if (l == 1) {
                for (int it = gw; it < 8 * 3584; it += NGW) { const int e = it / 3584, r = it % 3584;
                    tr_item(TrSrc{in.moe_w_gate + (size_t)e * 1024 * EFF, in.moe_w_up + (size_t)e * 1024 * EFF, EFF, EFF, 2}, 1024, (bf16_t*)(wsl + WS_MGU) + (size_t)e * 7168 * 1024, scr, r / 224, r % 224, lane); }
                for (int it = gw; it < 8 * 1792; it += NGW) { const int e = it / 1792, r = it % 1792;
                    tr_item(TrSrc{in.moe_w_down + (size_t)e * EFF * 1024, nullptr, 1024, 1024, 0}, EFF, (bf16_t*)(wsl + WS_MDN) + (size_t)e * 1024 * EFF, scr, r / 32, r % 32, lane); }
            }
            for (int m = gw; m < S; m += NGW) {
                f32x4 v[4]; rms_row(x_out + (size_t)m * 1024, in.ffn_norm + l * 1024, Hb + (size_t)m * 1024, lane, v);
                if (l == 1) {
                    float lg[8];
#pragma unroll
                    for (int e = 0; e < 8; ++e) lg[e] = 0.f;
#pragma unroll
                    for (int j = 0; j < 4; ++j)
#pragma unroll
                        for (int q = 0; q < 4; ++q) { const float* wr = in.moe_router + (size_t)(4 * lane + 256 * j + q) * 8; const f32x4 wa = *(const f32x4*)wr, wb = *(const f32x4*)(wr + 4); const float hv = v[j][q];
                            lg[0] += hv * wa.x; lg[1] += hv * wa.y; lg[2] += hv * wa.z; lg[3] += hv * wa.w; lg[4] += hv * wb.x; lg[5] += hv * wb.y; lg[6] += hv * wb.z; lg[7] += hv * wb.w; }
#pragma unroll
                    for (int e = 0; e < 8; ++e) lg[e] = wave_sum(lg[e]);
                    int e0 = 0; float v0 = lg[0];
#pragma unroll
                    for (int e = 1; e < 8; ++e) if (lg[e] > v0) { v0 = lg[e]; e0 = e; }
                    int e1 = -1; float v1 = -INFINITY;
#pragma unroll
                    for (int e = 0; e < 8; ++e) if (e != e0 && lg[e] > v1) { v1 = lg[e]; e1 = e; }
                    if (lane == 0) { const float w0 = 1.f / (1.f + __expf(v1 - v0)), w1 = 1.f - w0;
                        const int p0 = (int)__hip_atomic_fetch_add(ctl + CW_MOECNT + 64 * e0, 1u, RLX_AGENT), p1 = (int)__hip_atomic_fetch_add(ctl + CW_MOECNT + 64 * e1, 1u, RLX_AGENT);
                        ROWTOK[e0 * S + p0] = m; ROWTOK[e1 * S + p1] = m;
                        int* r = ROUTE + (size_t)m * 8; r[0] = e0; r[1] = e1; r[2] = p0; r[3] = p1; r[4] = __float_as_int(w0); r[5] = __float_as_int(w1); }
                }
            }
            SEAM(pb + 8);
        }
        if (l == 0) {
#define ACT0 ((bf16_t*)(wsl + WS_R1))
            if (PHON(9) && IN(pb + 9)) { PHASE_LOCALS
                pg8::StaticOrder So; So.init(Hb, (const bf16_t*)(wsl + WS_DGU), 1024, 1024, S, 2 * DFF, G, bid);
                pg8::EpiSwiglu E{ACT0, DFF};
                pg8::gemm_phase<pg8::EpiSwiglu, pg8::StaticOrder, true, false>(lds, 1024, 1024, 1024, So, E);
                SEAM(pb + 9);
            }
            if (PHON(10) && IN(pb + 10)) { PHASE_LOCALS
                pg8::StaticOrder So; So.init(ACT0, (const bf16_t*)(wsl + WS_DDN), DFF, DFF, S, 1024, G, bid);
                pg8::EpiResid E{x_out, x_out};
                pg8::gemm_phase<pg8::EpiResid, pg8::StaticOrder, true, false>(lds, DFF, DFF, DFF, So, E);
                SEAM(pb + 10);
            }
        } else {
#define ACT1 ((bf16_t*)(wsl + WS_R2))
#define YB ((bf16_t*)(wsl + WS_Y))
            for (int ps = 0; ps < 3; ++ps) {
                if (PHON(11) && IN(pb + 9 + 2 * ps)) { PHASE_LOCALS
                    if (tid == 0) { int tb = 0; for (int e = 0; e < 8; ++e) { const int c = (int)__hip_atomic_load(ctl + CW_MOECNT + 64 * e, RLX_AGENT); MTAB[e] = c; MTAB[8 + e] = tb; tb += (c + 255) >> 8; } MTAB[16] = tb; }
                    __syncthreads();
                    const int T = MTAB[16], tlo = 64 * ps, thi = T < tlo + 64 ? T : tlo + 64;
                    MoeGU So{MTAB, Hb, (const bf16_t*)(wsl + WS_MGU), ROWTOK, tlo, thi, G, bid};
                    pg8::EpiSwiglu E{ACT1, EFF};
                    pg8::gemm_phase<pg8::EpiSwiglu, MoeGU, true, true>(lds, 1024, 1024, 1024, So, E);
                    SEAM(pb + 9 + 2 * ps);
                }
                if (PHON(12) && IN(pb + 10 + 2 * ps)) { PHASE_LOCALS
                    if (tid == 0) { int tb = 0; for (int e = 0; e < 8; ++e) { const int c = (int)__hip_atomic_load(ctl + CW_MOECNT + 64 * e, RLX_AGENT); MTAB[e] = c; MTAB[8 + e] = tb; tb += (c + 255) >> 8; } MTAB[16] = tb; }
                    __syncthreads();
                    const int T = MTAB[16], tlo = 64 * ps, thi = T < tlo + 64 ? T : tlo + 64;
                    MoeDN So{MTAB, ACT1, (const bf16_t*)(wsl + WS_MDN), tlo, thi, G, bid};
                    pg8::EpiStore E{YB, 1024, nullptr, 1.f, 0};
                    pg8::gemm_phase<pg8::EpiStore, MoeDN, true, false>(lds, EFF, EFF, EFF, So, E);
                    SEAM(pb + 10 + 2 * ps);
                }
            }
            if (PHON(15) && IN(pb + 15)) { PHASE_LOCALS
                if (tid == 0) { int tb = 0; for (int e = 0; e < 8; ++e) { const int c = (int)__hip_atomic_load(ctl + CW_MOECNT + 64 * e, RLX_AGENT); MTAB[e] = c; MTAB[8 + e] = tb; tb += (c + 255) >> 8; } MTAB[16] = tb; }
                __syncthreads();
                for (int m = gw; m < S; m += NGW) {
                    const int* r = ROUTE + (size_t)m * 8; const int e0 = r[0], e1 = r[1]; const float w0 = __int_as_float(r[4]), w1 = __int_as_float(r[5]);
                    const bf16_t* y0 = YB + ((size_t)MTAB[8 + e0] * 256 + r[2]) * 1024; const bf16_t* y1 = YB + ((size_t)MTAB[8 + e1] * 256 + r[3]) * 1024;
                    float* xo = x_out + (size_t)m * 1024;
#pragma unroll
                    for (int j = 0; j < 4; ++j) { const int c = 4 * lane + 256 * j; f32x4 xv = *(const f32x4*)(xo + c); const u32x2 a = *(const u32x2*)(y0 + c), b = *(const u32x2*)(y1 + c);
                        xv.x += w0 * bflo(a.x) + w1 * bflo(b.x); xv.y += w0 * bfhi(a.x) + w1 * bfhi(b.x); xv.z += w0 * bflo(a.y) + w1 * bflo(b.y); xv.w += w0 * bfhi(a.y) + w1 * bfhi(b.y);
                        *(f32x4*)(xo + c) = xv; }
                }
                if (l == 0) SEAM(pb + 15);
            }
        }
    }
#undef IN
#undef SEAM
}

extern "C" void kernel_launch(void* const* d_in, const int* in_sizes, int n_in, void* d_out, int out_size, void* d_ws, size_t ws_size, hipStream_t stream) {
    static int grid = 0;
    if (grid == 0) {
        if (n_in != 28 || in_sizes[0] != S * DM || out_size != S * DM || ws_size < WS_END) { fprintf(stderr, "kernel_launch: unexpected problem (n_in %d, in0 %d, out %d, ws %zu < %zu); nothing launched\n", n_in, n_in > 0 ? in_sizes[0] : -1, out_size, ws_size, (size_t)WS_END); grid = -1; return; }
        int dev = 0, cus = 0, per_cu = 0;
        if (hipGetDevice(&dev) != hipSuccess || hipDeviceGetAttribute(&cus, hipDeviceAttributeMultiprocessorCount, dev) != hipSuccess) { grid = -1; return; }
        if (hipFuncSetAttribute((const void*)fwd_kernel, hipFuncAttributeMaxDynamicSharedMemorySize, LDS_BYTES) != hipSuccess) { fprintf(stderr, "kernel_launch: hipFuncSetAttribute failed\n"); grid = -1; return; }
        if (hipOccupancyMaxActiveBlocksPerMultiprocessor(&per_cu, (const void*)fwd_kernel, NWAVES * 64, LDS_BYTES) != hipSuccess || per_cu < 1) { fprintf(stderr, "kernel_launch: occupancy query reports %d blocks per CU\n", per_cu); (void)hipGetLastError(); }
        grid = cus;
    }
    if (grid < 0) return;
    if (hipMemsetAsync((char*)d_ws + WS_CTL, 0, CTL_ZERO_BYTES, stream) != hipSuccess) return;
    Args a{};
    const float** ip = (const float**)&a.in;
    for (int i = 0; i < 28; ++i) ip[i] = (const float*)d_in[i];
    a.out = (float*)d_out; a.ws = (unsigned char*)d_ws;
#if MK_MULTI
    for (int ph = 0; ph < NPHASES; ++ph) {
        if (ph >= 1 + 11 && ph < 1 + PH_PER_LAYER) continue;
        a.ph_lo = ph; a.ph_hi = ph + 1;
        hipLaunchKernelGGL(fwd_kernel, dim3(grid), dim3(NWAVES * 64), LDS_BYTES, stream, a);
    }
#else
    a.ph_lo = 0; a.ph_hi = NPHASES;
    hipLaunchKernelGGL(fwd_kernel, dim3(grid), dim3(NWAVES * 64), LDS_BYTES, stream, a);
#endif
    const hipError_t le = hipPeekAtLastError();
    if (le != hipSuccess) fprintf(stderr, "kernel_launch: launch failed: %s\n", hipGetErrorName(le));
}
```

```cpp
#include <hip/hip_runtime.h>
#include <cstdio>
#include <cstdint>
#include <cmath>

#define LAS __attribute__((address_space(3)))
#define GAS __attribute__((address_space(1)))
typedef unsigned short bf16_t;
typedef short bf16x8 __attribute__((ext_vector_type(8)));
typedef short s16x4 __attribute__((ext_vector_type(4)));
typedef float f32x2 __attribute__((ext_vector_type(2)));
typedef float f32x4 __attribute__((ext_vector_type(4)));
typedef float f32x16 __attribute__((ext_vector_type(16)));
typedef unsigned u32x2 __attribute__((ext_vector_type(2)));
typedef unsigned u32x4 __attribute__((ext_vector_type(4)));
typedef __bf16 bf16x2_t __attribute__((ext_vector_type(2)));
typedef GAS unsigned gu32;
#define RLX_AGENT __ATOMIC_RELAXED, __HIP_MEMORY_SCOPE_AGENT
#define DI __device__ __forceinline__

DI unsigned cvtpk(float lo, float hi) { f32x2 v = {lo, hi}; bf16x2_t b = __builtin_convertvector(v, bf16x2_t); return __builtin_bit_cast(unsigned, b); }
DI float bf2f(bf16_t b) { return __uint_as_float(((unsigned)b) << 16); }
DI float bflo(unsigned w) { return __uint_as_float(w << 16); }
DI float bfhi(unsigned w) { return __uint_as_float(w & 0xffff0000u); }
DI bf16_t f2bf(float f) { return (bf16_t)(cvtpk(f, 0.f) & 0xffffu); }
DI float fast_exp2(float x) { return __builtin_amdgcn_exp2f(x); }
DI float fast_log2(float x) { return __builtin_amdgcn_logf(x); }
DI float fast_rcp(float x) { return __builtin_amdgcn_rcpf(x); }
constexpr float LOG2E = 1.4426950408889634f;
DI float sigmoidf_(float x) { return fast_rcp(1.f + fast_exp2(-x * LOG2E)); }
DI float siluf_(float x) { return x * sigmoidf_(x); }
template <int K> DI unsigned sxu(unsigned v) { return (unsigned)__builtin_amdgcn_ds_swizzle((int)v, (K << 10) | 0x1f); }
template <int K> DI float sx(float v) { return __uint_as_float(sxu<K>(__float_as_uint(v))); }
DI unsigned sx32u(unsigned v, int hi) { auto rr = __builtin_amdgcn_permlane32_swap(v, v, false, false); return hi ? rr[0] : rr[1]; }
DI float sx32(float v, int hi) { return __uint_as_float(sx32u(__float_as_uint(v), hi)); }
DI float sum32sym(float v) { auto rr = __builtin_amdgcn_permlane32_swap(__float_as_uint(v), __float_as_uint(v), false, false); return __uint_as_float(rr[0]) + __uint_as_float(rr[1]); }

namespace pg8 {
constexpr int BM = 256, BK = 64, HALF = 128, HTB = HALF * BK * 2, STAGE_BYTES = 8 * HTB, NXCD = 8, WGM = 8;
__host__ __device__ __forceinline__ int lds_byte(int r, int c) { const int st = (r >> 4) * 2 + (c >> 5), rr = r & 15, cc = c & 31, ob = rr * 64 + cc * 2; return st * 1024 + (ob ^ (((ob >> 9) & 1) << 5)); }
__host__ __device__ __forceinline__ void stage_rc(int b, int& R, int& C) { const int st = b / 1024, sb = b % 1024, swz = sb ^ (((sb >> 9) & 1) << 5); R = (st >> 1) * 16 + swz / 64; C = (st & 1) * 32 + (swz % 64) / 2; }
__host__ __device__ __forceinline__ int perm32(int rho) { const int n = rho >> 4, i = rho & 15; return 8 * (i >> 2) + 4 * n + (i & 3); }

struct Unit { const bf16_t* a; const bf16_t* b; const int* rows; int nvalid, pm, pn; };

struct StaticOrder {
    const bf16_t* A; const bf16_t* Bt; int lda, ldb, nM, nN, nwg, G, c;
    DI void init(const bf16_t* A_, const bf16_t* Bt_, int lda_, int ldb_, int M, int N, int G_, int c_) { A = A_; Bt = Bt_; lda = lda_; ldb = ldb_; nM = M / BM; nN = N / BM; nwg = nM * nN; G = G_; c = c_; }
    DI bool next(int i, Unit& u) const {
        if (c < 0 || c >= G) return false;
        const long L = (long)i * G + c; if (L >= nwg) return false;
        int wgid = (int)L; { const int q = nwg / NXCD, r = nwg % NXCD, xcd = wgid % NXCD, off = wgid / NXCD; wgid = (xcd < r ? xcd * (q + 1) : r * (q + 1) + (xcd - r) * q) + off; }
        const int nig = WGM * nN, gid = wgid / nig, fm = gid * WGM, gsz = (nM - fm) < WGM ? (nM - fm) : WGM;
        u.pm = fm + ((wgid % nig) % gsz); u.pn = (wgid % nig) / gsz;
        u.a = A + (size_t)u.pm * BM * lda; u.b = Bt + (size_t)u.pn * BM * ldb; u.rows = nullptr; u.nvalid = BM; return true;
    }
};

struct EpiStore {
    static constexpr bool PERM = true;
    bf16_t* O; int ldc; const float* bias; float scale0; int act;
    DI void operator()(const f32x4 (&acc)[2][2][4][2], const Unit& u, int wr, int wc, int fr, int fq) const {
        const int row0 = u.pm * BM + wr * 64 + fr, col0 = u.pn * BM + wc * 32 + 8 * fq;
        const float sc = (u.pn == 0) ? scale0 : 1.f;
        f32x4 bv[2][2];
#pragma unroll
        for (int bj = 0; bj < 2; ++bj)
#pragma unroll
            for (int n = 0; n < 2; ++n) bv[bj][n] = bias ? *(const f32x4*)(bias + col0 + bj * HALF + 4 * n) : (f32x4){0.f, 0.f, 0.f, 0.f};
#pragma unroll
        for (int ai = 0; ai < 2; ++ai)
#pragma unroll
            for (int m = 0; m < 4; ++m) { bf16_t* rowp = O + (size_t)(row0 + ai * HALF + m * 16) * ldc + col0;
#pragma unroll
                for (int bj = 0; bj < 2; ++bj) { f32x4 v0 = (acc[ai][bj][m][0] + bv[bj][0]) * sc, v1 = (acc[ai][bj][m][1] + bv[bj][1]) * sc;
                    if (act) {
#pragma unroll
                        for (int e = 0; e < 4; ++e) { v0[e] = siluf_(v0[e]); v1[e] = siluf_(v1[e]); } }
                    u32x4 w; w.x = cvtpk(v0[0], v0[1]); w.y = cvtpk(v0[2], v0[3]); w.z = cvtpk(v1[0], v1[1]); w.w = cvtpk(v1[2], v1[3]);
                    *(u32x4*)(rowp + bj * HALF) = w; } }
    }
};
struct EpiGate {
    static constexpr bool PERM = true;
    bf16_t* Mg; const bf16_t* glog; int ldg; const float* bg; int first;
    DI void operator()(const f32x4 (&acc)[2][2][4][2], const Unit& u, int wr, int wc, int fr, int fq) const {
        const int row0 = u.pm * BM + wr * 64 + fr, col0 = u.pn * BM + wc * 32 + 8 * fq;
        f32x4 bv[2][2];
#pragma unroll
        for (int bj = 0; bj < 2; ++bj)
#pragma unroll
            for (int n = 0; n < 2; ++n) bv[bj][n] = *(const f32x4*)(bg + col0 + bj * HALF + 4 * n);
#pragma unroll
        for (int ai = 0; ai < 2; ++ai)
#pragma unroll
            for (int m = 0; m < 4; ++m) { const size_t row = (size_t)(row0 + ai * HALF + m * 16);
#pragma unroll
                for (int bj = 0; bj < 2; ++bj) { const int col = col0 + bj * HALF;
                    const u32x4 gl = *(const u32x4*)(glog + row * ldg + col);
                    u32x4 old = (u32x4){0u, 0u, 0u, 0u}; if (!first) old = *(const u32x4*)(Mg + row * 1024 + col);
                    float g[8] = {bflo(gl.x), bfhi(gl.x), bflo(gl.y), bfhi(gl.y), bflo(gl.z), bfhi(gl.z), bflo(gl.w), bfhi(gl.w)};
                    float o[8] = {bflo(old.x), bfhi(old.x), bflo(old.y), bfhi(old.y), bflo(old.z), bfhi(old.z), bflo(old.w), bfhi(old.w)};
#pragma unroll
                    for (int e = 0; e < 4; ++e) { o[e] += sigmoidf_(g[e] + bv[bj][0][e]) * acc[ai][bj][m][0][e]; o[4 + e] += sigmoidf_(g[4 + e] + bv[bj][1][e]) * acc[ai][bj][m][1][e]; }
                    u32x4 w; w.x = cvtpk(o[0], o[1]); w.y = cvtpk(o[2], o[3]); w.z = cvtpk(o[4], o[5]); w.w = cvtpk(o[6], o[7]);
                    *(u32x4*)(Mg + row * 1024 + col) = w; } }
    }
};
struct EpiResid {
    static constexpr bool PERM = false;
    const float* xin; float* out;
    DI void operator()(const f32x4 (&acc)[2][2][4][2], const Unit& u, int wr, int wc, int fr, int fq) const {
        const int row0 = u.pm * BM + wr * 64 + fr, col0 = u.pn * BM + wc * 32 + 4 * fq;
#pragma unroll
        for (int ai = 0; ai < 2; ++ai)
#pragma unroll
            for (int m = 0; m < 4; ++m) { const size_t off = (size_t)(row0 + ai * HALF + m * 16) * 1024 + col0;
#pragma unroll
                for (int bj = 0; bj < 2; ++bj)
#pragma unroll
                    for (int n = 0; n < 2; ++n) { const f32x4 b = *(const f32x4*)(xin + off + bj * HALF + n * 16); *(f32x4*)(out + off + bj * HALF + n * 16) = b + acc[ai][bj][m][n]; }
                if (m & 1) asm volatile("" ::: "memory"); }
    }
};
struct EpiSwiglu {
    static constexpr bool PERM = true;
    bf16_t* act; int ldact;
    DI void operator()(const f32x4 (&acc)[2][2][4][2], const Unit& u, int wr, int wc, int fr, int fq) const {
        const int row0 = u.pm * BM + wr * 64 + fr, col0 = u.pn * HALF + wc * 32 + 8 * fq;
#pragma unroll
        for (int ai = 0; ai < 2; ++ai)
#pragma unroll
            for (int m = 0; m < 4; ++m) { bf16_t* rowp = act + (size_t)(row0 + ai * HALF + m * 16) * ldact + col0;
                float o[8];
#pragma unroll
                for (int e = 0; e < 4; ++e) { o[e] = siluf_(acc[ai][0][m][0][e]) * acc[ai][1][m][0][e]; o[4 + e] = siluf_(acc[ai][0][m][1][e]) * acc[ai][1][m][1][e]; }
                u32x4 w; w.x = cvtpk(o[0], o[1]); w.y = cvtpk(o[2], o[3]); w.z = cvtpk(o[4], o[5]); w.w = cvtpk(o[6], o[7]);
                *(u32x4*)rowp = w; }
    }
};

template <class Epi, class Sched, bool ALIGN_EPI, bool GATHER>
__device__ __forceinline__ void gemm_phase(LAS unsigned char* lds, const int lda, const int ldb, const int K, const Sched& S, const Epi& E) {
    int tid_l = threadIdx.x; asm volatile("" : "+v"(tid_l));
    const int tid = tid_l, wid = __builtin_amdgcn_readfirstlane(tid >> 6), lane = tid & 63, wr = wid >> 2, wc = wid & 3, fr = lane & 15, fq = lane >> 4;
    const int nt = K / BK;
    unsigned voffB[2], vc0[2], vc1[2], vn0[2], vn1[2];
#pragma unroll
    for (int i = 0; i < 2; ++i) { int R, C; stage_rc(tid * 16 + i * 8192, R, C); const int Rb = Epi::PERM ? ((R & ~31) + perm32(R & 31)) : R;
        voffB[i] = (unsigned)(Rb * ldb + C) * 2u; vc0[i] = (unsigned)(R * lda + C) * 2u; vc1[i] = vc0[i]; vn0[i] = vc0[i]; vn1[i] = vc0[i]; }
    const size_t hsA = GATHER ? (size_t)0 : (size_t)HALF * lda * 2, hsB = (size_t)HALF * ldb * 2;
    const size_t kstep = (size_t)(BK * 2);
    const unsigned ldsw = (unsigned)wid * 1024u;
    const int aoff = lds_byte(wr * 64 + fr, fq * 8), boff = lds_byte(wc * 32 + fr, fq * 8);
#define PG8_SA(b, h) (((b) * 2 + (h)) * HTB)
#define PG8_SB(b, h) ((4 + (b) * 2 + (h)) * HTB)
#define PG8_STAGE(bufoff, gbase, voff) do { _Pragma("unroll") for (int _i = 0; _i < 2; ++_i) \
        __builtin_amdgcn_global_load_lds((const unsigned*)((const char*)(gbase) + (voff)[_i]), (LAS unsigned*)(lds + (bufoff) + ldsw + _i * 8192), 16, 0, 0); } while (0)
#define PG8_LDA(dst, b, h) do { _Pragma("unroll") for (int m = 0; m < 4; ++m) _Pragma("unroll") for (int k = 0; k < 2; ++k) dst[m][k] = *(const LAS bf16x8*)(lds + PG8_SA(b, h) + aoff + m * 2048 + k * 1024); } while (0)
#define PG8_LDB(dst, b, h) do { _Pragma("unroll") for (int n = 0; n < 2; ++n) _Pragma("unroll") for (int k = 0; k < 2; ++k) dst[n][k] = *(const LAS bf16x8*)(lds + PG8_SB(b, h) + boff + n * 2048 + k * 1024); } while (0)
#define PG8_MMA(ai, bj, At, Bt) do { __builtin_amdgcn_s_setprio(1); _Pragma("unroll") for (int m = 0; m < 4; ++m) _Pragma("unroll") for (int n = 0; n < 2; ++n) _Pragma("unroll") for (int k = 0; k < 2; ++k) \
        acc[ai][bj][m][n] = __builtin_amdgcn_mfma_f32_16x16x32_bf16(Bt[n][k], At[m][k], acc[ai][bj][m][n], 0, 0, 0); __builtin_amdgcn_s_setprio(0); } while (0)
#define PG8_WAIT_V(n) asm volatile("s_waitcnt vmcnt(" #n ")" ::: "memory")
#define PG8_WAIT_L(n) asm volatile("s_waitcnt lgkmcnt(" #n ")" ::: "memory")
#define PG8_BAR __builtin_amdgcn_s_barrier()
#define PG8_SCHED __builtin_amdgcn_sched_barrier(0)
#define PG8_GVOFF(U, o0, o1) do { if constexpr (GATHER) { _Pragma("unroll") for (int _i = 0; _i < 2; ++_i) { int R_, C_; stage_rc(tid * 16 + _i * 8192, R_, C_); \
        const int r0_ = R_, r1_ = R_ + HALF; const int t0_ = (U).rows[r0_ < (U).nvalid ? r0_ : 0], t1_ = (U).rows[r1_ < (U).nvalid ? r1_ : 0]; \
        o0[_i] = (unsigned)(t0_ * lda + C_) * 2u; o1[_i] = (unsigned)(t1_ * lda + C_) * 2u; } } } while (0)
    Unit cur, nxt; int ui = 0;
    if (!S.next(0, cur)) return;
    PG8_GVOFF(cur, vc0, vc1);
    f32x4 acc[2][2][4][2];
#pragma unroll
    for (int a = 0; a < 2; ++a)
#pragma unroll
        for (int b = 0; b < 2; ++b)
#pragma unroll
            for (int m = 0; m < 4; ++m)
#pragma unroll
                for (int n = 0; n < 2; ++n) acc[a][b][m][n] = (f32x4){0.f, 0.f, 0.f, 0.f};
    bf16x8 At[4][2], B0[2][2], B1[2][2];
    const char* cA = (const char*)cur.a; const char* cB = (const char*)cur.b;
    PG8_STAGE(PG8_SB(0, 0), cB, voffB); PG8_STAGE(PG8_SB(0, 1), cB + hsB, voffB); PG8_STAGE(PG8_SA(0, 0), cA, vc0); PG8_STAGE(PG8_SA(0, 1), cA + hsA, vc1);
    if (wr == 1) PG8_BAR;
    PG8_WAIT_V(2); PG8_BAR;
    PG8_STAGE(PG8_SB(1, 0), cB + kstep, voffB); PG8_STAGE(PG8_SA(1, 0), cA + kstep, vc0); PG8_STAGE(PG8_SB(1, 1), cB + hsB + kstep, voffB);
    PG8_WAIT_V(6); PG8_BAR;
    for (;;) {
        const bool has_next = S.next(ui + 1, nxt);
        const char* nA = has_next ? (const char*)nxt.a : cA; const char* nB = has_next ? (const char*)nxt.b : cB;
        if constexpr (GATHER) { if (has_next) { PG8_GVOFF(nxt, vn0, vn1); } else {
#pragma unroll
            for (int i = 0; i < 2; ++i) { vn0[i] = vc0[i]; vn1[i] = vc1[i]; } } }
        for (int t = 0; t < nt; t += 2) {
            const bool last = (t == nt - 2);
            const char* a1 = cA + (size_t)(t + 1) * kstep;
            const char* a2 = last ? nA : cA + (size_t)(t + 2) * kstep; const char* b2 = last ? nB : cB + (size_t)(t + 2) * kstep;
            const char* a3 = a2 + kstep; const char* b3 = b2 + kstep;
            unsigned v20[2], v21[2];
#pragma unroll
            for (int i = 0; i < 2; ++i) { v20[i] = (GATHER && last) ? vn0[i] : vc0[i]; v21[i] = GATHER ? (last ? vn1[i] : vc1[i]) : vc0[i]; }
            PG8_LDB(B0, 0, 0); PG8_LDB(B1, 0, 1); PG8_SCHED; PG8_LDA(At, 0, 0); PG8_STAGE(PG8_SA(1, 1), a1 + hsA, vc1);
            PG8_WAIT_V(8); PG8_WAIT_L(0); PG8_BAR; PG8_MMA(0, 0, At, B0); PG8_MMA(0, 1, At, B1); PG8_BAR; PG8_SCHED;
            PG8_LDA(At, 0, 1); PG8_STAGE(PG8_SB(0, 0), b2, voffB); PG8_STAGE(PG8_SB(0, 1), b2 + hsB, voffB); PG8_STAGE(PG8_SA(0, 0), a2, v20);
            PG8_WAIT_V(8); PG8_WAIT_L(0); PG8_BAR; PG8_MMA(1, 0, At, B0); PG8_MMA(1, 1, At, B1); PG8_BAR; PG8_SCHED;
            PG8_LDB(B0, 1, 0); PG8_LDB(B1, 1, 1); PG8_SCHED; PG8_LDA(At, 1, 0); PG8_STAGE(PG8_SA(0, 1), a2 + hsA, v21);
            PG8_WAIT_V(8); PG8_WAIT_L(0); PG8_BAR; PG8_MMA(0, 0, At, B0); PG8_MMA(0, 1, At, B1); PG8_BAR; PG8_SCHED;
            PG8_LDA(At, 1, 1); PG8_STAGE(PG8_SB(1, 0), b3, voffB); PG8_STAGE(PG8_SB(1, 1), b3 + hsB, voffB); PG8_STAGE(PG8_SA(1, 0), a3, v20);
            PG8_WAIT_V(8); PG8_WAIT_L(0); PG8_BAR; PG8_MMA(1, 0, At, B0); PG8_MMA(1, 1, At, B1); PG8_BAR; PG8_SCHED;
        }
        if constexpr (ALIGN_EPI) { if (wr == 0) PG8_BAR; }
        E(acc, cur, wr, wc, fr, fq);
        if (!has_next) break;
#pragma unroll
        for (int a = 0; a < 2; ++a)
#pragma unroll
            for (int b = 0; b < 2; ++b)
#pragma unroll
                for (int m = 0; m < 4; ++m)
#pragma unroll
                    for (int n = 0; n < 2; ++n) acc[a][b][m][n] = (f32x4){0.f, 0.f, 0.f, 0.f};
        cur = nxt; cA = nA; cB = nB; ++ui;
        if constexpr (GATHER) {
#pragma unroll
            for (int i = 0; i < 2; ++i) { vc0[i] = vn0[i]; vc1[i] = vn1[i]; } }
        if constexpr (ALIGN_EPI) { if (wr == 1) PG8_BAR; }
    }
    PG8_WAIT_V(0);
    if constexpr (!ALIGN_EPI) { if (wr == 0) PG8_BAR; }
    PG8_BAR;
#undef PG8_SA
#undef PG8_SB
#undef PG8_STAGE
#undef PG8_LDA
#undef PG8_LDB
#undef PG8_MMA
#undef PG8_WAIT_V
#undef PG8_WAIT_L
#undef PG8_BAR
#undef PG8_SCHED
#undef PG8_GVOFF
}
}
#define XB_TMO      128
#define XB_XCNT(j)  (256  + 64 * (j))
#define XB_XSUB(j)  (1280 + 64 * (j))
#define XB_XGEN(j)  (2304 + 64 * (j))
#define XB_TOP      3328
#define XB_TOPGEN   3392
#define XCD_BAR_WORDS 3456
#define XB_SPIN_CAP (1u << 18)

__device__ __forceinline__ unsigned xb_ld(unsigned* p)              { return __hip_atomic_load(p, __ATOMIC_RELAXED, __HIP_MEMORY_SCOPE_AGENT); }
__device__ __forceinline__ unsigned xb_add(unsigned* p, unsigned v) { return __hip_atomic_fetch_add(p, v, __ATOMIC_RELAXED, __HIP_MEMORY_SCOPE_AGENT); }
__device__ __forceinline__ unsigned xb_xcc_id() { return (unsigned)__builtin_amdgcn_s_getreg((3 << 11) | 20) & 0xFu; }
#define XB_SPIN(cond, bar) do { unsigned _sp = 0; while (cond) { __builtin_amdgcn_s_sleep(1); \
    if ((++_sp & 255u) == 0u) { if (xb_ld(&(bar)[XB_TMO])) break; if (_sp > XB_SPIN_CAP) { atomicAdd(&(bar)[XB_TMO], 1u); break; } } } } while (0)

struct XcdBarrier {
    unsigned* bar; unsigned x;
    volatile LAS unsigned* st;
};

__device__ __forceinline__ XcdBarrier xcd_barrier_post(unsigned* bar, volatile LAS unsigned* st) {
    XcdBarrier b; b.bar = bar; b.x = xb_xcc_id(); b.st = st;
    if (threadIdx.x == 0) (void)xb_add(&bar[XB_XCNT(b.x)], 1u);
    return b;
}
__device__ __forceinline__ void xcd_barrier_complete(unsigned* bar, unsigned x, unsigned& nloc, unsigned& nx) {
    const unsigned G = gridDim.x * gridDim.y * gridDim.z;
    unsigned sum, cnt, mine, sp = 0u;
    for (;;) {
        sum = 0u; cnt = 0u; mine = 0u;
#pragma unroll
        for (unsigned j = 0; j < 16; ++j) { const unsigned c = xb_ld(&bar[XB_XCNT(j)]); sum += c; cnt += (c > 0u) ? 1u : 0u; mine = (j == x) ? c : mine; }
        if (sum == G) break;
        __builtin_amdgcn_s_sleep(1);
        if ((++sp & 255u) == 0u) { if (xb_ld(&bar[XB_TMO])) break; if (sp > XB_SPIN_CAP) { atomicAdd(&bar[XB_TMO], 1u); break; } }
    }
    nloc = mine > 0u ? mine : 1u; nx = cnt > 0u ? cnt : 1u;
}

__device__ __forceinline__ void xcd_barrier(const XcdBarrier& b) {
    asm volatile("s_waitcnt vmcnt(0)" ::: "memory");
    __syncthreads();
    if (threadIdx.x == 0) {
        unsigned* bar = b.bar;
        __builtin_amdgcn_s_waitcnt(0);
        unsigned nloc = b.st[0], nx = b.st[1];
        if (nloc == 0u) { xcd_barrier_complete(bar, b.x, nloc, nx); b.st[0] = nloc; b.st[1] = nx; }
        const unsigned old = xb_add(&bar[XB_XSUB(b.x)], 1u);
        const unsigned gen = old / nloc;
        if (old + 1u == (gen + 1u) * nloc) {
            __builtin_amdgcn_fence(__ATOMIC_RELEASE, "agent");
            asm volatile("s_waitcnt vmcnt(0)" ::: "memory");
            const unsigned og = xb_add(&bar[XB_TOP], 1u);
            const unsigned tg = og / nx;
            if (og + 1u == (tg + 1u) * nx) xb_add(&bar[XB_TOPGEN], 1u);
            else XB_SPIN(xb_ld(&bar[XB_TOPGEN]) == tg, bar);
            __builtin_amdgcn_fence(__ATOMIC_ACQUIRE, "agent");
            xb_add(&bar[XB_XGEN(b.x)], 1u);
            asm volatile("s_waitcnt vmcnt(0)" ::: "memory");
        } else {
            XB_SPIN(xb_ld(&bar[XB_XGEN(b.x)]) == gen, bar);
            __builtin_amdgcn_fence(__ATOMIC_ACQUIRE, "agent");
            asm volatile("s_waitcnt vmcnt(0)" ::: "memory");
        }
    }
    __syncthreads();
}
namespace att {
typedef short v4i16_t __attribute__((ext_vector_type(4)));
DI f32x16 mfma32(bf16x8 a, bf16x8 b, f32x16 c) { return __builtin_amdgcn_mfma_f32_32x32x16_bf16(a, b, c, 0, 0, 0); }
DI f32x4 mfma16(bf16x8 a, bf16x8 b, f32x4 c) { return __builtin_amdgcn_mfma_f32_16x16x32_bf16(a, b, c, 0, 0, 0); }
DI int crow(int r, int hi) { return (r & 3) + 8 * (r >> 2) + 4 * hi; }
DI s16x4 vtr(const LAS char* p) { return __builtin_bit_cast(s16x4, __builtin_amdgcn_ds_read_tr16_b64_v4i16((LAS v4i16_t*)p)); }
DI int rfl(int x) { return __builtin_amdgcn_readfirstlane(x); }
constexpr float NEGBIG = -1e30f;

template <int D, int KS> DI f32x16 qk32(const LAS char* kp, const bf16x8* qf) {
    f32x16 acc;
#pragma unroll
    for (int i = 0; i < 16; ++i) acc[i] = 0.f;
#pragma unroll
    for (int d0 = 0; d0 < D / 16; ++d0) acc = mfma32(*(const LAS bf16x8*)(kp + d0 * 32), qf[d0], acc);
    return acc;
}
template <int VS> DI void pv32(f32x16 (&o)[2], const LAS char* vp, bf16x8 pf0, bf16x8 pf1) {
#pragma unroll
    for (int dh = 0; dh < 2; ++dh) {
        const s16x4 l0 = vtr(vp + dh * 64), h0 = vtr(vp + 8 * VS + dh * 64), l1 = vtr(vp + 16 * VS + dh * 64), h1 = vtr(vp + 24 * VS + dh * 64);
        const bf16x8 v0 = __builtin_shufflevector(l0, h0, 0, 1, 2, 3, 4, 5, 6, 7), v1 = __builtin_shufflevector(l1, h1, 0, 1, 2, 3, 4, 5, 6, 7);
        o[dh] = mfma32(v0, pf0, o[dh]); o[dh] = mfma32(v1, pf1, o[dh]);
    }
}
DI bf16x8 pack8(const f32x16& p, int s) {
    u32x4 w; w.x = cvtpk(p[8 * s], p[8 * s + 1]); w.y = cvtpk(p[8 * s + 2], p[8 * s + 3]); w.z = cvtpk(p[8 * s + 4], p[8 * s + 5]); w.w = cvtpk(p[8 * s + 6], p[8 * s + 7]);
    return __builtin_bit_cast(bf16x8, w);
}
DI float max16(const f32x16& p) { float a = fmaxf(fmaxf(p[0], p[1]), fmaxf(p[2], p[3]));
#pragma unroll
    for (int r = 4; r < 16; r += 4) a = fmaxf(a, fmaxf(fmaxf(p[r], p[r + 1]), fmaxf(p[r + 2], p[r + 3]))); return a; }
DI void store_ot(bf16_t* dst, const f32x16 (&o)[2], int hi) {
#pragma unroll
    for (int dh = 0; dh < 2; ++dh)
#pragma unroll
        for (int g4 = 0; g4 < 4; ++g4) { u32x2 w; w.x = cvtpk(o[dh][4 * g4], o[dh][4 * g4 + 1]); w.y = cvtpk(o[dh][4 * g4 + 2], o[dh][4 * g4 + 3]); *(u32x2*)(dst + 32 * dh + 8 * g4 + 4 * hi) = w; }
}

constexpr int MLA_KS = 208, MLA_VS = 144, MLA_KB = 128 * MLA_KS, MLA_VB = 128 * MLA_VS, MLA_BUF = MLA_KB + MLA_VB;
DI void mla_unit(LAS char* lds, const bf16_t* QM, const bf16_t* KM, const bf16_t* KV, bf16_t* ATT, int head, int qb) {
    int tid_l = threadIdx.x; asm volatile("" : "+v"(tid_l));
    const int tid = tid_l, lane = tid & 63, wid = rfl(tid >> 6), r32 = lane & 31, hi = lane >> 5, half = wid >> 2, wq = wid & 3;
    const int q0 = qb * 128, qpos = q0 + 32 * wq + r32, nsuper = qb + 1;
    bf16x8 qf[6];
    { const bf16_t* qp = QM + (size_t)qpos * 384 + head * 96 + hi * 8;
#pragma unroll
      for (int d0 = 0; d0 < 6; ++d0) qf[d0] = *(const bf16x8*)(qp + d0 * 16); }
    u32x4 kr[3], vr[2];
#define MLA_LOAD(i) do { _Pragma("unroll") for (int j = 0; j < 3; ++j) { const int c = tid + 512 * j, row = c / 12, ch = c % 12; kr[j] = *(const u32x4*)(KM + (size_t)(128 * (i) + row) * 384 + head * 96 + ch * 8); } \
        _Pragma("unroll") for (int j = 0; j < 2; ++j) { const int c = tid + 512 * j, row = c >> 3, ch = c & 7; vr[j] = *(const u32x4*)(KV + (size_t)(128 * (i) + row) * 512 + head * 128 + 64 + ch * 8); } } while (0)
#define MLA_STORE(b) do { LAS char* kb_ = lds + (b) * MLA_BUF; _Pragma("unroll") for (int j = 0; j < 3; ++j) { const int c = tid + 512 * j, row = c / 12, ch = c % 12; *(LAS u32x4*)(kb_ + row * MLA_KS + ch * 16) = kr[j]; } \
        _Pragma("unroll") for (int j = 0; j < 2; ++j) { const int c = tid + 512 * j, row = c >> 3, ch = c & 7; *(LAS u32x4*)(kb_ + MLA_KB + row * MLA_VS + ch * 16) = vr[j]; } } while (0)
    MLA_LOAD(0); MLA_STORE(0); __syncthreads();
    float m = -INFINITY, l = 0.f; f32x16 o[2];
#pragma unroll
    for (int i = 0; i < 16; ++i) { o[0][i] = 0.f; o[1][i] = 0.f; }
    const int vlane = (4 * hi + ((lane & 15) >> 2)) * MLA_VS + 2 * (16 * ((lane >> 4) & 1) + 4 * (lane & 3));
    for (int i = 0; i < nsuper; ++i) {
        const bool more = i + 1 < nsuper;
        if (more) MLA_LOAD(i + 1);
        const LAS char* kb = lds + (i & 1) * MLA_BUF; const LAS char* vb = kb + MLA_KB;
        const bool diag = (i == nsuper - 1);
        if (!(diag && half == 1 && wq < 2)) {
            const int koff = 64 * half;
            f32x16 p0 = qk32<96, MLA_KS>(kb + (koff + r32) * MLA_KS + hi * 16, qf);
            f32x16 p1 = qk32<96, MLA_KS>(kb + (koff + 32 + r32) * MLA_KS + hi * 16, qf);
            if (diag) { const int kbase = 128 * i + koff;
#pragma unroll
                for (int r = 0; r < 16; ++r) { const int k0 = kbase + crow(r, hi); if (k0 > qpos) p0[r] = -INFINITY; if (k0 + 32 > qpos) p1[r] = -INFINITY; } }
            float mx = fmaxf(max16(p0), max16(p1)); mx = fmaxf(mx, sx32(mx, hi));
            const float mn = fmaxf(m, mx), alpha = fast_exp2(m - mn); m = mn;
            float ls = 0.f;
#pragma unroll
            for (int r = 0; r < 16; ++r) { p0[r] = fast_exp2(p0[r] - mn); p1[r] = fast_exp2(p1[r] - mn); ls += p0[r] + p1[r]; }
            l = l * alpha + ls;
#pragma unroll
            for (int r = 0; r < 16; ++r) { o[0][r] *= alpha; o[1][r] *= alpha; }
            pv32<MLA_VS>(o, vb + koff * MLA_VS + vlane, pack8(p0, 0), pack8(p0, 1));
            pv32<MLA_VS>(o, vb + (koff + 32) * MLA_VS + vlane, pack8(p1, 0), pack8(p1, 1));
        }
        if (more) MLA_STORE((i + 1) & 1);
        __syncthreads();
    }
#undef MLA_LOAD
#undef MLA_STORE
    l = sum32sym(l);
    LAS float* mrg = (LAS float*)lds + (wq * 64 + lane) * 34;
    if (half == 1) { mrg[0] = m; mrg[1] = l;
#pragma unroll
        for (int r = 0; r < 16; ++r) { mrg[2 + r] = o[0][r]; mrg[18 + r] = o[1][r]; } }
    __syncthreads();
    if (half == 0) {
        const float mB = mrg[0], lB = mrg[1], mt = fmaxf(m, mB), fa = fast_exp2(m - mt), fb = fast_exp2(mB - mt), inv = 1.f / (l * fa + lB * fb);
#pragma unroll
        for (int r = 0; r < 16; ++r) { o[0][r] = (o[0][r] * fa + mrg[2 + r] * fb) * inv; o[1][r] = (o[1][r] * fa + mrg[18 + r] * fb) * inv; }
        store_ot(ATT + (size_t)qpos * 1024 + 768 + head * 64, o, hi);
    }
    __syncthreads();
}

constexpr int T_KS = 144, T_KB = 64 * T_KS, T_BUF = 2 * T_KB;
DI void sb_half(f32x16 (&o)[2], float& R, const LAS char* ktile, const LAS char* vtile, const bf16x8* qf, int kb, int hh, int qpos, int r32, int hi, int vlane) {
    f32x16 z = qk32<64, T_KS>(ktile + (32 * hh + r32) * T_KS + hi * 16, qf);
    float ls[16];
#pragma unroll
    for (int r = 0; r < 16; ++r) { const bool valid = (kb + crow(r, hi)) < qpos; const float az = fabsf(z[r]);
        const float sp = fmaxf(z[r], 0.f) + fast_log2(1.f + fast_exp2(-az)); ls[r] = valid ? -sp : 0.f; }
    float T[4], U[4];
#pragma unroll
    for (int g = 0; g < 4; ++g) { ls[4 * g + 2] += ls[4 * g + 3]; ls[4 * g + 1] += ls[4 * g + 2]; ls[4 * g] += ls[4 * g + 1]; T[g] = ls[4 * g]; }
#pragma unroll
    for (int g = 0; g < 4; ++g) U[g] = sx32(T[g], hi);
    float H[4]; float sp = 0.f;
#pragma unroll
    for (int g = 3; g >= 0; --g) { H[g] = sp + (hi == 0 ? U[g] : 0.f); sp += T[g] + U[g]; }
#pragma unroll
    for (int r = 0; r < 16; ++r) { const bool valid = (kb + crow(r, hi)) < qpos; const float lw = z[r] + R + H[r >> 2] + ls[r]; z[r] = valid ? fast_exp2(lw) : 0.f; }
    R += sp;
    pv32<T_KS>(o, vtile + (32 * hh) * T_KS + vlane, pack8(z, 0), pack8(z, 1));
}
DI void sb_unit(LAS char* lds, const bf16_t* PROJ, bf16_t* ATT, int head, int qb) {
    int tid_l = threadIdx.x; asm volatile("" : "+v"(tid_l));
    const int tid = tid_l, lane = tid & 63, wid = rfl(tid >> 6), r32 = lane & 31, hi = lane >> 5;
    const int q0 = qb * 256, wq0 = q0 + 32 * wid, qpos = wq0 + r32;
    bf16x8 qf[4];
    { const bf16_t* qp = PROJ + (size_t)qpos * 5632 + head * 64 + hi * 8;
#pragma unroll
      for (int d0 = 0; d0 < 4; ++d0) qf[d0] = *(const bf16x8*)(qp + d0 * 16); }
    const int srow = tid >> 3, sch = tid & 7;
    u32x4 kr, vr;
#define SB_LOAD(t) do { const bf16_t* p_ = PROJ + (size_t)(64 * (t) + srow) * 5632 + head * 64 + sch * 8; kr = *(const u32x4*)(p_ + 256); vr = *(const u32x4*)(p_ + 512); } while (0)
#define SB_STORE(b) do { LAS char* d_ = lds + (b) * T_BUF + srow * T_KS + sch * 16; *(LAS u32x4*)d_ = kr; *(LAS u32x4*)(d_ + T_KB) = vr; } while (0)
    volatile LAS int* flags = (volatile LAS int*)(lds + 2 * T_BUF);
    int t = 4 * qb + 3;
    SB_LOAD(t); SB_STORE(0); __syncthreads();
    float R = 0.f; f32x16 o[2];
#pragma unroll
    for (int i = 0; i < 16; ++i) { o[0][i] = 0.f; o[1][i] = 0.f; }
    const int vlane = (4 * hi + ((lane & 15) >> 2)) * T_KS + 2 * (16 * ((lane >> 4) & 1) + 4 * (lane & 3));
    bool done = false;
    for (int it = 0;; ++it) {
        const bool more = t > 0;
        if (more) SB_LOAD(t - 1);
        const LAS char* kt = lds + (it & 1) * T_BUF; const LAS char* vt = kt + T_KB;
        if (!done && 64 * t <= wq0 + 30) {
            if (64 * t + 32 <= wq0 + 30) sb_half(o, R, kt, vt, qf, 64 * t + 32, 1, qpos, r32, hi, vlane);
            sb_half(o, R, kt, vt, qf, 64 * t, 0, qpos, r32, hi, vlane);
            done = __all(R < -150.f) != 0;
        }
        if (lane == 0) flags[(it & 1) * 8 + wid] = done ? 0 : 1;
        if (more) SB_STORE((it + 1) & 1);
        __syncthreads();
        int any = 0;
#pragma unroll
        for (int w = 0; w < 8; ++w) any |= flags[(it & 1) * 8 + w];
        if (!more || !any) break;
        --t;
    }
#undef SB_LOAD
#undef SB_STORE
    store_ot(ATT + (size_t)qpos * 1024 + head * 64, o, hi);
    __syncthreads();
}

#ifndef NSAREP
#define NSAREP 0
#endif
#define NSA_NREP(bit) (((NSAREP >> (bit)) & 1) ? 2 : 1)
constexpr int N_LUT = 2 * T_BUF, N_IMP = N_LUT + 16384, N_SEL = N_IMP + 65536, N_UB = N_SEL + 2048, N_END = N_UB + 256;
struct NsaT {
    const bf16_t* PROJ;
    const bf16_t* KCMP; const bf16_t* VCMP;
    const bf16_t* KS; const bf16_t* VTS;
    const bf16_t* KW;
    const float* GN;
    const float* LUT8;
    bf16_t* ATT;
    float kb, bmax;
};
__host__ __device__ __forceinline__ int vts_key_of_slot(int slot) { const int hh = slot >> 5, s5 = slot & 31, s = s5 >> 4, h = (s5 >> 3) & 1, j = s5 & 7; return 32 * hh + 16 * s + 8 * (j >> 2) + 4 * h + (j & 3); }

DI void nsa_unit(LAS char* lds, const NsaT& T, int g, int qblk) {
    int tid_l = threadIdx.x; asm volatile("" : "+v"(tid_l));
    const int tid = tid_l, lane = tid & 63, wid = rfl(tid >> 6), r32 = lane & 31, hi = lane >> 5;
    const int q0 = qblk * 64;
    LAS float* lut = (LAS float*)(lds + N_LUT);
    LAS float* imp = (LAS float*)(lds + N_IMP);
    LAS unsigned* selb = (LAS unsigned*)(lds + N_SEL);
    LAS unsigned* ub = (LAS unsigned*)(lds + N_UB) + wid * 8;
    for (int i = tid; i < 4096; i += 512) lut[i] = T.LUT8[(i >> 2) * 8 + g * 4 + (i & 3)];
    for (int i = tid; i < 16384; i += 512) imp[i] = 0.f;
    selb[tid] = 0u;
    const int ql = r32 >> 2, hd = r32 & 3, h8 = g * 4 + hd, tq = q0 + 8 * wid + ql;
    bf16x8 qf[4];
    { const bf16_t* qp = T.PROJ + (size_t)tq * 5632 + 768 + h8 * 64 + hi * 8;
#pragma unroll
      for (int d0 = 0; d0 < 4; ++d0) qf[d0] = *(const bf16x8*)(qp + d0 * 16); }
    float ref;
    { float qs = 0.f;
#pragma unroll
      for (int d0 = 0; d0 < 4; ++d0)
#pragma unroll
          for (int e = 0; e < 8; ++e) { const float v = __uint_as_float(((unsigned)(unsigned short)qf[d0][e]) << 16); qs += v * v; }
      qs += sx32(qs, hi); ref = sqrtf(qs) * T.kb + T.bmax; }
    const float gc = T.GN[(size_t)tq * 24 + 3 * h8], gs = T.GN[(size_t)tq * 24 + 3 * h8 + 1], gw = T.GN[(size_t)tq * 24 + 3 * h8 + 2];
    const int srow = tid >> 3, sch = tid & 7;
    const int vlane = (4 * hi + ((lane & 15) >> 2)) * T_KS + 2 * (16 * ((lane >> 4) & 1) + 4 * (lane & 3));
    u32x4 kr, vr;
    __syncthreads();
    const float cfar = lut[1023 * 4 + hd] - ref;
    const int nmax = (q0 + 32) / 16 + 1;
    const int ntc = (nmax + 63) >> 6;
    const bf16_t* kc = T.KCMP + (size_t)g * 1024 * 64; const bf16_t* vc = T.VCMP + (size_t)g * 1024 * 64;
    const int relq = tq - 31;
    const int relw = q0 + 8 * wid - 31;
    float l = 0.f; float inv_l = 0.f; f32x16 oa[2];
    for (int rp_ = 0; rp_ < NSA_NREP(0); ++rp_) { l = 0.f;
    kr = *(const u32x4*)(kc + (size_t)srow * 64 + sch * 8);
    *(LAS u32x4*)(lds + srow * T_KS + sch * 16) = kr; __syncthreads();
    for (int j = 0; j < ntc; ++j) {
        const bool more = j + 1 < ntc;
        if (more) kr = *(const u32x4*)(kc + (size_t)(64 * (j + 1) + srow) * 64 + sch * 8);
        const LAS char* kt = lds + (j & 1) * T_BUF;
#pragma unroll
        for (int hh = 0; hh < 2; ++hh) {
            f32x16 s = qk32<64, T_KS>(kt + (32 * hh + r32) * T_KS + hi * 16, qf);
            const int n0 = 64 * j + 32 * hh;
            if (relw - 16 * (n0 + 31) >= 790) {
#pragma unroll
                for (int r = 0; r < 16; ++r) l += fast_exp2(s[r] + cfar);
            } else {
#pragma unroll
                for (int r = 0; r < 16; ++r) { const int rel = relq - 16 * (n0 + crow(r, hi)); l += (rel >= 0) ? fast_exp2(s[r] + lut[(rel < 1023 ? rel : 1023) * 4 + hd] - ref) : 0.f; }
            }
        }
        if (more) *(LAS u32x4*)(lds + ((j + 1) & 1) * T_BUF + srow * T_KS + sch * 16) = kr;
        __syncthreads();
    }
    l = sum32sym(l);
    inv_l = l > 0.f ? 1.f / l : 0.f;
#pragma unroll
    for (int i = 0; i < 16; ++i) { oa[0][i] = 0.f; oa[1][i] = 0.f; }
    float cprev = 0.f;
    kr = *(const u32x4*)(kc + (size_t)srow * 64 + sch * 8); vr = *(const u32x4*)(vc + (size_t)srow * 64 + sch * 8);
    { LAS char* d_ = lds + srow * T_KS + sch * 16; *(LAS u32x4*)d_ = kr; *(LAS u32x4*)(d_ + T_KB) = vr; } __syncthreads();
    for (int j = 0; j < ntc; ++j) {
        const bool more = j + 1 < ntc;
        if (more) { kr = *(const u32x4*)(kc + (size_t)(64 * (j + 1) + srow) * 64 + sch * 8); vr = *(const u32x4*)(vc + (size_t)(64 * (j + 1) + srow) * 64 + sch * 8); }
        const LAS char* kt = lds + (j & 1) * T_BUF; const LAS char* vt = kt + T_KB;
#pragma unroll
        for (int hh = 0; hh < 2; ++hh) {
            f32x16 s = qk32<64, T_KS>(kt + (32 * hh + r32) * T_KS + hi * 16, qf);
            const int n0 = 64 * j + 32 * hh;
            if (relw - 16 * (n0 + 31) >= 790) {
#pragma unroll
                for (int r = 0; r < 16; ++r) s[r] = fast_exp2(s[r] + cfar) * inv_l;
            } else {
#pragma unroll
                for (int r = 0; r < 16; ++r) { const int rel = relq - 16 * (n0 + crow(r, hi)); s[r] = (rel >= 0) ? fast_exp2(s[r] + lut[(rel < 1023 ? rel : 1023) * 4 + hd] - ref) * inv_l : 0.f; }
            }
            float gsm[4], c3[4], pc3[4];
#pragma unroll
            for (int gi = 0; gi < 4; ++gi) { float a = (s[4 * gi] + s[4 * gi + 1]) + (s[4 * gi + 2] + s[4 * gi + 3]), b = s[4 * gi + 3];
                a += sx<1>(a); a += sx<2>(a); b += sx<1>(b); b += sx<2>(b); gsm[gi] = a; c3[gi] = b; }
#pragma unroll
            for (int gi = 0; gi < 4; ++gi) pc3[gi] = sx32(c3[gi], hi);
            const int b0 = 16 * j + 8 * hh + hi;
            if (hd == 0) {
                LAS float* ip = imp + (8 * wid + ql) * 256 + b0;
                if (hi == 1) {
#pragma unroll
                    for (int gi = 0; gi < 4; ++gi) ip[2 * gi] = gsm[gi] + pc3[gi];
                } else { ip[0] = gsm[0] + cprev; ip[2] = gsm[1] + pc3[0]; ip[4] = gsm[2] + pc3[1]; ip[6] = gsm[3] + pc3[2]; }
            }
            cprev = pc3[3];
            pv32<T_KS>(oa, vt + (32 * hh) * T_KS + vlane, pack8(s, 0), pack8(s, 1));
        }
        if (more) { LAS char* d_ = lds + ((j + 1) & 1) * T_BUF + srow * T_KS + sch * 16; *(LAS u32x4*)d_ = kr; *(LAS u32x4*)(d_ + T_KB) = vr; }
        __syncthreads();
    }
    }
#pragma unroll
    for (int i = 0; i < 16; ++i) { oa[0][i] *= gc; oa[1][i] *= gc; }
    for (int rp_ = 0; rp_ < NSA_NREP(1); ++rp_) {
    if (qblk < 16) {
        if (lane < 8) selb[(8 * wid + lane) * 8] = (2u << qblk) - 1u;
    } else {
        unsigned kv[8][4];
#pragma unroll
        for (int q = 0; q < 8; ++q)
#pragma unroll
            for (int i = 0; i < 4; ++i) { const int b = lane + 64 * i; kv[q][i] = (b >= 1 && b <= qblk - 2) ? __float_as_uint(imp[(8 * wid + q) * 256 + b]) + 1u : 0u; }
        for (int rnd = 0; rnd < 13; ++rnd) {
#pragma unroll
            for (int q = 0; q < 8; ++q) {
                unsigned m = kv[q][0] > kv[q][1] ? kv[q][0] : kv[q][1]; { const unsigned m2 = kv[q][2] > kv[q][3] ? kv[q][2] : kv[q][3]; m = m > m2 ? m : m2; }
                { unsigned o_; o_ = sxu<1>(m); m = m > o_ ? m : o_; o_ = sxu<2>(m); m = m > o_ ? m : o_; o_ = sxu<4>(m); m = m > o_ ? m : o_; o_ = sxu<8>(m); m = m > o_ ? m : o_; o_ = sxu<16>(m); m = m > o_ ? m : o_;
                  auto rr = __builtin_amdgcn_permlane32_swap(m, m, false, false); m = rr[0] > rr[1] ? rr[0] : rr[1]; }
                const unsigned long long b0_ = __builtin_amdgcn_ballot_w64(kv[q][0] == m), b1_ = __builtin_amdgcn_ballot_w64(kv[q][1] == m), b2_ = __builtin_amdgcn_ballot_w64(kv[q][2] == m), b3_ = __builtin_amdgcn_ballot_w64(kv[q][3] == m);
                const int isel = b0_ ? 0 : b1_ ? 1 : b2_ ? 2 : 3; const unsigned long long bm = b0_ ? b0_ : b1_ ? b1_ : b2_ ? b2_ : b3_;
                const int lsel = __builtin_ctzll(bm), bsel = lsel + 64 * isel;
#pragma unroll
                for (int i = 0; i < 4; ++i) if (i == isel && lane == lsel) kv[q][i] = 0u;
                if (lane == 0) { LAS unsigned* sp_ = selb + (8 * wid + q) * 8 + (bsel >> 5); *sp_ = *sp_ | (1u << (bsel & 31)); }
            }
        }
        if (lane < 8) { LAS unsigned* sb = selb + (8 * wid + lane) * 8; sb[0] = sb[0] | 1u; sb[qblk >> 5] = sb[qblk >> 5] | (1u << (qblk & 31)); sb[(qblk - 1) >> 5] = sb[(qblk - 1) >> 5] | (1u << ((qblk - 1) & 31)); }
    }
    }
    asm volatile("s_waitcnt lgkmcnt(0)" ::: "memory");
#pragma unroll
    for (int w = 0; w < 8; ++w) { unsigned u = selb[(8 * wid + (lane & 7)) * 8 + w]; u |= sxu<1>(u); u |= sxu<2>(u); u |= sxu<4>(u); if (lane == 0) ub[w] = u; }
    asm volatile("s_waitcnt lgkmcnt(0)" ::: "memory");
    {
        const bf16_t* ksg = T.KS + (size_t)g * 16384 * 64; const bf16_t* vsg = T.PROJ + 1664 + g * 64;
        const LAS unsigned* mysel = selb + (8 * wid + ql) * 8;
        float ls = 0.f; f32x16 os[2];
        for (int rp_ = 0; rp_ < NSA_NREP(2); ++rp_) { ls = 0.f;
#pragma unroll
        for (int i = 0; i < 16; ++i) { os[0][i] = 0.f; os[1][i] = 0.f; }
        kr = *(const u32x4*)(ksg + (size_t)srow * 64 + sch * 8); vr = *(const u32x4*)(vsg + (size_t)srow * 5632 + sch * 8);
        { LAS char* d_ = lds + srow * T_KS + sch * 16; *(LAS u32x4*)d_ = kr; *(LAS u32x4*)(d_ + T_KB) = vr; } __syncthreads();
        u32x4 kq0 = kr, vq0 = vr, kq1 = kr, vq1 = vr;
#define SEL_LD(t, K_, V_) do { K_ = *(const u32x4*)(ksg + (size_t)(64 * (t) + srow) * 64 + sch * 8); V_ = *(const u32x4*)(vsg + (size_t)(64 * (t) + srow) * 5632 + sch * 8); } while (0)
        if (1 <= qblk) SEL_LD(1, kq0, vq0);
        if (2 <= qblk) SEL_LD(2, kq1, vq1);
        for (int b = 0; b <= qblk; ++b) {
            const bool more = b < qblk;
            if (b + 3 <= qblk) SEL_LD(b + 3, kr, vr);
            const LAS char* kt = lds + (b & 1) * T_BUF; const LAS char* vt = kt + T_KB;
            const unsigned ubw = (unsigned)rfl((int)ub[b >> 5]);
            if ((ubw >> (b & 31)) & 1u) {
                const bool mine = (mysel[b >> 5] >> (b & 31)) & 1u;
                f32x16 sc[2];
                sc[0] = qk32<64, T_KS>(kt + r32 * T_KS + hi * 16, qf); sc[1] = qk32<64, T_KS>(kt + (32 + r32) * T_KS + hi * 16, qf);
                if ((q0 + 8 * wid) - (64 * b + 63) >= 790) {
#pragma unroll
                    for (int hh = 0; hh < 2; ++hh)
#pragma unroll
                        for (int r = 0; r < 16; ++r) { const float p = mine ? fast_exp2(sc[hh][r] + cfar) : 0.f; sc[hh][r] = p; ls += p; }
                } else {
#pragma unroll
                    for (int hh = 0; hh < 2; ++hh)
#pragma unroll
                        for (int r = 0; r < 16; ++r) { const int rel = tq - (64 * b + 32 * hh + crow(r, hi)); const int rc = rel < 0 ? 0 : (rel < 1023 ? rel : 1023);
                            const float p = (mine && rel >= 0) ? fast_exp2(sc[hh][r] + lut[rc * 4 + hd] - ref) : 0.f; sc[hh][r] = p; ls += p; }
                }
                pv32<T_KS>(os, vt + vlane, pack8(sc[0], 0), pack8(sc[0], 1));
                pv32<T_KS>(os, vt + 32 * T_KS + vlane, pack8(sc[1], 0), pack8(sc[1], 1));
            }
            if (more) { LAS char* d_ = lds + ((b + 1) & 1) * T_BUF + srow * T_KS + sch * 16; *(LAS u32x4*)d_ = kq0; *(LAS u32x4*)(d_ + T_KB) = vq0; }
            kq0 = kq1; vq0 = vq1; kq1 = kr; vq1 = vr;
            __syncthreads();
        }
#undef SEL_LD
        }
        ls = sum32sym(ls);
        const float f = gs / ls;
#pragma unroll
        for (int i = 0; i < 16; ++i) { oa[0][i] += f * os[0][i]; oa[1][i] += f * os[1][i]; }
    }
    {
        const bf16_t* kw = T.KW + (size_t)g * 16384 * 64; const bf16_t* vw = T.PROJ + 1920 + g * 64;
        const int kt0 = qblk > 8 ? qblk - 8 : 0, ntw = qblk - kt0 + 1;
        float lw = 0.f; f32x16 ow[2];
        for (int rp_ = 0; rp_ < NSA_NREP(3); ++rp_) { lw = 0.f;
#pragma unroll
        for (int i = 0; i < 16; ++i) { ow[0][i] = 0.f; ow[1][i] = 0.f; }
        kr = *(const u32x4*)(kw + (size_t)(64 * kt0 + srow) * 64 + sch * 8); vr = *(const u32x4*)(vw + (size_t)(64 * kt0 + srow) * 5632 + sch * 8);
        { LAS char* d_ = lds + srow * T_KS + sch * 16; *(LAS u32x4*)d_ = kr; *(LAS u32x4*)(d_ + T_KB) = vr; } __syncthreads();
        for (int j = 0; j < ntw; ++j) {
            const bool more = j + 1 < ntw;
            if (more) { kr = *(const u32x4*)(kw + (size_t)(64 * (kt0 + j + 1) + srow) * 64 + sch * 8); vr = *(const u32x4*)(vw + (size_t)(64 * (kt0 + j + 1) + srow) * 5632 + sch * 8); }
            const LAS char* kt = lds + (j & 1) * T_BUF; const LAS char* vt = kt + T_KB;
            f32x16 p[2];
#pragma unroll
            for (int hh = 0; hh < 2; ++hh) { p[hh] = qk32<64, T_KS>(kt + (32 * hh + r32) * T_KS + hi * 16, qf);
#pragma unroll
                for (int r = 0; r < 16; ++r) { const int rel = tq - (64 * (kt0 + j) + 32 * hh + crow(r, hi)); const bool valid = rel >= 0 && rel < 512;
                    const float e = valid ? fast_exp2(p[hh][r] + lut[(rel < 0 ? 0 : rel) * 4 + hd] - ref) : 0.f; p[hh][r] = e; lw += e; } }
            pv32<T_KS>(ow, vt + vlane, pack8(p[0], 0), pack8(p[0], 1));
            pv32<T_KS>(ow, vt + 32 * T_KS + vlane, pack8(p[1], 0), pack8(p[1], 1));
            if (more) { LAS char* d_ = lds + ((j + 1) & 1) * T_BUF + srow * T_KS + sch * 16; *(LAS u32x4*)d_ = kr; *(LAS u32x4*)(d_ + T_KB) = vr; }
            __syncthreads();
        }
        }
        lw = sum32sym(lw);
        const float f = gw / lw;
#pragma unroll
        for (int i = 0; i < 16; ++i) { oa[0][i] += f * ow[0][i]; oa[1][i] += f * ow[1][i]; }
        store_ot(T.ATT + (size_t)tq * 1024 + 256 + h8 * 64, oa, hi);
    }
    __syncthreads();
}
}
constexpr int S = 16384, DM = 1024, NPROJ = 5632, INC = 5560, DFF = 2816, EFF = 3584, NEXP = 8;
constexpr int NWAVES = 8;
constexpr float EPS = 1e-6f;
constexpr float QK_SCALE64 = 0.125f * LOG2E;
constexpr float QK_SCALE96 = 0.10206207261596575f * LOG2E;
#ifndef MK_MULTI
#define MK_MULTI 0
#endif
constexpr int PC_SBQ = 0, PC_SBK = 256, PC_SBV = 512, PC_NQ = 768, PC_NKC = 1280, PC_NVC = 1408, PC_NKS = 1536, PC_NVS = 1664, PC_NKW = 1792, PC_NVW = 1920,
              PC_CQ = 2048, PC_CKV = 2304, PC_KR = 2432, PC_NG = 2464, PC_GATE = 2560;
__host__ __device__ __forceinline__ int win_oldcol(int c) {
    if (c < 2048) return c; if (c < 2464) return c + 24; if (c < 2488) return 2048 + (c - 2464); if (c < 2560) return -1; return c - 72; }

constexpr size_t MiB = 1u << 20;
constexpr size_t WS_CTL = 0, CTL_ZERO_BYTES = 1 * MiB;
constexpr size_t WS_LW = 1 * MiB, LW_STRIDE = 18 * MiB;
constexpr size_t LW_WIN = 0, LW_SBO = 11 * MiB, LW_NSAO = LW_SBO + MiB / 2, LW_MLAO = LW_NSAO + MiB, LW_WOUT = LW_MLAO + MiB / 2, LW_WUQ = LW_WOUT + 2 * MiB, LW_WUKV = LW_WUQ + MiB / 4, LW_CW1 = LW_WUKV + MiB / 4;
constexpr size_t WS_DGU = 37 * MiB, WS_DDN = 48 * MiB;
constexpr size_t WS_Y = 1 * MiB;
constexpr size_t WS_H = 74 * MiB;
constexpr size_t WS_ROPE = 106 * MiB;
constexpr size_t WS_LUT8 = 108 * MiB, WS_B1P = WS_LUT8 + 256 * 1024, WS_B1 = WS_LUT8 + 512 * 1024, WS_ROUTE = 109 * MiB, WS_ROWTOK = WS_ROUTE + 512 * 1024;
constexpr size_t WS_R1 = 110 * MiB;
constexpr size_t WS_MGU = WS_R1, WS_MDN = WS_R1 + 112 * MiB;
constexpr size_t WS_R2 = 296 * MiB;
constexpr size_t R2_KC = 0, R2_VC = R2_KC + 4 * MiB + MiB / 4, R2_KS = R2_VC + 4 * MiB + MiB / 4, R2_VTS = R2_KS + 4 * MiB, R2_KW = R2_VTS + 4 * MiB, R2_GN = R2_KW + 4 * MiB,
                 R2_QM = R2_GN + 2 * MiB, R2_KM = R2_QM + 12 * MiB, R2_HID = R2_KM + 12 * MiB, R2_KCMP = R2_HID + 2 * MiB, R2_VCMP = R2_KCMP + MiB / 4, R2_ATT = R2_VCMP + MiB / 4 + MiB / 2,
                 R2_MRG = R2_ATT + 32 * MiB, R2_QRAW = R2_MRG, R2_KVRAW = R2_MRG + 16 * MiB, R2_END = R2_MRG + 32 * MiB;
static_assert(R2_END <= 136 * MiB, "attention scratch");
constexpr size_t WS_END = 432 * MiB;
constexpr int KC_ROWS = S + 32;
constexpr int CW_TMO = 0, CW_BAR = 4096, CW_MOECNT = 16384;
constexpr int RING_BYTES = 131072, LDSCTL_OFF = RING_BYTES, MISC_OFF = LDSCTL_OFF + 320, LDS_BYTES = 147456;


#define LDS_WAIT() asm volatile("s_waitcnt lgkmcnt(0)" ::: "memory")
#define VM_WAIT() asm volatile("s_waitcnt vmcnt(0)" ::: "memory")
DI float wave_sum(float v) { v += sx<1>(v); v += sx<2>(v); v += sx<4>(v); v += sx<8>(v); v += sx<16>(v); return sum32sym(v); }

struct TrSrc { const float* a; const float* b; int ldn; int nsrc; int mode; };
DI f32x4 tr_fetch4(const TrSrc& s, int k, int n) {
    const f32x4 z = {0.f, 0.f, 0.f, 0.f};
    if (s.mode == 0) return n < s.nsrc ? *(const f32x4*)(s.a + (size_t)k * s.ldn + n) : z;
    if (s.mode == 1) { const int oc = win_oldcol(n); return oc >= 0 ? *(const f32x4*)(s.a + (size_t)k * s.ldn + oc) : z; }
    const int tile = n >> 8, w = n & 255; const long d = (w < 128) ? 0l : (long)((const char*)s.b - (const char*)s.a);
    return *(const f32x4*)((const float*)((const char*)s.a + d) + (size_t)k * s.ldn + 128 * tile + (w & 127));
}
DI void tr_item(const TrSrc& s, int K, bf16_t* WT, LAS float* scr, int kb, int nb, int lane) {
    const int k0 = 64 * kb, n0 = 32 * nb, r8 = lane >> 3, n4 = (lane & 7) * 4;
    f32x4 v[8];
#pragma unroll
    for (int i = 0; i < 8; ++i) v[i] = tr_fetch4(s, k0 + r8 + 8 * i, n0 + n4);
#pragma unroll
    for (int i = 0; i < 8; ++i) { LAS float* d = scr + (r8 + 8 * i) * 33 + n4; d[0] = v[i].x; d[1] = v[i].y; d[2] = v[i].z; d[3] = v[i].w; }
    LDS_WAIT(); asm volatile("" ::: "memory");
    const int c = lane & 7;
#pragma unroll
    for (int j = 0; j < 4; ++j) { const int n = (lane >> 3) + 8 * j; const LAS float* p = scr + (8 * c) * 33 + n;
        u32x4 o; o.x = cvtpk(p[0 * 33], p[1 * 33]); o.y = cvtpk(p[2 * 33], p[3 * 33]); o.z = cvtpk(p[4 * 33], p[5 * 33]); o.w = cvtpk(p[6 * 33], p[7 * 33]);
        *(u32x4*)(WT + (size_t)(n0 + n) * K + k0 + 8 * c) = o; }
    LDS_WAIT(); asm volatile("" ::: "memory");
}
DI void tr_matrix(const TrSrc& s, int K, int ndst, bf16_t* WT, LAS float* scr, int gw, int ngw, int lane) {
    const int nblk = ndst / 32, nitems = (K / 64) * nblk;
    for (int it = gw; it < nitems; it += ngw) tr_item(s, K, WT, scr, it / nblk, it % nblk, lane);
}

struct In {
    const float *x, *bias_table, *mix_norm, *w_in, *b_gate, *sb_w_o, *nsa_q_norm, *nsa_k_norm, *nsa_cmp_pos, *nsa_cmp_w1, *nsa_cmp_w2, *nsa_w_o, *mla_q_a_norm, *mla_kv_a_norm,
        *mla_w_uq, *mla_w_ukv, *mla_q_norm, *mla_k_norm, *mla_w_o, *w_out, *ffn_norm, *dense_w_gate, *dense_w_up, *dense_w_down, *moe_router, *moe_w_gate, *moe_w_up, *moe_w_down;
};
struct Args { In in; float* out; unsigned char* ws; int ph_lo, ph_hi; };

DI void rms_row(const float* xrow, const float* gain, bf16_t* orow, int lane, f32x4 (&v)[4]) {
    const f32x4* xr = (const f32x4*)xrow + lane; float s = 0.f;
#pragma unroll
    for (int j = 0; j < 4; ++j) { v[j] = xr[64 * j]; s += (v[j].x * v[j].x + v[j].y * v[j].y) + (v[j].z * v[j].z + v[j].w * v[j].w); }
    const float rstd = 1.f / sqrtf(wave_sum(s) * (1.f / 1024.f) + EPS);
    u32x2* o8 = (u32x2*)orow + lane;
#pragma unroll
    for (int j = 0; j < 4; ++j) { const f32x4 g = ((const f32x4*)gain)[lane + 64 * j]; v[j] = v[j] * rstd * g; u32x2 w; w.x = cvtpk(v[j].x, v[j].y); w.y = cvtpk(v[j].z, v[j].w); o8[64 * j] = w; }
}

DI int t5_bucket(int n) {
    if (n < 16) return n;
    int b = 16;
    b += n >= 21; b += n >= 27; b += n >= 35; b += n >= 46; b += n >= 59; b += n >= 77; b += n >= 99; b += n >= 128; b += n >= 166; b += n >= 216; b += n >= 280; b += n >= 363; b += n >= 470; b += n >= 609; b += n >= 790;
    return b;
}

struct MoeTab { int cnt[8]; int tb[9]; };
struct MoeGU {
    const volatile LAS int* tab; const bf16_t* Hb; const bf16_t* W; const int* rowtok; int t_lo, t_hi, G, c;
    DI bool next(int i, pg8::Unit& u) const {
        const int nrt = t_hi - t_lo; if (nrt <= 0) return false;
        const long L = (long)i * G + c; if (L >= (long)nrt * 28) return false;
        const int rt = t_lo + (int)(L % nrt), pn = (int)(L / nrt);
        int e = 0;
#pragma unroll
        for (int k = 1; k < 8; ++k) e += (tab[8 + k] <= rt) ? 1 : 0;
        const int j = rt - tab[8 + e], cnt = tab[e];
        u.a = Hb; u.b = W + ((size_t)e * 7168 + 256 * pn) * 1024; u.rows = rowtok + e * S + 256 * j; u.nvalid = (cnt - 256 * j) < 256 ? (cnt - 256 * j) : 256; u.pm = rt - t_lo; u.pn = pn; return true;
    }
};
struct MoeDN {
    const volatile LAS int* tab; const bf16_t* ACT; const bf16_t* W; int t_lo, t_hi, G, c;
    DI bool next(int i, pg8::Unit& u) const {
        const int nrt = t_hi - t_lo; if (nrt <= 0) return false;
        const long L = (long)i * G + c; if (L >= (long)nrt * 4) return false;
        const int rt = t_lo + (int)(L % nrt), pn = (int)(L / nrt);
        int e = 0;
#pragma unroll
        for (int k = 1; k < 8; ++k) e += (tab[8 + k] <= rt) ? 1 : 0;
        u.a = ACT + (size_t)(rt - t_lo) * 256 * EFF; u.b = W + ((size_t)e * 1024 + 256 * pn) * EFF; u.rows = nullptr; u.nvalid = 256; u.pm = rt; u.pn = pn; return true;
    }
};
constexpr int PH_PER_LAYER = 16, NPHASES = 1 + 2 * PH_PER_LAYER;
__global__ void __launch_bounds__(NWAVES * 64, 2) fwd_kernel(Args args) {
    extern __shared__ __attribute__((aligned(16))) unsigned char lds_raw[];
    LAS unsigned char* lds = (LAS unsigned char*)lds_raw;
    volatile LAS unsigned* MISC = (volatile LAS unsigned*)(lds + MISC_OFF);
    volatile LAS int* MTAB = (volatile LAS int*)(lds + MISC_OFF + 64);
    const int tid0 = threadIdx.x, wave = __builtin_amdgcn_readfirstlane(tid0 >> 6);
    const int G = gridDim.x, bid = blockIdx.x, vcu = (G % 8 == 0) ? (bid % 8) * (G / 8) + bid / 8 : bid;
    const int gw0 = vcu * NWAVES + wave, NGW = G * NWAVES;
    unsigned char* ws = args.ws; const In in = args.in;
    gu32* ctl = (gu32*)(ws + WS_CTL);
    for (int u = tid0; u < (LDS_BYTES - LDSCTL_OFF) / 4; u += NWAVES * 64) ((LAS unsigned*)(lds + LDSCTL_OFF))[u] = 0u;
    __syncthreads();
#if MK_MULTI
#define GRID_BAR() do { } while (0)
#else
    XcdBarrier bar = xcd_barrier_post((unsigned*)(ctl + CW_BAR), MISC + 8);
#define GRID_BAR() xcd_barrier(bar)
#endif
    const int lo = args.ph_lo, hi = args.ph_hi;
#ifndef ONLY_PHASE
#define ONLY_PHASE -1
#endif
#ifndef PHMASK
#define PHMASK 0x1ffff
#endif
#define PHON(n) ((ONLY_PHASE < 0 || ONLY_PHASE == (n)) && ((PHMASK >> ((n) == 99 ? 16 : (n))) & 1))
#ifndef REPMASK
#define REPMASK 0
#endif
#ifndef GREP
#define GREP 0
#endif
#define REPN(n) (((REPMASK >> ((n) == 99 ? 16 : (n))) & 1) ? 2 : 1)
#define IN(k) (lo <= (k) && (k) < hi)
#define SEAM(k) do { if (IN((k) + 1)) GRID_BAR(); } while (0)
#define PHASE_LOCALS int tid = tid0; asm volatile("" : "+v"(tid)); const int lane = tid & 63; int gw = gw0; asm volatile("" : "+s"(gw)); unsigned char* wsl = ws; asm volatile("" : "+s"(wsl)); (void)lane; (void)gw; (void)wsl;

#define lw (wsl + WS_LW + (size_t)l * LW_STRIDE)
#define Hb ((bf16_t*)(wsl + WS_H))
#define PROJ ((bf16_t*)(wsl + WS_R1))
#define R2P(off) (wsl + WS_R2 + (off))
#define KC ((bf16_t*)R2P(R2_KC))
#define VC ((bf16_t*)R2P(R2_VC))
#define KS ((bf16_t*)R2P(R2_KS))
#define VTS ((bf16_t*)R2P(R2_VTS))
#define KW ((bf16_t*)R2P(R2_KW))
#define GN ((float*)R2P(R2_GN))
#define QM ((bf16_t*)R2P(R2_QM))
#define KM ((bf16_t*)R2P(R2_KM))
#define HID ((bf16_t*)R2P(R2_HID))
#define KCMP ((bf16_t*)R2P(R2_KCMP))
#define VCMP ((bf16_t*)R2P(R2_VCMP))
#define ATT ((bf16_t*)R2P(R2_ATT))
#define MRG ((bf16_t*)R2P(R2_MRG))
#define QRAW ((bf16_t*)R2P(R2_QRAW))
#define KVRAW ((bf16_t*)R2P(R2_KVRAW))
#define ROPE ((float*)(wsl + WS_ROPE))
#define LUT8 ((float*)(wsl + WS_LUT8))
#define B1P ((float*)(wsl + WS_B1P))
#define B1 ((float*)(wsl + WS_B1))
#define CONS (B1 + 2048)
#define ROUTE ((int*)(wsl + WS_ROUTE))
#define ROWTOK ((int*)(wsl + WS_ROWTOK))
    LAS float* scr = (LAS float*)(lds + wave * 16384);

    if (PHON(99) && IN(0)) { PHASE_LOCALS for (int rep_ = 0; rep_ < REPN(99); ++rep_) {
        for (int l = 0; l < 2; ++l) {
            tr_matrix(TrSrc{in.w_in + (size_t)l * 1024 * INC, nullptr, INC, INC, 1}, 1024, NPROJ, (bf16_t*)(lw + LW_WIN), scr, gw, NGW, lane);
            tr_matrix(TrSrc{in.sb_w_o + (size_t)l * 256 * 1024, nullptr, 1024, 1024, 0}, 256, 1024, (bf16_t*)(lw + LW_SBO), scr, gw, NGW, lane);
            tr_matrix(TrSrc{in.nsa_w_o + (size_t)l * 512 * 1024, nullptr, 1024, 1024, 0}, 512, 1024, (bf16_t*)(lw + LW_NSAO), scr, gw, NGW, lane);
            tr_matrix(TrSrc{in.mla_w_o + (size_t)l * 256 * 1024, nullptr, 1024, 1024, 0}, 256, 1024, (bf16_t*)(lw + LW_MLAO), scr, gw, NGW, lane);
            tr_matrix(TrSrc{in.w_out + (size_t)l * 1024 * 1024, nullptr, 1024, 1024, 0}, 1024, 1024, (bf16_t*)(lw + LW_WOUT), scr, gw, NGW, lane);
            tr_matrix(TrSrc{in.mla_w_uq + (size_t)l * 256 * 384, nullptr, 384, 384, 0}, 256, 512, (bf16_t*)(lw + LW_WUQ), scr, gw, NGW, lane);
            tr_matrix(TrSrc{in.mla_w_ukv + (size_t)l * 128 * 512, nullptr, 512, 512, 0}, 128, 512, (bf16_t*)(lw + LW_WUKV), scr, gw, NGW, lane);
            for (int kv = 0; kv < 2; ++kv)
                tr_matrix(TrSrc{in.nsa_cmp_w1 + (size_t)(l * 2 + kv) * 2048 * 256, nullptr, 256, 256, 0}, 2048, 256, (bf16_t*)(lw + LW_CW1) + (size_t)kv * 256 * 2048, scr, gw, NGW, lane);
        }
        tr_matrix(TrSrc{in.dense_w_gate, in.dense_w_up, DFF, DFF, 2}, 1024, 2 * DFF, (bf16_t*)(wsl + WS_DGU), scr, gw, NGW, lane);
        tr_matrix(TrSrc{in.dense_w_down, nullptr, 1024, 1024, 0}, DFF, 1024, (bf16_t*)(wsl + WS_DDN), scr, gw, NGW, lane);
        const int gt = vcu * 512 + tid, NT = G * 512;
        for (int i = gt; i < S * 16; i += NT) {
            const int pos = i >> 4, fi = i & 15; const float inv = powf(10000.f, -(float)fi / 16.f); const float ang = (float)pos * inv;
            const double rev = (double)ang * 0.15915494309189535; const float fr = (float)(rev - rint(rev));
            ROPE[i] = __builtin_amdgcn_cosf(fr); ROPE[S * 16 + i] = __builtin_amdgcn_sinf(fr); }
        for (int i = gt; i < 1024 * 8; i += NT) LUT8[i] = in.bias_table[t5_bucket(i >> 3) * 8 + (i & 7)] * LOG2E;
        if (gw == 0) {
            float bm = 0.f; for (int i = lane; i < 256; i += 64) bm = fmaxf(bm, fabsf(in.bias_table[i]));
            bm = fmaxf(bm, sx<1>(bm)); bm = fmaxf(bm, sx<2>(bm)); bm = fmaxf(bm, sx<4>(bm)); bm = fmaxf(bm, sx<8>(bm)); bm = fmaxf(bm, sx<16>(bm)); bm = fmaxf(bm, sx32(bm, lane >> 5));
            if (lane == 0) CONS[0] = bm * LOG2E;
            for (int ll = 0; ll < 2; ++ll) { float gm = 0.f; for (int i = lane; i < 192; i += 64) gm = fmaxf(gm, fabsf(in.nsa_k_norm[ll * 192 + i]));
                gm = fmaxf(gm, sx<1>(gm)); gm = fmaxf(gm, sx<2>(gm)); gm = fmaxf(gm, sx<4>(gm)); gm = fmaxf(gm, sx<8>(gm)); gm = fmaxf(gm, sx<16>(gm)); gm = fmaxf(gm, sx32(gm, lane >> 5));
                if (lane == 0) CONS[1 + ll] = gm; }
        }
        for (int it = gw; it < 512; it += NGW) {
            const int kc = it & 31, cb = (it >> 5) & 3, lk = it >> 7; const float* pos = in.nsa_cmp_pos + (size_t)lk * 2048; const float* w1 = in.nsa_cmp_w1 + (size_t)lk * 2048 * 256;
            float a = 0.f; for (int k = 64 * kc; k < 64 * kc + 64; ++k) a += pos[k] * w1[(size_t)k * 256 + 64 * cb + lane];
            B1P[(lk * 32 + kc) * 256 + 64 * cb + lane] = a; }
        for (int i = gt; i < 2 * 2 * 32 * 64 / 8; i += NT) { const int z = i / 256, r = i % 256; bf16_t* p = (z >> 1 ? VC : KC) + ((size_t)(z & 1) * KC_ROWS + S) * 64 + r * 8; *(u32x4*)p = (u32x4){0u, 0u, 0u, 0u}; }
            }
        SEAM(0);
    }

    for (int l = 0; l < 2; ++l) {
        const int pb = 1 + PH_PER_LAYER * l;
        const float* x_in = (l == 0) ? in.x : args.out; float* x_out = args.out;
        if (PHON(0) && IN(pb + 0)) { PHASE_LOCALS for (int rep_ = 0; rep_ < REPN(0); ++rep_) {
            for (int m = gw; m < S; m += NGW) { f32x4 v[4]; rms_row(x_in + (size_t)m * 1024, in.mix_norm + l * 1024, Hb + (size_t)m * 1024, lane, v); }
            if (l == 0 && bid == 0) for (int i = tid; i < 1024; i += 512) { float a = 0.f; for (int kc = 0; kc < 32; ++kc) a += B1P[((i >> 8) * 32 + kc) * 256 + (i & 255)]; B1[i] = a; }
            }
            SEAM(pb + 0);
        }
        if (PHON(1) && IN(pb + 1)) { PHASE_LOCALS for (int rep_ = 0; rep_ < REPN(1); ++rep_) {
            pg8::StaticOrder So; So.init(Hb, (const bf16_t*)(lw + LW_WIN), 1024, 1024, S, NPROJ, G, bid);
            pg8::EpiStore E{PROJ, NPROJ, nullptr, QK_SCALE64, 0};
            pg8::gemm_phase<pg8::EpiStore, pg8::StaticOrder, true, false>(lds, 1024, 1024, 1024, So, E);
#if GREP & 1
            pg8::gemm_phase<pg8::EpiStore, pg8::StaticOrder, true, false>(lds, 1024, 1024, 1024, So, E);
#endif
            }
            SEAM(pb + 1);
        }
        if (PHON(2) && IN(pb + 2)) { PHASE_LOCALS for (int rep_ = 0; rep_ < REPN(2); ++rep_) {
            for (int t = gw; t < S; t += NGW) {
                bf16_t* pr = PROJ + (size_t)t * NPROJ;
                {
                    const u32x4 w = *(const u32x4*)(pr + PC_NQ + lane * 8); float v[8] = {bflo(w.x), bfhi(w.x), bflo(w.y), bfhi(w.y), bflo(w.z), bfhi(w.z), bflo(w.w), bfhi(w.w)};
                    float ss = 0.f;
#pragma unroll
                    for (int e = 0; e < 8; ++e) ss += v[e] * v[e];
                    ss += sx<1>(ss); ss += sx<2>(ss); ss += sx<4>(ss);
                    const float rs = QK_SCALE64 / sqrtf(ss * (1.f / 64.f) + EPS); const float* gq = in.nsa_q_norm + l * 64 + 8 * (lane & 7);
                    u32x4 o; o.x = cvtpk(v[0] * rs * gq[0], v[1] * rs * gq[1]); o.y = cvtpk(v[2] * rs * gq[2], v[3] * rs * gq[3]); o.z = cvtpk(v[4] * rs * gq[4], v[5] * rs * gq[5]); o.w = cvtpk(v[6] * rs * gq[6], v[7] * rs * gq[7]);
                    *(u32x4*)(pr + PC_NQ + lane * 8) = o;
                }
                {
                    const int sec = lane >> 4, gg = (lane >> 3) & 1, d8 = 8 * (lane & 7);
                    const int col = (sec == 0 ? PC_NKS : sec == 1 ? PC_NKW : sec == 2 ? PC_NKC : PC_NVC) + (lane & 15) * 8;
                    const u32x4 w = *(const u32x4*)(pr + col); float v[8] = {bflo(w.x), bfhi(w.x), bflo(w.y), bfhi(w.y), bflo(w.z), bfhi(w.z), bflo(w.w), bfhi(w.w)};
                    float ss = 0.f;
#pragma unroll
                    for (int e = 0; e < 8; ++e) ss += v[e] * v[e];
                    ss += sx<1>(ss); ss += sx<2>(ss); ss += sx<4>(ss);
                    const float rs = 1.f / sqrtf(ss * (1.f / 64.f) + EPS);
                    u32x4 o = w;
                    if (sec < 2) { const float* gk = in.nsa_k_norm + (l * 3 + 1 + sec) * 64 + d8;
                        o.x = cvtpk(v[0] * rs * gk[0], v[1] * rs * gk[1]); o.y = cvtpk(v[2] * rs * gk[2], v[3] * rs * gk[3]); o.z = cvtpk(v[4] * rs * gk[4], v[5] * rs * gk[5]); o.w = cvtpk(v[6] * rs * gk[6], v[7] * rs * gk[7]); }
                    bf16_t* dst = (sec == 0 ? KS + ((size_t)gg * S + t) * 64 : sec == 1 ? KW + ((size_t)gg * S + t) * 64 : sec == 2 ? KC + ((size_t)gg * KC_ROWS + t) * 64 : VC + ((size_t)gg * KC_ROWS + t) * 64) + d8;
                    *(u32x4*)dst = o;
                }
                {
                    const u32x2 w = *(const u32x2*)(pr + PC_CQ + lane * 4); float v[4] = {bflo(w.x), bfhi(w.x), bflo(w.y), bfhi(w.y)};
                    const float rs = 1.f / sqrtf(wave_sum((v[0] * v[0] + v[1] * v[1]) + (v[2] * v[2] + v[3] * v[3])) * (1.f / 256.f) + EPS); const float* ga = in.mla_q_a_norm + l * 256 + lane * 4;
                    u32x2 o; o.x = cvtpk(v[0] * rs * ga[0], v[1] * rs * ga[1]); o.y = cvtpk(v[2] * rs * ga[2], v[3] * rs * ga[3]); *(u32x2*)(pr + PC_CQ + lane * 4) = o;
                    const unsigned w2 = *(const unsigned*)(pr + PC_CKV + lane * 2); const float a = bflo(w2), b = bfhi(w2);
                    const float rs2 = 1.f / sqrtf(wave_sum(a * a + b * b) * (1.f / 128.f) + EPS); const float* gb = in.mla_kv_a_norm + l * 128 + lane * 2;
                    *(unsigned*)(pr + PC_CKV + lane * 2) = cvtpk(a * rs2 * gb[0], b * rs2 * gb[1]);
                }
                if (lane < 24) GN[(size_t)t * 24 + lane] = sigmoidf_(bf2f(pr[PC_NG + lane]));
            }
            }
            SEAM(pb + 2);
        }
        if (PHON(3) && IN(pb + 3)) { PHASE_LOCALS for (int rep_ = 0; rep_ < REPN(3); ++rep_) {
            for (int job = 0; job < 6; ++job) {
                pg8::StaticOrder So; pg8::EpiStore E; int lda, ldb, K;
                const bool wide = (G >= 256);
                if (job == 0) { lda = NPROJ; ldb = 256; K = 256; So.init(PROJ + PC_CQ, (const bf16_t*)(lw + LW_WUQ), lda, ldb, S, 512, wide ? 128 : G, wide ? (bid < 128 ? bid : -1) : bid); E = pg8::EpiStore{QRAW, 512, nullptr, 1.f, 0}; }
                else if (job == 1) { lda = NPROJ; ldb = 128; K = 128; So.init(PROJ + PC_CKV, (const bf16_t*)(lw + LW_WUKV), lda, ldb, S, 512, wide ? 128 : G, wide ? (bid >= 128 && bid < 256 ? bid - 128 : -1) : bid); E = pg8::EpiStore{KVRAW, 512, nullptr, 1.f, 0}; }
                else { const int z = job - 2, kv = z >> 1, gg = z & 1; lda = 1024; ldb = 2048; K = 2048;
                    So.init((kv ? VC : KC) + (size_t)gg * KC_ROWS * 64, (const bf16_t*)(lw + LW_CW1) + (size_t)kv * 256 * 2048, lda, ldb, 1024, 256, wide ? 4 : G, wide ? ((bid >= 32 * z && bid < 32 * z + 4) ? bid - 32 * z : -1) : bid);
                    E = pg8::EpiStore{HID + (size_t)z * 1024 * 256, 256, B1 + (l * 2 + kv) * 256, 1.f, 1}; }
                pg8::gemm_phase<pg8::EpiStore, pg8::StaticOrder, true, false>(lds, lda, ldb, K, So, E);
#if GREP & 16
                pg8::gemm_phase<pg8::EpiStore, pg8::StaticOrder, true, false>(lds, lda, ldb, K, So, E);
#endif
            }
            }
            SEAM(pb + 3);
        }
        if (PHON(4) && IN(pb + 4)) { PHASE_LOCALS for (int rep_ = 0; rep_ < REPN(4); ++rep_) {
            for (int t = gw; t < S; t += NGW) {
                const int hd = lane >> 4, i = lane & 15; const float c = ROPE[t * 16 + i], s = ROPE[S * 16 + t * 16 + i];
                {   const bf16_t* src = QRAW + (size_t)t * 512 + hd * 96 + i; float v[6]; float ss = 0.f;
#pragma unroll
                    for (int e = 0; e < 6; ++e) { v[e] = bf2f(src[16 * e]); ss += v[e] * v[e]; }
                    ss += sx<1>(ss); ss += sx<2>(ss); ss += sx<4>(ss); ss += sx<8>(ss);
                    const float rs = 1.f / sqrtf(ss * (1.f / 96.f) + EPS); const float* gq = in.mla_q_norm + l * 96 + i;
#pragma unroll
                    for (int e = 0; e < 6; ++e) v[e] = v[e] * rs * gq[16 * e];
                    const float x1 = v[4], x2 = v[5]; v[4] = x1 * c - x2 * s; v[5] = x2 * c + x1 * s;
                    bf16_t* dst = QM + (size_t)t * 384 + hd * 96 + i;
#pragma unroll
                    for (int e = 0; e < 6; ++e) dst[16 * e] = f2bf(v[e] * QK_SCALE96); }
                {   const bf16_t* src = KVRAW + (size_t)t * 512 + hd * 128 + i; const bf16_t* kr = PROJ + (size_t)t * NPROJ + PC_KR + i; float v[6]; float ss = 0.f;
#pragma unroll
                    for (int e = 0; e < 4; ++e) v[e] = bf2f(src[16 * e]);
                    v[4] = bf2f(kr[0]); v[5] = bf2f(kr[16]);
#pragma unroll
                    for (int e = 0; e < 6; ++e) ss += v[e] * v[e];
                    ss += sx<1>(ss); ss += sx<2>(ss); ss += sx<4>(ss); ss += sx<8>(ss);
                    const float rs = 1.f / sqrtf(ss * (1.f / 96.f) + EPS); const float* gk = in.mla_k_norm + l * 96 + i;
#pragma unroll
                    for (int e = 0; e < 6; ++e) v[e] = v[e] * rs * gk[16 * e];
                    const float x1 = v[4], x2 = v[5]; v[4] = x1 * c - x2 * s; v[5] = x2 * c + x1 * s;
                    bf16_t* dst = KM + (size_t)t * 384 + hd * 96 + i;
#pragma unroll
                    for (int e = 0; e < 6; ++e) dst[16 * e] = f2bf(v[e]); }
            }
            for (int it = gw; it < 4096; it += NGW) {
                const int z = it >> 10, n = it & 1023, kv = z >> 1, gg = z & 1; const bf16_t* hrow = HID + ((size_t)z * 1024 + n) * 256; const float* w2 = in.nsa_cmp_w2 + (size_t)(l * 2 + kv) * 256 * 64;
                { const u32x2 w = *(const u32x2*)(hrow + lane * 4); scr[lane * 4] = bflo(w.x); scr[lane * 4 + 1] = bfhi(w.x); scr[lane * 4 + 2] = bflo(w.y); scr[lane * 4 + 3] = bfhi(w.y); }
                LDS_WAIT(); asm volatile("" ::: "memory");
                float a = 0.f;
#pragma unroll 8
                for (int j = 0; j < 256; ++j) a += scr[j] * w2[j * 64 + lane];
                if (kv == 0) { const float rs = 1.f / sqrtf(wave_sum(a * a) * (1.f / 64.f) + EPS); KCMP[((size_t)gg * 1024 + n) * 64 + lane] = f2bf(a * rs * in.nsa_k_norm[(l * 3) * 64 + lane]); }
                else VCMP[((size_t)gg * 1024 + n) * 64 + lane] = f2bf(a);
                LDS_WAIT(); asm volatile("" ::: "memory");
            }
            }
            SEAM(pb + 4);
        }
        if (PHON(5) && IN(pb + 5)) { PHASE_LOCALS for (int rep_ = 0; rep_ < REPN(5); ++rep_) {
            __syncthreads();
            for (int r2_ = 0; r2_ < REPN(17); ++r2_) for (int u = vcu; u < 256; u += G) att::sb_unit((LAS char*)lds, PROJ, ATT, u >> 6, u & 63);
            for (int r2_ = 0; r2_ < REPN(18); ++r2_) for (int p = vcu; p < 256; p += G) { att::mla_unit((LAS char*)lds, QM, KM, KVRAW, ATT, p >> 6, 127 - (p & 63)); att::mla_unit((LAS char*)lds, QM, KM, KVRAW, ATT, p >> 6, p & 63); }
            att::NsaT T{PROJ, KCMP, VCMP, KS, VTS, KW, GN, LUT8, ATT, 8.08f * CONS[1 + l], CONS[0]};
            for (int r2_ = 0; r2_ < REPN(19); ++r2_) for (int p = vcu; p < 256; p += G) { att::nsa_unit((LAS char*)lds, T, p >> 7, 255 - (p & 127)); att::nsa_unit((LAS char*)lds, T, p >> 7, p & 127); }
            }
            SEAM(pb + 5);
        }
        if (PHON(6) && IN(pb + 6)) { PHASE_LOCALS for (int rep_ = 0; rep_ < REPN(6); ++rep_) {
            for (int mix = 0; mix < 3; ++mix) {
                const int K = (mix == 1) ? 512 : 256; const int acol = (mix == 0) ? 0 : (mix == 1) ? 256 : 768;
                const bf16_t* Bt = (const bf16_t*)(lw + (mix == 0 ? LW_SBO : mix == 1 ? LW_NSAO : LW_MLAO));
                pg8::StaticOrder So; So.init(ATT + acol, Bt, 1024, K, S, 1024, G, bid);
                pg8::EpiGate E{MRG, PROJ + PC_GATE + mix * 1024, NPROJ, in.b_gate + l * 3072 + mix * 1024, mix == 0 ? 1 : 0};
                pg8::gemm_phase<pg8::EpiGate, pg8::StaticOrder, true, false>(lds, 1024, K, K, So, E);
            }
            }
            SEAM(pb + 6);
        }
        if (PHON(7) && IN(pb + 7)) { PHASE_LOCALS for (int rep_ = 0; rep_ < REPN(7); ++rep_) {
            pg8::StaticOrder So; So.init(MRG, (const bf16_t*)(lw + LW_WOUT), 1024, 1024, S, 1024, G, bid);
            pg8::EpiResid E{x_in, x_out};
            pg8::gemm_phase<pg8::EpiResid, pg8::StaticOrder, true, false>(lds, 1024, 1024, 1024, So, E);
            }
            SEAM(pb + 7);
        }
        if (PHON(8) && IN(pb + 8)) { PHASE_LOCALS for (int rep_ = 0; rep_ < REPN(8); ++rep_) {
            if (l == 1) {
                for (int it = gw; it < 8 * 3584; it += NGW) { const int e = it / 3584, r = it % 3584;
                    tr_item(TrSrc{in.moe_w_gate + (size_t)e * 1024 * EFF, in.moe_w_up + (size_t)e * 1024 * EFF, EFF, EFF, 2}, 1024, (bf16_t*)(wsl + WS_MGU) + (size_t)e * 7168 * 1024, scr, r / 224, r % 224, lane); }
                for (int it = gw; it < 8 * 1792; it += NGW) { const int e = it / 1792, r = it % 1792;
                    tr_item(TrSrc{in.moe_w_down + (size_t)e * EFF * 1024, nullptr, 1024, 1024, 0}, EFF, (bf16_t*)(wsl + WS_MDN) + (size_t)e * 1024 * EFF, scr, r / 32, r % 32, lane); }
            }
            for (int m = gw; m < S; m += NGW) {
                f32x4 v[4]; rms_row(x_out + (size_t)m * 1024, in.ffn_norm + l * 1024, Hb + (size_t)m * 1024, lane, v);
                if (l == 1) {
                    float lg[8];
#pragma unroll
                    for (int e = 0; e < 8; ++e) lg[e] = 0.f;
#pragma unroll
                    for (int j = 0; j < 4; ++j)
#pragma unroll
                        for (int q = 0; q < 4; ++q) { const float* wr = in.moe_router + (size_t)(4 * lane + 256 * j + q) * 8; const f32x4 wa = *(const f32x4*)wr, wb = *(const f32x4*)(wr + 4); const float hv = v[j][q];
                            lg[0] += hv * wa.x; lg[1] += hv * wa.y; lg[2] += hv * wa.z; lg[3] += hv * wa.w; lg[4] += hv * wb.x; lg[5] += hv * wb.y; lg[6] += hv * wb.z; lg[7] += hv * wb.w; }
#pragma unroll
                    for (int e = 0; e < 8; ++e) lg[e] = wave_sum(lg[e]);
                    int e0 = 0; float v0 = lg[0];
#pragma unroll
                    for (int e = 1; e < 8; ++e) if (lg[e] > v0) { v0 = lg[e]; e0 = e; }
                    int e1 = -1; float v1 = -INFINITY;
#pragma unroll
                    for (int e = 0; e < 8; ++e) if (e != e0 && lg[e] > v1) { v1 = lg[e]; e1 = e; }
                    if (lane == 0) { const float w0 = 1.f / (1.f + __expf(v1 - v0)), w1 = 1.f - w0;
                        const int p0 = (int)__hip_atomic_fetch_add(ctl + CW_MOECNT + 64 * e0, 1u, RLX_AGENT), p1 = (int)__hip_atomic_fetch_add(ctl + CW_MOECNT + 64 * e1, 1u, RLX_AGENT);
                        ROWTOK[e0 * S + p0] = m; ROWTOK[e1 * S + p1] = m;
                        int* r = ROUTE + (size_t)m * 8; r[0] = e0; r[1] = e1; r[2] = p0; r[3] = p1; r[4] = __float_as_int(w0); r[5] = __float_as_int(w1); }
                }
            }
            }
            SEAM(pb + 8);
        }
        if (l == 0) {
#define ACT0 ((bf16_t*)(wsl + WS_R1))
            if (PHON(9) && IN(pb + 9)) { PHASE_LOCALS for (int rep_ = 0; rep_ < REPN(9); ++rep_) {
                pg8::StaticOrder So; So.init(Hb, (const bf16_t*)(wsl + WS_DGU), 1024, 1024, S, 2 * DFF, G, bid);
                pg8::EpiSwiglu E{ACT0, DFF};
                pg8::gemm_phase<pg8::EpiSwiglu, pg8::StaticOrder, true, false>(lds, 1024, 1024, 1024, So, E);
#if GREP & 2
                pg8::gemm_phase<pg8::EpiSwiglu, pg8::StaticOrder, true, false>(lds, 1024, 1024, 1024, So, E);
#endif
            }
                SEAM(pb + 9);
            }
            if (PHON(10) && IN(pb + 10)) { PHASE_LOCALS for (int rep_ = 0; rep_ < REPN(10); ++rep_) {
                pg8::StaticOrder So; So.init(ACT0, (const bf16_t*)(wsl + WS_DDN), DFF, DFF, S, 1024, G, bid);
                pg8::EpiResid E{x_out, x_out};
                pg8::gemm_phase<pg8::EpiResid, pg8::StaticOrder, true, false>(lds, DFF, DFF, DFF, So, E);
            }
                SEAM(pb + 10);
            }
        } else {
#define ACT1 ((bf16_t*)(wsl + WS_R2))
#define YB ((bf16_t*)(wsl + WS_Y))
            for (int ps = 0; ps < 3; ++ps) {
                if (PHON(11) && IN(pb + 9 + 2 * ps)) { PHASE_LOCALS for (int rep_ = 0; rep_ < REPN(11); ++rep_) {
                    if (tid == 0) { int tb = 0; for (int e = 0; e < 8; ++e) { const int c = (int)__hip_atomic_load(ctl + CW_MOECNT + 64 * e, RLX_AGENT); MTAB[e] = c; MTAB[8 + e] = tb; tb += (c + 255) >> 8; } MTAB[16] = tb; }
                    __syncthreads();
                    const int T = MTAB[16], tlo = 64 * ps, thi = T < tlo + 64 ? T : tlo + 64;
                    MoeGU So{MTAB, Hb, (const bf16_t*)(wsl + WS_MGU), ROWTOK, tlo, thi, G, bid};
                    pg8::EpiSwiglu E{ACT1, EFF};
                    pg8::gemm_phase<pg8::EpiSwiglu, MoeGU, true, true>(lds, 1024, 1024, 1024, So, E);
#if GREP & 4
                    pg8::gemm_phase<pg8::EpiSwiglu, MoeGU, true, true>(lds, 1024, 1024, 1024, So, E);
#endif
            }
                    SEAM(pb + 9 + 2 * ps);
                }
                if (PHON(12) && IN(pb + 10 + 2 * ps)) { PHASE_LOCALS for (int rep_ = 0; rep_ < REPN(12); ++rep_) {
                    if (tid == 0) { int tb = 0; for (int e = 0; e < 8; ++e) { const int c = (int)__hip_atomic_load(ctl + CW_MOECNT + 64 * e, RLX_AGENT); MTAB[e] = c; MTAB[8 + e] = tb; tb += (c + 255) >> 8; } MTAB[16] = tb; }
                    __syncthreads();
                    const int T = MTAB[16], tlo = 64 * ps, thi = T < tlo + 64 ? T : tlo + 64;
                    MoeDN So{MTAB, ACT1, (const bf16_t*)(wsl + WS_MDN), tlo, thi, G, bid};
                    pg8::EpiStore E{YB, 1024, nullptr, 1.f, 0};
                    pg8::gemm_phase<pg8::EpiStore, MoeDN, true, false>(lds, EFF, EFF, EFF, So, E);
#if GREP & 8
                    pg8::gemm_phase<pg8::EpiStore, MoeDN, true, false>(lds, EFF, EFF, EFF, So, E);
#endif
            }
                    SEAM(pb + 10 + 2 * ps);
                }
            }
            if (PHON(15) && IN(pb + 15)) { PHASE_LOCALS for (int rep_ = 0; rep_ < REPN(15); ++rep_) {
                if (tid == 0) { int tb = 0; for (int e = 0; e < 8; ++e) { const int c = (int)__hip_atomic_load(ctl + CW_MOECNT + 64 * e, RLX_AGENT); MTAB[e] = c; MTAB[8 + e] = tb; tb += (c + 255) >> 8; } MTAB[16] = tb; }
                __syncthreads();
                for (int m = gw; m < S; m += NGW) {
                    const int* r = ROUTE + (size_t)m * 8; const int e0 = r[0], e1 = r[1]; const float w0 = __int_as_float(r[4]), w1 = __int_as_float(r[5]);
                    const bf16_t* y0 = YB + ((size_t)MTAB[8 + e0] * 256 + r[2]) * 1024; const bf16_t* y1 = YB + ((size_t)MTAB[8 + e1] * 256 + r[3]) * 1024;
                    float* xo = x_out + (size_t)m * 1024;
#pragma unroll
                    for (int j = 0; j < 4; ++j) { const int c = 4 * lane + 256 * j; f32x4 xv = *(const f32x4*)(xo + c); const u32x2 a = *(const u32x2*)(y0 + c), b = *(const u32x2*)(y1 + c);
                        xv.x += w0 * bflo(a.x) + w1 * bflo(b.x); xv.y += w0 * bfhi(a.x) + w1 * bfhi(b.x); xv.z += w0 * bflo(a.y) + w1 * bflo(b.y); xv.w += w0 * bfhi(a.y) + w1 * bfhi(b.y);
                        *(f32x4*)(xo + c) = xv; }
                }
            }
                if (l == 0) SEAM(pb + 15);
            }
        }
    }
#undef IN
#undef SEAM
}

extern "C" void kernel_launch(void* const* d_in, const int* in_sizes, int n_in, void* d_out, int out_size, void* d_ws, size_t ws_size, hipStream_t stream) {
    static int grid = 0;
    if (grid == 0) {
        if (n_in != 28 || in_sizes[0] != S * DM || out_size != S * DM || ws_size < WS_END) { fprintf(stderr, "kernel_launch: unexpected problem (n_in %d, in0 %d, out %d, ws %zu < %zu); nothing launched\n", n_in, n_in > 0 ? in_sizes[0] : -1, out_size, ws_size, (size_t)WS_END); grid = -1; return; }
        int dev = 0, cus = 0, per_cu = 0;
        if (hipGetDevice(&dev) != hipSuccess || hipDeviceGetAttribute(&cus, hipDeviceAttributeMultiprocessorCount, dev) != hipSuccess) { grid = -1; return; }
        if (hipFuncSetAttribute((const void*)fwd_kernel, hipFuncAttributeMaxDynamicSharedMemorySize, LDS_BYTES) != hipSuccess) { fprintf(stderr, "kernel_launch: hipFuncSetAttribute failed\n"); grid = -1; return; }
        if (hipOccupancyMaxActiveBlocksPerMultiprocessor(&per_cu, (const void*)fwd_kernel, NWAVES * 64, LDS_BYTES) != hipSuccess || per_cu < 1) { fprintf(stderr, "kernel_launch: occupancy query reports %d blocks per CU\n", per_cu); (void)hipGetLastError(); }
        grid = cus;
    }
    if (grid < 0) return;
    if (hipMemsetAsync((char*)d_ws + WS_CTL, 0, CTL_ZERO_BYTES, stream) != hipSuccess) return;
    Args a{};
    const float** ip = (const float**)&a.in;
    for (int i = 0; i < 28; ++i) ip[i] = (const float*)d_in[i];
    a.out = (float*)d_out; a.ws = (unsigned char*)d_ws;
#if MK_MULTI
    for (int ph = 0; ph < NPHASES; ++ph) {
        if (ph >= 1 + 11 && ph < 1 + PH_PER_LAYER) continue;
        a.ph_lo = ph; a.ph_hi = ph + 1;
        hipLaunchKernelGGL(fwd_kernel, dim3(grid), dim3(NWAVES * 64), LDS_BYTES, stream, a);
    }
#else
    a.ph_lo = 0; a.ph_hi = NPHASES;
    hipLaunchKernelGGL(fwd_kernel, dim3(grid), dim3(NWAVES * 64), LDS_BYTES, stream, a);
#endif
    const hipError_t le = hipPeekAtLastError();
    if (le != hipSuccess) fprintf(stderr, "kernel_launch: launch failed: %s\n", hipGetErrorName(le));
}
```

```cpp
#include <hip/hip_runtime.h>
#include <cstdio>
#include <cstdint>
#include <cmath>

#define LAS __attribute__((address_space(3)))
#define GAS __attribute__((address_space(1)))
typedef unsigned short bf16_t;
typedef short bf16x8 __attribute__((ext_vector_type(8)));
typedef short s16x4 __attribute__((ext_vector_type(4)));
typedef float f32x2 __attribute__((ext_vector_type(2)));
typedef float f32x4 __attribute__((ext_vector_type(4)));
typedef float f32x16 __attribute__((ext_vector_type(16)));
typedef unsigned u32x2 __attribute__((ext_vector_type(2)));
typedef unsigned u32x4 __attribute__((ext_vector_type(4)));
typedef __bf16 bf16x2_t __attribute__((ext_vector_type(2)));
typedef GAS unsigned gu32;
#define RLX_AGENT __ATOMIC_RELAXED, __HIP_MEMORY_SCOPE_AGENT
#define DI __device__ __forceinline__

DI unsigned cvtpk(float lo, float hi) { f32x2 v = {lo, hi}; bf16x2_t b = __builtin_convertvector(v, bf16x2_t); return __builtin_bit_cast(unsigned, b); }
DI float bf2f(bf16_t b) { return __uint_as_float(((unsigned)b) << 16); }
DI float bflo(unsigned w) { return __uint_as_float(w << 16); }
DI float bfhi(unsigned w) { return __uint_as_float(w & 0xffff0000u); }
DI bf16_t f2bf(float f) { return (bf16_t)(cvtpk(f, 0.f) & 0xffffu); }
DI float fast_exp2(float x) { return __builtin_amdgcn_exp2f(x); }
DI float fast_log2(float x) { return __builtin_amdgcn_logf(x); }
DI float fast_rcp(float x) { return __builtin_amdgcn_rcpf(x); }
constexpr float LOG2E = 1.4426950408889634f;
DI float sigmoidf_(float x) { return fast_rcp(1.f + fast_exp2(-x * LOG2E)); }
DI float siluf_(float x) { return x * sigmoidf_(x); }
template <int K> DI unsigned sxu(unsigned v) { return (unsigned)__builtin_amdgcn_ds_swizzle((int)v, (K << 10) | 0x1f); }
template <int K> DI float sx(float v) { return __uint_as_float(sxu<K>(__float_as_uint(v))); }
DI unsigned sx32u(unsigned v, int hi) { auto rr = __builtin_amdgcn_permlane32_swap(v, v, false, false); return hi ? rr[0] : rr[1]; }
DI float sx32(float v, int hi) { return __uint_as_float(sx32u(__float_as_uint(v), hi)); }
DI float sum32sym(float v) { auto rr = __builtin_amdgcn_permlane32_swap(__float_as_uint(v), __float_as_uint(v), false, false); return __uint_as_float(rr[0]) + __uint_as_float(rr[1]); }

namespace pg8 {
constexpr int BM = 256, BK = 64, HALF = 128, HTB = HALF * BK * 2, STAGE_BYTES = 8 * HTB, NXCD = 8, WGM = 8;
__host__ __device__ __forceinline__ int lds_byte(int r, int c) { const int st = (r >> 4) * 2 + (c >> 5), rr = r & 15, cc = c & 31, ob = rr * 64 + cc * 2; return st * 1024 + (ob ^ (((ob >> 9) & 1) << 5)); }
__host__ __device__ __forceinline__ void stage_rc(int b, int& R, int& C) { const int st = b / 1024, sb = b % 1024, swz = sb ^ (((sb >> 9) & 1) << 5); R = (st >> 1) * 16 + swz / 64; C = (st & 1) * 32 + (swz % 64) / 2; }
__host__ __device__ __forceinline__ int perm32(int rho) { const int n = rho >> 4, i = rho & 15; return 8 * (i >> 2) + 4 * n + (i & 3); }

struct Unit { const bf16_t* a; const bf16_t* b; const int* rows; int nvalid, pm, pn; };

struct StaticOrder {
    const bf16_t* A; const bf16_t* Bt; int lda, ldb, nM, nN, nwg, G, c;
    DI void init(const bf16_t* A_, const bf16_t* Bt_, int lda_, int ldb_, int M, int N, int G_, int c_) { A = A_; Bt = Bt_; lda = lda_; ldb = ldb_; nM = M / BM; nN = N / BM; nwg = nM * nN; G = G_; c = c_; }
    DI bool next(int i, Unit& u) const {
        if (c < 0 || c >= G) return false;
        const long L = (long)i * G + c; if (L >= nwg) return false;
        int wgid = (int)L; { const int q = nwg / NXCD, r = nwg % NXCD, xcd = wgid % NXCD, off = wgid / NXCD; wgid = (xcd < r ? xcd * (q + 1) : r * (q + 1) + (xcd - r) * q) + off; }
        const int nig = WGM * nN, gid = wgid / nig, fm = gid * WGM, gsz = (nM - fm) < WGM ? (nM - fm) : WGM;
        u.pm = fm + ((wgid % nig) % gsz); u.pn = (wgid % nig) / gsz;
        u.a = A + (size_t)u.pm * BM * lda; u.b = Bt + (size_t)u.pn * BM * ldb; u.rows = nullptr; u.nvalid = BM; return true;
    }
};

struct EpiStore {
    static constexpr bool PERM = true;
    bf16_t* O; int ldc; const float* bias; float scale0; int act;
    DI void operator()(const f32x4 (&acc)[2][2][4][2], const Unit& u, int wr, int wc, int fr, int fq) const {
        const int row0 = u.pm * BM + wr * 64 + fr, col0 = u.pn * BM + wc * 32 + 8 * fq;
        const float sc = (u.pn == 0) ? scale0 : 1.f;
        f32x4 bv[2][2];
#pragma unroll
        for (int bj = 0; bj < 2; ++bj)
#pragma unroll
            for (int n = 0; n < 2; ++n) bv[bj][n] = bias ? *(const f32x4*)(bias + col0 + bj * HALF + 4 * n) : (f32x4){0.f, 0.f, 0.f, 0.f};
#pragma unroll
        for (int ai = 0; ai < 2; ++ai)
#pragma unroll
            for (int m = 0; m < 4; ++m) { bf16_t* rowp = O + (size_t)(row0 + ai * HALF + m * 16) * ldc + col0;
#pragma unroll
                for (int bj = 0; bj < 2; ++bj) { f32x4 v0 = (acc[ai][bj][m][0] + bv[bj][0]) * sc, v1 = (acc[ai][bj][m][1] + bv[bj][1]) * sc;
                    if (act) {
#pragma unroll
                        for (int e = 0; e < 4; ++e) { v0[e] = siluf_(v0[e]); v1[e] = siluf_(v1[e]); } }
                    u32x4 w; w.x = cvtpk(v0[0], v0[1]); w.y = cvtpk(v0[2], v0[3]); w.z = cvtpk(v1[0], v1[1]); w.w = cvtpk(v1[2], v1[3]);
                    *(u32x4*)(rowp + bj * HALF) = w; } }
    }
};
struct EpiGate {
    static constexpr bool PERM = true;
    bf16_t* Mg; const bf16_t* glog; int ldg; const float* bg; int first;
    DI void operator()(const f32x4 (&acc)[2][2][4][2], const Unit& u, int wr, int wc, int fr, int fq) const {
        const int row0 = u.pm * BM + wr * 64 + fr, col0 = u.pn * BM + wc * 32 + 8 * fq;
        f32x4 bv[2][2];
#pragma unroll
        for (int bj = 0; bj < 2; ++bj)
#pragma unroll
            for (int n = 0; n < 2; ++n) bv[bj][n] = *(const f32x4*)(bg + col0 + bj * HALF + 4 * n);
#pragma unroll
        for (int ai = 0; ai < 2; ++ai)
#pragma unroll
            for (int m = 0; m < 4; ++m) { const size_t row = (size_t)(row0 + ai * HALF + m * 16);
#pragma unroll
                for (int bj = 0; bj < 2; ++bj) { const int col = col0 + bj * HALF;
                    const u32x4 gl = *(const u32x4*)(glog + row * ldg + col);
                    u32x4 old = (u32x4){0u, 0u, 0u, 0u}; if (!first) old = *(const u32x4*)(Mg + row * 1024 + col);
                    float g[8] = {bflo(gl.x), bfhi(gl.x), bflo(gl.y), bfhi(gl.y), bflo(gl.z), bfhi(gl.z), bflo(gl.w), bfhi(gl.w)};
                    float o[8] = {bflo(old.x), bfhi(old.x), bflo(old.y), bfhi(old.y), bflo(old.z), bfhi(old.z), bflo(old.w), bfhi(old.w)};
#pragma unroll
                    for (int e = 0; e < 4; ++e) { o[e] += sigmoidf_(g[e] + bv[bj][0][e]) * acc[ai][bj][m][0][e]; o[4 + e] += sigmoidf_(g[4 + e] + bv[bj][1][e]) * acc[ai][bj][m][1][e]; }
                    u32x4 w; w.x = cvtpk(o[0], o[1]); w.y = cvtpk(o[2], o[3]); w.z = cvtpk(o[4], o[5]); w.w = cvtpk(o[6], o[7]);
                    *(u32x4*)(Mg + row * 1024 + col) = w; } }
    }
};
struct EpiResid {
    static constexpr bool PERM = false;
    const float* xin; float* out;
    DI void operator()(const f32x4 (&acc)[2][2][4][2], const Unit& u, int wr, int wc, int fr, int fq) const {
        const int row0 = u.pm * BM + wr * 64 + fr, col0 = u.pn * BM + wc * 32 + 4 * fq;
#pragma unroll
        for (int ai = 0; ai < 2; ++ai)
#pragma unroll
            for (int m = 0; m < 4; ++m) { const size_t off = (size_t)(row0 + ai * HALF + m * 16) * 1024 + col0;
#pragma unroll
                for (int bj = 0; bj < 2; ++bj)
#pragma unroll
                    for (int n = 0; n < 2; ++n) { const f32x4 b = *(const f32x4*)(xin + off + bj * HALF + n * 16); *(f32x4*)(out + off + bj * HALF + n * 16) = b + acc[ai][bj][m][n]; }
                if (m & 1) asm volatile("" ::: "memory"); }
    }
};
struct EpiSwiglu {
    static constexpr bool PERM = true;
    bf16_t* act; int ldact;
    DI void operator()(const f32x4 (&acc)[2][2][4][2], const Unit& u, int wr, int wc, int fr, int fq) const {
        const int row0 = u.pm * BM + wr * 64 + fr, col0 = u.pn * HALF + wc * 32 + 8 * fq;
#pragma unroll
        for (int ai = 0; ai < 2; ++ai)
#pragma unroll
            for (int m = 0; m < 4; ++m) { bf16_t* rowp = act + (size_t)(row0 + ai * HALF + m * 16) * ldact + col0;
                float o[8];
#pragma unroll
                for (int e = 0; e < 4; ++e) { o[e] = siluf_(acc[ai][0][m][0][e]) * acc[ai][1][m][0][e]; o[4 + e] = siluf_(acc[ai][0][m][1][e]) * acc[ai][1][m][1][e]; }
                u32x4 w; w.x = cvtpk(o[0], o[1]); w.y = cvtpk(o[2], o[3]); w.z = cvtpk(o[4], o[5]); w.w = cvtpk(o[6], o[7]);
                *(u32x4*)rowp = w; }
    }
};

template <class Epi, class Sched, bool ALIGN_EPI, bool GATHER>
__device__ __forceinline__ void gemm_phase(LAS unsigned char* lds, const int lda, const int ldb, const int K, const Sched& S, const Epi& E) {
    int tid_l = threadIdx.x; asm volatile("" : "+v"(tid_l));
    const int tid = tid_l, wid = __builtin_amdgcn_readfirstlane(tid >> 6), lane = tid & 63, wr = wid >> 2, wc = wid & 3, fr = lane & 15, fq = lane >> 4;
    const int nt = K / BK;
    unsigned voffB[2], vc0[2], vc1[2], vn0[2], vn1[2];
#pragma unroll
    for (int i = 0; i < 2; ++i) { int R, C; stage_rc(tid * 16 + i * 8192, R, C); const int Rb = Epi::PERM ? ((R & ~31) + perm32(R & 31)) : R;
        voffB[i] = (unsigned)(Rb * ldb + C) * 2u; vc0[i] = (unsigned)(R * lda + C) * 2u; vc1[i] = vc0[i]; vn0[i] = vc0[i]; vn1[i] = vc0[i]; }
    const size_t hsA = GATHER ? (size_t)0 : (size_t)HALF * lda * 2, hsB = (size_t)HALF * ldb * 2;
    const size_t kstep = (size_t)(BK * 2);
    const unsigned ldsw = (unsigned)wid * 1024u;
    const int aoff = lds_byte(wr * 64 + fr, fq * 8), boff = lds_byte(wc * 32 + fr, fq * 8);
#define PG8_SA(b, h) (((b) * 2 + (h)) * HTB)
#define PG8_SB(b, h) ((4 + (b) * 2 + (h)) * HTB)
#define PG8_STAGE(bufoff, gbase, voff) do { _Pragma("unroll") for (int _i = 0; _i < 2; ++_i) \
        __builtin_amdgcn_global_load_lds((const unsigned*)((const char*)(gbase) + (voff)[_i]), (LAS unsigned*)(lds + (bufoff) + ldsw + _i * 8192), 16, 0, 0); } while (0)
#define PG8_LDA(dst, b, h) do { _Pragma("unroll") for (int m = 0; m < 4; ++m) _Pragma("unroll") for (int k = 0; k < 2; ++k) dst[m][k] = *(const LAS bf16x8*)(lds + PG8_SA(b, h) + aoff + m * 2048 + k * 1024); } while (0)
#define PG8_LDB(dst, b, h) do { _Pragma("unroll") for (int n = 0; n < 2; ++n) _Pragma("unroll") for (int k = 0; k < 2; ++k) dst[n][k] = *(const LAS bf16x8*)(lds + PG8_SB(b, h) + boff + n * 2048 + k * 1024); } while (0)
#define PG8_MMA(ai, bj, At, Bt) do { __builtin_amdgcn_s_setprio(1); _Pragma("unroll") for (int m = 0; m < 4; ++m) _Pragma("unroll") for (int n = 0; n < 2; ++n) _Pragma("unroll") for (int k = 0; k < 2; ++k) \
        acc[ai][bj][m][n] = __builtin_amdgcn_mfma_f32_16x16x32_bf16(Bt[n][k], At[m][k], acc[ai][bj][m][n], 0, 0, 0); __builtin_amdgcn_s_setprio(0); } while (0)
#define PG8_WAIT_V(n) asm volatile("s_waitcnt vmcnt(" #n ")" ::: "memory")
#define PG8_WAIT_L(n) asm volatile("s_waitcnt lgkmcnt(" #n ")" ::: "memory")
#define PG8_BAR __builtin_amdgcn_s_barrier()
#define PG8_SCHED __builtin_amdgcn_sched_barrier(0)
#define PG8_GVOFF(U, o0, o1) do { if constexpr (GATHER) { _Pragma("unroll") for (int _i = 0; _i < 2; ++_i) { int R_, C_; stage_rc(tid * 16 + _i * 8192, R_, C_); \
        const int r0_ = R_, r1_ = R_ + HALF; const int t0_ = (U).rows[r0_ < (U).nvalid ? r0_ : 0], t1_ = (U).rows[r1_ < (U).nvalid ? r1_ : 0]; \
        o0[_i] = (unsigned)(t0_ * lda + C_) * 2u; o1[_i] = (unsigned)(t1_ * lda + C_) * 2u; } } } while (0)
    Unit cur, nxt; int ui = 0;
    if (!S.next(0, cur)) return;
    PG8_GVOFF(cur, vc0, vc1);
    f32x4 acc[2][2][4][2];
#pragma unroll
    for (int a = 0; a < 2; ++a)
#pragma unroll
        for (int b = 0; b < 2; ++b)
#pragma unroll
            for (int m = 0; m < 4; ++m)
#pragma unroll
                for (int n = 0; n < 2; ++n) acc[a][b][m][n] = (f32x4){0.f, 0.f, 0.f, 0.f};
    bf16x8 At[4][2], B0[2][2], B1[2][2];
    const char* cA = (const char*)cur.a; const char* cB = (const char*)cur.b;
    PG8_STAGE(PG8_SB(0, 0), cB, voffB); PG8_STAGE(PG8_SB(0, 1), cB + hsB, voffB); PG8_STAGE(PG8_SA(0, 0), cA, vc0); PG8_STAGE(PG8_SA(0, 1), cA + hsA, vc1);
    if (wr == 1) PG8_BAR;
    PG8_WAIT_V(2); PG8_BAR;
    PG8_STAGE(PG8_SB(1, 0), cB + kstep, voffB); PG8_STAGE(PG8_SA(1, 0), cA + kstep, vc0); PG8_STAGE(PG8_SB(1, 1), cB + hsB + kstep, voffB);
    PG8_WAIT_V(6); PG8_BAR;
    for (;;) {
        const bool has_next = S.next(ui + 1, nxt);
        const char* nA = has_next ? (const char*)nxt.a : cA; const char* nB = has_next ? (const char*)nxt.b : cB;
        if constexpr (GATHER) { if (has_next) { PG8_GVOFF(nxt, vn0, vn1); } else {
#pragma unroll
            for (int i = 0; i < 2; ++i) { vn0[i] = vc0[i]; vn1[i] = vc1[i]; } } }
        for (int t = 0; t < nt; t += 2) {
            const bool last = (t == nt - 2);
            const char* a1 = cA + (size_t)(t + 1) * kstep;
            const char* a2 = last ? nA : cA + (size_t)(t + 2) * kstep; const char* b2 = last ? nB : cB + (size_t)(t + 2) * kstep;
            const char* a3 = a2 + kstep; const char* b3 = b2 + kstep;
            unsigned v20[2], v21[2];
#pragma unroll
            for (int i = 0; i < 2; ++i) { v20[i] = (GATHER && last) ? vn0[i] : vc0[i]; v21[i] = GATHER ? (last ? vn1[i] : vc1[i]) : vc0[i]; }
            PG8_LDB(B0, 0, 0); PG8_LDB(B1, 0, 1); PG8_SCHED; PG8_LDA(At, 0, 0); PG8_STAGE(PG8_SA(1, 1), a1 + hsA, vc1);
            PG8_WAIT_V(8); PG8_WAIT_L(0); PG8_BAR; PG8_MMA(0, 0, At, B0); PG8_MMA(0, 1, At, B1); PG8_BAR; PG8_SCHED;
            PG8_LDA(At, 0, 1); PG8_STAGE(PG8_SB(0, 0), b2, voffB); PG8_STAGE(PG8_SB(0, 1), b2 + hsB, voffB); PG8_STAGE(PG8_SA(0, 0), a2, v20);
            PG8_WAIT_V(8); PG8_WAIT_L(0); PG8_BAR; PG8_MMA(1, 0, At, B0); PG8_MMA(1, 1, At, B1); PG8_BAR; PG8_SCHED;
            PG8_LDB(B0, 1, 0); PG8_LDB(B1, 1, 1); PG8_SCHED; PG8_LDA(At, 1, 0); PG8_STAGE(PG8_SA(0, 1), a2 + hsA, v21);
            PG8_WAIT_V(8); PG8_WAIT_L(0); PG8_BAR; PG8_MMA(0, 0, At, B0); PG8_MMA(0, 1, At, B1); PG8_BAR; PG8_SCHED;
            PG8_LDA(At, 1, 1); PG8_STAGE(PG8_SB(1, 0), b3, voffB); PG8_STAGE(PG8_SB(1, 1), b3 + hsB, voffB); PG8_STAGE(PG8_SA(1, 0), a3, v20);
            PG8_WAIT_V(8); PG8_WAIT_L(0); PG8_BAR; PG8_MMA(1, 0, At, B0); PG8_MMA(1, 1, At, B1); PG8_BAR; PG8_SCHED;
        }
        if constexpr (ALIGN_EPI) { if (wr == 0) PG8_BAR; }
        E(acc, cur, wr, wc, fr, fq);
        if (!has_next) break;
#pragma unroll
        for (int a = 0; a < 2; ++a)
#pragma unroll
            for (int b = 0; b < 2; ++b)
#pragma unroll
                for (int m = 0; m < 4; ++m)
#pragma unroll
                    for (int n = 0; n < 2; ++n) acc[a][b][m][n] = (f32x4){0.f, 0.f, 0.f, 0.f};
        cur = nxt; cA = nA; cB = nB; ++ui;
        if constexpr (GATHER) {
#pragma unroll
            for (int i = 0; i < 2; ++i) { vc0[i] = vn0[i]; vc1[i] = vn1[i]; } }
        if constexpr (ALIGN_EPI) { if (wr == 1) PG8_BAR; }
    }
    PG8_WAIT_V(0);
    if constexpr (!ALIGN_EPI) { if (wr == 0) PG8_BAR; }
    PG8_BAR;
#undef PG8_SA
#undef PG8_SB
#undef PG8_STAGE
#undef PG8_LDA
#undef PG8_LDB
#undef PG8_MMA
#undef PG8_WAIT_V
#undef PG8_WAIT_L
#undef PG8_BAR
#undef PG8_SCHED
#undef PG8_GVOFF
}
}
#define XB_TMO      128
#define XB_XCNT(j)  (256  + 64 * (j))
#define XB_XSUB(j)  (1280 + 64 * (j))
#define XB_XGEN(j)  (2304 + 64 * (j))
#define XB_TOP      3328
#define XB_TOPGEN   3392
#define XCD_BAR_WORDS 3456
#define XB_SPIN_CAP (1u << 18)

__device__ __forceinline__ unsigned xb_ld(unsigned* p)              { return __hip_atomic_load(p, __ATOMIC_RELAXED, __HIP_MEMORY_SCOPE_AGENT); }
__device__ __forceinline__ unsigned xb_add(unsigned* p, unsigned v) { return __hip_atomic_fetch_add(p, v, __ATOMIC_RELAXED, __HIP_MEMORY_SCOPE_AGENT); }
__device__ __forceinline__ unsigned xb_xcc_id() { return (unsigned)__builtin_amdgcn_s_getreg((3 << 11) | 20) & 0xFu; }
#define XB_SPIN(cond, bar) do { unsigned _sp = 0; while (cond) { __builtin_amdgcn_s_sleep(1); \
    if ((++_sp & 255u) == 0u) { if (xb_ld(&(bar)[XB_TMO])) break; if (_sp > XB_SPIN_CAP) { atomicAdd(&(bar)[XB_TMO], 1u); break; } } } } while (0)

struct XcdBarrier {
    unsigned* bar; unsigned x;
    volatile LAS unsigned* st;
};

__device__ __forceinline__ XcdBarrier xcd_barrier_post(unsigned* bar, volatile LAS unsigned* st) {
    XcdBarrier b; b.bar = bar; b.x = xb_xcc_id(); b.st = st;
    if (threadIdx.x == 0) (void)xb_add(&bar[XB_XCNT(b.x)], 1u);
    return b;
}
__device__ __forceinline__ void xcd_barrier_complete(unsigned* bar, unsigned x, unsigned& nloc, unsigned& nx) {
    const unsigned G = gridDim.x * gridDim.y * gridDim.z;
    unsigned sum, cnt, mine, sp = 0u;
    for (;;) {
        sum = 0u; cnt = 0u; mine = 0u;
#pragma unroll
        for (unsigned j = 0; j < 16; ++j) { const unsigned c = xb_ld(&bar[XB_XCNT(j)]); sum += c; cnt += (c > 0u) ? 1u : 0u; mine = (j == x) ? c : mine; }
        if (sum == G) break;
        __builtin_amdgcn_s_sleep(1);
        if ((++sp & 255u) == 0u) { if (xb_ld(&bar[XB_TMO])) break; if (sp > XB_SPIN_CAP) { atomicAdd(&bar[XB_TMO], 1u); break; } }
    }
    nloc = mine > 0u ? mine : 1u; nx = cnt > 0u ? cnt : 1u;
}

__device__ __forceinline__ void xcd_barrier(const XcdBarrier& b) {
    asm volatile("s_waitcnt vmcnt(0)" ::: "memory");
    __syncthreads();
    if (threadIdx.x == 0) {
        unsigned* bar = b.bar;
        __builtin_amdgcn_s_waitcnt(0);
        unsigned nloc = b.st[0], nx = b.st[1];
        if (nloc == 0u) { xcd_barrier_complete(bar, b.x, nloc, nx); b.st[0] = nloc; b.st[1] = nx; }
        const unsigned old = xb_add(&bar[XB_XSUB(b.x)], 1u);
        const unsigned gen = old / nloc;
        if (old + 1u == (gen + 1u) * nloc) {
            __builtin_amdgcn_fence(__ATOMIC_RELEASE, "agent");
            asm volatile("s_waitcnt vmcnt(0)" ::: "memory");
            const unsigned og = xb_add(&bar[XB_TOP], 1u);
            const unsigned tg = og / nx;
            if (og + 1u == (tg + 1u) * nx) xb_add(&bar[XB_TOPGEN], 1u);
            else XB_SPIN(xb_ld(&bar[XB_TOPGEN]) == tg, bar);
            __builtin_amdgcn_fence(__ATOMIC_ACQUIRE, "agent");
            xb_add(&bar[XB_XGEN(b.x)], 1u);
            asm volatile("s_waitcnt vmcnt(0)" ::: "memory");
        } else {
            XB_SPIN(xb_ld(&bar[XB_XGEN(b.x)]) == gen, bar);
            __builtin_amdgcn_fence(__ATOMIC_ACQUIRE, "agent");
            asm volatile("s_waitcnt vmcnt(0)" ::: "memory");
        }
    }
    __syncthreads();
}
namespace att {
typedef short v4i16_t __attribute__((ext_vector_type(4)));
DI f32x16 mfma32(bf16x8 a, bf16x8 b, f32x16 c) { return __builtin_amdgcn_mfma_f32_32x32x16_bf16(a, b, c, 0, 0, 0); }
DI f32x4 mfma16(bf16x8 a, bf16x8 b, f32x4 c) { return __builtin_amdgcn_mfma_f32_16x16x32_bf16(a, b, c, 0, 0, 0); }
DI int crow(int r, int hi) { return (r & 3) + 8 * (r >> 2) + 4 * hi; }
DI s16x4 vtr(const LAS char* p) { return __builtin_bit_cast(s16x4, __builtin_amdgcn_ds_read_tr16_b64_v4i16((LAS v4i16_t*)p)); }
DI int rfl(int x) { return __builtin_amdgcn_readfirstlane(x); }
constexpr float NEGBIG = -1e30f;

template <int D, int KS> DI f32x16 qk32(const LAS char* kp, const bf16x8* qf, float init = 0.f) {
    f32x16 acc;
#pragma unroll
    for (int i = 0; i < 16; ++i) acc[i] = init;
#pragma unroll
    for (int d0 = 0; d0 < D / 16; ++d0) acc = mfma32(*(const LAS bf16x8*)(kp + d0 * 32), qf[d0], acc);
    return acc;
}
template <int VS> DI void pv32(f32x16 (&o)[2], const LAS char* vp, bf16x8 pf0, bf16x8 pf1) {
#pragma unroll
    for (int dh = 0; dh < 2; ++dh) {
        const s16x4 l0 = vtr(vp + dh * 64), h0 = vtr(vp + 8 * VS + dh * 64), l1 = vtr(vp + 16 * VS + dh * 64), h1 = vtr(vp + 24 * VS + dh * 64);
        const bf16x8 v0 = __builtin_shufflevector(l0, h0, 0, 1, 2, 3, 4, 5, 6, 7), v1 = __builtin_shufflevector(l1, h1, 0, 1, 2, 3, 4, 5, 6, 7);
        o[dh] = mfma32(v0, pf0, o[dh]); o[dh] = mfma32(v1, pf1, o[dh]);
    }
}
DI bf16x8 pack8(const f32x16& p, int s) {
    u32x4 w; w.x = cvtpk(p[8 * s], p[8 * s + 1]); w.y = cvtpk(p[8 * s + 2], p[8 * s + 3]); w.z = cvtpk(p[8 * s + 4], p[8 * s + 5]); w.w = cvtpk(p[8 * s + 6], p[8 * s + 7]);
    return __builtin_bit_cast(bf16x8, w);
}
DI float max16(const f32x16& p) { float a = fmaxf(fmaxf(p[0], p[1]), fmaxf(p[2], p[3]));
#pragma unroll
    for (int r = 4; r < 16; r += 4) a = fmaxf(a, fmaxf(fmaxf(p[r], p[r + 1]), fmaxf(p[r + 2], p[r + 3]))); return a; }
DI void store_ot(bf16_t* dst, const f32x16 (&o)[2], int hi) {
#pragma unroll
    for (int dh = 0; dh < 2; ++dh)
#pragma unroll
        for (int g4 = 0; g4 < 4; ++g4) { u32x2 w; w.x = cvtpk(o[dh][4 * g4], o[dh][4 * g4 + 1]); w.y = cvtpk(o[dh][4 * g4 + 2], o[dh][4 * g4 + 3]); *(u32x2*)(dst + 32 * dh + 8 * g4 + 4 * hi) = w; }
}

constexpr int MLA_KS = 208, MLA_VS = 144, MLA_KB = 128 * MLA_KS, MLA_VB = 128 * MLA_VS, MLA_BUF = MLA_KB + MLA_VB;
DI void mla_unit(LAS char* lds, const bf16_t* QM, const bf16_t* KM, const bf16_t* KV, bf16_t* ATT, int head, int qb, float kb) {
    int tid_l = threadIdx.x; asm volatile("" : "+v"(tid_l));
    const int tid = tid_l, lane = tid & 63, wid = rfl(tid >> 6), r32 = lane & 31, hi = lane >> 5, half = wid >> 2, wq = wid & 3;
    const int q0 = qb * 128, qpos = q0 + 32 * wq + r32, nsuper = qb + 1;
    bf16x8 qf[6];
    { const bf16_t* qp = QM + (size_t)qpos * 384 + head * 96 + hi * 8;
#pragma unroll
      for (int d0 = 0; d0 < 6; ++d0) qf[d0] = *(const bf16x8*)(qp + d0 * 16); }
    float nref;
    { float qs = 0.f;
#pragma unroll
      for (int d0 = 0; d0 < 6; ++d0)
#pragma unroll
          for (int e = 0; e < 8; ++e) { const float v = __uint_as_float(((unsigned)(unsigned short)qf[d0][e]) << 16); qs += v * v; }
      qs += sx32(qs, hi); nref = -sqrtf(qs) * kb; }
    u32x4 kr[3], vr[2];
#define MLA_LOAD(i) do { _Pragma("unroll") for (int j = 0; j < 3; ++j) { const int c = tid + 512 * j, row = c / 12, ch = c % 12; kr[j] = *(const u32x4*)(KM + (size_t)(128 * (i) + row) * 384 + head * 96 + ch * 8); } \
        _Pragma("unroll") for (int j = 0; j < 2; ++j) { const int c = tid + 512 * j, row = c >> 3, ch = c & 7; vr[j] = *(const u32x4*)(KV + (size_t)(128 * (i) + row) * 512 + head * 128 + 64 + ch * 8); } } while (0)
#define MLA_STORE(b) do { LAS char* kb_ = lds + (b) * MLA_BUF; _Pragma("unroll") for (int j = 0; j < 3; ++j) { const int c = tid + 512 * j, row = c / 12, ch = c % 12; *(LAS u32x4*)(kb_ + row * MLA_KS + ch * 16) = kr[j]; } \
        _Pragma("unroll") for (int j = 0; j < 2; ++j) { const int c = tid + 512 * j, row = c >> 3, ch = c & 7; *(LAS u32x4*)(kb_ + MLA_KB + row * MLA_VS + ch * 16) = vr[j]; } } while (0)
    MLA_LOAD(0); MLA_STORE(0); __syncthreads();
    float l = 0.f; f32x16 o[2];
#pragma unroll
    for (int i = 0; i < 16; ++i) { o[0][i] = 0.f; o[1][i] = 0.f; }
    const int vlane = (4 * hi + ((lane & 15) >> 2)) * MLA_VS + 2 * (16 * ((lane >> 4) & 1) + 4 * (lane & 3));
    for (int i = 0; i < nsuper; ++i) {
        const bool more = i + 1 < nsuper;
        if (more) MLA_LOAD(i + 1);
        const LAS char* kb_ = lds + (i & 1) * MLA_BUF; const LAS char* vb = kb_ + MLA_KB;
        const bool diag = (i == nsuper - 1);
        if (!(diag && half == 1 && wq < 2)) {
            const int koff = 64 * half;
            f32x16 p0 = qk32<96, MLA_KS>(kb_ + (koff + r32) * MLA_KS + hi * 16, qf, nref);
            f32x16 p1 = qk32<96, MLA_KS>(kb_ + (koff + 32 + r32) * MLA_KS + hi * 16, qf, nref);
            if (diag) { const int kbase = 128 * i + koff;
#pragma unroll
                for (int r = 0; r < 16; ++r) { const int k0 = kbase + crow(r, hi); p0[r] = (k0 > qpos) ? 0.f : fast_exp2(p0[r]); p1[r] = (k0 + 32 > qpos) ? 0.f : fast_exp2(p1[r]); }
            } else {
#pragma unroll
                for (int r = 0; r < 16; ++r) { p0[r] = fast_exp2(p0[r]); p1[r] = fast_exp2(p1[r]); }
            }
#pragma unroll
            for (int r = 0; r < 16; ++r) l += p0[r] + p1[r];
            pv32<MLA_VS>(o, vb + koff * MLA_VS + vlane, pack8(p0, 0), pack8(p0, 1));
            pv32<MLA_VS>(o, vb + (koff + 32) * MLA_VS + vlane, pack8(p1, 0), pack8(p1, 1));
        }
        if (more) MLA_STORE((i + 1) & 1);
        __syncthreads();
    }
#undef MLA_LOAD
#undef MLA_STORE
    l = sum32sym(l);
    LAS float* mrg = (LAS float*)lds + (wq * 64 + lane) * 34;
    if (half == 1) { mrg[1] = l;
#pragma unroll
        for (int r = 0; r < 16; ++r) { mrg[2 + r] = o[0][r]; mrg[18 + r] = o[1][r]; } }
    __syncthreads();
    if (half == 0) {
        const float inv = 1.f / (l + mrg[1]);
#pragma unroll
        for (int r = 0; r < 16; ++r) { o[0][r] = (o[0][r] + mrg[2 + r]) * inv; o[1][r] = (o[1][r] + mrg[18 + r]) * inv; }
        store_ot(ATT + (size_t)qpos * 1024 + 768 + head * 64, o, hi);
    }
    __syncthreads();
}

constexpr int T_KS = 144, T_KB = 64 * T_KS, T_BUF = 2 * T_KB;
DI void sb_half(f32x16 (&o)[2], float& R, const LAS char* ktile, const LAS char* vtile, const bf16x8* qf, int kb, int hh, int qpos, int r32, int hi, int vlane) {
    f32x16 z = qk32<64, T_KS>(ktile + (32 * hh + r32) * T_KS + hi * 16, qf);
    float ls[16];
#pragma unroll
    for (int r = 0; r < 16; ++r) { const bool valid = (kb + crow(r, hi)) < qpos; const float az = fabsf(z[r]);
        const float sp = fmaxf(z[r], 0.f) + fast_log2(1.f + fast_exp2(-az)); ls[r] = valid ? -sp : 0.f; }
    float T[4], U[4];
#pragma unroll
    for (int g = 0; g < 4; ++g) { ls[4 * g + 2] += ls[4 * g + 3]; ls[4 * g + 1] += ls[4 * g + 2]; ls[4 * g] += ls[4 * g + 1]; T[g] = ls[4 * g]; }
#pragma unroll
    for (int g = 0; g < 4; ++g) U[g] = sx32(T[g], hi);
    float H[4]; float sp = 0.f;
#pragma unroll
    for (int g = 3; g >= 0; --g) { H[g] = sp + (hi == 0 ? U[g] : 0.f); sp += T[g] + U[g]; }
#pragma unroll
    for (int r = 0; r < 16; ++r) { const bool valid = (kb + crow(r, hi)) < qpos; const float lw = z[r] + R + H[r >> 2] + ls[r]; z[r] = valid ? fast_exp2(lw) : 0.f; }
    R += sp;
    pv32<T_KS>(o, vtile + (32 * hh) * T_KS + vlane, pack8(z, 0), pack8(z, 1));
}
DI void sb_unit(LAS char* lds, const bf16_t* PROJ, bf16_t* ATT, int head, int qb) {
    int tid_l = threadIdx.x; asm volatile("" : "+v"(tid_l));
    const int tid = tid_l, lane = tid & 63, wid = rfl(tid >> 6), r32 = lane & 31, hi = lane >> 5;
    const int q0 = qb * 256, wq0 = q0 + 32 * wid, qpos = wq0 + r32;
    bf16x8 qf[4];
    { const bf16_t* qp = PROJ + (size_t)qpos * 5632 + head * 64 + hi * 8;
#pragma unroll
      for (int d0 = 0; d0 < 4; ++d0) qf[d0] = *(const bf16x8*)(qp + d0 * 16); }
    const int srow = tid >> 3, sch = tid & 7;
    u32x4 kr, vr;
#define SB_LOAD(t) do { const bf16_t* p_ = PROJ + (size_t)(64 * (t) + srow) * 5632 + head * 64 + sch * 8; kr = *(const u32x4*)(p_ + 256); vr = *(const u32x4*)(p_ + 512); } while (0)
#define SB_STORE(b) do { LAS char* d_ = lds + (b) * T_BUF + srow * T_KS + sch * 16; *(LAS u32x4*)d_ = kr; *(LAS u32x4*)(d_ + T_KB) = vr; } while (0)
    volatile LAS int* flags = (volatile LAS int*)(lds + 2 * T_BUF);
    int t = 4 * qb + 3;
    SB_LOAD(t); SB_STORE(0); __syncthreads();
    float R = 0.f; f32x16 o[2];
#pragma unroll
    for (int i = 0; i < 16; ++i) { o[0][i] = 0.f; o[1][i] = 0.f; }
    const int vlane = (4 * hi + ((lane & 15) >> 2)) * T_KS + 2 * (16 * ((lane >> 4) & 1) + 4 * (lane & 3));
    bool done = false;
    for (int it = 0;; ++it) {
        const bool more = t > 0;
        if (more) SB_LOAD(t - 1);
        const LAS char* kt = lds + (it & 1) * T_BUF; const LAS char* vt = kt + T_KB;
        if (!done && 64 * t <= wq0 + 30) {
            if (64 * t + 32 <= wq0 + 30) sb_half(o, R, kt, vt, qf, 64 * t + 32, 1, qpos, r32, hi, vlane);
            sb_half(o, R, kt, vt, qf, 64 * t, 0, qpos, r32, hi, vlane);
            done = __all(R < -150.f) != 0;
        }
        if (lane == 0) flags[(it & 1) * 8 + wid] = done ? 0 : 1;
        if (more) SB_STORE((it + 1) & 1);
        __syncthreads();
        int any = 0;
#pragma unroll
        for (int w = 0; w < 8; ++w) any |= flags[(it & 1) * 8 + w];
        if (!more || !any) break;
        --t;
    }
#undef SB_LOAD
#undef SB_STORE
    store_ot(ATT + (size_t)qpos * 1024 + head * 64, o, hi);
    __syncthreads();
}

#ifndef NSAREP
#define NSAREP 0
#endif
#define NSA_NREP(bit) (((NSAREP >> (bit)) & 1) ? 2 : 1)
constexpr int N_LUT = 2 * T_BUF, N_IMP = N_LUT + 16384, N_OSTR = 65, N_BLKQ = N_IMP + 256 * N_OSTR * 4, N_L = N_BLKQ + 2048, N_REF = N_L + 1280, N_END = N_REF + 1024 + 64;
constexpr int N_QS = 144;
struct NsaT {
    const bf16_t* PROJ;
    const bf16_t* KCMP; const bf16_t* VCMP;
    const bf16_t* KS; const bf16_t* VTS;
    const bf16_t* KW;
    const float* GN;
    const float* LUT8;
    bf16_t* ATT;
    float kb, bmax;
};
__host__ __device__ __forceinline__ int vts_key_of_slot(int slot) { const int hh = slot >> 5, s5 = slot & 31, s = s5 >> 4, h = (s5 >> 3) & 1, j = s5 & 7; return 32 * hh + 16 * s + 8 * (j >> 2) + 4 * h + (j & 3); }

DI void nsa_unit(LAS char* lds, const NsaT& T, int g, int qblk) {
    int tid_l = threadIdx.x; asm volatile("" : "+v"(tid_l));
    const int tid = tid_l, lane = tid & 63, wid = rfl(tid >> 6), r32 = lane & 31, hi = lane >> 5;
    const int q0 = qblk * 64;
    LAS float* lut = (LAS float*)(lds + N_LUT);
    LAS float* imp = (LAS float*)(lds + N_IMP);
    LAS unsigned* bq32 = (LAS unsigned*)(lds + N_BLKQ);
    LAS float* refl = (LAS float*)(lds + N_REF);
    for (int i = tid; i < 4096; i += 512) lut[i] = T.LUT8[(i >> 2) * 8 + g * 4 + (i & 3)];
    for (int i = tid; i < 16384; i += 512) imp[i] = 0.f;
    bq32[tid] = 0u;
    const int ql = r32 >> 2, hd = r32 & 3, h8 = g * 4 + hd, tq = q0 + 8 * wid + ql;
    bf16x8 qf[4];
    { const bf16_t* qp = T.PROJ + (size_t)tq * 5632 + 768 + h8 * 64 + hi * 8;
#pragma unroll
      for (int d0 = 0; d0 < 4; ++d0) qf[d0] = *(const bf16x8*)(qp + d0 * 16); }
    float ref;
    { float qs = 0.f;
#pragma unroll
      for (int d0 = 0; d0 < 4; ++d0)
#pragma unroll
          for (int e = 0; e < 8; ++e) { const float v = __uint_as_float(((unsigned)(unsigned short)qf[d0][e]) << 16); qs += v * v; }
      qs += sx32(qs, hi); ref = sqrtf(qs) * T.kb + T.bmax; }
    if (hi == 0) refl[(8 * wid + ql) * 4 + hd] = ref;
    const float gc = T.GN[(size_t)tq * 24 + 3 * h8], gs = T.GN[(size_t)tq * 24 + 3 * h8 + 1], gw = T.GN[(size_t)tq * 24 + 3 * h8 + 2];
    const int srow = tid >> 3, sch = tid & 7;
    const int vlane = (4 * hi + ((lane & 15) >> 2)) * T_KS + 2 * (16 * ((lane >> 4) & 1) + 4 * (lane & 3));
    u32x4 kr, vr;
    __syncthreads();
    const float cfar = lut[1023 * 4 + hd] - ref;
    const int nmax = (q0 + 32) / 16 + 1;
    const int ntc = (nmax + 63) >> 6;
    const bf16_t* kc = T.KCMP + (size_t)g * 1024 * 64; const bf16_t* vc = T.VCMP + (size_t)g * 1024 * 64;
    const int relq = tq - 31;
    const int relw = q0 + 8 * wid - 31;
    float l = 0.f; float inv_l = 0.f; f32x16 oa[2];
    for (int rp_ = 0; rp_ < NSA_NREP(0); ++rp_) { l = 0.f;
    kr = *(const u32x4*)(kc + (size_t)srow * 64 + sch * 8);
    *(LAS u32x4*)(lds + srow * T_KS + sch * 16) = kr; __syncthreads();
    for (int j = 0; j < ntc; ++j) {
        const bool more = j + 1 < ntc;
        if (more) kr = *(const u32x4*)(kc + (size_t)(64 * (j + 1) + srow) * 64 + sch * 8);
        const LAS char* kt = lds + (j & 1) * T_BUF;
#pragma unroll
        for (int hh = 0; hh < 2; ++hh) {
            f32x16 s = qk32<64, T_KS>(kt + (32 * hh + r32) * T_KS + hi * 16, qf);
            const int n0 = 64 * j + 32 * hh;
            if (relw - 16 * (n0 + 31) >= 790) {
#pragma unroll
                for (int r = 0; r < 16; ++r) l += fast_exp2(s[r] + cfar);
            } else {
#pragma unroll
                for (int r = 0; r < 16; ++r) { const int rel = relq - 16 * (n0 + crow(r, hi)); l += (rel >= 0) ? fast_exp2(s[r] + lut[(rel < 1023 ? rel : 1023) * 4 + hd] - ref) : 0.f; }
            }
        }
        if (more) *(LAS u32x4*)(lds + ((j + 1) & 1) * T_BUF + srow * T_KS + sch * 16) = kr;
        __syncthreads();
    }
    l = sum32sym(l);
    inv_l = l > 0.f ? 1.f / l : 0.f;
#pragma unroll
    for (int i = 0; i < 16; ++i) { oa[0][i] = 0.f; oa[1][i] = 0.f; }
    float cprev = 0.f;
    kr = *(const u32x4*)(kc + (size_t)srow * 64 + sch * 8); vr = *(const u32x4*)(vc + (size_t)srow * 64 + sch * 8);
    { LAS char* d_ = lds + srow * T_KS + sch * 16; *(LAS u32x4*)d_ = kr; *(LAS u32x4*)(d_ + T_KB) = vr; } __syncthreads();
    for (int j = 0; j < ntc; ++j) {
        const bool more = j + 1 < ntc;
        if (more) { kr = *(const u32x4*)(kc + (size_t)(64 * (j + 1) + srow) * 64 + sch * 8); vr = *(const u32x4*)(vc + (size_t)(64 * (j + 1) + srow) * 64 + sch * 8); }
        const LAS char* kt = lds + (j & 1) * T_BUF; const LAS char* vt = kt + T_KB;
#pragma unroll
        for (int hh = 0; hh < 2; ++hh) {
            f32x16 s = qk32<64, T_KS>(kt + (32 * hh + r32) * T_KS + hi * 16, qf);
            const int n0 = 64 * j + 32 * hh;
            if (relw - 16 * (n0 + 31) >= 790) {
#pragma unroll
                for (int r = 0; r < 16; ++r) s[r] = fast_exp2(s[r] + cfar) * inv_l;
            } else {
#pragma unroll
                for (int r = 0; r < 16; ++r) { const int rel = relq - 16 * (n0 + crow(r, hi)); s[r] = (rel >= 0) ? fast_exp2(s[r] + lut[(rel < 1023 ? rel : 1023) * 4 + hd] - ref) * inv_l : 0.f; }
            }
            float gsm[4], c3[4], pc3[4];
#pragma unroll
            for (int gi = 0; gi < 4; ++gi) { float a = (s[4 * gi] + s[4 * gi + 1]) + (s[4 * gi + 2] + s[4 * gi + 3]), b = s[4 * gi + 3];
                a += sx<1>(a); a += sx<2>(a); b += sx<1>(b); b += sx<2>(b); gsm[gi] = a; c3[gi] = b; }
#pragma unroll
            for (int gi = 0; gi < 4; ++gi) pc3[gi] = sx32(c3[gi], hi);
            const int b0 = 16 * j + 8 * hh + hi;
            if (hd == 0) {
                LAS float* ip = imp + (8 * wid + ql) * 256 + b0;
                if (hi == 1) {
#pragma unroll
                    for (int gi = 0; gi < 4; ++gi) ip[2 * gi] = gsm[gi] + pc3[gi];
                } else { ip[0] = gsm[0] + cprev; ip[2] = gsm[1] + pc3[0]; ip[4] = gsm[2] + pc3[1]; ip[6] = gsm[3] + pc3[2]; }
            }
            cprev = pc3[3];
            pv32<T_KS>(oa, vt + (32 * hh) * T_KS + vlane, pack8(s, 0), pack8(s, 1));
        }
        if (more) { LAS char* d_ = lds + ((j + 1) & 1) * T_BUF + srow * T_KS + sch * 16; *(LAS u32x4*)d_ = kr; *(LAS u32x4*)(d_ + T_KB) = vr; }
        __syncthreads();
    }
    }
#pragma unroll
    for (int i = 0; i < 16; ++i) { oa[0][i] *= gc; oa[1][i] *= gc; }
    store_ot(T.ATT + (size_t)tq * 1024 + 256 + h8 * 64, oa, hi);
    for (int rp_ = 0; rp_ < NSA_NREP(1); ++rp_) {
    unsigned ones = 0xffffffffu; asm volatile("" : "+v"(ones));
    if (qblk < 16) {
        if (tid <= qblk) { bq32[2 * tid] = ones; bq32[2 * tid + 1] = ones; }
    } else {
        if (tid == 0) { bq32[0] = ones; bq32[1] = ones; bq32[2 * qblk] = ones; bq32[2 * qblk + 1] = ones; bq32[2 * qblk - 2] = ones; bq32[2 * qblk - 1] = ones; }
        unsigned kv[8][4];
#pragma unroll
        for (int q = 0; q < 8; ++q)
#pragma unroll
            for (int i = 0; i < 4; ++i) { const int b = lane + 64 * i; kv[q][i] = (b >= 1 && b <= qblk - 2) ? __float_as_uint(imp[(8 * wid + q) * 256 + b]) + 1u : 0u; }
        for (int rnd = 0; rnd < 13; ++rnd) {
#pragma unroll
            for (int q = 0; q < 8; ++q) {
                unsigned m = kv[q][0] > kv[q][1] ? kv[q][0] : kv[q][1]; { const unsigned m2 = kv[q][2] > kv[q][3] ? kv[q][2] : kv[q][3]; m = m > m2 ? m : m2; }
                { unsigned o_; o_ = sxu<1>(m); m = m > o_ ? m : o_; o_ = sxu<2>(m); m = m > o_ ? m : o_; o_ = sxu<4>(m); m = m > o_ ? m : o_; o_ = sxu<8>(m); m = m > o_ ? m : o_; o_ = sxu<16>(m); m = m > o_ ? m : o_;
                  auto rr = __builtin_amdgcn_permlane32_swap(m, m, false, false); m = rr[0] > rr[1] ? rr[0] : rr[1]; }
                const unsigned long long b0_ = __builtin_amdgcn_ballot_w64(kv[q][0] == m), b1_ = __builtin_amdgcn_ballot_w64(kv[q][1] == m), b2_ = __builtin_amdgcn_ballot_w64(kv[q][2] == m), b3_ = __builtin_amdgcn_ballot_w64(kv[q][3] == m);
                const int isel = b0_ ? 0 : b1_ ? 1 : b2_ ? 2 : 3; const unsigned long long bm = b0_ ? b0_ : b1_ ? b1_ : b2_ ? b2_ : b3_;
                const int lsel = __builtin_ctzll(bm), bsel = lsel + 64 * isel;
#pragma unroll
                for (int i = 0; i < 4; ++i) if (i == isel && lane == lsel) kv[q][i] = 0u;
                const int qi = 8 * wid + q;
                if (lane == 0) (void)__hip_atomic_fetch_or(bq32 + 2 * bsel + (qi >> 5), 1u << (qi & 31), __ATOMIC_RELAXED, __HIP_MEMORY_SCOPE_WORKGROUP);
            }
        }
    }
    }
    __syncthreads();
    {
        LAS float* slot = (LAS float*)(lds + N_IMP);
        LAS unsigned short* items = (LAS unsigned short*)(lds + N_L);
        volatile LAS int* nitems = (volatile LAS int*)(lds + N_L + 768);
        LAS unsigned* smask = (LAS unsigned*)(lds + N_L + 832);
        LAS unsigned char* npv = (LAS unsigned char*)(lds + N_L + 896);
        LAS int* part = (LAS int*)(lds + N_REF + 1024);
        if (tid < 256) { int np = 0; if (qblk >= 16 && tid >= 1 && tid <= qblk - 2) { const unsigned long long mk = ((unsigned long long)bq32[2 * tid + 1] << 32) | bq32[2 * tid]; np = (__builtin_popcountll(mk) + 7) >> 3; } npv[tid] = (unsigned char)np; }
        __syncthreads();
        if (tid < 16) { int sm = 0;
#pragma unroll
            for (int k = 0; k < 16; ++k) sm += npv[16 * tid + k]; part[tid] = sm; }
        __syncthreads();
        if (tid == 0) { int run = 0;
#pragma unroll
            for (int k = 0; k < 16; ++k) { const int v = part[k]; part[k] = run; run += v; } *nitems = run; }
        __syncthreads();
        if (tid < 256) { int st = part[tid >> 4]; for (int k = 0; k < (tid & 15); ++k) st += npv[(tid & ~15) + k]; const int np = npv[tid]; for (int pp = 0; pp < np; ++pp) items[st + pp] = (unsigned short)(tid | (pp << 8)); }
        { const int q = tid >> 3, c8 = tid & 7; const bf16_t* src = T.PROJ + (size_t)(q0 + q) * 5632 + 768 + g * 256 + c8 * 32; LAS char* dst = lds + (q * 4 + (c8 >> 1)) * N_QS + (c8 & 1) * 64;
#pragma unroll
          for (int i = 0; i < 4; ++i) *(LAS u32x4*)(dst + 16 * i) = *(const u32x4*)(src + 8 * i); }
        __syncthreads();
        const bf16_t* ksg = T.KS + (size_t)g * 256 * 4096 + lane * 8;
        const bf16_t* vtg = T.VTS + (size_t)g * 256 * 4096 + lane * 8;
        const int jslot = r32 >> 2;
        const float biasfar = lut[1023 * 4 + hd];
        float lpart = 0.f, lfull = 0.f; f32x16 os[2];
        for (int rp_ = 0; rp_ < NSA_NREP(2); ++rp_) { lpart = 0.f; lfull = 0.f;
#pragma unroll
        for (int i = 0; i < 16; ++i) { os[0][i] = 0.f; os[1][i] = 0.f; }
        bf16x8 kf[2][4], vf[2][2][2];
#define NSA_LDK(B) do { const bf16_t* p_ = ksg + (size_t)(B) * 4096; _Pragma("unroll") for (int hh = 0; hh < 2; ++hh) _Pragma("unroll") for (int d0 = 0; d0 < 4; ++d0) kf[hh][d0] = *(const bf16x8*)(p_ + (hh * 4 + d0) * 512); } while (0)
#define NSA_LDV(B) do { const bf16_t* p_ = vtg + (size_t)(B) * 4096; _Pragma("unroll") for (int hh = 0; hh < 2; ++hh) _Pragma("unroll") for (int dh = 0; dh < 2; ++dh) _Pragma("unroll") for (int s = 0; s < 2; ++s) vf[hh][dh][s] = *(const bf16x8*)(p_ + ((hh * 2 + dh) * 2 + s) * 512); } while (0)
#define NSA_SCORE(B, QF, INI, TS, OK, LS) do { \
            _Pragma("unroll") for (int hh = 0; hh < 2; ++hh) { _Pragma("unroll") for (int i = 0; i < 16; ++i) sc[hh][i] = (INI); \
                _Pragma("unroll") for (int d0 = 0; d0 < 4; ++d0) sc[hh] = mfma32(kf[hh][d0], (QF)[d0], sc[hh]); } \
            if (q0 - (64 * (B) + 63) >= 790) { _Pragma("unroll") for (int hh = 0; hh < 2; ++hh) _Pragma("unroll") for (int r = 0; r < 16; ++r) { const float p = (OK) ? fast_exp2(sc[hh][r]) : 0.f; sc[hh][r] = p; LS += p; } } \
            else { _Pragma("unroll") for (int hh = 0; hh < 2; ++hh) _Pragma("unroll") for (int r = 0; r < 16; ++r) { const int rel = (TS) - (64 * (B) + 32 * hh + crow(r, hi)); const int rc = rel < 0 ? 0 : (rel < 1023 ? rel : 1023); \
                const float p = ((OK) && rel >= 0) ? fast_exp2(sc[hh][r] + lut[rc * 4 + hd]) : 0.f; sc[hh][r] = p; LS += p; } } } while (0)
#define NSA_PV(O) do { _Pragma("unroll") for (int hh = 0; hh < 2; ++hh) { const bf16x8 p0 = pack8(sc[hh], 0), p1 = pack8(sc[hh], 1); \
            _Pragma("unroll") for (int dh = 0; dh < 2; ++dh) { (O)[dh] = mfma32(vf[hh][dh][0], p0, (O)[dh]); (O)[dh] = mfma32(vf[hh][dh][1], p1, (O)[dh]); } } } while (0)
        f32x16 sc[2];
        { const int nf = qblk < 16 ? qblk + 1 : 3;
          for (int fi = 0; fi < nf; ++fi) { const int fb = qblk < 16 ? fi : (fi == 0 ? 0 : qblk - 2 + fi);
            NSA_LDK(fb); NSA_LDV(fb);
            const float ini = ((q0 - (64 * fb + 63) >= 790) ? biasfar : 0.f) - ref;
            NSA_SCORE(fb, qf, ini, tq, true, lpart);
            NSA_PV(os); } }
        const int ni = *nitems;
        int it_b = -1, it_p = 0;
        if (wid < ni) { const int e = items[wid]; it_b = e & 255; it_p = e >> 8; NSA_LDK(it_b); NSA_LDV(it_b); }
        for (int i0 = 0; i0 < ni; i0 += 8) {
            const int inext = i0 + 8 + wid; int nb_ = -1, np_ = 0;
            if (inext < ni) { const int e = items[inext]; nb_ = e & 255; np_ = e >> 8; }
            unsigned long long msk = 0ull;
            if (it_b >= 0) {
                unsigned long long m_ = ((unsigned long long)(unsigned)rfl((int)bq32[2 * it_b + 1]) << 32) | (unsigned)rfl((int)bq32[2 * it_b]);
                for (int i_ = 0; i_ < 8 * it_p; ++i_) m_ &= m_ - 1ull;
                unsigned long long t_ = m_; for (int i_ = 0; i_ < 8; ++i_) t_ &= t_ - 1ull;
                msk = m_ & ~t_;
                int qsel = -1; { unsigned long long mm = msk;
#pragma unroll
                    for (int j = 0; j < 8; ++j) { const int qj = mm ? (int)__builtin_ctzll(mm) : -1; mm &= mm - 1ull; if (jslot == j) qsel = qj; } }
                const bool valid = qsel >= 0; const int row = (valid ? qsel : 0) * 4 + hd, ts = q0 + (valid ? qsel : 0);
                const float ini = ((q0 - (64 * it_b + 63) >= 790) ? biasfar : 0.f) - refl[row];
                bf16x8 qv[4];
#pragma unroll
                for (int d0 = 0; d0 < 4; ++d0) qv[d0] = *(const LAS bf16x8*)(lds + row * N_QS + d0 * 32 + hi * 16);
                float ls = 0.f;
                NSA_SCORE(it_b, qv, ini, ts, valid, ls);
                if (nb_ >= 0) NSA_LDK(nb_);
                f32x16 ot[2];
#pragma unroll
                for (int i = 0; i < 16; ++i) { ot[0][i] = 0.f; ot[1][i] = 0.f; }
                NSA_PV(ot);
                if (nb_ >= 0) NSA_LDV(nb_);
                ls = sum32sym(ls);
                LAS float* sp = slot + (wid * 32 + r32) * N_OSTR;
#pragma unroll
                for (int dh = 0; dh < 2; ++dh)
#pragma unroll
                    for (int r = 0; r < 16; ++r) sp[32 * dh + crow(r, hi)] = ot[dh][r];
                if (hi == 0) sp[64] = ls;
            }
            if (lane == 0) { smask[2 * wid] = (unsigned)msk; smask[2 * wid + 1] = (unsigned)(msk >> 32); }
            __syncthreads();
            const unsigned smv = smask[lane & 15];
#pragma unroll
            for (int w = 0; w < 8; ++w) {
                const unsigned long long mw = ((unsigned long long)(unsigned)__builtin_amdgcn_readlane((int)smv, 2 * w + 1) << 32) | (unsigned)__builtin_amdgcn_readlane((int)smv, 2 * w);
                unsigned mine = (unsigned)(mw >> (8 * wid)) & 0xffu;
                while (mine) { const int qo = __builtin_ctz(mine); mine &= mine - 1u;
                    const int j = __builtin_popcountll(mw & ((1ull << (8 * wid + qo)) - 1ull));
                    if (ql == qo) { const LAS float* sp = slot + (w * 32 + j * 4 + hd) * N_OSTR;
#pragma unroll
                        for (int dh = 0; dh < 2; ++dh)
#pragma unroll
                            for (int r = 0; r < 16; ++r) os[dh][r] += sp[32 * dh + crow(r, hi)];
                        lfull += sp[64]; } }
            }
            __syncthreads();
            it_b = nb_; it_p = np_;
        }
#undef NSA_LDK
#undef NSA_LDV
#undef NSA_SCORE
#undef NSA_PV
        }
        { const float f = gs / (sum32sym(lpart) + lfull);
#pragma unroll
          for (int i = 0; i < 16; ++i) { oa[0][i] = f * os[0][i]; oa[1][i] = f * os[1][i]; } }
        { const bf16_t* qp = T.PROJ + (size_t)tq * 5632 + 768 + h8 * 64 + hi * 8;
#pragma unroll
          for (int d0 = 0; d0 < 4; ++d0) qf[d0] = *(const bf16x8*)(qp + d0 * 16); }
        __syncthreads();
    }
    {
        const bf16_t* kw = T.KW + (size_t)g * 16384 * 64; const bf16_t* vw = T.PROJ + 1920 + g * 64;
        const int kt0 = qblk > 8 ? qblk - 8 : 0, ntw = qblk - kt0 + 1;
        float lw = 0.f; f32x16 ow[2];
        for (int rp_ = 0; rp_ < NSA_NREP(3); ++rp_) { lw = 0.f;
#pragma unroll
        for (int i = 0; i < 16; ++i) { ow[0][i] = 0.f; ow[1][i] = 0.f; }
        kr = *(const u32x4*)(kw + (size_t)(64 * kt0 + srow) * 64 + sch * 8); vr = *(const u32x4*)(vw + (size_t)(64 * kt0 + srow) * 5632 + sch * 8);
        { LAS char* d_ = lds + srow * T_KS + sch * 16; *(LAS u32x4*)d_ = kr; *(LAS u32x4*)(d_ + T_KB) = vr; } __syncthreads();
        for (int j = 0; j < ntw; ++j) {
            const bool more = j + 1 < ntw;
            if (more) { kr = *(const u32x4*)(kw + (size_t)(64 * (kt0 + j + 1) + srow) * 64 + sch * 8); vr = *(const u32x4*)(vw + (size_t)(64 * (kt0 + j + 1) + srow) * 5632 + sch * 8); }
            const LAS char* kt = lds + (j & 1) * T_BUF; const LAS char* vt = kt + T_KB;
            f32x16 p[2];
#pragma unroll
            for (int hh = 0; hh < 2; ++hh) { p[hh] = qk32<64, T_KS>(kt + (32 * hh + r32) * T_KS + hi * 16, qf);
#pragma unroll
                for (int r = 0; r < 16; ++r) { const int rel = tq - (64 * (kt0 + j) + 32 * hh + crow(r, hi)); const bool valid = rel >= 0 && rel < 512;
                    const float e = valid ? fast_exp2(p[hh][r] + lut[(rel < 0 ? 0 : rel) * 4 + hd] - ref) : 0.f; p[hh][r] = e; lw += e; } }
            pv32<T_KS>(ow, vt + vlane, pack8(p[0], 0), pack8(p[0], 1));
            pv32<T_KS>(ow, vt + 32 * T_KS + vlane, pack8(p[1], 0), pack8(p[1], 1));
            if (more) { LAS char* d_ = lds + ((j + 1) & 1) * T_BUF + srow * T_KS + sch * 16; *(LAS u32x4*)d_ = kr; *(LAS u32x4*)(d_ + T_KB) = vr; }
            __syncthreads();
        }
        }
        lw = sum32sym(lw);
        const float f = gw / lw;
#pragma unroll
        for (int i = 0; i < 16; ++i) { oa[0][i] += f * ow[0][i]; oa[1][i] += f * ow[1][i]; }
        { const bf16_t* ap = T.ATT + (size_t)tq * 1024 + 256 + h8 * 64;
#pragma unroll
          for (int dh = 0; dh < 2; ++dh)
#pragma unroll
              for (int g4 = 0; g4 < 4; ++g4) { const u32x2 w = *(const u32x2*)(ap + 32 * dh + 8 * g4 + 4 * hi); oa[dh][4 * g4] += bflo(w.x); oa[dh][4 * g4 + 1] += bfhi(w.x); oa[dh][4 * g4 + 2] += bflo(w.y); oa[dh][4 * g4 + 3] += bfhi(w.y); } }
        store_ot(T.ATT + (size_t)tq * 1024 + 256 + h8 * 64, oa, hi);
    }
    __syncthreads();
}
}
constexpr int S = 16384, DM = 1024, NPROJ = 5632, INC = 5560, DFF = 2816, EFF = 3584, NEXP = 8;
constexpr int NWAVES = 8;
constexpr float EPS = 1e-6f;
constexpr float QK_SCALE64 = 0.125f * LOG2E;
constexpr float QK_SCALE96 = 0.10206207261596575f * LOG2E;
#ifndef MK_MULTI
#define MK_MULTI 0
#endif
constexpr int PC_SBQ = 0, PC_SBK = 256, PC_SBV = 512, PC_NQ = 768, PC_NKC = 1280, PC_NVC = 1408, PC_NKS = 1536, PC_NVS = 1664, PC_NKW = 1792, PC_NVW = 1920,
              PC_CQ = 2048, PC_CKV = 2304, PC_KR = 2432, PC_NG = 2464, PC_GATE = 2560;
__host__ __device__ __forceinline__ int win_oldcol(int c) {
    if (c < 2048) return c; if (c < 2464) return c + 24; if (c < 2488) return 2048 + (c - 2464); if (c < 2560) return -1; return c - 72; }

constexpr size_t MiB = 1u << 20;
constexpr size_t WS_CTL = 0, CTL_ZERO_BYTES = 1 * MiB;
constexpr size_t WS_LW = 1 * MiB, LW_STRIDE = 18 * MiB;
constexpr size_t LW_WIN = 0, LW_SBO = 11 * MiB, LW_NSAO = LW_SBO + MiB / 2, LW_MLAO = LW_NSAO + MiB, LW_WOUT = LW_MLAO + MiB / 2, LW_WUQ = LW_WOUT + 2 * MiB, LW_WUKV = LW_WUQ + MiB / 4, LW_CW1 = LW_WUKV + MiB / 4;
constexpr size_t WS_DGU = 37 * MiB, WS_DDN = 48 * MiB;
constexpr size_t WS_Y = 1 * MiB;
constexpr size_t WS_H = 74 * MiB;
constexpr size_t WS_ROPE = 106 * MiB;
constexpr size_t WS_LUT8 = 108 * MiB, WS_B1P = WS_LUT8 + 256 * 1024, WS_B1 = WS_LUT8 + 512 * 1024, WS_ROUTE = 109 * MiB, WS_ROWTOK = WS_ROUTE + 512 * 1024;
constexpr size_t WS_R1 = 110 * MiB;
constexpr size_t WS_MGU = WS_R1, WS_MDN = WS_R1 + 112 * MiB;
constexpr size_t WS_R2 = 296 * MiB;
constexpr size_t R2_KC = 0, R2_VC = R2_KC + 4 * MiB + MiB / 4, R2_KS = R2_VC + 4 * MiB + MiB / 4, R2_VTS = R2_KS + 4 * MiB, R2_KW = R2_VTS + 4 * MiB, R2_GN = R2_KW + 4 * MiB,
                 R2_QM = R2_GN + 2 * MiB, R2_KM = R2_QM + 12 * MiB, R2_HID = R2_KM + 12 * MiB, R2_KCMP = R2_HID + 2 * MiB, R2_VCMP = R2_KCMP + MiB / 4, R2_ATT = R2_VCMP + MiB / 4 + MiB / 2,
                 R2_MRG = R2_ATT + 32 * MiB, R2_QRAW = R2_MRG, R2_KVRAW = R2_MRG + 16 * MiB, R2_END = R2_MRG + 32 * MiB;
static_assert(R2_END <= 136 * MiB, "attention scratch");
constexpr size_t WS_END = 432 * MiB;
constexpr int KC_ROWS = S + 32;
constexpr int CW_TMO = 0, CW_BAR = 4096, CW_MOECNT = 16384;
constexpr int RING_BYTES = 131072, LDSCTL_OFF = RING_BYTES, MISC_OFF = LDSCTL_OFF + 320, LDS_BYTES = 147456;


#define LDS_WAIT() asm volatile("s_waitcnt lgkmcnt(0)" ::: "memory")
#define VM_WAIT() asm volatile("s_waitcnt vmcnt(0)" ::: "memory")
DI float wave_sum(float v) { v += sx<1>(v); v += sx<2>(v); v += sx<4>(v); v += sx<8>(v); v += sx<16>(v); return sum32sym(v); }

struct TrSrc { const float* a; const float* b; int ldn; int nsrc; int mode; };
DI f32x4 tr_fetch4(const TrSrc& s, int k, int n) {
    const f32x4 z = {0.f, 0.f, 0.f, 0.f};
    if (s.mode == 0) return n < s.nsrc ? *(const f32x4*)(s.a + (size_t)k * s.ldn + n) : z;
    if (s.mode == 1) { const int oc = win_oldcol(n); return oc >= 0 ? *(const f32x4*)(s.a + (size_t)k * s.ldn + oc) : z; }
    const int tile = n >> 8, w = n & 255; const long d = (w < 128) ? 0l : (long)((const char*)s.b - (const char*)s.a);
    return *(const f32x4*)((const float*)((const char*)s.a + d) + (size_t)k * s.ldn + 128 * tile + (w & 127));
}
DI void tr_item(const TrSrc& s, int K, bf16_t* WT, LAS float* scr, int kb, int nb, int lane) {
    const int k0 = 64 * kb, n0 = 32 * nb, r8 = lane >> 3, n4 = (lane & 7) * 4;
    f32x4 v[8];
#pragma unroll
    for (int i = 0; i < 8; ++i) v[i] = tr_fetch4(s, k0 + r8 + 8 * i, n0 + n4);
#pragma unroll
    for (int i = 0; i < 8; ++i) { LAS float* d = scr + (r8 + 8 * i) * 33 + n4; d[0] = v[i].x; d[1] = v[i].y; d[2] = v[i].z; d[3] = v[i].w; }
    LDS_WAIT(); asm volatile("" ::: "memory");
    const int c = lane & 7;
#pragma unroll
    for (int j = 0; j < 4; ++j) { const int n = (lane >> 3) + 8 * j; const LAS float* p = scr + (8 * c) * 33 + n;
        u32x4 o; o.x = cvtpk(p[0 * 33], p[1 * 33]); o.y = cvtpk(p[2 * 33], p[3 * 33]); o.z = cvtpk(p[4 * 33], p[5 * 33]); o.w = cvtpk(p[6 * 33], p[7 * 33]);
        *(u32x4*)(WT + (size_t)(n0 + n) * K + k0 + 8 * c) = o; }
    LDS_WAIT(); asm volatile("" ::: "memory");
}
DI void tr_matrix(const TrSrc& s, int K, int ndst, bf16_t* WT, LAS float* scr, int gw, int ngw, int lane) {
    const int nblk = ndst / 32, nitems = (K / 64) * nblk;
    for (int it = gw; it < nitems; it += ngw) tr_item(s, K, WT, scr, it / nblk, it % nblk, lane);
}

struct In {
    const float *x, *bias_table, *mix_norm, *w_in, *b_gate, *sb_w_o, *nsa_q_norm, *nsa_k_norm, *nsa_cmp_pos, *nsa_cmp_w1, *nsa_cmp_w2, *nsa_w_o, *mla_q_a_norm, *mla_kv_a_norm,
        *mla_w_uq, *mla_w_ukv, *mla_q_norm, *mla_k_norm, *mla_w_o, *w_out, *ffn_norm, *dense_w_gate, *dense_w_up, *dense_w_down, *moe_router, *moe_w_gate, *moe_w_up, *moe_w_down;
};
struct Args { In in; float* out; unsigned char* ws; int ph_lo, ph_hi; };

DI void rms_row(const float* xrow, const float* gain, bf16_t* orow, int lane, f32x4 (&v)[4]) {
    const f32x4* xr = (const f32x4*)xrow + lane; float s = 0.f;
#pragma unroll
    for (int j = 0; j < 4; ++j) { v[j] = xr[64 * j]; s += (v[j].x * v[j].x + v[j].y * v[j].y) + (v[j].z * v[j].z + v[j].w * v[j].w); }
    const float rstd = 1.f / sqrtf(wave_sum(s) * (1.f / 1024.f) + EPS);
    u32x2* o8 = (u32x2*)orow + lane;
#pragma unroll
    for (int j = 0; j < 4; ++j) { const f32x4 g = ((const f32x4*)gain)[lane + 64 * j]; v[j] = v[j] * rstd * g; u32x2 w; w.x = cvtpk(v[j].x, v[j].y); w.y = cvtpk(v[j].z, v[j].w); o8[64 * j] = w; }
}

DI int t5_bucket(int n) {
    if (n < 16) return n;
    int b = 16;
    b += n >= 21; b += n >= 27; b += n >= 35; b += n >= 46; b += n >= 59; b += n >= 77; b += n >= 99; b += n >= 128; b += n >= 166; b += n >= 216; b += n >= 280; b += n >= 363; b += n >= 470; b += n >= 609; b += n >= 790;
    return b;
}

struct MoeTab { int cnt[8]; int tb[9]; };
struct MoeGU {
    const volatile LAS int* tab; const bf16_t* Hb; const bf16_t* W; const int* rowtok; int t_lo, t_hi, G, c;
    DI bool next(int i, pg8::Unit& u) const {
        const int nrt = t_hi - t_lo; if (nrt <= 0) return false;
        const long L = (long)i * G + c; if (L >= (long)nrt * 28) return false;
        const int rt = t_lo + (int)(L % nrt), pn = (int)(L / nrt);
        int e = 0;
#pragma unroll
        for (int k = 1; k < 8; ++k) e += (tab[8 + k] <= rt) ? 1 : 0;
        const int j = rt - tab[8 + e], cnt = tab[e];
        u.a = Hb; u.b = W + ((size_t)e * 7168 + 256 * pn) * 1024; u.rows = rowtok + e * S + 256 * j; u.nvalid = (cnt - 256 * j) < 256 ? (cnt - 256 * j) : 256; u.pm = rt - t_lo; u.pn = pn; return true;
    }
};
struct MoeDN {
    const volatile LAS int* tab; const bf16_t* ACT; const bf16_t* W; int t_lo, t_hi, G, c;
    DI bool next(int i, pg8::Unit& u) const {
        const int nrt = t_hi - t_lo; if (nrt <= 0) return false;
        const long L = (long)i * G + c; if (L >= (long)nrt * 4) return false;
        const int rt = t_lo + (int)(L % nrt), pn = (int)(L / nrt);
        int e = 0;
#pragma unroll
        for (int k = 1; k < 8; ++k) e += (tab[8 + k] <= rt) ? 1 : 0;
        u.a = ACT + (size_t)(rt - t_lo) * 256 * EFF; u.b = W + ((size_t)e * 1024 + 256 * pn) * EFF; u.rows = nullptr; u.nvalid = 256; u.pm = rt; u.pn = pn; return true;
    }
};
constexpr int PH_PER_LAYER = 16, NPHASES = 1 + 2 * PH_PER_LAYER;
__global__ void __launch_bounds__(NWAVES * 64, 2) fwd_kernel(Args args) {
    extern __shared__ __attribute__((aligned(16))) unsigned char lds_raw[];
    LAS unsigned char* lds = (LAS unsigned char*)lds_raw;
    volatile LAS unsigned* MISC = (volatile LAS unsigned*)(lds + MISC_OFF);
    volatile LAS int* MTAB = (volatile LAS int*)(lds + MISC_OFF + 64);
    const int tid0 = threadIdx.x, wave = __builtin_amdgcn_readfirstlane(tid0 >> 6);
    const int G = gridDim.x, bid = blockIdx.x, vcu = (G % 8 == 0) ? (bid % 8) * (G / 8) + bid / 8 : bid;
    const int gw0 = vcu * NWAVES + wave, NGW = G * NWAVES;
    unsigned char* ws = args.ws; const In in = args.in;
    gu32* ctl = (gu32*)(ws + WS_CTL);
    for (int u = tid0; u < (LDS_BYTES - LDSCTL_OFF) / 4; u += NWAVES * 64) ((LAS unsigned*)(lds + LDSCTL_OFF))[u] = 0u;
    __syncthreads();
#if MK_MULTI
#define GRID_BAR() do { } while (0)
#else
    XcdBarrier bar = xcd_barrier_post((unsigned*)(ctl + CW_BAR), MISC + 8);
#define GRID_BAR() xcd_barrier(bar)
#endif
    const int lo = args.ph_lo, hi = args.ph_hi;
#ifndef ONLY_PHASE
#define ONLY_PHASE -1
#endif
#ifndef PHMASK
#define PHMASK 0x1ffff
#endif
#define PHON(n) ((ONLY_PHASE < 0 || ONLY_PHASE == (n)) && ((PHMASK >> ((n) == 99 ? 16 : (n))) & 1))
#ifndef REPMASK
#define REPMASK 0
#endif
#ifndef GREP
#define GREP 0
#endif
#define REPN(n) (((REPMASK >> ((n) == 99 ? 16 : (n))) & 1) ? 2 : 1)
#define IN(k) (lo <= (k) && (k) < hi)
#define SEAM(k) do { if (IN((k) + 1)) GRID_BAR(); } while (0)
#define PHASE_LOCALS int tid = tid0; asm volatile("" : "+v"(tid)); const int lane = tid & 63; int gw = gw0; asm volatile("" : "+s"(gw)); unsigned char* wsl = ws; asm volatile("" : "+s"(wsl)); (void)lane; (void)gw; (void)wsl;

#define lw (wsl + WS_LW + (size_t)l * LW_STRIDE)
#define Hb ((bf16_t*)(wsl + WS_H))
#define PROJ ((bf16_t*)(wsl + WS_R1))
#define R2P(off) (wsl + WS_R2 + (off))
#define KC ((bf16_t*)R2P(R2_KC))
#define VC ((bf16_t*)R2P(R2_VC))
#define KS ((bf16_t*)R2P(R2_KS))
#define VTS ((bf16_t*)R2P(R2_VTS))
#define KW ((bf16_t*)R2P(R2_KW))
#define GN ((float*)R2P(R2_GN))
#define QM ((bf16_t*)R2P(R2_QM))
#define KM ((bf16_t*)R2P(R2_KM))
#define HID ((bf16_t*)R2P(R2_HID))
#define KCMP ((bf16_t*)R2P(R2_KCMP))
#define VCMP ((bf16_t*)R2P(R2_VCMP))
#define ATT ((bf16_t*)R2P(R2_ATT))
#define MRG ((bf16_t*)R2P(R2_MRG))
#define QRAW ((bf16_t*)R2P(R2_QRAW))
#define KVRAW ((bf16_t*)R2P(R2_KVRAW))
#define ROPE ((float*)(wsl + WS_ROPE))
#define LUT8 ((float*)(wsl + WS_LUT8))
#define B1P ((float*)(wsl + WS_B1P))
#define B1 ((float*)(wsl + WS_B1))
#define CONS (B1 + 2048)
#define ROUTE ((int*)(wsl + WS_ROUTE))
#define ROWTOK ((int*)(wsl + WS_ROWTOK))
    LAS float* scr = (LAS float*)(lds + wave * 16384);

    if (PHON(99) && IN(0)) { PHASE_LOCALS for (int rep_ = 0; rep_ < REPN(99); ++rep_) {
        for (int l = 0; l < 2; ++l) {
            tr_matrix(TrSrc{in.w_in + (size_t)l * 1024 * INC, nullptr, INC, INC, 1}, 1024, NPROJ, (bf16_t*)(lw + LW_WIN), scr, gw, NGW, lane);
            tr_matrix(TrSrc{in.sb_w_o + (size_t)l * 256 * 1024, nullptr, 1024, 1024, 0}, 256, 1024, (bf16_t*)(lw + LW_SBO), scr, gw, NGW, lane);
            tr_matrix(TrSrc{in.nsa_w_o + (size_t)l * 512 * 1024, nullptr, 1024, 1024, 0}, 512, 1024, (bf16_t*)(lw + LW_NSAO), scr, gw, NGW, lane);
            tr_matrix(TrSrc{in.mla_w_o + (size_t)l * 256 * 1024, nullptr, 1024, 1024, 0}, 256, 1024, (bf16_t*)(lw + LW_MLAO), scr, gw, NGW, lane);
            tr_matrix(TrSrc{in.w_out + (size_t)l * 1024 * 1024, nullptr, 1024, 1024, 0}, 1024, 1024, (bf16_t*)(lw + LW_WOUT), scr, gw, NGW, lane);
            tr_matrix(TrSrc{in.mla_w_uq + (size_t)l * 256 * 384, nullptr, 384, 384, 0}, 256, 512, (bf16_t*)(lw + LW_WUQ), scr, gw, NGW, lane);
            tr_matrix(TrSrc{in.mla_w_ukv + (size_t)l * 128 * 512, nullptr, 512, 512, 0}, 128, 512, (bf16_t*)(lw + LW_WUKV), scr, gw, NGW, lane);
            for (int kv = 0; kv < 2; ++kv)
                tr_matrix(TrSrc{in.nsa_cmp_w1 + (size_t)(l * 2 + kv) * 2048 * 256, nullptr, 256, 256, 0}, 2048, 256, (bf16_t*)(lw + LW_CW1) + (size_t)kv * 256 * 2048, scr, gw, NGW, lane);
        }
        tr_matrix(TrSrc{in.dense_w_gate, in.dense_w_up, DFF, DFF, 2}, 1024, 2 * DFF, (bf16_t*)(wsl + WS_DGU), scr, gw, NGW, lane);
        tr_matrix(TrSrc{in.dense_w_down, nullptr, 1024, 1024, 0}, DFF, 1024, (bf16_t*)(wsl + WS_DDN), scr, gw, NGW, lane);
        const int gt = vcu * 512 + tid, NT = G * 512;
        for (int i = gt; i < S * 16; i += NT) {
            const int pos = i >> 4, fi = i & 15; const float inv = powf(10000.f, -(float)fi / 16.f); const float ang = (float)pos * inv;
            const double rev = (double)ang * 0.15915494309189535; const float fr = (float)(rev - rint(rev));
            ROPE[i] = __builtin_amdgcn_cosf(fr); ROPE[S * 16 + i] = __builtin_amdgcn_sinf(fr); }
        for (int i = gt; i < 1024 * 8; i += NT) LUT8[i] = in.bias_table[t5_bucket(i >> 3) * 8 + (i & 7)] * LOG2E;
        if (gw == 0) {
            float bm = 0.f; for (int i = lane; i < 256; i += 64) bm = fmaxf(bm, fabsf(in.bias_table[i]));
            bm = fmaxf(bm, sx<1>(bm)); bm = fmaxf(bm, sx<2>(bm)); bm = fmaxf(bm, sx<4>(bm)); bm = fmaxf(bm, sx<8>(bm)); bm = fmaxf(bm, sx<16>(bm)); bm = fmaxf(bm, sx32(bm, lane >> 5));
            if (lane == 0) CONS[0] = bm * LOG2E;
            for (int ll = 0; ll < 2; ++ll) { float gm = 0.f; for (int i = lane; i < 192; i += 64) gm = fmaxf(gm, fabsf(in.nsa_k_norm[ll * 192 + i]));
                gm = fmaxf(gm, sx<1>(gm)); gm = fmaxf(gm, sx<2>(gm)); gm = fmaxf(gm, sx<4>(gm)); gm = fmaxf(gm, sx<8>(gm)); gm = fmaxf(gm, sx<16>(gm)); gm = fmaxf(gm, sx32(gm, lane >> 5));
                if (lane == 0) CONS[1 + ll] = gm;
                float km = 0.f; for (int i = lane; i < 96; i += 64) km = fmaxf(km, fabsf(in.mla_k_norm[ll * 96 + i]));
                km = fmaxf(km, sx<1>(km)); km = fmaxf(km, sx<2>(km)); km = fmaxf(km, sx<4>(km)); km = fmaxf(km, sx<8>(km)); km = fmaxf(km, sx<16>(km)); km = fmaxf(km, sx32(km, lane >> 5));
                if (lane == 0) CONS[3 + ll] = km; }
        }
        for (int it = gw; it < 512; it += NGW) {
            const int kc = it & 31, cb = (it >> 5) & 3, lk = it >> 7; const float* pos = in.nsa_cmp_pos + (size_t)lk * 2048; const float* w1 = in.nsa_cmp_w1 + (size_t)lk * 2048 * 256;
            float a = 0.f; for (int k = 64 * kc; k < 64 * kc + 64; ++k) a += pos[k] * w1[(size_t)k * 256 + 64 * cb + lane];
            B1P[(lk * 32 + kc) * 256 + 64 * cb + lane] = a; }
        for (int i = gt; i < 2 * 2 * 32 * 64 / 8; i += NT) { const int z = i / 256, r = i % 256; bf16_t* p = (z >> 1 ? VC : KC) + ((size_t)(z & 1) * KC_ROWS + S) * 64 + r * 8; *(u32x4*)p = (u32x4){0u, 0u, 0u, 0u}; }
            }
        SEAM(0);
    }

    for (int l = 0; l < 2; ++l) {
        const int pb = 1 + PH_PER_LAYER * l;
        const float* x_in = (l == 0) ? in.x : args.out; float* x_out = args.out;
        if (PHON(0) && IN(pb + 0)) { PHASE_LOCALS for (int rep_ = 0; rep_ < REPN(0); ++rep_) {
            for (int m = gw; m < S; m += NGW) { f32x4 v[4]; rms_row(x_in + (size_t)m * 1024, in.mix_norm + l * 1024, Hb + (size_t)m * 1024, lane, v); }
            if (l == 0 && bid == 0) for (int i = tid; i < 1024; i += 512) { float a = 0.f; for (int kc = 0; kc < 32; ++kc) a += B1P[((i >> 8) * 32 + kc) * 256 + (i & 255)]; B1[i] = a; }
            }
            SEAM(pb + 0);
        }
        if (PHON(1) && IN(pb + 1)) { PHASE_LOCALS for (int rep_ = 0; rep_ < REPN(1); ++rep_) {
            pg8::StaticOrder So; So.init(Hb, (const bf16_t*)(lw + LW_WIN), 1024, 1024, S, NPROJ, G, bid);
            pg8::EpiStore E{PROJ, NPROJ, nullptr, QK_SCALE64, 0};
            pg8::gemm_phase<pg8::EpiStore, pg8::StaticOrder, true, false>(lds, 1024, 1024, 1024, So, E);
#if GREP & 1
            pg8::gemm_phase<pg8::EpiStore, pg8::StaticOrder, true, false>(lds, 1024, 1024, 1024, So, E);
#endif
            }
            SEAM(pb + 1);
        }
        if (PHON(2) && IN(pb + 2)) { PHASE_LOCALS for (int rep_ = 0; rep_ < REPN(2); ++rep_) {
            for (int t = gw; t < S; t += NGW) {
                bf16_t* pr = PROJ + (size_t)t * NPROJ;
                {
                    const u32x4 w = *(const u32x4*)(pr + PC_NQ + lane * 8); float v[8] = {bflo(w.x), bfhi(w.x), bflo(w.y), bfhi(w.y), bflo(w.z), bfhi(w.z), bflo(w.w), bfhi(w.w)};
                    float ss = 0.f;
#pragma unroll
                    for (int e = 0; e < 8; ++e) ss += v[e] * v[e];
                    ss += sx<1>(ss); ss += sx<2>(ss); ss += sx<4>(ss);
                    const float rs = QK_SCALE64 / sqrtf(ss * (1.f / 64.f) + EPS); const float* gq = in.nsa_q_norm + l * 64 + 8 * (lane & 7);
                    u32x4 o; o.x = cvtpk(v[0] * rs * gq[0], v[1] * rs * gq[1]); o.y = cvtpk(v[2] * rs * gq[2], v[3] * rs * gq[3]); o.z = cvtpk(v[4] * rs * gq[4], v[5] * rs * gq[5]); o.w = cvtpk(v[6] * rs * gq[6], v[7] * rs * gq[7]);
                    *(u32x4*)(pr + PC_NQ + lane * 8) = o;
                }
                {
                    const int sec = lane >> 4, gg = (lane >> 3) & 1, d8 = 8 * (lane & 7);
                    const int col = (sec == 0 ? PC_NKS : sec == 1 ? PC_NKW : sec == 2 ? PC_NKC : PC_NVC) + (lane & 15) * 8;
                    const u32x4 w = *(const u32x4*)(pr + col); float v[8] = {bflo(w.x), bfhi(w.x), bflo(w.y), bfhi(w.y), bflo(w.z), bfhi(w.z), bflo(w.w), bfhi(w.w)};
                    float ss = 0.f;
#pragma unroll
                    for (int e = 0; e < 8; ++e) ss += v[e] * v[e];
                    ss += sx<1>(ss); ss += sx<2>(ss); ss += sx<4>(ss);
                    const float rs = 1.f / sqrtf(ss * (1.f / 64.f) + EPS);
                    u32x4 o = w;
                    if (sec < 2) { const float* gk = in.nsa_k_norm + (l * 3 + 1 + sec) * 64 + d8;
                        o.x = cvtpk(v[0] * rs * gk[0], v[1] * rs * gk[1]); o.y = cvtpk(v[2] * rs * gk[2], v[3] * rs * gk[3]); o.z = cvtpk(v[4] * rs * gk[4], v[5] * rs * gk[5]); o.w = cvtpk(v[6] * rs * gk[6], v[7] * rs * gk[7]); }
                    const int c8 = lane & 7; const size_t ksf = ((((size_t)(gg * 256 + (t >> 6)) * 2 + ((t >> 5) & 1)) * 4 + (c8 >> 1)) * 64 + (c8 & 1) * 32 + (t & 31)) * 8;
                    bf16_t* dst = (sec == 0 ? KS + ksf : (sec == 1 ? KW + ((size_t)gg * S + t) * 64 : sec == 2 ? KC + ((size_t)gg * KC_ROWS + t) * 64 : VC + ((size_t)gg * KC_ROWS + t) * 64) + d8);
                    *(u32x4*)dst = o;
                }
                {
                    const u32x2 w = *(const u32x2*)(pr + PC_CQ + lane * 4); float v[4] = {bflo(w.x), bfhi(w.x), bflo(w.y), bfhi(w.y)};
                    const float rs = 1.f / sqrtf(wave_sum((v[0] * v[0] + v[1] * v[1]) + (v[2] * v[2] + v[3] * v[3])) * (1.f / 256.f) + EPS); const float* ga = in.mla_q_a_norm + l * 256 + lane * 4;
                    u32x2 o; o.x = cvtpk(v[0] * rs * ga[0], v[1] * rs * ga[1]); o.y = cvtpk(v[2] * rs * ga[2], v[3] * rs * ga[3]); *(u32x2*)(pr + PC_CQ + lane * 4) = o;
                    const unsigned w2 = *(const unsigned*)(pr + PC_CKV + lane * 2); const float a = bflo(w2), b = bfhi(w2);
                    const float rs2 = 1.f / sqrtf(wave_sum(a * a + b * b) * (1.f / 128.f) + EPS); const float* gb = in.mla_kv_a_norm + l * 128 + lane * 2;
                    *(unsigned*)(pr + PC_CKV + lane * 2) = cvtpk(a * rs2 * gb[0], b * rs2 * gb[1]);
                }
                if (lane < 24) GN[(size_t)t * 24 + lane] = sigmoidf_(bf2f(pr[PC_NG + lane]));
            }
            for (int it = gw; it < 512; it += NGW) {
                const int gg = it >> 8, blk = it & 255; const bf16_t* src = PROJ + (size_t)(blk * 64) * NPROJ + PC_NVS + gg * 64 + lane; bf16_t* dstb = VTS + (size_t)(gg * 256 + blk) * 4096;
                for (int s8 = 0; s8 < 8; ++s8) { unsigned short e[8];
#pragma unroll
                    for (int j = 0; j < 8; ++j) { const int k = att::vts_key_of_slot(8 * s8 + j); e[j] = src[(size_t)k * NPROJ]; }
                    u32x4 o; o.x = e[0] | ((unsigned)e[1] << 16); o.y = e[2] | ((unsigned)e[3] << 16); o.z = e[4] | ((unsigned)e[5] << 16); o.w = e[6] | ((unsigned)e[7] << 16);
                    const int hh = s8 >> 2, ss = (s8 >> 1) & 1, h = s8 & 1;
                    *(u32x4*)(dstb + ((((hh * 2 + (lane >> 5)) * 2 + ss) * 64) + h * 32 + (lane & 31)) * 8) = o; }
            }
            }
            SEAM(pb + 2);
        }
        if (PHON(3) && IN(pb + 3)) { PHASE_LOCALS for (int rep_ = 0; rep_ < REPN(3); ++rep_) {
            for (int job = 0; job < 6; ++job) {
                pg8::StaticOrder So; pg8::EpiStore E; int lda, ldb, K;
                const bool wide = (G >= 256);
                if (job == 0) { lda = NPROJ; ldb = 256; K = 256; So.init(PROJ + PC_CQ, (const bf16_t*)(lw + LW_WUQ), lda, ldb, S, 512, wide ? 128 : G, wide ? (bid < 128 ? bid : -1) : bid); E = pg8::EpiStore{QRAW, 512, nullptr, 1.f, 0}; }
                else if (job == 1) { lda = NPROJ; ldb = 128; K = 128; So.init(PROJ + PC_CKV, (const bf16_t*)(lw + LW_WUKV), lda, ldb, S, 512, wide ? 128 : G, wide ? (bid >= 128 && bid < 256 ? bid - 128 : -1) : bid); E = pg8::EpiStore{KVRAW, 512, nullptr, 1.f, 0}; }
                else { const int z = job - 2, kv = z >> 1, gg = z & 1; lda = 1024; ldb = 2048; K = 2048;
                    So.init((kv ? VC : KC) + (size_t)gg * KC_ROWS * 64, (const bf16_t*)(lw + LW_CW1) + (size_t)kv * 256 * 2048, lda, ldb, 1024, 256, wide ? 4 : G, wide ? ((bid >= 32 * z && bid < 32 * z + 4) ? bid - 32 * z : -1) : bid);
                    E = pg8::EpiStore{HID + (size_t)z * 1024 * 256, 256, B1 + (l * 2 + kv) * 256, 1.f, 1}; }
                pg8::gemm_phase<pg8::EpiStore, pg8::StaticOrder, true, false>(lds, lda, ldb, K, So, E);
#if GREP & 16
                pg8::gemm_phase<pg8::EpiStore, pg8::StaticOrder, true, false>(lds, lda, ldb, K, So, E);
#endif
            }
            }
            SEAM(pb + 3);
        }
        if (PHON(4) && IN(pb + 4)) { PHASE_LOCALS for (int rep_ = 0; rep_ < REPN(4); ++rep_) {
            for (int t = gw; t < S; t += NGW) {
                const int hd = lane >> 4, i = lane & 15; const float c = ROPE[t * 16 + i], s = ROPE[S * 16 + t * 16 + i];
                {   const bf16_t* src = QRAW + (size_t)t * 512 + hd * 96 + i; float v[6]; float ss = 0.f;
#pragma unroll
                    for (int e = 0; e < 6; ++e) { v[e] = bf2f(src[16 * e]); ss += v[e] * v[e]; }
                    ss += sx<1>(ss); ss += sx<2>(ss); ss += sx<4>(ss); ss += sx<8>(ss);
                    const float rs = 1.f / sqrtf(ss * (1.f / 96.f) + EPS); const float* gq = in.mla_q_norm + l * 96 + i;
#pragma unroll
                    for (int e = 0; e < 6; ++e) v[e] = v[e] * rs * gq[16 * e];
                    const float x1 = v[4], x2 = v[5]; v[4] = x1 * c - x2 * s; v[5] = x2 * c + x1 * s;
                    bf16_t* dst = QM + (size_t)t * 384 + hd * 96 + i;
#pragma unroll
                    for (int e = 0; e < 6; ++e) dst[16 * e] = f2bf(v[e] * QK_SCALE96); }
                {   const bf16_t* src = KVRAW + (size_t)t * 512 + hd * 128 + i; const bf16_t* kr = PROJ + (size_t)t * NPROJ + PC_KR + i; float v[6]; float ss = 0.f;
#pragma unroll
                    for (int e = 0; e < 4; ++e) v[e] = bf2f(src[16 * e]);
                    v[4] = bf2f(kr[0]); v[5] = bf2f(kr[16]);
#pragma unroll
                    for (int e = 0; e < 6; ++e) ss += v[e] * v[e];
                    ss += sx<1>(ss); ss += sx<2>(ss); ss += sx<4>(ss); ss += sx<8>(ss);
                    const float rs = 1.f / sqrtf(ss * (1.f / 96.f) + EPS); const float* gk = in.mla_k_norm + l * 96 + i;
#pragma unroll
                    for (int e = 0; e < 6; ++e) v[e] = v[e] * rs * gk[16 * e];
                    const float x1 = v[4], x2 = v[5]; v[4] = x1 * c - x2 * s; v[5] = x2 * c + x1 * s;
                    bf16_t* dst = KM + (size_t)t * 384 + hd * 96 + i;
#pragma unroll
                    for (int e = 0; e < 6; ++e) dst[16 * e] = f2bf(v[e]); }
            }
            for (int it = gw; it < 4096; it += NGW) {
                const int z = it >> 10, n = it & 1023, kv = z >> 1, gg = z & 1; const bf16_t* hrow = HID + ((size_t)z * 1024 + n) * 256; const float* w2 = in.nsa_cmp_w2 + (size_t)(l * 2 + kv) * 256 * 64;
                { const u32x2 w = *(const u32x2*)(hrow + lane * 4); scr[lane * 4] = bflo(w.x); scr[lane * 4 + 1] = bfhi(w.x); scr[lane * 4 + 2] = bflo(w.y); scr[lane * 4 + 3] = bfhi(w.y); }
                LDS_WAIT(); asm volatile("" ::: "memory");
                float a = 0.f;
#pragma unroll 8
                for (int j = 0; j < 256; ++j) a += scr[j] * w2[j * 64 + lane];
                if (kv == 0) { const float rs = 1.f / sqrtf(wave_sum(a * a) * (1.f / 64.f) + EPS); KCMP[((size_t)gg * 1024 + n) * 64 + lane] = f2bf(a * rs * in.nsa_k_norm[(l * 3) * 64 + lane]); }
                else VCMP[((size_t)gg * 1024 + n) * 64 + lane] = f2bf(a);
                LDS_WAIT(); asm volatile("" ::: "memory");
            }
            }
            SEAM(pb + 4);
        }
        if (PHON(5) && IN(pb + 5)) { PHASE_LOCALS for (int rep_ = 0; rep_ < REPN(5); ++rep_) {
            __syncthreads();
            for (int r2_ = 0; r2_ < REPN(17); ++r2_) for (int u = vcu; u < 256; u += G) att::sb_unit((LAS char*)lds, PROJ, ATT, u >> 6, u & 63);
            for (int r2_ = 0; r2_ < REPN(18); ++r2_) for (int p = vcu; p < 256; p += G) { const float mkb = 9.9f * CONS[3 + l]; att::mla_unit((LAS char*)lds, QM, KM, KVRAW, ATT, p >> 6, 127 - (p & 63), mkb); att::mla_unit((LAS char*)lds, QM, KM, KVRAW, ATT, p >> 6, p & 63, mkb); }
            att::NsaT T{PROJ, KCMP, VCMP, KS, VTS, KW, GN, LUT8, ATT, 8.08f * CONS[1 + l], CONS[0]};
            for (int r2_ = 0; r2_ < REPN(19); ++r2_) for (int p = vcu; p < 256; p += G) { att::nsa_unit((LAS char*)lds, T, p >> 7, 255 - (p & 127)); att::nsa_unit((LAS char*)lds, T, p >> 7, p & 127); }
            }
            SEAM(pb + 5);
        }
        if (PHON(6) && IN(pb + 6)) { PHASE_LOCALS for (int rep_ = 0; rep_ < REPN(6); ++rep_) {
            for (int mix = 0; mix < 3; ++mix) {
                const int K = (mix == 1) ? 512 : 256; const int acol = (mix == 0) ? 0 : (mix == 1) ? 256 : 768;
                const bf16_t* Bt = (const bf16_t*)(lw + (mix == 0 ? LW_SBO : mix == 1 ? LW_NSAO : LW_MLAO));
                pg8::StaticOrder So; So.init(ATT + acol, Bt, 1024, K, S, 1024, G, bid);
                pg8::EpiGate E{MRG, PROJ + PC_GATE + mix * 1024, NPROJ, in.b_gate + l * 3072 + mix * 1024, mix == 0 ? 1 : 0};
                pg8::gemm_phase<pg8::EpiGate, pg8::StaticOrder, true, false>(lds, 1024, K, K, So, E);
            }
            }
            SEAM(pb + 6);
        }
        if (PHON(7) && IN(pb + 7)) { PHASE_LOCALS for (int rep_ = 0; rep_ < REPN(7); ++rep_) {
            pg8::StaticOrder So; So.init(MRG, (const bf16_t*)(lw + LW_WOUT), 1024, 1024, S, 1024, G, bid);
            pg8::EpiResid E{x_in, x_out};
            pg8::gemm_phase<pg8::EpiResid, pg8::StaticOrder, true, false>(lds, 1024, 1024, 1024, So, E);
            }
            SEAM(pb + 7);
        }
        if (PHON(8) && IN(pb + 8)) { PHASE_LOCALS for (int rep_ = 0; rep_ < REPN(8); ++rep_) {
            if (l == 1) {
                for (int it = gw; it < 8 * 3584; it += NGW) { const int e = it / 3584, r = it % 3584;
                    tr_item(TrSrc{in.moe_w_gate + (size_t)e * 1024 * EFF, in.moe_w_up + (size_t)e * 1024 * EFF, EFF, EFF, 2}, 1024, (bf16_t*)(wsl + WS_MGU) + (size_t)e * 7168 * 1024, scr, r / 224, r % 224, lane); }
                for (int it = gw; it < 8 * 1792; it += NGW) { const int e = it / 1792, r = it % 1792;
                    tr_item(TrSrc{in.moe_w_down + (size_t)e * EFF * 1024, nullptr, 1024, 1024, 0}, EFF, (bf16_t*)(wsl + WS_MDN) + (size_t)e * 1024 * EFF, scr, r / 32, r % 32, lane); }
            }
            for (int m = gw; m < S; m += NGW) {
                f32x4 v[4]; rms_row(x_out + (size_t)m * 1024, in.ffn_norm + l * 1024, Hb + (size_t)m * 1024, lane, v);
                if (l == 1) {
                    float lg[8];
#pragma unroll
                    for (int e = 0; e < 8; ++e) lg[e] = 0.f;
#pragma unroll
                    for (int j = 0; j < 4; ++j)
#pragma unroll
                        for (int q = 0; q < 4; ++q) { const float* wr = in.moe_router + (size_t)(4 * lane + 256 * j + q) * 8; const f32x4 wa = *(const f32x4*)wr, wb = *(const f32x4*)(wr + 4); const float hv = v[j][q];
                            lg[0] += hv * wa.x; lg[1] += hv * wa.y; lg[2] += hv * wa.z; lg[3] += hv * wa.w; lg[4] += hv * wb.x; lg[5] += hv * wb.y; lg[6] += hv * wb.z; lg[7] += hv * wb.w; }
#pragma unroll
                    for (int e = 0; e < 8; ++e) lg[e] = wave_sum(lg[e]);
                    int e0 = 0; float v0 = lg[0];
#pragma unroll
                    for (int e = 1; e < 8; ++e) if (lg[e] > v0) { v0 = lg[e]; e0 = e; }
                    int e1 = -1; float v1 = -INFINITY;
#pragma unroll
                    for (int e = 0; e < 8; ++e) if (e != e0 && lg[e] > v1) { v1 = lg[e]; e1 = e; }
                    if (lane == 0) { const float w0 = 1.f / (1.f + __expf(v1 - v0)), w1 = 1.f - w0;
                        const int p0 = (int)__hip_atomic_fetch_add(ctl + CW_MOECNT + 64 * e0, 1u, RLX_AGENT), p1 = (int)__hip_atomic_fetch_add(ctl + CW_MOECNT + 64 * e1, 1u, RLX_AGENT);
                        ROWTOK[e0 * S + p0] = m; ROWTOK[e1 * S + p1] = m;
                        int* r = ROUTE + (size_t)m * 8; r[0] = e0; r[1] = e1; r[2] = p0; r[3] = p1; r[4] = __float_as_int(w0); r[5] = __float_as_int(w1); }
                }
            }
            }
            SEAM(pb + 8);
        }
        if (l == 0) {
#define ACT0 ((bf16_t*)(wsl + WS_R1))
            if (PHON(9) && IN(pb + 9)) { PHASE_LOCALS for (int rep_ = 0; rep_ < REPN(9); ++rep_) {
                pg8::StaticOrder So; So.init(Hb, (const bf16_t*)(wsl + WS_DGU), 1024, 1024, S, 2 * DFF, G, bid);
                pg8::EpiSwiglu E{ACT0, DFF};
                pg8::gemm_phase<pg8::EpiSwiglu, pg8::StaticOrder, true, false>(lds, 1024, 1024, 1024, So, E);
#if GREP & 2
                pg8::gemm_phase<pg8::EpiSwiglu, pg8::StaticOrder, true, false>(lds, 1024, 1024, 1024, So, E);
#endif
            }
                SEAM(pb + 9);
            }
            if (PHON(10) && IN(pb + 10)) { PHASE_LOCALS for (int rep_ = 0; rep_ < REPN(10); ++rep_) {
                pg8::StaticOrder So; So.init(ACT0, (const bf16_t*)(wsl + WS_DDN), DFF, DFF, S, 1024, G, bid);
                pg8::EpiResid E{x_out, x_out};
                pg8::gemm_phase<pg8::EpiResid, pg8::StaticOrder, true, false>(lds, DFF, DFF, DFF, So, E);
            }
                SEAM(pb + 10);
            }
        } else {
#define ACT1 ((bf16_t*)(wsl + WS_R2))
#define YB ((bf16_t*)(wsl + WS_Y))
            for (int ps = 0; ps < 3; ++ps) {
                if (PHON(11) && IN(pb + 9 + 2 * ps)) { PHASE_LOCALS for (int rep_ = 0; rep_ < REPN(11); ++rep_) {
                    if (tid == 0) { int tb = 0; for (int e = 0; e < 8; ++e) { const int c = (int)__hip_atomic_load(ctl + CW_MOECNT + 64 * e, RLX_AGENT); MTAB[e] = c; MTAB[8 + e] = tb; tb += (c + 255) >> 8; } MTAB[16] = tb; }
                    __syncthreads();
                    const int T = MTAB[16], tlo = 64 * ps, thi = T < tlo + 64 ? T : tlo + 64;
                    MoeGU So{MTAB, Hb, (const bf16_t*)(wsl + WS_MGU), ROWTOK, tlo, thi, G, bid};
                    pg8::EpiSwiglu E{ACT1, EFF};
                    pg8::gemm_phase<pg8::EpiSwiglu, MoeGU, true, true>(lds, 1024, 1024, 1024, So, E);
#if GREP & 4
                    pg8::gemm_phase<pg8::EpiSwiglu, MoeGU, true, true>(lds, 1024, 1024, 1024, So, E);
#endif
            }
                    SEAM(pb + 9 + 2 * ps);
                }
                if (PHON(12) && IN(pb + 10 + 2 * ps)) { PHASE_LOCALS for (int rep_ = 0; rep_ < REPN(12); ++rep_) {
                    if (tid == 0) { int tb = 0; for (int e = 0; e < 8; ++e) { const int c = (int)__hip_atomic_load(ctl + CW_MOECNT + 64 * e, RLX_AGENT); MTAB[e] = c; MTAB[8 + e] = tb; tb += (c + 255) >> 8; } MTAB[16] = tb; }
                    __syncthreads();
                    const int T = MTAB[16], tlo = 64 * ps, thi = T < tlo + 64 ? T : tlo + 64;
                    MoeDN So{MTAB, ACT1, (const bf16_t*)(wsl + WS_MDN), tlo, thi, G, bid};
                    pg8::EpiStore E{YB, 1024, nullptr, 1.f, 0};
                    pg8::gemm_phase<pg8::EpiStore, MoeDN, true, false>(lds, EFF, EFF, EFF, So, E);
#if GREP & 8
                    pg8::gemm_phase<pg8::EpiStore, MoeDN, true, false>(lds, EFF, EFF, EFF, So, E);
#endif
            }
                    SEAM(pb + 10 + 2 * ps);
                }
            }
            if (PHON(15) && IN(pb + 15)) { PHASE_LOCALS for (int rep_ = 0; rep_ < REPN(15); ++rep_) {
                if (tid == 0) { int tb = 0; for (int e = 0; e < 8; ++e) { const int c = (int)__hip_atomic_load(ctl + CW_MOECNT + 64 * e, RLX_AGENT); MTAB[e] = c; MTAB[8 + e] = tb; tb += (c + 255) >> 8; } MTAB[16] = tb; }
                __syncthreads();
                for (int m = gw; m < S; m += NGW) {
                    const int* r = ROUTE + (size_t)m * 8; const int e0 = r[0], e1 = r[1]; const float w0 = __int_as_float(r[4]), w1 = __int_as_float(r[5]);
                    const bf16_t* y0 = YB + ((size_t)MTAB[8 + e0] * 256 + r[2]) * 1024; const bf16_t* y1 = YB + ((size_t)MTAB[8 + e1] * 256 + r[3]) * 1024;
                    float* xo = x_out + (size_t)m * 1024;
#pragma unroll
                    for (int j = 0; j < 4; ++j) { const int c = 4 * lane + 256 * j; f32x4 xv = *(const f32x4*)(xo + c); const u32x2 a = *(const u32x2*)(y0 + c), b = *(const u32x2*)(y1 + c);
                        xv.x += w0 * bflo(a.x) + w1 * bflo(b.x); xv.y += w0 * bfhi(a.x) + w1 * bfhi(b.x); xv.z += w0 * bflo(a.y) + w1 * bflo(b.y); xv.w += w0 * bfhi(a.y) + w1 * bfhi(b.y);
                        *(f32x4*)(xo + c) = xv; }
                }
            }
                if (l == 0) SEAM(pb + 15);
            }
        }
    }
#undef IN
#undef SEAM
}

extern "C" void kernel_launch(void* const* d_in, const int* in_sizes, int n_in, void* d_out, int out_size, void* d_ws, size_t ws_size, hipStream_t stream) {
    static int grid = 0;
    if (grid == 0) {
        if (n_in != 28 || in_sizes[0] != S * DM || out_size != S * DM || ws_size < WS_END) { fprintf(stderr, "kernel_launch: unexpected problem (n_in %d, in0 %d, out %d, ws %zu < %zu); nothing launched\n", n_in, n_in > 0 ? in_sizes[0] : -1, out_size, ws_size, (size_t)WS_END); grid = -1; return; }
        int dev = 0, cus = 0, per_cu = 0;
        if (hipGetDevice(&dev) != hipSuccess || hipDeviceGetAttribute(&cus, hipDeviceAttributeMultiprocessorCount, dev) != hipSuccess) { grid = -1; return; }
        if (hipFuncSetAttribute((const void*)fwd_kernel, hipFuncAttributeMaxDynamicSharedMemorySize, LDS_BYTES) != hipSuccess) { fprintf(stderr, "kernel_launch: hipFuncSetAttribute failed\n"); grid = -1; return; }
        if (hipOccupancyMaxActiveBlocksPerMultiprocessor(&per_cu, (const void*)fwd_kernel, NWAVES * 64, LDS_BYTES) != hipSuccess || per_cu < 1) { fprintf(stderr, "kernel_launch: occupancy query reports %d blocks per CU\n", per_cu); (void)hipGetLastError(); }
        grid = cus;
    }
    if (grid < 0) return;
    if (hipMemsetAsync((char*)d_ws + WS_CTL, 0, CTL_ZERO_BYTES, stream) != hipSuccess) return;
    Args a{};
    const float** ip = (const float**)&a.in;
    for (int i = 0; i < 28; ++i) ip[i] = (const float*)d_in[i];
    a.out = (float*)d_out; a.ws = (unsigned char*)d_ws;
#if MK_MULTI
    for (int ph = 0; ph < NPHASES; ++ph) {
        if (ph >= 1 + 11 && ph < 1 + PH_PER_LAYER) continue;
        a.ph_lo = ph; a.ph_hi = ph + 1;
        hipLaunchKernelGGL(fwd_kernel, dim3(grid), dim3(NWAVES * 64), LDS_BYTES, stream, a);
    }
#else
    a.ph_lo = 0; a.ph_hi = NPHASES;
    hipLaunchKernelGGL(fwd_kernel, dim3(grid), dim3(NWAVES * 64), LDS_BYTES, stream, a);
#endif
    const hipError_t le = hipPeekAtLastError();
    if (le != hipSuccess) fprintf(stderr, "kernel_launch: launch failed: %s\n", hipGetErrorName(le));
}
```

```cpp
#include <hip/hip_runtime.h>
#include <cstdio>
#include <cstdint>
#include <cmath>

#define LAS __attribute__((address_space(3)))
#define GAS __attribute__((address_space(1)))
typedef unsigned short bf16_t;
typedef short bf16x8 __attribute__((ext_vector_type(8)));
typedef short s16x4 __attribute__((ext_vector_type(4)));
typedef float f32x2 __attribute__((ext_vector_type(2)));
typedef float f32x4 __attribute__((ext_vector_type(4)));
typedef float f32x16 __attribute__((ext_vector_type(16)));
typedef unsigned u32x2 __attribute__((ext_vector_type(2)));
typedef unsigned u32x4 __attribute__((ext_vector_type(4)));
typedef __bf16 bf16x2_t __attribute__((ext_vector_type(2)));
typedef GAS unsigned gu32;
#define RLX_AGENT __ATOMIC_RELAXED, __HIP_MEMORY_SCOPE_AGENT
#define DI __device__ __forceinline__

DI unsigned cvtpk(float lo, float hi) { f32x2 v = {lo, hi}; bf16x2_t b = __builtin_convertvector(v, bf16x2_t); return __builtin_bit_cast(unsigned, b); }
DI float bf2f(bf16_t b) { return __uint_as_float(((unsigned)b) << 16); }
DI float bflo(unsigned w) { return __uint_as_float(w << 16); }
DI float bfhi(unsigned w) { return __uint_as_float(w & 0xffff0000u); }
DI bf16_t f2bf(float f) { return (bf16_t)(cvtpk(f, 0.f) & 0xffffu); }
DI float fast_exp2(float x) { return __builtin_amdgcn_exp2f(x); }
DI float fast_log2(float x) { return __builtin_amdgcn_logf(x); }
DI float fast_rcp(float x) { return __builtin_amdgcn_rcpf(x); }
constexpr float LOG2E = 1.4426950408889634f;
DI float sigmoidf_(float x) { return fast_rcp(1.f + fast_exp2(-x * LOG2E)); }
DI float siluf_(float x) { return x * sigmoidf_(x); }
template <int K> DI unsigned sxu(unsigned v) { return (unsigned)__builtin_amdgcn_ds_swizzle((int)v, (K << 10) | 0x1f); }
template <int K> DI float sx(float v) { return __uint_as_float(sxu<K>(__float_as_uint(v))); }
DI unsigned sx32u(unsigned v, int hi) { auto rr = __builtin_amdgcn_permlane32_swap(v, v, false, false); return hi ? rr[0] : rr[1]; }
DI float sx32(float v, int hi) { return __uint_as_float(sx32u(__float_as_uint(v), hi)); }
DI float sum32sym(float v) { auto rr = __builtin_amdgcn_permlane32_swap(__float_as_uint(v), __float_as_uint(v), false, false); return __uint_as_float(rr[0]) + __uint_as_float(rr[1]); }

#ifndef TPROBE
#define TPROBE 0
#endif
DI int lane_id() { int l_; asm volatile("v_mbcnt_lo_u32_b32 %0, -1, 0\n\tv_mbcnt_hi_u32_b32 %0, -1, %0" : "=v"(l_)); return l_; }
DI unsigned long long tp_now() { return __builtin_amdgcn_s_memrealtime(); }
#define TP_BEGIN(id) unsigned long long tp_t0_ = 0; if (TPROBE == (id)) tp_t0_ = tp_now();
#define TP_END(id, ctr) do { if (TPROBE == (id)) { const unsigned long long d_ = tp_now() - tp_t0_; if (lane_id() == 0) atomicAdd((unsigned long long*)(ctr), d_); } } while (0)

namespace pg8 {
constexpr int BM = 256, BK = 64, HALF = 128, HTB = HALF * BK * 2, STAGE_BYTES = 8 * HTB, NXCD = 8, WGM = 8;
__host__ __device__ __forceinline__ int lds_byte(int r, int c) { const int st = (r >> 4) * 2 + (c >> 5), rr = r & 15, cc = c & 31, ob = rr * 64 + cc * 2; return st * 1024 + (ob ^ (((ob >> 9) & 1) << 5)); }
__host__ __device__ __forceinline__ void stage_rc(int b, int& R, int& C) { const int st = b / 1024, sb = b % 1024, swz = sb ^ (((sb >> 9) & 1) << 5); R = (st >> 1) * 16 + swz / 64; C = (st & 1) * 32 + (swz % 64) / 2; }
__host__ __device__ __forceinline__ int perm32(int rho) { const int n = rho >> 4, i = rho & 15; return 8 * (i >> 2) + 4 * n + (i & 3); }

struct Unit { const bf16_t* a; const bf16_t* b; const int* rows; int nvalid, pm, pn; };

struct StaticOrder {
    const bf16_t* A; const bf16_t* Bt; int lda, ldb, nM, nN, nwg, G, c;
    DI void init(const bf16_t* A_, const bf16_t* Bt_, int lda_, int ldb_, int M, int N, int G_, int c_) { A = A_; Bt = Bt_; lda = lda_; ldb = ldb_; nM = M / BM; nN = N / BM; nwg = nM * nN; G = G_; c = c_; }
    DI bool next(int i, Unit& u) const {
        if (c < 0 || c >= G) return false;
        const long L = (long)i * G + c; if (L >= nwg) return false;
        int wgid = (int)L; { const int q = nwg / NXCD, r = nwg % NXCD, xcd = wgid % NXCD, off = wgid / NXCD; wgid = (xcd < r ? xcd * (q + 1) : r * (q + 1) + (xcd - r) * q) + off; }
        const int nig = WGM * nN, gid = wgid / nig, fm = gid * WGM, gsz = (nM - fm) < WGM ? (nM - fm) : WGM;
        u.pm = fm + ((wgid % nig) % gsz); u.pn = (wgid % nig) / gsz;
        u.a = A + (size_t)u.pm * BM * lda; u.b = Bt + (size_t)u.pn * BM * ldb; u.rows = nullptr; u.nvalid = BM; return true;
    }
};

struct EpiStore {
    static constexpr bool PERM = true;
    bf16_t* O; int ldc; const float* bias; float scale0; int act;
    DI void operator()(const f32x4 (&acc)[2][2][4][2], const Unit& u, int wr, int wc, int fr, int fq) const {
        const int row0 = u.pm * BM + wr * 64 + fr, col0 = u.pn * BM + wc * 32 + 8 * fq;
        const float sc = (u.pn == 0) ? scale0 : 1.f;
        f32x4 bv[2][2];
#pragma unroll
        for (int bj = 0; bj < 2; ++bj)
#pragma unroll
            for (int n = 0; n < 2; ++n) bv[bj][n] = bias ? *(const f32x4*)(bias + col0 + bj * HALF + 4 * n) : (f32x4){0.f, 0.f, 0.f, 0.f};
#pragma unroll
        for (int ai = 0; ai < 2; ++ai)
#pragma unroll
            for (int m = 0; m < 4; ++m) { bf16_t* rowp = O + (size_t)(row0 + ai * HALF + m * 16) * ldc + col0;
#pragma unroll
                for (int bj = 0; bj < 2; ++bj) { f32x4 v0 = (acc[ai][bj][m][0] + bv[bj][0]) * sc, v1 = (acc[ai][bj][m][1] + bv[bj][1]) * sc;
                    if (act) {
#pragma unroll
                        for (int e = 0; e < 4; ++e) { v0[e] = siluf_(v0[e]); v1[e] = siluf_(v1[e]); } }
                    u32x4 w; w.x = cvtpk(v0[0], v0[1]); w.y = cvtpk(v0[2], v0[3]); w.z = cvtpk(v1[0], v1[1]); w.w = cvtpk(v1[2], v1[3]);
                    *(u32x4*)(rowp + bj * HALF) = w; } }
    }
};
struct EpiGate {
    static constexpr bool PERM = true;
    bf16_t* Mg; const bf16_t* glog; int ldg; const float* bg; int first;
    DI void operator()(const f32x4 (&acc)[2][2][4][2], const Unit& u, int wr, int wc, int fr, int fq) const {
        const int row0 = u.pm * BM + wr * 64 + fr, col0 = u.pn * BM + wc * 32 + 8 * fq;
        f32x4 bv[2][2];
#pragma unroll
        for (int bj = 0; bj < 2; ++bj)
#pragma unroll
            for (int n = 0; n < 2; ++n) bv[bj][n] = *(const f32x4*)(bg + col0 + bj * HALF + 4 * n);
#pragma unroll
        for (int ai = 0; ai < 2; ++ai)
#pragma unroll
            for (int m = 0; m < 4; ++m) { const size_t row = (size_t)(row0 + ai * HALF + m * 16);
#pragma unroll
                for (int bj = 0; bj < 2; ++bj) { const int col = col0 + bj * HALF;
                    const u32x4 gl = *(const u32x4*)(glog + row * ldg + col);
                    u32x4 old = (u32x4){0u, 0u, 0u, 0u}; if (!first) old = *(const u32x4*)(Mg + row * 1024 + col);
                    float g[8] = {bflo(gl.x), bfhi(gl.x), bflo(gl.y), bfhi(gl.y), bflo(gl.z), bfhi(gl.z), bflo(gl.w), bfhi(gl.w)};
                    float o[8] = {bflo(old.x), bfhi(old.x), bflo(old.y), bfhi(old.y), bflo(old.z), bfhi(old.z), bflo(old.w), bfhi(old.w)};
#pragma unroll
                    for (int e = 0; e < 4; ++e) { o[e] += sigmoidf_(g[e] + bv[bj][0][e]) * acc[ai][bj][m][0][e]; o[4 + e] += sigmoidf_(g[4 + e] + bv[bj][1][e]) * acc[ai][bj][m][1][e]; }
                    u32x4 w; w.x = cvtpk(o[0], o[1]); w.y = cvtpk(o[2], o[3]); w.z = cvtpk(o[4], o[5]); w.w = cvtpk(o[6], o[7]);
                    *(u32x4*)(Mg + row * 1024 + col) = w; } }
    }
};
struct EpiResid {
    static constexpr bool PERM = false;
    const float* xin; float* out;
    DI void operator()(const f32x4 (&acc)[2][2][4][2], const Unit& u, int wr, int wc, int fr, int fq) const {
        const int row0 = u.pm * BM + wr * 64 + fr, col0 = u.pn * BM + wc * 32 + 4 * fq;
#pragma unroll
        for (int ai = 0; ai < 2; ++ai)
#pragma unroll
            for (int m = 0; m < 4; ++m) { const size_t off = (size_t)(row0 + ai * HALF + m * 16) * 1024 + col0;
#pragma unroll
                for (int bj = 0; bj < 2; ++bj)
#pragma unroll
                    for (int n = 0; n < 2; ++n) { const f32x4 b = *(const f32x4*)(xin + off + bj * HALF + n * 16); *(f32x4*)(out + off + bj * HALF + n * 16) = b + acc[ai][bj][m][n]; }
                if (m & 1) asm volatile("" ::: "memory"); }
    }
};
struct EpiF32 {
    static constexpr bool PERM = false;
    float* O; int ldc;
    DI void operator()(const f32x4 (&acc)[2][2][4][2], const Unit& u, int wr, int wc, int fr_in, int fq_in) const {
        int fr = fr_in, fq = fq_in; asm volatile("" : "+v"(fr), "+v"(fq));
        const int row0 = u.pm * BM + wr * 64 + fr, col0 = u.pn * BM + wc * 32 + 4 * fq;
#pragma unroll
        for (int ai = 0; ai < 2; ++ai)
#pragma unroll
            for (int m = 0; m < 4; ++m) { float* rowp = O + (size_t)(row0 + ai * HALF + m * 16) * ldc + col0;
#pragma unroll
                for (int bj = 0; bj < 2; ++bj)
#pragma unroll
                    for (int n = 0; n < 2; ++n) *(f32x4*)(rowp + bj * HALF + n * 16) = acc[ai][bj][m][n]; }
    }
};
struct EpiSwiglu {
    static constexpr bool PERM = true;
    bf16_t* act; int ldact;
    DI void operator()(const f32x4 (&acc)[2][2][4][2], const Unit& u, int wr, int wc, int fr, int fq) const {
        const int row0 = u.pm * BM + wr * 64 + fr, col0 = u.pn * HALF + wc * 32 + 8 * fq;
#pragma unroll
        for (int ai = 0; ai < 2; ++ai)
#pragma unroll
            for (int m = 0; m < 4; ++m) { bf16_t* rowp = act + (size_t)(row0 + ai * HALF + m * 16) * ldact + col0;
                float o[8];
#pragma unroll
                for (int e = 0; e < 4; ++e) { o[e] = siluf_(acc[ai][0][m][0][e]) * acc[ai][1][m][0][e]; o[4 + e] = siluf_(acc[ai][0][m][1][e]) * acc[ai][1][m][1][e]; }
                u32x4 w; w.x = cvtpk(o[0], o[1]); w.y = cvtpk(o[2], o[3]); w.z = cvtpk(o[4], o[5]); w.w = cvtpk(o[6], o[7]);
                *(u32x4*)rowp = w; }
    }
};

template <class Epi, class Sched, bool ALIGN_EPI, bool GATHER>
__device__ __forceinline__ void gemm_phase(LAS unsigned char* lds, const int lda, const int ldb, const int K, const Sched& S, const Epi& E, const int wave_id) {
    int tid_l = wave_id * 64 + lane_id(); asm volatile("" : "+v"(tid_l));
    const int tid = tid_l, wid = __builtin_amdgcn_readfirstlane(tid >> 6), lane = tid & 63, wr = wid >> 2, wc = wid & 3, fr = lane & 15, fq = lane >> 4;
    const int nt = K / BK;
    unsigned voffB[2], vc0[2], vc1[2], vn0[2], vn1[2];
#pragma unroll
    for (int i = 0; i < 2; ++i) { int R, C; stage_rc(tid * 16 + i * 8192, R, C); const int Rb = Epi::PERM ? ((R & ~31) + perm32(R & 31)) : R;
        voffB[i] = (unsigned)(Rb * ldb + C) * 2u; vc0[i] = (unsigned)(R * lda + C) * 2u; vc1[i] = vc0[i]; vn0[i] = vc0[i]; vn1[i] = vc0[i]; }
    const size_t hsA = GATHER ? (size_t)0 : (size_t)HALF * lda * 2, hsB = (size_t)HALF * ldb * 2;
    const size_t kstep = (size_t)(BK * 2);
    const unsigned ldsw = (unsigned)wid * 1024u;
    const int aoff = lds_byte(wr * 64 + fr, fq * 8), boff = lds_byte(wc * 32 + fr, fq * 8);
#define PG8_SA(b, h) (((b) * 2 + (h)) * HTB)
#define PG8_SB(b, h) ((4 + (b) * 2 + (h)) * HTB)
#define PG8_STAGE(bufoff, gbase, voff) do { _Pragma("unroll") for (int _i = 0; _i < 2; ++_i) \
        __builtin_amdgcn_global_load_lds((const unsigned*)((const char*)(gbase) + (voff)[_i]), (LAS unsigned*)(lds + (bufoff) + ldsw + _i * 8192), 16, 0, 0); } while (0)
#define PG8_LDA(dst, b, h) do { _Pragma("unroll") for (int m = 0; m < 4; ++m) _Pragma("unroll") for (int k = 0; k < 2; ++k) dst[m][k] = *(const LAS bf16x8*)(lds + PG8_SA(b, h) + aoff + m * 2048 + k * 1024); } while (0)
#define PG8_LDB(dst, b, h) do { _Pragma("unroll") for (int n = 0; n < 2; ++n) _Pragma("unroll") for (int k = 0; k < 2; ++k) dst[n][k] = *(const LAS bf16x8*)(lds + PG8_SB(b, h) + boff + n * 2048 + k * 1024); } while (0)
#define PG8_MMA(ai, bj, At, Bt) do { __builtin_amdgcn_s_setprio(1); _Pragma("unroll") for (int m = 0; m < 4; ++m) _Pragma("unroll") for (int n = 0; n < 2; ++n) _Pragma("unroll") for (int k = 0; k < 2; ++k) \
        acc[ai][bj][m][n] = __builtin_amdgcn_mfma_f32_16x16x32_bf16(Bt[n][k], At[m][k], acc[ai][bj][m][n], 0, 0, 0); __builtin_amdgcn_s_setprio(0); } while (0)
#define PG8_WAIT_V(n) asm volatile("s_waitcnt vmcnt(" #n ")" ::: "memory")
#define PG8_WAIT_L(n) asm volatile("s_waitcnt lgkmcnt(" #n ")" ::: "memory")
#define PG8_BAR __builtin_amdgcn_s_barrier()
#define PG8_SCHED __builtin_amdgcn_sched_barrier(0)
#define PG8_GVOFF(U, o0, o1) do { if constexpr (GATHER) { _Pragma("unroll") for (int _i = 0; _i < 2; ++_i) { int R_, C_; stage_rc(tid * 16 + _i * 8192, R_, C_); \
        const int r0_ = R_, r1_ = R_ + HALF; const int t0_ = (U).rows[r0_ < (U).nvalid ? r0_ : 0], t1_ = (U).rows[r1_ < (U).nvalid ? r1_ : 0]; \
        o0[_i] = (unsigned)(t0_ * lda + C_) * 2u; o1[_i] = (unsigned)(t1_ * lda + C_) * 2u; } } } while (0)
    Unit cur, nxt; int ui = 0;
    if (!S.next(0, cur)) return;
    PG8_GVOFF(cur, vc0, vc1);
    f32x4 acc[2][2][4][2];
#pragma unroll
    for (int a = 0; a < 2; ++a)
#pragma unroll
        for (int b = 0; b < 2; ++b)
#pragma unroll
            for (int m = 0; m < 4; ++m)
#pragma unroll
                for (int n = 0; n < 2; ++n) acc[a][b][m][n] = (f32x4){0.f, 0.f, 0.f, 0.f};
    bf16x8 At[4][2], B0[2][2], B1[2][2];
    const char* cA = (const char*)cur.a; const char* cB = (const char*)cur.b;
    PG8_STAGE(PG8_SB(0, 0), cB, voffB); PG8_STAGE(PG8_SB(0, 1), cB + hsB, voffB); PG8_STAGE(PG8_SA(0, 0), cA, vc0); PG8_STAGE(PG8_SA(0, 1), cA + hsA, vc1);
    if (wr == 1) PG8_BAR;
    PG8_WAIT_V(2); PG8_BAR;
    PG8_STAGE(PG8_SB(1, 0), cB + kstep, voffB); PG8_STAGE(PG8_SA(1, 0), cA + kstep, vc0); PG8_STAGE(PG8_SB(1, 1), cB + hsB + kstep, voffB);
    PG8_WAIT_V(6); PG8_BAR;
    for (;;) {
        const bool has_next = S.next(ui + 1, nxt);
        const char* nA = has_next ? (const char*)nxt.a : cA; const char* nB = has_next ? (const char*)nxt.b : cB;
        if constexpr (GATHER) { if (has_next) { PG8_GVOFF(nxt, vn0, vn1); } else {
#pragma unroll
            for (int i = 0; i < 2; ++i) { vn0[i] = vc0[i]; vn1[i] = vc1[i]; } } }
        for (int t = 0; t < nt; t += 2) {
            const bool last = (t == nt - 2);
            const char* a1 = cA + (size_t)(t + 1) * kstep;
            const char* a2 = last ? nA : cA + (size_t)(t + 2) * kstep; const char* b2 = last ? nB : cB + (size_t)(t + 2) * kstep;
            const char* a3 = a2 + kstep; const char* b3 = b2 + kstep;
            unsigned v20[2], v21[2];
#pragma unroll
            for (int i = 0; i < 2; ++i) { v20[i] = (GATHER && last) ? vn0[i] : vc0[i]; v21[i] = GATHER ? (last ? vn1[i] : vc1[i]) : vc0[i]; }
            PG8_LDB(B0, 0, 0); PG8_LDB(B1, 0, 1); PG8_SCHED; PG8_LDA(At, 0, 0); PG8_STAGE(PG8_SA(1, 1), a1 + hsA, vc1);
            PG8_WAIT_V(8); PG8_WAIT_L(0); PG8_BAR; PG8_MMA(0, 0, At, B0); PG8_MMA(0, 1, At, B1); PG8_BAR; PG8_SCHED;
            PG8_LDA(At, 0, 1); PG8_STAGE(PG8_SB(0, 0), b2, voffB); PG8_STAGE(PG8_SB(0, 1), b2 + hsB, voffB); PG8_STAGE(PG8_SA(0, 0), a2, v20);
            PG8_WAIT_V(8); PG8_WAIT_L(0); PG8_BAR; PG8_MMA(1, 0, At, B0); PG8_MMA(1, 1, At, B1); PG8_BAR; PG8_SCHED;
            PG8_LDB(B0, 1, 0); PG8_LDB(B1, 1, 1); PG8_SCHED; PG8_LDA(At, 1, 0); PG8_STAGE(PG8_SA(0, 1), a2 + hsA, v21);
            PG8_WAIT_V(8); PG8_WAIT_L(0); PG8_BAR; PG8_MMA(0, 0, At, B0); PG8_MMA(0, 1, At, B1); PG8_BAR; PG8_SCHED;
            PG8_LDA(At, 1, 1); PG8_STAGE(PG8_SB(1, 0), b3, voffB); PG8_STAGE(PG8_SB(1, 1), b3 + hsB, voffB); PG8_STAGE(PG8_SA(1, 0), a3, v20);
            PG8_WAIT_V(8); PG8_WAIT_L(0); PG8_BAR; PG8_MMA(1, 0, At, B0); PG8_MMA(1, 1, At, B1); PG8_BAR; PG8_SCHED;
        }
        if constexpr (ALIGN_EPI) { if (wr == 0) PG8_BAR; }
        E(acc, cur, wr, wc, fr, fq);
        if (!has_next) break;
#pragma unroll
        for (int a = 0; a < 2; ++a)
#pragma unroll
            for (int b = 0; b < 2; ++b)
#pragma unroll
                for (int m = 0; m < 4; ++m)
#pragma unroll
                    for (int n = 0; n < 2; ++n) acc[a][b][m][n] = (f32x4){0.f, 0.f, 0.f, 0.f};
        cur = nxt; cA = nA; cB = nB; ++ui;
        if constexpr (GATHER) {
#pragma unroll
            for (int i = 0; i < 2; ++i) { vc0[i] = vn0[i]; vc1[i] = vn1[i]; } }
        if constexpr (ALIGN_EPI) { if (wr == 1) PG8_BAR; }
    }
    PG8_WAIT_V(0);
    if constexpr (!ALIGN_EPI) { if (wr == 0) PG8_BAR; }
    PG8_BAR;
#undef PG8_SA
#undef PG8_SB
#undef PG8_STAGE
#undef PG8_LDA
#undef PG8_LDB
#undef PG8_MMA
#undef PG8_WAIT_V
#undef PG8_WAIT_L
#undef PG8_BAR
#undef PG8_SCHED
#undef PG8_GVOFF
}
}
#define XB_TMO      128
#define XB_XCNT(j)  (256  + 64 * (j))
#define XB_XSUB(j)  (1280 + 64 * (j))
#define XB_XGEN(j)  (2304 + 64 * (j))
#define XB_TOP      3328
#define XB_TOPGEN   3392
#define XCD_BAR_WORDS 3456
#define XB_SPIN_CAP (1u << 18)

__device__ __forceinline__ unsigned xb_ld(unsigned* p)              { return __hip_atomic_load(p, __ATOMIC_RELAXED, __HIP_MEMORY_SCOPE_AGENT); }
__device__ __forceinline__ unsigned xb_add(unsigned* p, unsigned v) { return __hip_atomic_fetch_add(p, v, __ATOMIC_RELAXED, __HIP_MEMORY_SCOPE_AGENT); }
__device__ __forceinline__ unsigned xb_xcc_id() { return (unsigned)__builtin_amdgcn_s_getreg((3 << 11) | 20) & 0xFu; }
#define XB_SPIN(cond, bar) do { unsigned _sp = 0; while (cond) { __builtin_amdgcn_s_sleep(1); \
    if ((++_sp & 255u) == 0u) { if (xb_ld(&(bar)[XB_TMO])) break; if (_sp > XB_SPIN_CAP) { atomicAdd(&(bar)[XB_TMO], 1u); break; } } } } while (0)

struct XcdBarrier {
    unsigned* bar; unsigned x;
    volatile LAS unsigned* st;
};

__device__ __forceinline__ XcdBarrier xcd_barrier_post(unsigned* bar, volatile LAS unsigned* st) {
    XcdBarrier b; b.bar = bar; b.x = xb_xcc_id(); b.st = st;
    if (threadIdx.x == 0) (void)xb_add(&bar[XB_XCNT(b.x)], 1u);
    return b;
}
__device__ __forceinline__ void xcd_barrier_complete(unsigned* bar, unsigned x, unsigned& nloc, unsigned& nx) {
    const unsigned G = gridDim.x * gridDim.y * gridDim.z;
    unsigned sum, cnt, mine, sp = 0u;
    for (;;) {
        sum = 0u; cnt = 0u; mine = 0u;
#pragma unroll
        for (unsigned j = 0; j < 16; ++j) { const unsigned c = xb_ld(&bar[XB_XCNT(j)]); sum += c; cnt += (c > 0u) ? 1u : 0u; mine = (j == x) ? c : mine; }
        if (sum == G) break;
        __builtin_amdgcn_s_sleep(1);
        if ((++sp & 255u) == 0u) { if (xb_ld(&bar[XB_TMO])) break; if (sp > XB_SPIN_CAP) { atomicAdd(&bar[XB_TMO], 1u); break; } }
    }
    nloc = mine > 0u ? mine : 1u; nx = cnt > 0u ? cnt : 1u;
}

__device__ __forceinline__ void xcd_barrier(const XcdBarrier& b) {
    asm volatile("s_waitcnt vmcnt(0)" ::: "memory");
    __syncthreads();
    if (threadIdx.x == 0) {
        unsigned* bar = b.bar;
        __builtin_amdgcn_s_waitcnt(0);
        unsigned nloc = b.st[0], nx = b.st[1];
        if (nloc == 0u) { xcd_barrier_complete(bar, b.x, nloc, nx); b.st[0] = nloc; b.st[1] = nx; }
        const unsigned old = xb_add(&bar[XB_XSUB(b.x)], 1u);
        const unsigned gen = old / nloc;
        if (old + 1u == (gen + 1u) * nloc) {
            __builtin_amdgcn_fence(__ATOMIC_RELEASE, "agent");
            asm volatile("s_waitcnt vmcnt(0)" ::: "memory");
            const unsigned og = xb_add(&bar[XB_TOP], 1u);
            const unsigned tg = og / nx;
            if (og + 1u == (tg + 1u) * nx) xb_add(&bar[XB_TOPGEN], 1u);
            else XB_SPIN(xb_ld(&bar[XB_TOPGEN]) == tg, bar);
            __builtin_amdgcn_fence(__ATOMIC_ACQUIRE, "agent");
            xb_add(&bar[XB_XGEN(b.x)], 1u);
            asm volatile("s_waitcnt vmcnt(0)" ::: "memory");
        } else {
            XB_SPIN(xb_ld(&bar[XB_XGEN(b.x)]) == gen, bar);
            __builtin_amdgcn_fence(__ATOMIC_ACQUIRE, "agent");
            asm volatile("s_waitcnt vmcnt(0)" ::: "memory");
        }
    }
    __syncthreads();
}
namespace att {
typedef short v4i16_t __attribute__((ext_vector_type(4)));
DI f32x16 mfma32(bf16x8 a, bf16x8 b, f32x16 c) { return __builtin_amdgcn_mfma_f32_32x32x16_bf16(a, b, c, 0, 0, 0); }
DI f32x4 mfma16(bf16x8 a, bf16x8 b, f32x4 c) { return __builtin_amdgcn_mfma_f32_16x16x32_bf16(a, b, c, 0, 0, 0); }
DI int crow(int r, int hi) { return (r & 3) + 8 * (r >> 2) + 4 * hi; }
DI s16x4 vtr(const LAS char* p) { return __builtin_bit_cast(s16x4, __builtin_amdgcn_ds_read_tr16_b64_v4i16((LAS v4i16_t*)p)); }
DI int rfl(int x) { return __builtin_amdgcn_readfirstlane(x); }
constexpr float NEGBIG = -1e30f;
#define LDS_BAR() asm volatile("s_waitcnt lgkmcnt(0)\n\ts_barrier" ::: "memory")

template <int D, int KS> DI f32x16 qk32(const LAS char* kp, const bf16x8* qf, float init = 0.f) {
    f32x16 acc;
#pragma unroll
    for (int i = 0; i < 16; ++i) acc[i] = init;
    bf16x8 kfr[D / 16];
#pragma unroll
    for (int d0 = 0; d0 < D / 16; ++d0) kfr[d0] = *(const LAS bf16x8*)(kp + d0 * 32);
    asm volatile("" ::: "memory");
#pragma unroll
    for (int d0 = 0; d0 < D / 16; ++d0) acc = mfma32(kfr[d0], qf[d0], acc);
    return acc;
}
template <int D, int KS> DI void qk64(f32x16& a0, f32x16& a1, const LAS char* kp, const bf16x8* qf, float init = 0.f) {
#pragma unroll
    for (int i = 0; i < 16; ++i) { a0[i] = init; a1[i] = init; }
    bf16x8 k0[D / 16], k1[D / 16];
#pragma unroll
    for (int d0 = 0; d0 < D / 16; ++d0) { k0[d0] = *(const LAS bf16x8*)(kp + d0 * 32); k1[d0] = *(const LAS bf16x8*)(kp + 32 * KS + d0 * 32); }
    asm volatile("" ::: "memory");
#pragma unroll
    for (int d0 = 0; d0 < D / 16; ++d0) { a0 = mfma32(k0[d0], qf[d0], a0); a1 = mfma32(k1[d0], qf[d0], a1); }
}
template <int VS> DI void pv32(f32x16 (&o)[2], const LAS char* vp, bf16x8 pf0, bf16x8 pf1) {
    s16x4 t[2][4];
#pragma unroll
    for (int dh = 0; dh < 2; ++dh) { t[dh][0] = vtr(vp + dh * 64); t[dh][1] = vtr(vp + 8 * VS + dh * 64); t[dh][2] = vtr(vp + 16 * VS + dh * 64); t[dh][3] = vtr(vp + 24 * VS + dh * 64); }
    asm volatile("" ::: "memory");
#pragma unroll
    for (int dh = 0; dh < 2; ++dh) {
        const bf16x8 v0 = __builtin_shufflevector(t[dh][0], t[dh][1], 0, 1, 2, 3, 4, 5, 6, 7), v1 = __builtin_shufflevector(t[dh][2], t[dh][3], 0, 1, 2, 3, 4, 5, 6, 7);
        o[dh] = mfma32(v0, pf0, o[dh]); o[dh] = mfma32(v1, pf1, o[dh]);
    }
}
template <int VS> DI void pv64(f32x16 (&o)[2], const LAS char* vp, const f32x16& p0, const f32x16& p1);
DI bf16x8 pack8(const f32x16& p, int s) {
    u32x4 w; w.x = cvtpk(p[8 * s], p[8 * s + 1]); w.y = cvtpk(p[8 * s + 2], p[8 * s + 3]); w.z = cvtpk(p[8 * s + 4], p[8 * s + 5]); w.w = cvtpk(p[8 * s + 6], p[8 * s + 7]);
    return __builtin_bit_cast(bf16x8, w);
}
template <int VS> DI void pv64(f32x16 (&o)[2], const LAS char* vp, const f32x16& p0, const f32x16& p1) {
    s16x4 t[2][2][4];
#pragma unroll
    for (int hh = 0; hh < 2; ++hh)
#pragma unroll
        for (int dh = 0; dh < 2; ++dh)
#pragma unroll
            for (int k = 0; k < 4; ++k) t[hh][dh][k] = vtr(vp + (32 * hh + 8 * k) * VS + dh * 64);
    const bf16x8 pa0 = pack8(p0, 0), pa1 = pack8(p0, 1), pb0 = pack8(p1, 0), pb1 = pack8(p1, 1);
    asm volatile("" ::: "memory");
#pragma unroll
    for (int dh = 0; dh < 2; ++dh) {
        o[dh] = mfma32(__builtin_shufflevector(t[0][dh][0], t[0][dh][1], 0, 1, 2, 3, 4, 5, 6, 7), pa0, o[dh]);
        o[dh] = mfma32(__builtin_shufflevector(t[0][dh][2], t[0][dh][3], 0, 1, 2, 3, 4, 5, 6, 7), pa1, o[dh]);
        o[dh] = mfma32(__builtin_shufflevector(t[1][dh][0], t[1][dh][1], 0, 1, 2, 3, 4, 5, 6, 7), pb0, o[dh]);
        o[dh] = mfma32(__builtin_shufflevector(t[1][dh][2], t[1][dh][3], 0, 1, 2, 3, 4, 5, 6, 7), pb1, o[dh]);
    }
}
DI float max16(const f32x16& p) { float a = fmaxf(fmaxf(p[0], p[1]), fmaxf(p[2], p[3]));
#pragma unroll
    for (int r = 4; r < 16; r += 4) a = fmaxf(a, fmaxf(fmaxf(p[r], p[r + 1]), fmaxf(p[r + 2], p[r + 3]))); return a; }
DI void store_ot(bf16_t* dst, const f32x16 (&o)[2], int hi) {
#pragma unroll
    for (int dh = 0; dh < 2; ++dh)
#pragma unroll
        for (int g4 = 0; g4 < 4; ++g4) { u32x2 w; w.x = cvtpk(o[dh][4 * g4], o[dh][4 * g4 + 1]); w.y = cvtpk(o[dh][4 * g4 + 2], o[dh][4 * g4 + 3]); *(u32x2*)(dst + 32 * dh + 8 * g4 + 4 * hi) = w; }
}

#define ATT_SB() __builtin_amdgcn_sched_barrier(0)
template <int D, int KS, int VS> DI void step64(f32x16 (&o)[2], float& l, const LAS char* kp, const LAS char* vp, const bf16x8* qf, float init) {
    bf16x8 k0[D / 16], k1[D / 16];
#pragma unroll
    for (int d0 = 0; d0 < D / 16; ++d0) { k0[d0] = *(const LAS bf16x8*)(kp + d0 * 32); k1[d0] = *(const LAS bf16x8*)(kp + 32 * KS + d0 * 32); }
    s16x4 t[2][2][4];
#pragma unroll
    for (int hh = 0; hh < 2; ++hh)
#pragma unroll
        for (int dh = 0; dh < 2; ++dh)
#pragma unroll
            for (int k = 0; k < 4; ++k) t[hh][dh][k] = vtr(vp + (32 * hh + 8 * k) * VS + dh * 64);
    f32x16 a0, a1;
#pragma unroll
    for (int i = 0; i < 16; ++i) { a0[i] = init; a1[i] = init; }
    ATT_SB();
#pragma unroll
    for (int d0 = 0; d0 < D / 16; ++d0) a0 = mfma32(k0[d0], qf[d0], a0);
#pragma unroll
    for (int d0 = 0; d0 < D / 16 - 4; ++d0) a1 = mfma32(k1[d0], qf[d0], a1);
    ATT_SB();
    float ls = 0.f;
#pragma unroll
    for (int g = 0; g < 4; ++g) {
        a1 = mfma32(k1[D / 16 - 4 + g], qf[D / 16 - 4 + g], a1);
#pragma unroll
        for (int e = 0; e < 4; ++e) { a0[4 * g + e] = fast_exp2(a0[4 * g + e]); ls += a0[4 * g + e]; }
        asm volatile("" : "+v"(a0), "+v"(ls)); ATT_SB();
    }
    const bf16x8 pa0 = pack8(a0, 0), pa1 = pack8(a0, 1);
    ATT_SB();
#pragma unroll
    for (int g = 0; g < 4; ++g) {
        const int dh = g & 1, s = g >> 1;
        o[dh] = mfma32(__builtin_shufflevector(t[0][dh][2 * s], t[0][dh][2 * s + 1], 0, 1, 2, 3, 4, 5, 6, 7), s ? pa1 : pa0, o[dh]);
#pragma unroll
        for (int e = 0; e < 4; ++e) { a1[4 * g + e] = fast_exp2(a1[4 * g + e]); ls += a1[4 * g + e]; }
        asm volatile("" : "+v"(a1), "+v"(ls)); ATT_SB();
    }
    const bf16x8 pb0 = pack8(a1, 0), pb1 = pack8(a1, 1);
    ATT_SB();
#pragma unroll
    for (int g = 0; g < 4; ++g) { const int dh = g & 1, s = g >> 1;
        o[dh] = mfma32(__builtin_shufflevector(t[1][dh][2 * s], t[1][dh][2 * s + 1], 0, 1, 2, 3, 4, 5, 6, 7), s ? pb1 : pb0, o[dh]); }
    l += ls;
}

constexpr int MLA_KS = 208, MLA_VS = 144, MLA_KB = 128 * MLA_KS, MLA_VB = 128 * MLA_VS, MLA_BUF = MLA_KB + MLA_VB;
DI void mla_unit(LAS char* lds, const bf16_t* QM, const bf16_t* KM, const bf16_t* KV, bf16_t* ATT, int head, int qb, float kb, int wave_id, unsigned long long* tp) {
    TP_BEGIN(7) unsigned long long tpacc_ = 0, tpa_ = 0;
    int tid_l = wave_id * 64 + lane_id(); asm volatile("" : "+v"(tid_l));
    const int tid = tid_l, lane = tid & 63, wid = rfl(tid >> 6), r32 = lane & 31, hi = lane >> 5, half = wid >> 2, wq = wid & 3;
    const int q0 = qb * 128, qpos = q0 + 32 * wq + r32, nsuper = qb + 1;
    bf16x8 qf[6];
    { const bf16_t* qp = QM + (size_t)qpos * 384 + head * 96 + hi * 8;
#pragma unroll
      for (int d0 = 0; d0 < 6; ++d0) qf[d0] = *(const bf16x8*)(qp + d0 * 16); }
    float nref;
    { float qs = 0.f;
#pragma unroll
      for (int d0 = 0; d0 < 6; ++d0)
#pragma unroll
          for (int e = 0; e < 8; ++e) { const float v = __uint_as_float(((unsigned)(unsigned short)qf[d0][e]) << 16); qs += v * v; }
      qs += sx32(qs, hi); nref = -sqrtf(qs) * kb; }
    u32x4 kr[3], vr[2];
#define MLA_LOAD(i) do { _Pragma("unroll") for (int j = 0; j < 3; ++j) { const int c = tid + 512 * j, row = c / 12, ch = c % 12; kr[j] = *(const u32x4*)(KM + (size_t)(128 * (i) + row) * 384 + head * 96 + ch * 8); } \
        _Pragma("unroll") for (int j = 0; j < 2; ++j) { const int c = tid + 512 * j, row = c >> 3, ch = c & 7; vr[j] = *(const u32x4*)(KV + (size_t)(128 * (i) + row) * 512 + head * 128 + 64 + ch * 8); } } while (0)
#define MLA_STORE(b) do { LAS char* kb_ = lds + (b) * MLA_BUF; _Pragma("unroll") for (int j = 0; j < 3; ++j) { const int c = tid + 512 * j, row = c / 12, ch = c % 12; *(LAS u32x4*)(kb_ + row * MLA_KS + ch * 16) = kr[j]; } \
        _Pragma("unroll") for (int j = 0; j < 2; ++j) { const int c = tid + 512 * j, row = c >> 3, ch = c & 7; *(LAS u32x4*)(kb_ + MLA_KB + row * MLA_VS + ch * 16) = vr[j]; } } while (0)
    MLA_LOAD(0); MLA_STORE(0); __syncthreads();
    float l = 0.f; f32x16 o[2];
#pragma unroll
    for (int i = 0; i < 16; ++i) { o[0][i] = 0.f; o[1][i] = 0.f; }
    const int vlane = (4 * hi + ((lane & 15) >> 2)) * MLA_VS + 2 * (16 * ((lane >> 4) & 1) + 4 * (lane & 3));
    for (int i = 0; i < nsuper; ++i) {
        const bool more = i + 1 < nsuper;
        if (more) MLA_LOAD(i + 1);
        const LAS char* kb_ = lds + (i & 1) * MLA_BUF; const LAS char* vb = kb_ + MLA_KB;
        const bool diag = (i == nsuper - 1);
        if (TPROBE == 14 || TPROBE == 15 || TPROBE == 16) tpa_ = tp_now();
        if (!(diag && half == 1 && wq < 2)) {
            const int koff = 64 * half;
            if (!diag) step64<96, MLA_KS, MLA_VS>(o, l, kb_ + (koff + r32) * MLA_KS + hi * 16, vb + koff * MLA_VS + vlane, qf, nref);
            else {
            f32x16 p0, p1; qk64<96, MLA_KS>(p0, p1, kb_ + (koff + r32) * MLA_KS + hi * 16, qf, nref);
            { const int kbase = 128 * i + koff;
#pragma unroll
                for (int r = 0; r < 16; ++r) { const int k0 = kbase + crow(r, hi); p0[r] = (k0 > qpos) ? 0.f : fast_exp2(p0[r]); p1[r] = (k0 + 32 > qpos) ? 0.f : fast_exp2(p1[r]); } }
#pragma unroll
            for (int r = 0; r < 16; ++r) l += p0[r] + p1[r];
            pv64<MLA_VS>(o, vb + koff * MLA_VS + vlane, p0, p1);
            }
        }
        if (TPROBE == 15) tpacc_ += tp_now() - tpa_;
        if (TPROBE == 16) tpa_ = tp_now();
        if (more) MLA_STORE((i + 1) & 1);
        if (TPROBE == 16) tpacc_ += tp_now() - tpa_;
        if (TPROBE == 14) tpa_ = tp_now();
        __syncthreads();
        if (TPROBE == 14) tpacc_ += tp_now() - tpa_;
    }
#undef MLA_LOAD
#undef MLA_STORE
    l = sum32sym(l);
    LAS float* mrg = (LAS float*)lds + (wq * 64 + lane) * 34;
    if (half == 1) { mrg[1] = l;
#pragma unroll
        for (int r = 0; r < 16; ++r) { mrg[2 + r] = o[0][r]; mrg[18 + r] = o[1][r]; } }
    __syncthreads();
    if (half == 0) {
        const float inv = 1.f / (l + mrg[1]);
#pragma unroll
        for (int r = 0; r < 16; ++r) { o[0][r] = (o[0][r] + mrg[2 + r]) * inv; o[1][r] = (o[1][r] + mrg[18 + r]) * inv; }
        store_ot(ATT + (size_t)qpos * 1024 + 768 + head * 64, o, hi);
    }
    __syncthreads();
    TP_END(7, tp);
    if ((TPROBE == 14 || TPROBE == 15 || TPROBE == 16) && lane == 0) atomicAdd(tp, tpacc_);
}

constexpr int T_KS = 144, T_KB = 64 * T_KS, T_BUF = 2 * T_KB;
DI void sb_half(f32x16 (&o)[2], float& R, const LAS char* ktile, const LAS char* vtile, const bf16x8* qf, int kb, int hh, int qpos, int r32, int hi, int vlane) {
    f32x16 z = qk32<64, T_KS>(ktile + (32 * hh + r32) * T_KS + hi * 16, qf);
    float ls[16];
#pragma unroll
    for (int r = 0; r < 16; ++r) { const bool valid = (kb + crow(r, hi)) < qpos; const float az = fabsf(z[r]);
        const float sp = fmaxf(z[r], 0.f) + fast_log2(1.f + fast_exp2(-az)); ls[r] = valid ? -sp : 0.f; }
    float T[4], U[4];
#pragma unroll
    for (int g = 0; g < 4; ++g) { ls[4 * g + 2] += ls[4 * g + 3]; ls[4 * g + 1] += ls[4 * g + 2]; ls[4 * g] += ls[4 * g + 1]; T[g] = ls[4 * g]; }
#pragma unroll
    for (int g = 0; g < 4; ++g) U[g] = sx32(T[g], hi);
    float H[4]; float sp = 0.f;
#pragma unroll
    for (int g = 3; g >= 0; --g) { H[g] = sp + (hi == 0 ? U[g] : 0.f); sp += T[g] + U[g]; }
#pragma unroll
    for (int r = 0; r < 16; ++r) { const bool valid = (kb + crow(r, hi)) < qpos; const float lw = z[r] + R + H[r >> 2] + ls[r]; z[r] = valid ? fast_exp2(lw) : 0.f; }
    R += sp;
    pv32<T_KS>(o, vtile + (32 * hh) * T_KS + vlane, pack8(z, 0), pack8(z, 1));
}
DI void sb_unit(LAS char* lds, const bf16_t* PROJ, bf16_t* ATT, int head, int qb, int wave_id) {
    int tid_l = wave_id * 64 + lane_id(); asm volatile("" : "+v"(tid_l));
    const int tid = tid_l, lane = tid & 63, wid = rfl(tid >> 6), r32 = lane & 31, hi = lane >> 5;
    const int q0 = qb * 256, wq0 = q0 + 32 * wid, qpos = wq0 + r32;
    bf16x8 qf[4];
    { const bf16_t* qp = PROJ + (size_t)qpos * 5632 + head * 64 + hi * 8;
#pragma unroll
      for (int d0 = 0; d0 < 4; ++d0) qf[d0] = *(const bf16x8*)(qp + d0 * 16); }
    const int srow = tid >> 3, sch = tid & 7;
    u32x4 kr, vr;
#define SB_LOAD(t) do { const bf16_t* p_ = PROJ + (size_t)(64 * (t) + srow) * 5632 + head * 64 + sch * 8; kr = *(const u32x4*)(p_ + 256); vr = *(const u32x4*)(p_ + 512); } while (0)
#define SB_STORE(b) do { LAS char* d_ = lds + (b) * T_BUF + srow * T_KS + sch * 16; *(LAS u32x4*)d_ = kr; *(LAS u32x4*)(d_ + T_KB) = vr; } while (0)
    volatile LAS int* flags = (volatile LAS int*)(lds + 2 * T_BUF);
    int t = 4 * qb + 3;
    SB_LOAD(t); SB_STORE(0); __syncthreads();
    float R = 0.f; f32x16 o[2];
#pragma unroll
    for (int i = 0; i < 16; ++i) { o[0][i] = 0.f; o[1][i] = 0.f; }
    const int vlane = (4 * hi + ((lane & 15) >> 2)) * T_KS + 2 * (16 * ((lane >> 4) & 1) + 4 * (lane & 3));
    bool done = false;
    for (int it = 0;; ++it) {
        const bool more = t > 0;
        if (more) SB_LOAD(t - 1);
        const LAS char* kt = lds + (it & 1) * T_BUF; const LAS char* vt = kt + T_KB;
        if (!done && 64 * t <= wq0 + 30) {
            if (64 * t + 32 <= wq0 + 30) sb_half(o, R, kt, vt, qf, 64 * t + 32, 1, qpos, r32, hi, vlane);
            sb_half(o, R, kt, vt, qf, 64 * t, 0, qpos, r32, hi, vlane);
            done = __all(R < -150.f) != 0;
        }
        if (lane == 0) flags[(it & 1) * 8 + wid] = done ? 0 : 1;
        if (more) SB_STORE((it + 1) & 1);
        __syncthreads();
        int any = 0;
#pragma unroll
        for (int w = 0; w < 8; ++w) any |= flags[(it & 1) * 8 + w];
        if (!more || !any) break;
        --t;
    }
#undef SB_LOAD
#undef SB_STORE
    store_ot(ATT + (size_t)qpos * 1024 + head * 64, o, hi);
    __syncthreads();
}

#ifndef NSAREP
#define NSAREP 0
#endif
#define NSA_NREP(bit) (((NSAREP >> (bit)) & 1) ? 2 : 1)
constexpr int N_LUT = 2 * T_BUF, N_IMP = N_LUT + 16384, N_OSTR = 68, N_BLKQ = N_IMP + 256 * N_OSTR * 4, N_L = N_BLKQ + 2048, N_REF = N_L + 1280, N_END = N_REF + 1024 + 64;
constexpr int N_QS = 144;
struct NsaT {
    const bf16_t* PROJ;
    const bf16_t* KCMP; const bf16_t* VCMP;
    const bf16_t* KS; const bf16_t* VTS;
    const bf16_t* KW;
    const float* GN;
    const float* LUT8;
    bf16_t* ATT;
    float kb, bmax;
    unsigned long long* tp;
};
__host__ __device__ __forceinline__ int vts_key_of_slot(int slot) { const int hh = slot >> 5, s5 = slot & 31, s = s5 >> 4, h = (s5 >> 3) & 1, j = s5 & 7; return 32 * hh + 16 * s + 8 * (j >> 2) + 4 * h + (j & 3); }

DI void nsa_unit(LAS char* lds, const NsaT& T, int g, int qblk, int wave_id) {
    int tid_l = wave_id * 64 + lane_id(); asm volatile("" : "+v"(tid_l));
    const int tid = tid_l, lane = tid & 63, wid = rfl(tid >> 6), r32 = lane & 31, hi = lane >> 5;
    const int q0 = qblk * 64;
    TP_BEGIN(6)
    LAS float* lut = (LAS float*)(lds + N_LUT);
    LAS float* imp = (LAS float*)(lds + N_IMP);
    LAS unsigned* bq32 = (LAS unsigned*)(lds + N_BLKQ);
    LAS float* refl = (LAS float*)(lds + N_REF);
    for (int i = tid; i < 4096; i += 512) lut[i] = T.LUT8[(i >> 2) * 8 + g * 4 + (i & 3)];
    for (int i = tid; i < 16384; i += 512) imp[i] = 0.f;
    bq32[tid] = 0u;
    const int ql = r32 >> 2, hd = r32 & 3, h8 = g * 4 + hd, tq = q0 + 8 * wid + ql;
    bf16x8 qf[4];
    { const bf16_t* qp = T.PROJ + (size_t)tq * 5632 + 768 + h8 * 64 + hi * 8;
#pragma unroll
      for (int d0 = 0; d0 < 4; ++d0) qf[d0] = *(const bf16x8*)(qp + d0 * 16); }
    float ref;
    { float qs = 0.f;
#pragma unroll
      for (int d0 = 0; d0 < 4; ++d0)
#pragma unroll
          for (int e = 0; e < 8; ++e) { const float v = __uint_as_float(((unsigned)(unsigned short)qf[d0][e]) << 16); qs += v * v; }
      qs += sx32(qs, hi); ref = sqrtf(qs) * T.kb + T.bmax; }
    if (hi == 0) refl[(8 * wid + ql) * 4 + hd] = ref;
    const float gc = T.GN[(size_t)tq * 24 + 3 * h8], gs = T.GN[(size_t)tq * 24 + 3 * h8 + 1], gw = T.GN[(size_t)tq * 24 + 3 * h8 + 2];
    const int srow = tid >> 3, sch = tid & 7;
    const int vlane = (4 * hi + ((lane & 15) >> 2)) * T_KS + 2 * (16 * ((lane >> 4) & 1) + 4 * (lane & 3));
    u32x4 kr, vr;
    __syncthreads();
    const float cfar = lut[1023 * 4 + hd] - ref;
    const int nmax = (q0 + 32) / 16 + 1;
    const int ntc = (nmax + 63) >> 6;
    const bf16_t* kc = T.KCMP + (size_t)g * 1024 * 64; const bf16_t* vc = T.VCMP + (size_t)g * 1024 * 64;
    const int relq = tq - 31;
    const int relw = q0 + 8 * wid - 31;
    float l = 0.f; float inv_l = 0.f; f32x16 oa[2];
    { TP_BEGIN(4)
    for (int rp_ = 0; rp_ < NSA_NREP(0); ++rp_) { l = 0.f;
    u32x4 kq, vq;
    kr = *(const u32x4*)(kc + (size_t)srow * 64 + sch * 8);
    *(LAS u32x4*)(lds + srow * T_KS + sch * 16) = kr; kq = kr;
    if (1 < ntc) kq = *(const u32x4*)(kc + (size_t)(64 + srow) * 64 + sch * 8);
    LDS_BAR();
    for (int j = 0; j < ntc; ++j) {
        const bool more = j + 1 < ntc;
        if (j + 2 < ntc) kr = *(const u32x4*)(kc + (size_t)(64 * (j + 2) + srow) * 64 + sch * 8);
        const LAS char* kt = lds + (j & 1) * T_BUF;
#pragma unroll
        for (int hh = 0; hh < 2; ++hh) {
            f32x16 s = qk32<64, T_KS>(kt + (32 * hh + r32) * T_KS + hi * 16, qf);
            const int n0 = 64 * j + 32 * hh;
            if (relw - 16 * (n0 + 31) >= 790) {
#pragma unroll
                for (int r = 0; r < 16; ++r) l += fast_exp2(s[r] + cfar);
            } else {
#pragma unroll
                for (int r = 0; r < 16; ++r) { const int rel = relq - 16 * (n0 + crow(r, hi)); l += (rel >= 0) ? fast_exp2(s[r] + lut[(rel < 1023 ? rel : 1023) * 4 + hd] - ref) : 0.f; }
            }
        }
        if (more) *(LAS u32x4*)(lds + ((j + 1) & 1) * T_BUF + srow * T_KS + sch * 16) = kq;
        kq = kr;
        LDS_BAR();
    }
    l = sum32sym(l);
    inv_l = l > 0.f ? 1.f / l : 0.f;
#pragma unroll
    for (int i = 0; i < 16; ++i) { oa[0][i] = 0.f; oa[1][i] = 0.f; }
    float cprev = 0.f;
    kr = *(const u32x4*)(kc + (size_t)srow * 64 + sch * 8); vr = *(const u32x4*)(vc + (size_t)srow * 64 + sch * 8);
    { LAS char* d_ = lds + srow * T_KS + sch * 16; *(LAS u32x4*)d_ = kr; *(LAS u32x4*)(d_ + T_KB) = vr; } kq = kr; vq = vr;
    if (1 < ntc) { kq = *(const u32x4*)(kc + (size_t)(64 + srow) * 64 + sch * 8); vq = *(const u32x4*)(vc + (size_t)(64 + srow) * 64 + sch * 8); }
    LDS_BAR();
    for (int j = 0; j < ntc; ++j) {
        const bool more = j + 1 < ntc;
        if (j + 2 < ntc) { kr = *(const u32x4*)(kc + (size_t)(64 * (j + 2) + srow) * 64 + sch * 8); vr = *(const u32x4*)(vc + (size_t)(64 * (j + 2) + srow) * 64 + sch * 8); }
        const LAS char* kt = lds + (j & 1) * T_BUF; const LAS char* vt = kt + T_KB;
#pragma unroll
        for (int hh = 0; hh < 2; ++hh) {
            f32x16 s = qk32<64, T_KS>(kt + (32 * hh + r32) * T_KS + hi * 16, qf);
            const int n0 = 64 * j + 32 * hh;
            if (relw - 16 * (n0 + 31) >= 790) {
#pragma unroll
                for (int r = 0; r < 16; ++r) s[r] = fast_exp2(s[r] + cfar) * inv_l;
            } else {
#pragma unroll
                for (int r = 0; r < 16; ++r) { const int rel = relq - 16 * (n0 + crow(r, hi)); s[r] = (rel >= 0) ? fast_exp2(s[r] + lut[(rel < 1023 ? rel : 1023) * 4 + hd] - ref) * inv_l : 0.f; }
            }
            float gsm[4], c3[4], pc3[4];
#pragma unroll
            for (int gi = 0; gi < 4; ++gi) { float a = (s[4 * gi] + s[4 * gi + 1]) + (s[4 * gi + 2] + s[4 * gi + 3]), b = s[4 * gi + 3];
                a += sx<1>(a); a += sx<2>(a); b += sx<1>(b); b += sx<2>(b); gsm[gi] = a; c3[gi] = b; }
#pragma unroll
            for (int gi = 0; gi < 4; ++gi) pc3[gi] = sx32(c3[gi], hi);
            const int b0 = 16 * j + 8 * hh + hi;
            if (hd == 0) {
                LAS float* ip = imp + (8 * wid + ql) * 256 + b0;
                if (hi == 1) {
#pragma unroll
                    for (int gi = 0; gi < 4; ++gi) ip[2 * gi] = gsm[gi] + pc3[gi];
                } else { ip[0] = gsm[0] + cprev; ip[2] = gsm[1] + pc3[0]; ip[4] = gsm[2] + pc3[1]; ip[6] = gsm[3] + pc3[2]; }
            }
            cprev = pc3[3];
            pv32<T_KS>(oa, vt + (32 * hh) * T_KS + vlane, pack8(s, 0), pack8(s, 1));
        }
        if (more) { LAS char* d_ = lds + ((j + 1) & 1) * T_BUF + srow * T_KS + sch * 16; *(LAS u32x4*)d_ = kq; *(LAS u32x4*)(d_ + T_KB) = vq; }
        kq = kr; vq = vr;
        LDS_BAR();
    }
    }
    TP_END(4, T.tp); }
#pragma unroll
    for (int i = 0; i < 16; ++i) { oa[0][i] *= gc; oa[1][i] *= gc; }
    store_ot(T.ATT + (size_t)tq * 1024 + 256 + h8 * 64, oa, hi);
    { TP_BEGIN(3)
    for (int rp_ = 0; rp_ < NSA_NREP(1); ++rp_) {
    unsigned ones = 0xffffffffu; asm volatile("" : "+v"(ones));
    if (qblk < 16) {
        if (tid <= qblk) { bq32[2 * tid] = ones; bq32[2 * tid + 1] = ones; }
    } else {
        if (tid == 0) { bq32[0] = ones; bq32[1] = ones; bq32[2 * qblk] = ones; bq32[2 * qblk + 1] = ones; bq32[2 * qblk - 2] = ones; bq32[2 * qblk - 1] = ones; }
        unsigned kv[8][4];
#pragma unroll
        for (int q = 0; q < 8; ++q)
#pragma unroll
            for (int i = 0; i < 4; ++i) { const int b = lane + 64 * i; kv[q][i] = (b >= 1 && b <= qblk - 2) ? __float_as_uint(imp[(8 * wid + q) * 256 + b]) + 1u : 0u; }
        for (int rnd = 0; rnd < 13; ++rnd) {
#pragma unroll
            for (int q = 0; q < 8; ++q) {
                unsigned m = kv[q][0] > kv[q][1] ? kv[q][0] : kv[q][1]; { const unsigned m2 = kv[q][2] > kv[q][3] ? kv[q][2] : kv[q][3]; m = m > m2 ? m : m2; }
                { unsigned o_; o_ = sxu<1>(m); m = m > o_ ? m : o_; o_ = sxu<2>(m); m = m > o_ ? m : o_; o_ = sxu<4>(m); m = m > o_ ? m : o_; o_ = sxu<8>(m); m = m > o_ ? m : o_; o_ = sxu<16>(m); m = m > o_ ? m : o_;
                  auto rr = __builtin_amdgcn_permlane32_swap(m, m, false, false); m = rr[0] > rr[1] ? rr[0] : rr[1]; }
                const unsigned long long b0_ = __builtin_amdgcn_ballot_w64(kv[q][0] == m), b1_ = __builtin_amdgcn_ballot_w64(kv[q][1] == m), b2_ = __builtin_amdgcn_ballot_w64(kv[q][2] == m), b3_ = __builtin_amdgcn_ballot_w64(kv[q][3] == m);
                const int isel = b0_ ? 0 : b1_ ? 1 : b2_ ? 2 : 3; const unsigned long long bm = b0_ ? b0_ : b1_ ? b1_ : b2_ ? b2_ : b3_;
                const int lsel = __builtin_ctzll(bm), bsel = lsel + 64 * isel;
#pragma unroll
                for (int i = 0; i < 4; ++i) if (i == isel && lane == lsel) kv[q][i] = 0u;
                const int qi = 8 * wid + q;
                if (lane == 0) (void)__hip_atomic_fetch_or(bq32 + 2 * bsel + (qi >> 5), 1u << (qi & 31), __ATOMIC_RELAXED, __HIP_MEMORY_SCOPE_WORKGROUP);
            }
        }
    }
    }
    TP_END(3, T.tp); }
    __syncthreads();
    {
        LAS float* slot = (LAS float*)(lds + N_IMP);
        LAS unsigned short* items = (LAS unsigned short*)(lds + N_L);
        volatile LAS int* nitems = (volatile LAS int*)(lds + N_L + 768);
        LAS unsigned* smask = (LAS unsigned*)(lds + N_L + 832);
        LAS unsigned char* npv = (LAS unsigned char*)(lds + N_L + 896);
        LAS int* part = (LAS int*)(lds + N_REF + 1024);
        if (tid < 256) { int np = 0; if (qblk >= 16 && tid >= 1 && tid <= qblk - 2) { const unsigned long long mk = ((unsigned long long)bq32[2 * tid + 1] << 32) | bq32[2 * tid]; np = (__builtin_popcountll(mk) + 7) >> 3; } npv[tid] = (unsigned char)np; }
        __syncthreads();
        if (tid < 16) { int sm = 0;
#pragma unroll
            for (int k = 0; k < 16; ++k) sm += npv[16 * tid + k]; part[tid] = sm; }
        __syncthreads();
        if (tid == 0) { int run = 0;
#pragma unroll
            for (int k = 0; k < 16; ++k) { const int v = part[k]; part[k] = run; run += v; } *nitems = run; }
        __syncthreads();
        if (tid < 256) { int st = part[tid >> 4]; for (int k = 0; k < (tid & 15); ++k) st += npv[(tid & ~15) + k]; const int np = npv[tid]; for (int pp = 0; pp < np; ++pp) items[st + pp] = (unsigned short)(tid | (pp << 8)); }
        { const int q = tid >> 3, c8 = tid & 7; const bf16_t* src = T.PROJ + (size_t)(q0 + q) * 5632 + 768 + g * 256 + c8 * 32; LAS char* dst = lds + (q * 4 + (c8 >> 1)) * N_QS + (c8 & 1) * 64;
#pragma unroll
          for (int i = 0; i < 4; ++i) *(LAS u32x4*)(dst + 16 * i) = *(const u32x4*)(src + 8 * i); }
        __syncthreads();
        const bf16_t* ksg = T.KS + (size_t)g * 256 * 4096 + lane * 8;
        const bf16_t* vtg = T.VTS + (size_t)g * 256 * 4096 + lane * 8;
        const int jslot = r32 >> 2;
        const int myq = 8 * wid + ql; const unsigned qmlo = myq < 32 ? ((1u << myq) - 1u) : 0xffffffffu, qmhi = myq < 32 ? 0u : ((1u << (myq - 32)) - 1u);
        const float biasfar = lut[1023 * 4 + hd];
        float lpart = 0.f, lfull = 0.f; f32x16 os[2];
        for (int rp_ = 0; rp_ < NSA_NREP(2); ++rp_) { lpart = 0.f; lfull = 0.f;
#pragma unroll
        for (int i = 0; i < 16; ++i) { os[0][i] = 0.f; os[1][i] = 0.f; }
        bf16x8 kf[2][4], vf[2][2][2];
#define NSA_LDK(B) do { const bf16_t* p_ = ksg + (size_t)(B) * 4096; _Pragma("unroll") for (int hh = 0; hh < 2; ++hh) _Pragma("unroll") for (int d0 = 0; d0 < 4; ++d0) kf[hh][d0] = *(const bf16x8*)(p_ + (hh * 4 + d0) * 512); } while (0)
#define NSA_LDV(B) do { const bf16_t* p_ = vtg + (size_t)(B) * 4096; _Pragma("unroll") for (int hh = 0; hh < 2; ++hh) _Pragma("unroll") for (int dh = 0; dh < 2; ++dh) _Pragma("unroll") for (int s = 0; s < 2; ++s) vf[hh][dh][s] = *(const bf16x8*)(p_ + ((hh * 2 + dh) * 2 + s) * 512); } while (0)
#define NSA_SCORE(B, QF, INI, TS, OK, LS) do { \
            _Pragma("unroll") for (int hh = 0; hh < 2; ++hh) { _Pragma("unroll") for (int i = 0; i < 16; ++i) sc[hh][i] = (INI); \
                _Pragma("unroll") for (int d0 = 0; d0 < 4; ++d0) sc[hh] = mfma32(kf[hh][d0], (QF)[d0], sc[hh]); } \
            if (q0 - (64 * (B) + 63) >= 790) { _Pragma("unroll") for (int hh = 0; hh < 2; ++hh) _Pragma("unroll") for (int r = 0; r < 16; ++r) { const float p = (OK) ? fast_exp2(sc[hh][r]) : 0.f; sc[hh][r] = p; LS += p; } } \
            else { _Pragma("unroll") for (int hh = 0; hh < 2; ++hh) _Pragma("unroll") for (int r = 0; r < 16; ++r) { const int rel = (TS) - (64 * (B) + 32 * hh + crow(r, hi)); const int rc = rel < 0 ? 0 : (rel < 1023 ? rel : 1023); \
                const float p = ((OK) && rel >= 0) ? fast_exp2(sc[hh][r] + lut[rc * 4 + hd]) : 0.f; sc[hh][r] = p; LS += p; } } } while (0)
#define NSA_PV(O) do { _Pragma("unroll") for (int hh = 0; hh < 2; ++hh) { const bf16x8 p0 = pack8(sc[hh], 0), p1 = pack8(sc[hh], 1); \
            _Pragma("unroll") for (int dh = 0; dh < 2; ++dh) { (O)[dh] = mfma32(vf[hh][dh][0], p0, (O)[dh]); (O)[dh] = mfma32(vf[hh][dh][1], p1, (O)[dh]); } } } while (0)
        f32x16 sc[2];
        { TP_BEGIN(2) const int nf = qblk < 16 ? qblk + 1 : 3;
          for (int fi = 0; fi < nf; ++fi) { const int fb = qblk < 16 ? fi : (fi == 0 ? 0 : qblk - 2 + fi);
            NSA_LDK(fb); NSA_LDV(fb);
            const float ini = ((q0 - (64 * fb + 63) >= 790) ? biasfar : 0.f) - ref;
            NSA_SCORE(fb, qf, ini, tq, true, lpart);
            NSA_PV(os); } TP_END(2, T.tp); }
        TP_BEGIN(1)
        const int ni = *nitems; unsigned long long tpacc_ = 0;
        int it_b = -1, it_p = 0;
        if (wid < ni) { const int e = items[wid]; it_b = e & 255; it_p = e >> 8; NSA_LDK(it_b); NSA_LDV(it_b); }
        for (int i0 = 0; i0 < ni; i0 += 8) {
            const int inext = i0 + 8 + wid; int nb_ = -1, np_ = 0;
            if (inext < ni) { const int e = items[inext]; nb_ = e & 255; np_ = e >> 8; }
            unsigned long long msk = 0ull;
            unsigned long long tpa_ = 0; if (TPROBE == 11 || TPROBE == 12 || TPROBE == 13) tpa_ = tp_now();
            if (it_b >= 0) {
                unsigned long long m_ = ((unsigned long long)(unsigned)rfl((int)bq32[2 * it_b + 1]) << 32) | (unsigned)rfl((int)bq32[2 * it_b]);
                for (int i_ = 0; i_ < 8 * it_p; ++i_) m_ &= m_ - 1ull;
                unsigned long long t_ = m_; for (int i_ = 0; i_ < 8; ++i_) t_ &= t_ - 1ull;
                msk = m_ & ~t_;
                int qsel = -1; { unsigned long long mm = msk;
#pragma unroll
                    for (int j = 0; j < 8; ++j) { const int qj = mm ? (int)__builtin_ctzll(mm) : -1; mm &= mm - 1ull; if (jslot == j) qsel = qj; } }
                const bool valid = qsel >= 0; const int row = (valid ? qsel : 0) * 4 + hd, ts = q0 + (valid ? qsel : 0);
                const float ini = ((q0 - (64 * it_b + 63) >= 790) ? biasfar : 0.f) - refl[row];
                bf16x8 qv[4];
#pragma unroll
                for (int d0 = 0; d0 < 4; ++d0) qv[d0] = *(const LAS bf16x8*)(lds + row * N_QS + d0 * 32 + hi * 16);
                float ls = 0.f;
                NSA_SCORE(it_b, qv, ini, ts, valid, ls);
                if (nb_ >= 0) NSA_LDK(nb_);
                f32x16 ot[2];
#pragma unroll
                for (int i = 0; i < 16; ++i) { ot[0][i] = 0.f; ot[1][i] = 0.f; }
                NSA_PV(ot);
                if (nb_ >= 0) NSA_LDV(nb_);
                ls = sum32sym(ls);
                LAS float* sp = slot + (wid * 32 + r32) * N_OSTR;
#pragma unroll
                for (int dh = 0; dh < 2; ++dh)
#pragma unroll
                    for (int g4 = 0; g4 < 4; ++g4) *(LAS f32x4*)(sp + 32 * dh + 8 * g4 + 4 * hi) = (f32x4){ot[dh][4 * g4], ot[dh][4 * g4 + 1], ot[dh][4 * g4 + 2], ot[dh][4 * g4 + 3]};
                if (hi == 0) sp[64] = ls;
            }
            if (lane == 0) { smask[2 * wid] = (unsigned)msk; smask[2 * wid + 1] = (unsigned)(msk >> 32); }
            if (TPROBE == 11) tpacc_ += tp_now() - tpa_;
            if (TPROBE == 12 || TPROBE == 13) tpa_ = tp_now();
            LDS_BAR();
            if (TPROBE == 12) tpacc_ += tp_now() - tpa_;
            if (TPROBE == 13) tpa_ = tp_now();
            const unsigned smv = smask[lane & 15];
#pragma unroll
            for (int w = 0; w < 8; ++w) {
                const unsigned mlo = (unsigned)__builtin_amdgcn_readlane((int)smv, 2 * w), mhi = (unsigned)__builtin_amdgcn_readlane((int)smv, 2 * w + 1);
                const unsigned long long mw = ((unsigned long long)mhi << 32) | mlo;
                if ((unsigned)(mw >> (8 * wid)) & 0xffu) {
                    const bool has = (myq < 32 ? (mlo >> myq) : (mhi >> (myq - 32))) & 1u;
                    const int j = __builtin_popcount(mlo & qmlo) + __builtin_popcount(mhi & qmhi);
                    const LAS float* sp = slot + (w * 32 + (has ? j : 0) * 4 + hd) * N_OSTR;
                    f32x4 v[2][4];
#pragma unroll
                    for (int dh = 0; dh < 2; ++dh)
#pragma unroll
                        for (int g4 = 0; g4 < 4; ++g4) v[dh][g4] = *(const LAS f32x4*)(sp + 32 * dh + 8 * g4 + 4 * hi);
                    const float lv = sp[64];
                    if (has) {
#pragma unroll
                        for (int dh = 0; dh < 2; ++dh)
#pragma unroll
                            for (int g4 = 0; g4 < 4; ++g4) { os[dh][4 * g4] += v[dh][g4].x; os[dh][4 * g4 + 1] += v[dh][g4].y; os[dh][4 * g4 + 2] += v[dh][g4].z; os[dh][4 * g4 + 3] += v[dh][g4].w; }
                        lfull += lv; }
                }
            }
            if (TPROBE == 13) tpacc_ += tp_now() - tpa_;
            LDS_BAR();
            it_b = nb_; it_p = np_;
        }
        TP_END(1, T.tp);
        if ((TPROBE == 11 || TPROBE == 12 || TPROBE == 13) && lane == 0) atomicAdd(T.tp, tpacc_);
#undef NSA_LDK
#undef NSA_LDV
#undef NSA_SCORE
#undef NSA_PV
        }
        { const float f = gs / (sum32sym(lpart) + lfull);
#pragma unroll
          for (int i = 0; i < 16; ++i) { oa[0][i] = f * os[0][i]; oa[1][i] = f * os[1][i]; } }
        { const bf16_t* qp = T.PROJ + (size_t)tq * 5632 + 768 + h8 * 64 + hi * 8;
#pragma unroll
          for (int d0 = 0; d0 < 4; ++d0) qf[d0] = *(const bf16x8*)(qp + d0 * 16); }
        __syncthreads();
    }
    {
        const bf16_t* kw = T.KW + (size_t)g * 16384 * 64; const bf16_t* vw = T.PROJ + 1920 + g * 64;
        const int kt0 = qblk > 8 ? qblk - 8 : 0, ntw = qblk - kt0 + 1;
        float lw = 0.f; f32x16 ow[2];
        TP_BEGIN(5)
        for (int rp_ = 0; rp_ < NSA_NREP(3); ++rp_) { lw = 0.f;
#pragma unroll
        for (int i = 0; i < 16; ++i) { ow[0][i] = 0.f; ow[1][i] = 0.f; }
#define WIN_LD(t, K_, V_) do { K_ = *(const u32x4*)(kw + (size_t)(64 * (t) + srow) * 64 + sch * 8); V_ = *(const u32x4*)(vw + (size_t)(64 * (t) + srow) * 5632 + sch * 8); } while (0)
        u32x4 kq, vq;
        WIN_LD(kt0, kr, vr);
        { LAS char* d_ = lds + srow * T_KS + sch * 16; *(LAS u32x4*)d_ = kr; *(LAS u32x4*)(d_ + T_KB) = vr; }
        kq = kr; vq = vr;
        if (1 < ntw) WIN_LD(kt0 + 1, kq, vq);
        LDS_BAR();
        for (int j = 0; j < ntw; ++j) {
            const bool more = j + 1 < ntw;
            if (j + 2 < ntw) WIN_LD(kt0 + j + 2, kr, vr);
            const LAS char* kt = lds + (j & 1) * T_BUF; const LAS char* vt = kt + T_KB;
            f32x16 p[2];
#pragma unroll
            for (int hh = 0; hh < 2; ++hh) { p[hh] = qk32<64, T_KS>(kt + (32 * hh + r32) * T_KS + hi * 16, qf);
#pragma unroll
                for (int r = 0; r < 16; ++r) { const int rel = tq - (64 * (kt0 + j) + 32 * hh + crow(r, hi)); const bool valid = rel >= 0 && rel < 512;
                    const float e = valid ? fast_exp2(p[hh][r] + lut[(rel < 0 ? 0 : rel) * 4 + hd] - ref) : 0.f; p[hh][r] = e; lw += e; } }
            pv64<T_KS>(ow, vt + vlane, p[0], p[1]);
            if (more) { LAS char* d_ = lds + ((j + 1) & 1) * T_BUF + srow * T_KS + sch * 16; *(LAS u32x4*)d_ = kq; *(LAS u32x4*)(d_ + T_KB) = vq; }
            kq = kr; vq = vr;
            LDS_BAR();
        }
#undef WIN_LD
        }
        TP_END(5, T.tp);
        lw = sum32sym(lw);
        const float f = gw / lw;
#pragma unroll
        for (int i = 0; i < 16; ++i) { oa[0][i] += f * ow[0][i]; oa[1][i] += f * ow[1][i]; }
        { const bf16_t* ap = T.ATT + (size_t)tq * 1024 + 256 + h8 * 64;
#pragma unroll
          for (int dh = 0; dh < 2; ++dh)
#pragma unroll
              for (int g4 = 0; g4 < 4; ++g4) { const u32x2 w = *(const u32x2*)(ap + 32 * dh + 8 * g4 + 4 * hi); oa[dh][4 * g4] += bflo(w.x); oa[dh][4 * g4 + 1] += bfhi(w.x); oa[dh][4 * g4 + 2] += bflo(w.y); oa[dh][4 * g4 + 3] += bfhi(w.y); } }
        store_ot(T.ATT + (size_t)tq * 1024 + 256 + h8 * 64, oa, hi);
    }
    __syncthreads();
    TP_END(6, T.tp);
}
}
constexpr int S = 16384, DM = 1024, NPROJ = 5632, INC = 5560, DFF = 2816, EFF = 3584, NEXP = 8;
constexpr int NWAVES = 8;
constexpr float EPS = 1e-6f;
constexpr float QK_SCALE64 = 0.125f * LOG2E;
constexpr float QK_SCALE96 = 0.10206207261596575f * LOG2E;
#ifndef MK_MULTI
#define MK_MULTI 0
#endif
constexpr int PC_SBQ = 0, PC_SBK = 256, PC_SBV = 512, PC_NQ = 768, PC_NKC = 1280, PC_NVC = 1408, PC_NKS = 1536, PC_NVS = 1664, PC_NKW = 1792, PC_NVW = 1920,
              PC_CQ = 2048, PC_CKV = 2304, PC_KR = 2432, PC_NG = 2464, PC_GATE = 2560;
__host__ __device__ __forceinline__ int win_oldcol(int c) {
    if (c < 2048) return c; if (c < 2464) return c + 24; if (c < 2488) return 2048 + (c - 2464); if (c < 2560) return -1; return c - 72; }

constexpr size_t MiB = 1u << 20;
constexpr size_t WS_CTL = 0, CTL_ZERO_BYTES = 1 * MiB;
constexpr size_t WS_LW = 1 * MiB, LW_STRIDE = 18 * MiB;
constexpr size_t LW_WIN = 0, LW_SBO = 11 * MiB, LW_NSAO = LW_SBO + MiB / 2, LW_MLAO = LW_NSAO + MiB, LW_WOUT = LW_MLAO + MiB / 2, LW_WUQ = LW_WOUT + 2 * MiB, LW_WUKV = LW_WUQ + MiB / 4, LW_CW1 = LW_WUKV + MiB / 4;
constexpr size_t WS_DGU = 37 * MiB, WS_DDN = 48 * MiB;
constexpr size_t WS_Y = 1 * MiB;
constexpr size_t WS_H = 74 * MiB;
constexpr size_t WS_ROPE = 106 * MiB;
constexpr size_t WS_LUT8 = 108 * MiB, WS_B1P = WS_LUT8 + 256 * 1024, WS_B1 = WS_LUT8 + 512 * 1024, WS_ROUTE = 109 * MiB, WS_ROWTOK = WS_ROUTE + 512 * 1024;
constexpr size_t WS_R1 = 110 * MiB;
constexpr size_t WS_MGU = WS_R1, WS_MDN = WS_R1 + 112 * MiB;
constexpr size_t WS_R2 = 296 * MiB;
constexpr size_t R2_KC = 0, R2_VC = R2_KC + 4 * MiB + MiB / 4, R2_KS = R2_VC + 4 * MiB + MiB / 4, R2_VTS = R2_KS + 4 * MiB, R2_KW = R2_VTS + 4 * MiB, R2_GN = R2_KW + 4 * MiB,
                 R2_QM = R2_GN + 2 * MiB, R2_KM = R2_QM + 12 * MiB, R2_HID = R2_KM + 12 * MiB, R2_KCMP = R2_HID + 2 * MiB, R2_VCMP = R2_KCMP + MiB / 4, R2_ATT = R2_VCMP + MiB / 4 + MiB / 2,
                 R2_MRG = R2_ATT + 32 * MiB, R2_QRAW = R2_MRG, R2_KVRAW = R2_MRG + 16 * MiB, R2_END = R2_MRG + 32 * MiB;
static_assert(R2_END <= 136 * MiB, "attention scratch");
constexpr size_t WS_END = 432 * MiB;
constexpr int KC_ROWS = S + 32;
constexpr int CW_TMO = 0, CW_BAR = 4096, CW_MOECNT = 16384, CW_NSAQ = 17408;
constexpr int RING_BYTES = 131072, LDSCTL_OFF = RING_BYTES, MISC_OFF = LDSCTL_OFF + 320, LDS_BYTES = 147456;


#define LDS_WAIT() asm volatile("s_waitcnt lgkmcnt(0)" ::: "memory")
#define VM_WAIT() asm volatile("s_waitcnt vmcnt(0)" ::: "memory")
DI float wave_sum(float v) { v += sx<1>(v); v += sx<2>(v); v += sx<4>(v); v += sx<8>(v); v += sx<16>(v); return sum32sym(v); }

struct TrSrc { const float* a; const float* b; int ldn; int nsrc; int mode; };
DI f32x4 tr_fetch4(const TrSrc& s, int k, int n) {
    const f32x4 z = {0.f, 0.f, 0.f, 0.f};
    if (s.mode == 0) return n < s.nsrc ? *(const f32x4*)(s.a + (size_t)k * s.ldn + n) : z;
    if (s.mode == 1) { const int oc = win_oldcol(n); return oc >= 0 ? *(const f32x4*)(s.a + (size_t)k * s.ldn + oc) : z; }
    const int tile = n >> 8, w = n & 255; const long d = (w < 128) ? 0l : (long)((const char*)s.b - (const char*)s.a);
    return *(const f32x4*)((const float*)((const char*)s.a + d) + (size_t)k * s.ldn + 128 * tile + (w & 127));
}
DI void tr_load(const TrSrc& s, int kb, int nb, int lane, f32x4 (&v)[8]) {
    const int k0 = 64 * kb, n0 = 32 * nb, r8 = lane >> 3, n4 = (lane & 7) * 4;
#pragma unroll
    for (int i = 0; i < 8; ++i) v[i] = tr_fetch4(s, k0 + r8 + 8 * i, n0 + n4);
}
DI void tr_store(const f32x4 (&v)[8], int K, bf16_t* WT, LAS float* scr, int kb, int nb, int lane) {
    const int k0 = 64 * kb, n0 = 32 * nb, r8 = lane >> 3, n4 = (lane & 7) * 4;
#pragma unroll
    for (int i = 0; i < 8; ++i) { LAS float* d = scr + (r8 + 8 * i) * 33 + n4; d[0] = v[i].x; d[1] = v[i].y; d[2] = v[i].z; d[3] = v[i].w; }
    LDS_WAIT(); asm volatile("" ::: "memory");
    const int c = lane & 7;
#pragma unroll
    for (int j = 0; j < 4; ++j) { const int n = (lane >> 3) + 8 * j; const LAS float* p = scr + (8 * c) * 33 + n;
        u32x4 o; o.x = cvtpk(p[0 * 33], p[1 * 33]); o.y = cvtpk(p[2 * 33], p[3 * 33]); o.z = cvtpk(p[4 * 33], p[5 * 33]); o.w = cvtpk(p[6 * 33], p[7 * 33]);
        *(u32x4*)(WT + (size_t)(n0 + n) * K + k0 + 8 * c) = o; }
    LDS_WAIT(); asm volatile("" ::: "memory");
}
DI void tr_item(const TrSrc& s, int K, bf16_t* WT, LAS float* scr, int kb, int nb, int lane) { f32x4 v[8]; tr_load(s, kb, nb, lane, v); tr_store(v, K, WT, scr, kb, nb, lane); }
DI void tr_matrix(const TrSrc& s, int K, int ndst, bf16_t* WT, LAS float* scr, int gw, int ngw, int lane, int& off) {
    const int nblk = ndst / 32, nitems = (K / 64) * nblk;
    int st = gw - off; if (st < 0) st += ngw;
    if (st < nitems) { f32x4 v[8], w[8]; tr_load(s, st / nblk, st % nblk, lane, v);
        for (int it = st; it < nitems; it += ngw) { const int nx = it + ngw; if (nx < nitems) tr_load(s, nx / nblk, nx % nblk, lane, w);
            tr_store(v, K, WT, scr, it / nblk, it % nblk, lane);
#pragma unroll
            for (int i = 0; i < 8; ++i) v[i] = w[i]; } }
    off = (off + nitems) % ngw;
}

DI void tr_batch(const float* a, const float* b, size_t sstride, int ldn, int nsrc, int mode, int K, int ndst, bf16_t* WT, size_t dstride, int nexp, LAS float* scr, int gw, int ngw, int lane, int& off) {
    const int nblk = ndst / 32, per = (K / 64) * nblk, nitems = nexp * per;
    int st = gw - off; if (st < 0) st += ngw;
    if (st < nitems) { f32x4 v[8], w[8];
        { const int e = st / per, r = st % per; tr_load(TrSrc{a + (size_t)e * sstride, b ? b + (size_t)e * sstride : nullptr, ldn, nsrc, mode}, r / nblk, r % nblk, lane, v); }
        for (int it = st; it < nitems; it += ngw) { const int nx = it + ngw;
            if (nx < nitems) { const int e = nx / per, r = nx % per; tr_load(TrSrc{a + (size_t)e * sstride, b ? b + (size_t)e * sstride : nullptr, ldn, nsrc, mode}, r / nblk, r % nblk, lane, w); }
            { const int e = it / per, r = it % per; tr_store(v, K, WT + (size_t)e * dstride, scr, r / nblk, r % nblk, lane); }
#pragma unroll
            for (int i = 0; i < 8; ++i) v[i] = w[i]; } }
    off = (off + nitems) % ngw;
}

struct In {
    const float *x, *bias_table, *mix_norm, *w_in, *b_gate, *sb_w_o, *nsa_q_norm, *nsa_k_norm, *nsa_cmp_pos, *nsa_cmp_w1, *nsa_cmp_w2, *nsa_w_o, *mla_q_a_norm, *mla_kv_a_norm,
        *mla_w_uq, *mla_w_ukv, *mla_q_norm, *mla_k_norm, *mla_w_o, *w_out, *ffn_norm, *dense_w_gate, *dense_w_up, *dense_w_down, *moe_router, *moe_w_gate, *moe_w_up, *moe_w_down;
};
struct Args { In in; float* out; unsigned char* ws; int ph_lo, ph_hi; };

DI void rms_row(const float* xrow, const float* gain, bf16_t* orow, int lane, f32x4 (&v)[4]) {
    const f32x4* xr = (const f32x4*)xrow + lane; float s = 0.f;
#pragma unroll
    for (int j = 0; j < 4; ++j) { v[j] = xr[64 * j]; s += (v[j].x * v[j].x + v[j].y * v[j].y) + (v[j].z * v[j].z + v[j].w * v[j].w); }
    const float rstd = 1.f / sqrtf(wave_sum(s) * (1.f / 1024.f) + EPS);
    u32x2* o8 = (u32x2*)orow + lane;
#pragma unroll
    for (int j = 0; j < 4; ++j) { const f32x4 g = ((const f32x4*)gain)[lane + 64 * j]; v[j] = v[j] * rstd * g; u32x2 w; w.x = cvtpk(v[j].x, v[j].y); w.y = cvtpk(v[j].z, v[j].w); o8[64 * j] = w; }
}

DI int t5_bucket(int n) {
    if (n < 16) return n;
    int b = 16;
    b += n >= 21; b += n >= 27; b += n >= 35; b += n >= 46; b += n >= 59; b += n >= 77; b += n >= 99; b += n >= 128; b += n >= 166; b += n >= 216; b += n >= 280; b += n >= 363; b += n >= 470; b += n >= 609; b += n >= 790;
    return b;
}

struct MoeTab { int cnt[8]; int tb[9]; };
struct MoeGU {
    const volatile LAS int* tab; const bf16_t* Hb; const bf16_t* W; const int* rowtok; int t_lo, t_hi, G, c;
    DI bool next(int i, pg8::Unit& u) const {
        const int nrt = t_hi - t_lo; if (nrt <= 0) return false;
        const long L = (long)i * G + c; if (L >= (long)nrt * 28) return false;
        const int rt = t_lo + (int)(L % nrt), pn = (int)(L / nrt);
        int e = 0;
#pragma unroll
        for (int k = 1; k < 8; ++k) e += (tab[8 + k] <= rt) ? 1 : 0;
        const int j = rt - tab[8 + e], cnt = tab[e];
        u.a = Hb; u.b = W + ((size_t)e * 7168 + 256 * pn) * 1024; u.rows = rowtok + e * S + 256 * j; u.nvalid = (cnt - 256 * j) < 256 ? (cnt - 256 * j) : 256; u.pm = rt - t_lo; u.pn = pn; return true;
    }
};
struct MoeDN {
    const volatile LAS int* tab; const bf16_t* ACT; const bf16_t* W; int t_lo, t_hi, G, c;
    DI bool next(int i, pg8::Unit& u) const {
        const int nrt = t_hi - t_lo; if (nrt <= 0) return false;
        const long L = (long)i * G + c; if (L >= (long)nrt * 4) return false;
        const int rt = t_lo + (int)(L % nrt), pn = (int)(L / nrt);
        int e = 0;
#pragma unroll
        for (int k = 1; k < 8; ++k) e += (tab[8 + k] <= rt) ? 1 : 0;
        u.a = ACT + (size_t)(rt - t_lo) * 256 * EFF; u.b = W + ((size_t)e * 1024 + 256 * pn) * EFF; u.rows = nullptr; u.nvalid = 256; u.pm = rt; u.pn = pn; return true;
    }
};
constexpr int PH_PER_LAYER = 16, NPHASES = 1 + 2 * PH_PER_LAYER;
__global__ void __launch_bounds__(NWAVES * 64, 2) fwd_kernel(Args args) {
    extern __shared__ __attribute__((aligned(16))) unsigned char lds_raw[];
    LAS unsigned char* lds = (LAS unsigned char*)lds_raw;
    volatile LAS unsigned* MISC = (volatile LAS unsigned*)(lds + MISC_OFF);
    volatile LAS int* MTAB = (volatile LAS int*)(lds + MISC_OFF + 64);
    const int tid0 = threadIdx.x, wave = __builtin_amdgcn_readfirstlane(tid0 >> 6);
    const int G = gridDim.x, bid = blockIdx.x, vcu = (G % 8 == 0) ? (bid % 8) * (G / 8) + bid / 8 : bid;
    const int gw0 = vcu * NWAVES + wave, NGW = G * NWAVES;
    unsigned char* ws = args.ws; const In in = args.in;
    gu32* ctl = (gu32*)(ws + WS_CTL);
    for (int u = tid0; u < (LDS_BYTES - LDSCTL_OFF) / 4; u += NWAVES * 64) ((LAS unsigned*)(lds + LDSCTL_OFF))[u] = 0u;
    __syncthreads();
#if MK_MULTI
#define GRID_BAR() do { } while (0)
#else
    XcdBarrier bar = xcd_barrier_post((unsigned*)(ctl + CW_BAR), MISC + 8);
#define TPCTR ((unsigned long long*)(ctl + 20480))
#define GRID_BAR() do { TP_BEGIN(9) xcd_barrier(bar); TP_END(9, TPCTR); } while (0)
#endif
    const int lo = args.ph_lo, hi = args.ph_hi;
#ifndef ONLY_PHASE
#define ONLY_PHASE -1
#endif
#ifndef PHMASK
#define PHMASK 0x1ffff
#endif
#define PHON(n) ((ONLY_PHASE < 0 || ONLY_PHASE == (n)) && ((PHMASK >> ((n) == 99 ? 16 : (n))) & 1))
#ifndef REPMASK
#define REPMASK 0
#endif
#ifndef GREP
#define GREP 0
#endif
#define REPN(n) (((REPMASK >> ((n) == 99 ? 16 : (n))) & 1) ? 2 : 1)
#define IN(k) (lo <= (k) && (k) < hi)
#define SEAM(k) do { if (IN((k) + 1)) { unsigned long long tq0_ = 0; const bool tpk_ = (TPROBE >= 100) && (TPROBE - 100 == ((k) == 0 ? 16 : ((k) - 1) % 16)); if (tpk_) tq0_ = tp_now(); GRID_BAR(); if (tpk_ && lane_id() == 0) atomicAdd(TPCTR, tp_now() - tq0_); } } while (0)
#define PHASE_LOCALS int tid = wave * 64 + lane_id(); asm volatile("" : "+v"(tid)); const int lane = tid & 63; int gw = gw0; asm volatile("" : "+s"(gw)); unsigned char* wsl = ws; asm volatile("" : "+s"(wsl)); (void)lane; (void)gw; (void)wsl;

#define lw (wsl + WS_LW + (size_t)l * LW_STRIDE)
#define Hb ((bf16_t*)(wsl + WS_H))
#define PROJ ((bf16_t*)(wsl + WS_R1))
#define R2P(off) (wsl + WS_R2 + (off))
#define KC ((bf16_t*)R2P(R2_KC))
#define VC ((bf16_t*)R2P(R2_VC))
#define KS ((bf16_t*)R2P(R2_KS))
#define VTS ((bf16_t*)R2P(R2_VTS))
#define KW ((bf16_t*)R2P(R2_KW))
#define GN ((float*)R2P(R2_GN))
#define QM ((bf16_t*)R2P(R2_QM))
#define KM ((bf16_t*)R2P(R2_KM))
#define HID ((bf16_t*)R2P(R2_HID))
#define KCMP ((bf16_t*)R2P(R2_KCMP))
#define VCMP ((bf16_t*)R2P(R2_VCMP))
#define ATT ((bf16_t*)R2P(R2_ATT))
#define MRG ((bf16_t*)R2P(R2_MRG))
#define QRAW ((bf16_t*)R2P(R2_QRAW))
#define KVRAW ((bf16_t*)R2P(R2_KVRAW))
#define ROPE ((float*)(wsl + WS_ROPE))
#define LUT8 ((float*)(wsl + WS_LUT8))
#define B1P ((float*)(wsl + WS_B1P))
#define B1 ((float*)(wsl + WS_B1))
#define CONS (B1 + 2048)
#define ROUTE ((int*)(wsl + WS_ROUTE))
#define ROWTOK ((int*)(wsl + WS_ROWTOK))
    LAS float* scr = (LAS float*)(lds + wave * 16384);

    if (PHON(99) && IN(0)) { PHASE_LOCALS TP_BEGIN(36) for (int rep_ = 0; rep_ < REPN(99); ++rep_) {
        int troff = 0;
        for (int l = 0; l < 2; ++l) {
            tr_matrix(TrSrc{in.w_in + (size_t)l * 1024 * INC, nullptr, INC, INC, 1}, 1024, NPROJ, (bf16_t*)(lw + LW_WIN), scr, gw, NGW, lane, troff);
            tr_matrix(TrSrc{in.sb_w_o + (size_t)l * 256 * 1024, nullptr, 1024, 1024, 0}, 256, 1024, (bf16_t*)(lw + LW_SBO), scr, gw, NGW, lane, troff);
            tr_matrix(TrSrc{in.nsa_w_o + (size_t)l * 512 * 1024, nullptr, 1024, 1024, 0}, 512, 1024, (bf16_t*)(lw + LW_NSAO), scr, gw, NGW, lane, troff);
            tr_matrix(TrSrc{in.mla_w_o + (size_t)l * 256 * 1024, nullptr, 1024, 1024, 0}, 256, 1024, (bf16_t*)(lw + LW_MLAO), scr, gw, NGW, lane, troff);
            tr_matrix(TrSrc{in.w_out + (size_t)l * 1024 * 1024, nullptr, 1024, 1024, 0}, 1024, 1024, (bf16_t*)(lw + LW_WOUT), scr, gw, NGW, lane, troff);
            tr_matrix(TrSrc{in.mla_w_uq + (size_t)l * 256 * 384, nullptr, 384, 384, 0}, 256, 512, (bf16_t*)(lw + LW_WUQ), scr, gw, NGW, lane, troff);
            tr_matrix(TrSrc{in.mla_w_ukv + (size_t)l * 128 * 512, nullptr, 512, 512, 0}, 128, 512, (bf16_t*)(lw + LW_WUKV), scr, gw, NGW, lane, troff);
            for (int kv = 0; kv < 2; ++kv)
                tr_matrix(TrSrc{in.nsa_cmp_w1 + (size_t)(l * 2 + kv) * 2048 * 256, nullptr, 256, 256, 0}, 2048, 256, (bf16_t*)(lw + LW_CW1) + (size_t)kv * 256 * 2048, scr, gw, NGW, lane, troff);
        }
        tr_matrix(TrSrc{in.dense_w_gate, in.dense_w_up, DFF, DFF, 2}, 1024, 2 * DFF, (bf16_t*)(wsl + WS_DGU), scr, gw, NGW, lane, troff);
        tr_matrix(TrSrc{in.dense_w_down, nullptr, 1024, 1024, 0}, DFF, 1024, (bf16_t*)(wsl + WS_DDN), scr, gw, NGW, lane, troff);
        const int gt = vcu * 512 + tid, NT = G * 512;
        for (int i = gt; i < S * 16; i += NT) {
            const int pos = i >> 4, fi = i & 15; const float inv = powf(10000.f, -(float)fi / 16.f); const float ang = (float)pos * inv;
            const double rev = (double)ang * 0.15915494309189535; const float fr = (float)(rev - rint(rev));
            ROPE[i] = __builtin_amdgcn_cosf(fr); ROPE[S * 16 + i] = __builtin_amdgcn_sinf(fr); }
        for (int i = gt; i < 1024 * 8; i += NT) LUT8[i] = in.bias_table[t5_bucket(i >> 3) * 8 + (i & 7)] * LOG2E;
        if (gw == 0) {
            float bm = 0.f; for (int i = lane; i < 256; i += 64) bm = fmaxf(bm, fabsf(in.bias_table[i]));
            bm = fmaxf(bm, sx<1>(bm)); bm = fmaxf(bm, sx<2>(bm)); bm = fmaxf(bm, sx<4>(bm)); bm = fmaxf(bm, sx<8>(bm)); bm = fmaxf(bm, sx<16>(bm)); bm = fmaxf(bm, sx32(bm, lane >> 5));
            if (lane == 0) CONS[0] = bm * LOG2E;
            for (int ll = 0; ll < 2; ++ll) { float gm = 0.f; for (int i = lane; i < 192; i += 64) gm = fmaxf(gm, fabsf(in.nsa_k_norm[ll * 192 + i]));
                gm = fmaxf(gm, sx<1>(gm)); gm = fmaxf(gm, sx<2>(gm)); gm = fmaxf(gm, sx<4>(gm)); gm = fmaxf(gm, sx<8>(gm)); gm = fmaxf(gm, sx<16>(gm)); gm = fmaxf(gm, sx32(gm, lane >> 5));
                if (lane == 0) CONS[1 + ll] = gm;
                float km = 0.f; for (int i = lane; i < 96; i += 64) km = fmaxf(km, fabsf(in.mla_k_norm[ll * 96 + i]));
                km = fmaxf(km, sx<1>(km)); km = fmaxf(km, sx<2>(km)); km = fmaxf(km, sx<4>(km)); km = fmaxf(km, sx<8>(km)); km = fmaxf(km, sx<16>(km)); km = fmaxf(km, sx32(km, lane >> 5));
                if (lane == 0) CONS[3 + ll] = km; }
        }
        for (int it = gw; it < 512; it += NGW) {
            const int kc = it & 31, cb = (it >> 5) & 3, lk = it >> 7; const float* pos = in.nsa_cmp_pos + (size_t)lk * 2048; const float* w1 = in.nsa_cmp_w1 + (size_t)lk * 2048 * 256;
            float a = 0.f; for (int k = 64 * kc; k < 64 * kc + 64; ++k) a += pos[k] * w1[(size_t)k * 256 + 64 * cb + lane];
            B1P[(lk * 32 + kc) * 256 + 64 * cb + lane] = a; }
        for (int i = gt; i < 2 * 2 * 32 * 64 / 8; i += NT) { const int z = i / 256, r = i % 256; bf16_t* p = (z >> 1 ? VC : KC) + ((size_t)(z & 1) * KC_ROWS + S) * 64 + r * 8; *(u32x4*)p = (u32x4){0u, 0u, 0u, 0u}; }
        for (int m = gw; m < S; m += NGW) { f32x4 v[4]; rms_row(in.x + (size_t)m * 1024, in.mix_norm, Hb + (size_t)m * 1024, lane, v); }
            }
            TP_END(36, TPCTR);
        SEAM(0);
    }

    for (int l = 0; l < 2; ++l) {
        const int pb = 1 + PH_PER_LAYER * l;
        const float* x_in = (l == 0) ? in.x : args.out; float* x_out = args.out;
        if (l > 0 && PHON(0) && IN(pb + 0)) { PHASE_LOCALS TP_BEGIN(20) for (int rep_ = 0; rep_ < REPN(0); ++rep_) {
            for (int m = gw; m < S; m += NGW) { f32x4 v[4]; rms_row(x_in + (size_t)m * 1024, in.mix_norm + l * 1024, Hb + (size_t)m * 1024, lane, v); }
            }
            TP_END(20, TPCTR);
            SEAM(pb + 0);
        }
        if (PHON(1) && IN(pb + 1)) { PHASE_LOCALS TP_BEGIN(21) for (int rep_ = 0; rep_ < REPN(1); ++rep_) {
            pg8::StaticOrder So; So.init(Hb, (const bf16_t*)(lw + LW_WIN), 1024, 1024, S, NPROJ, G, bid);
            pg8::EpiStore E{PROJ, NPROJ, nullptr, QK_SCALE64, 0};
            pg8::gemm_phase<pg8::EpiStore, pg8::StaticOrder, true, false>(lds, 1024, 1024, 1024, So, E, wave);
#if GREP & 1
            pg8::gemm_phase<pg8::EpiStore, pg8::StaticOrder, true, false>(lds, 1024, 1024, 1024, So, E, wave);
#endif
            }
            TP_END(21, TPCTR);
            SEAM(pb + 1);
        }
        if (PHON(2) && IN(pb + 2)) { PHASE_LOCALS TP_BEGIN(22) for (int rep_ = 0; rep_ < REPN(2); ++rep_) {
            if (l == 0 && bid == 0) for (int i = tid; i < 1024; i += 512) { float a = 0.f; for (int kc = 0; kc < 32; ++kc) a += B1P[((i >> 8) * 32 + kc) * 256 + (i & 255)]; B1[i] = a; }
            for (int t = gw; t < S; t += NGW) {
                bf16_t* pr = PROJ + (size_t)t * NPROJ;
                {
                    const u32x4 w = *(const u32x4*)(pr + PC_NQ + lane * 8); float v[8] = {bflo(w.x), bfhi(w.x), bflo(w.y), bfhi(w.y), bflo(w.z), bfhi(w.z), bflo(w.w), bfhi(w.w)};
                    float ss = 0.f;
#pragma unroll
                    for (int e = 0; e < 8; ++e) ss += v[e] * v[e];
                    ss += sx<1>(ss); ss += sx<2>(ss); ss += sx<4>(ss);
                    const float rs = QK_SCALE64 / sqrtf(ss * (1.f / 64.f) + EPS); const float* gq = in.nsa_q_norm + l * 64 + 8 * (lane & 7);
                    u32x4 o; o.x = cvtpk(v[0] * rs * gq[0], v[1] * rs * gq[1]); o.y = cvtpk(v[2] * rs * gq[2], v[3] * rs * gq[3]); o.z = cvtpk(v[4] * rs * gq[4], v[5] * rs * gq[5]); o.w = cvtpk(v[6] * rs * gq[6], v[7] * rs * gq[7]);
                    *(u32x4*)(pr + PC_NQ + lane * 8) = o;
                }
                {
                    const int sec = lane >> 4, gg = (lane >> 3) & 1, d8 = 8 * (lane & 7);
                    const int col = (sec == 0 ? PC_NKS : sec == 1 ? PC_NKW : sec == 2 ? PC_NKC : PC_NVC) + (lane & 15) * 8;
                    const u32x4 w = *(const u32x4*)(pr + col); float v[8] = {bflo(w.x), bfhi(w.x), bflo(w.y), bfhi(w.y), bflo(w.z), bfhi(w.z), bflo(w.w), bfhi(w.w)};
                    float ss = 0.f;
#pragma unroll
                    for (int e = 0; e < 8; ++e) ss += v[e] * v[e];
                    ss += sx<1>(ss); ss += sx<2>(ss); ss += sx<4>(ss);
                    const float rs = 1.f / sqrtf(ss * (1.f / 64.f) + EPS);
                    u32x4 o = w;
                    if (sec < 2) { const float* gk = in.nsa_k_norm + (l * 3 + 1 + sec) * 64 + d8;
                        o.x = cvtpk(v[0] * rs * gk[0], v[1] * rs * gk[1]); o.y = cvtpk(v[2] * rs * gk[2], v[3] * rs * gk[3]); o.z = cvtpk(v[4] * rs * gk[4], v[5] * rs * gk[5]); o.w = cvtpk(v[6] * rs * gk[6], v[7] * rs * gk[7]); }
                    const int c8 = lane & 7; const size_t ksf = ((((size_t)(gg * 256 + (t >> 6)) * 2 + ((t >> 5) & 1)) * 4 + (c8 >> 1)) * 64 + (c8 & 1) * 32 + (t & 31)) * 8;
                    bf16_t* dst = (sec == 0 ? KS + ksf : (sec == 1 ? KW + ((size_t)gg * S + t) * 64 : sec == 2 ? KC + ((size_t)gg * KC_ROWS + t) * 64 : VC + ((size_t)gg * KC_ROWS + t) * 64) + d8);
                    *(u32x4*)dst = o;
                }
                {
                    const u32x2 w = *(const u32x2*)(pr + PC_CQ + lane * 4); float v[4] = {bflo(w.x), bfhi(w.x), bflo(w.y), bfhi(w.y)};
                    const float rs = 1.f / sqrtf(wave_sum((v[0] * v[0] + v[1] * v[1]) + (v[2] * v[2] + v[3] * v[3])) * (1.f / 256.f) + EPS); const float* ga = in.mla_q_a_norm + l * 256 + lane * 4;
                    u32x2 o; o.x = cvtpk(v[0] * rs * ga[0], v[1] * rs * ga[1]); o.y = cvtpk(v[2] * rs * ga[2], v[3] * rs * ga[3]); *(u32x2*)(pr + PC_CQ + lane * 4) = o;
                    const unsigned w2 = *(const unsigned*)(pr + PC_CKV + lane * 2); const float a = bflo(w2), b = bfhi(w2);
                    const float rs2 = 1.f / sqrtf(wave_sum(a * a + b * b) * (1.f / 128.f) + EPS); const float* gb = in.mla_kv_a_norm + l * 128 + lane * 2;
                    *(unsigned*)(pr + PC_CKV + lane * 2) = cvtpk(a * rs2 * gb[0], b * rs2 * gb[1]);
                }
                if (lane < 24) GN[(size_t)t * 24 + lane] = sigmoidf_(bf2f(pr[PC_NG + lane]));
            }
            for (int it = gw; it < 512; it += NGW) {
                const int gg = it >> 8, blk = it & 255; const bf16_t* src = PROJ + (size_t)(blk * 64) * NPROJ + PC_NVS + gg * 64 + lane; bf16_t* dstb = VTS + (size_t)(gg * 256 + blk) * 4096;
                for (int s8 = 0; s8 < 8; ++s8) { unsigned short e[8];
#pragma unroll
                    for (int j = 0; j < 8; ++j) { const int k = att::vts_key_of_slot(8 * s8 + j); e[j] = src[(size_t)k * NPROJ]; }
                    u32x4 o; o.x = e[0] | ((unsigned)e[1] << 16); o.y = e[2] | ((unsigned)e[3] << 16); o.z = e[4] | ((unsigned)e[5] << 16); o.w = e[6] | ((unsigned)e[7] << 16);
                    const int hh = s8 >> 2, ss = (s8 >> 1) & 1, h = s8 & 1;
                    *(u32x4*)(dstb + ((((hh * 2 + (lane >> 5)) * 2 + ss) * 64) + h * 32 + (lane & 31)) * 8) = o; }
            }
            }
            TP_END(22, TPCTR);
            SEAM(pb + 2);
        }
        if (PHON(3) && IN(pb + 3)) { PHASE_LOCALS TP_BEGIN(23) for (int rep_ = 0; rep_ < REPN(3); ++rep_) {
            const bool wide = (G >= 256);
            for (int job = 0; job < 2; ++job) {
                pg8::StaticOrder So; pg8::EpiStore E; int lda, ldb, K;
                if (job == 0) { lda = NPROJ; ldb = 256; K = 256; So.init(PROJ + PC_CQ, (const bf16_t*)(lw + LW_WUQ), lda, ldb, S, 512, wide ? 128 : G, wide ? (bid < 128 ? bid : -1) : bid); E = pg8::EpiStore{QRAW, 512, nullptr, 1.f, 0}; }
                else { lda = NPROJ; ldb = 128; K = 128; So.init(PROJ + PC_CKV, (const bf16_t*)(lw + LW_WUKV), lda, ldb, S, 512, wide ? 128 : G, wide ? (bid >= 128 && bid < 256 ? bid - 128 : -1) : bid); E = pg8::EpiStore{KVRAW, 512, nullptr, 1.f, 0}; }
                pg8::gemm_phase<pg8::EpiStore, pg8::StaticOrder, true, false>(lds, lda, ldb, K, So, E, wave);
#if GREP & 16
                pg8::gemm_phase<pg8::EpiStore, pg8::StaticOrder, true, false>(lds, lda, ldb, K, So, E, wave);
#endif
            }
            for (int jz = 0; jz < 32; ++jz) {
                const int z = jz >> 3, ks = jz & 7, kv = z >> 1, gg = z & 1;
                pg8::StaticOrder So; So.init((kv ? VC : KC) + (size_t)gg * KC_ROWS * 64 + ks * 256, (const bf16_t*)(lw + LW_CW1) + (size_t)kv * 256 * 2048 + ks * 256, 1024, 2048, 1024, 256, wide ? 4 : G, wide ? ((bid >= 128 + 4 * jz && bid < 132 + 4 * jz) ? bid - 128 - 4 * jz : -1) : bid);
                pg8::EpiF32 E{(float*)ATT + (size_t)jz * 1024 * 256, 256};
                pg8::gemm_phase<pg8::EpiF32, pg8::StaticOrder, true, false>(lds, 1024, 2048, 256, So, E, wave);
            }
            }
            TP_END(23, TPCTR);
            SEAM(pb + 3);
        }
        if (PHON(4) && IN(pb + 4)) { PHASE_LOCALS TP_BEGIN(24) for (int rep_ = 0; rep_ < REPN(4); ++rep_) {
            const int kvb = (2 * vcu >= G) ? 1 : 0;
            { const float* w2g = in.nsa_cmp_w2 + (size_t)(l * 2 + kvb) * 256 * 64; LAS f32x4* w2l = (LAS f32x4*)lds;
#pragma unroll
              for (int i = 0; i < 8; ++i) w2l[tid + 512 * i] = *(const f32x4*)(w2g + (size_t)(tid + 512 * i) * 4); }
            __syncthreads();
            LAS unsigned short* ws16 = (LAS unsigned short*)(lds + 65536 + wave * 4096);
            for (int t = gw; t < S; t += NGW) {
                if (lane < 48) *(LAS u32x4*)(ws16 + 8 * lane) = *(const u32x4*)(QRAW + (size_t)t * 512 + 8 * lane);
                if (lane < 32) *(LAS u32x4*)(ws16 + 384 + (lane >> 3) * 96 + (lane & 7) * 8) = *(const u32x4*)(KVRAW + (size_t)t * 512 + (lane >> 3) * 128 + (lane & 7) * 8);
                else if (lane < 48) { const int hh_ = (lane - 32) >> 2, c_ = lane & 3; *(LAS u32x4*)(ws16 + 384 + hh_ * 96 + 64 + c_ * 8) = *(const u32x4*)(PROJ + (size_t)t * NPROJ + PC_KR + c_ * 8); }
                LDS_WAIT(); asm volatile("" ::: "memory");
                const int hd = lane >> 4, i = lane & 15; const float c = ROPE[t * 16 + i], s = ROPE[S * 16 + t * 16 + i];
                {   LAS unsigned short* src = ws16 + hd * 96 + i; float v[6]; float ss = 0.f;
#pragma unroll
                    for (int e = 0; e < 6; ++e) { v[e] = bf2f(src[16 * e]); ss += v[e] * v[e]; }
                    ss += sx<1>(ss); ss += sx<2>(ss); ss += sx<4>(ss); ss += sx<8>(ss);
                    const float rs = 1.f / sqrtf(ss * (1.f / 96.f) + EPS); const float* gq = in.mla_q_norm + l * 96 + i;
#pragma unroll
                    for (int e = 0; e < 6; ++e) v[e] = v[e] * rs * gq[16 * e];
                    const float x1 = v[4], x2 = v[5]; v[4] = x1 * c - x2 * s; v[5] = x2 * c + x1 * s;
#pragma unroll
                    for (int e = 0; e < 6; ++e) src[16 * e] = f2bf(v[e] * QK_SCALE96); }
                {   LAS unsigned short* src = ws16 + 384 + hd * 96 + i; float v[6]; float ss = 0.f;
#pragma unroll
                    for (int e = 0; e < 6; ++e) { v[e] = bf2f(src[16 * e]); ss += v[e] * v[e]; }
                    ss += sx<1>(ss); ss += sx<2>(ss); ss += sx<4>(ss); ss += sx<8>(ss);
                    const float rs = 1.f / sqrtf(ss * (1.f / 96.f) + EPS); const float* gk = in.mla_k_norm + l * 96 + i;
#pragma unroll
                    for (int e = 0; e < 6; ++e) v[e] = v[e] * rs * gk[16 * e];
                    const float x1 = v[4], x2 = v[5]; v[4] = x1 * c - x2 * s; v[5] = x2 * c + x1 * s;
#pragma unroll
                    for (int e = 0; e < 6; ++e) src[16 * e] = f2bf(v[e]); }
                LDS_WAIT(); asm volatile("" ::: "memory");
                if (lane < 48) { *(u32x4*)(QM + (size_t)t * 384 + 8 * lane) = *(const LAS u32x4*)(ws16 + 8 * lane); *(u32x4*)(KM + (size_t)t * 384 + 8 * lane) = *(const LAS u32x4*)(ws16 + 384 + 8 * lane); }
                LDS_WAIT(); asm volatile("" ::: "memory");
            }
            {
                LAS float* hs = (LAS float*)(lds + 65536 + wave * 4096); const LAS float* w2l = (const LAS float*)lds;
                const int hw = (kvb ? vcu - G / 2 : vcu) * NWAVES + wave, nhw = (kvb ? G - G / 2 : G / 2) * NWAVES;
                for (int it = hw; it < 2048; it += nhw) {
                    const int gg = it >> 10, n = it & 1023, z = kvb * 2 + gg;
                    { f32x4 hsum = *(const f32x4*)(B1 + (l * 2 + kvb) * 256 + lane * 4);
#pragma unroll
                      for (int ks = 0; ks < 8; ++ks) hsum += *(const f32x4*)((const float*)ATT + ((size_t)(z * 8 + ks) * 1024 + n) * 256 + lane * 4);
                      *(LAS f32x4*)(hs + lane * 4) = (f32x4){siluf_(hsum.x), siluf_(hsum.y), siluf_(hsum.z), siluf_(hsum.w)}; }
                    LDS_WAIT(); asm volatile("" ::: "memory");
                    float a0 = 0.f, a1 = 0.f, a2 = 0.f, a3 = 0.f;
#pragma unroll 4
                    for (int j = 0; j < 256; j += 4) { const f32x4 h4 = *(const LAS f32x4*)(hs + j);
                        a0 += h4.x * w2l[j * 64 + lane]; a1 += h4.y * w2l[(j + 1) * 64 + lane]; a2 += h4.z * w2l[(j + 2) * 64 + lane]; a3 += h4.w * w2l[(j + 3) * 64 + lane]; }
                    const float a = (a0 + a1) + (a2 + a3);
                    if (kvb == 0) { const float rs = 1.f / sqrtf(wave_sum(a * a) * (1.f / 64.f) + EPS); KCMP[((size_t)gg * 1024 + n) * 64 + lane] = f2bf(a * rs * in.nsa_k_norm[(l * 3) * 64 + lane]); }
                    else VCMP[((size_t)gg * 1024 + n) * 64 + lane] = f2bf(a);
                    LDS_WAIT(); asm volatile("" ::: "memory");
                }
            }
            __syncthreads();
            }
            TP_END(24, TPCTR);
            SEAM(pb + 4);
        }
        if (PHON(5) && IN(pb + 5)) { PHASE_LOCALS TP_BEGIN(25) for (int rep_ = 0; rep_ < REPN(5); ++rep_) {
            __syncthreads();
            for (int r2_ = 0; r2_ < REPN(17); ++r2_) for (int u = vcu; u < 256; u += G) att::sb_unit((LAS char*)lds, PROJ, ATT, u >> 6, u & 63, wave);
            for (int r2_ = 0; r2_ < REPN(18); ++r2_) for (int p = vcu; p < 256; p += G) { const float mkb = 9.9f * CONS[3 + l]; att::mla_unit((LAS char*)lds, QM, KM, KVRAW, ATT, p >> 6, 127 - (p & 63), mkb, wave, TPCTR); att::mla_unit((LAS char*)lds, QM, KM, KVRAW, ATT, p >> 6, p & 63, mkb, wave, TPCTR); }
            att::NsaT T{PROJ, KCMP, VCMP, KS, VTS, KW, GN, LUT8, ATT, 8.08f * CONS[1 + l], CONS[0], (unsigned long long*)(ctl + 20480)};
            for (int r2_ = 0; r2_ < REPN(19); ++r2_) { volatile LAS int* qslot = (volatile LAS int*)(lds + MISC_OFF + 192); const int qg = (2 * vcu >= G) ? 1 : 0;
                for (;;) { __syncthreads(); if (tid == 0) *qslot = (int)__hip_atomic_fetch_add(ctl + CW_NSAQ + 64 * (4 * l + 2 * r2_ + qg), 1u, RLX_AGENT); __syncthreads();
                    const int u = *qslot; if (u >= 256) break; att::nsa_unit((LAS char*)lds, T, qg, 255 - u, wave); } }
            }
            TP_END(25, TPCTR);
            SEAM(pb + 5);
        }
        if (PHON(6) && IN(pb + 6)) { PHASE_LOCALS TP_BEGIN(26) for (int rep_ = 0; rep_ < REPN(6); ++rep_) {
            for (int mix = 0; mix < 3; ++mix) {
                const int K = (mix == 1) ? 512 : 256; const int acol = (mix == 0) ? 0 : (mix == 1) ? 256 : 768;
                const bf16_t* Bt = (const bf16_t*)(lw + (mix == 0 ? LW_SBO : mix == 1 ? LW_NSAO : LW_MLAO));
                pg8::StaticOrder So; So.init(ATT + acol, Bt, 1024, K, S, 1024, G, bid);
                pg8::EpiGate E{MRG, PROJ + PC_GATE + mix * 1024, NPROJ, in.b_gate + l * 3072 + mix * 1024, mix == 0 ? 1 : 0};
                pg8::gemm_phase<pg8::EpiGate, pg8::StaticOrder, true, false>(lds, 1024, K, K, So, E, wave);
            }
            }
            TP_END(26, TPCTR);
            SEAM(pb + 6);
        }
        if (PHON(7) && IN(pb + 7)) { PHASE_LOCALS TP_BEGIN(27) for (int rep_ = 0; rep_ < REPN(7); ++rep_) {
            pg8::StaticOrder So; So.init(MRG, (const bf16_t*)(lw + LW_WOUT), 1024, 1024, S, 1024, G, bid);
            pg8::EpiResid E{x_in, x_out};
            pg8::gemm_phase<pg8::EpiResid, pg8::StaticOrder, true, false>(lds, 1024, 1024, 1024, So, E, wave);
            }
            TP_END(27, TPCTR);
            SEAM(pb + 7);
        }
        if (PHON(8) && IN(pb + 8)) { PHASE_LOCALS TP_BEGIN(28) for (int rep_ = 0; rep_ < REPN(8); ++rep_) {
            if (l == 1) {
                int troff = 0;
                tr_batch(in.moe_w_gate, in.moe_w_up, (size_t)1024 * EFF, EFF, EFF, 2, 1024, 2 * EFF, (bf16_t*)(wsl + WS_MGU), (size_t)7168 * 1024, 8, scr, gw, NGW, lane, troff);
                tr_batch(in.moe_w_down, nullptr, (size_t)EFF * 1024, 1024, 1024, 0, EFF, 1024, (bf16_t*)(wsl + WS_MDN), (size_t)1024 * EFF, 8, scr, gw, NGW, lane, troff);
            }
            for (int m = gw; m < S; m += NGW) {
                f32x4 v[4]; rms_row(x_out + (size_t)m * 1024, in.ffn_norm + l * 1024, Hb + (size_t)m * 1024, lane, v);
                if (l == 1) {
                    float lg[8];
#pragma unroll
                    for (int e = 0; e < 8; ++e) lg[e] = 0.f;
#pragma unroll
                    for (int j = 0; j < 4; ++j)
#pragma unroll
                        for (int q = 0; q < 4; ++q) { const float* wr = in.moe_router + (size_t)(4 * lane + 256 * j + q) * 8; const f32x4 wa = *(const f32x4*)wr, wb = *(const f32x4*)(wr + 4); const float hv = v[j][q];
                            lg[0] += hv * wa.x; lg[1] += hv * wa.y; lg[2] += hv * wa.z; lg[3] += hv * wa.w; lg[4] += hv * wb.x; lg[5] += hv * wb.y; lg[6] += hv * wb.z; lg[7] += hv * wb.w; }
#pragma unroll
                    for (int e = 0; e < 8; ++e) lg[e] = wave_sum(lg[e]);
                    int e0 = 0; float v0 = lg[0];
#pragma unroll
                    for (int e = 1; e < 8; ++e) if (lg[e] > v0) { v0 = lg[e]; e0 = e; }
                    int e1 = -1; float v1 = -INFINITY;
#pragma unroll
                    for (int e = 0; e < 8; ++e) if (e != e0 && lg[e] > v1) { v1 = lg[e]; e1 = e; }
                    if (lane == 0) { const float w0 = 1.f / (1.f + __expf(v1 - v0)), w1 = 1.f - w0;
                        const int p0 = (int)__hip_atomic_fetch_add(ctl + CW_MOECNT + 64 * e0, 1u, RLX_AGENT), p1 = (int)__hip_atomic_fetch_add(ctl + CW_MOECNT + 64 * e1, 1u, RLX_AGENT);
                        ROWTOK[e0 * S + p0] = m; ROWTOK[e1 * S + p1] = m;
                        int* r = ROUTE + (size_t)m * 8; r[0] = e0; r[1] = e1; r[2] = p0; r[3] = p1; r[4] = __float_as_int(w0); r[5] = __float_as_int(w1); }
                }
            }
            }
            TP_END(28, TPCTR);
            SEAM(pb + 8);
        }
        if (l == 0) {
#define ACT0 ((bf16_t*)(wsl + WS_R1))
            if (PHON(9) && IN(pb + 9)) { PHASE_LOCALS TP_BEGIN(29) for (int rep_ = 0; rep_ < REPN(9); ++rep_) {
                pg8::StaticOrder So; So.init(Hb, (const bf16_t*)(wsl + WS_DGU), 1024, 1024, S, 2 * DFF, G, bid);
                pg8::EpiSwiglu E{ACT0, DFF};
                pg8::gemm_phase<pg8::EpiSwiglu, pg8::StaticOrder, true, false>(lds, 1024, 1024, 1024, So, E, wave);
#if GREP & 2
                pg8::gemm_phase<pg8::EpiSwiglu, pg8::StaticOrder, true, false>(lds, 1024, 1024, 1024, So, E, wave);
#endif
            }
            TP_END(29, TPCTR);
                SEAM(pb + 9);
            }
            if (PHON(10) && IN(pb + 10)) { PHASE_LOCALS TP_BEGIN(30) for (int rep_ = 0; rep_ < REPN(10); ++rep_) {
                pg8::StaticOrder So; So.init(ACT0, (const bf16_t*)(wsl + WS_DDN), DFF, DFF, S, 1024, G, bid);
                pg8::EpiResid E{x_out, x_out};
                pg8::gemm_phase<pg8::EpiResid, pg8::StaticOrder, true, false>(lds, DFF, DFF, DFF, So, E, wave);
            }
            TP_END(30, TPCTR);
                SEAM(pb + 10);
            }
        } else {
#define ACT1 ((bf16_t*)(wsl + WS_R2))
#define YB ((bf16_t*)(wsl + WS_Y))
            for (int ps = 0; ps < 2; ++ps) {
                if (PHON(11) && IN(pb + 9 + 2 * ps)) { PHASE_LOCALS TP_BEGIN(31) for (int rep_ = 0; rep_ < REPN(11); ++rep_) {
                    if (tid == 0) { int tb = 0; for (int e = 0; e < 8; ++e) { const int c = (int)__hip_atomic_load(ctl + CW_MOECNT + 64 * e, RLX_AGENT); MTAB[e] = c; MTAB[8 + e] = tb; tb += (c + 255) >> 8; } MTAB[16] = tb; }
                    __syncthreads();
                    const int T = MTAB[16], tlo = 64 * ps, thi = (ps == 1) ? T : (T < 64 ? T : 64);
                    MoeGU So{MTAB, Hb, (const bf16_t*)(wsl + WS_MGU), ROWTOK, tlo, thi, G, bid};
                    pg8::EpiSwiglu E{ACT1, EFF};
                    pg8::gemm_phase<pg8::EpiSwiglu, MoeGU, true, true>(lds, 1024, 1024, 1024, So, E, wave);
#if GREP & 4
                    pg8::gemm_phase<pg8::EpiSwiglu, MoeGU, true, true>(lds, 1024, 1024, 1024, So, E, wave);
#endif
            }
            TP_END(31, TPCTR);
                    SEAM(pb + 9 + 2 * ps);
                }
                if (PHON(12) && IN(pb + 10 + 2 * ps)) { PHASE_LOCALS TP_BEGIN(32) for (int rep_ = 0; rep_ < REPN(12); ++rep_) {
                    if (tid == 0) { int tb = 0; for (int e = 0; e < 8; ++e) { const int c = (int)__hip_atomic_load(ctl + CW_MOECNT + 64 * e, RLX_AGENT); MTAB[e] = c; MTAB[8 + e] = tb; tb += (c + 255) >> 8; } MTAB[16] = tb; }
                    __syncthreads();
                    const int T = MTAB[16], tlo = 64 * ps, thi = (ps == 1) ? T : (T < 64 ? T : 64);
                    MoeDN So{MTAB, ACT1, (const bf16_t*)(wsl + WS_MDN), tlo, thi, G, bid};
                    pg8::EpiStore E{YB, 1024, nullptr, 1.f, 0};
                    pg8::gemm_phase<pg8::EpiStore, MoeDN, true, false>(lds, EFF, EFF, EFF, So, E, wave);
#if GREP & 8
                    pg8::gemm_phase<pg8::EpiStore, MoeDN, true, false>(lds, EFF, EFF, EFF, So, E, wave);
#endif
            }
            TP_END(32, TPCTR);
                    SEAM(pb + 10 + 2 * ps);
                }
            }
            if (PHON(15) && IN(pb + 15)) { PHASE_LOCALS TP_BEGIN(35) for (int rep_ = 0; rep_ < REPN(15); ++rep_) {
                if (tid == 0) { int tb = 0; for (int e = 0; e < 8; ++e) { const int c = (int)__hip_atomic_load(ctl + CW_MOECNT + 64 * e, RLX_AGENT); MTAB[e] = c; MTAB[8 + e] = tb; tb += (c + 255) >> 8; } MTAB[16] = tb; }
                __syncthreads();
                for (int m = gw; m < S; m += NGW) {
                    const int* r = ROUTE + (size_t)m * 8; const int e0 = r[0], e1 = r[1]; const float w0 = __int_as_float(r[4]), w1 = __int_as_float(r[5]);
                    const bf16_t* y0 = YB + ((size_t)MTAB[8 + e0] * 256 + r[2]) * 1024; const bf16_t* y1 = YB + ((size_t)MTAB[8 + e1] * 256 + r[3]) * 1024;
                    float* xo = x_out + (size_t)m * 1024;
#pragma unroll
                    for (int j = 0; j < 4; ++j) { const int c = 4 * lane + 256 * j; f32x4 xv = *(const f32x4*)(xo + c); const u32x2 a = *(const u32x2*)(y0 + c), b = *(const u32x2*)(y1 + c);
                        xv.x += w0 * bflo(a.x) + w1 * bflo(b.x); xv.y += w0 * bfhi(a.x) + w1 * bfhi(b.x); xv.z += w0 * bflo(a.y) + w1 * bflo(b.y); xv.w += w0 * bfhi(a.y) + w1 * bfhi(b.y);
                        *(f32x4*)(xo + c) = xv; }
                }
            }
            TP_END(35, TPCTR);
                if (l == 0) SEAM(pb + 15);
            }
        }
    }
#if TPROBE != 0 && !MK_MULTI
    xcd_barrier(bar);
    if (bid == 0 && wave == 0 && lane_id() == 0) { const unsigned long long tot = __hip_atomic_load((unsigned long long*)(ctl + 20480), RLX_AGENT) / (unsigned long long)(G * NWAVES); const unsigned long long t0 = tp_now(); while (tp_now() - t0 < tot) __builtin_amdgcn_s_sleep(8); }
#endif
#undef IN
#undef SEAM
}

extern "C" void kernel_launch(void* const* d_in, const int* in_sizes, int n_in, void* d_out, int out_size, void* d_ws, size_t ws_size, hipStream_t stream) {
    static int grid = 0;
    if (grid == 0) {
        if (n_in != 28 || in_sizes[0] != S * DM || out_size != S * DM || ws_size < WS_END) { fprintf(stderr, "kernel_launch: unexpected problem (n_in %d, in0 %d, out %d, ws %zu < %zu); nothing launched\n", n_in, n_in > 0 ? in_sizes[0] : -1, out_size, ws_size, (size_t)WS_END); grid = -1; return; }
        int dev = 0, cus = 0, per_cu = 0;
        if (hipGetDevice(&dev) != hipSuccess || hipDeviceGetAttribute(&cus, hipDeviceAttributeMultiprocessorCount, dev) != hipSuccess) { grid = -1; return; }
        if (hipFuncSetAttribute((const void*)fwd_kernel, hipFuncAttributeMaxDynamicSharedMemorySize, LDS_BYTES) != hipSuccess) { fprintf(stderr, "kernel_launch: hipFuncSetAttribute failed\n"); grid = -1; return; }
        if (hipOccupancyMaxActiveBlocksPerMultiprocessor(&per_cu, (const void*)fwd_kernel, NWAVES * 64, LDS_BYTES) != hipSuccess || per_cu < 1) { fprintf(stderr, "kernel_launch: occupancy query reports %d blocks per CU\n", per_cu); (void)hipGetLastError(); }
        grid = cus;
    }
    if (grid < 0) return;
    if (hipMemsetAsync((char*)d_ws + WS_CTL, 0, CTL_ZERO_BYTES, stream) != hipSuccess) return;
    Args a{};
    const float** ip = (const float**)&a.in;
    for (int i = 0; i < 28; ++i) ip[i] = (const float*)d_in[i];
    a.out = (float*)d_out; a.ws = (unsigned char*)d_ws;
#if MK_MULTI
    for (int ph = 0; ph < NPHASES; ++ph) {
        if (ph >= 1 + 11 && ph < 1 + PH_PER_LAYER) continue;
        a.ph_lo = ph; a.ph_hi = ph + 1;
        hipLaunchKernelGGL(fwd_kernel, dim3(grid), dim3(NWAVES * 64), LDS_BYTES, stream, a);
    }
#else
    a.ph_lo = 0; a.ph_hi = NPHASES;
    hipLaunchKernelGGL(fwd_kernel, dim3(grid), dim3(NWAVES * 64), LDS_BYTES, stream, a);
#endif
    const hipError_t le = hipPeekAtLastError();
    if (le != hipSuccess) fprintf(stderr, "kernel_launch: launch failed: %s\n", hipGetErrorName(le));
}
```

```cpp
#include <hip/hip_runtime.h>
#include <cstdio>
#include <cstdint>
#include <cmath>

#define LAS __attribute__((address_space(3)))
#define GAS __attribute__((address_space(1)))
typedef unsigned short bf16_t;
typedef short bf16x8 __attribute__((ext_vector_type(8)));
typedef short s16x4 __attribute__((ext_vector_type(4)));
typedef float f32x2 __attribute__((ext_vector_type(2)));
typedef float f32x4 __attribute__((ext_vector_type(4)));
typedef float f32x16 __attribute__((ext_vector_type(16)));
typedef unsigned u32x2 __attribute__((ext_vector_type(2)));
typedef unsigned u32x4 __attribute__((ext_vector_type(4)));
typedef __bf16 bf16x2_t __attribute__((ext_vector_type(2)));
typedef GAS unsigned gu32;
#define RLX_AGENT __ATOMIC_RELAXED, __HIP_MEMORY_SCOPE_AGENT
#define DI __device__ __forceinline__

DI unsigned cvtpk(float lo, float hi) { f32x2 v = {lo, hi}; bf16x2_t b = __builtin_convertvector(v, bf16x2_t); return __builtin_bit_cast(unsigned, b); }
DI float bf2f(bf16_t b) { return __uint_as_float(((unsigned)b) << 16); }
DI float bflo(unsigned w) { return __uint_as_float(w << 16); }
DI float bfhi(unsigned w) { return __uint_as_float(w & 0xffff0000u); }
DI bf16_t f2bf(float f) { return (bf16_t)(cvtpk(f, 0.f) & 0xffffu); }
DI float fast_exp2(float x) { return __builtin_amdgcn_exp2f(x); }
DI float fast_log2(float x) { return __builtin_amdgcn_logf(x); }
DI float fast_rcp(float x) { return __builtin_amdgcn_rcpf(x); }
constexpr float LOG2E = 1.4426950408889634f;
DI float sigmoidf_(float x) { return fast_rcp(1.f + fast_exp2(-x * LOG2E)); }
DI float siluf_(float x) { return x * sigmoidf_(x); }
template <int K> DI unsigned sxu(unsigned v) { return (unsigned)__builtin_amdgcn_ds_swizzle((int)v, (K << 10) | 0x1f); }
template <int K> DI float sx(float v) { return __uint_as_float(sxu<K>(__float_as_uint(v))); }
DI unsigned sx32u(unsigned v, int hi) { auto rr = __builtin_amdgcn_permlane32_swap(v, v, false, false); return hi ? rr[0] : rr[1]; }
DI float sx32(float v, int hi) { return __uint_as_float(sx32u(__float_as_uint(v), hi)); }
DI float sum32sym(float v) { auto rr = __builtin_amdgcn_permlane32_swap(__float_as_uint(v), __float_as_uint(v), false, false); return __uint_as_float(rr[0]) + __uint_as_float(rr[1]); }

#ifndef TPROBE
#define TPROBE 0
#endif
DI int lane_id() { int l_; asm volatile("v_mbcnt_lo_u32_b32 %0, -1, 0\n\tv_mbcnt_hi_u32_b32 %0, -1, %0" : "=v"(l_)); return l_; }
DI unsigned long long tp_now() { return __builtin_amdgcn_s_memrealtime(); }
#define TP_BEGIN(id) unsigned long long tp_t0_ = 0; if (TPROBE == (id)) tp_t0_ = tp_now();
#define TP_END(id, ctr) do { if (TPROBE == (id)) { const unsigned long long d_ = tp_now() - tp_t0_; if (lane_id() == 0) atomicAdd((unsigned long long*)(ctr), d_); } } while (0)

namespace pg8 {
constexpr int BM = 256, BK = 64, HALF = 128, HTB = HALF * BK * 2, STAGE_BYTES = 8 * HTB, NXCD = 8, WGM = 8;
__host__ __device__ __forceinline__ int lds_byte(int r, int c) { const int st = (r >> 4) * 2 + (c >> 5), rr = r & 15, cc = c & 31, ob = rr * 64 + cc * 2; return st * 1024 + (ob ^ (((ob >> 9) & 1) << 5)); }
__host__ __device__ __forceinline__ void stage_rc(int b, int& R, int& C) { const int st = b / 1024, sb = b % 1024, swz = sb ^ (((sb >> 9) & 1) << 5); R = (st >> 1) * 16 + swz / 64; C = (st & 1) * 32 + (swz % 64) / 2; }
__host__ __device__ __forceinline__ int perm32(int rho) { const int n = rho >> 4, i = rho & 15; return 8 * (i >> 2) + 4 * n + (i & 3); }

struct Unit { const bf16_t* a; const bf16_t* b; const int* rows; int nvalid, pm, pn; };

struct StaticOrder {
    const bf16_t* A; const bf16_t* Bt; int lda, ldb, nM, nN, nwg, G, c;
    DI void init(const bf16_t* A_, const bf16_t* Bt_, int lda_, int ldb_, int M, int N, int G_, int c_) { A = A_; Bt = Bt_; lda = lda_; ldb = ldb_; nM = M / BM; nN = N / BM; nwg = nM * nN; G = G_; c = c_; }
    DI bool next(int i, Unit& u) const {
        if (c < 0 || c >= G) return false;
        const long L = (long)i * G + c; if (L >= nwg) return false;
        int wgid = (int)L; { const int q = nwg / NXCD, r = nwg % NXCD, xcd = wgid % NXCD, off = wgid / NXCD; wgid = (xcd < r ? xcd * (q + 1) : r * (q + 1) + (xcd - r) * q) + off; }
        const int nig = WGM * nN, gid = wgid / nig, fm = gid * WGM, gsz = (nM - fm) < WGM ? (nM - fm) : WGM;
        u.pm = fm + ((wgid % nig) % gsz); u.pn = (wgid % nig) / gsz;
        u.a = A + (size_t)u.pm * BM * lda; u.b = Bt + (size_t)u.pn * BM * ldb; u.rows = nullptr; u.nvalid = BM; return true;
    }
};

struct EpiStore {
    static constexpr bool PERM = true;
    bf16_t* O; int ldc; const float* bias; float scale0; int act;
    DI void operator()(const f32x4 (&acc)[2][2][4][2], const Unit& u, int wr, int wc, int fr, int fq) const {
        const int row0 = u.pm * BM + wr * 64 + fr, col0 = u.pn * BM + wc * 32 + 8 * fq;
        const float sc = (u.pn == 0) ? scale0 : 1.f;
        f32x4 bv[2][2];
#pragma unroll
        for (int bj = 0; bj < 2; ++bj)
#pragma unroll
            for (int n = 0; n < 2; ++n) bv[bj][n] = bias ? *(const f32x4*)(bias + col0 + bj * HALF + 4 * n) : (f32x4){0.f, 0.f, 0.f, 0.f};
#pragma unroll
        for (int ai = 0; ai < 2; ++ai)
#pragma unroll
            for (int m = 0; m < 4; ++m) { bf16_t* rowp = O + (size_t)(row0 + ai * HALF + m * 16) * ldc + col0;
#pragma unroll
                for (int bj = 0; bj < 2; ++bj) { f32x4 v0 = (acc[ai][bj][m][0] + bv[bj][0]) * sc, v1 = (acc[ai][bj][m][1] + bv[bj][1]) * sc;
                    if (act) {
#pragma unroll
                        for (int e = 0; e < 4; ++e) { v0[e] = siluf_(v0[e]); v1[e] = siluf_(v1[e]); } }
                    u32x4 w; w.x = cvtpk(v0[0], v0[1]); w.y = cvtpk(v0[2], v0[3]); w.z = cvtpk(v1[0], v1[1]); w.w = cvtpk(v1[2], v1[3]);
                    *(u32x4*)(rowp + bj * HALF) = w; } }
    }
};
struct EpiGate {
    static constexpr bool PERM = true;
    bf16_t* Mg; const bf16_t* glog; int ldg; const float* bg; int first;
    DI void operator()(const f32x4 (&acc)[2][2][4][2], const Unit& u, int wr, int wc, int fr, int fq) const {
        const int row0 = u.pm * BM + wr * 64 + fr, col0 = u.pn * BM + wc * 32 + 8 * fq;
        f32x4 bv[2][2];
#pragma unroll
        for (int bj = 0; bj < 2; ++bj)
#pragma unroll
            for (int n = 0; n < 2; ++n) bv[bj][n] = *(const f32x4*)(bg + col0 + bj * HALF + 4 * n);
#pragma unroll
        for (int ai = 0; ai < 2; ++ai)
#pragma unroll
            for (int m = 0; m < 4; ++m) { const size_t row = (size_t)(row0 + ai * HALF + m * 16);
#pragma unroll
                for (int bj = 0; bj < 2; ++bj) { const int col = col0 + bj * HALF;
                    const u32x4 gl = *(const u32x4*)(glog + row * ldg + col);
                    u32x4 old = (u32x4){0u, 0u, 0u, 0u}; if (!first) old = *(const u32x4*)(Mg + row * 1024 + col);
                    float g[8] = {bflo(gl.x), bfhi(gl.x), bflo(gl.y), bfhi(gl.y), bflo(gl.z), bfhi(gl.z), bflo(gl.w), bfhi(gl.w)};
                    float o[8] = {bflo(old.x), bfhi(old.x), bflo(old.y), bfhi(old.y), bflo(old.z), bfhi(old.z), bflo(old.w), bfhi(old.w)};
#pragma unroll
                    for (int e = 0; e < 4; ++e) { o[e] += sigmoidf_(g[e] + bv[bj][0][e]) * acc[ai][bj][m][0][e]; o[4 + e] += sigmoidf_(g[4 + e] + bv[bj][1][e]) * acc[ai][bj][m][1][e]; }
                    u32x4 w; w.x = cvtpk(o[0], o[1]); w.y = cvtpk(o[2], o[3]); w.z = cvtpk(o[4], o[5]); w.w = cvtpk(o[6], o[7]);
                    *(u32x4*)(Mg + row * 1024 + col) = w; } }
    }
};
struct EpiResid {
    static constexpr bool PERM = false;
    const float* xin; float* out;
    DI void operator()(const f32x4 (&acc)[2][2][4][2], const Unit& u, int wr, int wc, int fr, int fq) const {
        const int row0 = u.pm * BM + wr * 64 + fr, col0 = u.pn * BM + wc * 32 + 4 * fq;
#pragma unroll
        for (int ai = 0; ai < 2; ++ai)
#pragma unroll
            for (int m = 0; m < 4; ++m) { const size_t off = (size_t)(row0 + ai * HALF + m * 16) * 1024 + col0;
#pragma unroll
                for (int bj = 0; bj < 2; ++bj)
#pragma unroll
                    for (int n = 0; n < 2; ++n) { const f32x4 b = *(const f32x4*)(xin + off + bj * HALF + n * 16); *(f32x4*)(out + off + bj * HALF + n * 16) = b + acc[ai][bj][m][n]; }
                if (m & 1) asm volatile("" ::: "memory"); }
    }
};
struct EpiF32 {
    static constexpr bool PERM = false;
    float* O; int ldc;
    DI void operator()(const f32x4 (&acc)[2][2][4][2], const Unit& u, int wr, int wc, int fr_in, int fq_in) const {
        int fr = fr_in, fq = fq_in; asm volatile("" : "+v"(fr), "+v"(fq));
        const int row0 = u.pm * BM + wr * 64 + fr, col0 = u.pn * BM + wc * 32 + 4 * fq;
#pragma unroll
        for (int ai = 0; ai < 2; ++ai)
#pragma unroll
            for (int m = 0; m < 4; ++m) { float* rowp = O + (size_t)(row0 + ai * HALF + m * 16) * ldc + col0;
#pragma unroll
                for (int bj = 0; bj < 2; ++bj)
#pragma unroll
                    for (int n = 0; n < 2; ++n) *(f32x4*)(rowp + bj * HALF + n * 16) = acc[ai][bj][m][n]; }
    }
};
struct EpiSwiglu {
    static constexpr bool PERM = true;
    bf16_t* act; int ldact;
    DI void operator()(const f32x4 (&acc)[2][2][4][2], const Unit& u, int wr, int wc, int fr, int fq) const {
        const int row0 = u.pm * BM + wr * 64 + fr, col0 = u.pn * HALF + wc * 32 + 8 * fq;
#pragma unroll
        for (int ai = 0; ai < 2; ++ai)
#pragma unroll
            for (int m = 0; m < 4; ++m) { bf16_t* rowp = act + (size_t)(row0 + ai * HALF + m * 16) * ldact + col0;
                float o[8];
#pragma unroll
                for (int e = 0; e < 4; ++e) { o[e] = siluf_(acc[ai][0][m][0][e]) * acc[ai][1][m][0][e]; o[4 + e] = siluf_(acc[ai][0][m][1][e]) * acc[ai][1][m][1][e]; }
                u32x4 w; w.x = cvtpk(o[0], o[1]); w.y = cvtpk(o[2], o[3]); w.z = cvtpk(o[4], o[5]); w.w = cvtpk(o[6], o[7]);
                *(u32x4*)rowp = w; }
    }
};

template <class Epi, class Sched, bool ALIGN_EPI, bool GATHER>
__device__ __forceinline__ void gemm_phase(LAS unsigned char* lds, const int lda, const int ldb, const int K, const Sched& S, const Epi& E, const int wave_id) {
    int tid_l = wave_id * 64 + lane_id(); asm volatile("" : "+v"(tid_l));
    const int tid = tid_l, wid = __builtin_amdgcn_readfirstlane(tid >> 6), lane = tid & 63, wr = wid >> 2, wc = wid & 3, fr = lane & 15, fq = lane >> 4;
    const int nt = K / BK;
    unsigned voffB[2], vc0[2], vc1[2], vn0[2], vn1[2];
#pragma unroll
    for (int i = 0; i < 2; ++i) { int R, C; stage_rc(tid * 16 + i * 8192, R, C); const int Rb = Epi::PERM ? ((R & ~31) + perm32(R & 31)) : R;
        voffB[i] = (unsigned)(Rb * ldb + C) * 2u; vc0[i] = (unsigned)(R * lda + C) * 2u; vc1[i] = vc0[i]; vn0[i] = vc0[i]; vn1[i] = vc0[i]; }
    const size_t hsA = GATHER ? (size_t)0 : (size_t)HALF * lda * 2, hsB = (size_t)HALF * ldb * 2;
    const size_t kstep = (size_t)(BK * 2);
    const unsigned ldsw = (unsigned)wid * 1024u;
    const int aoff = lds_byte(wr * 64 + fr, fq * 8), boff = lds_byte(wc * 32 + fr, fq * 8);
#define PG8_SA(b, h) (((b) * 2 + (h)) * HTB)
#define PG8_SB(b, h) ((4 + (b) * 2 + (h)) * HTB)
#define PG8_STAGE(bufoff, gbase, voff) do { _Pragma("unroll") for (int _i = 0; _i < 2; ++_i) \
        __builtin_amdgcn_global_load_lds((const unsigned*)((const char*)(gbase) + (voff)[_i]), (LAS unsigned*)(lds + (bufoff) + ldsw + _i * 8192), 16, 0, 0); } while (0)
#define PG8_LDA(dst, b, h) do { _Pragma("unroll") for (int m = 0; m < 4; ++m) _Pragma("unroll") for (int k = 0; k < 2; ++k) dst[m][k] = *(const LAS bf16x8*)(lds + PG8_SA(b, h) + aoff + m * 2048 + k * 1024); } while (0)
#define PG8_LDB(dst, b, h) do { _Pragma("unroll") for (int n = 0; n < 2; ++n) _Pragma("unroll") for (int k = 0; k < 2; ++k) dst[n][k] = *(const LAS bf16x8*)(lds + PG8_SB(b, h) + boff + n * 2048 + k * 1024); } while (0)
#define PG8_MMA(ai, bj, At, Bt) do { __builtin_amdgcn_s_setprio(1); _Pragma("unroll") for (int m = 0; m < 4; ++m) _Pragma("unroll") for (int n = 0; n < 2; ++n) _Pragma("unroll") for (int k = 0; k < 2; ++k) \
        acc[ai][bj][m][n] = __builtin_amdgcn_mfma_f32_16x16x32_bf16(Bt[n][k], At[m][k], acc[ai][bj][m][n], 0, 0, 0); __builtin_amdgcn_s_setprio(0); } while (0)
#define PG8_WAIT_V(n) asm volatile("s_waitcnt vmcnt(" #n ")" ::: "memory")
#define PG8_WAIT_L(n) asm volatile("s_waitcnt lgkmcnt(" #n ")" ::: "memory")
#define PG8_BAR __builtin_amdgcn_s_barrier()
#define PG8_SCHED __builtin_amdgcn_sched_barrier(0)
#define PG8_GVOFF(U, o0, o1) do { if constexpr (GATHER) { _Pragma("unroll") for (int _i = 0; _i < 2; ++_i) { int R_, C_; stage_rc(tid * 16 + _i * 8192, R_, C_); \
        const int r0_ = R_, r1_ = R_ + HALF; const int t0_ = (U).rows[r0_ < (U).nvalid ? r0_ : 0], t1_ = (U).rows[r1_ < (U).nvalid ? r1_ : 0]; \
        o0[_i] = (unsigned)(t0_ * lda + C_) * 2u; o1[_i] = (unsigned)(t1_ * lda + C_) * 2u; } } } while (0)
    Unit cur, nxt; int ui = 0;
    if (!S.next(0, cur)) return;
    PG8_GVOFF(cur, vc0, vc1);
    f32x4 acc[2][2][4][2];
#pragma unroll
    for (int a = 0; a < 2; ++a)
#pragma unroll
        for (int b = 0; b < 2; ++b)
#pragma unroll
            for (int m = 0; m < 4; ++m)
#pragma unroll
                for (int n = 0; n < 2; ++n) acc[a][b][m][n] = (f32x4){0.f, 0.f, 0.f, 0.f};
    bf16x8 At[4][2], B0[2][2], B1[2][2];
    const char* cA = (const char*)cur.a; const char* cB = (const char*)cur.b;
    PG8_STAGE(PG8_SB(0, 0), cB, voffB); PG8_STAGE(PG8_SB(0, 1), cB + hsB, voffB); PG8_STAGE(PG8_SA(0, 0), cA, vc0); PG8_STAGE(PG8_SA(0, 1), cA + hsA, vc1);
    if (wr == 1) PG8_BAR;
    PG8_WAIT_V(2); PG8_BAR;
    PG8_STAGE(PG8_SB(1, 0), cB + kstep, voffB); PG8_STAGE(PG8_SA(1, 0), cA + kstep, vc0); PG8_STAGE(PG8_SB(1, 1), cB + hsB + kstep, voffB);
    PG8_WAIT_V(6); PG8_BAR;
    for (;;) {
        const bool has_next = S.next(ui + 1, nxt);
        const char* nA = has_next ? (const char*)nxt.a : cA; const char* nB = has_next ? (const char*)nxt.b : cB;
        if constexpr (GATHER) { if (has_next) { PG8_GVOFF(nxt, vn0, vn1); } else {
#pragma unroll
            for (int i = 0; i < 2; ++i) { vn0[i] = vc0[i]; vn1[i] = vc1[i]; } } }
        for (int t = 0; t < nt; t += 2) {
            const bool last = (t == nt - 2);
            const char* a1 = cA + (size_t)(t + 1) * kstep;
            const char* a2 = last ? nA : cA + (size_t)(t + 2) * kstep; const char* b2 = last ? nB : cB + (size_t)(t + 2) * kstep;
            const char* a3 = a2 + kstep; const char* b3 = b2 + kstep;
            unsigned v20[2], v21[2];
#pragma unroll
            for (int i = 0; i < 2; ++i) { v20[i] = (GATHER && last) ? vn0[i] : vc0[i]; v21[i] = GATHER ? (last ? vn1[i] : vc1[i]) : vc0[i]; }
            PG8_LDB(B0, 0, 0); PG8_LDB(B1, 0, 1); PG8_SCHED; PG8_LDA(At, 0, 0); PG8_STAGE(PG8_SA(1, 1), a1 + hsA, vc1);
            PG8_WAIT_V(8); PG8_WAIT_L(0); PG8_BAR; PG8_MMA(0, 0, At, B0); PG8_MMA(0, 1, At, B1); PG8_BAR; PG8_SCHED;
            PG8_LDA(At, 0, 1); PG8_STAGE(PG8_SB(0, 0), b2, voffB); PG8_STAGE(PG8_SB(0, 1), b2 + hsB, voffB); PG8_STAGE(PG8_SA(0, 0), a2, v20);
            PG8_WAIT_V(8); PG8_WAIT_L(0); PG8_BAR; PG8_MMA(1, 0, At, B0); PG8_MMA(1, 1, At, B1); PG8_BAR; PG8_SCHED;
            PG8_LDB(B0, 1, 0); PG8_LDB(B1, 1, 1); PG8_SCHED; PG8_LDA(At, 1, 0); PG8_STAGE(PG8_SA(0, 1), a2 + hsA, v21);
            PG8_WAIT_V(8); PG8_WAIT_L(0); PG8_BAR; PG8_MMA(0, 0, At, B0); PG8_MMA(0, 1, At, B1); PG8_BAR; PG8_SCHED;
            PG8_LDA(At, 1, 1); PG8_STAGE(PG8_SB(1, 0), b3, voffB); PG8_STAGE(PG8_SB(1, 1), b3 + hsB, voffB); PG8_STAGE(PG8_SA(1, 0), a3, v20);
            PG8_WAIT_V(8); PG8_WAIT_L(0); PG8_BAR; PG8_MMA(1, 0, At, B0); PG8_MMA(1, 1, At, B1); PG8_BAR; PG8_SCHED;
        }
        if constexpr (ALIGN_EPI) { if (wr == 0) PG8_BAR; }
        E(acc, cur, wr, wc, fr, fq);
        if (!has_next) break;
#pragma unroll
        for (int a = 0; a < 2; ++a)
#pragma unroll
            for (int b = 0; b < 2; ++b)
#pragma unroll
                for (int m = 0; m < 4; ++m)
#pragma unroll
                    for (int n = 0; n < 2; ++n) acc[a][b][m][n] = (f32x4){0.f, 0.f, 0.f, 0.f};
        cur = nxt; cA = nA; cB = nB; ++ui;
        if constexpr (GATHER) {
#pragma unroll
            for (int i = 0; i < 2; ++i) { vc0[i] = vn0[i]; vc1[i] = vn1[i]; } }
        if constexpr (ALIGN_EPI) { if (wr == 1) PG8_BAR; }
    }
    PG8_WAIT_V(0);
    if constexpr (!ALIGN_EPI) { if (wr == 0) PG8_BAR; }
    PG8_BAR;
#undef PG8_SA
#undef PG8_SB
#undef PG8_STAGE
#undef PG8_LDA
#undef PG8_LDB
#undef PG8_MMA
#undef PG8_WAIT_V
#undef PG8_WAIT_L
#undef PG8_BAR
#undef PG8_SCHED
#undef PG8_GVOFF
}
}
#define XB_TMO      128
#define XB_XCNT(j)  (256  + 64 * (j))
#define XB_XSUB(j)  (1280 + 64 * (j))
#define XB_XGEN(j)  (2304 + 64 * (j))
#define XB_TOP      3328
#define XB_TOPGEN   3392
#define XCD_BAR_WORDS 3456
#define XB_SPIN_CAP (1u << 18)

__device__ __forceinline__ unsigned xb_ld(unsigned* p)              { return __hip_atomic_load(p, __ATOMIC_RELAXED, __HIP_MEMORY_SCOPE_AGENT); }
__device__ __forceinline__ unsigned xb_add(unsigned* p, unsigned v) { return __hip_atomic_fetch_add(p, v, __ATOMIC_RELAXED, __HIP_MEMORY_SCOPE_AGENT); }
__device__ __forceinline__ unsigned xb_xcc_id() { return (unsigned)__builtin_amdgcn_s_getreg((3 << 11) | 20) & 0xFu; }
#define XB_SPIN(cond, bar) do { unsigned _sp = 0; while (cond) { __builtin_amdgcn_s_sleep(1); \
    if ((++_sp & 255u) == 0u) { if (xb_ld(&(bar)[XB_TMO])) break; if (_sp > XB_SPIN_CAP) { atomicAdd(&(bar)[XB_TMO], 1u); break; } } } } while (0)

struct XcdBarrier {
    unsigned* bar; unsigned x;
    volatile LAS unsigned* st;
};

__device__ __forceinline__ XcdBarrier xcd_barrier_post(unsigned* bar, volatile LAS unsigned* st) {
    XcdBarrier b; b.bar = bar; b.x = xb_xcc_id(); b.st = st;
    if (threadIdx.x == 0) (void)xb_add(&bar[XB_XCNT(b.x)], 1u);
    return b;
}
__device__ __forceinline__ void xcd_barrier_complete(unsigned* bar, unsigned x, unsigned& nloc, unsigned& nx) {
    const unsigned G = gridDim.x * gridDim.y * gridDim.z;
    unsigned sum, cnt, mine, sp = 0u;
    for (;;) {
        sum = 0u; cnt = 0u; mine = 0u;
#pragma unroll
        for (unsigned j = 0; j < 16; ++j) { const unsigned c = xb_ld(&bar[XB_XCNT(j)]); sum += c; cnt += (c > 0u) ? 1u : 0u; mine = (j == x) ? c : mine; }
        if (sum == G) break;
        __builtin_amdgcn_s_sleep(1);
        if ((++sp & 255u) == 0u) { if (xb_ld(&bar[XB_TMO])) break; if (sp > XB_SPIN_CAP) { atomicAdd(&bar[XB_TMO], 1u); break; } }
    }
    nloc = mine > 0u ? mine : 1u; nx = cnt > 0u ? cnt : 1u;
}

__device__ __forceinline__ void xcd_barrier(const XcdBarrier& b) {
    asm volatile("s_waitcnt vmcnt(0)" ::: "memory");
    __syncthreads();
    if (threadIdx.x == 0) {
        unsigned* bar = b.bar;
        __builtin_amdgcn_s_waitcnt(0);
        unsigned nloc = b.st[0], nx = b.st[1];
        if (nloc == 0u) { xcd_barrier_complete(bar, b.x, nloc, nx); b.st[0] = nloc; b.st[1] = nx; }
        const unsigned old = xb_add(&bar[XB_XSUB(b.x)], 1u);
        const unsigned gen = old / nloc;
        if (old + 1u == (gen + 1u) * nloc) {
            __builtin_amdgcn_fence(__ATOMIC_RELEASE, "agent");
            asm volatile("s_waitcnt vmcnt(0)" ::: "memory");
            const unsigned og = xb_add(&bar[XB_TOP], 1u);
            const unsigned tg = og / nx;
            if (og + 1u == (tg + 1u) * nx) xb_add(&bar[XB_TOPGEN], 1u);
            else XB_SPIN(xb_ld(&bar[XB_TOPGEN]) == tg, bar);
            __builtin_amdgcn_fence(__ATOMIC_ACQUIRE, "agent");
            xb_add(&bar[XB_XGEN(b.x)], 1u);
            asm volatile("s_waitcnt vmcnt(0)" ::: "memory");
        } else {
            XB_SPIN(xb_ld(&bar[XB_XGEN(b.x)]) == gen, bar);
            __builtin_amdgcn_fence(__ATOMIC_ACQUIRE, "agent");
            asm volatile("s_waitcnt vmcnt(0)" ::: "memory");
        }
    }
    __syncthreads();
}
namespace att {
typedef short v4i16_t __attribute__((ext_vector_type(4)));
DI f32x16 mfma32(bf16x8 a, bf16x8 b, f32x16 c) { return __builtin_amdgcn_mfma_f32_32x32x16_bf16(a, b, c, 0, 0, 0); }
DI f32x4 mfma16(bf16x8 a, bf16x8 b, f32x4 c) { return __builtin_amdgcn_mfma_f32_16x16x32_bf16(a, b, c, 0, 0, 0); }
DI int crow(int r, int hi) { return (r & 3) + 8 * (r >> 2) + 4 * hi; }
DI s16x4 vtr(const LAS char* p) { return __builtin_bit_cast(s16x4, __builtin_amdgcn_ds_read_tr16_b64_v4i16((LAS v4i16_t*)p)); }
DI int rfl(int x) { return __builtin_amdgcn_readfirstlane(x); }
constexpr float NEGBIG = -1e30f;
#define LDS_BAR() asm volatile("s_waitcnt lgkmcnt(0)\n\ts_barrier" ::: "memory")

template <int D, int KS> DI f32x16 qk32(const LAS char* kp, const bf16x8* qf, float init = 0.f) {
    f32x16 acc;
#pragma unroll
    for (int i = 0; i < 16; ++i) acc[i] = init;
    bf16x8 kfr[D / 16];
#pragma unroll
    for (int d0 = 0; d0 < D / 16; ++d0) kfr[d0] = *(const LAS bf16x8*)(kp + d0 * 32);
    asm volatile("" ::: "memory");
#pragma unroll
    for (int d0 = 0; d0 < D / 16; ++d0) acc = mfma32(kfr[d0], qf[d0], acc);
    return acc;
}
template <int D, int KS> DI void qk64(f32x16& a0, f32x16& a1, const LAS char* kp, const bf16x8* qf, float init = 0.f) {
#pragma unroll
    for (int i = 0; i < 16; ++i) { a0[i] = init; a1[i] = init; }
    bf16x8 k0[D / 16], k1[D / 16];
#pragma unroll
    for (int d0 = 0; d0 < D / 16; ++d0) { k0[d0] = *(const LAS bf16x8*)(kp + d0 * 32); k1[d0] = *(const LAS bf16x8*)(kp + 32 * KS + d0 * 32); }
    asm volatile("" ::: "memory");
#pragma unroll
    for (int d0 = 0; d0 < D / 16; ++d0) { a0 = mfma32(k0[d0], qf[d0], a0); a1 = mfma32(k1[d0], qf[d0], a1); }
}
template <int VS> DI void pv32(f32x16 (&o)[2], const LAS char* vp, bf16x8 pf0, bf16x8 pf1) {
    s16x4 t[2][4];
#pragma unroll
    for (int dh = 0; dh < 2; ++dh) { t[dh][0] = vtr(vp + dh * 64); t[dh][1] = vtr(vp + 8 * VS + dh * 64); t[dh][2] = vtr(vp + 16 * VS + dh * 64); t[dh][3] = vtr(vp + 24 * VS + dh * 64); }
    asm volatile("" ::: "memory");
#pragma unroll
    for (int dh = 0; dh < 2; ++dh) {
        const bf16x8 v0 = __builtin_shufflevector(t[dh][0], t[dh][1], 0, 1, 2, 3, 4, 5, 6, 7), v1 = __builtin_shufflevector(t[dh][2], t[dh][3], 0, 1, 2, 3, 4, 5, 6, 7);
        o[dh] = mfma32(v0, pf0, o[dh]); o[dh] = mfma32(v1, pf1, o[dh]);
    }
}
template <int VS> DI void pv64(f32x16 (&o)[2], const LAS char* vp, const f32x16& p0, const f32x16& p1);
DI bf16x8 pack8(const f32x16& p, int s) {
    u32x4 w; w.x = cvtpk(p[8 * s], p[8 * s + 1]); w.y = cvtpk(p[8 * s + 2], p[8 * s + 3]); w.z = cvtpk(p[8 * s + 4], p[8 * s + 5]); w.w = cvtpk(p[8 * s + 6], p[8 * s + 7]);
    return __builtin_bit_cast(bf16x8, w);
}
template <int VS> DI void pv64(f32x16 (&o)[2], const LAS char* vp, const f32x16& p0, const f32x16& p1) {
    s16x4 t[2][2][4];
#pragma unroll
    for (int hh = 0; hh < 2; ++hh)
#pragma unroll
        for (int dh = 0; dh < 2; ++dh)
#pragma unroll
            for (int k = 0; k < 4; ++k) t[hh][dh][k] = vtr(vp + (32 * hh + 8 * k) * VS + dh * 64);
    const bf16x8 pa0 = pack8(p0, 0), pa1 = pack8(p0, 1), pb0 = pack8(p1, 0), pb1 = pack8(p1, 1);
    asm volatile("" ::: "memory");
#pragma unroll
    for (int dh = 0; dh < 2; ++dh) {
        o[dh] = mfma32(__builtin_shufflevector(t[0][dh][0], t[0][dh][1], 0, 1, 2, 3, 4, 5, 6, 7), pa0, o[dh]);
        o[dh] = mfma32(__builtin_shufflevector(t[0][dh][2], t[0][dh][3], 0, 1, 2, 3, 4, 5, 6, 7), pa1, o[dh]);
        o[dh] = mfma32(__builtin_shufflevector(t[1][dh][0], t[1][dh][1], 0, 1, 2, 3, 4, 5, 6, 7), pb0, o[dh]);
        o[dh] = mfma32(__builtin_shufflevector(t[1][dh][2], t[1][dh][3], 0, 1, 2, 3, 4, 5, 6, 7), pb1, o[dh]);
    }
}
DI float max16(const f32x16& p) { float a = fmaxf(fmaxf(p[0], p[1]), fmaxf(p[2], p[3]));
#pragma unroll
    for (int r = 4; r < 16; r += 4) a = fmaxf(a, fmaxf(fmaxf(p[r], p[r + 1]), fmaxf(p[r + 2], p[r + 3]))); return a; }
DI void store_ot(bf16_t* dst, const f32x16 (&o)[2], int hi) {
#pragma unroll
    for (int dh = 0; dh < 2; ++dh)
#pragma unroll
        for (int g4 = 0; g4 < 4; ++g4) { u32x2 w; w.x = cvtpk(o[dh][4 * g4], o[dh][4 * g4 + 1]); w.y = cvtpk(o[dh][4 * g4 + 2], o[dh][4 * g4 + 3]); *(u32x2*)(dst + 32 * dh + 8 * g4 + 4 * hi) = w; }
}

#define ATT_SB() __builtin_amdgcn_sched_barrier(0)
template <int D, int KS, int VS> DI void step64(f32x16 (&o)[2], float& l, const LAS char* kp, const LAS char* vp, const bf16x8* qf, float init) {
    bf16x8 k0[D / 16], k1[D / 16];
#pragma unroll
    for (int d0 = 0; d0 < D / 16; ++d0) { k0[d0] = *(const LAS bf16x8*)(kp + d0 * 32); k1[d0] = *(const LAS bf16x8*)(kp + 32 * KS + d0 * 32); }
    s16x4 t[2][2][4];
#pragma unroll
    for (int hh = 0; hh < 2; ++hh)
#pragma unroll
        for (int dh = 0; dh < 2; ++dh)
#pragma unroll
            for (int k = 0; k < 4; ++k) t[hh][dh][k] = vtr(vp + (32 * hh + 8 * k) * VS + dh * 64);
    f32x16 a0, a1;
#pragma unroll
    for (int i = 0; i < 16; ++i) { a0[i] = init; a1[i] = init; }
    ATT_SB();
#pragma unroll
    for (int d0 = 0; d0 < D / 16; ++d0) a0 = mfma32(k0[d0], qf[d0], a0);
#pragma unroll
    for (int d0 = 0; d0 < D / 16 - 4; ++d0) a1 = mfma32(k1[d0], qf[d0], a1);
    ATT_SB();
    float ls = 0.f;
#pragma unroll
    for (int g = 0; g < 4; ++g) {
        a1 = mfma32(k1[D / 16 - 4 + g], qf[D / 16 - 4 + g], a1);
#pragma unroll
        for (int e = 0; e < 4; ++e) { a0[4 * g + e] = fast_exp2(a0[4 * g + e]); ls += a0[4 * g + e]; }
        asm volatile("" : "+v"(a0), "+v"(ls)); ATT_SB();
    }
    const bf16x8 pa0 = pack8(a0, 0), pa1 = pack8(a0, 1);
    ATT_SB();
#pragma unroll
    for (int g = 0; g < 4; ++g) {
        const int dh = g & 1, s = g >> 1;
        o[dh] = mfma32(__builtin_shufflevector(t[0][dh][2 * s], t[0][dh][2 * s + 1], 0, 1, 2, 3, 4, 5, 6, 7), s ? pa1 : pa0, o[dh]);
#pragma unroll
        for (int e = 0; e < 4; ++e) { a1[4 * g + e] = fast_exp2(a1[4 * g + e]); ls += a1[4 * g + e]; }
        asm volatile("" : "+v"(a1), "+v"(ls)); ATT_SB();
    }
    const bf16x8 pb0 = pack8(a1, 0), pb1 = pack8(a1, 1);
    ATT_SB();
#pragma unroll
    for (int g = 0; g < 4; ++g) { const int dh = g & 1, s = g >> 1;
        o[dh] = mfma32(__builtin_shufflevector(t[1][dh][2 * s], t[1][dh][2 * s + 1], 0, 1, 2, 3, 4, 5, 6, 7), s ? pb1 : pb0, o[dh]); }
    l += ls;
}

constexpr int MLA_KS = 208, MLA_VS = 144, MLA_KB = 128 * MLA_KS, MLA_VB = 128 * MLA_VS, MLA_BUF = MLA_KB + MLA_VB;
DI void mla_unit(LAS char* lds, const bf16_t* QM, const bf16_t* KM, const bf16_t* KV, bf16_t* ATT, int head, int qb, float kb, int wave_id, unsigned long long* tp) {
    TP_BEGIN(7) unsigned long long tpacc_ = 0, tpa_ = 0;
    int tid_l = wave_id * 64 + lane_id(); asm volatile("" : "+v"(tid_l));
    const int tid = tid_l, lane = tid & 63, wid = rfl(tid >> 6), r32 = lane & 31, hi = lane >> 5, half = wid >> 2, wq = wid & 3;
    const int q0 = qb * 128, qpos = q0 + 32 * wq + r32, nsuper = qb + 1;
    bf16x8 qf[6];
    { const bf16_t* qp = QM + (size_t)qpos * 384 + head * 96 + hi * 8;
#pragma unroll
      for (int d0 = 0; d0 < 6; ++d0) qf[d0] = *(const bf16x8*)(qp + d0 * 16); }
    float nref;
    { float qs = 0.f;
#pragma unroll
      for (int d0 = 0; d0 < 6; ++d0)
#pragma unroll
          for (int e = 0; e < 8; ++e) { const float v = __uint_as_float(((unsigned)(unsigned short)qf[d0][e]) << 16); qs += v * v; }
      qs += sx32(qs, hi); nref = -sqrtf(qs) * kb; }
    u32x4 kr[3], vr[2];
#define MLA_LOAD(i) do { _Pragma("unroll") for (int j = 0; j < 3; ++j) { const int c = tid + 512 * j, row = c / 12, ch = c % 12; kr[j] = *(const u32x4*)(KM + (size_t)(128 * (i) + row) * 384 + head * 96 + ch * 8); } \
        _Pragma("unroll") for (int j = 0; j < 2; ++j) { const int c = tid + 512 * j, row = c >> 3, ch = c & 7; vr[j] = *(const u32x4*)(KV + (size_t)(128 * (i) + row) * 512 + head * 128 + 64 + ch * 8); } } while (0)
#define MLA_STORE(b) do { LAS char* kb_ = lds + (b) * MLA_BUF; _Pragma("unroll") for (int j = 0; j < 3; ++j) { const int c = tid + 512 * j, row = c / 12, ch = c % 12; *(LAS u32x4*)(kb_ + row * MLA_KS + ch * 16) = kr[j]; } \
        _Pragma("unroll") for (int j = 0; j < 2; ++j) { const int c = tid + 512 * j, row = c >> 3, ch = c & 7; *(LAS u32x4*)(kb_ + MLA_KB + row * MLA_VS + ch * 16) = vr[j]; } } while (0)
    MLA_LOAD(0); MLA_STORE(0); __syncthreads();
    float l = 0.f; f32x16 o[2];
#pragma unroll
    for (int i = 0; i < 16; ++i) { o[0][i] = 0.f; o[1][i] = 0.f; }
    const int vlane = (4 * hi + ((lane & 15) >> 2)) * MLA_VS + 2 * (16 * ((lane >> 4) & 1) + 4 * (lane & 3));
    for (int i = 0; i < nsuper; ++i) {
        const bool more = i + 1 < nsuper;
        if (more) MLA_LOAD(i + 1);
        const LAS char* kb_ = lds + (i & 1) * MLA_BUF; const LAS char* vb = kb_ + MLA_KB;
        const bool diag = (i == nsuper - 1);
        if (TPROBE == 14 || TPROBE == 15 || TPROBE == 16) tpa_ = tp_now();
        if (!(diag && half == 1 && wq < 2)) {
            const int koff = 64 * half;
            if (!diag) step64<96, MLA_KS, MLA_VS>(o, l, kb_ + (koff + r32) * MLA_KS + hi * 16, vb + koff * MLA_VS + vlane, qf, nref);
            else {
            f32x16 p0, p1; qk64<96, MLA_KS>(p0, p1, kb_ + (koff + r32) * MLA_KS + hi * 16, qf, nref);
            { const int kbase = 128 * i + koff;
#pragma unroll
                for (int r = 0; r < 16; ++r) { const int k0 = kbase + crow(r, hi); p0[r] = (k0 > qpos) ? 0.f : fast_exp2(p0[r]); p1[r] = (k0 + 32 > qpos) ? 0.f : fast_exp2(p1[r]); } }
#pragma unroll
            for (int r = 0; r < 16; ++r) l += p0[r] + p1[r];
            pv64<MLA_VS>(o, vb + koff * MLA_VS + vlane, p0, p1);
            }
        }
        if (TPROBE == 15) tpacc_ += tp_now() - tpa_;
        if (TPROBE == 16) tpa_ = tp_now();
        if (more) MLA_STORE((i + 1) & 1);
        if (TPROBE == 16) tpacc_ += tp_now() - tpa_;
        if (TPROBE == 14) tpa_ = tp_now();
        __syncthreads();
        if (TPROBE == 14) tpacc_ += tp_now() - tpa_;
    }
#undef MLA_LOAD
#undef MLA_STORE
    l = sum32sym(l);
    LAS float* mrg = (LAS float*)lds + (wq * 64 + lane) * 34;
    if (half == 1) { mrg[1] = l;
#pragma unroll
        for (int r = 0; r < 16; ++r) { mrg[2 + r] = o[0][r]; mrg[18 + r] = o[1][r]; } }
    __syncthreads();
    if (half == 0) {
        const float inv = 1.f / (l + mrg[1]);
#pragma unroll
        for (int r = 0; r < 16; ++r) { o[0][r] = (o[0][r] + mrg[2 + r]) * inv; o[1][r] = (o[1][r] + mrg[18 + r]) * inv; }
        store_ot(ATT + (size_t)qpos * 1024 + 768 + head * 64, o, hi);
    }
    __syncthreads();
    TP_END(7, tp);
    if ((TPROBE == 14 || TPROBE == 15 || TPROBE == 16) && lane == 0) atomicAdd(tp, tpacc_);
}

constexpr int T_KS = 144, T_KB = 64 * T_KS, T_BUF = 2 * T_KB;
DI void sb_half(f32x16 (&o)[2], float& R, const LAS char* ktile, const LAS char* vtile, const bf16x8* qf, int kb, int hh, int qpos, int r32, int hi, int vlane) {
    f32x16 z = qk32<64, T_KS>(ktile + (32 * hh + r32) * T_KS + hi * 16, qf);
    float ls[16];
#pragma unroll
    for (int r = 0; r < 16; ++r) { const bool valid = (kb + crow(r, hi)) < qpos; const float az = fabsf(z[r]);
        const float sp = fmaxf(z[r], 0.f) + fast_log2(1.f + fast_exp2(-az)); ls[r] = valid ? -sp : 0.f; }
    float T[4], U[4];
#pragma unroll
    for (int g = 0; g < 4; ++g) { ls[4 * g + 2] += ls[4 * g + 3]; ls[4 * g + 1] += ls[4 * g + 2]; ls[4 * g] += ls[4 * g + 1]; T[g] = ls[4 * g]; }
#pragma unroll
    for (int g = 0; g < 4; ++g) U[g] = sx32(T[g], hi);
    float H[4]; float sp = 0.f;
#pragma unroll
    for (int g = 3; g >= 0; --g) { H[g] = sp + (hi == 0 ? U[g] : 0.f); sp += T[g] + U[g]; }
#pragma unroll
    for (int r = 0; r < 16; ++r) { const bool valid = (kb + crow(r, hi)) < qpos; const float lw = z[r] + R + H[r >> 2] + ls[r]; z[r] = valid ? fast_exp2(lw) : 0.f; }
    R += sp;
    pv32<T_KS>(o, vtile + (32 * hh) * T_KS + vlane, pack8(z, 0), pack8(z, 1));
}
DI void sb_unit(LAS char* lds, const bf16_t* PROJ, bf16_t* ATT, int head, int qb, int wave_id) {
    int tid_l = wave_id * 64 + lane_id(); asm volatile("" : "+v"(tid_l));
    const int tid = tid_l, lane = tid & 63, wid = rfl(tid >> 6), r32 = lane & 31, hi = lane >> 5;
    const int q0 = qb * 256, wq0 = q0 + 32 * wid, qpos = wq0 + r32;
    bf16x8 qf[4];
    { const bf16_t* qp = PROJ + (size_t)qpos * 5632 + head * 64 + hi * 8;
#pragma unroll
      for (int d0 = 0; d0 < 4; ++d0) qf[d0] = *(const bf16x8*)(qp + d0 * 16); }
    const int srow = tid >> 3, sch = tid & 7;
    u32x4 kr, vr;
#define SB_LOAD(t) do { const bf16_t* p_ = PROJ + (size_t)(64 * (t) + srow) * 5632 + head * 64 + sch * 8; kr = *(const u32x4*)(p_ + 256); vr = *(const u32x4*)(p_ + 512); } while (0)
#define SB_STORE(b) do { LAS char* d_ = lds + (b) * T_BUF + srow * T_KS + sch * 16; *(LAS u32x4*)d_ = kr; *(LAS u32x4*)(d_ + T_KB) = vr; } while (0)
    volatile LAS int* flags = (volatile LAS int*)(lds + 2 * T_BUF);
    int t = 4 * qb + 3;
    SB_LOAD(t); SB_STORE(0); __syncthreads();
    float R = 0.f; f32x16 o[2];
#pragma unroll
    for (int i = 0; i < 16; ++i) { o[0][i] = 0.f; o[1][i] = 0.f; }
    const int vlane = (4 * hi + ((lane & 15) >> 2)) * T_KS + 2 * (16 * ((lane >> 4) & 1) + 4 * (lane & 3));
    bool done = false;
    for (int it = 0;; ++it) {
        const bool more = t > 0;
        if (more) SB_LOAD(t - 1);
        const LAS char* kt = lds + (it & 1) * T_BUF; const LAS char* vt = kt + T_KB;
        if (!done && 64 * t <= wq0 + 30) {
            if (64 * t + 32 <= wq0 + 30) sb_half(o, R, kt, vt, qf, 64 * t + 32, 1, qpos, r32, hi, vlane);
            sb_half(o, R, kt, vt, qf, 64 * t, 0, qpos, r32, hi, vlane);
            done = __all(R < -150.f) != 0;
        }
        if (lane == 0) flags[(it & 1) * 8 + wid] = done ? 0 : 1;
        if (more) SB_STORE((it + 1) & 1);
        __syncthreads();
        int any = 0;
#pragma unroll
        for (int w = 0; w < 8; ++w) any |= flags[(it & 1) * 8 + w];
        if (!more || !any) break;
        --t;
    }
#undef SB_LOAD
#undef SB_STORE
    store_ot(ATT + (size_t)qpos * 1024 + head * 64, o, hi);
    __syncthreads();
}

#ifndef NSAREP
#define NSAREP 0
#endif
#define NSA_NREP(bit) (((NSAREP >> (bit)) & 1) ? 2 : 1)
constexpr int N_LUT = 2 * T_BUF, N_IMP = N_LUT + 16384, N_OSTR = 68, N_BLKQ = N_IMP + 256 * N_OSTR * 4, N_L = N_BLKQ + 2048, N_REF = N_L + 1280, N_END = N_REF + 1024 + 64;
constexpr int N_QS = 144;
struct NsaT {
    const bf16_t* PROJ;
    const bf16_t* KCMP; const bf16_t* VCMP;
    const bf16_t* KS; const bf16_t* VTS;
    const bf16_t* KW;
    const float* GN;
    const float* LUT8;
    bf16_t* ATT;
    float kb, bmax;
    unsigned long long* tp;
};
__host__ __device__ __forceinline__ int vts_key_of_slot(int slot) { const int hh = slot >> 5, s5 = slot & 31, s = s5 >> 4, h = (s5 >> 3) & 1, j = s5 & 7; return 32 * hh + 16 * s + 8 * (j >> 2) + 4 * h + (j & 3); }

DI void nsa_unit(LAS char* lds, const NsaT& T, int g, int qblk, int wave_id) {
    int tid_l = wave_id * 64 + lane_id(); asm volatile("" : "+v"(tid_l));
    const int tid = tid_l, lane = tid & 63, wid = rfl(tid >> 6), r32 = lane & 31, hi = lane >> 5;
    const int q0 = qblk * 64;
    TP_BEGIN(6)
    LAS float* lut = (LAS float*)(lds + N_LUT);
    LAS float* imp = (LAS float*)(lds + N_IMP);
    LAS unsigned* bq32 = (LAS unsigned*)(lds + N_BLKQ);
    LAS float* refl = (LAS float*)(lds + N_REF);
    for (int i = tid; i < 4096; i += 512) lut[i] = T.LUT8[(i >> 2) * 8 + g * 4 + (i & 3)];
    for (int i = tid; i < 16384; i += 512) imp[i] = 0.f;
    bq32[tid] = 0u;
    const int ql = r32 >> 2, hd = r32 & 3, h8 = g * 4 + hd, tq = q0 + 8 * wid + ql;
    bf16x8 qf[4];
    { const bf16_t* qp = T.PROJ + (size_t)tq * 5632 + 768 + h8 * 64 + hi * 8;
#pragma unroll
      for (int d0 = 0; d0 < 4; ++d0) qf[d0] = *(const bf16x8*)(qp + d0 * 16); }
    float ref;
    { float qs = 0.f;
#pragma unroll
      for (int d0 = 0; d0 < 4; ++d0)
#pragma unroll
          for (int e = 0; e < 8; ++e) { const float v = __uint_as_float(((unsigned)(unsigned short)qf[d0][e]) << 16); qs += v * v; }
      qs += sx32(qs, hi); ref = sqrtf(qs) * T.kb + T.bmax; }
    if (hi == 0) refl[(8 * wid + ql) * 4 + hd] = ref;
    const float gc = T.GN[(size_t)tq * 24 + 3 * h8], gs = T.GN[(size_t)tq * 24 + 3 * h8 + 1], gw = T.GN[(size_t)tq * 24 + 3 * h8 + 2];
    const int srow = tid >> 3, sch = tid & 7;
    const int vlane = (4 * hi + ((lane & 15) >> 2)) * T_KS + 2 * (16 * ((lane >> 4) & 1) + 4 * (lane & 3));
    u32x4 kr, vr;
    __syncthreads();
    const float cfar = lut[1023 * 4 + hd] - ref;
    const int nmax = (q0 + 32) / 16 + 1;
    const int ntc = (nmax + 63) >> 6;
    const bf16_t* kc = T.KCMP + (size_t)g * 1024 * 64; const bf16_t* vc = T.VCMP + (size_t)g * 1024 * 64;
    const int relq = tq - 31;
    const int relw = q0 + 8 * wid - 31;
    float l = 0.f; float inv_l = 0.f; f32x16 oa[2];
    { TP_BEGIN(4)
    for (int rp_ = 0; rp_ < NSA_NREP(0); ++rp_) { l = 0.f;
    u32x4 kq, vq;
    kr = *(const u32x4*)(kc + (size_t)srow * 64 + sch * 8);
    *(LAS u32x4*)(lds + srow * T_KS + sch * 16) = kr; kq = kr;
    if (1 < ntc) kq = *(const u32x4*)(kc + (size_t)(64 + srow) * 64 + sch * 8);
    LDS_BAR();
    for (int j = 0; j < ntc; ++j) {
        const bool more = j + 1 < ntc;
        if (j + 2 < ntc) kr = *(const u32x4*)(kc + (size_t)(64 * (j + 2) + srow) * 64 + sch * 8);
        const LAS char* kt = lds + (j & 1) * T_BUF;
#pragma unroll
        for (int hh = 0; hh < 2; ++hh) {
            f32x16 s = qk32<64, T_KS>(kt + (32 * hh + r32) * T_KS + hi * 16, qf);
            const int n0 = 64 * j + 32 * hh;
            if (relw - 16 * (n0 + 31) >= 790) {
#pragma unroll
                for (int r = 0; r < 16; ++r) l += fast_exp2(s[r] + cfar);
            } else {
#pragma unroll
                for (int r = 0; r < 16; ++r) { const int rel = relq - 16 * (n0 + crow(r, hi)); l += (rel >= 0) ? fast_exp2(s[r] + lut[(rel < 1023 ? rel : 1023) * 4 + hd] - ref) : 0.f; }
            }
        }
        if (more) *(LAS u32x4*)(lds + ((j + 1) & 1) * T_BUF + srow * T_KS + sch * 16) = kq;
        kq = kr;
        LDS_BAR();
    }
    l = sum32sym(l);
    inv_l = l > 0.f ? 1.f / l : 0.f;
#pragma unroll
    for (int i = 0; i < 16; ++i) { oa[0][i] = 0.f; oa[1][i] = 0.f; }
    float cprev = 0.f;
    kr = *(const u32x4*)(kc + (size_t)srow * 64 + sch * 8); vr = *(const u32x4*)(vc + (size_t)srow * 64 + sch * 8);
    { LAS char* d_ = lds + srow * T_KS + sch * 16; *(LAS u32x4*)d_ = kr; *(LAS u32x4*)(d_ + T_KB) = vr; } kq = kr; vq = vr;
    if (1 < ntc) { kq = *(const u32x4*)(kc + (size_t)(64 + srow) * 64 + sch * 8); vq = *(const u32x4*)(vc + (size_t)(64 + srow) * 64 + sch * 8); }
    LDS_BAR();
    for (int j = 0; j < ntc; ++j) {
        const bool more = j + 1 < ntc;
        if (j + 2 < ntc) { kr = *(const u32x4*)(kc + (size_t)(64 * (j + 2) + srow) * 64 + sch * 8); vr = *(const u32x4*)(vc + (size_t)(64 * (j + 2) + srow) * 64 + sch * 8); }
        const LAS char* kt = lds + (j & 1) * T_BUF; const LAS char* vt = kt + T_KB;
#pragma unroll
        for (int hh = 0; hh < 2; ++hh) {
            f32x16 s = qk32<64, T_KS>(kt + (32 * hh + r32) * T_KS + hi * 16, qf);
            const int n0 = 64 * j + 32 * hh;
            if (relw - 16 * (n0 + 31) >= 790) {
#pragma unroll
                for (int r = 0; r < 16; ++r) s[r] = fast_exp2(s[r] + cfar) * inv_l;
            } else {
#pragma unroll
                for (int r = 0; r < 16; ++r) { const int rel = relq - 16 * (n0 + crow(r, hi)); s[r] = (rel >= 0) ? fast_exp2(s[r] + lut[(rel < 1023 ? rel : 1023) * 4 + hd] - ref) * inv_l : 0.f; }
            }
            float gsm[4], c3[4], pc3[4];
#pragma unroll
            for (int gi = 0; gi < 4; ++gi) { float a = (s[4 * gi] + s[4 * gi + 1]) + (s[4 * gi + 2] + s[4 * gi + 3]), b = s[4 * gi + 3];
                a += sx<1>(a); a += sx<2>(a); b += sx<1>(b); b += sx<2>(b); gsm[gi] = a; c3[gi] = b; }
#pragma unroll
            for (int gi = 0; gi < 4; ++gi) pc3[gi] = sx32(c3[gi], hi);
            const int b0 = 16 * j + 8 * hh + hi;
            if (hd == 0) {
                LAS float* ip = imp + (8 * wid + ql) * 256 + b0;
                if (hi == 1) {
#pragma unroll
                    for (int gi = 0; gi < 4; ++gi) ip[2 * gi] = gsm[gi] + pc3[gi];
                } else { ip[0] = gsm[0] + cprev; ip[2] = gsm[1] + pc3[0]; ip[4] = gsm[2] + pc3[1]; ip[6] = gsm[3] + pc3[2]; }
            }
            cprev = pc3[3];
            pv32<T_KS>(oa, vt + (32 * hh) * T_KS + vlane, pack8(s, 0), pack8(s, 1));
        }
        if (more) { LAS char* d_ = lds + ((j + 1) & 1) * T_BUF + srow * T_KS + sch * 16; *(LAS u32x4*)d_ = kq; *(LAS u32x4*)(d_ + T_KB) = vq; }
        kq = kr; vq = vr;
        LDS_BAR();
    }
    }
    TP_END(4, T.tp); }
#pragma unroll
    for (int i = 0; i < 16; ++i) { oa[0][i] *= gc; oa[1][i] *= gc; }
    store_ot(T.ATT + (size_t)tq * 1024 + 256 + h8 * 64, oa, hi);
    { TP_BEGIN(3)
    for (int rp_ = 0; rp_ < NSA_NREP(1); ++rp_) {
    unsigned ones = 0xffffffffu; asm volatile("" : "+v"(ones));
    if (qblk < 16) {
        if (tid <= qblk) { bq32[2 * tid] = ones; bq32[2 * tid + 1] = ones; }
    } else {
        if (tid == 0) { bq32[0] = ones; bq32[1] = ones; bq32[2 * qblk] = ones; bq32[2 * qblk + 1] = ones; bq32[2 * qblk - 2] = ones; bq32[2 * qblk - 1] = ones; }
        unsigned kv[8][4];
#pragma unroll
        for (int q = 0; q < 8; ++q)
#pragma unroll
            for (int i = 0; i < 4; ++i) { const int b = lane + 64 * i; kv[q][i] = (b >= 1 && b <= qblk - 2) ? __float_as_uint(imp[(8 * wid + q) * 256 + b]) + 1u : 0u; }
        unsigned T8[8];
#pragma unroll
        for (int q = 0; q < 8; ++q) T8[q] = 0u;
        for (int bit = 31; bit >= 0; --bit) {
#pragma unroll
            for (int q = 0; q < 8; ++q) { const unsigned t2 = T8[q] | (1u << bit);
                const int cnt = __builtin_popcountll(__builtin_amdgcn_ballot_w64(kv[q][0] >= t2)) + __builtin_popcountll(__builtin_amdgcn_ballot_w64(kv[q][1] >= t2))
                              + __builtin_popcountll(__builtin_amdgcn_ballot_w64(kv[q][2] >= t2)) + __builtin_popcountll(__builtin_amdgcn_ballot_w64(kv[q][3] >= t2));
                T8[q] = (cnt >= 13) ? t2 : T8[q]; }
        }
#pragma unroll
        for (int q = 0; q < 8; ++q) { const unsigned Tq = T8[q];
            int quota = 13 - (__builtin_popcountll(__builtin_amdgcn_ballot_w64(kv[q][0] > Tq)) + __builtin_popcountll(__builtin_amdgcn_ballot_w64(kv[q][1] > Tq))
                            + __builtin_popcountll(__builtin_amdgcn_ballot_w64(kv[q][2] > Tq)) + __builtin_popcountll(__builtin_amdgcn_ballot_w64(kv[q][3] > Tq)));
            const int qi = 8 * wid + q;
#pragma unroll
            for (int i = 0; i < 4; ++i) {
                const unsigned long long me = __builtin_amdgcn_ballot_w64(kv[q][i] == Tq); const int pe = __builtin_popcountll(me); const int take = pe < quota ? pe : quota;
                unsigned long long km = 0ull, mm = me; for (int t_ = 0; t_ < take; ++t_) { km |= mm & (0ull - mm); mm &= mm - 1ull; }
                quota -= take;
                const bool tie = (lane < 32 ? (unsigned)km >> lane : (unsigned)(km >> 32) >> (lane - 32)) & 1u;
                if (kv[q][i] > Tq || (kv[q][i] == Tq && tie)) (void)__hip_atomic_fetch_or(bq32 + 2 * (lane + 64 * i) + (qi >> 5), 1u << (qi & 31), __ATOMIC_RELAXED, __HIP_MEMORY_SCOPE_WORKGROUP);
            }
        }
    }
    }
    TP_END(3, T.tp); }
    __syncthreads();
    {
        LAS float* slot = (LAS float*)(lds + N_IMP);
        LAS unsigned short* items = (LAS unsigned short*)(lds + N_L);
        volatile LAS int* nitems = (volatile LAS int*)(lds + N_L + 768);
        LAS unsigned* smask = (LAS unsigned*)(lds + N_L + 832);
        LAS unsigned char* npv = (LAS unsigned char*)(lds + N_L + 896);
        LAS int* part = (LAS int*)(lds + N_REF + 1024);
        if (tid < 256) { int np = 0; if (qblk >= 16 && tid >= 1 && tid <= qblk - 2) { const unsigned long long mk = ((unsigned long long)bq32[2 * tid + 1] << 32) | bq32[2 * tid]; np = (__builtin_popcountll(mk) + 7) >> 3; } npv[tid] = (unsigned char)np; }
        __syncthreads();
        if (tid < 16) { int sm = 0;
#pragma unroll
            for (int k = 0; k < 16; ++k) sm += npv[16 * tid + k]; part[tid] = sm; }
        __syncthreads();
        if (tid == 0) { int run = 0;
#pragma unroll
            for (int k = 0; k < 16; ++k) { const int v = part[k]; part[k] = run; run += v; } *nitems = run; }
        __syncthreads();
        if (tid < 256) { int st = part[tid >> 4]; for (int k = 0; k < (tid & 15); ++k) st += npv[(tid & ~15) + k]; const int np = npv[tid]; for (int pp = 0; pp < np; ++pp) items[st + pp] = (unsigned short)(tid | (pp << 8)); }
        { const int q = tid >> 3, c8 = tid & 7; const bf16_t* src = T.PROJ + (size_t)(q0 + q) * 5632 + 768 + g * 256 + c8 * 32; LAS char* dst = lds + (q * 4 + (c8 >> 1)) * N_QS + (c8 & 1) * 64;
#pragma unroll
          for (int i = 0; i < 4; ++i) *(LAS u32x4*)(dst + 16 * i) = *(const u32x4*)(src + 8 * i); }
        __syncthreads();
        const bf16_t* ksg = T.KS + (size_t)g * 256 * 4096 + lane * 8;
        const bf16_t* vtg = T.VTS + (size_t)g * 256 * 4096 + lane * 8;
        const int jslot = r32 >> 2;
        const int myq = 8 * wid + ql; const unsigned qmlo = myq < 32 ? ((1u << myq) - 1u) : 0xffffffffu, qmhi = myq < 32 ? 0u : ((1u << (myq - 32)) - 1u);
        const float biasfar = lut[1023 * 4 + hd];
        float lpart = 0.f, lfull = 0.f; f32x16 os[2];
        for (int rp_ = 0; rp_ < NSA_NREP(2); ++rp_) { lpart = 0.f; lfull = 0.f;
#pragma unroll
        for (int i = 0; i < 16; ++i) { os[0][i] = 0.f; os[1][i] = 0.f; }
        bf16x8 kf[2][4], vf[2][2][2];
#define NSA_LDK(B) do { const bf16_t* p_ = ksg + (size_t)(B) * 4096; _Pragma("unroll") for (int hh = 0; hh < 2; ++hh) _Pragma("unroll") for (int d0 = 0; d0 < 4; ++d0) kf[hh][d0] = *(const bf16x8*)(p_ + (hh * 4 + d0) * 512); } while (0)
#define NSA_LDV(B) do { const bf16_t* p_ = vtg + (size_t)(B) * 4096; _Pragma("unroll") for (int hh = 0; hh < 2; ++hh) _Pragma("unroll") for (int dh = 0; dh < 2; ++dh) _Pragma("unroll") for (int s = 0; s < 2; ++s) vf[hh][dh][s] = *(const bf16x8*)(p_ + ((hh * 2 + dh) * 2 + s) * 512); } while (0)
#define NSA_SCORE(B, QF, INI, TS, OK, LS) do { \
            _Pragma("unroll") for (int hh = 0; hh < 2; ++hh) { _Pragma("unroll") for (int i = 0; i < 16; ++i) sc[hh][i] = (INI); \
                _Pragma("unroll") for (int d0 = 0; d0 < 4; ++d0) sc[hh] = mfma32(kf[hh][d0], (QF)[d0], sc[hh]); } \
            if (q0 - (64 * (B) + 63) >= 790) { _Pragma("unroll") for (int hh = 0; hh < 2; ++hh) _Pragma("unroll") for (int r = 0; r < 16; ++r) { const float p = (OK) ? fast_exp2(sc[hh][r]) : 0.f; sc[hh][r] = p; LS += p; } } \
            else { _Pragma("unroll") for (int hh = 0; hh < 2; ++hh) _Pragma("unroll") for (int r = 0; r < 16; ++r) { const int rel = (TS) - (64 * (B) + 32 * hh + crow(r, hi)); const int rc = rel < 0 ? 0 : (rel < 1023 ? rel : 1023); \
                const float p = ((OK) && rel >= 0) ? fast_exp2(sc[hh][r] + lut[rc * 4 + hd]) : 0.f; sc[hh][r] = p; LS += p; } } } while (0)
#define NSA_PV(O) do { _Pragma("unroll") for (int hh = 0; hh < 2; ++hh) { const bf16x8 p0 = pack8(sc[hh], 0), p1 = pack8(sc[hh], 1); \
            _Pragma("unroll") for (int dh = 0; dh < 2; ++dh) { (O)[dh] = mfma32(vf[hh][dh][0], p0, (O)[dh]); (O)[dh] = mfma32(vf[hh][dh][1], p1, (O)[dh]); } } } while (0)
        f32x16 sc[2];
        { TP_BEGIN(2) const int nf = qblk < 16 ? qblk + 1 : 3;
          for (int fi = 0; fi < nf; ++fi) { const int fb = qblk < 16 ? fi : (fi == 0 ? 0 : qblk - 2 + fi);
            NSA_LDK(fb); NSA_LDV(fb);
            const float ini = ((q0 - (64 * fb + 63) >= 790) ? biasfar : 0.f) - ref;
            NSA_SCORE(fb, qf, ini, tq, true, lpart);
            NSA_PV(os); } TP_END(2, T.tp); }
        TP_BEGIN(1)
        const int ni = *nitems; unsigned long long tpacc_ = 0;
        int it_b = -1, it_p = 0;
        if (wid < ni) { const int e = items[wid]; it_b = e & 255; it_p = e >> 8; NSA_LDK(it_b); NSA_LDV(it_b); }
        for (int i0 = 0; i0 < ni; i0 += 8) {
            const int inext = i0 + 8 + wid; int nb_ = -1, np_ = 0;
            if (inext < ni) { const int e = items[inext]; nb_ = e & 255; np_ = e >> 8; }
            unsigned long long msk = 0ull;
            unsigned long long tpa_ = 0; if (TPROBE == 11 || TPROBE == 12 || TPROBE == 13) tpa_ = tp_now();
            if (it_b >= 0) {
                unsigned long long m_ = ((unsigned long long)(unsigned)rfl((int)bq32[2 * it_b + 1]) << 32) | (unsigned)rfl((int)bq32[2 * it_b]);
                for (int i_ = 0; i_ < 8 * it_p; ++i_) m_ &= m_ - 1ull;
                unsigned long long t_ = m_; for (int i_ = 0; i_ < 8; ++i_) t_ &= t_ - 1ull;
                msk = m_ & ~t_;
                int qsel = -1; { unsigned long long mm = msk;
#pragma unroll
                    for (int j = 0; j < 8; ++j) { const int qj = mm ? (int)__builtin_ctzll(mm) : -1; mm &= mm - 1ull; if (jslot == j) qsel = qj; } }
                const bool valid = qsel >= 0; const int row = (valid ? qsel : 0) * 4 + hd, ts = q0 + (valid ? qsel : 0);
                const float ini = ((q0 - (64 * it_b + 63) >= 790) ? biasfar : 0.f) - refl[row];
                bf16x8 qv[4];
#pragma unroll
                for (int d0 = 0; d0 < 4; ++d0) qv[d0] = *(const LAS bf16x8*)(lds + row * N_QS + d0 * 32 + hi * 16);
                float ls = 0.f;
                NSA_SCORE(it_b, qv, ini, ts, valid, ls);
                if (nb_ >= 0) NSA_LDK(nb_);
                f32x16 ot[2];
#pragma unroll
                for (int i = 0; i < 16; ++i) { ot[0][i] = 0.f; ot[1][i] = 0.f; }
                NSA_PV(ot);
                if (nb_ >= 0) NSA_LDV(nb_);
                ls = sum32sym(ls);
                LAS float* sp = slot + (wid * 32 + r32) * N_OSTR;
#pragma unroll
                for (int dh = 0; dh < 2; ++dh)
#pragma unroll
                    for (int g4 = 0; g4 < 4; ++g4) *(LAS f32x4*)(sp + 32 * dh + 8 * g4 + 4 * hi) = (f32x4){ot[dh][4 * g4], ot[dh][4 * g4 + 1], ot[dh][4 * g4 + 2], ot[dh][4 * g4 + 3]};
                if (hi == 0) sp[64] = ls;
            }
            if (lane == 0) { smask[2 * wid] = (unsigned)msk; smask[2 * wid + 1] = (unsigned)(msk >> 32); }
            if (TPROBE == 11) tpacc_ += tp_now() - tpa_;
            if (TPROBE == 12 || TPROBE == 13) tpa_ = tp_now();
            LDS_BAR();
            if (TPROBE == 12) tpacc_ += tp_now() - tpa_;
            if (TPROBE == 13) tpa_ = tp_now();
            const unsigned smv = smask[lane & 15];
#pragma unroll
            for (int w = 0; w < 8; ++w) {
                const unsigned mlo = (unsigned)__builtin_amdgcn_readlane((int)smv, 2 * w), mhi = (unsigned)__builtin_amdgcn_readlane((int)smv, 2 * w + 1);
                const unsigned long long mw = ((unsigned long long)mhi << 32) | mlo;
                if ((unsigned)(mw >> (8 * wid)) & 0xffu) {
                    const bool has = (myq < 32 ? (mlo >> myq) : (mhi >> (myq - 32))) & 1u;
                    const int j = __builtin_popcount(mlo & qmlo) + __builtin_popcount(mhi & qmhi);
                    const LAS float* sp = slot + (w * 32 + (has ? j : 0) * 4 + hd) * N_OSTR;
                    f32x4 v[2][4];
#pragma unroll
                    for (int dh = 0; dh < 2; ++dh)
#pragma unroll
                        for (int g4 = 0; g4 < 4; ++g4) v[dh][g4] = *(const LAS f32x4*)(sp + 32 * dh + 8 * g4 + 4 * hi);
                    const float lv = sp[64];
                    if (has) {
#pragma unroll
                        for (int dh = 0; dh < 2; ++dh)
#pragma unroll
                            for (int g4 = 0; g4 < 4; ++g4) { os[dh][4 * g4] += v[dh][g4].x; os[dh][4 * g4 + 1] += v[dh][g4].y; os[dh][4 * g4 + 2] += v[dh][g4].z; os[dh][4 * g4 + 3] += v[dh][g4].w; }
                        lfull += lv; }
                }
            }
            if (TPROBE == 13) tpacc_ += tp_now() - tpa_;
            LDS_BAR();
            it_b = nb_; it_p = np_;
        }
        TP_END(1, T.tp);
        if ((TPROBE == 11 || TPROBE == 12 || TPROBE == 13) && lane == 0) atomicAdd(T.tp, tpacc_);
#undef NSA_LDK
#undef NSA_LDV
#undef NSA_SCORE
#undef NSA_PV
        }
        { const float f = gs / (sum32sym(lpart) + lfull);
#pragma unroll
          for (int i = 0; i < 16; ++i) { oa[0][i] = f * os[0][i]; oa[1][i] = f * os[1][i]; } }
        { const bf16_t* qp = T.PROJ + (size_t)tq * 5632 + 768 + h8 * 64 + hi * 8;
#pragma unroll
          for (int d0 = 0; d0 < 4; ++d0) qf[d0] = *(const bf16x8*)(qp + d0 * 16); }
        __syncthreads();
    }
    {
        const bf16_t* kw = T.KW + (size_t)g * 16384 * 64; const bf16_t* vw = T.PROJ + 1920 + g * 64;
        const int kt0 = qblk > 8 ? qblk - 8 : 0, ntw = qblk - kt0 + 1;
        float lw = 0.f; f32x16 ow[2];
        TP_BEGIN(5)
        for (int rp_ = 0; rp_ < NSA_NREP(3); ++rp_) { lw = 0.f;
#pragma unroll
        for (int i = 0; i < 16; ++i) { ow[0][i] = 0.f; ow[1][i] = 0.f; }
#define WIN_LD(t, K_, V_) do { K_ = *(const u32x4*)(kw + (size_t)(64 * (t) + srow) * 64 + sch * 8); V_ = *(const u32x4*)(vw + (size_t)(64 * (t) + srow) * 5632 + sch * 8); } while (0)
        u32x4 kq, vq;
        WIN_LD(kt0, kr, vr);
        { LAS char* d_ = lds + srow * T_KS + sch * 16; *(LAS u32x4*)d_ = kr; *(LAS u32x4*)(d_ + T_KB) = vr; }
        kq = kr; vq = vr;
        if (1 < ntw) WIN_LD(kt0 + 1, kq, vq);
        LDS_BAR();
        for (int j = 0; j < ntw; ++j) {
            const bool more = j + 1 < ntw;
            if (j + 2 < ntw) WIN_LD(kt0 + j + 2, kr, vr);
            const LAS char* kt = lds + (j & 1) * T_BUF; const LAS char* vt = kt + T_KB;
            f32x16 p[2];
#pragma unroll
            for (int hh = 0; hh < 2; ++hh) { p[hh] = qk32<64, T_KS>(kt + (32 * hh + r32) * T_KS + hi * 16, qf);
#pragma unroll
                for (int r = 0; r < 16; ++r) { const int rel = tq - (64 * (kt0 + j) + 32 * hh + crow(r, hi)); const bool valid = rel >= 0 && rel < 512;
                    const float e = valid ? fast_exp2(p[hh][r] + lut[(rel < 0 ? 0 : rel) * 4 + hd] - ref) : 0.f; p[hh][r] = e; lw += e; } }
            pv64<T_KS>(ow, vt + vlane, p[0], p[1]);
            if (more) { LAS char* d_ = lds + ((j + 1) & 1) * T_BUF + srow * T_KS + sch * 16; *(LAS u32x4*)d_ = kq; *(LAS u32x4*)(d_ + T_KB) = vq; }
            kq = kr; vq = vr;
            LDS_BAR();
        }
#undef WIN_LD
        }
        TP_END(5, T.tp);
        lw = sum32sym(lw);
        const float f = gw / lw;
#pragma unroll
        for (int i = 0; i < 16; ++i) { oa[0][i] += f * ow[0][i]; oa[1][i] += f * ow[1][i]; }
        { const bf16_t* ap = T.ATT + (size_t)tq * 1024 + 256 + h8 * 64;
#pragma unroll
          for (int dh = 0; dh < 2; ++dh)
#pragma unroll
              for (int g4 = 0; g4 < 4; ++g4) { const u32x2 w = *(const u32x2*)(ap + 32 * dh + 8 * g4 + 4 * hi); oa[dh][4 * g4] += bflo(w.x); oa[dh][4 * g4 + 1] += bfhi(w.x); oa[dh][4 * g4 + 2] += bflo(w.y); oa[dh][4 * g4 + 3] += bfhi(w.y); } }
        store_ot(T.ATT + (size_t)tq * 1024 + 256 + h8 * 64, oa, hi);
    }
    __syncthreads();
    TP_END(6, T.tp);
}
}
constexpr int S = 16384, DM = 1024, NPROJ = 5632, INC = 5560, DFF = 2816, EFF = 3584, NEXP = 8;
constexpr int NWAVES = 8;
constexpr float EPS = 1e-6f;
constexpr float QK_SCALE64 = 0.125f * LOG2E;
constexpr float QK_SCALE96 = 0.10206207261596575f * LOG2E;
#ifndef MK_MULTI
#define MK_MULTI 0
#endif
constexpr int PC_SBQ = 0, PC_SBK = 256, PC_SBV = 512, PC_NQ = 768, PC_NKC = 1280, PC_NVC = 1408, PC_NKS = 1536, PC_NVS = 1664, PC_NKW = 1792, PC_NVW = 1920,
              PC_CQ = 2048, PC_CKV = 2304, PC_KR = 2432, PC_NG = 2464, PC_GATE = 2560;
__host__ __device__ __forceinline__ int win_oldcol(int c) {
    if (c < 2048) return c; if (c < 2464) return c + 24; if (c < 2488) return 2048 + (c - 2464); if (c < 2560) return -1; return c - 72; }

constexpr size_t MiB = 1u << 20;
constexpr size_t WS_CTL = 0, CTL_ZERO_BYTES = 1 * MiB;
constexpr size_t WS_LW = 1 * MiB, LW_STRIDE = 18 * MiB;
constexpr size_t LW_WIN = 0, LW_SBO = 11 * MiB, LW_NSAO = LW_SBO + MiB / 2, LW_MLAO = LW_NSAO + MiB, LW_WOUT = LW_MLAO + MiB / 2, LW_WUQ = LW_WOUT + 2 * MiB, LW_WUKV = LW_WUQ + MiB / 4, LW_CW1 = LW_WUKV + MiB / 4;
constexpr size_t WS_DGU = 37 * MiB, WS_DDN = 48 * MiB;
constexpr size_t WS_Y = 1 * MiB;
constexpr size_t WS_H = 74 * MiB;
constexpr size_t WS_ROPE = 106 * MiB;
constexpr size_t WS_LUT8 = 108 * MiB, WS_B1P = WS_LUT8 + 256 * 1024, WS_B1 = WS_LUT8 + 512 * 1024, WS_ROUTE = 109 * MiB, WS_ROWTOK = WS_ROUTE + 512 * 1024;
constexpr size_t WS_R1 = 110 * MiB;
constexpr size_t WS_MGU = WS_R1, WS_MDN = WS_R1 + 112 * MiB;
constexpr size_t WS_R2 = 296 * MiB;
constexpr size_t R2_KC = 0, R2_VC = R2_KC + 4 * MiB + MiB / 4, R2_KS = R2_VC + 4 * MiB + MiB / 4, R2_VTS = R2_KS + 4 * MiB, R2_KW = R2_VTS + 4 * MiB, R2_GN = R2_KW + 4 * MiB,
                 R2_QM = R2_GN + 2 * MiB, R2_KM = R2_QM + 12 * MiB, R2_HID = R2_KM + 12 * MiB, R2_KCMP = R2_HID + 2 * MiB, R2_VCMP = R2_KCMP + MiB / 4, R2_ATT = R2_VCMP + MiB / 4 + MiB / 2,
                 R2_MRG = R2_ATT + 32 * MiB, R2_QRAW = R2_MRG, R2_KVRAW = R2_MRG + 16 * MiB, R2_HIDP = R2_MRG + 32 * MiB  , R2_END = R2_HIDP + 16 * MiB;
static_assert(R2_END <= 136 * MiB, "attention scratch");
constexpr size_t WS_END = 432 * MiB;
constexpr int KC_ROWS = S + 32;
constexpr int CW_TMO = 0, CW_BAR = 4096, CW_MOECNT = 16384, CW_NSAQ = 17408, CW_SPLIT = 18432;
constexpr int RING_BYTES = 131072, LDSCTL_OFF = RING_BYTES, MISC_OFF = LDSCTL_OFF + 320, LDS_BYTES = 147456;


#define LDS_WAIT() asm volatile("s_waitcnt lgkmcnt(0)" ::: "memory")
#define VM_WAIT() asm volatile("s_waitcnt vmcnt(0)" ::: "memory")
DI float wave_sum(float v) { v += sx<1>(v); v += sx<2>(v); v += sx<4>(v); v += sx<8>(v); v += sx<16>(v); return sum32sym(v); }

struct TrSrc { const float* a; const float* b; int ldn; int nsrc; int mode; };
DI f32x4 tr_fetch4(const TrSrc& s, int k, int n) {
    const f32x4 z = {0.f, 0.f, 0.f, 0.f};
    if (s.mode == 0) return n < s.nsrc ? *(const f32x4*)(s.a + (size_t)k * s.ldn + n) : z;
    if (s.mode == 1) { const int oc = win_oldcol(n); return oc >= 0 ? *(const f32x4*)(s.a + (size_t)k * s.ldn + oc) : z; }
    const int tile = n >> 8, w = n & 255; const long d = (w < 128) ? 0l : (long)((const char*)s.b - (const char*)s.a);
    return *(const f32x4*)((const float*)((const char*)s.a + d) + (size_t)k * s.ldn + 128 * tile + (w & 127));
}
DI void tr_load(const TrSrc& s, int kb, int nb, int lane, f32x4 (&v)[8]) {
    const int k0 = 64 * kb, n0 = 32 * nb, r8 = lane >> 3, n4 = (lane & 7) * 4;
#pragma unroll
    for (int i = 0; i < 8; ++i) v[i] = tr_fetch4(s, k0 + r8 + 8 * i, n0 + n4);
}
DI void tr_store(const f32x4 (&v)[8], int K, bf16_t* WT, LAS float* scr, int kb, int nb, int lane) {
    const int k0 = 64 * kb, n0 = 32 * nb, r8 = lane >> 3, n4 = (lane & 7) * 4;
#pragma unroll
    for (int i = 0; i < 8; ++i) { LAS float* d = scr + (r8 + 8 * i) * 33 + n4; d[0] = v[i].x; d[1] = v[i].y; d[2] = v[i].z; d[3] = v[i].w; }
    LDS_WAIT(); asm volatile("" ::: "memory");
    const int c = lane & 7;
#pragma unroll
    for (int j = 0; j < 4; ++j) { const int n = (lane >> 3) + 8 * j; const LAS float* p = scr + (8 * c) * 33 + n;
        u32x4 o; o.x = cvtpk(p[0 * 33], p[1 * 33]); o.y = cvtpk(p[2 * 33], p[3 * 33]); o.z = cvtpk(p[4 * 33], p[5 * 33]); o.w = cvtpk(p[6 * 33], p[7 * 33]);
        *(u32x4*)(WT + (size_t)(n0 + n) * K + k0 + 8 * c) = o; }
    LDS_WAIT(); asm volatile("" ::: "memory");
}
DI void tr_item(const TrSrc& s, int K, bf16_t* WT, LAS float* scr, int kb, int nb, int lane) { f32x4 v[8]; tr_load(s, kb, nb, lane, v); tr_store(v, K, WT, scr, kb, nb, lane); }
DI void tr_matrix(const TrSrc& s, int K, int ndst, bf16_t* WT, LAS float* scr, int gw, int ngw, int lane, int& off) {
    const int nblk = ndst / 32, nitems = (K / 64) * nblk;
    int st = gw - off; if (st < 0) st += ngw;
    if (st < nitems) { f32x4 v[8], w[8]; tr_load(s, st / nblk, st % nblk, lane, v);
        for (int it = st; it < nitems; it += ngw) { const int nx = it + ngw; if (nx < nitems) tr_load(s, nx / nblk, nx % nblk, lane, w);
            tr_store(v, K, WT, scr, it / nblk, it % nblk, lane);
#pragma unroll
            for (int i = 0; i < 8; ++i) v[i] = w[i]; } }
    off = (off + nitems) % ngw;
}

DI void tr_batch(const float* a, const float* b, size_t sstride, int ldn, int nsrc, int mode, int K, int ndst, bf16_t* WT, size_t dstride, int nexp, LAS float* scr, int gw, int ngw, int lane, int& off) {
    const int nblk = ndst / 32, per = (K / 64) * nblk, nitems = nexp * per;
    int st = gw - off; if (st < 0) st += ngw;
    if (st < nitems) { f32x4 v[8], w[8];
        { const int e = st / per, r = st % per; tr_load(TrSrc{a + (size_t)e * sstride, b ? b + (size_t)e * sstride : nullptr, ldn, nsrc, mode}, r / nblk, r % nblk, lane, v); }
        for (int it = st; it < nitems; it += ngw) { const int nx = it + ngw;
            if (nx < nitems) { const int e = nx / per, r = nx % per; tr_load(TrSrc{a + (size_t)e * sstride, b ? b + (size_t)e * sstride : nullptr, ldn, nsrc, mode}, r / nblk, r % nblk, lane, w); }
            { const int e = it / per, r = it % per; tr_store(v, K, WT + (size_t)e * dstride, scr, r / nblk, r % nblk, lane); }
#pragma unroll
            for (int i = 0; i < 8; ++i) v[i] = w[i]; } }
    off = (off + nitems) % ngw;
}

struct In {
    const float *x, *bias_table, *mix_norm, *w_in, *b_gate, *sb_w_o, *nsa_q_norm, *nsa_k_norm, *nsa_cmp_pos, *nsa_cmp_w1, *nsa_cmp_w2, *nsa_w_o, *mla_q_a_norm, *mla_kv_a_norm,
        *mla_w_uq, *mla_w_ukv, *mla_q_norm, *mla_k_norm, *mla_w_o, *w_out, *ffn_norm, *dense_w_gate, *dense_w_up, *dense_w_down, *moe_router, *moe_w_gate, *moe_w_up, *moe_w_down;
};
struct Args { In in; float* out; unsigned char* ws; int ph_lo, ph_hi; };

DI void rms_row(const float* xrow, const float* gain, bf16_t* orow, int lane, f32x4 (&v)[4]) {
    const f32x4* xr = (const f32x4*)xrow + lane; float s = 0.f;
#pragma unroll
    for (int j = 0; j < 4; ++j) { v[j] = xr[64 * j]; s += (v[j].x * v[j].x + v[j].y * v[j].y) + (v[j].z * v[j].z + v[j].w * v[j].w); }
    const float rstd = 1.f / sqrtf(wave_sum(s) * (1.f / 1024.f) + EPS);
    u32x2* o8 = (u32x2*)orow + lane;
#pragma unroll
    for (int j = 0; j < 4; ++j) { const f32x4 g = ((const f32x4*)gain)[lane + 64 * j]; v[j] = v[j] * rstd * g; u32x2 w; w.x = cvtpk(v[j].x, v[j].y); w.y = cvtpk(v[j].z, v[j].w); o8[64 * j] = w; }
}

DI int t5_bucket(int n) {
    if (n < 16) return n;
    int b = 16;
    b += n >= 21; b += n >= 27; b += n >= 35; b += n >= 46; b += n >= 59; b += n >= 77; b += n >= 99; b += n >= 128; b += n >= 166; b += n >= 216; b += n >= 280; b += n >= 363; b += n >= 470; b += n >= 609; b += n >= 790;
    return b;
}

struct MoeTab { int cnt[8]; int tb[9]; };
struct MoeGU {
    const volatile LAS int* tab; const bf16_t* Hb; const bf16_t* W; const int* rowtok; int t_lo, t_hi, G, c;
    DI bool next(int i, pg8::Unit& u) const {
        const int nrt = t_hi - t_lo; if (nrt <= 0) return false;
        const long L = (long)i * G + c; if (L >= (long)nrt * 28) return false;
        const int rt = t_lo + (int)(L % nrt), pn = (int)(L / nrt);
        int e = 0;
#pragma unroll
        for (int k = 1; k < 8; ++k) e += (tab[8 + k] <= rt) ? 1 : 0;
        const int j = rt - tab[8 + e], cnt = tab[e];
        u.a = Hb; u.b = W + ((size_t)e * 7168 + 256 * pn) * 1024; u.rows = rowtok + e * S + 256 * j; u.nvalid = (cnt - 256 * j) < 256 ? (cnt - 256 * j) : 256; u.pm = rt - t_lo; u.pn = pn; return true;
    }
};
struct MoeDN {
    const volatile LAS int* tab; const bf16_t* ACT; const bf16_t* W; int t_lo, t_hi, G, c;
    DI bool next(int i, pg8::Unit& u) const {
        const int nrt = t_hi - t_lo; if (nrt <= 0) return false;
        const long L = (long)i * G + c; if (L >= (long)nrt * 4) return false;
        const int rt = t_lo + (int)(L % nrt), pn = (int)(L / nrt);
        int e = 0;
#pragma unroll
        for (int k = 1; k < 8; ++k) e += (tab[8 + k] <= rt) ? 1 : 0;
        u.a = ACT + (size_t)(rt - t_lo) * 256 * EFF; u.b = W + ((size_t)e * 1024 + 256 * pn) * EFF; u.rows = nullptr; u.nvalid = 256; u.pm = rt; u.pn = pn; return true;
    }
};
constexpr int PH_PER_LAYER = 16, NPHASES = 1 + 2 * PH_PER_LAYER;
__global__ void __launch_bounds__(NWAVES * 64, 2) fwd_kernel(Args args) {
    extern __shared__ __attribute__((aligned(16))) unsigned char lds_raw[];
    LAS unsigned char* lds = (LAS unsigned char*)lds_raw;
    volatile LAS unsigned* MISC = (volatile LAS unsigned*)(lds + MISC_OFF);
    volatile LAS int* MTAB = (volatile LAS int*)(lds + MISC_OFF + 64);
    const int tid0 = threadIdx.x, wave = __builtin_amdgcn_readfirstlane(tid0 >> 6);
    const int G = gridDim.x, bid = blockIdx.x, vcu = (G % 8 == 0) ? (bid % 8) * (G / 8) + bid / 8 : bid;
    const int gw0 = vcu * NWAVES + wave, NGW = G * NWAVES;
    unsigned char* ws = args.ws; const In in = args.in;
    gu32* ctl = (gu32*)(ws + WS_CTL);
    for (int u = tid0; u < (LDS_BYTES - LDSCTL_OFF) / 4; u += NWAVES * 64) ((LAS unsigned*)(lds + LDSCTL_OFF))[u] = 0u;
    __syncthreads();
#if MK_MULTI
#define GRID_BAR() do { } while (0)
#else
    XcdBarrier bar = xcd_barrier_post((unsigned*)(ctl + CW_BAR), MISC + 8);
#define TPCTR ((unsigned long long*)(ctl + 20480))
#define GRID_BAR() do { TP_BEGIN(9) xcd_barrier(bar); TP_END(9, TPCTR); } while (0)
#endif
    const int lo = args.ph_lo, hi = args.ph_hi;
#ifndef ONLY_PHASE
#define ONLY_PHASE -1
#endif
#ifndef PHMASK
#define PHMASK 0x1ffff
#endif
#define PHON(n) ((ONLY_PHASE < 0 || ONLY_PHASE == (n)) && ((PHMASK >> ((n) == 99 ? 16 : (n))) & 1))
#ifndef REPMASK
#define REPMASK 0
#endif
#ifndef GREP
#define GREP 0
#endif
#define REPN(n) (((REPMASK >> ((n) == 99 ? 16 : (n))) & 1) ? 2 : 1)
#define IN(k) (lo <= (k) && (k) < hi)
#define SEAM(k) do { if (IN((k) + 1)) { unsigned long long tq0_ = 0; const bool tpk_ = (TPROBE >= 100) && (TPROBE - 100 == ((k) == 0 ? 16 : ((k) - 1) % 16)); if (tpk_) tq0_ = tp_now(); GRID_BAR(); if (tpk_ && lane_id() == 0) atomicAdd(TPCTR, tp_now() - tq0_); } } while (0)
#define PHASE_LOCALS int tid = wave * 64 + lane_id(); asm volatile("" : "+v"(tid)); const int lane = tid & 63; int gw = gw0; asm volatile("" : "+s"(gw)); unsigned char* wsl = ws; asm volatile("" : "+s"(wsl)); (void)lane; (void)gw; (void)wsl;

#define lw (wsl + WS_LW + (size_t)l * LW_STRIDE)
#define Hb ((bf16_t*)(wsl + WS_H))
#define PROJ ((bf16_t*)(wsl + WS_R1))
#define R2P(off) (wsl + WS_R2 + (off))
#define KC ((bf16_t*)R2P(R2_KC))
#define VC ((bf16_t*)R2P(R2_VC))
#define KS ((bf16_t*)R2P(R2_KS))
#define VTS ((bf16_t*)R2P(R2_VTS))
#define KW ((bf16_t*)R2P(R2_KW))
#define GN ((float*)R2P(R2_GN))
#define QM ((bf16_t*)R2P(R2_QM))
#define KM ((bf16_t*)R2P(R2_KM))
#define HID ((bf16_t*)R2P(R2_HID))
#define KCMP ((bf16_t*)R2P(R2_KCMP))
#define VCMP ((bf16_t*)R2P(R2_VCMP))
#define ATT ((bf16_t*)R2P(R2_ATT))
#define MRG ((bf16_t*)R2P(R2_MRG))
#define QRAW ((bf16_t*)R2P(R2_QRAW))
#define KVRAW ((bf16_t*)R2P(R2_KVRAW))
#define HIDP ((float*)R2P(R2_HIDP))
#define ROPE ((float*)(wsl + WS_ROPE))
#define LUT8 ((float*)(wsl + WS_LUT8))
#define B1P ((float*)(wsl + WS_B1P))
#define B1 ((float*)(wsl + WS_B1))
#define CONS (B1 + 2048)
#define ROUTE ((int*)(wsl + WS_ROUTE))
#define ROWTOK ((int*)(wsl + WS_ROWTOK))
    LAS float* scr = (LAS float*)(lds + wave * 16384);

    if (PHON(99) && IN(0)) { PHASE_LOCALS TP_BEGIN(36) for (int rep_ = 0; rep_ < REPN(99); ++rep_) {
        int troff = 0;
        for (int l = 0; l < 2; ++l) {
            tr_matrix(TrSrc{in.w_in + (size_t)l * 1024 * INC, nullptr, INC, INC, 1}, 1024, NPROJ, (bf16_t*)(lw + LW_WIN), scr, gw, NGW, lane, troff);
            tr_matrix(TrSrc{in.sb_w_o + (size_t)l * 256 * 1024, nullptr, 1024, 1024, 0}, 256, 1024, (bf16_t*)(lw + LW_SBO), scr, gw, NGW, lane, troff);
            tr_matrix(TrSrc{in.nsa_w_o + (size_t)l * 512 * 1024, nullptr, 1024, 1024, 0}, 512, 1024, (bf16_t*)(lw + LW_NSAO), scr, gw, NGW, lane, troff);
            tr_matrix(TrSrc{in.mla_w_o + (size_t)l * 256 * 1024, nullptr, 1024, 1024, 0}, 256, 1024, (bf16_t*)(lw + LW_MLAO), scr, gw, NGW, lane, troff);
            tr_matrix(TrSrc{in.w_out + (size_t)l * 1024 * 1024, nullptr, 1024, 1024, 0}, 1024, 1024, (bf16_t*)(lw + LW_WOUT), scr, gw, NGW, lane, troff);
            tr_matrix(TrSrc{in.mla_w_uq + (size_t)l * 256 * 384, nullptr, 384, 384, 0}, 256, 512, (bf16_t*)(lw + LW_WUQ), scr, gw, NGW, lane, troff);
            tr_matrix(TrSrc{in.mla_w_ukv + (size_t)l * 128 * 512, nullptr, 512, 512, 0}, 128, 512, (bf16_t*)(lw + LW_WUKV), scr, gw, NGW, lane, troff);
            for (int kv = 0; kv < 2; ++kv)
                tr_matrix(TrSrc{in.nsa_cmp_w1 + (size_t)(l * 2 + kv) * 2048 * 256, nullptr, 256, 256, 0}, 2048, 256, (bf16_t*)(lw + LW_CW1) + (size_t)kv * 256 * 2048, scr, gw, NGW, lane, troff);
        }
        tr_matrix(TrSrc{in.dense_w_gate, in.dense_w_up, DFF, DFF, 2}, 1024, 2 * DFF, (bf16_t*)(wsl + WS_DGU), scr, gw, NGW, lane, troff);
        tr_matrix(TrSrc{in.dense_w_down, nullptr, 1024, 1024, 0}, DFF, 1024, (bf16_t*)(wsl + WS_DDN), scr, gw, NGW, lane, troff);
        const int gt = vcu * 512 + tid, NT = G * 512;
        for (int i = gt; i < S * 16; i += NT) {
            const int pos = i >> 4, fi = i & 15; const float inv = powf(10000.f, -(float)fi / 16.f); const float ang = (float)pos * inv;
            const double rev = (double)ang * 0.15915494309189535; const float fr = (float)(rev - rint(rev));
            ROPE[i] = __builtin_amdgcn_cosf(fr); ROPE[S * 16 + i] = __builtin_amdgcn_sinf(fr); }
        for (int i = gt; i < 1024 * 8; i += NT) LUT8[i] = in.bias_table[t5_bucket(i >> 3) * 8 + (i & 7)] * LOG2E;
        if (gw == 0) {
            float bm = 0.f; for (int i = lane; i < 256; i += 64) bm = fmaxf(bm, fabsf(in.bias_table[i]));
            bm = fmaxf(bm, sx<1>(bm)); bm = fmaxf(bm, sx<2>(bm)); bm = fmaxf(bm, sx<4>(bm)); bm = fmaxf(bm, sx<8>(bm)); bm = fmaxf(bm, sx<16>(bm)); bm = fmaxf(bm, sx32(bm, lane >> 5));
            if (lane == 0) CONS[0] = bm * LOG2E;
            for (int ll = 0; ll < 2; ++ll) { float gm = 0.f; for (int i = lane; i < 192; i += 64) gm = fmaxf(gm, fabsf(in.nsa_k_norm[ll * 192 + i]));
                gm = fmaxf(gm, sx<1>(gm)); gm = fmaxf(gm, sx<2>(gm)); gm = fmaxf(gm, sx<4>(gm)); gm = fmaxf(gm, sx<8>(gm)); gm = fmaxf(gm, sx<16>(gm)); gm = fmaxf(gm, sx32(gm, lane >> 5));
                if (lane == 0) CONS[1 + ll] = gm;
                float km = 0.f; for (int i = lane; i < 96; i += 64) km = fmaxf(km, fabsf(in.mla_k_norm[ll * 96 + i]));
                km = fmaxf(km, sx<1>(km)); km = fmaxf(km, sx<2>(km)); km = fmaxf(km, sx<4>(km)); km = fmaxf(km, sx<8>(km)); km = fmaxf(km, sx<16>(km)); km = fmaxf(km, sx32(km, lane >> 5));
                if (lane == 0) CONS[3 + ll] = km; }
        }
        for (int it = gw; it < 512; it += NGW) {
            const int kc = it & 31, cb = (it >> 5) & 3, lk = it >> 7; const float* pos = in.nsa_cmp_pos + (size_t)lk * 2048; const float* w1 = in.nsa_cmp_w1 + (size_t)lk * 2048 * 256;
            float a = 0.f; for (int k = 64 * kc; k < 64 * kc + 64; ++k) a += pos[k] * w1[(size_t)k * 256 + 64 * cb + lane];
            B1P[(lk * 32 + kc) * 256 + 64 * cb + lane] = a; }
        for (int i = gt; i < 2 * 2 * 32 * 64 / 8; i += NT) { const int z = i / 256, r = i % 256; bf16_t* p = (z >> 1 ? VC : KC) + ((size_t)(z & 1) * KC_ROWS + S) * 64 + r * 8; *(u32x4*)p = (u32x4){0u, 0u, 0u, 0u}; }
        for (int m = gw; m < S; m += NGW) { f32x4 v[4]; rms_row(in.x + (size_t)m * 1024, in.mix_norm, Hb + (size_t)m * 1024, lane, v); }
            }
            TP_END(36, TPCTR);
        SEAM(0);
    }

    for (int l = 0; l < 2; ++l) {
        const int pb = 1 + PH_PER_LAYER * l;
        const float* x_in = (l == 0) ? in.x : args.out; float* x_out = args.out;
        if (l > 0 && PHON(0) && IN(pb + 0)) { PHASE_LOCALS TP_BEGIN(20) for (int rep_ = 0; rep_ < REPN(0); ++rep_) {
            for (int m = gw; m < S; m += NGW) { f32x4 v[4]; rms_row(x_in + (size_t)m * 1024, in.mix_norm + l * 1024, Hb + (size_t)m * 1024, lane, v); }
            }
            TP_END(20, TPCTR);
            SEAM(pb + 0);
        }
        if (PHON(1) && IN(pb + 1)) { PHASE_LOCALS TP_BEGIN(21) for (int rep_ = 0; rep_ < REPN(1); ++rep_) {
            pg8::StaticOrder So; So.init(Hb, (const bf16_t*)(lw + LW_WIN), 1024, 1024, S, NPROJ, G, bid);
            pg8::EpiStore E{PROJ, NPROJ, nullptr, QK_SCALE64, 0};
            pg8::gemm_phase<pg8::EpiStore, pg8::StaticOrder, true, false>(lds, 1024, 1024, 1024, So, E, wave);
#if GREP & 1
            pg8::gemm_phase<pg8::EpiStore, pg8::StaticOrder, true, false>(lds, 1024, 1024, 1024, So, E, wave);
#endif
            }
            TP_END(21, TPCTR);
            SEAM(pb + 1);
        }
        if (PHON(2) && IN(pb + 2)) { PHASE_LOCALS TP_BEGIN(22) for (int rep_ = 0; rep_ < REPN(2); ++rep_) {
            if (l == 0 && bid == 0) for (int i = tid; i < 1024; i += 512) { float a = 0.f; for (int kc = 0; kc < 32; ++kc) a += B1P[((i >> 8) * 32 + kc) * 256 + (i & 255)]; B1[i] = a; }
            for (int t = gw; t < S; t += NGW) {
                bf16_t* pr = PROJ + (size_t)t * NPROJ;
                {
                    const u32x4 w = *(const u32x4*)(pr + PC_NQ + lane * 8); float v[8] = {bflo(w.x), bfhi(w.x), bflo(w.y), bfhi(w.y), bflo(w.z), bfhi(w.z), bflo(w.w), bfhi(w.w)};
                    float ss = 0.f;
#pragma unroll
                    for (int e = 0; e < 8; ++e) ss += v[e] * v[e];
                    ss += sx<1>(ss); ss += sx<2>(ss); ss += sx<4>(ss);
                    const float rs = QK_SCALE64 / sqrtf(ss * (1.f / 64.f) + EPS); const float* gq = in.nsa_q_norm + l * 64 + 8 * (lane & 7);
                    u32x4 o; o.x = cvtpk(v[0] * rs * gq[0], v[1] * rs * gq[1]); o.y = cvtpk(v[2] * rs * gq[2], v[3] * rs * gq[3]); o.z = cvtpk(v[4] * rs * gq[4], v[5] * rs * gq[5]); o.w = cvtpk(v[6] * rs * gq[6], v[7] * rs * gq[7]);
                    *(u32x4*)(pr + PC_NQ + lane * 8) = o;
                }
                {
                    const int sec = lane >> 4, gg = (lane >> 3) & 1, d8 = 8 * (lane & 7);
                    const int col = (sec == 0 ? PC_NKS : sec == 1 ? PC_NKW : sec == 2 ? PC_NKC : PC_NVC) + (lane & 15) * 8;
                    const u32x4 w = *(const u32x4*)(pr + col); float v[8] = {bflo(w.x), bfhi(w.x), bflo(w.y), bfhi(w.y), bflo(w.z), bfhi(w.z), bflo(w.w), bfhi(w.w)};
                    float ss = 0.f;
#pragma unroll
                    for (int e = 0; e < 8; ++e) ss += v[e] * v[e];
                    ss += sx<1>(ss); ss += sx<2>(ss); ss += sx<4>(ss);
                    const float rs = 1.f / sqrtf(ss * (1.f / 64.f) + EPS);
                    u32x4 o = w;
                    if (sec < 2) { const float* gk = in.nsa_k_norm + (l * 3 + 1 + sec) * 64 + d8;
                        o.x = cvtpk(v[0] * rs * gk[0], v[1] * rs * gk[1]); o.y = cvtpk(v[2] * rs * gk[2], v[3] * rs * gk[3]); o.z = cvtpk(v[4] * rs * gk[4], v[5] * rs * gk[5]); o.w = cvtpk(v[6] * rs * gk[6], v[7] * rs * gk[7]); }
                    const int c8 = lane & 7; const size_t ksf = ((((size_t)(gg * 256 + (t >> 6)) * 2 + ((t >> 5) & 1)) * 4 + (c8 >> 1)) * 64 + (c8 & 1) * 32 + (t & 31)) * 8;
                    bf16_t* dst = (sec == 0 ? KS + ksf : (sec == 1 ? KW + ((size_t)gg * S + t) * 64 : sec == 2 ? KC + ((size_t)gg * KC_ROWS + t) * 64 : VC + ((size_t)gg * KC_ROWS + t) * 64) + d8);
                    *(u32x4*)dst = o;
                }
                {
                    const u32x2 w = *(const u32x2*)(pr + PC_CQ + lane * 4); float v[4] = {bflo(w.x), bfhi(w.x), bflo(w.y), bfhi(w.y)};
                    const float rs = 1.f / sqrtf(wave_sum((v[0] * v[0] + v[1] * v[1]) + (v[2] * v[2] + v[3] * v[3])) * (1.f / 256.f) + EPS); const float* ga = in.mla_q_a_norm + l * 256 + lane * 4;
                    u32x2 o; o.x = cvtpk(v[0] * rs * ga[0], v[1] * rs * ga[1]); o.y = cvtpk(v[2] * rs * ga[2], v[3] * rs * ga[3]); *(u32x2*)(pr + PC_CQ + lane * 4) = o;
                    const unsigned w2 = *(const unsigned*)(pr + PC_CKV + lane * 2); const float a = bflo(w2), b = bfhi(w2);
                    const float rs2 = 1.f / sqrtf(wave_sum(a * a + b * b) * (1.f / 128.f) + EPS); const float* gb = in.mla_kv_a_norm + l * 128 + lane * 2;
                    *(unsigned*)(pr + PC_CKV + lane * 2) = cvtpk(a * rs2 * gb[0], b * rs2 * gb[1]);
                }
                if (lane < 24) GN[(size_t)t * 24 + lane] = sigmoidf_(bf2f(pr[PC_NG + lane]));
            }
            for (int it = gw; it < 512; it += NGW) {
                const int gg = it >> 8, blk = it & 255; const bf16_t* src = PROJ + (size_t)(blk * 64) * NPROJ + PC_NVS + gg * 64 + lane; bf16_t* dstb = VTS + (size_t)(gg * 256 + blk) * 4096;
                for (int s8 = 0; s8 < 8; ++s8) { unsigned short e[8];
#pragma unroll
                    for (int j = 0; j < 8; ++j) { const int k = att::vts_key_of_slot(8 * s8 + j); e[j] = src[(size_t)k * NPROJ]; }
                    u32x4 o; o.x = e[0] | ((unsigned)e[1] << 16); o.y = e[2] | ((unsigned)e[3] << 16); o.z = e[4] | ((unsigned)e[5] << 16); o.w = e[6] | ((unsigned)e[7] << 16);
                    const int hh = s8 >> 2, ss = (s8 >> 1) & 1, h = s8 & 1;
                    *(u32x4*)(dstb + ((((hh * 2 + (lane >> 5)) * 2 + ss) * 64) + h * 32 + (lane & 31)) * 8) = o; }
            }
            }
            TP_END(22, TPCTR);
            SEAM(pb + 2);
        }
        if (PHON(3) && IN(pb + 3)) { PHASE_LOCALS TP_BEGIN(23) for (int rep_ = 0; rep_ < REPN(3); ++rep_) {
            const bool wide = (G >= 256);
            for (int job = 0; job < 2; ++job) {
                pg8::StaticOrder So; pg8::EpiStore E; int lda, ldb, K;
                if (job == 0) { lda = NPROJ; ldb = 256; K = 256; So.init(PROJ + PC_CQ, (const bf16_t*)(lw + LW_WUQ), lda, ldb, S, 512, wide ? 128 : G, wide ? (bid < 128 ? bid : -1) : bid); E = pg8::EpiStore{QRAW, 512, nullptr, 1.f, 0}; }
                else { lda = NPROJ; ldb = 128; K = 128; So.init(PROJ + PC_CKV, (const bf16_t*)(lw + LW_WUKV), lda, ldb, S, 512, wide ? 128 : G, wide ? (bid >= 128 && bid < 256 ? bid - 128 : -1) : bid); E = pg8::EpiStore{KVRAW, 512, nullptr, 1.f, 0}; }
                pg8::gemm_phase<pg8::EpiStore, pg8::StaticOrder, true, false>(lds, lda, ldb, K, So, E, wave);
#if GREP & 16
                pg8::gemm_phase<pg8::EpiStore, pg8::StaticOrder, true, false>(lds, lda, ldb, K, So, E, wave);
#endif
            }
            for (int jz = 0; jz < 16; ++jz) {
                const int z = jz >> 2, ks = jz & 3, kv = z >> 1, gg = z & 1;
                pg8::StaticOrder So; So.init((kv ? VC : KC) + (size_t)gg * KC_ROWS * 64 + ks * 512, (const bf16_t*)(lw + LW_CW1) + (size_t)kv * 256 * 2048 + ks * 512, 1024, 2048, 1024, 256, wide ? 4 : G, wide ? ((bid >= 128 + 4 * jz && bid < 132 + 4 * jz) ? bid - 128 - 4 * jz : -1) : bid);
                pg8::EpiF32 E{HIDP + (size_t)jz * 1024 * 256, 256};
                pg8::gemm_phase<pg8::EpiF32, pg8::StaticOrder, true, false>(lds, 1024, 2048, 512, So, E, wave);
            }
            }
            TP_END(23, TPCTR);
            SEAM(pb + 3);
        }
        if (PHON(4) && IN(pb + 4)) { PHASE_LOCALS TP_BEGIN(24) for (int rep_ = 0; rep_ < REPN(4); ++rep_) {
            const int kvb = (2 * vcu >= G) ? 1 : 0;
            { const float* w2g = in.nsa_cmp_w2 + (size_t)(l * 2 + kvb) * 256 * 64; LAS f32x4* w2l = (LAS f32x4*)lds;
#pragma unroll
              for (int i = 0; i < 8; ++i) w2l[tid + 512 * i] = *(const f32x4*)(w2g + (size_t)(tid + 512 * i) * 4); }
            __syncthreads();
            LAS unsigned short* ws16 = (LAS unsigned short*)(lds + 65536 + wave * 4096);
            for (int t = gw; t < S; t += NGW) {
                if (lane < 48) *(LAS u32x4*)(ws16 + 8 * lane) = *(const u32x4*)(QRAW + (size_t)t * 512 + 8 * lane);
                if (lane < 32) *(LAS u32x4*)(ws16 + 384 + (lane >> 3) * 96 + (lane & 7) * 8) = *(const u32x4*)(KVRAW + (size_t)t * 512 + (lane >> 3) * 128 + (lane & 7) * 8);
                else if (lane < 48) { const int hh_ = (lane - 32) >> 2, c_ = lane & 3; *(LAS u32x4*)(ws16 + 384 + hh_ * 96 + 64 + c_ * 8) = *(const u32x4*)(PROJ + (size_t)t * NPROJ + PC_KR + c_ * 8); }
                LDS_WAIT(); asm volatile("" ::: "memory");
                const int hd = lane >> 4, i = lane & 15; const float c = ROPE[t * 16 + i], s = ROPE[S * 16 + t * 16 + i];
                {   LAS unsigned short* src = ws16 + hd * 96 + i; float v[6]; float ss = 0.f;
#pragma unroll
                    for (int e = 0; e < 6; ++e) { v[e] = bf2f(src[16 * e]); ss += v[e] * v[e]; }
                    ss += sx<1>(ss); ss += sx<2>(ss); ss += sx<4>(ss); ss += sx<8>(ss);
                    const float rs = 1.f / sqrtf(ss * (1.f / 96.f) + EPS); const float* gq = in.mla_q_norm + l * 96 + i;
#pragma unroll
                    for (int e = 0; e < 6; ++e) v[e] = v[e] * rs * gq[16 * e];
                    const float x1 = v[4], x2 = v[5]; v[4] = x1 * c - x2 * s; v[5] = x2 * c + x1 * s;
#pragma unroll
                    for (int e = 0; e < 6; ++e) src[16 * e] = f2bf(v[e] * QK_SCALE96); }
                {   LAS unsigned short* src = ws16 + 384 + hd * 96 + i; float v[6]; float ss = 0.f;
#pragma unroll
                    for (int e = 0; e < 6; ++e) { v[e] = bf2f(src[16 * e]); ss += v[e] * v[e]; }
                    ss += sx<1>(ss); ss += sx<2>(ss); ss += sx<4>(ss); ss += sx<8>(ss);
                    const float rs = 1.f / sqrtf(ss * (1.f / 96.f) + EPS); const float* gk = in.mla_k_norm + l * 96 + i;
#pragma unroll
                    for (int e = 0; e < 6; ++e) v[e] = v[e] * rs * gk[16 * e];
                    const float x1 = v[4], x2 = v[5]; v[4] = x1 * c - x2 * s; v[5] = x2 * c + x1 * s;
#pragma unroll
                    for (int e = 0; e < 6; ++e) src[16 * e] = f2bf(v[e]); }
                LDS_WAIT(); asm volatile("" ::: "memory");
                if (lane < 48) { *(u32x4*)(QM + (size_t)t * 384 + 8 * lane) = *(const LAS u32x4*)(ws16 + 8 * lane); *(u32x4*)(KM + (size_t)t * 384 + 8 * lane) = *(const LAS u32x4*)(ws16 + 384 + 8 * lane); }
                LDS_WAIT(); asm volatile("" ::: "memory");
            }
            {
                LAS float* hs = (LAS float*)(lds + 65536 + wave * 4096); const LAS float* w2l = (const LAS float*)lds;
                const int hw = (kvb ? vcu - G / 2 : vcu) * NWAVES + wave, nhw = (kvb ? G - G / 2 : G / 2) * NWAVES;
                for (int it = hw; it < 2048; it += nhw) {
                    const int gg = it >> 10, n = it & 1023, z = kvb * 2 + gg;
                    { f32x4 hsum = *(const f32x4*)(B1 + (l * 2 + kvb) * 256 + lane * 4);
#pragma unroll
                      for (int ks = 0; ks < 4; ++ks) hsum += *(const f32x4*)(HIDP + ((size_t)(z * 4 + ks) * 1024 + n) * 256 + lane * 4);
                      *(LAS f32x4*)(hs + lane * 4) = (f32x4){siluf_(hsum.x), siluf_(hsum.y), siluf_(hsum.z), siluf_(hsum.w)}; }
                    LDS_WAIT(); asm volatile("" ::: "memory");
                    float a0 = 0.f, a1 = 0.f, a2 = 0.f, a3 = 0.f;
#pragma unroll 4
                    for (int j = 0; j < 256; j += 4) { const f32x4 h4 = *(const LAS f32x4*)(hs + j);
                        a0 += h4.x * w2l[j * 64 + lane]; a1 += h4.y * w2l[(j + 1) * 64 + lane]; a2 += h4.z * w2l[(j + 2) * 64 + lane]; a3 += h4.w * w2l[(j + 3) * 64 + lane]; }
                    const float a = (a0 + a1) + (a2 + a3);
                    if (kvb == 0) { const float rs = 1.f / sqrtf(wave_sum(a * a) * (1.f / 64.f) + EPS); KCMP[((size_t)gg * 1024 + n) * 64 + lane] = f2bf(a * rs * in.nsa_k_norm[(l * 3) * 64 + lane]); }
                    else VCMP[((size_t)gg * 1024 + n) * 64 + lane] = f2bf(a);
                    LDS_WAIT(); asm volatile("" ::: "memory");
                }
            }
            __syncthreads();
            }
            TP_END(24, TPCTR);
            SEAM(pb + 4);
        }
        if (PHON(5) && IN(pb + 5)) { PHASE_LOCALS TP_BEGIN(25) for (int rep_ = 0; rep_ < REPN(5); ++rep_) {
            __syncthreads();
            for (int r2_ = 0; r2_ < REPN(17); ++r2_) for (int u = vcu; u < 256; u += G) att::sb_unit((LAS char*)lds, PROJ, ATT, u >> 6, u & 63, wave);
            for (int r2_ = 0; r2_ < REPN(18); ++r2_) for (int p = vcu; p < 256; p += G) { const float mkb = 9.9f * CONS[3 + l]; att::mla_unit((LAS char*)lds, QM, KM, KVRAW, ATT, p >> 6, 127 - (p & 63), mkb, wave, TPCTR); att::mla_unit((LAS char*)lds, QM, KM, KVRAW, ATT, p >> 6, p & 63, mkb, wave, TPCTR); }
            att::NsaT T{PROJ, KCMP, VCMP, KS, VTS, KW, GN, LUT8, ATT, 8.08f * CONS[1 + l], CONS[0], (unsigned long long*)(ctl + 20480)};
            for (int r2_ = 0; r2_ < REPN(19); ++r2_) { volatile LAS int* qslot = (volatile LAS int*)(lds + MISC_OFF + 192); const int qg = (2 * vcu >= G) ? 1 : 0;
                for (;;) { __syncthreads(); if (tid == 0) *qslot = (int)__hip_atomic_fetch_add(ctl + CW_NSAQ + 64 * (4 * l + 2 * r2_ + qg), 1u, RLX_AGENT); __syncthreads();
                    const int u = *qslot; if (u >= 256) break; att::nsa_unit((LAS char*)lds, T, qg, 255 - u, wave); } }
            }
            TP_END(25, TPCTR);
            SEAM(pb + 5);
        }
        if (PHON(6) && IN(pb + 6)) { PHASE_LOCALS TP_BEGIN(26) for (int rep_ = 0; rep_ < REPN(6); ++rep_) {
            for (int mix = 0; mix < 3; ++mix) {
                const int K = (mix == 1) ? 512 : 256; const int acol = (mix == 0) ? 0 : (mix == 1) ? 256 : 768;
                const bf16_t* Bt = (const bf16_t*)(lw + (mix == 0 ? LW_SBO : mix == 1 ? LW_NSAO : LW_MLAO));
                pg8::StaticOrder So; So.init(ATT + acol, Bt, 1024, K, S, 1024, G, bid);
                pg8::EpiGate E{MRG, PROJ + PC_GATE + mix * 1024, NPROJ, in.b_gate + l * 3072 + mix * 1024, mix == 0 ? 1 : 0};
                pg8::gemm_phase<pg8::EpiGate, pg8::StaticOrder, true, false>(lds, 1024, K, K, So, E, wave);
            }
            }
            TP_END(26, TPCTR);
            SEAM(pb + 6);
        }
        if (PHON(7) && IN(pb + 7)) { PHASE_LOCALS TP_BEGIN(27) for (int rep_ = 0; rep_ < REPN(7); ++rep_) {
            pg8::StaticOrder So; So.init(MRG, (const bf16_t*)(lw + LW_WOUT), 1024, 1024, S, 1024, G, bid);
            pg8::EpiResid E{x_in, x_out};
            pg8::gemm_phase<pg8::EpiResid, pg8::StaticOrder, true, false>(lds, 1024, 1024, 1024, So, E, wave);
            }
            TP_END(27, TPCTR);
            SEAM(pb + 7);
        }
        if (PHON(8) && IN(pb + 8)) { PHASE_LOCALS TP_BEGIN(28) for (int rep_ = 0; rep_ < REPN(8); ++rep_) {
            if (l == 1) {
                int troff = 0;
                tr_batch(in.moe_w_gate, in.moe_w_up, (size_t)1024 * EFF, EFF, EFF, 2, 1024, 2 * EFF, (bf16_t*)(wsl + WS_MGU), (size_t)7168 * 1024, 8, scr, gw, NGW, lane, troff);
                tr_batch(in.moe_w_down, nullptr, (size_t)EFF * 1024, 1024, 1024, 0, EFF, 1024, (bf16_t*)(wsl + WS_MDN), (size_t)1024 * EFF, 8, scr, gw, NGW, lane, troff);
            }
            for (int m = gw; m < S; m += NGW) {
                f32x4 v[4]; rms_row(x_out + (size_t)m * 1024, in.ffn_norm + l * 1024, Hb + (size_t)m * 1024, lane, v);
                if (l == 1) {
                    float lg[8];
#pragma unroll
                    for (int e = 0; e < 8; ++e) lg[e] = 0.f;
#pragma unroll
                    for (int j = 0; j < 4; ++j)
#pragma unroll
                        for (int q = 0; q < 4; ++q) { const float* wr = in.moe_router + (size_t)(4 * lane + 256 * j + q) * 8; const f32x4 wa = *(const f32x4*)wr, wb = *(const f32x4*)(wr + 4); const float hv = v[j][q];
                            lg[0] += hv * wa.x; lg[1] += hv * wa.y; lg[2] += hv * wa.z; lg[3] += hv * wa.w; lg[4] += hv * wb.x; lg[5] += hv * wb.y; lg[6] += hv * wb.z; lg[7] += hv * wb.w; }
#pragma unroll
                    for (int e = 0; e < 8; ++e) lg[e] = wave_sum(lg[e]);
                    int e0 = 0; float v0 = lg[0];
#pragma unroll
                    for (int e = 1; e < 8; ++e) if (lg[e] > v0) { v0 = lg[e]; e0 = e; }
                    int e1 = -1; float v1 = -INFINITY;
#pragma unroll
                    for (int e = 0; e < 8; ++e) if (e != e0 && lg[e] > v1) { v1 = lg[e]; e1 = e; }
                    if (lane == 0) { const float w0 = 1.f / (1.f + __expf(v1 - v0)), w1 = 1.f - w0;
                        const int p0 = (int)__hip_atomic_fetch_add(ctl + CW_MOECNT + 64 * e0, 1u, RLX_AGENT), p1 = (int)__hip_atomic_fetch_add(ctl + CW_MOECNT + 64 * e1, 1u, RLX_AGENT);
                        ROWTOK[e0 * S + p0] = m; ROWTOK[e1 * S + p1] = m;
                        int* r = ROUTE + (size_t)m * 8; r[0] = e0; r[1] = e1; r[2] = p0; r[3] = p1; r[4] = __float_as_int(w0); r[5] = __float_as_int(w1); }
                }
            }
            }
            TP_END(28, TPCTR);
            SEAM(pb + 8);
        }
        if (l == 0) {
#define ACT0 ((bf16_t*)(wsl + WS_R1))
            if (PHON(9) && IN(pb + 9)) { PHASE_LOCALS TP_BEGIN(29) for (int rep_ = 0; rep_ < REPN(9); ++rep_) {
                pg8::StaticOrder So; So.init(Hb, (const bf16_t*)(wsl + WS_DGU), 1024, 1024, S, 2 * DFF, G, bid);
                pg8::EpiSwiglu E{ACT0, DFF};
                pg8::gemm_phase<pg8::EpiSwiglu, pg8::StaticOrder, true, false>(lds, 1024, 1024, 1024, So, E, wave);
#if GREP & 2
                pg8::gemm_phase<pg8::EpiSwiglu, pg8::StaticOrder, true, false>(lds, 1024, 1024, 1024, So, E, wave);
#endif
            }
            TP_END(29, TPCTR);
                SEAM(pb + 9);
            }
            if (PHON(10) && IN(pb + 10)) { PHASE_LOCALS TP_BEGIN(30) for (int rep_ = 0; rep_ < REPN(10); ++rep_) {
                pg8::StaticOrder So; So.init(ACT0, (const bf16_t*)(wsl + WS_DDN), DFF, DFF, S, 1024, G, bid);
                pg8::EpiResid E{x_out, x_out};
                pg8::gemm_phase<pg8::EpiResid, pg8::StaticOrder, true, false>(lds, DFF, DFF, DFF, So, E, wave);
            }
            TP_END(30, TPCTR);
                SEAM(pb + 10);
            }
        } else {
#define ACT1 ((bf16_t*)(wsl + WS_R2))
#define YB ((bf16_t*)(wsl + WS_Y))
            for (int ps = 0; ps < 2; ++ps) {
                if (PHON(11) && IN(pb + 9 + 2 * ps)) { PHASE_LOCALS TP_BEGIN(31) for (int rep_ = 0; rep_ < REPN(11); ++rep_) {
                    if (tid == 0) { int tb = 0; for (int e = 0; e < 8; ++e) { const int c = (int)__hip_atomic_load(ctl + CW_MOECNT + 64 * e, RLX_AGENT); MTAB[e] = c; MTAB[8 + e] = tb; tb += (c + 255) >> 8; } MTAB[16] = tb; }
                    __syncthreads();
                    const int T = MTAB[16], tlo = 64 * ps, thi = (ps == 1) ? T : (T < 64 ? T : 64);
                    MoeGU So{MTAB, Hb, (const bf16_t*)(wsl + WS_MGU), ROWTOK, tlo, thi, G, bid};
                    pg8::EpiSwiglu E{ACT1, EFF};
                    pg8::gemm_phase<pg8::EpiSwiglu, MoeGU, true, true>(lds, 1024, 1024, 1024, So, E, wave);
#if GREP & 4
                    pg8::gemm_phase<pg8::EpiSwiglu, MoeGU, true, true>(lds, 1024, 1024, 1024, So, E, wave);
#endif
            }
            TP_END(31, TPCTR);
                    SEAM(pb + 9 + 2 * ps);
                }
                if (PHON(12) && IN(pb + 10 + 2 * ps)) { PHASE_LOCALS TP_BEGIN(32) for (int rep_ = 0; rep_ < REPN(12); ++rep_) {
                    if (tid == 0) { int tb = 0; for (int e = 0; e < 8; ++e) { const int c = (int)__hip_atomic_load(ctl + CW_MOECNT + 64 * e, RLX_AGENT); MTAB[e] = c; MTAB[8 + e] = tb; tb += (c + 255) >> 8; } MTAB[16] = tb; }
                    __syncthreads();
                    const int T = MTAB[16], tlo = 64 * ps, thi = (ps == 1) ? T : (T < 64 ? T : 64);
                    MoeDN So{MTAB, ACT1, (const bf16_t*)(wsl + WS_MDN), tlo, thi, G, bid};
                    pg8::EpiStore E{YB, 1024, nullptr, 1.f, 0};
                    pg8::gemm_phase<pg8::EpiStore, MoeDN, true, false>(lds, EFF, EFF, EFF, So, E, wave);
#if GREP & 8
                    pg8::gemm_phase<pg8::EpiStore, MoeDN, true, false>(lds, EFF, EFF, EFF, So, E, wave);
#endif
            }
            TP_END(32, TPCTR);
                    SEAM(pb + 10 + 2 * ps);
                }
            }
            if (PHON(15) && IN(pb + 15)) { PHASE_LOCALS TP_BEGIN(35) for (int rep_ = 0; rep_ < REPN(15); ++rep_) {
                if (tid == 0) { int tb = 0; for (int e = 0; e < 8; ++e) { const int c = (int)__hip_atomic_load(ctl + CW_MOECNT + 64 * e, RLX_AGENT); MTAB[e] = c; MTAB[8 + e] = tb; tb += (c + 255) >> 8; } MTAB[16] = tb; }
                __syncthreads();
                for (int m = gw; m < S; m += NGW) {
                    const int* r = ROUTE + (size_t)m * 8; const int e0 = r[0], e1 = r[1]; const float w0 = __int_as_float(r[4]), w1 = __int_as_float(r[5]);
                    const bf16_t* y0 = YB + ((size_t)MTAB[8 + e0] * 256 + r[2]) * 1024; const bf16_t* y1 = YB + ((size_t)MTAB[8 + e1] * 256 + r[3]) * 1024;
                    float* xo = x_out + (size_t)m * 1024;
#pragma unroll
                    for (int j = 0; j < 4; ++j) { const int c = 4 * lane + 256 * j; f32x4 xv = *(const f32x4*)(xo + c); const u32x2 a = *(const u32x2*)(y0 + c), b = *(const u32x2*)(y1 + c);
                        xv.x += w0 * bflo(a.x) + w1 * bflo(b.x); xv.y += w0 * bfhi(a.x) + w1 * bfhi(b.x); xv.z += w0 * bflo(a.y) + w1 * bflo(b.y); xv.w += w0 * bfhi(a.y) + w1 * bfhi(b.y);
                        *(f32x4*)(xo + c) = xv; }
                }
            }
            TP_END(35, TPCTR);
                if (l == 0) SEAM(pb + 15);
            }
        }
    }
#if TPROBE != 0 && !MK_MULTI
    xcd_barrier(bar);
    if (bid == 0 && wave == 0 && lane_id() == 0) { const unsigned long long tot = __hip_atomic_load((unsigned long long*)(ctl + 20480), RLX_AGENT) / (unsigned long long)(G * NWAVES); const unsigned long long t0 = tp_now(); while (tp_now() - t0 < tot) __builtin_amdgcn_s_sleep(8); }
#endif
#undef IN
#undef SEAM
}

extern "C" void kernel_launch(void* const* d_in, const int* in_sizes, int n_in, void* d_out, int out_size, void* d_ws, size_t ws_size, hipStream_t stream) {
    static int grid = 0;
    if (grid == 0) {
        if (n_in != 28 || in_sizes[0] != S * DM || out_size != S * DM || ws_size < WS_END) { fprintf(stderr, "kernel_launch: unexpected problem (n_in %d, in0 %d, out %d, ws %zu < %zu); nothing launched\n", n_in, n_in > 0 ? in_sizes[0] : -1, out_size, ws_size, (size_t)WS_END); grid = -1; return; }
        int dev = 0, cus = 0, per_cu = 0;
        if (hipGetDevice(&dev) != hipSuccess || hipDeviceGetAttribute(&cus, hipDeviceAttributeMultiprocessorCount, dev) != hipSuccess) { grid = -1; return; }
        if (hipFuncSetAttribute((const void*)fwd_kernel, hipFuncAttributeMaxDynamicSharedMemorySize, LDS_BYTES) != hipSuccess) { fprintf(stderr, "kernel_launch: hipFuncSetAttribute failed\n"); grid = -1; return; }
        if (hipOccupancyMaxActiveBlocksPerMultiprocessor(&per_cu, (const void*)fwd_kernel, NWAVES * 64, LDS_BYTES) != hipSuccess || per_cu < 1) { fprintf(stderr, "kernel_launch: occupancy query reports %d blocks per CU\n", per_cu); (void)hipGetLastError(); }
        grid = cus;
    }
    if (grid < 0) return;
    if (hipMemsetAsync((char*)d_ws + WS_CTL, 0, CTL_ZERO_BYTES, stream) != hipSuccess) return;
    Args a{};
    const float** ip = (const float**)&a.in;
    for (int i = 0; i < 28; ++i) ip[i] = (const float*)d_in[i];
    a.out = (float*)d_out; a.ws = (unsigned char*)d_ws;
#if MK_MULTI
    for (int ph = 0; ph < NPHASES; ++ph) {
        if (ph >= 1 + 11 && ph < 1 + PH_PER_LAYER) continue;
        a.ph_lo = ph; a.ph_hi = ph + 1;
        hipLaunchKernelGGL(fwd_kernel, dim3(grid), dim3(NWAVES * 64), LDS_BYTES, stream, a);
    }
#else
    a.ph_lo = 0; a.ph_hi = NPHASES;
    hipLaunchKernelGGL(fwd_kernel, dim3(grid), dim3(NWAVES * 64), LDS_BYTES, stream, a);
#endif
    const hipError_t le = hipPeekAtLastError();
    if (le != hipSuccess) fprintf(stderr, "kernel_launch: launch failed: %s\n", hipGetErrorName(le));
}
```

```cpp
#include <hip/hip_runtime.h>
#include <cstdio>
#include <cstdint>
#include <cmath>

#define LAS __attribute__((address_space(3)))
#define GAS __attribute__((address_space(1)))
typedef unsigned short bf16_t;
typedef short bf16x8 __attribute__((ext_vector_type(8)));
typedef short s16x4 __attribute__((ext_vector_type(4)));
typedef float f32x2 __attribute__((ext_vector_type(2)));
typedef float f32x4 __attribute__((ext_vector_type(4)));
typedef float f32x16 __attribute__((ext_vector_type(16)));
typedef unsigned u32x2 __attribute__((ext_vector_type(2)));
typedef unsigned u32x4 __attribute__((ext_vector_type(4)));
typedef __bf16 bf16x2_t __attribute__((ext_vector_type(2)));
typedef GAS unsigned gu32;
#define RLX_AGENT __ATOMIC_RELAXED, __HIP_MEMORY_SCOPE_AGENT
#define DI __device__ __forceinline__

DI unsigned cvtpk(float lo, float hi) { f32x2 v = {lo, hi}; bf16x2_t b = __builtin_convertvector(v, bf16x2_t); return __builtin_bit_cast(unsigned, b); }
DI float bf2f(bf16_t b) { return __uint_as_float(((unsigned)b) << 16); }
DI float bflo(unsigned w) { return __uint_as_float(w << 16); }
DI float bfhi(unsigned w) { return __uint_as_float(w & 0xffff0000u); }
DI bf16_t f2bf(float f) { return (bf16_t)(cvtpk(f, 0.f) & 0xffffu); }
DI float fast_exp2(float x) { return __builtin_amdgcn_exp2f(x); }
DI float fast_log2(float x) { return __builtin_amdgcn_logf(x); }
DI float fast_rcp(float x) { return __builtin_amdgcn_rcpf(x); }
constexpr float LOG2E = 1.4426950408889634f;
DI float sigmoidf_(float x) { return fast_rcp(1.f + fast_exp2(-x * LOG2E)); }
DI float siluf_(float x) { return x * sigmoidf_(x); }
template <int K> DI unsigned sxu(unsigned v) { return (unsigned)__builtin_amdgcn_ds_swizzle((int)v, (K << 10) | 0x1f); }
template <int K> DI float sx(float v) { return __uint_as_float(sxu<K>(__float_as_uint(v))); }
DI unsigned sx32u(unsigned v, int hi) { auto rr = __builtin_amdgcn_permlane32_swap(v, v, false, false); return hi ? rr[0] : rr[1]; }
DI float sx32(float v, int hi) { return __uint_as_float(sx32u(__float_as_uint(v), hi)); }
DI float sum32sym(float v) { auto rr = __builtin_amdgcn_permlane32_swap(__float_as_uint(v), __float_as_uint(v), false, false); return __uint_as_float(rr[0]) + __uint_as_float(rr[1]); }

#ifndef TPROBE
#define TPROBE 0
#endif
DI int lane_id() { int l_; asm volatile("v_mbcnt_lo_u32_b32 %0, -1, 0\n\tv_mbcnt_hi_u32_b32 %0, -1, %0" : "=v"(l_)); return l_; }
DI unsigned long long tp_now() { return __builtin_amdgcn_s_memrealtime(); }
#define TP_BEGIN(id) unsigned long long tp_t0_ = 0; if (TPROBE == (id)) tp_t0_ = tp_now();
#define TP_END(id, ctr) do { if (TPROBE == (id)) { const unsigned long long d_ = tp_now() - tp_t0_; if (lane_id() == 0) atomicAdd((unsigned long long*)(ctr), d_); } } while (0)

namespace pg8 {
constexpr int BM = 256, BK = 64, HALF = 128, HTB = HALF * BK * 2, STAGE_BYTES = 8 * HTB, NXCD = 8, WGM = 8;
__host__ __device__ __forceinline__ int lds_byte(int r, int c) { const int st = (r >> 4) * 2 + (c >> 5), rr = r & 15, cc = c & 31, ob = rr * 64 + cc * 2; return st * 1024 + (ob ^ (((ob >> 9) & 1) << 5)); }
__host__ __device__ __forceinline__ void stage_rc(int b, int& R, int& C) { const int st = b / 1024, sb = b % 1024, swz = sb ^ (((sb >> 9) & 1) << 5); R = (st >> 1) * 16 + swz / 64; C = (st & 1) * 32 + (swz % 64) / 2; }
__host__ __device__ __forceinline__ int perm32(int rho) { const int n = rho >> 4, i = rho & 15; return 8 * (i >> 2) + 4 * n + (i & 3); }

struct Unit { const bf16_t* a; const bf16_t* b; const int* rows; int nvalid, pm, pn; };

struct StaticOrder {
    const bf16_t* A; const bf16_t* Bt; int lda, ldb, nM, nN, nwg, G, c;
    DI void init(const bf16_t* A_, const bf16_t* Bt_, int lda_, int ldb_, int M, int N, int G_, int c_) { A = A_; Bt = Bt_; lda = lda_; ldb = ldb_; nM = M / BM; nN = N / BM; nwg = nM * nN; G = G_; c = c_; }
    DI bool next(int i, Unit& u) const {
        if (c < 0 || c >= G) return false;
        const long L = (long)i * G + c; if (L >= nwg) return false;
        int wgid = (int)L; { const int q = nwg / NXCD, r = nwg % NXCD, xcd = wgid % NXCD, off = wgid / NXCD; wgid = (xcd < r ? xcd * (q + 1) : r * (q + 1) + (xcd - r) * q) + off; }
        const int nig = WGM * nN, gid = wgid / nig, fm = gid * WGM, gsz = (nM - fm) < WGM ? (nM - fm) : WGM;
        u.pm = fm + ((wgid % nig) % gsz); u.pn = (wgid % nig) / gsz;
        u.a = A + (size_t)u.pm * BM * lda; u.b = Bt + (size_t)u.pn * BM * ldb; u.rows = nullptr; u.nvalid = BM; return true;
    }
};

struct EpiStore {
    static constexpr bool PERM = true;
    bf16_t* O; int ldc; const float* bias; float scale0; int act;
    DI void operator()(const f32x4 (&acc)[2][2][4][2], const Unit& u, int wr, int wc, int fr, int fq) const {
        const int row0 = u.pm * BM + wr * 64 + fr, col0 = u.pn * BM + wc * 32 + 8 * fq;
        const float sc = (u.pn == 0) ? scale0 : 1.f;
        f32x4 bv[2][2];
#pragma unroll
        for (int bj = 0; bj < 2; ++bj)
#pragma unroll
            for (int n = 0; n < 2; ++n) bv[bj][n] = bias ? *(const f32x4*)(bias + col0 + bj * HALF + 4 * n) : (f32x4){0.f, 0.f, 0.f, 0.f};
#pragma unroll
        for (int ai = 0; ai < 2; ++ai)
#pragma unroll
            for (int m = 0; m < 4; ++m) { bf16_t* rowp = O + (size_t)(row0 + ai * HALF + m * 16) * ldc + col0;
#pragma unroll
                for (int bj = 0; bj < 2; ++bj) { f32x4 v0 = (acc[ai][bj][m][0] + bv[bj][0]) * sc, v1 = (acc[ai][bj][m][1] + bv[bj][1]) * sc;
                    if (act) {
#pragma unroll
                        for (int e = 0; e < 4; ++e) { v0[e] = siluf_(v0[e]); v1[e] = siluf_(v1[e]); } }
                    u32x4 w; w.x = cvtpk(v0[0], v0[1]); w.y = cvtpk(v0[2], v0[3]); w.z = cvtpk(v1[0], v1[1]); w.w = cvtpk(v1[2], v1[3]);
                    *(u32x4*)(rowp + bj * HALF) = w; } }
    }
};
struct EpiGate {
    static constexpr bool PERM = true;
    bf16_t* Mg; const bf16_t* glog; int ldg; const float* bg; int first;
    DI void operator()(const f32x4 (&acc)[2][2][4][2], const Unit& u, int wr, int wc, int fr, int fq) const {
        const int row0 = u.pm * BM + wr * 64 + fr, col0 = u.pn * BM + wc * 32 + 8 * fq;
        f32x4 bv[2][2];
#pragma unroll
        for (int bj = 0; bj < 2; ++bj)
#pragma unroll
            for (int n = 0; n < 2; ++n) bv[bj][n] = *(const f32x4*)(bg + col0 + bj * HALF + 4 * n);
#pragma unroll
        for (int ai = 0; ai < 2; ++ai)
#pragma unroll
            for (int m = 0; m < 4; ++m) { const size_t row = (size_t)(row0 + ai * HALF + m * 16);
#pragma unroll
                for (int bj = 0; bj < 2; ++bj) { const int col = col0 + bj * HALF;
                    const u32x4 gl = *(const u32x4*)(glog + row * ldg + col);
                    u32x4 old = (u32x4){0u, 0u, 0u, 0u}; if (!first) old = *(const u32x4*)(Mg + row * 1024 + col);
                    float g[8] = {bflo(gl.x), bfhi(gl.x), bflo(gl.y), bfhi(gl.y), bflo(gl.z), bfhi(gl.z), bflo(gl.w), bfhi(gl.w)};
                    float o[8] = {bflo(old.x), bfhi(old.x), bflo(old.y), bfhi(old.y), bflo(old.z), bfhi(old.z), bflo(old.w), bfhi(old.w)};
#pragma unroll
                    for (int e = 0; e < 4; ++e) { o[e] += sigmoidf_(g[e] + bv[bj][0][e]) * acc[ai][bj][m][0][e]; o[4 + e] += sigmoidf_(g[4 + e] + bv[bj][1][e]) * acc[ai][bj][m][1][e]; }
                    u32x4 w; w.x = cvtpk(o[0], o[1]); w.y = cvtpk(o[2], o[3]); w.z = cvtpk(o[4], o[5]); w.w = cvtpk(o[6], o[7]);
                    *(u32x4*)(Mg + row * 1024 + col) = w; } }
    }
};
struct EpiResid {
    static constexpr bool PERM = false;
    const float* xin; float* out;
    DI void operator()(const f32x4 (&acc)[2][2][4][2], const Unit& u, int wr, int wc, int fr, int fq) const {
        const int row0 = u.pm * BM + wr * 64 + fr, col0 = u.pn * BM + wc * 32 + 4 * fq;
#pragma unroll
        for (int ai = 0; ai < 2; ++ai)
#pragma unroll
            for (int m = 0; m < 4; ++m) { const size_t off = (size_t)(row0 + ai * HALF + m * 16) * 1024 + col0;
#pragma unroll
                for (int bj = 0; bj < 2; ++bj)
#pragma unroll
                    for (int n = 0; n < 2; ++n) { const f32x4 b = *(const f32x4*)(xin + off + bj * HALF + n * 16); *(f32x4*)(out + off + bj * HALF + n * 16) = b + acc[ai][bj][m][n]; }
                if (m & 1) asm volatile("" ::: "memory"); }
    }
};
struct EpiF32 {
    static constexpr bool PERM = false;
    float* O; int ldc;
    DI void operator()(const f32x4 (&acc)[2][2][4][2], const Unit& u, int wr, int wc, int fr_in, int fq_in) const {
        int fr = fr_in, fq = fq_in; asm volatile("" : "+v"(fr), "+v"(fq));
        const int row0 = u.pm * BM + wr * 64 + fr, col0 = u.pn * BM + wc * 32 + 4 * fq;
#pragma unroll
        for (int ai = 0; ai < 2; ++ai)
#pragma unroll
            for (int m = 0; m < 4; ++m) { float* rowp = O + (size_t)(row0 + ai * HALF + m * 16) * ldc + col0;
#pragma unroll
                for (int bj = 0; bj < 2; ++bj)
#pragma unroll
                    for (int n = 0; n < 2; ++n) *(f32x4*)(rowp + bj * HALF + n * 16) = acc[ai][bj][m][n]; }
    }
};
struct EpiSwiglu {
    static constexpr bool PERM = true;
    bf16_t* act; int ldact;
    DI void operator()(const f32x4 (&acc)[2][2][4][2], const Unit& u, int wr, int wc, int fr, int fq) const {
        const int row0 = u.pm * BM + wr * 64 + fr, col0 = u.pn * HALF + wc * 32 + 8 * fq;
#pragma unroll
        for (int ai = 0; ai < 2; ++ai)
#pragma unroll
            for (int m = 0; m < 4; ++m) { bf16_t* rowp = act + (size_t)(row0 + ai * HALF + m * 16) * ldact + col0;
                float o[8];
#pragma unroll
                for (int e = 0; e < 4; ++e) { o[e] = siluf_(acc[ai][0][m][0][e]) * acc[ai][1][m][0][e]; o[4 + e] = siluf_(acc[ai][0][m][1][e]) * acc[ai][1][m][1][e]; }
                u32x4 w; w.x = cvtpk(o[0], o[1]); w.y = cvtpk(o[2], o[3]); w.z = cvtpk(o[4], o[5]); w.w = cvtpk(o[6], o[7]);
                *(u32x4*)rowp = w; }
    }
};

template <class Epi, class Sched, bool ALIGN_EPI, bool GATHER>
__device__ __forceinline__ void gemm_phase(LAS unsigned char* lds, const int lda, const int ldb, const int K, const Sched& S, const Epi& E, const int wave_id) {
    int tid_l = wave_id * 64 + lane_id(); asm volatile("" : "+v"(tid_l));
    const int tid = tid_l, wid = __builtin_amdgcn_readfirstlane(tid >> 6), lane = tid & 63, wr = wid >> 2, wc = wid & 3, fr = lane & 15, fq = lane >> 4;
    const int nt = K / BK;
    unsigned voffB[2], vc0[2], vc1[2], vn0[2], vn1[2];
#pragma unroll
    for (int i = 0; i < 2; ++i) { int R, C; stage_rc(tid * 16 + i * 8192, R, C); const int Rb = Epi::PERM ? ((R & ~31) + perm32(R & 31)) : R;
        voffB[i] = (unsigned)(Rb * ldb + C) * 2u; vc0[i] = (unsigned)(R * lda + C) * 2u; vc1[i] = vc0[i]; vn0[i] = vc0[i]; vn1[i] = vc0[i]; }
    const size_t hsA = GATHER ? (size_t)0 : (size_t)HALF * lda * 2, hsB = (size_t)HALF * ldb * 2;
    const size_t kstep = (size_t)(BK * 2);
    const unsigned ldsw = (unsigned)wid * 1024u;
    const int aoff = lds_byte(wr * 64 + fr, fq * 8), boff = lds_byte(wc * 32 + fr, fq * 8);
#define PG8_SA(b, h) (((b) * 2 + (h)) * HTB)
#define PG8_SB(b, h) ((4 + (b) * 2 + (h)) * HTB)
#define PG8_STAGE(bufoff, gbase, voff) do { _Pragma("unroll") for (int _i = 0; _i < 2; ++_i) \
        __builtin_amdgcn_global_load_lds((const unsigned*)((const char*)(gbase) + (voff)[_i]), (LAS unsigned*)(lds + (bufoff) + ldsw + _i * 8192), 16, 0, 0); } while (0)
#define PG8_LDA(dst, b, h) do { _Pragma("unroll") for (int m = 0; m < 4; ++m) _Pragma("unroll") for (int k = 0; k < 2; ++k) dst[m][k] = *(const LAS bf16x8*)(lds + PG8_SA(b, h) + aoff + m * 2048 + k * 1024); } while (0)
#define PG8_LDB(dst, b, h) do { _Pragma("unroll") for (int n = 0; n < 2; ++n) _Pragma("unroll") for (int k = 0; k < 2; ++k) dst[n][k] = *(const LAS bf16x8*)(lds + PG8_SB(b, h) + boff + n * 2048 + k * 1024); } while (0)
#define PG8_MMA(ai, bj, At, Bt) do { __builtin_amdgcn_s_setprio(1); _Pragma("unroll") for (int m = 0; m < 4; ++m) _Pragma("unroll") for (int n = 0; n < 2; ++n) _Pragma("unroll") for (int k = 0; k < 2; ++k) \
        acc[ai][bj][m][n] = __builtin_amdgcn_mfma_f32_16x16x32_bf16(Bt[n][k], At[m][k], acc[ai][bj][m][n], 0, 0, 0); __builtin_amdgcn_s_setprio(0); } while (0)
#define PG8_WAIT_V(n) asm volatile("s_waitcnt vmcnt(" #n ")" ::: "memory")
#define PG8_WAIT_L(n) asm volatile("s_waitcnt lgkmcnt(" #n ")" ::: "memory")
#define PG8_BAR __builtin_amdgcn_s_barrier()
#define PG8_SCHED __builtin_amdgcn_sched_barrier(0)
#define PG8_GVOFF(U, o0, o1) do { if constexpr (GATHER) { _Pragma("unroll") for (int _i = 0; _i < 2; ++_i) { int R_, C_; stage_rc(tid * 16 + _i * 8192, R_, C_); \
        const int r0_ = R_, r1_ = R_ + HALF; const int t0_ = (U).rows[r0_ < (U).nvalid ? r0_ : 0], t1_ = (U).rows[r1_ < (U).nvalid ? r1_ : 0]; \
        o0[_i] = (unsigned)(t0_ * lda + C_) * 2u; o1[_i] = (unsigned)(t1_ * lda + C_) * 2u; } } } while (0)
    Unit cur, nxt; int ui = 0;
    if (!S.next(0, cur)) return;
    PG8_GVOFF(cur, vc0, vc1);
    f32x4 acc[2][2][4][2];
#pragma unroll
    for (int a = 0; a < 2; ++a)
#pragma unroll
        for (int b = 0; b < 2; ++b)
#pragma unroll
            for (int m = 0; m < 4; ++m)
#pragma unroll
                for (int n = 0; n < 2; ++n) acc[a][b][m][n] = (f32x4){0.f, 0.f, 0.f, 0.f};
    bf16x8 At[4][2], B0[2][2], B1[2][2];
    const char* cA = (const char*)cur.a; const char* cB = (const char*)cur.b;
    PG8_STAGE(PG8_SB(0, 0), cB, voffB); PG8_STAGE(PG8_SB(0, 1), cB + hsB, voffB); PG8_STAGE(PG8_SA(0, 0), cA, vc0); PG8_STAGE(PG8_SA(0, 1), cA + hsA, vc1);
    if (wr == 1) PG8_BAR;
    PG8_WAIT_V(2); PG8_BAR;
    PG8_STAGE(PG8_SB(1, 0), cB + kstep, voffB); PG8_STAGE(PG8_SA(1, 0), cA + kstep, vc0); PG8_STAGE(PG8_SB(1, 1), cB + hsB + kstep, voffB);
    PG8_WAIT_V(6); PG8_BAR;
    for (;;) {
        const bool has_next = S.next(ui + 1, nxt);
        const char* nA = has_next ? (const char*)nxt.a : cA; const char* nB = has_next ? (const char*)nxt.b : cB;
        if constexpr (GATHER) { if (has_next) { PG8_GVOFF(nxt, vn0, vn1); } else {
#pragma unroll
            for (int i = 0; i < 2; ++i) { vn0[i] = vc0[i]; vn1[i] = vc1[i]; } } }
        for (int t = 0; t < nt; t += 2) {
            const bool last = (t == nt - 2);
            const char* a1 = cA + (size_t)(t + 1) * kstep;
            const char* a2 = last ? nA : cA + (size_t)(t + 2) * kstep; const char* b2 = last ? nB : cB + (size_t)(t + 2) * kstep;
            const char* a3 = a2 + kstep; const char* b3 = b2 + kstep;
            unsigned v20[2], v21[2];
#pragma unroll
            for (int i = 0; i < 2; ++i) { v20[i] = (GATHER && last) ? vn0[i] : vc0[i]; v21[i] = GATHER ? (last ? vn1[i] : vc1[i]) : vc0[i]; }
            PG8_LDB(B0, 0, 0); PG8_LDB(B1, 0, 1); PG8_SCHED; PG8_LDA(At, 0, 0); PG8_STAGE(PG8_SA(1, 1), a1 + hsA, vc1);
            PG8_WAIT_V(8); PG8_WAIT_L(0); PG8_BAR; PG8_MMA(0, 0, At, B0); PG8_MMA(0, 1, At, B1); PG8_BAR; PG8_SCHED;
            PG8_LDA(At, 0, 1); PG8_STAGE(PG8_SB(0, 0), b2, voffB); PG8_STAGE(PG8_SB(0, 1), b2 + hsB, voffB); PG8_STAGE(PG8_SA(0, 0), a2, v20);
            PG8_WAIT_V(8); PG8_WAIT_L(0); PG8_BAR; PG8_MMA(1, 0, At, B0); PG8_MMA(1, 1, At, B1); PG8_BAR; PG8_SCHED;
            PG8_LDB(B0, 1, 0); PG8_LDB(B1, 1, 1); PG8_SCHED; PG8_LDA(At, 1, 0); PG8_STAGE(PG8_SA(0, 1), a2 + hsA, v21);
            PG8_WAIT_V(8); PG8_WAIT_L(0); PG8_BAR; PG8_MMA(0, 0, At, B0); PG8_MMA(0, 1, At, B1); PG8_BAR; PG8_SCHED;
            PG8_LDA(At, 1, 1); PG8_STAGE(PG8_SB(1, 0), b3, voffB); PG8_STAGE(PG8_SB(1, 1), b3 + hsB, voffB); PG8_STAGE(PG8_SA(1, 0), a3, v20);
            PG8_WAIT_V(8); PG8_WAIT_L(0); PG8_BAR; PG8_MMA(1, 0, At, B0); PG8_MMA(1, 1, At, B1); PG8_BAR; PG8_SCHED;
        }
        if constexpr (ALIGN_EPI) { if (wr == 0) PG8_BAR; }
        E(acc, cur, wr, wc, fr, fq);
        if (!has_next) break;
#pragma unroll
        for (int a = 0; a < 2; ++a)
#pragma unroll
            for (int b = 0; b < 2; ++b)
#pragma unroll
                for (int m = 0; m < 4; ++m)
#pragma unroll
                    for (int n = 0; n < 2; ++n) acc[a][b][m][n] = (f32x4){0.f, 0.f, 0.f, 0.f};
        cur = nxt; cA = nA; cB = nB; ++ui;
        if constexpr (GATHER) {
#pragma unroll
            for (int i = 0; i < 2; ++i) { vc0[i] = vn0[i]; vc1[i] = vn1[i]; } }
        if constexpr (ALIGN_EPI) { if (wr == 1) PG8_BAR; }
    }
    PG8_WAIT_V(0);
    if constexpr (!ALIGN_EPI) { if (wr == 0) PG8_BAR; }
    PG8_BAR;
#undef PG8_SA
#undef PG8_SB
#undef PG8_STAGE
#undef PG8_LDA
#undef PG8_LDB
#undef PG8_MMA
#undef PG8_WAIT_V
#undef PG8_WAIT_L
#undef PG8_BAR
#undef PG8_SCHED
#undef PG8_GVOFF
}
}
#define XB_TMO      128
#define XB_XCNT(j)  (256  + 64 * (j))
#define XB_XSUB(j)  (1280 + 64 * (j))
#define XB_XGEN(j)  (2304 + 64 * (j))
#define XB_TOP      3328
#define XB_TOPGEN   3392
#define XCD_BAR_WORDS 3456
#define XB_SPIN_CAP (1u << 18)

__device__ __forceinline__ unsigned xb_ld(unsigned* p)              { return __hip_atomic_load(p, __ATOMIC_RELAXED, __HIP_MEMORY_SCOPE_AGENT); }
__device__ __forceinline__ unsigned xb_add(unsigned* p, unsigned v) { return __hip_atomic_fetch_add(p, v, __ATOMIC_RELAXED, __HIP_MEMORY_SCOPE_AGENT); }
__device__ __forceinline__ unsigned xb_xcc_id() { return (unsigned)__builtin_amdgcn_s_getreg((3 << 11) | 20) & 0xFu; }
#define XB_SPIN(cond, bar) do { unsigned _sp = 0; while (cond) { __builtin_amdgcn_s_sleep(1); \
    if ((++_sp & 255u) == 0u) { if (xb_ld(&(bar)[XB_TMO])) break; if (_sp > XB_SPIN_CAP) { atomicAdd(&(bar)[XB_TMO], 1u); break; } } } } while (0)

struct XcdBarrier {
    unsigned* bar; unsigned x;
    volatile LAS unsigned* st;
};

__device__ __forceinline__ XcdBarrier xcd_barrier_post(unsigned* bar, volatile LAS unsigned* st) {
    XcdBarrier b; b.bar = bar; b.x = xb_xcc_id(); b.st = st;
    if (threadIdx.x == 0) (void)xb_add(&bar[XB_XCNT(b.x)], 1u);
    return b;
}
__device__ __forceinline__ void xcd_barrier_complete(unsigned* bar, unsigned x, unsigned& nloc, unsigned& nx) {
    const unsigned G = gridDim.x * gridDim.y * gridDim.z;
    unsigned sum, cnt, mine, sp = 0u;
    for (;;) {
        sum = 0u; cnt = 0u; mine = 0u;
#pragma unroll
        for (unsigned j = 0; j < 16; ++j) { const unsigned c = xb_ld(&bar[XB_XCNT(j)]); sum += c; cnt += (c > 0u) ? 1u : 0u; mine = (j == x) ? c : mine; }
        if (sum == G) break;
        __builtin_amdgcn_s_sleep(1);
        if ((++sp & 255u) == 0u) { if (xb_ld(&bar[XB_TMO])) break; if (sp > XB_SPIN_CAP) { atomicAdd(&bar[XB_TMO], 1u); break; } }
    }
    nloc = mine > 0u ? mine : 1u; nx = cnt > 0u ? cnt : 1u;
}

__device__ __forceinline__ void xcd_barrier(const XcdBarrier& b) {
    asm volatile("s_waitcnt vmcnt(0)" ::: "memory");
    __syncthreads();
    if (threadIdx.x == 0) {
        unsigned* bar = b.bar;
        __builtin_amdgcn_s_waitcnt(0);
        unsigned nloc = b.st[0], nx = b.st[1];
        if (nloc == 0u) { xcd_barrier_complete(bar, b.x, nloc, nx); b.st[0] = nloc; b.st[1] = nx; }
        const unsigned old = xb_add(&bar[XB_XSUB(b.x)], 1u);
        const unsigned gen = old / nloc;
        if (old + 1u == (gen + 1u) * nloc) {
            __builtin_amdgcn_fence(__ATOMIC_RELEASE, "agent");
            asm volatile("s_waitcnt vmcnt(0)" ::: "memory");
            const unsigned og = xb_add(&bar[XB_TOP], 1u);
            const unsigned tg = og / nx;
            if (og + 1u == (tg + 1u) * nx) xb_add(&bar[XB_TOPGEN], 1u);
            else XB_SPIN(xb_ld(&bar[XB_TOPGEN]) == tg, bar);
            __builtin_amdgcn_fence(__ATOMIC_ACQUIRE, "agent");
            xb_add(&bar[XB_XGEN(b.x)], 1u);
            asm volatile("s_waitcnt vmcnt(0)" ::: "memory");
        } else {
            XB_SPIN(xb_ld(&bar[XB_XGEN(b.x)]) == gen, bar);
            __builtin_amdgcn_fence(__ATOMIC_ACQUIRE, "agent");
            asm volatile("s_waitcnt vmcnt(0)" ::: "memory");
        }
    }
    __syncthreads();
}
namespace att {
typedef short v4i16_t __attribute__((ext_vector_type(4)));
DI f32x16 mfma32(bf16x8 a, bf16x8 b, f32x16 c) { return __builtin_amdgcn_mfma_f32_32x32x16_bf16(a, b, c, 0, 0, 0); }
DI f32x4 mfma16(bf16x8 a, bf16x8 b, f32x4 c) { return __builtin_amdgcn_mfma_f32_16x16x32_bf16(a, b, c, 0, 0, 0); }
DI int crow(int r, int hi) { return (r & 3) + 8 * (r >> 2) + 4 * hi; }
DI s16x4 vtr(const LAS char* p) { return __builtin_bit_cast(s16x4, __builtin_amdgcn_ds_read_tr16_b64_v4i16((LAS v4i16_t*)p)); }
DI int rfl(int x) { return __builtin_amdgcn_readfirstlane(x); }
constexpr float NEGBIG = -1e30f;
#define LDS_BAR() asm volatile("s_waitcnt lgkmcnt(0)\n\ts_barrier" ::: "memory")

template <int D, int KS> DI f32x16 qk32(const LAS char* kp, const bf16x8* qf, float init = 0.f) {
    f32x16 acc;
#pragma unroll
    for (int i = 0; i < 16; ++i) acc[i] = init;
    bf16x8 kfr[D / 16];
#pragma unroll
    for (int d0 = 0; d0 < D / 16; ++d0) kfr[d0] = *(const LAS bf16x8*)(kp + d0 * 32);
    asm volatile("" ::: "memory");
#pragma unroll
    for (int d0 = 0; d0 < D / 16; ++d0) acc = mfma32(kfr[d0], qf[d0], acc);
    return acc;
}
template <int D, int KS> DI void qk64(f32x16& a0, f32x16& a1, const LAS char* kp, const bf16x8* qf, float init = 0.f) {
#pragma unroll
    for (int i = 0; i < 16; ++i) { a0[i] = init; a1[i] = init; }
    bf16x8 k0[D / 16], k1[D / 16];
#pragma unroll
    for (int d0 = 0; d0 < D / 16; ++d0) { k0[d0] = *(const LAS bf16x8*)(kp + d0 * 32); k1[d0] = *(const LAS bf16x8*)(kp + 32 * KS + d0 * 32); }
    asm volatile("" ::: "memory");
#pragma unroll
    for (int d0 = 0; d0 < D / 16; ++d0) { a0 = mfma32(k0[d0], qf[d0], a0); a1 = mfma32(k1[d0], qf[d0], a1); }
}
template <int VS> DI void pv32(f32x16 (&o)[2], const LAS char* vp, bf16x8 pf0, bf16x8 pf1) {
    s16x4 t[2][4];
#pragma unroll
    for (int dh = 0; dh < 2; ++dh) { t[dh][0] = vtr(vp + dh * 64); t[dh][1] = vtr(vp + 8 * VS + dh * 64); t[dh][2] = vtr(vp + 16 * VS + dh * 64); t[dh][3] = vtr(vp + 24 * VS + dh * 64); }
    asm volatile("" ::: "memory");
#pragma unroll
    for (int dh = 0; dh < 2; ++dh) {
        const bf16x8 v0 = __builtin_shufflevector(t[dh][0], t[dh][1], 0, 1, 2, 3, 4, 5, 6, 7), v1 = __builtin_shufflevector(t[dh][2], t[dh][3], 0, 1, 2, 3, 4, 5, 6, 7);
        o[dh] = mfma32(v0, pf0, o[dh]); o[dh] = mfma32(v1, pf1, o[dh]);
    }
}
template <int VS> DI void pv64(f32x16 (&o)[2], const LAS char* vp, const f32x16& p0, const f32x16& p1);
DI bf16x8 pack8(const f32x16& p, int s) {
    u32x4 w; w.x = cvtpk(p[8 * s], p[8 * s + 1]); w.y = cvtpk(p[8 * s + 2], p[8 * s + 3]); w.z = cvtpk(p[8 * s + 4], p[8 * s + 5]); w.w = cvtpk(p[8 * s + 6], p[8 * s + 7]);
    return __builtin_bit_cast(bf16x8, w);
}
template <int VS> DI void pv64(f32x16 (&o)[2], const LAS char* vp, const f32x16& p0, const f32x16& p1) {
    s16x4 t[2][2][4];
#pragma unroll
    for (int hh = 0; hh < 2; ++hh)
#pragma unroll
        for (int dh = 0; dh < 2; ++dh)
#pragma unroll
            for (int k = 0; k < 4; ++k) t[hh][dh][k] = vtr(vp + (32 * hh + 8 * k) * VS + dh * 64);
    const bf16x8 pa0 = pack8(p0, 0), pa1 = pack8(p0, 1), pb0 = pack8(p1, 0), pb1 = pack8(p1, 1);
    asm volatile("" ::: "memory");
#pragma unroll
    for (int dh = 0; dh < 2; ++dh) {
        o[dh] = mfma32(__builtin_shufflevector(t[0][dh][0], t[0][dh][1], 0, 1, 2, 3, 4, 5, 6, 7), pa0, o[dh]);
        o[dh] = mfma32(__builtin_shufflevector(t[0][dh][2], t[0][dh][3], 0, 1, 2, 3, 4, 5, 6, 7), pa1, o[dh]);
        o[dh] = mfma32(__builtin_shufflevector(t[1][dh][0], t[1][dh][1], 0, 1, 2, 3, 4, 5, 6, 7), pb0, o[dh]);
        o[dh] = mfma32(__builtin_shufflevector(t[1][dh][2], t[1][dh][3], 0, 1, 2, 3, 4, 5, 6, 7), pb1, o[dh]);
    }
}
DI float max16(const f32x16& p) { float a = fmaxf(fmaxf(p[0], p[1]), fmaxf(p[2], p[3]));
#pragma unroll
    for (int r = 4; r < 16; r += 4) a = fmaxf(a, fmaxf(fmaxf(p[r], p[r + 1]), fmaxf(p[r + 2], p[r + 3]))); return a; }
DI void store_ot(bf16_t* dst, const f32x16 (&o)[2], int hi) {
#pragma unroll
    for (int dh = 0; dh < 2; ++dh)
#pragma unroll
        for (int g4 = 0; g4 < 4; ++g4) { u32x2 w; w.x = cvtpk(o[dh][4 * g4], o[dh][4 * g4 + 1]); w.y = cvtpk(o[dh][4 * g4 + 2], o[dh][4 * g4 + 3]); *(u32x2*)(dst + 32 * dh + 8 * g4 + 4 * hi) = w; }
}

#define ATT_SB() __builtin_amdgcn_sched_barrier(0)
template <int D, int KS, int VS> DI void step64(f32x16 (&o)[2], float& l, const LAS char* kp, const LAS char* vp, const bf16x8* qf, float init) {
    bf16x8 k0[D / 16], k1[D / 16];
#pragma unroll
    for (int d0 = 0; d0 < D / 16; ++d0) { k0[d0] = *(const LAS bf16x8*)(kp + d0 * 32); k1[d0] = *(const LAS bf16x8*)(kp + 32 * KS + d0 * 32); }
    s16x4 t[2][2][4];
#pragma unroll
    for (int hh = 0; hh < 2; ++hh)
#pragma unroll
        for (int dh = 0; dh < 2; ++dh)
#pragma unroll
            for (int k = 0; k < 4; ++k) t[hh][dh][k] = vtr(vp + (32 * hh + 8 * k) * VS + dh * 64);
    f32x16 a0, a1;
#pragma unroll
    for (int i = 0; i < 16; ++i) { a0[i] = init; a1[i] = init; }
    ATT_SB();
#pragma unroll
    for (int d0 = 0; d0 < D / 16; ++d0) a0 = mfma32(k0[d0], qf[d0], a0);
#pragma unroll
    for (int d0 = 0; d0 < D / 16 - 4; ++d0) a1 = mfma32(k1[d0], qf[d0], a1);
    ATT_SB();
    float ls = 0.f;
#pragma unroll
    for (int g = 0; g < 4; ++g) {
        a1 = mfma32(k1[D / 16 - 4 + g], qf[D / 16 - 4 + g], a1);
#pragma unroll
        for (int e = 0; e < 4; ++e) { a0[4 * g + e] = fast_exp2(a0[4 * g + e]); ls += a0[4 * g + e]; }
        asm volatile("" : "+v"(a0), "+v"(ls)); ATT_SB();
    }
    const bf16x8 pa0 = pack8(a0, 0), pa1 = pack8(a0, 1);
    ATT_SB();
#pragma unroll
    for (int g = 0; g < 4; ++g) {
        const int dh = g & 1, s = g >> 1;
        o[dh] = mfma32(__builtin_shufflevector(t[0][dh][2 * s], t[0][dh][2 * s + 1], 0, 1, 2, 3, 4, 5, 6, 7), s ? pa1 : pa0, o[dh]);
#pragma unroll
        for (int e = 0; e < 4; ++e) { a1[4 * g + e] = fast_exp2(a1[4 * g + e]); ls += a1[4 * g + e]; }
        asm volatile("" : "+v"(a1), "+v"(ls)); ATT_SB();
    }
    const bf16x8 pb0 = pack8(a1, 0), pb1 = pack8(a1, 1);
    ATT_SB();
#pragma unroll
    for (int g = 0; g < 4; ++g) { const int dh = g & 1, s = g >> 1;
        o[dh] = mfma32(__builtin_shufflevector(t[1][dh][2 * s], t[1][dh][2 * s + 1], 0, 1, 2, 3, 4, 5, 6, 7), s ? pb1 : pb0, o[dh]); }
    l += ls;
}

constexpr int MLA_KS = 208, MLA_VS = 144, MLA_KB = 128 * MLA_KS, MLA_VB = 128 * MLA_VS, MLA_BUF = MLA_KB + MLA_VB;
DI void mla_unit(LAS char* lds, const bf16_t* QM, const bf16_t* KM, const bf16_t* KV, bf16_t* ATT, int head, int qb, float kb, int wave_id, unsigned long long* tp) {
    TP_BEGIN(7) unsigned long long tpacc_ = 0, tpa_ = 0;
    int tid_l = wave_id * 64 + lane_id(); asm volatile("" : "+v"(tid_l));
    const int tid = tid_l, lane = tid & 63, wid = rfl(tid >> 6), r32 = lane & 31, hi = lane >> 5, half = wid >> 2, wq = wid & 3;
    const int q0 = qb * 128, qpos = q0 + 32 * wq + r32, nsuper = qb + 1;
    bf16x8 qf[6];
    { const bf16_t* qp = QM + (size_t)qpos * 384 + head * 96 + hi * 8;
#pragma unroll
      for (int d0 = 0; d0 < 6; ++d0) qf[d0] = *(const bf16x8*)(qp + d0 * 16); }
    float nref;
    { float qs = 0.f;
#pragma unroll
      for (int d0 = 0; d0 < 6; ++d0)
#pragma unroll
          for (int e = 0; e < 8; ++e) { const float v = __uint_as_float(((unsigned)(unsigned short)qf[d0][e]) << 16); qs += v * v; }
      qs += sx32(qs, hi); nref = -sqrtf(qs) * kb; }
    u32x4 kr[3], vr[2];
#define MLA_LOAD(i) do { _Pragma("unroll") for (int j = 0; j < 3; ++j) { const int c = tid + 512 * j, row = c / 12, ch = c % 12; kr[j] = *(const u32x4*)(KM + (size_t)(128 * (i) + row) * 384 + head * 96 + ch * 8); } \
        _Pragma("unroll") for (int j = 0; j < 2; ++j) { const int c = tid + 512 * j, row = c >> 3, ch = c & 7; vr[j] = *(const u32x4*)(KV + (size_t)(128 * (i) + row) * 512 + head * 128 + 64 + ch * 8); } } while (0)
#define MLA_STORE(b) do { LAS char* kb_ = lds + (b) * MLA_BUF; _Pragma("unroll") for (int j = 0; j < 3; ++j) { const int c = tid + 512 * j, row = c / 12, ch = c % 12; *(LAS u32x4*)(kb_ + row * MLA_KS + ch * 16) = kr[j]; } \
        _Pragma("unroll") for (int j = 0; j < 2; ++j) { const int c = tid + 512 * j, row = c >> 3, ch = c & 7; *(LAS u32x4*)(kb_ + MLA_KB + row * MLA_VS + ch * 16) = vr[j]; } } while (0)
    MLA_LOAD(0); MLA_STORE(0); __syncthreads();
    float l = 0.f; f32x16 o[2];
#pragma unroll
    for (int i = 0; i < 16; ++i) { o[0][i] = 0.f; o[1][i] = 0.f; }
    const int vlane = (4 * hi + ((lane & 15) >> 2)) * MLA_VS + 2 * (16 * ((lane >> 4) & 1) + 4 * (lane & 3));
    for (int i = 0; i < nsuper; ++i) {
        const bool more = i + 1 < nsuper;
        if (more) MLA_LOAD(i + 1);
        const LAS char* kb_ = lds + (i & 1) * MLA_BUF; const LAS char* vb = kb_ + MLA_KB;
        const bool diag = (i == nsuper - 1);
        if (TPROBE == 14 || TPROBE == 15 || TPROBE == 16) tpa_ = tp_now();
        if (!(diag && half == 1 && wq < 2)) {
            const int koff = 64 * half;
            if (!diag) step64<96, MLA_KS, MLA_VS>(o, l, kb_ + (koff + r32) * MLA_KS + hi * 16, vb + koff * MLA_VS + vlane, qf, nref);
            else {
            f32x16 p0, p1; qk64<96, MLA_KS>(p0, p1, kb_ + (koff + r32) * MLA_KS + hi * 16, qf, nref);
            { const int kbase = 128 * i + koff;
#pragma unroll
                for (int r = 0; r < 16; ++r) { const int k0 = kbase + crow(r, hi); p0[r] = (k0 > qpos) ? 0.f : fast_exp2(p0[r]); p1[r] = (k0 + 32 > qpos) ? 0.f : fast_exp2(p1[r]); } }
#pragma unroll
            for (int r = 0; r < 16; ++r) l += p0[r] + p1[r];
            pv64<MLA_VS>(o, vb + koff * MLA_VS + vlane, p0, p1);
            }
        }
        if (TPROBE == 15) tpacc_ += tp_now() - tpa_;
        if (TPROBE == 16) tpa_ = tp_now();
        if (more) MLA_STORE((i + 1) & 1);
        if (TPROBE == 16) tpacc_ += tp_now() - tpa_;
        if (TPROBE == 14) tpa_ = tp_now();
        __syncthreads();
        if (TPROBE == 14) tpacc_ += tp_now() - tpa_;
    }
#undef MLA_LOAD
#undef MLA_STORE
    l = sum32sym(l);
    LAS float* mrg = (LAS float*)lds + (wq * 64 + lane) * 34;
    if (half == 1) { mrg[1] = l;
#pragma unroll
        for (int r = 0; r < 16; ++r) { mrg[2 + r] = o[0][r]; mrg[18 + r] = o[1][r]; } }
    __syncthreads();
    if (half == 0) {
        const float inv = 1.f / (l + mrg[1]);
#pragma unroll
        for (int r = 0; r < 16; ++r) { o[0][r] = (o[0][r] + mrg[2 + r]) * inv; o[1][r] = (o[1][r] + mrg[18 + r]) * inv; }
        store_ot(ATT + (size_t)qpos * 1024 + 768 + head * 64, o, hi);
    }
    __syncthreads();
    TP_END(7, tp);
    if ((TPROBE == 14 || TPROBE == 15 || TPROBE == 16) && lane == 0) atomicAdd(tp, tpacc_);
}

constexpr int T_KS = 144, T_KB = 64 * T_KS, T_BUF = 2 * T_KB;
DI void sb_half(f32x16 (&o)[2], float& R, const LAS char* ktile, const LAS char* vtile, const bf16x8* qf, int kb, int hh, int qpos, int r32, int hi, int vlane) {
    f32x16 z = qk32<64, T_KS>(ktile + (32 * hh + r32) * T_KS + hi * 16, qf);
    float ls[16];
#pragma unroll
    for (int r = 0; r < 16; ++r) { const bool valid = (kb + crow(r, hi)) < qpos; const float az = fabsf(z[r]);
        const float sp = fmaxf(z[r], 0.f) + fast_log2(1.f + fast_exp2(-az)); ls[r] = valid ? -sp : 0.f; }
    float T[4], U[4];
#pragma unroll
    for (int g = 0; g < 4; ++g) { ls[4 * g + 2] += ls[4 * g + 3]; ls[4 * g + 1] += ls[4 * g + 2]; ls[4 * g] += ls[4 * g + 1]; T[g] = ls[4 * g]; }
#pragma unroll
    for (int g = 0; g < 4; ++g) U[g] = sx32(T[g], hi);
    float H[4]; float sp = 0.f;
#pragma unroll
    for (int g = 3; g >= 0; --g) { H[g] = sp + (hi == 0 ? U[g] : 0.f); sp += T[g] + U[g]; }
#pragma unroll
    for (int r = 0; r < 16; ++r) { const bool valid = (kb + crow(r, hi)) < qpos; const float lw = z[r] + R + H[r >> 2] + ls[r]; z[r] = valid ? fast_exp2(lw) : 0.f; }
    R += sp;
    pv32<T_KS>(o, vtile + (32 * hh) * T_KS + vlane, pack8(z, 0), pack8(z, 1));
}
DI void sb_unit(LAS char* lds, const bf16_t* PROJ, bf16_t* ATT, int head, int qb, int wave_id) {
    int tid_l = wave_id * 64 + lane_id(); asm volatile("" : "+v"(tid_l));
    const int tid = tid_l, lane = tid & 63, wid = rfl(tid >> 6), r32 = lane & 31, hi = lane >> 5;
    const int q0 = qb * 256, wq0 = q0 + 32 * wid, qpos = wq0 + r32;
    bf16x8 qf[4];
    { const bf16_t* qp = PROJ + (size_t)qpos * 5632 + head * 64 + hi * 8;
#pragma unroll
      for (int d0 = 0; d0 < 4; ++d0) qf[d0] = *(const bf16x8*)(qp + d0 * 16); }
    const int srow = tid >> 3, sch = tid & 7;
    u32x4 kr, vr;
#define SB_LOAD(t) do { const bf16_t* p_ = PROJ + (size_t)(64 * (t) + srow) * 5632 + head * 64 + sch * 8; kr = *(const u32x4*)(p_ + 256); vr = *(const u32x4*)(p_ + 512); } while (0)
#define SB_STORE(b) do { LAS char* d_ = lds + (b) * T_BUF + srow * T_KS + sch * 16; *(LAS u32x4*)d_ = kr; *(LAS u32x4*)(d_ + T_KB) = vr; } while (0)
    volatile LAS int* flags = (volatile LAS int*)(lds + 2 * T_BUF);
    int t = 4 * qb + 3;
    SB_LOAD(t); SB_STORE(0); __syncthreads();
    float R = 0.f; f32x16 o[2];
#pragma unroll
    for (int i = 0; i < 16; ++i) { o[0][i] = 0.f; o[1][i] = 0.f; }
    const int vlane = (4 * hi + ((lane & 15) >> 2)) * T_KS + 2 * (16 * ((lane >> 4) & 1) + 4 * (lane & 3));
    bool done = false;
    for (int it = 0;; ++it) {
        const bool more = t > 0;
        if (more) SB_LOAD(t - 1);
        const LAS char* kt = lds + (it & 1) * T_BUF; const LAS char* vt = kt + T_KB;
        if (!done && 64 * t <= wq0 + 30) {
            if (64 * t + 32 <= wq0 + 30) sb_half(o, R, kt, vt, qf, 64 * t + 32, 1, qpos, r32, hi, vlane);
            sb_half(o, R, kt, vt, qf, 64 * t, 0, qpos, r32, hi, vlane);
            done = __all(R < -150.f) != 0;
        }
        if (lane == 0) flags[(it & 1) * 8 + wid] = done ? 0 : 1;
        if (more) SB_STORE((it + 1) & 1);
        __syncthreads();
        int any = 0;
#pragma unroll
        for (int w = 0; w < 8; ++w) any |= flags[(it & 1) * 8 + w];
        if (!more || !any) break;
        --t;
    }
#undef SB_LOAD
#undef SB_STORE
    store_ot(ATT + (size_t)qpos * 1024 + head * 64, o, hi);
    __syncthreads();
}

#ifndef NSAREP
#define NSAREP 0
#endif
#define NSA_NREP(bit) (((NSAREP >> (bit)) & 1) ? 2 : 1)
constexpr int N_LUT = 2 * T_BUF, N_IMP = N_LUT + 16384, N_OSTR = 68, N_BLKQ = N_IMP + 256 * N_OSTR * 4, N_L = N_BLKQ + 2048, N_REF = N_L + 1280, N_END = N_REF + 1024 + 64;
constexpr int N_QS = 144;
struct NsaT {
    const bf16_t* PROJ;
    const bf16_t* KCMP; const bf16_t* VCMP;
    const bf16_t* KS; const bf16_t* VTS;
    const bf16_t* KW;
    const float* GN;
    const float* LUT8;
    bf16_t* ATT;
    float kb, bmax;
    unsigned long long* tp;
};
__host__ __device__ __forceinline__ int vts_key_of_slot(int slot) { const int hh = slot >> 5, s5 = slot & 31, s = s5 >> 4, h = (s5 >> 3) & 1, j = s5 & 7; return 32 * hh + 16 * s + 8 * (j >> 2) + 4 * h + (j & 3); }

DI void nsa_load_lut(LAS char* lds, const float* LUT8, int g, int tid) { LAS float* lut = (LAS float*)(lds + N_LUT); for (int i = tid; i < 4096; i += 512) lut[i] = LUT8[(i >> 2) * 8 + g * 4 + (i & 3)]; }
DI void nsa_unit(LAS char* lds, const NsaT& T, int g, int qblk, int wave_id) {
    int tid_l = wave_id * 64 + lane_id(); asm volatile("" : "+v"(tid_l));
    const int tid = tid_l, lane = tid & 63, wid = rfl(tid >> 6), r32 = lane & 31, hi = lane >> 5;
    const int q0 = qblk * 64;
    TP_BEGIN(6)
    LAS float* lut = (LAS float*)(lds + N_LUT);
    LAS float* imp = (LAS float*)(lds + N_IMP);
    LAS unsigned* bq32 = (LAS unsigned*)(lds + N_BLKQ);
    LAS float* refl = (LAS float*)(lds + N_REF);
    for (int i = tid; i < 16384; i += 512) imp[i] = 0.f;
    bq32[tid] = 0u;
    const int ql = r32 >> 2, hd = r32 & 3, h8 = g * 4 + hd, tq = q0 + 8 * wid + ql;
    bf16x8 qf[4];
    { const bf16_t* qp = T.PROJ + (size_t)tq * 5632 + 768 + h8 * 64 + hi * 8;
#pragma unroll
      for (int d0 = 0; d0 < 4; ++d0) qf[d0] = *(const bf16x8*)(qp + d0 * 16); }
    float ref;
    { float qs = 0.f;
#pragma unroll
      for (int d0 = 0; d0 < 4; ++d0)
#pragma unroll
          for (int e = 0; e < 8; ++e) { const float v = __uint_as_float(((unsigned)(unsigned short)qf[d0][e]) << 16); qs += v * v; }
      qs += sx32(qs, hi); ref = sqrtf(qs) * T.kb + T.bmax; }
    if (hi == 0) refl[(8 * wid + ql) * 4 + hd] = ref;
    const float gc = T.GN[(size_t)tq * 24 + 3 * h8], gs = T.GN[(size_t)tq * 24 + 3 * h8 + 1], gw = T.GN[(size_t)tq * 24 + 3 * h8 + 2];
    const int srow = tid >> 3, sch = tid & 7;
    const int vlane = (4 * hi + ((lane & 15) >> 2)) * T_KS + 2 * (16 * ((lane >> 4) & 1) + 4 * (lane & 3));
    u32x4 kr, vr;
    __syncthreads();
    const float cfar = lut[1023 * 4 + hd] - ref;
    const int nmax = (q0 + 32) / 16 + 1;
    const int ntc = (nmax + 63) >> 6;
    const bf16_t* kc = T.KCMP + (size_t)g * 1024 * 64; const bf16_t* vc = T.VCMP + (size_t)g * 1024 * 64;
    const int relq = tq - 31;
    const int relw = q0 + 8 * wid - 31;
    float l = 0.f; float inv_l = 0.f; f32x16 oa[2];
    { TP_BEGIN(4)
    for (int rp_ = 0; rp_ < NSA_NREP(0); ++rp_) { l = 0.f;
    u32x4 kq, vq;
    u32x4 v2a = *(const u32x4*)(vc + (size_t)srow * 64 + sch * 8), v2b = v2a; if (1 < ntc) v2b = *(const u32x4*)(vc + (size_t)(64 + srow) * 64 + sch * 8);
    kr = *(const u32x4*)(kc + (size_t)srow * 64 + sch * 8);
    *(LAS u32x4*)(lds + srow * T_KS + sch * 16) = kr; kq = kr;
    if (1 < ntc) kq = *(const u32x4*)(kc + (size_t)(64 + srow) * 64 + sch * 8);
    LDS_BAR();
    for (int j = 0; j < ntc; ++j) {
        const bool more = j + 1 < ntc;
        if (j + 2 < ntc) kr = *(const u32x4*)(kc + (size_t)(64 * (j + 2) + srow) * 64 + sch * 8);
        const LAS char* kt = lds + (j & 1) * T_BUF;
#pragma unroll
        for (int hh = 0; hh < 2; ++hh) {
            f32x16 s = qk32<64, T_KS>(kt + (32 * hh + r32) * T_KS + hi * 16, qf);
            const int n0 = 64 * j + 32 * hh;
            if (relw - 16 * (n0 + 31) >= 790) {
#pragma unroll
                for (int r = 0; r < 16; ++r) l += fast_exp2(s[r] + cfar);
            } else {
#pragma unroll
                for (int r = 0; r < 16; ++r) { const int rel = relq - 16 * (n0 + crow(r, hi)); l += (rel >= 0) ? fast_exp2(s[r] + lut[(rel < 1023 ? rel : 1023) * 4 + hd] - ref) : 0.f; }
            }
        }
        if (more) *(LAS u32x4*)(lds + ((j + 1) & 1) * T_BUF + srow * T_KS + sch * 16) = kq;
        kq = kr;
        LDS_BAR();
    }
    l = sum32sym(l);
    inv_l = l > 0.f ? 1.f / l : 0.f;
#pragma unroll
    for (int i = 0; i < 16; ++i) { oa[0][i] = 0.f; oa[1][i] = 0.f; }
    float cprev = 0.f;
    kr = *(const u32x4*)(kc + (size_t)srow * 64 + sch * 8); vr = v2a;
    { LAS char* d_ = lds + srow * T_KS + sch * 16; *(LAS u32x4*)d_ = kr; *(LAS u32x4*)(d_ + T_KB) = vr; } kq = kr; vq = vr;
    if (1 < ntc) { kq = *(const u32x4*)(kc + (size_t)(64 + srow) * 64 + sch * 8); vq = v2b; }
    LDS_BAR();
    for (int j = 0; j < ntc; ++j) {
        const bool more = j + 1 < ntc;
        if (j + 2 < ntc) { kr = *(const u32x4*)(kc + (size_t)(64 * (j + 2) + srow) * 64 + sch * 8); vr = *(const u32x4*)(vc + (size_t)(64 * (j + 2) + srow) * 64 + sch * 8); }
        const LAS char* kt = lds + (j & 1) * T_BUF; const LAS char* vt = kt + T_KB;
#pragma unroll
        for (int hh = 0; hh < 2; ++hh) {
            f32x16 s = qk32<64, T_KS>(kt + (32 * hh + r32) * T_KS + hi * 16, qf);
            const int n0 = 64 * j + 32 * hh;
            if (relw - 16 * (n0 + 31) >= 790) {
#pragma unroll
                for (int r = 0; r < 16; ++r) s[r] = fast_exp2(s[r] + cfar) * inv_l;
            } else {
#pragma unroll
                for (int r = 0; r < 16; ++r) { const int rel = relq - 16 * (n0 + crow(r, hi)); s[r] = (rel >= 0) ? fast_exp2(s[r] + lut[(rel < 1023 ? rel : 1023) * 4 + hd] - ref) * inv_l : 0.f; }
            }
            float gsm[4], c3[4], pc3[4];
#pragma unroll
            for (int gi = 0; gi < 4; ++gi) { float a = (s[4 * gi] + s[4 * gi + 1]) + (s[4 * gi + 2] + s[4 * gi + 3]), b = s[4 * gi + 3];
                a += sx<1>(a); a += sx<2>(a); b += sx<1>(b); b += sx<2>(b); gsm[gi] = a; c3[gi] = b; }
#pragma unroll
            for (int gi = 0; gi < 4; ++gi) pc3[gi] = sx32(c3[gi], hi);
            const int b0 = 16 * j + 8 * hh + hi;
            if (hd == 0) {
                LAS float* ip = imp + (8 * wid + ql) * 256 + b0;
                if (hi == 1) {
#pragma unroll
                    for (int gi = 0; gi < 4; ++gi) ip[2 * gi] = gsm[gi] + pc3[gi];
                } else { ip[0] = gsm[0] + cprev; ip[2] = gsm[1] + pc3[0]; ip[4] = gsm[2] + pc3[1]; ip[6] = gsm[3] + pc3[2]; }
            }
            cprev = pc3[3];
            pv32<T_KS>(oa, vt + (32 * hh) * T_KS + vlane, pack8(s, 0), pack8(s, 1));
        }
        if (more) { LAS char* d_ = lds + ((j + 1) & 1) * T_BUF + srow * T_KS + sch * 16; *(LAS u32x4*)d_ = kq; *(LAS u32x4*)(d_ + T_KB) = vq; }
        kq = kr; vq = vr;
        LDS_BAR();
    }
    }
    TP_END(4, T.tp); }
#pragma unroll
    for (int i = 0; i < 16; ++i) { oa[0][i] *= gc; oa[1][i] *= gc; }
    store_ot(T.ATT + (size_t)tq * 1024 + 256 + h8 * 64, oa, hi);
    { TP_BEGIN(3)
    for (int rp_ = 0; rp_ < NSA_NREP(1); ++rp_) {
    unsigned ones = 0xffffffffu; asm volatile("" : "+v"(ones));
    if (qblk < 16) {
        if (tid <= qblk) { bq32[2 * tid] = ones; bq32[2 * tid + 1] = ones; }
    } else {
        if (tid == 0) { bq32[0] = ones; bq32[1] = ones; bq32[2 * qblk] = ones; bq32[2 * qblk + 1] = ones; bq32[2 * qblk - 2] = ones; bq32[2 * qblk - 1] = ones; }
        unsigned kv[8][4];
#pragma unroll
        for (int q = 0; q < 8; ++q)
#pragma unroll
            for (int i = 0; i < 4; ++i) { const int b = lane + 64 * i; kv[q][i] = (b >= 1 && b <= qblk - 2) ? __float_as_uint(imp[(8 * wid + q) * 256 + b]) + 1u : 0u; }
        unsigned T8[8];
#pragma unroll
        for (int q = 0; q < 8; ++q) T8[q] = 0u;
        for (int bit = 31; bit >= 0; --bit) {
#pragma unroll
            for (int q = 0; q < 8; ++q) { const unsigned t2 = T8[q] | (1u << bit);
                const int cnt = __builtin_popcountll(__builtin_amdgcn_ballot_w64(kv[q][0] >= t2)) + __builtin_popcountll(__builtin_amdgcn_ballot_w64(kv[q][1] >= t2))
                              + __builtin_popcountll(__builtin_amdgcn_ballot_w64(kv[q][2] >= t2)) + __builtin_popcountll(__builtin_amdgcn_ballot_w64(kv[q][3] >= t2));
                T8[q] = (cnt >= 13) ? t2 : T8[q]; }
        }
#pragma unroll
        for (int q = 0; q < 8; ++q) { const unsigned Tq = T8[q];
            int quota = 13 - (__builtin_popcountll(__builtin_amdgcn_ballot_w64(kv[q][0] > Tq)) + __builtin_popcountll(__builtin_amdgcn_ballot_w64(kv[q][1] > Tq))
                            + __builtin_popcountll(__builtin_amdgcn_ballot_w64(kv[q][2] > Tq)) + __builtin_popcountll(__builtin_amdgcn_ballot_w64(kv[q][3] > Tq)));
            const int qi = 8 * wid + q;
#pragma unroll
            for (int i = 0; i < 4; ++i) {
                const unsigned long long me = __builtin_amdgcn_ballot_w64(kv[q][i] == Tq); const int pe = __builtin_popcountll(me); const int take = pe < quota ? pe : quota;
                unsigned long long km = 0ull, mm = me; for (int t_ = 0; t_ < take; ++t_) { km |= mm & (0ull - mm); mm &= mm - 1ull; }
                quota -= take;
                const bool tie = (lane < 32 ? (unsigned)km >> lane : (unsigned)(km >> 32) >> (lane - 32)) & 1u;
                if (kv[q][i] > Tq || (kv[q][i] == Tq && tie)) (void)__hip_atomic_fetch_or(bq32 + 2 * (lane + 64 * i) + (qi >> 5), 1u << (qi & 31), __ATOMIC_RELAXED, __HIP_MEMORY_SCOPE_WORKGROUP);
            }
        }
    }
    }
    TP_END(3, T.tp); }
    __syncthreads();
    {
        LAS float* slot = (LAS float*)(lds + N_IMP);
        LAS unsigned short* items = (LAS unsigned short*)(lds + N_L);
        volatile LAS int* nitems = (volatile LAS int*)(lds + N_L + 768);
        LAS unsigned* smask = (LAS unsigned*)(lds + N_L + 832);
        LAS unsigned char* npv = (LAS unsigned char*)(lds + N_L + 896);
        LAS int* part = (LAS int*)(lds + N_REF + 1024);
        if (tid < 256) { int np = 0; if (qblk >= 16 && tid >= 1 && tid <= qblk - 2) { const unsigned long long mk = ((unsigned long long)bq32[2 * tid + 1] << 32) | bq32[2 * tid]; np = (__builtin_popcountll(mk) + 7) >> 3; } npv[tid] = (unsigned char)np; }
        __syncthreads();
        if (tid < 16) { int sm = 0;
#pragma unroll
            for (int k = 0; k < 16; ++k) sm += npv[16 * tid + k]; part[tid] = sm; }
        __syncthreads();
        if (tid == 0) { int run = 0;
#pragma unroll
            for (int k = 0; k < 16; ++k) { const int v = part[k]; part[k] = run; run += v; } *nitems = run; }
        __syncthreads();
        if (tid < 256) { int st = part[tid >> 4]; for (int k = 0; k < (tid & 15); ++k) st += npv[(tid & ~15) + k]; const int np = npv[tid]; for (int pp = 0; pp < np; ++pp) items[st + pp] = (unsigned short)(tid | (pp << 8)); }
        { const int q = tid >> 3, c8 = tid & 7; const bf16_t* src = T.PROJ + (size_t)(q0 + q) * 5632 + 768 + g * 256 + c8 * 32; LAS char* dst = lds + (q * 4 + (c8 >> 1)) * N_QS + (c8 & 1) * 64;
#pragma unroll
          for (int i = 0; i < 4; ++i) *(LAS u32x4*)(dst + 16 * i) = *(const u32x4*)(src + 8 * i); }
        __syncthreads();
        const bf16_t* ksg = T.KS + (size_t)g * 256 * 4096 + lane * 8;
        const bf16_t* vtg = T.VTS + (size_t)g * 256 * 4096 + lane * 8;
        const int jslot = r32 >> 2;
        const int myq = 8 * wid + ql; const unsigned qmlo = myq < 32 ? ((1u << myq) - 1u) : 0xffffffffu, qmhi = myq < 32 ? 0u : ((1u << (myq - 32)) - 1u);
        const float biasfar = lut[1023 * 4 + hd];
        float lpart = 0.f, lfull = 0.f; f32x16 os[2];
        for (int rp_ = 0; rp_ < NSA_NREP(2); ++rp_) { lpart = 0.f; lfull = 0.f;
#pragma unroll
        for (int i = 0; i < 16; ++i) { os[0][i] = 0.f; os[1][i] = 0.f; }
        bf16x8 kf[2][4], vf[2][2][2];
#define NSA_LDK(B) do { const bf16_t* p_ = ksg + (size_t)(B) * 4096; _Pragma("unroll") for (int hh = 0; hh < 2; ++hh) _Pragma("unroll") for (int d0 = 0; d0 < 4; ++d0) kf[hh][d0] = *(const bf16x8*)(p_ + (hh * 4 + d0) * 512); } while (0)
#define NSA_LDV(B) do { const bf16_t* p_ = vtg + (size_t)(B) * 4096; _Pragma("unroll") for (int hh = 0; hh < 2; ++hh) _Pragma("unroll") for (int dh = 0; dh < 2; ++dh) _Pragma("unroll") for (int s = 0; s < 2; ++s) vf[hh][dh][s] = *(const bf16x8*)(p_ + ((hh * 2 + dh) * 2 + s) * 512); } while (0)
#define NSA_SCORE(B, QF, INI, TS, OK, LS) do { \
            _Pragma("unroll") for (int hh = 0; hh < 2; ++hh) { _Pragma("unroll") for (int i = 0; i < 16; ++i) sc[hh][i] = (INI); \
                _Pragma("unroll") for (int d0 = 0; d0 < 4; ++d0) sc[hh] = mfma32(kf[hh][d0], (QF)[d0], sc[hh]); } \
            if (q0 - (64 * (B) + 63) >= 790) { _Pragma("unroll") for (int hh = 0; hh < 2; ++hh) _Pragma("unroll") for (int r = 0; r < 16; ++r) { const float p = (OK) ? fast_exp2(sc[hh][r]) : 0.f; sc[hh][r] = p; LS += p; } } \
            else { _Pragma("unroll") for (int hh = 0; hh < 2; ++hh) _Pragma("unroll") for (int r = 0; r < 16; ++r) { const int rel = (TS) - (64 * (B) + 32 * hh + crow(r, hi)); const int rc = rel < 0 ? 0 : (rel < 1023 ? rel : 1023); \
                const float p = ((OK) && rel >= 0) ? fast_exp2(sc[hh][r] + lut[rc * 4 + hd]) : 0.f; sc[hh][r] = p; LS += p; } } } while (0)
#define NSA_PV(O) do { _Pragma("unroll") for (int hh = 0; hh < 2; ++hh) { const bf16x8 p0 = pack8(sc[hh], 0), p1 = pack8(sc[hh], 1); \
            _Pragma("unroll") for (int dh = 0; dh < 2; ++dh) { (O)[dh] = mfma32(vf[hh][dh][0], p0, (O)[dh]); (O)[dh] = mfma32(vf[hh][dh][1], p1, (O)[dh]); } } } while (0)
        f32x16 sc[2];
        { TP_BEGIN(2) const int nf = qblk < 16 ? qblk + 1 : 3;
          { const int fb0 = 0; NSA_LDK(fb0); NSA_LDV(fb0); }
          for (int fi = 0; fi < nf; ++fi) { const int fb = qblk < 16 ? fi : (fi == 0 ? 0 : qblk - 2 + fi); const int fn = qblk < 16 ? fi + 1 : qblk - 1 + fi;
            const float ini = ((q0 - (64 * fb + 63) >= 790) ? biasfar : 0.f) - ref;
            NSA_SCORE(fb, qf, ini, tq, true, lpart);
            if (fi + 1 < nf) NSA_LDK(fn);
            NSA_PV(os);
            if (fi + 1 < nf) NSA_LDV(fn); } TP_END(2, T.tp); }
        TP_BEGIN(1)
        const int ni = *nitems; unsigned long long tpacc_ = 0;
        int it_b = -1, it_p = 0;
        if (wid < ni) { const int e = items[wid]; it_b = e & 255; it_p = e >> 8; NSA_LDK(it_b); NSA_LDV(it_b); }
        for (int i0 = 0; i0 < ni; i0 += 8) {
            const int inext = i0 + 8 + wid; int nb_ = -1, np_ = 0;
            if (inext < ni) { const int e = items[inext]; nb_ = e & 255; np_ = e >> 8; }
            unsigned long long msk = 0ull;
            unsigned long long tpa_ = 0; if (TPROBE == 11 || TPROBE == 12 || TPROBE == 13) tpa_ = tp_now();
            if (it_b >= 0) {
                unsigned long long m_ = ((unsigned long long)(unsigned)rfl((int)bq32[2 * it_b + 1]) << 32) | (unsigned)rfl((int)bq32[2 * it_b]);
                for (int i_ = 0; i_ < 8 * it_p; ++i_) m_ &= m_ - 1ull;
                unsigned long long t_ = m_; for (int i_ = 0; i_ < 8; ++i_) t_ &= t_ - 1ull;
                msk = m_ & ~t_;
                int qsel = -1; { unsigned long long mm = msk;
#pragma unroll
                    for (int j = 0; j < 8; ++j) { const int qj = mm ? (int)__builtin_ctzll(mm) : -1; mm &= mm - 1ull; if (jslot == j) qsel = qj; } }
                const bool valid = qsel >= 0; const int row = (valid ? qsel : 0) * 4 + hd, ts = q0 + (valid ? qsel : 0);
                const float ini = ((q0 - (64 * it_b + 63) >= 790) ? biasfar : 0.f) - refl[row];
                bf16x8 qv[4];
#pragma unroll
                for (int d0 = 0; d0 < 4; ++d0) qv[d0] = *(const LAS bf16x8*)(lds + row * N_QS + d0 * 32 + hi * 16);
                float ls = 0.f;
                NSA_SCORE(it_b, qv, ini, ts, valid, ls);
                if (nb_ >= 0) NSA_LDK(nb_);
                f32x16 ot[2];
#pragma unroll
                for (int i = 0; i < 16; ++i) { ot[0][i] = 0.f; ot[1][i] = 0.f; }
                NSA_PV(ot);
                if (nb_ >= 0) NSA_LDV(nb_);
                ls = sum32sym(ls);
                LAS float* sp = slot + (wid * 32 + r32) * N_OSTR;
#pragma unroll
                for (int dh = 0; dh < 2; ++dh)
#pragma unroll
                    for (int g4 = 0; g4 < 4; ++g4) *(LAS f32x4*)(sp + 32 * dh + 8 * g4 + 4 * hi) = (f32x4){ot[dh][4 * g4], ot[dh][4 * g4 + 1], ot[dh][4 * g4 + 2], ot[dh][4 * g4 + 3]};
                if (hi == 0) sp[64] = ls;
            }
            if (lane == 0) { smask[2 * wid] = (unsigned)msk; smask[2 * wid + 1] = (unsigned)(msk >> 32); }
            if (TPROBE == 11) tpacc_ += tp_now() - tpa_;
            if (TPROBE == 12 || TPROBE == 13) tpa_ = tp_now();
            LDS_BAR();
            if (TPROBE == 12) tpacc_ += tp_now() - tpa_;
            if (TPROBE == 13) tpa_ = tp_now();
            const unsigned smv = smask[lane & 15];
#pragma unroll
            for (int w = 0; w < 8; ++w) {
                const unsigned mlo = (unsigned)__builtin_amdgcn_readlane((int)smv, 2 * w), mhi = (unsigned)__builtin_amdgcn_readlane((int)smv, 2 * w + 1);
                const unsigned long long mw = ((unsigned long long)mhi << 32) | mlo;
                if ((unsigned)(mw >> (8 * wid)) & 0xffu) {
                    const bool has = (myq < 32 ? (mlo >> myq) : (mhi >> (myq - 32))) & 1u;
                    const int j = __builtin_popcount(mlo & qmlo) + __builtin_popcount(mhi & qmhi);
                    const LAS float* sp = slot + (w * 32 + (has ? j : 0) * 4 + hd) * N_OSTR;
                    f32x4 v[2][4];
#pragma unroll
                    for (int dh = 0; dh < 2; ++dh)
#pragma unroll
                        for (int g4 = 0; g4 < 4; ++g4) v[dh][g4] = *(const LAS f32x4*)(sp + 32 * dh + 8 * g4 + 4 * hi);
                    const float lv = sp[64];
                    if (has) {
#pragma unroll
                        for (int dh = 0; dh < 2; ++dh)
#pragma unroll
                            for (int g4 = 0; g4 < 4; ++g4) { os[dh][4 * g4] += v[dh][g4].x; os[dh][4 * g4 + 1] += v[dh][g4].y; os[dh][4 * g4 + 2] += v[dh][g4].z; os[dh][4 * g4 + 3] += v[dh][g4].w; }
                        lfull += lv; }
                }
            }
            if (TPROBE == 13) tpacc_ += tp_now() - tpa_;
            LDS_BAR();
            it_b = nb_; it_p = np_;
        }
        TP_END(1, T.tp);
        if ((TPROBE == 11 || TPROBE == 12 || TPROBE == 13) && lane == 0) atomicAdd(T.tp, tpacc_);
#undef NSA_LDK
#undef NSA_LDV
#undef NSA_SCORE
#undef NSA_PV
        }
        { const float f = gs / (sum32sym(lpart) + lfull);
#pragma unroll
          for (int i = 0; i < 16; ++i) { oa[0][i] = f * os[0][i]; oa[1][i] = f * os[1][i]; } }
        { const bf16_t* qp = T.PROJ + (size_t)tq * 5632 + 768 + h8 * 64 + hi * 8;
#pragma unroll
          for (int d0 = 0; d0 < 4; ++d0) qf[d0] = *(const bf16x8*)(qp + d0 * 16); }
        __syncthreads();
    }
    {
        const bf16_t* kw = T.KW + (size_t)g * 16384 * 64; const bf16_t* vw = T.PROJ + 1920 + g * 64;
        const int kt0 = qblk > 8 ? qblk - 8 : 0, ntw = qblk - kt0 + 1;
        float lw = 0.f; f32x16 ow[2];
        TP_BEGIN(5)
        for (int rp_ = 0; rp_ < NSA_NREP(3); ++rp_) { lw = 0.f;
#pragma unroll
        for (int i = 0; i < 16; ++i) { ow[0][i] = 0.f; ow[1][i] = 0.f; }
#define WIN_LD(t, K_, V_) do { K_ = *(const u32x4*)(kw + (size_t)(64 * (t) + srow) * 64 + sch * 8); V_ = *(const u32x4*)(vw + (size_t)(64 * (t) + srow) * 5632 + sch * 8); } while (0)
        u32x4 kq, vq;
        WIN_LD(kt0, kr, vr);
        { LAS char* d_ = lds + srow * T_KS + sch * 16; *(LAS u32x4*)d_ = kr; *(LAS u32x4*)(d_ + T_KB) = vr; }
        kq = kr; vq = vr;
        if (1 < ntw) WIN_LD(kt0 + 1, kq, vq);
        LDS_BAR();
        for (int j = 0; j < ntw; ++j) {
            const bool more = j + 1 < ntw;
            if (j + 2 < ntw) WIN_LD(kt0 + j + 2, kr, vr);
            const LAS char* kt = lds + (j & 1) * T_BUF; const LAS char* vt = kt + T_KB;
            f32x16 p[2];
#pragma unroll
            for (int hh = 0; hh < 2; ++hh) { p[hh] = qk32<64, T_KS>(kt + (32 * hh + r32) * T_KS + hi * 16, qf);
#pragma unroll
                for (int r = 0; r < 16; ++r) { const int rel = tq - (64 * (kt0 + j) + 32 * hh + crow(r, hi)); const bool valid = rel >= 0 && rel < 512;
                    const float e = valid ? fast_exp2(p[hh][r] + lut[(rel < 0 ? 0 : rel) * 4 + hd] - ref) : 0.f; p[hh][r] = e; lw += e; } }
            pv64<T_KS>(ow, vt + vlane, p[0], p[1]);
            if (more) { LAS char* d_ = lds + ((j + 1) & 1) * T_BUF + srow * T_KS + sch * 16; *(LAS u32x4*)d_ = kq; *(LAS u32x4*)(d_ + T_KB) = vq; }
            kq = kr; vq = vr;
            LDS_BAR();
        }
#undef WIN_LD
        }
        TP_END(5, T.tp);
        lw = sum32sym(lw);
        const float f = gw / lw;
#pragma unroll
        for (int i = 0; i < 16; ++i) { oa[0][i] += f * ow[0][i]; oa[1][i] += f * ow[1][i]; }
        { const bf16_t* ap = T.ATT + (size_t)tq * 1024 + 256 + h8 * 64;
#pragma unroll
          for (int dh = 0; dh < 2; ++dh)
#pragma unroll
              for (int g4 = 0; g4 < 4; ++g4) { const u32x2 w = *(const u32x2*)(ap + 32 * dh + 8 * g4 + 4 * hi); oa[dh][4 * g4] += bflo(w.x); oa[dh][4 * g4 + 1] += bfhi(w.x); oa[dh][4 * g4 + 2] += bflo(w.y); oa[dh][4 * g4 + 3] += bfhi(w.y); } }
        store_ot(T.ATT + (size_t)tq * 1024 + 256 + h8 * 64, oa, hi);
    }
    __syncthreads();
    TP_END(6, T.tp);
}
}
constexpr int S = 16384, DM = 1024, NPROJ = 5632, INC = 5560, DFF = 2816, EFF = 3584, NEXP = 8;
constexpr int NWAVES = 8;
constexpr float EPS = 1e-6f;
constexpr float QK_SCALE64 = 0.125f * LOG2E;
constexpr float QK_SCALE96 = 0.10206207261596575f * LOG2E;
#ifndef MK_MULTI
#define MK_MULTI 0
#endif
constexpr int PC_SBQ = 0, PC_SBK = 256, PC_SBV = 512, PC_NQ = 768, PC_NKC = 1280, PC_NVC = 1408, PC_NKS = 1536, PC_NVS = 1664, PC_NKW = 1792, PC_NVW = 1920,
              PC_CQ = 2048, PC_CKV = 2304, PC_KR = 2432, PC_NG = 2464, PC_GATE = 2560;
__host__ __device__ __forceinline__ int win_oldcol(int c) {
    if (c < 2048) return c; if (c < 2464) return c + 24; if (c < 2488) return 2048 + (c - 2464); if (c < 2560) return -1; return c - 72; }

constexpr size_t MiB = 1u << 20;
constexpr size_t WS_CTL = 0, CTL_ZERO_BYTES = 1 * MiB;
constexpr size_t WS_LW = 1 * MiB, LW_STRIDE = 18 * MiB;
constexpr size_t LW_WIN = 0, LW_SBO = 11 * MiB, LW_NSAO = LW_SBO + MiB / 2, LW_MLAO = LW_NSAO + MiB, LW_WOUT = LW_MLAO + MiB / 2, LW_WUQ = LW_WOUT + 2 * MiB, LW_WUKV = LW_WUQ + MiB / 4, LW_CW1 = LW_WUKV + MiB / 4;
constexpr size_t WS_DGU = 37 * MiB, WS_DDN = 48 * MiB;
constexpr size_t WS_Y = 1 * MiB;
constexpr size_t WS_H = 74 * MiB;
constexpr size_t WS_ROPE = 106 * MiB;
constexpr size_t WS_LUT8 = 108 * MiB, WS_B1P = WS_LUT8 + 256 * 1024, WS_B1 = WS_LUT8 + 512 * 1024, WS_ROUTE = 109 * MiB, WS_ROWTOK = WS_ROUTE + 512 * 1024;
constexpr size_t WS_R1 = 110 * MiB;
constexpr size_t WS_MGU = WS_R1, WS_MDN = WS_R1 + 112 * MiB;
constexpr size_t WS_R2 = 296 * MiB;
constexpr size_t R2_KC = 0, R2_VC = R2_KC + 4 * MiB + MiB / 4, R2_KS = R2_VC + 4 * MiB + MiB / 4, R2_VTS = R2_KS + 4 * MiB, R2_KW = R2_VTS + 4 * MiB, R2_GN = R2_KW + 4 * MiB,
                 R2_QM = R2_GN + 2 * MiB, R2_KM = R2_QM + 12 * MiB, R2_HID = R2_KM + 12 * MiB, R2_KCMP = R2_HID + 2 * MiB, R2_VCMP = R2_KCMP + MiB / 4, R2_ATT = R2_VCMP + MiB / 4 + MiB / 2,
                 R2_MRG = R2_ATT + 32 * MiB, R2_QRAW = R2_MRG, R2_KVRAW = R2_MRG + 16 * MiB, R2_HIDP = R2_MRG + 32 * MiB  , R2_END = R2_HIDP + 16 * MiB;
static_assert(R2_END <= 136 * MiB, "attention scratch");
constexpr size_t WS_END = 432 * MiB;
constexpr int KC_ROWS = S + 32;
constexpr int CW_TMO = 0, CW_BAR = 4096, CW_MOECNT = 16384, CW_NSAQ = 17408, CW_SPLIT = 18432;
constexpr int RING_BYTES = 131072, LDSCTL_OFF = RING_BYTES, MISC_OFF = LDSCTL_OFF + 320, LDS_BYTES = 147456;


#define LDS_WAIT() asm volatile("s_waitcnt lgkmcnt(0)" ::: "memory")
#define VM_WAIT() asm volatile("s_waitcnt vmcnt(0)" ::: "memory")
DI float wave_sum(float v) { v += sx<1>(v); v += sx<2>(v); v += sx<4>(v); v += sx<8>(v); v += sx<16>(v); return sum32sym(v); }

struct TrSrc { const float* a; const float* b; int ldn; int nsrc; int mode; };
DI f32x4 tr_fetch4(const TrSrc& s, int k, int n) {
    const f32x4 z = {0.f, 0.f, 0.f, 0.f};
    if (s.mode == 0) return n < s.nsrc ? *(const f32x4*)(s.a + (size_t)k * s.ldn + n) : z;
    if (s.mode == 1) { const int oc = win_oldcol(n); return oc >= 0 ? *(const f32x4*)(s.a + (size_t)k * s.ldn + oc) : z; }
    const int tile = n >> 8, w = n & 255; const long d = (w < 128) ? 0l : (long)((const char*)s.b - (const char*)s.a);
    return *(const f32x4*)((const float*)((const char*)s.a + d) + (size_t)k * s.ldn + 128 * tile + (w & 127));
}
DI void tr_load(const TrSrc& s, int kb, int nb, int lane, f32x4 (&v)[8]) {
    const int k0 = 64 * kb, n0 = 32 * nb, r8 = lane >> 3, n4 = (lane & 7) * 4;
#pragma unroll
    for (int i = 0; i < 8; ++i) v[i] = tr_fetch4(s, k0 + r8 + 8 * i, n0 + n4);
}
DI void tr_store(const f32x4 (&v)[8], int K, bf16_t* WT, LAS float* scr, int kb, int nb, int lane) {
    const int k0 = 64 * kb, n0 = 32 * nb, r8 = lane >> 3, n4 = (lane & 7) * 4;
#pragma unroll
    for (int i = 0; i < 8; ++i) { LAS float* d = scr + (r8 + 8 * i) * 33 + n4; d[0] = v[i].x; d[1] = v[i].y; d[2] = v[i].z; d[3] = v[i].w; }
    LDS_WAIT(); asm volatile("" ::: "memory");
    const int c = lane & 7;
#pragma unroll
    for (int j = 0; j < 4; ++j) { const int n = (lane >> 3) + 8 * j; const LAS float* p = scr + (8 * c) * 33 + n;
        u32x4 o; o.x = cvtpk(p[0 * 33], p[1 * 33]); o.y = cvtpk(p[2 * 33], p[3 * 33]); o.z = cvtpk(p[4 * 33], p[5 * 33]); o.w = cvtpk(p[6 * 33], p[7 * 33]);
        *(u32x4*)(WT + (size_t)(n0 + n) * K + k0 + 8 * c) = o; }
    LDS_WAIT(); asm volatile("" ::: "memory");
}
DI void tr_item(const TrSrc& s, int K, bf16_t* WT, LAS float* scr, int kb, int nb, int lane) { f32x4 v[8]; tr_load(s, kb, nb, lane, v); tr_store(v, K, WT, scr, kb, nb, lane); }
DI void tr_matrix(const TrSrc& s, int K, int ndst, bf16_t* WT, LAS float* scr, int gw, int ngw, int lane, int& off) {
    const int nblk = ndst / 32, nitems = (K / 64) * nblk;
    int st = gw - off; if (st < 0) st += ngw;
    if (st < nitems) { f32x4 v[8], w[8]; tr_load(s, st / nblk, st % nblk, lane, v);
        for (int it = st; it < nitems; it += ngw) { const int nx = it + ngw; if (nx < nitems) tr_load(s, nx / nblk, nx % nblk, lane, w);
            tr_store(v, K, WT, scr, it / nblk, it % nblk, lane);
#pragma unroll
            for (int i = 0; i < 8; ++i) v[i] = w[i]; } }
    off = (off + nitems) % ngw;
}

DI void tr_batch(const float* a, const float* b, size_t sstride, int ldn, int nsrc, int mode, int K, int ndst, bf16_t* WT, size_t dstride, int nexp, LAS float* scr, int gw, int ngw, int lane, int& off) {
    const int nblk = ndst / 32, per = (K / 64) * nblk, nitems = nexp * per;
    int st = gw - off; if (st < 0) st += ngw;
    if (st < nitems) { f32x4 v[8], w[8];
        { const int e = st / per, r = st % per; tr_load(TrSrc{a + (size_t)e * sstride, b ? b + (size_t)e * sstride : nullptr, ldn, nsrc, mode}, r / nblk, r % nblk, lane, v); }
        for (int it = st; it < nitems; it += ngw) { const int nx = it + ngw;
            if (nx < nitems) { const int e = nx / per, r = nx % per; tr_load(TrSrc{a + (size_t)e * sstride, b ? b + (size_t)e * sstride : nullptr, ldn, nsrc, mode}, r / nblk, r % nblk, lane, w); }
            { const int e = it / per, r = it % per; tr_store(v, K, WT + (size_t)e * dstride, scr, r / nblk, r % nblk, lane); }
#pragma unroll
            for (int i = 0; i < 8; ++i) v[i] = w[i]; } }
    off = (off + nitems) % ngw;
}

struct In {
    const float *x, *bias_table, *mix_norm, *w_in, *b_gate, *sb_w_o, *nsa_q_norm, *nsa_k_norm, *nsa_cmp_pos, *nsa_cmp_w1, *nsa_cmp_w2, *nsa_w_o, *mla_q_a_norm, *mla_kv_a_norm,
        *mla_w_uq, *mla_w_ukv, *mla_q_norm, *mla_k_norm, *mla_w_o, *w_out, *ffn_norm, *dense_w_gate, *dense_w_up, *dense_w_down, *moe_router, *moe_w_gate, *moe_w_up, *moe_w_down;
};
struct Args { In in; float* out; unsigned char* ws; int ph_lo, ph_hi; };

DI void rms_row(const float* xrow, const float* gain, bf16_t* orow, int lane, f32x4 (&v)[4]) {
    const f32x4* xr = (const f32x4*)xrow + lane; float s = 0.f;
#pragma unroll
    for (int j = 0; j < 4; ++j) { v[j] = xr[64 * j]; s += (v[j].x * v[j].x + v[j].y * v[j].y) + (v[j].z * v[j].z + v[j].w * v[j].w); }
    const float rstd = 1.f / sqrtf(wave_sum(s) * (1.f / 1024.f) + EPS);
    u32x2* o8 = (u32x2*)orow + lane;
#pragma unroll
    for (int j = 0; j < 4; ++j) { const f32x4 g = ((const f32x4*)gain)[lane + 64 * j]; v[j] = v[j] * rstd * g; u32x2 w; w.x = cvtpk(v[j].x, v[j].y); w.y = cvtpk(v[j].z, v[j].w); o8[64 * j] = w; }
}

DI int t5_bucket(int n) {
    if (n < 16) return n;
    int b = 16;
    b += n >= 21; b += n >= 27; b += n >= 35; b += n >= 46; b += n >= 59; b += n >= 77; b += n >= 99; b += n >= 128; b += n >= 166; b += n >= 216; b += n >= 280; b += n >= 363; b += n >= 470; b += n >= 609; b += n >= 790;
    return b;
}

struct MoeTab { int cnt[8]; int tb[9]; };
struct MoeGU {
    const volatile LAS int* tab; const bf16_t* Hb; const bf16_t* W; const int* rowtok; int t_lo, t_hi, G, c;
    DI bool next(int i, pg8::Unit& u) const {
        const int nrt = t_hi - t_lo; if (nrt <= 0) return false;
        const long L = (long)i * G + c; if (L >= (long)nrt * 28) return false;
        const int rt = t_lo + (int)(L % nrt), pn = (int)(L / nrt);
        int e = 0;
#pragma unroll
        for (int k = 1; k < 8; ++k) e += (tab[8 + k] <= rt) ? 1 : 0;
        const int j = rt - tab[8 + e], cnt = tab[e];
        u.a = Hb; u.b = W + ((size_t)e * 7168 + 256 * pn) * 1024; u.rows = rowtok + e * S + 256 * j; u.nvalid = (cnt - 256 * j) < 256 ? (cnt - 256 * j) : 256; u.pm = rt - t_lo; u.pn = pn; return true;
    }
};
struct MoeDN {
    const volatile LAS int* tab; const bf16_t* ACT; const bf16_t* W; int t_lo, t_hi, G, c;
    DI bool next(int i, pg8::Unit& u) const {
        const int nrt = t_hi - t_lo; if (nrt <= 0) return false;
        const long L = (long)i * G + c; if (L >= (long)nrt * 4) return false;
        const int rt = t_lo + (int)(L % nrt), pn = (int)(L / nrt);
        int e = 0;
#pragma unroll
        for (int k = 1; k < 8; ++k) e += (tab[8 + k] <= rt) ? 1 : 0;
        u.a = ACT + (size_t)(rt - t_lo) * 256 * EFF; u.b = W + ((size_t)e * 1024 + 256 * pn) * EFF; u.rows = nullptr; u.nvalid = 256; u.pm = rt; u.pn = pn; return true;
    }
};
constexpr int PH_PER_LAYER = 16, NPHASES = 1 + 2 * PH_PER_LAYER;
__global__ void __launch_bounds__(NWAVES * 64, 2) fwd_kernel(Args args) {
    extern __shared__ __attribute__((aligned(16))) unsigned char lds_raw[];
    LAS unsigned char* lds = (LAS unsigned char*)lds_raw;
    volatile LAS unsigned* MISC = (volatile LAS unsigned*)(lds + MISC_OFF);
    volatile LAS int* MTAB = (volatile LAS int*)(lds + MISC_OFF + 64);
    const int tid0 = threadIdx.x, wave = __builtin_amdgcn_readfirstlane(tid0 >> 6);
    const int G = gridDim.x, bid = blockIdx.x, vcu = (G % 8 == 0) ? (bid % 8) * (G / 8) + bid / 8 : bid;
    const int gw0 = vcu * NWAVES + wave, NGW = G * NWAVES;
    unsigned char* ws = args.ws; const In in = args.in;
    gu32* ctl = (gu32*)(ws + WS_CTL);
    for (int u = tid0; u < (LDS_BYTES - LDSCTL_OFF) / 4; u += NWAVES * 64) ((LAS unsigned*)(lds + LDSCTL_OFF))[u] = 0u;
    __syncthreads();
#if MK_MULTI
#define GRID_BAR() do { } while (0)
#else
    XcdBarrier bar = xcd_barrier_post((unsigned*)(ctl + CW_BAR), MISC + 8);
#define TPCTR ((unsigned long long*)(ctl + 20480))
#define GRID_BAR() do { TP_BEGIN(9) xcd_barrier(bar); TP_END(9, TPCTR); } while (0)
#endif
    const int lo = args.ph_lo, hi = args.ph_hi;
#ifndef ONLY_PHASE
#define ONLY_PHASE -1
#endif
#ifndef PHMASK
#define PHMASK 0x1ffff
#endif
#define PHON(n) ((ONLY_PHASE < 0 || ONLY_PHASE == (n)) && ((PHMASK >> ((n) == 99 ? 16 : (n))) & 1))
#ifndef REPMASK
#define REPMASK 0
#endif
#ifndef GREP
#define GREP 0
#endif
#define REPN(n) (((REPMASK >> ((n) == 99 ? 16 : (n))) & 1) ? 2 : 1)
#define IN(k) (lo <= (k) && (k) < hi)
#define SEAM(k) do { if (IN((k) + 1)) { unsigned long long tq0_ = 0; const bool tpk_ = (TPROBE >= 100) && (TPROBE - 100 == ((k) == 0 ? 16 : ((k) - 1) % 16)); if (tpk_) tq0_ = tp_now(); GRID_BAR(); if (tpk_ && lane_id() == 0) atomicAdd(TPCTR, tp_now() - tq0_); } } while (0)
#define PHASE_LOCALS int tid = wave * 64 + lane_id(); asm volatile("" : "+v"(tid)); const int lane = tid & 63; int gw = gw0; asm volatile("" : "+s"(gw)); unsigned char* wsl = ws; asm volatile("" : "+s"(wsl)); (void)lane; (void)gw; (void)wsl;

#define lw (wsl + WS_LW + (size_t)l * LW_STRIDE)
#define Hb ((bf16_t*)(wsl + WS_H))
#define PROJ ((bf16_t*)(wsl + WS_R1))
#define R2P(off) (wsl + WS_R2 + (off))
#define KC ((bf16_t*)R2P(R2_KC))
#define VC ((bf16_t*)R2P(R2_VC))
#define KS ((bf16_t*)R2P(R2_KS))
#define VTS ((bf16_t*)R2P(R2_VTS))
#define KW ((bf16_t*)R2P(R2_KW))
#define GN ((float*)R2P(R2_GN))
#define QM ((bf16_t*)R2P(R2_QM))
#define KM ((bf16_t*)R2P(R2_KM))
#define HID ((bf16_t*)R2P(R2_HID))
#define KCMP ((bf16_t*)R2P(R2_KCMP))
#define VCMP ((bf16_t*)R2P(R2_VCMP))
#define ATT ((bf16_t*)R2P(R2_ATT))
#define MRG ((bf16_t*)R2P(R2_MRG))
#define QRAW ((bf16_t*)R2P(R2_QRAW))
#define KVRAW ((bf16_t*)R2P(R2_KVRAW))
#define HIDP ((float*)R2P(R2_HIDP))
#define ROPE ((float*)(wsl + WS_ROPE))
#define LUT8 ((float*)(wsl + WS_LUT8))
#define B1P ((float*)(wsl + WS_B1P))
#define B1 ((float*)(wsl + WS_B1))
#define CONS (B1 + 2048)
#define ROUTE ((int*)(wsl + WS_ROUTE))
#define ROWTOK ((int*)(wsl + WS_ROWTOK))
    LAS float* scr = (LAS float*)(lds + wave * 16384);

    if (PHON(99) && IN(0)) { PHASE_LOCALS TP_BEGIN(36) for (int rep_ = 0; rep_ < REPN(99); ++rep_) {
        int troff = 0;
        for (int l = 0; l < 2; ++l) {
            tr_matrix(TrSrc{in.w_in + (size_t)l * 1024 * INC, nullptr, INC, INC, 1}, 1024, NPROJ, (bf16_t*)(lw + LW_WIN), scr, gw, NGW, lane, troff);
            tr_matrix(TrSrc{in.sb_w_o + (size_t)l * 256 * 1024, nullptr, 1024, 1024, 0}, 256, 1024, (bf16_t*)(lw + LW_SBO), scr, gw, NGW, lane, troff);
            tr_matrix(TrSrc{in.nsa_w_o + (size_t)l * 512 * 1024, nullptr, 1024, 1024, 0}, 512, 1024, (bf16_t*)(lw + LW_NSAO), scr, gw, NGW, lane, troff);
            tr_matrix(TrSrc{in.mla_w_o + (size_t)l * 256 * 1024, nullptr, 1024, 1024, 0}, 256, 1024, (bf16_t*)(lw + LW_MLAO), scr, gw, NGW, lane, troff);
            tr_matrix(TrSrc{in.w_out + (size_t)l * 1024 * 1024, nullptr, 1024, 1024, 0}, 1024, 1024, (bf16_t*)(lw + LW_WOUT), scr, gw, NGW, lane, troff);
            tr_matrix(TrSrc{in.mla_w_uq + (size_t)l * 256 * 384, nullptr, 384, 384, 0}, 256, 512, (bf16_t*)(lw + LW_WUQ), scr, gw, NGW, lane, troff);
            tr_matrix(TrSrc{in.mla_w_ukv + (size_t)l * 128 * 512, nullptr, 512, 512, 0}, 128, 512, (bf16_t*)(lw + LW_WUKV), scr, gw, NGW, lane, troff);
            for (int kv = 0; kv < 2; ++kv)
                tr_matrix(TrSrc{in.nsa_cmp_w1 + (size_t)(l * 2 + kv) * 2048 * 256, nullptr, 256, 256, 0}, 2048, 256, (bf16_t*)(lw + LW_CW1) + (size_t)kv * 256 * 2048, scr, gw, NGW, lane, troff);
        }
        tr_matrix(TrSrc{in.dense_w_gate, in.dense_w_up, DFF, DFF, 2}, 1024, 2 * DFF, (bf16_t*)(wsl + WS_DGU), scr, gw, NGW, lane, troff);
        tr_matrix(TrSrc{in.dense_w_down, nullptr, 1024, 1024, 0}, DFF, 1024, (bf16_t*)(wsl + WS_DDN), scr, gw, NGW, lane, troff);
        const int gt = vcu * 512 + tid, NT = G * 512;
        for (int i = gt; i < S * 16; i += NT) {
            const int pos = i >> 4, fi = i & 15; const float inv = powf(10000.f, -(float)fi / 16.f); const float ang = (float)pos * inv;
            const double rev = (double)ang * 0.15915494309189535; const float fr = (float)(rev - rint(rev));
            ROPE[i] = __builtin_amdgcn_cosf(fr); ROPE[S * 16 + i] = __builtin_amdgcn_sinf(fr); }
        for (int i = gt; i < 1024 * 8; i += NT) LUT8[i] = in.bias_table[t5_bucket(i >> 3) * 8 + (i & 7)] * LOG2E;
        if (gw == 0) {
            float bm = 0.f; for (int i = lane; i < 256; i += 64) bm = fmaxf(bm, fabsf(in.bias_table[i]));
            bm = fmaxf(bm, sx<1>(bm)); bm = fmaxf(bm, sx<2>(bm)); bm = fmaxf(bm, sx<4>(bm)); bm = fmaxf(bm, sx<8>(bm)); bm = fmaxf(bm, sx<16>(bm)); bm = fmaxf(bm, sx32(bm, lane >> 5));
            if (lane == 0) CONS[0] = bm * LOG2E;
            for (int ll = 0; ll < 2; ++ll) { float gm = 0.f; for (int i = lane; i < 192; i += 64) gm = fmaxf(gm, fabsf(in.nsa_k_norm[ll * 192 + i]));
                gm = fmaxf(gm, sx<1>(gm)); gm = fmaxf(gm, sx<2>(gm)); gm = fmaxf(gm, sx<4>(gm)); gm = fmaxf(gm, sx<8>(gm)); gm = fmaxf(gm, sx<16>(gm)); gm = fmaxf(gm, sx32(gm, lane >> 5));
                if (lane == 0) CONS[1 + ll] = gm;
                float km = 0.f; for (int i = lane; i < 96; i += 64) km = fmaxf(km, fabsf(in.mla_k_norm[ll * 96 + i]));
                km = fmaxf(km, sx<1>(km)); km = fmaxf(km, sx<2>(km)); km = fmaxf(km, sx<4>(km)); km = fmaxf(km, sx<8>(km)); km = fmaxf(km, sx<16>(km)); km = fmaxf(km, sx32(km, lane >> 5));
                if (lane == 0) CONS[3 + ll] = km; }
        }
        for (int it = gw; it < 512; it += NGW) {
            const int kc = it & 31, cb = (it >> 5) & 3, lk = it >> 7; const float* pos = in.nsa_cmp_pos + (size_t)lk * 2048; const float* w1 = in.nsa_cmp_w1 + (size_t)lk * 2048 * 256;
            float wv_[64];
#pragma unroll
            for (int k = 0; k < 64; ++k) wv_[k] = w1[(size_t)(64 * kc + k) * 256 + 64 * cb + lane];
            float a = 0.f;
#pragma unroll
            for (int k = 0; k < 64; ++k) a += pos[64 * kc + k] * wv_[k];
            B1P[(lk * 32 + kc) * 256 + 64 * cb + lane] = a; }
        for (int i = gt; i < 2 * 2 * 32 * 64 / 8; i += NT) { const int z = i / 256, r = i % 256; bf16_t* p = (z >> 1 ? VC : KC) + ((size_t)(z & 1) * KC_ROWS + S) * 64 + r * 8; *(u32x4*)p = (u32x4){0u, 0u, 0u, 0u}; }
        for (int m = gw; m < S; m += NGW) { f32x4 v[4]; rms_row(in.x + (size_t)m * 1024, in.mix_norm, Hb + (size_t)m * 1024, lane, v); }
            }
            TP_END(36, TPCTR);
        SEAM(0);
    }

    for (int l = 0; l < 2; ++l) {
        const int pb = 1 + PH_PER_LAYER * l;
        const float* x_in = (l == 0) ? in.x : args.out; float* x_out = args.out;
        if (l > 0 && PHON(0) && IN(pb + 0)) { PHASE_LOCALS TP_BEGIN(20) for (int rep_ = 0; rep_ < REPN(0); ++rep_) {
            for (int m = gw; m < S; m += NGW) { f32x4 v[4]; rms_row(x_in + (size_t)m * 1024, in.mix_norm + l * 1024, Hb + (size_t)m * 1024, lane, v); }
            }
            TP_END(20, TPCTR);
            SEAM(pb + 0);
        }
        if (PHON(1) && IN(pb + 1)) { PHASE_LOCALS TP_BEGIN(21) for (int rep_ = 0; rep_ < REPN(1); ++rep_) {
            pg8::StaticOrder So; So.init(Hb, (const bf16_t*)(lw + LW_WIN), 1024, 1024, S, NPROJ, G, bid);
            pg8::EpiStore E{PROJ, NPROJ, nullptr, QK_SCALE64, 0};
            pg8::gemm_phase<pg8::EpiStore, pg8::StaticOrder, true, false>(lds, 1024, 1024, 1024, So, E, wave);
#if GREP & 1
            pg8::gemm_phase<pg8::EpiStore, pg8::StaticOrder, true, false>(lds, 1024, 1024, 1024, So, E, wave);
#endif
            }
            TP_END(21, TPCTR);
            SEAM(pb + 1);
        }
        if (PHON(2) && IN(pb + 2)) { PHASE_LOCALS TP_BEGIN(22) for (int rep_ = 0; rep_ < REPN(2); ++rep_) {
            if (l == 0 && bid < 2) { const int i = bid * 512 + tid; float pv_[32];
#pragma unroll
                for (int kc = 0; kc < 32; ++kc) pv_[kc] = B1P[((i >> 8) * 32 + kc) * 256 + (i & 255)];
                float a = 0.f;
#pragma unroll
                for (int kc = 0; kc < 32; ++kc) a += pv_[kc];
                B1[i] = a; }
            for (int t = gw; t < S; t += NGW) {
                bf16_t* pr = PROJ + (size_t)t * NPROJ;
                {
                    const u32x4 w = *(const u32x4*)(pr + PC_NQ + lane * 8); float v[8] = {bflo(w.x), bfhi(w.x), bflo(w.y), bfhi(w.y), bflo(w.z), bfhi(w.z), bflo(w.w), bfhi(w.w)};
                    float ss = 0.f;
#pragma unroll
                    for (int e = 0; e < 8; ++e) ss += v[e] * v[e];
                    ss += sx<1>(ss); ss += sx<2>(ss); ss += sx<4>(ss);
                    const float rs = QK_SCALE64 / sqrtf(ss * (1.f / 64.f) + EPS); const float* gq = in.nsa_q_norm + l * 64 + 8 * (lane & 7);
                    u32x4 o; o.x = cvtpk(v[0] * rs * gq[0], v[1] * rs * gq[1]); o.y = cvtpk(v[2] * rs * gq[2], v[3] * rs * gq[3]); o.z = cvtpk(v[4] * rs * gq[4], v[5] * rs * gq[5]); o.w = cvtpk(v[6] * rs * gq[6], v[7] * rs * gq[7]);
                    *(u32x4*)(pr + PC_NQ + lane * 8) = o;
                }
                {
                    const int sec = lane >> 4, gg = (lane >> 3) & 1, d8 = 8 * (lane & 7);
                    const int col = (sec == 0 ? PC_NKS : sec == 1 ? PC_NKW : sec == 2 ? PC_NKC : PC_NVC) + (lane & 15) * 8;
                    const u32x4 w = *(const u32x4*)(pr + col); float v[8] = {bflo(w.x), bfhi(w.x), bflo(w.y), bfhi(w.y), bflo(w.z), bfhi(w.z), bflo(w.w), bfhi(w.w)};
                    float ss = 0.f;
#pragma unroll
                    for (int e = 0; e < 8; ++e) ss += v[e] * v[e];
                    ss += sx<1>(ss); ss += sx<2>(ss); ss += sx<4>(ss);
                    const float rs = 1.f / sqrtf(ss * (1.f / 64.f) + EPS);
                    u32x4 o = w;
                    if (sec < 2) { const float* gk = in.nsa_k_norm + (l * 3 + 1 + sec) * 64 + d8;
                        o.x = cvtpk(v[0] * rs * gk[0], v[1] * rs * gk[1]); o.y = cvtpk(v[2] * rs * gk[2], v[3] * rs * gk[3]); o.z = cvtpk(v[4] * rs * gk[4], v[5] * rs * gk[5]); o.w = cvtpk(v[6] * rs * gk[6], v[7] * rs * gk[7]); }
                    const int c8 = lane & 7; const size_t ksf = ((((size_t)(gg * 256 + (t >> 6)) * 2 + ((t >> 5) & 1)) * 4 + (c8 >> 1)) * 64 + (c8 & 1) * 32 + (t & 31)) * 8;
                    bf16_t* dst = (sec == 0 ? KS + ksf : (sec == 1 ? KW + ((size_t)gg * S + t) * 64 : sec == 2 ? KC + ((size_t)gg * KC_ROWS + t) * 64 : VC + ((size_t)gg * KC_ROWS + t) * 64) + d8);
                    *(u32x4*)dst = o;
                }
                {
                    const u32x2 w = *(const u32x2*)(pr + PC_CQ + lane * 4); float v[4] = {bflo(w.x), bfhi(w.x), bflo(w.y), bfhi(w.y)};
                    const float rs = 1.f / sqrtf(wave_sum((v[0] * v[0] + v[1] * v[1]) + (v[2] * v[2] + v[3] * v[3])) * (1.f / 256.f) + EPS); const float* ga = in.mla_q_a_norm + l * 256 + lane * 4;
                    u32x2 o; o.x = cvtpk(v[0] * rs * ga[0], v[1] * rs * ga[1]); o.y = cvtpk(v[2] * rs * ga[2], v[3] * rs * ga[3]); *(u32x2*)(pr + PC_CQ + lane * 4) = o;
                    const unsigned w2 = *(const unsigned*)(pr + PC_CKV + lane * 2); const float a = bflo(w2), b = bfhi(w2);
                    const float rs2 = 1.f / sqrtf(wave_sum(a * a + b * b) * (1.f / 128.f) + EPS); const float* gb = in.mla_kv_a_norm + l * 128 + lane * 2;
                    *(unsigned*)(pr + PC_CKV + lane * 2) = cvtpk(a * rs2 * gb[0], b * rs2 * gb[1]);
                }
                if (lane < 24) GN[(size_t)t * 24 + lane] = sigmoidf_(bf2f(pr[PC_NG + lane]));
            }
            for (int it = gw; it < 4096; it += NGW) {
                const int gg = it >> 11, blk = (it >> 3) & 255, s8 = it & 7; const bf16_t* src = PROJ + (size_t)(blk * 64) * NPROJ + PC_NVS + gg * 64 + lane; bf16_t* dstb = VTS + (size_t)(gg * 256 + blk) * 4096;
                unsigned short e[8];
#pragma unroll
                for (int j = 0; j < 8; ++j) { const int k = att::vts_key_of_slot(8 * s8 + j); e[j] = src[(size_t)k * NPROJ]; }
                u32x4 o; o.x = e[0] | ((unsigned)e[1] << 16); o.y = e[2] | ((unsigned)e[3] << 16); o.z = e[4] | ((unsigned)e[5] << 16); o.w = e[6] | ((unsigned)e[7] << 16);
                const int hh = s8 >> 2, ss = (s8 >> 1) & 1, h = s8 & 1;
                *(u32x4*)(dstb + ((((hh * 2 + (lane >> 5)) * 2 + ss) * 64) + h * 32 + (lane & 31)) * 8) = o;
            }
            }
            TP_END(22, TPCTR);
            SEAM(pb + 2);
        }
        if (PHON(3) && IN(pb + 3)) { PHASE_LOCALS TP_BEGIN(23) for (int rep_ = 0; rep_ < REPN(3); ++rep_) {
            const bool wide = (G >= 256);
            for (int job = 0; job < 2; ++job) {
                pg8::StaticOrder So; pg8::EpiStore E; int lda, ldb, K;
                if (job == 0) { lda = NPROJ; ldb = 256; K = 256; So.init(PROJ + PC_CQ, (const bf16_t*)(lw + LW_WUQ), lda, ldb, S, 512, wide ? 128 : G, wide ? (bid < 128 ? bid : -1) : bid); E = pg8::EpiStore{QRAW, 512, nullptr, 1.f, 0}; }
                else { lda = NPROJ; ldb = 128; K = 128; So.init(PROJ + PC_CKV, (const bf16_t*)(lw + LW_WUKV), lda, ldb, S, 512, wide ? 128 : G, wide ? (bid >= 128 && bid < 256 ? bid - 128 : -1) : bid); E = pg8::EpiStore{KVRAW, 512, nullptr, 1.f, 0}; }
                pg8::gemm_phase<pg8::EpiStore, pg8::StaticOrder, true, false>(lds, lda, ldb, K, So, E, wave);
#if GREP & 16
                pg8::gemm_phase<pg8::EpiStore, pg8::StaticOrder, true, false>(lds, lda, ldb, K, So, E, wave);
#endif
            }
            for (int jz = 0; jz < 16; ++jz) {
                const int z = jz >> 2, ks = jz & 3, kv = z >> 1, gg = z & 1;
                pg8::StaticOrder So; So.init((kv ? VC : KC) + (size_t)gg * KC_ROWS * 64 + ks * 512, (const bf16_t*)(lw + LW_CW1) + (size_t)kv * 256 * 2048 + ks * 512, 1024, 2048, 1024, 256, wide ? 4 : G, wide ? ((bid >= 128 + 4 * jz && bid < 132 + 4 * jz) ? bid - 128 - 4 * jz : -1) : bid);
                pg8::EpiF32 E{HIDP + (size_t)jz * 1024 * 256, 256};
                pg8::gemm_phase<pg8::EpiF32, pg8::StaticOrder, true, false>(lds, 1024, 2048, 512, So, E, wave);
            }
            }
            TP_END(23, TPCTR);
            SEAM(pb + 3);
        }
        if (PHON(4) && IN(pb + 4)) { PHASE_LOCALS TP_BEGIN(24) for (int rep_ = 0; rep_ < REPN(4); ++rep_) {
            const int kvb = (2 * vcu >= G) ? 1 : 0;
            { const float* w2g = in.nsa_cmp_w2 + (size_t)(l * 2 + kvb) * 256 * 64; LAS f32x4* w2l = (LAS f32x4*)lds;
#pragma unroll
              for (int i = 0; i < 8; ++i) w2l[tid + 512 * i] = *(const f32x4*)(w2g + (size_t)(tid + 512 * i) * 4); }
            __syncthreads();
            LAS unsigned short* ws16 = (LAS unsigned short*)(lds + 65536 + wave * 4096);
            for (int t = gw; t < S; t += NGW) {
                if (lane < 48) *(LAS u32x4*)(ws16 + 8 * lane) = *(const u32x4*)(QRAW + (size_t)t * 512 + 8 * lane);
                if (lane < 32) *(LAS u32x4*)(ws16 + 384 + (lane >> 3) * 96 + (lane & 7) * 8) = *(const u32x4*)(KVRAW + (size_t)t * 512 + (lane >> 3) * 128 + (lane & 7) * 8);
                else if (lane < 48) { const int hh_ = (lane - 32) >> 2, c_ = lane & 3; *(LAS u32x4*)(ws16 + 384 + hh_ * 96 + 64 + c_ * 8) = *(const u32x4*)(PROJ + (size_t)t * NPROJ + PC_KR + c_ * 8); }
                LDS_WAIT(); asm volatile("" ::: "memory");
                const int hd = lane >> 4, i = lane & 15; const float c = ROPE[t * 16 + i], s = ROPE[S * 16 + t * 16 + i];
                {   LAS unsigned short* src = ws16 + hd * 96 + i; float v[6]; float ss = 0.f;
#pragma unroll
                    for (int e = 0; e < 6; ++e) { v[e] = bf2f(src[16 * e]); ss += v[e] * v[e]; }
                    ss += sx<1>(ss); ss += sx<2>(ss); ss += sx<4>(ss); ss += sx<8>(ss);
                    const float rs = 1.f / sqrtf(ss * (1.f / 96.f) + EPS); const float* gq = in.mla_q_norm + l * 96 + i;
#pragma unroll
                    for (int e = 0; e < 6; ++e) v[e] = v[e] * rs * gq[16 * e];
                    const float x1 = v[4], x2 = v[5]; v[4] = x1 * c - x2 * s; v[5] = x2 * c + x1 * s;
#pragma unroll
                    for (int e = 0; e < 6; ++e) src[16 * e] = f2bf(v[e] * QK_SCALE96); }
                {   LAS unsigned short* src = ws16 + 384 + hd * 96 + i; float v[6]; float ss = 0.f;
#pragma unroll
                    for (int e = 0; e < 6; ++e) { v[e] = bf2f(src[16 * e]); ss += v[e] * v[e]; }
                    ss += sx<1>(ss); ss += sx<2>(ss); ss += sx<4>(ss); ss += sx<8>(ss);
                    const float rs = 1.f / sqrtf(ss * (1.f / 96.f) + EPS); const float* gk = in.mla_k_norm + l * 96 + i;
#pragma unroll
                    for (int e = 0; e < 6; ++e) v[e] = v[e] * rs * gk[16 * e];
                    const float x1 = v[4], x2 = v[5]; v[4] = x1 * c - x2 * s; v[5] = x2 * c + x1 * s;
#pragma unroll
                    for (int e = 0; e < 6; ++e) src[16 * e] = f2bf(v[e]); }
                LDS_WAIT(); asm volatile("" ::: "memory");
                if (lane < 48) { *(u32x4*)(QM + (size_t)t * 384 + 8 * lane) = *(const LAS u32x4*)(ws16 + 8 * lane); *(u32x4*)(KM + (size_t)t * 384 + 8 * lane) = *(const LAS u32x4*)(ws16 + 384 + 8 * lane); }
                LDS_WAIT(); asm volatile("" ::: "memory");
            }
            {
                LAS float* hs = (LAS float*)(lds + 65536 + wave * 4096); const LAS float* w2l = (const LAS float*)lds;
                const int hw = (kvb ? vcu - G / 2 : vcu) * NWAVES + wave, nhw = (kvb ? G - G / 2 : G / 2) * NWAVES;
                for (int it = hw; it < 2048; it += nhw) {
                    const int gg = it >> 10, n = it & 1023, z = kvb * 2 + gg;
                    { f32x4 hsum = *(const f32x4*)(B1 + (l * 2 + kvb) * 256 + lane * 4);
#pragma unroll
                      for (int ks = 0; ks < 4; ++ks) hsum += *(const f32x4*)(HIDP + ((size_t)(z * 4 + ks) * 1024 + n) * 256 + lane * 4);
                      *(LAS f32x4*)(hs + lane * 4) = (f32x4){siluf_(hsum.x), siluf_(hsum.y), siluf_(hsum.z), siluf_(hsum.w)}; }
                    LDS_WAIT(); asm volatile("" ::: "memory");
                    float a0 = 0.f, a1 = 0.f, a2 = 0.f, a3 = 0.f;
#pragma unroll 4
                    for (int j = 0; j < 256; j += 4) { const f32x4 h4 = *(const LAS f32x4*)(hs + j);
                        a0 += h4.x * w2l[j * 64 + lane]; a1 += h4.y * w2l[(j + 1) * 64 + lane]; a2 += h4.z * w2l[(j + 2) * 64 + lane]; a3 += h4.w * w2l[(j + 3) * 64 + lane]; }
                    const float a = (a0 + a1) + (a2 + a3);
                    if (kvb == 0) { const float rs = 1.f / sqrtf(wave_sum(a * a) * (1.f / 64.f) + EPS); KCMP[((size_t)gg * 1024 + n) * 64 + lane] = f2bf(a * rs * in.nsa_k_norm[(l * 3) * 64 + lane]); }
                    else VCMP[((size_t)gg * 1024 + n) * 64 + lane] = f2bf(a);
                    LDS_WAIT(); asm volatile("" ::: "memory");
                }
            }
            __syncthreads();
            }
            TP_END(24, TPCTR);
            SEAM(pb + 4);
        }
        if (PHON(5) && IN(pb + 5)) { PHASE_LOCALS TP_BEGIN(25) for (int rep_ = 0; rep_ < REPN(5); ++rep_) {
            __syncthreads();
            for (int r2_ = 0; r2_ < REPN(17); ++r2_) for (int u = vcu; u < 256; u += G) att::sb_unit((LAS char*)lds, PROJ, ATT, u >> 6, u & 63, wave);
            for (int r2_ = 0; r2_ < REPN(18); ++r2_) for (int p = vcu; p < 256; p += G) { const float mkb = 9.9f * CONS[3 + l]; att::mla_unit((LAS char*)lds, QM, KM, KVRAW, ATT, p >> 6, 127 - (p & 63), mkb, wave, TPCTR); att::mla_unit((LAS char*)lds, QM, KM, KVRAW, ATT, p >> 6, p & 63, mkb, wave, TPCTR); }
            att::NsaT T{PROJ, KCMP, VCMP, KS, VTS, KW, GN, LUT8, ATT, 8.08f * CONS[1 + l], CONS[0], (unsigned long long*)(ctl + 20480)};
            for (int r2_ = 0; r2_ < REPN(19); ++r2_) { volatile LAS int* qslot = (volatile LAS int*)(lds + MISC_OFF + 192); const int qg = (2 * vcu >= G) ? 1 : 0;
                __syncthreads(); att::nsa_load_lut((LAS char*)lds, LUT8, qg, tid);
                for (;;) { __syncthreads(); if (tid == 0) *qslot = (int)__hip_atomic_fetch_add(ctl + CW_NSAQ + 64 * (4 * l + 2 * r2_ + qg), 1u, RLX_AGENT); __syncthreads();
                    const int u = *qslot; if (u >= 256) break; att::nsa_unit((LAS char*)lds, T, qg, 255 - u, wave); } }
            }
            TP_END(25, TPCTR);
            SEAM(pb + 5);
        }
        if (PHON(6) && IN(pb + 6)) { PHASE_LOCALS TP_BEGIN(26) for (int rep_ = 0; rep_ < REPN(6); ++rep_) {
            for (int mix = 0; mix < 3; ++mix) {
                const int K = (mix == 1) ? 512 : 256; const int acol = (mix == 0) ? 0 : (mix == 1) ? 256 : 768;
                const bf16_t* Bt = (const bf16_t*)(lw + (mix == 0 ? LW_SBO : mix == 1 ? LW_NSAO : LW_MLAO));
                pg8::StaticOrder So; So.init(ATT + acol, Bt, 1024, K, S, 1024, G, bid);
                pg8::EpiGate E{MRG, PROJ + PC_GATE + mix * 1024, NPROJ, in.b_gate + l * 3072 + mix * 1024, mix == 0 ? 1 : 0};
                pg8::gemm_phase<pg8::EpiGate, pg8::StaticOrder, true, false>(lds, 1024, K, K, So, E, wave);
            }
            }
            TP_END(26, TPCTR);
            SEAM(pb + 6);
        }
        if (PHON(7) && IN(pb + 7)) { PHASE_LOCALS TP_BEGIN(27) for (int rep_ = 0; rep_ < REPN(7); ++rep_) {
            pg8::StaticOrder So; So.init(MRG, (const bf16_t*)(lw + LW_WOUT), 1024, 1024, S, 1024, G, bid);
            pg8::EpiResid E{x_in, x_out};
            pg8::gemm_phase<pg8::EpiResid, pg8::StaticOrder, true, false>(lds, 1024, 1024, 1024, So, E, wave);
            }
            TP_END(27, TPCTR);
            SEAM(pb + 7);
        }
        if (PHON(8) && IN(pb + 8)) { PHASE_LOCALS TP_BEGIN(28) for (int rep_ = 0; rep_ < REPN(8); ++rep_) {
            if (l == 1) {
                int troff = 0;
                tr_batch(in.moe_w_gate, in.moe_w_up, (size_t)1024 * EFF, EFF, EFF, 2, 1024, 2 * EFF, (bf16_t*)(wsl + WS_MGU), (size_t)7168 * 1024, 8, scr, gw, NGW, lane, troff);
                tr_batch(in.moe_w_down, nullptr, (size_t)EFF * 1024, 1024, 1024, 0, EFF, 1024, (bf16_t*)(wsl + WS_MDN), (size_t)1024 * EFF, 8, scr, gw, NGW, lane, troff);
            }
            for (int m = gw; m < S; m += NGW) {
                f32x4 v[4]; rms_row(x_out + (size_t)m * 1024, in.ffn_norm + l * 1024, Hb + (size_t)m * 1024, lane, v);
                if (l == 1) {
                    float lg[8];
#pragma unroll
                    for (int e = 0; e < 8; ++e) lg[e] = 0.f;
#pragma unroll
                    for (int j = 0; j < 4; ++j)
#pragma unroll
                        for (int q = 0; q < 4; ++q) { const float* wr = in.moe_router + (size_t)(4 * lane + 256 * j + q) * 8; const f32x4 wa = *(const f32x4*)wr, wb = *(const f32x4*)(wr + 4); const float hv = v[j][q];
                            lg[0] += hv * wa.x; lg[1] += hv * wa.y; lg[2] += hv * wa.z; lg[3] += hv * wa.w; lg[4] += hv * wb.x; lg[5] += hv * wb.y; lg[6] += hv * wb.z; lg[7] += hv * wb.w; }
#pragma unroll
                    for (int e = 0; e < 8; ++e) lg[e] = wave_sum(lg[e]);
                    int e0 = 0; float v0 = lg[0];
#pragma unroll
                    for (int e = 1; e < 8; ++e) if (lg[e] > v0) { v0 = lg[e]; e0 = e; }
                    int e1 = -1; float v1 = -INFINITY;
#pragma unroll
                    for (int e = 0; e < 8; ++e) if (e != e0 && lg[e] > v1) { v1 = lg[e]; e1 = e; }
                    if (lane == 0) { const float w0 = 1.f / (1.f + __expf(v1 - v0)), w1 = 1.f - w0;
                        const int p0 = (int)__hip_atomic_fetch_add(ctl + CW_MOECNT + 64 * e0, 1u, RLX_AGENT), p1 = (int)__hip_atomic_fetch_add(ctl + CW_MOECNT + 64 * e1, 1u, RLX_AGENT);
                        ROWTOK[e0 * S + p0] = m; ROWTOK[e1 * S + p1] = m;
                        int* r = ROUTE + (size_t)m * 8; r[0] = e0; r[1] = e1; r[2] = p0; r[3] = p1; r[4] = __float_as_int(w0); r[5] = __float_as_int(w1); }
                }
            }
            }
            TP_END(28, TPCTR);
            SEAM(pb + 8);
        }
        if (l == 0) {
#define ACT0 ((bf16_t*)(wsl + WS_R1))
            if (PHON(9) && IN(pb + 9)) { PHASE_LOCALS TP_BEGIN(29) for (int rep_ = 0; rep_ < REPN(9); ++rep_) {
                pg8::StaticOrder So; So.init(Hb, (const bf16_t*)(wsl + WS_DGU), 1024, 1024, S, 2 * DFF, G, bid);
                pg8::EpiSwiglu E{ACT0, DFF};
                pg8::gemm_phase<pg8::EpiSwiglu, pg8::StaticOrder, true, false>(lds, 1024, 1024, 1024, So, E, wave);
#if GREP & 2
                pg8::gemm_phase<pg8::EpiSwiglu, pg8::StaticOrder, true, false>(lds, 1024, 1024, 1024, So, E, wave);
#endif
            }
            TP_END(29, TPCTR);
                SEAM(pb + 9);
            }
            if (PHON(10) && IN(pb + 10)) { PHASE_LOCALS TP_BEGIN(30) for (int rep_ = 0; rep_ < REPN(10); ++rep_) {
                pg8::StaticOrder So; So.init(ACT0, (const bf16_t*)(wsl + WS_DDN), DFF, DFF, S, 1024, G, bid);
                pg8::EpiResid E{x_out, x_out};
                pg8::gemm_phase<pg8::EpiResid, pg8::StaticOrder, true, false>(lds, DFF, DFF, DFF, So, E, wave);
            }
            TP_END(30, TPCTR);
                SEAM(pb + 10);
            }
        } else {
#define ACT1 ((bf16_t*)(wsl + WS_R2))
#define YB ((bf16_t*)(wsl + WS_Y))
            for (int ps = 0; ps < 2; ++ps) {
                if (PHON(11) && IN(pb + 9 + 2 * ps)) { PHASE_LOCALS TP_BEGIN(31) for (int rep_ = 0; rep_ < REPN(11); ++rep_) {
                    if (tid == 0) { int tb = 0; for (int e = 0; e < 8; ++e) { const int c = (int)__hip_atomic_load(ctl + CW_MOECNT + 64 * e, RLX_AGENT); MTAB[e] = c; MTAB[8 + e] = tb; tb += (c + 255) >> 8; } MTAB[16] = tb; }
                    __syncthreads();
                    const int T = MTAB[16], tlo = 64 * ps, thi = (ps == 1) ? T : (T < 64 ? T : 64);
                    MoeGU So{MTAB, Hb, (const bf16_t*)(wsl + WS_MGU), ROWTOK, tlo, thi, G, bid};
                    pg8::EpiSwiglu E{ACT1, EFF};
                    pg8::gemm_phase<pg8::EpiSwiglu, MoeGU, true, true>(lds, 1024, 1024, 1024, So, E, wave);
#if GREP & 4
                    pg8::gemm_phase<pg8::EpiSwiglu, MoeGU, true, true>(lds, 1024, 1024, 1024, So, E, wave);
#endif
            }
            TP_END(31, TPCTR);
                    SEAM(pb + 9 + 2 * ps);
                }
                if (PHON(12) && IN(pb + 10 + 2 * ps)) { PHASE_LOCALS TP_BEGIN(32) for (int rep_ = 0; rep_ < REPN(12); ++rep_) {
                    if (tid == 0) { int tb = 0; for (int e = 0; e < 8; ++e) { const int c = (int)__hip_atomic_load(ctl + CW_MOECNT + 64 * e, RLX_AGENT); MTAB[e] = c; MTAB[8 + e] = tb; tb += (c + 255) >> 8; } MTAB[16] = tb; }
                    __syncthreads();
                    const int T = MTAB[16], tlo = 64 * ps, thi = (ps == 1) ? T : (T < 64 ? T : 64);
                    MoeDN So{MTAB, ACT1, (const bf16_t*)(wsl + WS_MDN), tlo, thi, G, bid};
                    pg8::EpiStore E{YB, 1024, nullptr, 1.f, 0};
                    pg8::gemm_phase<pg8::EpiStore, MoeDN, true, false>(lds, EFF, EFF, EFF, So, E, wave);
#if GREP & 8
                    pg8::gemm_phase<pg8::EpiStore, MoeDN, true, false>(lds, EFF, EFF, EFF, So, E, wave);
#endif
            }
            TP_END(32, TPCTR);
                    SEAM(pb + 10 + 2 * ps);
                }
            }
            if (PHON(15) && IN(pb + 15)) { PHASE_LOCALS TP_BEGIN(35) for (int rep_ = 0; rep_ < REPN(15); ++rep_) {
                if (tid == 0) { int tb = 0; for (int e = 0; e < 8; ++e) { const int c = (int)__hip_atomic_load(ctl + CW_MOECNT + 64 * e, RLX_AGENT); MTAB[e] = c; MTAB[8 + e] = tb; tb += (c + 255) >> 8; } MTAB[16] = tb; }
                __syncthreads();
                for (int m = gw; m < S; m += NGW) {
                    const int* r = ROUTE + (size_t)m * 8; const int e0 = r[0], e1 = r[1]; const float w0 = __int_as_float(r[4]), w1 = __int_as_float(r[5]);
                    const bf16_t* y0 = YB + ((size_t)MTAB[8 + e0] * 256 + r[2]) * 1024; const bf16_t* y1 = YB + ((size_t)MTAB[8 + e1] * 256 + r[3]) * 1024;
                    float* xo = x_out + (size_t)m * 1024;
#pragma unroll
                    for (int j = 0; j < 4; ++j) { const int c = 4 * lane + 256 * j; f32x4 xv = *(const f32x4*)(xo + c); const u32x2 a = *(const u32x2*)(y0 + c), b = *(const u32x2*)(y1 + c);
                        xv.x += w0 * bflo(a.x) + w1 * bflo(b.x); xv.y += w0 * bfhi(a.x) + w1 * bfhi(b.x); xv.z += w0 * bflo(a.y) + w1 * bflo(b.y); xv.w += w0 * bfhi(a.y) + w1 * bfhi(b.y);
                        *(f32x4*)(xo + c) = xv; }
                }
            }
            TP_END(35, TPCTR);
                if (l == 0) SEAM(pb + 15);
            }
        }
    }
#if TPROBE != 0 && !MK_MULTI
    xcd_barrier(bar);
    if (bid == 0 && wave == 0 && lane_id() == 0) { const unsigned long long tot = __hip_atomic_load((unsigned long long*)(ctl + 20480), RLX_AGENT) / (unsigned long long)(G * NWAVES); const unsigned long long t0 = tp_now(); while (tp_now() - t0 < tot) __builtin_amdgcn_s_sleep(8); }
#endif
#undef IN
#undef SEAM
}

extern "C" void kernel_launch(void* const* d_in, const int* in_sizes, int n_in, void* d_out, int out_size, void* d_ws, size_t ws_size, hipStream_t stream) {
    static int grid = 0;
    if (grid == 0) {
        if (n_in != 28 || in_sizes[0] != S * DM || out_size != S * DM || ws_size < WS_END) { fprintf(stderr, "kernel_launch: unexpected problem (n_in %d, in0 %d, out %d, ws %zu < %zu); nothing launched\n", n_in, n_in > 0 ? in_sizes[0] : -1, out_size, ws_size, (size_t)WS_END); grid = -1; return; }
        int dev = 0, cus = 0, per_cu = 0;
        if (hipGetDevice(&dev) != hipSuccess || hipDeviceGetAttribute(&cus, hipDeviceAttributeMultiprocessorCount, dev) != hipSuccess) { grid = -1; return; }
        if (hipFuncSetAttribute((const void*)fwd_kernel, hipFuncAttributeMaxDynamicSharedMemorySize, LDS_BYTES) != hipSuccess) { fprintf(stderr, "kernel_launch: hipFuncSetAttribute failed\n"); grid = -1; return; }
        if (hipOccupancyMaxActiveBlocksPerMultiprocessor(&per_cu, (const void*)fwd_kernel, NWAVES * 64, LDS_BYTES) != hipSuccess || per_cu < 1) { fprintf(stderr, "kernel_launch: occupancy query reports %d blocks per CU\n", per_cu); (void)hipGetLastError(); }
        grid = cus;
    }
    if (grid < 0) return;
    if (hipMemsetAsync((char*)d_ws + WS_CTL, 0, CTL_ZERO_BYTES, stream) != hipSuccess) return;
    Args a{};
    const float** ip = (const float**)&a.in;
    for (int i = 0; i < 28; ++i) ip[i] = (const float*)d_in[i];
    a.out = (float*)d_out; a.ws = (unsigned char*)d_ws;
#if MK_MULTI
    for (int ph = 0; ph < NPHASES; ++ph) {
        if (ph >= 1 + 11 && ph < 1 + PH_PER_LAYER) continue;
        a.ph_lo = ph; a.ph_hi = ph + 1;
        hipLaunchKernelGGL(fwd_kernel, dim3(grid), dim3(NWAVES * 64), LDS_BYTES, stream, a);
    }
#else
    a.ph_lo = 0; a.ph_hi = NPHASES;
    hipLaunchKernelGGL(fwd_kernel, dim3(grid), dim3(NWAVES * 64), LDS_BYTES, stream, a);
#endif
    const hipError_t le = hipPeekAtLastError();
    if (le != hipSuccess) fprintf(stderr, "kernel_launch: launch failed: %s\n", hipGetErrorName(le));
}
```

```cpp
#include <hip/hip_runtime.h>
#include <cstdio>
#include <cstdint>
#include <cmath>

#define LAS __attribute__((address_space(3)))
#define GAS __attribute__((address_space(1)))
typedef unsigned short bf16_t;
typedef short bf16x8 __attribute__((ext_vector_type(8)));
typedef short s16x4 __attribute__((ext_vector_type(4)));
typedef float f32x2 __attribute__((ext_vector_type(2)));
typedef float f32x4 __attribute__((ext_vector_type(4)));
typedef float f32x16 __attribute__((ext_vector_type(16)));
typedef unsigned u32x2 __attribute__((ext_vector_type(2)));
typedef unsigned u32x4 __attribute__((ext_vector_type(4)));
typedef __bf16 bf16x2_t __attribute__((ext_vector_type(2)));
typedef GAS unsigned gu32;
#define RLX_AGENT __ATOMIC_RELAXED, __HIP_MEMORY_SCOPE_AGENT
#define DI __device__ __forceinline__

DI unsigned cvtpk(float lo, float hi) { f32x2 v = {lo, hi}; bf16x2_t b = __builtin_convertvector(v, bf16x2_t); return __builtin_bit_cast(unsigned, b); }
DI float bf2f(bf16_t b) { return __uint_as_float(((unsigned)b) << 16); }
DI float bflo(unsigned w) { return __uint_as_float(w << 16); }
DI float bfhi(unsigned w) { return __uint_as_float(w & 0xffff0000u); }
DI bf16_t f2bf(float f) { return (bf16_t)(cvtpk(f, 0.f) & 0xffffu); }
DI float fast_exp2(float x) { return __builtin_amdgcn_exp2f(x); }
DI float fast_log2(float x) { return __builtin_amdgcn_logf(x); }
DI float fast_rcp(float x) { return __builtin_amdgcn_rcpf(x); }
constexpr float LOG2E = 1.4426950408889634f;
DI float sigmoidf_(float x) { return fast_rcp(1.f + fast_exp2(-x * LOG2E)); }
DI float siluf_(float x) { return x * sigmoidf_(x); }
template <int K> DI unsigned sxu(unsigned v) { return (unsigned)__builtin_amdgcn_ds_swizzle((int)v, (K << 10) | 0x1f); }
template <int K> DI float sx(float v) { return __uint_as_float(sxu<K>(__float_as_uint(v))); }
DI unsigned sx32u(unsigned v, int hi) { auto rr = __builtin_amdgcn_permlane32_swap(v, v, false, false); return hi ? rr[0] : rr[1]; }
DI float sx32(float v, int hi) { return __uint_as_float(sx32u(__float_as_uint(v), hi)); }
DI float sum32sym(float v) { auto rr = __builtin_amdgcn_permlane32_swap(__float_as_uint(v), __float_as_uint(v), false, false); return __uint_as_float(rr[0]) + __uint_as_float(rr[1]); }

#ifndef TPROBE
#define TPROBE 0
#endif
DI int lane_id() { int l_; asm volatile("v_mbcnt_lo_u32_b32 %0, -1, 0\n\tv_mbcnt_hi_u32_b32 %0, -1, %0" : "=v"(l_)); return l_; }
DI unsigned long long tp_now() { return __builtin_amdgcn_s_memrealtime(); }
#define TP_BEGIN(id) unsigned long long tp_t0_ = 0; if (TPROBE == (id)) tp_t0_ = tp_now();
#define TP_END(id, ctr) do { if (TPROBE == (id)) { const unsigned long long d_ = tp_now() - tp_t0_; if (lane_id() == 0) atomicAdd((unsigned long long*)(ctr), d_); } } while (0)

namespace pg8 {
constexpr int BM = 256, BK = 64, HALF = 128, HTB = HALF * BK * 2, STAGE_BYTES = 8 * HTB, NXCD = 8, WGM = 8;
__host__ __device__ __forceinline__ int lds_byte(int r, int c) { const int st = (r >> 4) * 2 + (c >> 5), rr = r & 15, cc = c & 31, ob = rr * 64 + cc * 2; return st * 1024 + (ob ^ (((ob >> 9) & 1) << 5)); }
__host__ __device__ __forceinline__ void stage_rc(int b, int& R, int& C) { const int st = b / 1024, sb = b % 1024, swz = sb ^ (((sb >> 9) & 1) << 5); R = (st >> 1) * 16 + swz / 64; C = (st & 1) * 32 + (swz % 64) / 2; }
__host__ __device__ __forceinline__ int perm32(int rho) { const int n = rho >> 4, i = rho & 15; return 8 * (i >> 2) + 4 * n + (i & 3); }

struct Unit { const bf16_t* a; const bf16_t* b; const int* rows; int nvalid, pm, pn; };

struct StaticOrder {
    const bf16_t* A; const bf16_t* Bt; int lda, ldb, nM, nN, nwg, G, c;
    DI void init(const bf16_t* A_, const bf16_t* Bt_, int lda_, int ldb_, int M, int N, int G_, int c_) { A = A_; Bt = Bt_; lda = lda_; ldb = ldb_; nM = M / BM; nN = N / BM; nwg = nM * nN; G = G_; c = c_; }
    DI bool next(int i, Unit& u) const {
        if (c < 0 || c >= G) return false;
        const long L = (long)i * G + c; if (L >= nwg) return false;
        int wgid = (int)L; { const int q = nwg / NXCD, r = nwg % NXCD, xcd = wgid % NXCD, off = wgid / NXCD; wgid = (xcd < r ? xcd * (q + 1) : r * (q + 1) + (xcd - r) * q) + off; }
        const int nig = WGM * nN, gid = wgid / nig, fm = gid * WGM, gsz = (nM - fm) < WGM ? (nM - fm) : WGM;
        u.pm = fm + ((wgid % nig) % gsz); u.pn = (wgid % nig) / gsz;
        u.a = A + (size_t)u.pm * BM * lda; u.b = Bt + (size_t)u.pn * BM * ldb; u.rows = nullptr; u.nvalid = BM; return true;
    }
};

struct EpiStore {
    static constexpr bool PERM = true;
    bf16_t* O; int ldc; const float* bias; float scale0; int act;
    DI void operator()(const f32x4 (&acc)[2][2][4][2], const Unit& u, int wr, int wc, int fr, int fq) const {
        const int row0 = u.pm * BM + wr * 64 + fr, col0 = u.pn * BM + wc * 32 + 8 * fq;
        const float sc = (u.pn == 0) ? scale0 : 1.f;
        f32x4 bv[2][2];
#pragma unroll
        for (int bj = 0; bj < 2; ++bj)
#pragma unroll
            for (int n = 0; n < 2; ++n) bv[bj][n] = bias ? *(const f32x4*)(bias + col0 + bj * HALF + 4 * n) : (f32x4){0.f, 0.f, 0.f, 0.f};
#pragma unroll
        for (int ai = 0; ai < 2; ++ai)
#pragma unroll
            for (int m = 0; m < 4; ++m) { bf16_t* rowp = O + (size_t)(row0 + ai * HALF + m * 16) * ldc + col0;
#pragma unroll
                for (int bj = 0; bj < 2; ++bj) { f32x4 v0 = (acc[ai][bj][m][0] + bv[bj][0]) * sc, v1 = (acc[ai][bj][m][1] + bv[bj][1]) * sc;
                    if (act) {
#pragma unroll
                        for (int e = 0; e < 4; ++e) { v0[e] = siluf_(v0[e]); v1[e] = siluf_(v1[e]); } }
                    u32x4 w; w.x = cvtpk(v0[0], v0[1]); w.y = cvtpk(v0[2], v0[3]); w.z = cvtpk(v1[0], v1[1]); w.w = cvtpk(v1[2], v1[3]);
                    *(u32x4*)(rowp + bj * HALF) = w; } }
    }
};
struct EpiGate {
    static constexpr bool PERM = true;
    bf16_t* Mg; const bf16_t* glog; int ldg; const float* bg; int first;
    DI void operator()(const f32x4 (&acc)[2][2][4][2], const Unit& u, int wr, int wc, int fr, int fq) const {
        const int row0 = u.pm * BM + wr * 64 + fr, col0 = u.pn * BM + wc * 32 + 8 * fq;
        f32x4 bv[2][2];
#pragma unroll
        for (int bj = 0; bj < 2; ++bj)
#pragma unroll
            for (int n = 0; n < 2; ++n) bv[bj][n] = *(const f32x4*)(bg + col0 + bj * HALF + 4 * n);
#pragma unroll
        for (int ai = 0; ai < 2; ++ai)
#pragma unroll
            for (int m = 0; m < 4; ++m) { const size_t row = (size_t)(row0 + ai * HALF + m * 16);
#pragma unroll
                for (int bj = 0; bj < 2; ++bj) { const int col = col0 + bj * HALF;
                    const u32x4 gl = *(const u32x4*)(glog + row * ldg + col);
                    u32x4 old = (u32x4){0u, 0u, 0u, 0u}; if (!first) old = *(const u32x4*)(Mg + row * 1024 + col);
                    float g[8] = {bflo(gl.x), bfhi(gl.x), bflo(gl.y), bfhi(gl.y), bflo(gl.z), bfhi(gl.z), bflo(gl.w), bfhi(gl.w)};
                    float o[8] = {bflo(old.x), bfhi(old.x), bflo(old.y), bfhi(old.y), bflo(old.z), bfhi(old.z), bflo(old.w), bfhi(old.w)};
#pragma unroll
                    for (int e = 0; e < 4; ++e) { o[e] += sigmoidf_(g[e] + bv[bj][0][e]) * acc[ai][bj][m][0][e]; o[4 + e] += sigmoidf_(g[4 + e] + bv[bj][1][e]) * acc[ai][bj][m][1][e]; }
                    u32x4 w; w.x = cvtpk(o[0], o[1]); w.y = cvtpk(o[2], o[3]); w.z = cvtpk(o[4], o[5]); w.w = cvtpk(o[6], o[7]);
                    *(u32x4*)(Mg + row * 1024 + col) = w; } }
    }
};
struct EpiResid {
    static constexpr bool PERM = false;
    const float* xin; float* out;
    DI void operator()(const f32x4 (&acc)[2][2][4][2], const Unit& u, int wr, int wc, int fr, int fq) const {
        const int row0 = u.pm * BM + wr * 64 + fr, col0 = u.pn * BM + wc * 32 + 4 * fq;
#pragma unroll
        for (int ai = 0; ai < 2; ++ai)
#pragma unroll
            for (int m = 0; m < 4; ++m) { const size_t off = (size_t)(row0 + ai * HALF + m * 16) * 1024 + col0;
#pragma unroll
                for (int bj = 0; bj < 2; ++bj)
#pragma unroll
                    for (int n = 0; n < 2; ++n) { const f32x4 b = *(const f32x4*)(xin + off + bj * HALF + n * 16); *(f32x4*)(out + off + bj * HALF + n * 16) = b + acc[ai][bj][m][n]; }
                if (m & 1) asm volatile("" ::: "memory"); }
    }
};
struct EpiF32 {
    static constexpr bool PERM = false;
    float* O; int ldc;
    DI void operator()(const f32x4 (&acc)[2][2][4][2], const Unit& u, int wr, int wc, int fr_in, int fq_in) const {
        int fr = fr_in, fq = fq_in; asm volatile("" : "+v"(fr), "+v"(fq));
        const int row0 = u.pm * BM + wr * 64 + fr, col0 = u.pn * BM + wc * 32 + 4 * fq;
#pragma unroll
        for (int ai = 0; ai < 2; ++ai)
#pragma unroll
            for (int m = 0; m < 4; ++m) { float* rowp = O + (size_t)(row0 + ai * HALF + m * 16) * ldc + col0;
#pragma unroll
                for (int bj = 0; bj < 2; ++bj)
#pragma unroll
                    for (int n = 0; n < 2; ++n) *(f32x4*)(rowp + bj * HALF + n * 16) = acc[ai][bj][m][n]; }
    }
};
struct EpiSwiglu {
    static constexpr bool PERM = true;
    bf16_t* act; int ldact;
    DI void operator()(const f32x4 (&acc)[2][2][4][2], const Unit& u, int wr, int wc, int fr, int fq) const {
        const int row0 = u.pm * BM + wr * 64 + fr, col0 = u.pn * HALF + wc * 32 + 8 * fq;
#pragma unroll
        for (int ai = 0; ai < 2; ++ai)
#pragma unroll
            for (int m = 0; m < 4; ++m) { bf16_t* rowp = act + (size_t)(row0 + ai * HALF + m * 16) * ldact + col0;
                float o[8];
#pragma unroll
                for (int e = 0; e < 4; ++e) { o[e] = siluf_(acc[ai][0][m][0][e]) * acc[ai][1][m][0][e]; o[4 + e] = siluf_(acc[ai][0][m][1][e]) * acc[ai][1][m][1][e]; }
                u32x4 w; w.x = cvtpk(o[0], o[1]); w.y = cvtpk(o[2], o[3]); w.z = cvtpk(o[4], o[5]); w.w = cvtpk(o[6], o[7]);
                *(u32x4*)rowp = w; }
    }
};

template <class Epi, class Sched, bool ALIGN_EPI, bool GATHER>
__device__ __forceinline__ void gemm_phase(LAS unsigned char* lds, const int lda, const int ldb, const int K, const Sched& S, const Epi& E, const int wave_id) {
    int tid_l = wave_id * 64 + lane_id(); asm volatile("" : "+v"(tid_l));
    const int tid = tid_l, wid = __builtin_amdgcn_readfirstlane(tid >> 6), lane = tid & 63, wr = wid >> 2, wc = wid & 3, fr = lane & 15, fq = lane >> 4;
    const int nt = K / BK;
    unsigned voffB[2], vc0[2], vc1[2], vn0[2], vn1[2];
#pragma unroll
    for (int i = 0; i < 2; ++i) { int R, C; stage_rc(tid * 16 + i * 8192, R, C); const int Rb = Epi::PERM ? ((R & ~31) + perm32(R & 31)) : R;
        voffB[i] = (unsigned)(Rb * ldb + C) * 2u; vc0[i] = (unsigned)(R * lda + C) * 2u; vc1[i] = vc0[i]; vn0[i] = vc0[i]; vn1[i] = vc0[i]; }
    const size_t hsA = GATHER ? (size_t)0 : (size_t)HALF * lda * 2, hsB = (size_t)HALF * ldb * 2;
    const size_t kstep = (size_t)(BK * 2);
    const unsigned ldsw = (unsigned)wid * 1024u;
    const int aoff = lds_byte(wr * 64 + fr, fq * 8), boff = lds_byte(wc * 32 + fr, fq * 8);
#define PG8_SA(b, h) (((b) * 2 + (h)) * HTB)
#define PG8_SB(b, h) ((4 + (b) * 2 + (h)) * HTB)
#define PG8_STAGE(bufoff, gbase, voff) do { _Pragma("unroll") for (int _i = 0; _i < 2; ++_i) \
        __builtin_amdgcn_global_load_lds((const unsigned*)((const char*)(gbase) + (voff)[_i]), (LAS unsigned*)(lds + (bufoff) + ldsw + _i * 8192), 16, 0, 0); } while (0)
#define PG8_LDA(dst, b, h) do { _Pragma("unroll") for (int m = 0; m < 4; ++m) _Pragma("unroll") for (int k = 0; k < 2; ++k) dst[m][k] = *(const LAS bf16x8*)(lds + PG8_SA(b, h) + aoff + m * 2048 + k * 1024); } while (0)
#define PG8_LDB(dst, b, h) do { _Pragma("unroll") for (int n = 0; n < 2; ++n) _Pragma("unroll") for (int k = 0; k < 2; ++k) dst[n][k] = *(const LAS bf16x8*)(lds + PG8_SB(b, h) + boff + n * 2048 + k * 1024); } while (0)
#define PG8_MMA(ai, bj, At, Bt) do { __builtin_amdgcn_s_setprio(1); _Pragma("unroll") for (int m = 0; m < 4; ++m) _Pragma("unroll") for (int n = 0; n < 2; ++n) _Pragma("unroll") for (int k = 0; k < 2; ++k) \
        acc[ai][bj][m][n] = __builtin_amdgcn_mfma_f32_16x16x32_bf16(Bt[n][k], At[m][k], acc[ai][bj][m][n], 0, 0, 0); __builtin_amdgcn_s_setprio(0); } while (0)
#define PG8_WAIT_V(n) asm volatile("s_waitcnt vmcnt(" #n ")" ::: "memory")
#define PG8_WAIT_L(n) asm volatile("s_waitcnt lgkmcnt(" #n ")" ::: "memory")
#define PG8_BAR __builtin_amdgcn_s_barrier()
#define PG8_SCHED __builtin_amdgcn_sched_barrier(0)
#define PG8_GVOFF(U, o0, o1) do { if constexpr (GATHER) { _Pragma("unroll") for (int _i = 0; _i < 2; ++_i) { int R_, C_; stage_rc(tid * 16 + _i * 8192, R_, C_); \
        const int r0_ = R_, r1_ = R_ + HALF; const int t0_ = (U).rows[r0_ < (U).nvalid ? r0_ : 0], t1_ = (U).rows[r1_ < (U).nvalid ? r1_ : 0]; \
        o0[_i] = (unsigned)(t0_ * lda + C_) * 2u; o1[_i] = (unsigned)(t1_ * lda + C_) * 2u; } } } while (0)
    Unit cur, nxt; int ui = 0;
    if (!S.next(0, cur)) return;
    PG8_GVOFF(cur, vc0, vc1);
    f32x4 acc[2][2][4][2];
#pragma unroll
    for (int a = 0; a < 2; ++a)
#pragma unroll
        for (int b = 0; b < 2; ++b)
#pragma unroll
            for (int m = 0; m < 4; ++m)
#pragma unroll
                for (int n = 0; n < 2; ++n) acc[a][b][m][n] = (f32x4){0.f, 0.f, 0.f, 0.f};
    bf16x8 At[4][2], B0[2][2], B1[2][2];
    const char* cA = (const char*)cur.a; const char* cB = (const char*)cur.b;
    PG8_STAGE(PG8_SB(0, 0), cB, voffB); PG8_STAGE(PG8_SB(0, 1), cB + hsB, voffB); PG8_STAGE(PG8_SA(0, 0), cA, vc0); PG8_STAGE(PG8_SA(0, 1), cA + hsA, vc1);
    if (wr == 1) PG8_BAR;
    PG8_WAIT_V(2); PG8_BAR;
    PG8_STAGE(PG8_SB(1, 0), cB + kstep, voffB); PG8_STAGE(PG8_SA(1, 0), cA + kstep, vc0); PG8_STAGE(PG8_SB(1, 1), cB + hsB + kstep, voffB);
    PG8_WAIT_V(6); PG8_BAR;
    for (;;) {
        const bool has_next = S.next(ui + 1, nxt);
        const char* nA = has_next ? (const char*)nxt.a : cA; const char* nB = has_next ? (const char*)nxt.b : cB;
        if constexpr (GATHER) { if (has_next) { PG8_GVOFF(nxt, vn0, vn1); } else {
#pragma unroll
            for (int i = 0; i < 2; ++i) { vn0[i] = vc0[i]; vn1[i] = vc1[i]; } } }
        for (int t = 0; t < nt; t += 2) {
            const bool last = (t == nt - 2);
            const char* a1 = cA + (size_t)(t + 1) * kstep;
            const char* a2 = last ? nA : cA + (size_t)(t + 2) * kstep; const char* b2 = last ? nB : cB + (size_t)(t + 2) * kstep;
            const char* a3 = a2 + kstep; const char* b3 = b2 + kstep;
            unsigned v20[2], v21[2];
#pragma unroll
            for (int i = 0; i < 2; ++i) { v20[i] = (GATHER && last) ? vn0[i] : vc0[i]; v21[i] = GATHER ? (last ? vn1[i] : vc1[i]) : vc0[i]; }
            PG8_LDB(B0, 0, 0); PG8_LDB(B1, 0, 1); PG8_SCHED; PG8_LDA(At, 0, 0); PG8_STAGE(PG8_SA(1, 1), a1 + hsA, vc1);
            PG8_WAIT_V(8); PG8_WAIT_L(0); PG8_BAR; PG8_MMA(0, 0, At, B0); PG8_MMA(0, 1, At, B1); PG8_BAR; PG8_SCHED;
            PG8_LDA(At, 0, 1); PG8_STAGE(PG8_SB(0, 0), b2, voffB); PG8_STAGE(PG8_SB(0, 1), b2 + hsB, voffB); PG8_STAGE(PG8_SA(0, 0), a2, v20);
            PG8_WAIT_V(8); PG8_WAIT_L(0); PG8_BAR; PG8_MMA(1, 0, At, B0); PG8_MMA(1, 1, At, B1); PG8_BAR; PG8_SCHED;
            PG8_LDB(B0, 1, 0); PG8_LDB(B1, 1, 1); PG8_SCHED; PG8_LDA(At, 1, 0); PG8_STAGE(PG8_SA(0, 1), a2 + hsA, v21);
            PG8_WAIT_V(8); PG8_WAIT_L(0); PG8_BAR; PG8_MMA(0, 0, At, B0); PG8_MMA(0, 1, At, B1); PG8_BAR; PG8_SCHED;
            PG8_LDA(At, 1, 1); PG8_STAGE(PG8_SB(1, 0), b3, voffB); PG8_STAGE(PG8_SB(1, 1), b3 + hsB, voffB); PG8_STAGE(PG8_SA(1, 0), a3, v20);
            PG8_WAIT_V(8); PG8_WAIT_L(0); PG8_BAR; PG8_MMA(1, 0, At, B0); PG8_MMA(1, 1, At, B1); PG8_BAR; PG8_SCHED;
        }
        if constexpr (ALIGN_EPI) { if (wr == 0) PG8_BAR; }
        E(acc, cur, wr, wc, fr, fq);
        if (!has_next) break;
#pragma unroll
        for (int a = 0; a < 2; ++a)
#pragma unroll
            for (int b = 0; b < 2; ++b)
#pragma unroll
                for (int m = 0; m < 4; ++m)
#pragma unroll
                    for (int n = 0; n < 2; ++n) acc[a][b][m][n] = (f32x4){0.f, 0.f, 0.f, 0.f};
        cur = nxt; cA = nA; cB = nB; ++ui;
        if constexpr (GATHER) {
#pragma unroll
            for (int i = 0; i < 2; ++i) { vc0[i] = vn0[i]; vc1[i] = vn1[i]; } }
        if constexpr (ALIGN_EPI) { if (wr == 1) PG8_BAR; }
    }
    PG8_WAIT_V(0);
    if constexpr (!ALIGN_EPI) { if (wr == 0) PG8_BAR; }
    PG8_BAR;
#undef PG8_SA
#undef PG8_SB
#undef PG8_STAGE
#undef PG8_LDA
#undef PG8_LDB
#undef PG8_MMA
#undef PG8_WAIT_V
#undef PG8_WAIT_L
#undef PG8_BAR
#undef PG8_SCHED
#undef PG8_GVOFF
}
}
#define XB_TMO      128
#define XB_XCNT(j)  (256  + 64 * (j))
#define XB_XSUB(j)  (1280 + 64 * (j))
#define XB_XGEN(j)  (2304 + 64 * (j))
#define XB_TOP      3328
#define XB_TOPGEN   3392
#define XCD_BAR_WORDS 3456
#define XB_SPIN_CAP (1u << 18)

__device__ __forceinline__ unsigned xb_ld(unsigned* p)              { return __hip_atomic_load(p, __ATOMIC_RELAXED, __HIP_MEMORY_SCOPE_AGENT); }
__device__ __forceinline__ unsigned xb_add(unsigned* p, unsigned v) { return __hip_atomic_fetch_add(p, v, __ATOMIC_RELAXED, __HIP_MEMORY_SCOPE_AGENT); }
__device__ __forceinline__ unsigned xb_xcc_id() { return (unsigned)__builtin_amdgcn_s_getreg((3 << 11) | 20) & 0xFu; }
#define XB_SPIN(cond, bar) do { unsigned _sp = 0; while (cond) { __builtin_amdgcn_s_sleep(1); \
    if ((++_sp & 255u) == 0u) { if (xb_ld(&(bar)[XB_TMO])) break; if (_sp > XB_SPIN_CAP) { atomicAdd(&(bar)[XB_TMO], 1u); break; } } } } while (0)

struct XcdBarrier {
    unsigned* bar; unsigned x;
    volatile LAS unsigned* st;
};

__device__ __forceinline__ XcdBarrier xcd_barrier_post(unsigned* bar, volatile LAS unsigned* st) {
    XcdBarrier b; b.bar = bar; b.x = xb_xcc_id(); b.st = st;
    if (threadIdx.x == 0) (void)xb_add(&bar[XB_XCNT(b.x)], 1u);
    return b;
}
__device__ __forceinline__ void xcd_barrier_complete(unsigned* bar, unsigned x, unsigned& nloc, unsigned& nx) {
    const unsigned G = gridDim.x * gridDim.y * gridDim.z;
    unsigned sum, cnt, mine, sp = 0u;
    for (;;) {
        sum = 0u; cnt = 0u; mine = 0u;
#pragma unroll
        for (unsigned j = 0; j < 16; ++j) { const unsigned c = xb_ld(&bar[XB_XCNT(j)]); sum += c; cnt += (c > 0u) ? 1u : 0u; mine = (j == x) ? c : mine; }
        if (sum == G) break;
        __builtin_amdgcn_s_sleep(1);
        if ((++sp & 255u) == 0u) { if (xb_ld(&bar[XB_TMO])) break; if (sp > XB_SPIN_CAP) { atomicAdd(&bar[XB_TMO], 1u); break; } }
    }
    nloc = mine > 0u ? mine : 1u; nx = cnt > 0u ? cnt : 1u;
}

__device__ __forceinline__ void xcd_barrier(const XcdBarrier& b) {
    asm volatile("s_waitcnt vmcnt(0)" ::: "memory");
    __syncthreads();
    if (threadIdx.x == 0) {
        unsigned* bar = b.bar;
        __builtin_amdgcn_s_waitcnt(0);
        unsigned nloc = b.st[0], nx = b.st[1];
        if (nloc == 0u) { xcd_barrier_complete(bar, b.x, nloc, nx); b.st[0] = nloc; b.st[1] = nx; }
        const unsigned old = xb_add(&bar[XB_XSUB(b.x)], 1u);
        const unsigned gen = old / nloc;
        if (old + 1u == (gen + 1u) * nloc) {
            __builtin_amdgcn_fence(__ATOMIC_RELEASE, "agent");
            asm volatile("s_waitcnt vmcnt(0)" ::: "memory");
            const unsigned og = xb_add(&bar[XB_TOP], 1u);
            const unsigned tg = og / nx;
            if (og + 1u == (tg + 1u) * nx) xb_add(&bar[XB_TOPGEN], 1u);
            else XB_SPIN(xb_ld(&bar[XB_TOPGEN]) == tg, bar);
            __builtin_amdgcn_fence(__ATOMIC_ACQUIRE, "agent");
            xb_add(&bar[XB_XGEN(b.x)], 1u);
            asm volatile("s_waitcnt vmcnt(0)" ::: "memory");
        } else {
            XB_SPIN(xb_ld(&bar[XB_XGEN(b.x)]) == gen, bar);
            __builtin_amdgcn_fence(__ATOMIC_ACQUIRE, "agent");
            asm volatile("s_waitcnt vmcnt(0)" ::: "memory");
        }
    }
    __syncthreads();
}
namespace att {
typedef short v4i16_t __attribute__((ext_vector_type(4)));
DI f32x16 mfma32(bf16x8 a, bf16x8 b, f32x16 c) { return __builtin_amdgcn_mfma_f32_32x32x16_bf16(a, b, c, 0, 0, 0); }
DI f32x4 mfma16(bf16x8 a, bf16x8 b, f32x4 c) { return __builtin_amdgcn_mfma_f32_16x16x32_bf16(a, b, c, 0, 0, 0); }
DI int crow(int r, int hi) { return (r & 3) + 8 * (r >> 2) + 4 * hi; }
DI s16x4 vtr(const LAS char* p) { return __builtin_bit_cast(s16x4, __builtin_amdgcn_ds_read_tr16_b64_v4i16((LAS v4i16_t*)p)); }
DI int rfl(int x) { return __builtin_amdgcn_readfirstlane(x); }
constexpr float NEGBIG = -1e30f;
#define LDS_BAR() asm volatile("s_waitcnt lgkmcnt(0)\n\ts_barrier" ::: "memory")

template <int D, int KS> DI f32x16 qk32(const LAS char* kp, const bf16x8* qf, float init = 0.f) {
    f32x16 acc;
#pragma unroll
    for (int i = 0; i < 16; ++i) acc[i] = init;
    bf16x8 kfr[D / 16];
#pragma unroll
    for (int d0 = 0; d0 < D / 16; ++d0) kfr[d0] = *(const LAS bf16x8*)(kp + d0 * 32);
    asm volatile("" ::: "memory");
#pragma unroll
    for (int d0 = 0; d0 < D / 16; ++d0) acc = mfma32(kfr[d0], qf[d0], acc);
    return acc;
}
template <int D, int KS> DI void qk64(f32x16& a0, f32x16& a1, const LAS char* kp, const bf16x8* qf, float init = 0.f) {
#pragma unroll
    for (int i = 0; i < 16; ++i) { a0[i] = init; a1[i] = init; }
    bf16x8 k0[D / 16], k1[D / 16];
#pragma unroll
    for (int d0 = 0; d0 < D / 16; ++d0) { k0[d0] = *(const LAS bf16x8*)(kp + d0 * 32); k1[d0] = *(const LAS bf16x8*)(kp + 32 * KS + d0 * 32); }
    asm volatile("" ::: "memory");
#pragma unroll
    for (int d0 = 0; d0 < D / 16; ++d0) { a0 = mfma32(k0[d0], qf[d0], a0); a1 = mfma32(k1[d0], qf[d0], a1); }
}
template <int VS> DI void pv32(f32x16 (&o)[2], const LAS char* vp, bf16x8 pf0, bf16x8 pf1) {
    s16x4 t[2][4];
#pragma unroll
    for (int dh = 0; dh < 2; ++dh) { t[dh][0] = vtr(vp + dh * 64); t[dh][1] = vtr(vp + 8 * VS + dh * 64); t[dh][2] = vtr(vp + 16 * VS + dh * 64); t[dh][3] = vtr(vp + 24 * VS + dh * 64); }
    asm volatile("" ::: "memory");
#pragma unroll
    for (int dh = 0; dh < 2; ++dh) {
        const bf16x8 v0 = __builtin_shufflevector(t[dh][0], t[dh][1], 0, 1, 2, 3, 4, 5, 6, 7), v1 = __builtin_shufflevector(t[dh][2], t[dh][3], 0, 1, 2, 3, 4, 5, 6, 7);
        o[dh] = mfma32(v0, pf0, o[dh]); o[dh] = mfma32(v1, pf1, o[dh]);
    }
}
template <int VS> DI void pv64(f32x16 (&o)[2], const LAS char* vp, const f32x16& p0, const f32x16& p1);
DI bf16x8 pack8(const f32x16& p, int s) {
    u32x4 w; w.x = cvtpk(p[8 * s], p[8 * s + 1]); w.y = cvtpk(p[8 * s + 2], p[8 * s + 3]); w.z = cvtpk(p[8 * s + 4], p[8 * s + 5]); w.w = cvtpk(p[8 * s + 6], p[8 * s + 7]);
    return __builtin_bit_cast(bf16x8, w);
}
template <int VS> DI void pv64(f32x16 (&o)[2], const LAS char* vp, const f32x16& p0, const f32x16& p1) {
    s16x4 t[2][2][4];
#pragma unroll
    for (int hh = 0; hh < 2; ++hh)
#pragma unroll
        for (int dh = 0; dh < 2; ++dh)
#pragma unroll
            for (int k = 0; k < 4; ++k) t[hh][dh][k] = vtr(vp + (32 * hh + 8 * k) * VS + dh * 64);
    const bf16x8 pa0 = pack8(p0, 0), pa1 = pack8(p0, 1), pb0 = pack8(p1, 0), pb1 = pack8(p1, 1);
    asm volatile("" ::: "memory");
#pragma unroll
    for (int dh = 0; dh < 2; ++dh) {
        o[dh] = mfma32(__builtin_shufflevector(t[0][dh][0], t[0][dh][1], 0, 1, 2, 3, 4, 5, 6, 7), pa0, o[dh]);
        o[dh] = mfma32(__builtin_shufflevector(t[0][dh][2], t[0][dh][3], 0, 1, 2, 3, 4, 5, 6, 7), pa1, o[dh]);
        o[dh] = mfma32(__builtin_shufflevector(t[1][dh][0], t[1][dh][1], 0, 1, 2, 3, 4, 5, 6, 7), pb0, o[dh]);
        o[dh] = mfma32(__builtin_shufflevector(t[1][dh][2], t[1][dh][3], 0, 1, 2, 3, 4, 5, 6, 7), pb1, o[dh]);
    }
}
DI float max16(const f32x16& p) { float a = fmaxf(fmaxf(p[0], p[1]), fmaxf(p[2], p[3]));
#pragma unroll
    for (int r = 4; r < 16; r += 4) a = fmaxf(a, fmaxf(fmaxf(p[r], p[r + 1]), fmaxf(p[r + 2], p[r + 3]))); return a; }
DI void store_ot(bf16_t* dst, const f32x16 (&o)[2], int hi) {
#pragma unroll
    for (int dh = 0; dh < 2; ++dh)
#pragma unroll
        for (int g4 = 0; g4 < 4; ++g4) { u32x2 w; w.x = cvtpk(o[dh][4 * g4], o[dh][4 * g4 + 1]); w.y = cvtpk(o[dh][4 * g4 + 2], o[dh][4 * g4 + 3]); *(u32x2*)(dst + 32 * dh + 8 * g4 + 4 * hi) = w; }
}

#define ATT_SB() __builtin_amdgcn_sched_barrier(0)
template <int D, int KS, int VS> DI void step64(f32x16 (&o)[2], float& l, const LAS char* kp, const LAS char* vp, const bf16x8* qf, float init) {
    bf16x8 k0[D / 16], k1[D / 16];
#pragma unroll
    for (int d0 = 0; d0 < D / 16; ++d0) { k0[d0] = *(const LAS bf16x8*)(kp + d0 * 32); k1[d0] = *(const LAS bf16x8*)(kp + 32 * KS + d0 * 32); }
    s16x4 t[2][2][4];
#pragma unroll
    for (int hh = 0; hh < 2; ++hh)
#pragma unroll
        for (int dh = 0; dh < 2; ++dh)
#pragma unroll
            for (int k = 0; k < 4; ++k) t[hh][dh][k] = vtr(vp + (32 * hh + 8 * k) * VS + dh * 64);
    f32x16 a0, a1;
#pragma unroll
    for (int i = 0; i < 16; ++i) { a0[i] = init; a1[i] = init; }
    ATT_SB();
#pragma unroll
    for (int d0 = 0; d0 < D / 16; ++d0) a0 = mfma32(k0[d0], qf[d0], a0);
#pragma unroll
    for (int d0 = 0; d0 < D / 16 - 4; ++d0) a1 = mfma32(k1[d0], qf[d0], a1);
    ATT_SB();
    float ls = 0.f;
#pragma unroll
    for (int g = 0; g < 4; ++g) {
        a1 = mfma32(k1[D / 16 - 4 + g], qf[D / 16 - 4 + g], a1);
#pragma unroll
        for (int e = 0; e < 4; ++e) { a0[4 * g + e] = fast_exp2(a0[4 * g + e]); ls += a0[4 * g + e]; }
        asm volatile("" : "+v"(a0), "+v"(ls)); ATT_SB();
    }
    const bf16x8 pa0 = pack8(a0, 0), pa1 = pack8(a0, 1);
    ATT_SB();
#pragma unroll
    for (int g = 0; g < 4; ++g) {
        const int dh = g & 1, s = g >> 1;
        o[dh] = mfma32(__builtin_shufflevector(t[0][dh][2 * s], t[0][dh][2 * s + 1], 0, 1, 2, 3, 4, 5, 6, 7), s ? pa1 : pa0, o[dh]);
#pragma unroll
        for (int e = 0; e < 4; ++e) { a1[4 * g + e] = fast_exp2(a1[4 * g + e]); ls += a1[4 * g + e]; }
        asm volatile("" : "+v"(a1), "+v"(ls)); ATT_SB();
    }
    const bf16x8 pb0 = pack8(a1, 0), pb1 = pack8(a1, 1);
    ATT_SB();
#pragma unroll
    for (int g = 0; g < 4; ++g) { const int dh = g & 1, s = g >> 1;
        o[dh] = mfma32(__builtin_shufflevector(t[1][dh][2 * s], t[1][dh][2 * s + 1], 0, 1, 2, 3, 4, 5, 6, 7), s ? pb1 : pb0, o[dh]); }
    l += ls;
}

constexpr int MLA_KS = 208, MLA_VS = 144, MLA_KB = 128 * MLA_KS, MLA_VB = 128 * MLA_VS, MLA_BUF = MLA_KB + MLA_VB;
DI void mla_unit(LAS char* lds, const bf16_t* QM, const bf16_t* KM, const bf16_t* KV, bf16_t* ATT, int head, int qb, float kb, int wave_id, unsigned long long* tp) {
    TP_BEGIN(7) unsigned long long tpacc_ = 0, tpa_ = 0;
    int tid_l = wave_id * 64 + lane_id(); asm volatile("" : "+v"(tid_l));
    const int tid = tid_l, lane = tid & 63, wid = rfl(tid >> 6), r32 = lane & 31, hi = lane >> 5, half = wid >> 2, wq = wid & 3;
    const int q0 = qb * 128, qpos = q0 + 32 * wq + r32, nsuper = qb + 1;
    bf16x8 qf[6];
    { const bf16_t* qp = QM + (size_t)qpos * 384 + head * 96 + hi * 8;
#pragma unroll
      for (int d0 = 0; d0 < 6; ++d0) qf[d0] = *(const bf16x8*)(qp + d0 * 16); }
    float nref;
    { float qs = 0.f;
#pragma unroll
      for (int d0 = 0; d0 < 6; ++d0)
#pragma unroll
          for (int e = 0; e < 8; ++e) { const float v = __uint_as_float(((unsigned)(unsigned short)qf[d0][e]) << 16); qs += v * v; }
      qs += sx32(qs, hi); nref = -sqrtf(qs) * kb; }
    u32x4 kr[3], vr[2];
#define MLA_LOAD(i) do { _Pragma("unroll") for (int j = 0; j < 3; ++j) { const int c = tid + 512 * j, row = c / 12, ch = c % 12; kr[j] = *(const u32x4*)(KM + (size_t)(128 * (i) + row) * 384 + head * 96 + ch * 8); } \
        _Pragma("unroll") for (int j = 0; j < 2; ++j) { const int c = tid + 512 * j, row = c >> 3, ch = c & 7; vr[j] = *(const u32x4*)(KV + (size_t)(128 * (i) + row) * 512 + head * 128 + 64 + ch * 8); } } while (0)
#define MLA_STORE(b) do { LAS char* kb_ = lds + (b) * MLA_BUF; _Pragma("unroll") for (int j = 0; j < 3; ++j) { const int c = tid + 512 * j, row = c / 12, ch = c % 12; *(LAS u32x4*)(kb_ + row * MLA_KS + ch * 16) = kr[j]; } \
        _Pragma("unroll") for (int j = 0; j < 2; ++j) { const int c = tid + 512 * j, row = c >> 3, ch = c & 7; *(LAS u32x4*)(kb_ + MLA_KB + row * MLA_VS + ch * 16) = vr[j]; } } while (0)
    MLA_LOAD(0); MLA_STORE(0); __syncthreads();
    float l = 0.f; f32x16 o[2];
#pragma unroll
    for (int i = 0; i < 16; ++i) { o[0][i] = 0.f; o[1][i] = 0.f; }
    const int vlane = (4 * hi + ((lane & 15) >> 2)) * MLA_VS + 2 * (16 * ((lane >> 4) & 1) + 4 * (lane & 3));
    for (int i = 0; i < nsuper; ++i) {
        const bool more = i + 1 < nsuper;
        if (more) MLA_LOAD(i + 1);
        const LAS char* kb_ = lds + (i & 1) * MLA_BUF; const LAS char* vb = kb_ + MLA_KB;
        const bool diag = (i == nsuper - 1);
        if (TPROBE == 14 || TPROBE == 15 || TPROBE == 16) tpa_ = tp_now();
        if (!(diag && half == 1 && wq < 2)) {
            const int koff = 64 * half;
            if (!diag) step64<96, MLA_KS, MLA_VS>(o, l, kb_ + (koff + r32) * MLA_KS + hi * 16, vb + koff * MLA_VS + vlane, qf, nref);
            else {
            f32x16 p0, p1; qk64<96, MLA_KS>(p0, p1, kb_ + (koff + r32) * MLA_KS + hi * 16, qf, nref);
            { const int kbase = 128 * i + koff;
#pragma unroll
                for (int r = 0; r < 16; ++r) { const int k0 = kbase + crow(r, hi); p0[r] = (k0 > qpos) ? 0.f : fast_exp2(p0[r]); p1[r] = (k0 + 32 > qpos) ? 0.f : fast_exp2(p1[r]); } }
#pragma unroll
            for (int r = 0; r < 16; ++r) l += p0[r] + p1[r];
            pv64<MLA_VS>(o, vb + koff * MLA_VS + vlane, p0, p1);
            }
        }
        if (TPROBE == 15) tpacc_ += tp_now() - tpa_;
        if (TPROBE == 16) tpa_ = tp_now();
        if (more) MLA_STORE((i + 1) & 1);
        if (TPROBE == 16) tpacc_ += tp_now() - tpa_;
        if (TPROBE == 14) tpa_ = tp_now();
        __syncthreads();
        if (TPROBE == 14) tpacc_ += tp_now() - tpa_;
    }
#undef MLA_LOAD
#undef MLA_STORE
    l = sum32sym(l);
    LAS float* mrg = (LAS float*)lds + (wq * 64 + lane) * 34;
    if (half == 1) { mrg[1] = l;
#pragma unroll
        for (int r = 0; r < 16; ++r) { mrg[2 + r] = o[0][r]; mrg[18 + r] = o[1][r]; } }
    __syncthreads();
    if (half == 0) {
        const float inv = 1.f / (l + mrg[1]);
#pragma unroll
        for (int r = 0; r < 16; ++r) { o[0][r] = (o[0][r] + mrg[2 + r]) * inv; o[1][r] = (o[1][r] + mrg[18 + r]) * inv; }
        store_ot(ATT + (size_t)qpos * 1024 + 768 + head * 64, o, hi);
    }
    __syncthreads();
    TP_END(7, tp);
    if ((TPROBE == 14 || TPROBE == 15 || TPROBE == 16) && lane == 0) atomicAdd(tp, tpacc_);
}

constexpr int T_KS = 144, T_KB = 64 * T_KS, T_BUF = 2 * T_KB;
DI void sb_half(f32x16 (&o)[2], float& R, const LAS char* ktile, const LAS char* vtile, const bf16x8* qf, int kb, int hh, int qpos, int r32, int hi, int vlane) {
    f32x16 z = qk32<64, T_KS>(ktile + (32 * hh + r32) * T_KS + hi * 16, qf);
    float ls[16];
#pragma unroll
    for (int r = 0; r < 16; ++r) { const bool valid = (kb + crow(r, hi)) < qpos; const float az = fabsf(z[r]);
        const float sp = fmaxf(z[r], 0.f) + fast_log2(1.f + fast_exp2(-az)); ls[r] = valid ? -sp : 0.f; }
    float T[4], U[4];
#pragma unroll
    for (int g = 0; g < 4; ++g) { ls[4 * g + 2] += ls[4 * g + 3]; ls[4 * g + 1] += ls[4 * g + 2]; ls[4 * g] += ls[4 * g + 1]; T[g] = ls[4 * g]; }
#pragma unroll
    for (int g = 0; g < 4; ++g) U[g] = sx32(T[g], hi);
    float H[4]; float sp = 0.f;
#pragma unroll
    for (int g = 3; g >= 0; --g) { H[g] = sp + (hi == 0 ? U[g] : 0.f); sp += T[g] + U[g]; }
#pragma unroll
    for (int r = 0; r < 16; ++r) { const bool valid = (kb + crow(r, hi)) < qpos; const float lw = z[r] + R + H[r >> 2] + ls[r]; z[r] = valid ? fast_exp2(lw) : 0.f; }
    R += sp;
    pv32<T_KS>(o, vtile + (32 * hh) * T_KS + vlane, pack8(z, 0), pack8(z, 1));
}
DI void sb_unit(LAS char* lds, const bf16_t* PROJ, bf16_t* ATT, int head, int qb, int wave_id) {
    int tid_l = wave_id * 64 + lane_id(); asm volatile("" : "+v"(tid_l));
    const int tid = tid_l, lane = tid & 63, wid = rfl(tid >> 6), r32 = lane & 31, hi = lane >> 5;
    const int q0 = qb * 256, wq0 = q0 + 32 * wid, qpos = wq0 + r32;
    bf16x8 qf[4];
    { const bf16_t* qp = PROJ + (size_t)qpos * 5632 + head * 64 + hi * 8;
#pragma unroll
      for (int d0 = 0; d0 < 4; ++d0) qf[d0] = *(const bf16x8*)(qp + d0 * 16); }
    const int srow = tid >> 3, sch = tid & 7;
    u32x4 kr, vr;
#define SB_LOAD(t) do { const bf16_t* p_ = PROJ + (size_t)(64 * (t) + srow) * 5632 + head * 64 + sch * 8; kr = *(const u32x4*)(p_ + 256); vr = *(const u32x4*)(p_ + 512); } while (0)
#define SB_STORE(b) do { LAS char* d_ = lds + (b) * T_BUF + srow * T_KS + sch * 16; *(LAS u32x4*)d_ = kr; *(LAS u32x4*)(d_ + T_KB) = vr; } while (0)
    volatile LAS int* flags = (volatile LAS int*)(lds + 2 * T_BUF);
    int t = 4 * qb + 3;
    SB_LOAD(t); SB_STORE(0); __syncthreads();
    float R = 0.f; f32x16 o[2];
#pragma unroll
    for (int i = 0; i < 16; ++i) { o[0][i] = 0.f; o[1][i] = 0.f; }
    const int vlane = (4 * hi + ((lane & 15) >> 2)) * T_KS + 2 * (16 * ((lane >> 4) & 1) + 4 * (lane & 3));
    bool done = false;
    for (int it = 0;; ++it) {
        const bool more = t > 0;
        if (more) SB_LOAD(t - 1);
        const LAS char* kt = lds + (it & 1) * T_BUF; const LAS char* vt = kt + T_KB;
        if (!done && 64 * t <= wq0 + 30) {
            if (64 * t + 32 <= wq0 + 30) sb_half(o, R, kt, vt, qf, 64 * t + 32, 1, qpos, r32, hi, vlane);
            sb_half(o, R, kt, vt, qf, 64 * t, 0, qpos, r32, hi, vlane);
            done = __all(R < -150.f) != 0;
        }
        if (lane == 0) flags[(it & 1) * 8 + wid] = done ? 0 : 1;
        if (more) SB_STORE((it + 1) & 1);
        __syncthreads();
        int any = 0;
#pragma unroll
        for (int w = 0; w < 8; ++w) any |= flags[(it & 1) * 8 + w];
        if (!more || !any) break;
        --t;
    }
#undef SB_LOAD
#undef SB_STORE
    store_ot(ATT + (size_t)qpos * 1024 + head * 64, o, hi);
    __syncthreads();
}

#ifndef NSAREP
#define NSAREP 0
#endif
#define NSA_NREP(bit) (((NSAREP >> (bit)) & 1) ? 2 : 1)
constexpr int N_LUT = 2 * T_BUF, N_IMP = N_LUT + 16384, N_OSTR = 68, N_BLKQ = N_IMP + 256 * N_OSTR * 4, N_L = N_BLKQ + 2048, N_REF = N_L + 1280, N_END = N_REF + 1024 + 64;
constexpr int N_QS = 144;
struct NsaT {
    const bf16_t* PROJ;
    const bf16_t* KCMP; const bf16_t* VCMP;
    const bf16_t* KS; const bf16_t* VTS;
    const bf16_t* KW;
    const float* GN;
    const float* LUT8;
    bf16_t* ATT;
    float kb, bmax;
    unsigned long long* tp;
};
__host__ __device__ __forceinline__ int vts_key_of_slot(int slot) { const int hh = slot >> 5, s5 = slot & 31, s = s5 >> 4, h = (s5 >> 3) & 1, j = s5 & 7; return 32 * hh + 16 * s + 8 * (j >> 2) + 4 * h + (j & 3); }

DI void nsa_load_lut(LAS char* lds, const float* LUT8, int g, int tid) { LAS float* lut = (LAS float*)(lds + N_LUT); for (int i = tid; i < 4096; i += 512) lut[i] = LUT8[(i >> 2) * 8 + g * 4 + (i & 3)]; }
DI void nsa_unit(LAS char* lds, const NsaT& T, int g, int qblk, int wave_id) {
    int tid_l = wave_id * 64 + lane_id(); asm volatile("" : "+v"(tid_l));
    const int tid = tid_l, lane = tid & 63, wid = rfl(tid >> 6), r32 = lane & 31, hi = lane >> 5;
    const int q0 = qblk * 64;
    TP_BEGIN(6)
    LAS float* lut = (LAS float*)(lds + N_LUT);
    LAS float* imp = (LAS float*)(lds + N_IMP);
    LAS unsigned* bq32 = (LAS unsigned*)(lds + N_BLKQ);
    LAS float* refl = (LAS float*)(lds + N_REF);
    for (int i = tid; i < 16384; i += 512) imp[i] = 0.f;
    bq32[tid] = 0u;
    const int ql = r32 >> 2, hd = r32 & 3, h8 = g * 4 + hd, tq = q0 + 8 * wid + ql;
    bf16x8 qf[4];
    { const bf16_t* qp = T.PROJ + (size_t)tq * 5632 + 768 + h8 * 64 + hi * 8;
#pragma unroll
      for (int d0 = 0; d0 < 4; ++d0) qf[d0] = *(const bf16x8*)(qp + d0 * 16); }
    float ref;
    { float qs = 0.f;
#pragma unroll
      for (int d0 = 0; d0 < 4; ++d0)
#pragma unroll
          for (int e = 0; e < 8; ++e) { const float v = __uint_as_float(((unsigned)(unsigned short)qf[d0][e]) << 16); qs += v * v; }
      qs += sx32(qs, hi); ref = sqrtf(qs) * T.kb + T.bmax; }
    if (hi == 0) refl[(8 * wid + ql) * 4 + hd] = ref;
    const float gc = T.GN[(size_t)tq * 24 + 3 * h8], gs = T.GN[(size_t)tq * 24 + 3 * h8 + 1], gw = T.GN[(size_t)tq * 24 + 3 * h8 + 2];
    const int srow = tid >> 3, sch = tid & 7;
    const int vlane = (4 * hi + ((lane & 15) >> 2)) * T_KS + 2 * (16 * ((lane >> 4) & 1) + 4 * (lane & 3));
    u32x4 kr, vr;
    __syncthreads();
    const float cfar = lut[1023 * 4 + hd] - ref;
    const int nmax = (q0 + 32) / 16 + 1;
    const int ntc = (nmax + 63) >> 6;
    const bf16_t* kc = T.KCMP + (size_t)g * 1024 * 64; const bf16_t* vc = T.VCMP + (size_t)g * 1024 * 64;
    const int relq = tq - 31;
    const int relw = q0 + 8 * wid - 31;
    float l = 0.f; float inv_l = 0.f; f32x16 oa[2];
    { TP_BEGIN(4)
    for (int rp_ = 0; rp_ < NSA_NREP(0); ++rp_) { l = 0.f;
    u32x4 kq, vq;
    u32x4 v2a = *(const u32x4*)(vc + (size_t)srow * 64 + sch * 8), v2b = v2a; if (1 < ntc) v2b = *(const u32x4*)(vc + (size_t)(64 + srow) * 64 + sch * 8);
    kr = *(const u32x4*)(kc + (size_t)srow * 64 + sch * 8);
    *(LAS u32x4*)(lds + srow * T_KS + sch * 16) = kr; kq = kr;
    if (1 < ntc) kq = *(const u32x4*)(kc + (size_t)(64 + srow) * 64 + sch * 8);
    LDS_BAR();
    for (int j = 0; j < ntc; ++j) {
        const bool more = j + 1 < ntc;
        if (j + 2 < ntc) kr = *(const u32x4*)(kc + (size_t)(64 * (j + 2) + srow) * 64 + sch * 8);
        const LAS char* kt = lds + (j & 1) * T_BUF;
#pragma unroll
        for (int hh = 0; hh < 2; ++hh) {
            f32x16 s = qk32<64, T_KS>(kt + (32 * hh + r32) * T_KS + hi * 16, qf);
            const int n0 = 64 * j + 32 * hh;
            if (relw - 16 * (n0 + 31) >= 790) {
#pragma unroll
                for (int r = 0; r < 16; ++r) l += fast_exp2(s[r] + cfar);
            } else {
#pragma unroll
                for (int r = 0; r < 16; ++r) { const int rel = relq - 16 * (n0 + crow(r, hi)); l += (rel >= 0) ? fast_exp2(s[r] + lut[(rel < 1023 ? rel : 1023) * 4 + hd] - ref) : 0.f; }
            }
        }
        if (more) *(LAS u32x4*)(lds + ((j + 1) & 1) * T_BUF + srow * T_KS + sch * 16) = kq;
        kq = kr;
        LDS_BAR();
    }
    l = sum32sym(l);
    inv_l = l > 0.f ? 1.f / l : 0.f;
#pragma unroll
    for (int i = 0; i < 16; ++i) { oa[0][i] = 0.f; oa[1][i] = 0.f; }
    float cprev = 0.f;
    kr = *(const u32x4*)(kc + (size_t)srow * 64 + sch * 8); vr = v2a;
    { LAS char* d_ = lds + srow * T_KS + sch * 16; *(LAS u32x4*)d_ = kr; *(LAS u32x4*)(d_ + T_KB) = vr; } kq = kr; vq = vr;
    if (1 < ntc) { kq = *(const u32x4*)(kc + (size_t)(64 + srow) * 64 + sch * 8); vq = v2b; }
    LDS_BAR();
    for (int j = 0; j < ntc; ++j) {
        const bool more = j + 1 < ntc;
        if (j + 2 < ntc) { kr = *(const u32x4*)(kc + (size_t)(64 * (j + 2) + srow) * 64 + sch * 8); vr = *(const u32x4*)(vc + (size_t)(64 * (j + 2) + srow) * 64 + sch * 8); }
        const LAS char* kt = lds + (j & 1) * T_BUF; const LAS char* vt = kt + T_KB;
#pragma unroll
        for (int hh = 0; hh < 2; ++hh) {
            f32x16 s = qk32<64, T_KS>(kt + (32 * hh + r32) * T_KS + hi * 16, qf);
            const int n0 = 64 * j + 32 * hh;
            if (relw - 16 * (n0 + 31) >= 790) {
#pragma unroll
                for (int r = 0; r < 16; ++r) s[r] = fast_exp2(s[r] + cfar) * inv_l;
            } else {
#pragma unroll
                for (int r = 0; r < 16; ++r) { const int rel = relq - 16 * (n0 + crow(r, hi)); s[r] = (rel >= 0) ? fast_exp2(s[r] + lut[(rel < 1023 ? rel : 1023) * 4 + hd] - ref) * inv_l : 0.f; }
            }
            float gsm[4], c3[4], pc3[4];
#pragma unroll
            for (int gi = 0; gi < 4; ++gi) { float a = (s[4 * gi] + s[4 * gi + 1]) + (s[4 * gi + 2] + s[4 * gi + 3]), b = s[4 * gi + 3];
                a += sx<1>(a); a += sx<2>(a); b += sx<1>(b); b += sx<2>(b); gsm[gi] = a; c3[gi] = b; }
#pragma unroll
            for (int gi = 0; gi < 4; ++gi) pc3[gi] = sx32(c3[gi], hi);
            const int b0 = 16 * j + 8 * hh + hi;
            if (hd == 0) {
                LAS float* ip = imp + (8 * wid + ql) * 256 + b0;
                if (hi == 1) {
#pragma unroll
                    for (int gi = 0; gi < 4; ++gi) ip[2 * gi] = gsm[gi] + pc3[gi];
                } else { ip[0] = gsm[0] + cprev; ip[2] = gsm[1] + pc3[0]; ip[4] = gsm[2] + pc3[1]; ip[6] = gsm[3] + pc3[2]; }
            }
            cprev = pc3[3];
            pv32<T_KS>(oa, vt + (32 * hh) * T_KS + vlane, pack8(s, 0), pack8(s, 1));
        }
        if (more) { LAS char* d_ = lds + ((j + 1) & 1) * T_BUF + srow * T_KS + sch * 16; *(LAS u32x4*)d_ = kq; *(LAS u32x4*)(d_ + T_KB) = vq; }
        kq = kr; vq = vr;
        LDS_BAR();
    }
    }
    TP_END(4, T.tp); }
#pragma unroll
    for (int i = 0; i < 16; ++i) { oa[0][i] *= gc; oa[1][i] *= gc; }
    store_ot(T.ATT + (size_t)tq * 1024 + 256 + h8 * 64, oa, hi);
    { TP_BEGIN(3)
    for (int rp_ = 0; rp_ < NSA_NREP(1); ++rp_) {
    unsigned ones = 0xffffffffu; asm volatile("" : "+v"(ones));
    if (qblk < 16) {
        if (tid <= qblk) { bq32[2 * tid] = ones; bq32[2 * tid + 1] = ones; }
    } else {
        if (tid == 0) { bq32[0] = ones; bq32[1] = ones; bq32[2 * qblk] = ones; bq32[2 * qblk + 1] = ones; bq32[2 * qblk - 2] = ones; bq32[2 * qblk - 1] = ones; }
        unsigned kv[8][4];
#pragma unroll
        for (int q = 0; q < 8; ++q)
#pragma unroll
            for (int i = 0; i < 4; ++i) { const int b = lane + 64 * i; kv[q][i] = (b >= 1 && b <= qblk - 2) ? __float_as_uint(imp[(8 * wid + q) * 256 + b]) + 1u : 0u; }
        unsigned T8[8];
#pragma unroll
        for (int q = 0; q < 8; ++q) T8[q] = 0u;
        for (int bit = 31; bit >= 0; --bit) {
#pragma unroll
            for (int q = 0; q < 8; ++q) { const unsigned t2 = T8[q] | (1u << bit);
                const int cnt = __builtin_popcountll(__builtin_amdgcn_ballot_w64(kv[q][0] >= t2)) + __builtin_popcountll(__builtin_amdgcn_ballot_w64(kv[q][1] >= t2))
                              + __builtin_popcountll(__builtin_amdgcn_ballot_w64(kv[q][2] >= t2)) + __builtin_popcountll(__builtin_amdgcn_ballot_w64(kv[q][3] >= t2));
                T8[q] = (cnt >= 13) ? t2 : T8[q]; }
        }
#pragma unroll
        for (int q = 0; q < 8; ++q) { const unsigned Tq = T8[q];
            int quota = 13 - (__builtin_popcountll(__builtin_amdgcn_ballot_w64(kv[q][0] > Tq)) + __builtin_popcountll(__builtin_amdgcn_ballot_w64(kv[q][1] > Tq))
                            + __builtin_popcountll(__builtin_amdgcn_ballot_w64(kv[q][2] > Tq)) + __builtin_popcountll(__builtin_amdgcn_ballot_w64(kv[q][3] > Tq)));
            const int qi = 8 * wid + q;
#pragma unroll
            for (int i = 0; i < 4; ++i) {
                const unsigned long long me = __builtin_amdgcn_ballot_w64(kv[q][i] == Tq); const int pe = __builtin_popcountll(me); const int take = pe < quota ? pe : quota;
                unsigned long long km = 0ull, mm = me; for (int t_ = 0; t_ < take; ++t_) { km |= mm & (0ull - mm); mm &= mm - 1ull; }
                quota -= take;
                const bool tie = (lane < 32 ? (unsigned)km >> lane : (unsigned)(km >> 32) >> (lane - 32)) & 1u;
                if (kv[q][i] > Tq || (kv[q][i] == Tq && tie)) (void)__hip_atomic_fetch_or(bq32 + 2 * (lane + 64 * i) + (qi >> 5), 1u << (qi & 31), __ATOMIC_RELAXED, __HIP_MEMORY_SCOPE_WORKGROUP);
            }
        }
    }
    }
    TP_END(3, T.tp); }
    __syncthreads();
    {
        LAS float* slot = (LAS float*)(lds + N_IMP);
        LAS unsigned short* items = (LAS unsigned short*)(lds + N_L);
        volatile LAS int* nitems = (volatile LAS int*)(lds + N_L + 768);
        LAS unsigned* smask = (LAS unsigned*)(lds + N_L + 832);
        LAS unsigned char* npv = (LAS unsigned char*)(lds + N_L + 896);
        LAS int* part = (LAS int*)(lds + N_REF + 1024);
        if (tid < 256) { int np = 0; if (qblk >= 16 && tid >= 1 && tid <= qblk - 2) { const unsigned long long mk = ((unsigned long long)bq32[2 * tid + 1] << 32) | bq32[2 * tid]; np = (__builtin_popcountll(mk) + 7) >> 3; } npv[tid] = (unsigned char)np; }
        __syncthreads();
        if (tid < 16) { int sm = 0;
#pragma unroll
            for (int k = 0; k < 16; ++k) sm += npv[16 * tid + k]; part[tid] = sm; }
        __syncthreads();
        if (tid == 0) { int run = 0;
#pragma unroll
            for (int k = 0; k < 16; ++k) { const int v = part[k]; part[k] = run; run += v; } *nitems = run; }
        __syncthreads();
        if (tid < 256) { int st = part[tid >> 4]; for (int k = 0; k < (tid & 15); ++k) st += npv[(tid & ~15) + k]; const int np = npv[tid]; for (int pp = 0; pp < np; ++pp) items[st + pp] = (unsigned short)(tid | (pp << 8)); }
        { const int q = tid >> 3, c8 = tid & 7; const bf16_t* src = T.PROJ + (size_t)(q0 + q) * 5632 + 768 + g * 256 + c8 * 32; LAS char* dst = lds + (q * 4 + (c8 >> 1)) * N_QS + (c8 & 1) * 64;
#pragma unroll
          for (int i = 0; i < 4; ++i) *(LAS u32x4*)(dst + 16 * i) = *(const u32x4*)(src + 8 * i); }
        __syncthreads();
        const bf16_t* ksg = T.KS + (size_t)g * 256 * 4096 + lane * 8;
        const bf16_t* vtg = T.VTS + (size_t)g * 256 * 4096 + lane * 8;
        const int jslot = r32 >> 2;
        const int myq = 8 * wid + ql; const unsigned qmlo = myq < 32 ? ((1u << myq) - 1u) : 0xffffffffu, qmhi = myq < 32 ? 0u : ((1u << (myq - 32)) - 1u);
        const float biasfar = lut[1023 * 4 + hd];
        float lpart = 0.f, lfull = 0.f; f32x16 os[2];
        for (int rp_ = 0; rp_ < NSA_NREP(2); ++rp_) { lpart = 0.f; lfull = 0.f;
#pragma unroll
        for (int i = 0; i < 16; ++i) { os[0][i] = 0.f; os[1][i] = 0.f; }
        bf16x8 kf[2][4], vf[2][2][2];
#define NSA_LDK(B) do { const bf16_t* p_ = ksg + (size_t)(B) * 4096; _Pragma("unroll") for (int hh = 0; hh < 2; ++hh) _Pragma("unroll") for (int d0 = 0; d0 < 4; ++d0) kf[hh][d0] = *(const bf16x8*)(p_ + (hh * 4 + d0) * 512); } while (0)
#define NSA_LDV(B) do { const bf16_t* p_ = vtg + (size_t)(B) * 4096; _Pragma("unroll") for (int hh = 0; hh < 2; ++hh) _Pragma("unroll") for (int dh = 0; dh < 2; ++dh) _Pragma("unroll") for (int s = 0; s < 2; ++s) vf[hh][dh][s] = *(const bf16x8*)(p_ + ((hh * 2 + dh) * 2 + s) * 512); } while (0)
#define NSA_SCORE(B, QF, INI, TS, OK, LS) do { \
            _Pragma("unroll") for (int hh = 0; hh < 2; ++hh) { _Pragma("unroll") for (int i = 0; i < 16; ++i) sc[hh][i] = (INI); \
                _Pragma("unroll") for (int d0 = 0; d0 < 4; ++d0) sc[hh] = mfma32(kf[hh][d0], (QF)[d0], sc[hh]); } \
            if (q0 - (64 * (B) + 63) >= 790) { _Pragma("unroll") for (int hh = 0; hh < 2; ++hh) _Pragma("unroll") for (int r = 0; r < 16; ++r) { const float p = (OK) ? fast_exp2(sc[hh][r]) : 0.f; sc[hh][r] = p; LS += p; } } \
            else { _Pragma("unroll") for (int hh = 0; hh < 2; ++hh) _Pragma("unroll") for (int r = 0; r < 16; ++r) { const int rel = (TS) - (64 * (B) + 32 * hh + crow(r, hi)); const int rc = rel < 0 ? 0 : (rel < 1023 ? rel : 1023); \
                const float p = ((OK) && rel >= 0) ? fast_exp2(sc[hh][r] + lut[rc * 4 + hd]) : 0.f; sc[hh][r] = p; LS += p; } } } while (0)
#define NSA_PV(O) do { _Pragma("unroll") for (int hh = 0; hh < 2; ++hh) { const bf16x8 p0 = pack8(sc[hh], 0), p1 = pack8(sc[hh], 1); \
            _Pragma("unroll") for (int dh = 0; dh < 2; ++dh) { (O)[dh] = mfma32(vf[hh][dh][0], p0, (O)[dh]); (O)[dh] = mfma32(vf[hh][dh][1], p1, (O)[dh]); } } } while (0)
        f32x16 sc[2];
        { TP_BEGIN(2) const int nf = qblk < 16 ? qblk + 1 : 3;
          { const int fb0 = 0; NSA_LDK(fb0); NSA_LDV(fb0); }
          for (int fi = 0; fi < nf; ++fi) { const int fb = qblk < 16 ? fi : (fi == 0 ? 0 : qblk - 2 + fi); const int fn = qblk < 16 ? fi + 1 : qblk - 1 + fi;
            const float ini = ((q0 - (64 * fb + 63) >= 790) ? biasfar : 0.f) - ref;
            NSA_SCORE(fb, qf, ini, tq, true, lpart);
            if (fi + 1 < nf) NSA_LDK(fn);
            NSA_PV(os);
            if (fi + 1 < nf) NSA_LDV(fn); } TP_END(2, T.tp); }
        TP_BEGIN(1)
        const int ni = *nitems; unsigned long long tpacc_ = 0;
        int it_b = -1, it_p = 0;
        if (wid < ni) { const int e = items[wid]; it_b = e & 255; it_p = e >> 8; NSA_LDK(it_b); NSA_LDV(it_b); }
        for (int i0 = 0; i0 < ni; i0 += 8) {
            const int inext = i0 + 8 + wid; int nb_ = -1, np_ = 0;
            if (inext < ni) { const int e = items[inext]; nb_ = e & 255; np_ = e >> 8; }
            unsigned long long msk = 0ull;
            unsigned long long tpa_ = 0; if (TPROBE == 11 || TPROBE == 12 || TPROBE == 13) tpa_ = tp_now();
            if (it_b >= 0) {
                unsigned long long m_ = ((unsigned long long)(unsigned)rfl((int)bq32[2 * it_b + 1]) << 32) | (unsigned)rfl((int)bq32[2 * it_b]);
                for (int i_ = 0; i_ < 8 * it_p; ++i_) m_ &= m_ - 1ull;
                unsigned long long t_ = m_; for (int i_ = 0; i_ < 8; ++i_) t_ &= t_ - 1ull;
                msk = m_ & ~t_;
                int qsel = -1; { unsigned long long mm = msk;
#pragma unroll
                    for (int j = 0; j < 8; ++j) { const int qj = mm ? (int)__builtin_ctzll(mm) : -1; mm &= mm - 1ull; if (jslot == j) qsel = qj; } }
                const bool valid = qsel >= 0; const int row = (valid ? qsel : 0) * 4 + hd, ts = q0 + (valid ? qsel : 0);
                const float ini = ((q0 - (64 * it_b + 63) >= 790) ? biasfar : 0.f) - refl[row];
                bf16x8 qv[4];
#pragma unroll
                for (int d0 = 0; d0 < 4; ++d0) qv[d0] = *(const LAS bf16x8*)(lds + row * N_QS + d0 * 32 + hi * 16);
                float ls = 0.f;
                NSA_SCORE(it_b, qv, ini, ts, valid, ls);
                if (nb_ >= 0) NSA_LDK(nb_);
                f32x16 ot[2];
#pragma unroll
                for (int i = 0; i < 16; ++i) { ot[0][i] = 0.f; ot[1][i] = 0.f; }
                NSA_PV(ot);
                if (nb_ >= 0) NSA_LDV(nb_);
                ls = sum32sym(ls);
                LAS float* sp = slot + (wid * 32 + r32) * N_OSTR;
#pragma unroll
                for (int dh = 0; dh < 2; ++dh)
#pragma unroll
                    for (int g4 = 0; g4 < 4; ++g4) *(LAS f32x4*)(sp + 32 * dh + 8 * g4 + 4 * hi) = (f32x4){ot[dh][4 * g4], ot[dh][4 * g4 + 1], ot[dh][4 * g4 + 2], ot[dh][4 * g4 + 3]};
                if (hi == 0) sp[64] = ls;
            }
            if (lane == 0) { smask[2 * wid] = (unsigned)msk; smask[2 * wid + 1] = (unsigned)(msk >> 32); }
            if (TPROBE == 11) tpacc_ += tp_now() - tpa_;
            if (TPROBE == 12 || TPROBE == 13) tpa_ = tp_now();
            LDS_BAR();
            if (TPROBE == 12) tpacc_ += tp_now() - tpa_;
            if (TPROBE == 13) tpa_ = tp_now();
            const unsigned smv = smask[lane & 15];
#pragma unroll
            for (int w = 0; w < 8; ++w) {
                const unsigned mlo = (unsigned)__builtin_amdgcn_readlane((int)smv, 2 * w), mhi = (unsigned)__builtin_amdgcn_readlane((int)smv, 2 * w + 1);
                const unsigned long long mw = ((unsigned long long)mhi << 32) | mlo;
                if ((unsigned)(mw >> (8 * wid)) & 0xffu) {
                    const bool has = (myq < 32 ? (mlo >> myq) : (mhi >> (myq - 32))) & 1u;
                    const int j = __builtin_popcount(mlo & qmlo) + __builtin_popcount(mhi & qmhi);
                    const LAS float* sp = slot + (w * 32 + (has ? j : 0) * 4 + hd) * N_OSTR;
                    f32x4 v[2][4];
#pragma unroll
                    for (int dh = 0; dh < 2; ++dh)
#pragma unroll
                        for (int g4 = 0; g4 < 4; ++g4) v[dh][g4] = *(const LAS f32x4*)(sp + 32 * dh + 8 * g4 + 4 * hi);
                    const float lv = sp[64];
                    if (has) {
#pragma unroll
                        for (int dh = 0; dh < 2; ++dh)
#pragma unroll
                            for (int g4 = 0; g4 < 4; ++g4) { os[dh][4 * g4] += v[dh][g4].x; os[dh][4 * g4 + 1] += v[dh][g4].y; os[dh][4 * g4 + 2] += v[dh][g4].z; os[dh][4 * g4 + 3] += v[dh][g4].w; }
                        lfull += lv; }
                }
            }
            if (TPROBE == 13) tpacc_ += tp_now() - tpa_;
            LDS_BAR();
            it_b = nb_; it_p = np_;
        }
        TP_END(1, T.tp);
        if ((TPROBE == 11 || TPROBE == 12 || TPROBE == 13) && lane == 0) atomicAdd(T.tp, tpacc_);
#undef NSA_LDK
#undef NSA_LDV
#undef NSA_SCORE
#undef NSA_PV
        }
        { const float f = gs / (sum32sym(lpart) + lfull);
#pragma unroll
          for (int i = 0; i < 16; ++i) { oa[0][i] = f * os[0][i]; oa[1][i] = f * os[1][i]; } }
        { const bf16_t* qp = T.PROJ + (size_t)tq * 5632 + 768 + h8 * 64 + hi * 8;
#pragma unroll
          for (int d0 = 0; d0 < 4; ++d0) qf[d0] = *(const bf16x8*)(qp + d0 * 16); }
        __syncthreads();
    }
    {
        const bf16_t* kw = T.KW + (size_t)g * 16384 * 64; const bf16_t* vw = T.PROJ + 1920 + g * 64;
        const int kt0 = qblk > 8 ? qblk - 8 : 0, ntw = qblk - kt0 + 1;
        float lw = 0.f; f32x16 ow[2];
        TP_BEGIN(5)
        for (int rp_ = 0; rp_ < NSA_NREP(3); ++rp_) { lw = 0.f;
#pragma unroll
        for (int i = 0; i < 16; ++i) { ow[0][i] = 0.f; ow[1][i] = 0.f; }
#define WIN_LD(t, K_, V_) do { K_ = *(const u32x4*)(kw + (size_t)(64 * (t) + srow) * 64 + sch * 8); V_ = *(const u32x4*)(vw + (size_t)(64 * (t) + srow) * 5632 + sch * 8); } while (0)
        u32x4 kq, vq;
        WIN_LD(kt0, kr, vr);
        { LAS char* d_ = lds + srow * T_KS + sch * 16; *(LAS u32x4*)d_ = kr; *(LAS u32x4*)(d_ + T_KB) = vr; }
        kq = kr; vq = vr;
        if (1 < ntw) WIN_LD(kt0 + 1, kq, vq);
        LDS_BAR();
        for (int j = 0; j < ntw; ++j) {
            const bool more = j + 1 < ntw;
            if (j + 2 < ntw) WIN_LD(kt0 + j + 2, kr, vr);
            const LAS char* kt = lds + (j & 1) * T_BUF; const LAS char* vt = kt + T_KB;
            f32x16 p[2];
#pragma unroll
            for (int hh = 0; hh < 2; ++hh) { p[hh] = qk32<64, T_KS>(kt + (32 * hh + r32) * T_KS + hi * 16, qf);
#pragma unroll
                for (int r = 0; r < 16; ++r) { const int rel = tq - (64 * (kt0 + j) + 32 * hh + crow(r, hi)); const bool valid = rel >= 0 && rel < 512;
                    const float e = valid ? fast_exp2(p[hh][r] + lut[(rel < 0 ? 0 : rel) * 4 + hd] - ref) : 0.f; p[hh][r] = e; lw += e; } }
            pv64<T_KS>(ow, vt + vlane, p[0], p[1]);
            if (more) { LAS char* d_ = lds + ((j + 1) & 1) * T_BUF + srow * T_KS + sch * 16; *(LAS u32x4*)d_ = kq; *(LAS u32x4*)(d_ + T_KB) = vq; }
            kq = kr; vq = vr;
            LDS_BAR();
        }
#undef WIN_LD
        }
        TP_END(5, T.tp);
        lw = sum32sym(lw);
        const float f = gw / lw;
#pragma unroll
        for (int i = 0; i < 16; ++i) { oa[0][i] += f * ow[0][i]; oa[1][i] += f * ow[1][i]; }
        { const bf16_t* ap = T.ATT + (size_t)tq * 1024 + 256 + h8 * 64;
#pragma unroll
          for (int dh = 0; dh < 2; ++dh)
#pragma unroll
              for (int g4 = 0; g4 < 4; ++g4) { const u32x2 w = *(const u32x2*)(ap + 32 * dh + 8 * g4 + 4 * hi); oa[dh][4 * g4] += bflo(w.x); oa[dh][4 * g4 + 1] += bfhi(w.x); oa[dh][4 * g4 + 2] += bflo(w.y); oa[dh][4 * g4 + 3] += bfhi(w.y); } }
        store_ot(T.ATT + (size_t)tq * 1024 + 256 + h8 * 64, oa, hi);
    }
    __syncthreads();
    TP_END(6, T.tp);
}
}
constexpr int S = 16384, DM = 1024, NPROJ = 5632, INC = 5560, DFF = 2816, EFF = 3584, NEXP = 8;
constexpr int NWAVES = 8;
constexpr float EPS = 1e-6f;
constexpr float QK_SCALE64 = 0.125f * LOG2E;
constexpr float QK_SCALE96 = 0.10206207261596575f * LOG2E;
#ifndef MK_MULTI
#define MK_MULTI 0
#endif
constexpr int PC_SBQ = 0, PC_SBK = 256, PC_SBV = 512, PC_NQ = 768, PC_NKC = 1280, PC_NVC = 1408, PC_NKS = 1536, PC_NVS = 1664, PC_NKW = 1792, PC_NVW = 1920,
              PC_CQ = 2048, PC_CKV = 2304, PC_KR = 2432, PC_NG = 2464, PC_GATE = 2560;
__host__ __device__ __forceinline__ int win_oldcol(int c) {
    if (c < 2048) return c; if (c < 2464) return c + 24; if (c < 2488) return 2048 + (c - 2464); if (c < 2560) return -1; return c - 72; }

constexpr size_t MiB = 1u << 20;
constexpr size_t WS_CTL = 0, CTL_ZERO_BYTES = 1 * MiB;
constexpr size_t WS_LW = 1 * MiB, LW_STRIDE = 18 * MiB;
constexpr size_t LW_WIN = 0, LW_SBO = 11 * MiB, LW_NSAO = LW_SBO + MiB / 2, LW_MLAO = LW_NSAO + MiB, LW_WOUT = LW_MLAO + MiB / 2, LW_WUQ = LW_WOUT + 2 * MiB, LW_WUKV = LW_WUQ + MiB / 4, LW_CW1 = LW_WUKV + MiB / 4;
constexpr size_t WS_DGU = 37 * MiB, WS_DDN = 48 * MiB;
constexpr size_t WS_Y = 1 * MiB;
constexpr size_t WS_H = 74 * MiB;
constexpr size_t WS_ROPE = 106 * MiB;
constexpr size_t WS_LUT8 = 108 * MiB, WS_B1P = WS_LUT8 + 256 * 1024, WS_B1 = WS_LUT8 + 512 * 1024, WS_ROUTE = 109 * MiB, WS_ROWTOK = WS_ROUTE + 512 * 1024;
constexpr size_t WS_R1 = 110 * MiB;
constexpr size_t WS_MGU = WS_R1, WS_MDN = WS_R1 + 112 * MiB;
constexpr size_t WS_R2 = 296 * MiB;
constexpr size_t R2_KC = 0, R2_VC = R2_KC + 4 * MiB + MiB / 4, R2_KS = R2_VC + 4 * MiB + MiB / 4, R2_VTS = R2_KS + 4 * MiB, R2_KW = R2_VTS + 4 * MiB, R2_GN = R2_KW + 4 * MiB,
                 R2_QM = R2_GN + 2 * MiB, R2_KM = R2_QM + 12 * MiB, R2_HID = R2_KM + 12 * MiB, R2_KCMP = R2_HID + 2 * MiB, R2_VCMP = R2_KCMP + MiB / 4, R2_ATT = R2_VCMP + MiB / 4 + MiB / 2,
                 R2_MRG = R2_ATT + 32 * MiB, R2_QRAW = R2_MRG, R2_KVRAW = R2_MRG + 16 * MiB, R2_HIDP = R2_MRG + 32 * MiB  , R2_END = R2_HIDP + 16 * MiB;
static_assert(R2_END <= 136 * MiB, "attention scratch");
constexpr size_t WS_END = 432 * MiB;
constexpr int KC_ROWS = S + 32;
constexpr int CW_TMO = 0, CW_BAR = 4096, CW_MOECNT = 16384, CW_NSAQ = 17408, CW_SPLIT = 18432;
constexpr int RING_BYTES = 131072, LDSCTL_OFF = RING_BYTES, MISC_OFF = LDSCTL_OFF + 320, LDS_BYTES = 147456;


#define LDS_WAIT() asm volatile("s_waitcnt lgkmcnt(0)" ::: "memory")
#define VM_WAIT() asm volatile("s_waitcnt vmcnt(0)" ::: "memory")
DI float wave_sum(float v) { v += sx<1>(v); v += sx<2>(v); v += sx<4>(v); v += sx<8>(v); v += sx<16>(v); return sum32sym(v); }

struct TrSrc { const float* a; const float* b; int ldn; int nsrc; int mode; };
DI f32x4 tr_fetch4(const TrSrc& s, int k, int n) {
    const f32x4 z = {0.f, 0.f, 0.f, 0.f};
    if (s.mode == 0) return n < s.nsrc ? *(const f32x4*)(s.a + (size_t)k * s.ldn + n) : z;
    if (s.mode == 1) { const int oc = win_oldcol(n); return oc >= 0 ? *(const f32x4*)(s.a + (size_t)k * s.ldn + oc) : z; }
    const int tile = n >> 8, w = n & 255; const long d = (w < 128) ? 0l : (long)((const char*)s.b - (const char*)s.a);
    return *(const f32x4*)((const float*)((const char*)s.a + d) + (size_t)k * s.ldn + 128 * tile + (w & 127));
}
DI void tr_load(const TrSrc& s, int kb, int nb, int lane, f32x4 (&v)[8]) {
    const int k0 = 64 * kb, n0 = 32 * nb, r8 = lane >> 3, n4 = (lane & 7) * 4;
#pragma unroll
    for (int i = 0; i < 8; ++i) v[i] = tr_fetch4(s, k0 + r8 + 8 * i, n0 + n4);
}
DI void tr_store(const f32x4 (&v)[8], int K, bf16_t* WT, LAS float* scr, int kb, int nb, int lane) {
    const int k0 = 64 * kb, n0 = 32 * nb, r8 = lane >> 3, n4 = (lane & 7) * 4;
#pragma unroll
    for (int i = 0; i < 8; ++i) { LAS float* d = scr + (r8 + 8 * i) * 33 + n4; d[0] = v[i].x; d[1] = v[i].y; d[2] = v[i].z; d[3] = v[i].w; }
    LDS_WAIT(); asm volatile("" ::: "memory");
    const int c = lane & 7;
#pragma unroll
    for (int j = 0; j < 4; ++j) { const int n = (lane >> 3) + 8 * j; const LAS float* p = scr + (8 * c) * 33 + n;
        u32x4 o; o.x = cvtpk(p[0 * 33], p[1 * 33]); o.y = cvtpk(p[2 * 33], p[3 * 33]); o.z = cvtpk(p[4 * 33], p[5 * 33]); o.w = cvtpk(p[6 * 33], p[7 * 33]);
        *(u32x4*)(WT + (size_t)(n0 + n) * K + k0 + 8 * c) = o; }
    LDS_WAIT(); asm volatile("" ::: "memory");
}
DI void tr_item(const TrSrc& s, int K, bf16_t* WT, LAS float* scr, int kb, int nb, int lane) { f32x4 v[8]; tr_load(s, kb, nb, lane, v); tr_store(v, K, WT, scr, kb, nb, lane); }
DI void tr_matrix(const TrSrc& s, int K, int ndst, bf16_t* WT, LAS float* scr, int gw, int ngw, int lane, int& off) {
    const int nblk = ndst / 32, nitems = (K / 64) * nblk;
    int st = gw - off; if (st < 0) st += ngw;
    if (st < nitems) { f32x4 v[8], w[8]; tr_load(s, st / nblk, st % nblk, lane, v);
        for (int it = st; it < nitems; it += ngw) { const int nx = it + ngw; if (nx < nitems) tr_load(s, nx / nblk, nx % nblk, lane, w);
            tr_store(v, K, WT, scr, it / nblk, it % nblk, lane);
#pragma unroll
            for (int i = 0; i < 8; ++i) v[i] = w[i]; } }
    off = (off + nitems) % ngw;
}

DI void tr_batch(const float* a, const float* b, size_t sstride, int ldn, int nsrc, int mode, int K, int ndst, bf16_t* WT, size_t dstride, int nexp, LAS float* scr, int gw, int ngw, int lane, int& off) {
    const int nblk = ndst / 32, per = (K / 64) * nblk, nitems = nexp * per;
    int st = gw - off; if (st < 0) st += ngw;
    if (st < nitems) { f32x4 v[8], w[8];
        { const int e = st / per, r = st % per; tr_load(TrSrc{a + (size_t)e * sstride, b ? b + (size_t)e * sstride : nullptr, ldn, nsrc, mode}, r / nblk, r % nblk, lane, v); }
        for (int it = st; it < nitems; it += ngw) { const int nx = it + ngw;
            if (nx < nitems) { const int e = nx / per, r = nx % per; tr_load(TrSrc{a + (size_t)e * sstride, b ? b + (size_t)e * sstride : nullptr, ldn, nsrc, mode}, r / nblk, r % nblk, lane, w); }
            { const int e = it / per, r = it % per; tr_store(v, K, WT + (size_t)e * dstride, scr, r / nblk, r % nblk, lane); }
#pragma unroll
            for (int i = 0; i < 8; ++i) v[i] = w[i]; } }
    off = (off + nitems) % ngw;
}

struct In {
    const float *x, *bias_table, *mix_norm, *w_in, *b_gate, *sb_w_o, *nsa_q_norm, *nsa_k_norm, *nsa_cmp_pos, *nsa_cmp_w1, *nsa_cmp_w2, *nsa_w_o, *mla_q_a_norm, *mla_kv_a_norm,
        *mla_w_uq, *mla_w_ukv, *mla_q_norm, *mla_k_norm, *mla_w_o, *w_out, *ffn_norm, *dense_w_gate, *dense_w_up, *dense_w_down, *moe_router, *moe_w_gate, *moe_w_up, *moe_w_down;
};
struct Args { In in; float* out; unsigned char* ws; int ph_lo, ph_hi; };

DI void rms_row(const float* xrow, const float* gain, bf16_t* orow, int lane, f32x4 (&v)[4]) {
    const f32x4* xr = (const f32x4*)xrow + lane; float s = 0.f;
#pragma unroll
    for (int j = 0; j < 4; ++j) { v[j] = xr[64 * j]; s += (v[j].x * v[j].x + v[j].y * v[j].y) + (v[j].z * v[j].z + v[j].w * v[j].w); }
    const float rstd = 1.f / sqrtf(wave_sum(s) * (1.f / 1024.f) + EPS);
    u32x2* o8 = (u32x2*)orow + lane;
#pragma unroll
    for (int j = 0; j < 4; ++j) { const f32x4 g = ((const f32x4*)gain)[lane + 64 * j]; v[j] = v[j] * rstd * g; u32x2 w; w.x = cvtpk(v[j].x, v[j].y); w.y = cvtpk(v[j].z, v[j].w); o8[64 * j] = w; }
}

DI int t5_bucket(int n) {
    if (n < 16) return n;
    int b = 16;
    b += n >= 21; b += n >= 27; b += n >= 35; b += n >= 46; b += n >= 59; b += n >= 77; b += n >= 99; b += n >= 128; b += n >= 166; b += n >= 216; b += n >= 280; b += n >= 363; b += n >= 470; b += n >= 609; b += n >= 790;
    return b;
}

struct MoeTab { int cnt[8]; int tb[9]; };
struct MoeGU {
    const volatile LAS int* tab; const bf16_t* Hb; const bf16_t* W; const int* rowtok; int t_lo, t_hi, G, c;
    DI bool next(int i, pg8::Unit& u) const {
        const int nrt = t_hi - t_lo; if (nrt <= 0) return false;
        const long L = (long)i * G + c; if (L >= (long)nrt * 28) return false;
        const int rt = t_lo + (int)(L % nrt), pn = (int)(L / nrt);
        int e = 0;
#pragma unroll
        for (int k = 1; k < 8; ++k) e += (tab[8 + k] <= rt) ? 1 : 0;
        const int j = rt - tab[8 + e], cnt = tab[e];
        u.a = Hb; u.b = W + ((size_t)e * 7168 + 256 * pn) * 1024; u.rows = rowtok + e * S + 256 * j; u.nvalid = (cnt - 256 * j) < 256 ? (cnt - 256 * j) : 256; u.pm = rt - t_lo; u.pn = pn; return true;
    }
};
struct MoeDN {
    const volatile LAS int* tab; const bf16_t* ACT; const bf16_t* W; int t_lo, t_hi, G, c;
    DI bool next(int i, pg8::Unit& u) const {
        const int nrt = t_hi - t_lo; if (nrt <= 0) return false;
        const long L = (long)i * G + c; if (L >= (long)nrt * 4) return false;
        const int rt = t_lo + (int)(L % nrt), pn = (int)(L / nrt);
        int e = 0;
#pragma unroll
        for (int k = 1; k < 8; ++k) e += (tab[8 + k] <= rt) ? 1 : 0;
        u.a = ACT + (size_t)(rt - t_lo) * 256 * EFF; u.b = W + ((size_t)e * 1024 + 256 * pn) * EFF; u.rows = nullptr; u.nvalid = 256; u.pm = rt; u.pn = pn; return true;
    }
};
constexpr int PH_PER_LAYER = 16, NPHASES = 1 + 2 * PH_PER_LAYER;
__global__ void __launch_bounds__(NWAVES * 64, 2) fwd_kernel(Args args) {
    extern __shared__ __attribute__((aligned(16))) unsigned char lds_raw[];
    LAS unsigned char* lds = (LAS unsigned char*)lds_raw;
    volatile LAS unsigned* MISC = (volatile LAS unsigned*)(lds + MISC_OFF);
    volatile LAS int* MTAB = (volatile LAS int*)(lds + MISC_OFF + 64);
    const int tid0 = threadIdx.x, wave = __builtin_amdgcn_readfirstlane(tid0 >> 6);
    const int G = gridDim.x, bid = blockIdx.x, vcu = (G % 8 == 0) ? (bid % 8) * (G / 8) + bid / 8 : bid;
    const int gw0 = vcu * NWAVES + wave, NGW = G * NWAVES;
    unsigned char* ws = args.ws; const In in = args.in;
    gu32* ctl = (gu32*)(ws + WS_CTL);
    for (int u = tid0; u < (LDS_BYTES - LDSCTL_OFF) / 4; u += NWAVES * 64) ((LAS unsigned*)(lds + LDSCTL_OFF))[u] = 0u;
    __syncthreads();
#if MK_MULTI
#define GRID_BAR() do { } while (0)
#else
    XcdBarrier bar = xcd_barrier_post((unsigned*)(ctl + CW_BAR), MISC + 8);
#define TPCTR ((unsigned long long*)(ctl + 20480))
#define GRID_BAR() do { TP_BEGIN(9) xcd_barrier(bar); TP_END(9, TPCTR); } while (0)
#endif
    const int lo = args.ph_lo, hi = args.ph_hi;
#ifndef ONLY_PHASE
#define ONLY_PHASE -1
#endif
#ifndef PHMASK
#define PHMASK 0x1ffff
#endif
#define PHON(n) ((ONLY_PHASE < 0 || ONLY_PHASE == (n)) && ((PHMASK >> ((n) == 99 ? 16 : (n))) & 1))
#ifndef REPMASK
#define REPMASK 0
#endif
#ifndef GREP
#define GREP 0
#endif
#define REPN(n) (((REPMASK >> ((n) == 99 ? 16 : (n))) & 1) ? 2 : 1)
#define IN(k) (lo <= (k) && (k) < hi)
#define SEAM(k) do { if (IN((k) + 1)) { unsigned long long tq0_ = 0; const bool tpk_ = (TPROBE >= 100) && (TPROBE - 100 == ((k) == 0 ? 16 : ((k) - 1) % 16)); if (tpk_) tq0_ = tp_now(); GRID_BAR(); if (tpk_ && lane_id() == 0) atomicAdd(TPCTR, tp_now() - tq0_); } } while (0)
#define PHASE_LOCALS int tid = wave * 64 + lane_id(); asm volatile("" : "+v"(tid)); const int lane = tid & 63; int gw = gw0; asm volatile("" : "+s"(gw)); unsigned char* wsl = ws; asm volatile("" : "+s"(wsl)); (void)lane; (void)gw; (void)wsl;

#define lw (wsl + WS_LW + (size_t)l * LW_STRIDE)
#define Hb ((bf16_t*)(wsl + WS_H))
#define PROJ ((bf16_t*)(wsl + WS_R1))
#define R2P(off) (wsl + WS_R2 + (off))
#define KC ((bf16_t*)R2P(R2_KC))
#define VC ((bf16_t*)R2P(R2_VC))
#define KS ((bf16_t*)R2P(R2_KS))
#define VTS ((bf16_t*)R2P(R2_VTS))
#define KW ((bf16_t*)R2P(R2_KW))
#define GN ((float*)R2P(R2_GN))
#define QM ((bf16_t*)R2P(R2_QM))
#define KM ((bf16_t*)R2P(R2_KM))
#define HID ((bf16_t*)R2P(R2_HID))
#define KCMP ((bf16_t*)R2P(R2_KCMP))
#define VCMP ((bf16_t*)R2P(R2_VCMP))
#define ATT ((bf16_t*)R2P(R2_ATT))
#define MRG ((bf16_t*)R2P(R2_MRG))
#define QRAW ((bf16_t*)R2P(R2_QRAW))
#define KVRAW ((bf16_t*)R2P(R2_KVRAW))
#define HIDP ((float*)R2P(R2_HIDP))
#define ROPE ((float*)(wsl + WS_ROPE))
#define LUT8 ((float*)(wsl + WS_LUT8))
#define B1P ((float*)(wsl + WS_B1P))
#define B1 ((float*)(wsl + WS_B1))
#define CONS (B1 + 2048)
#define ROUTE ((int*)(wsl + WS_ROUTE))
#define ROWTOK ((int*)(wsl + WS_ROWTOK))
    LAS float* scr = (LAS float*)(lds + wave * 16384);

    if (PHON(99) && IN(0)) { PHASE_LOCALS TP_BEGIN(36) for (int rep_ = 0; rep_ < REPN(99); ++rep_) {
        int troff = 0;
        for (int l = 0; l < 2; ++l) {
            tr_matrix(TrSrc{in.w_in + (size_t)l * 1024 * INC, nullptr, INC, INC, 1}, 1024, NPROJ, (bf16_t*)(lw + LW_WIN), scr, gw, NGW, lane, troff);
            tr_matrix(TrSrc{in.sb_w_o + (size_t)l * 256 * 1024, nullptr, 1024, 1024, 0}, 256, 1024, (bf16_t*)(lw + LW_SBO), scr, gw, NGW, lane, troff);
            tr_matrix(TrSrc{in.nsa_w_o + (size_t)l * 512 * 1024, nullptr, 1024, 1024, 0}, 512, 1024, (bf16_t*)(lw + LW_NSAO), scr, gw, NGW, lane, troff);
            tr_matrix(TrSrc{in.mla_w_o + (size_t)l * 256 * 1024, nullptr, 1024, 1024, 0}, 256, 1024, (bf16_t*)(lw + LW_MLAO), scr, gw, NGW, lane, troff);
            tr_matrix(TrSrc{in.w_out + (size_t)l * 1024 * 1024, nullptr, 1024, 1024, 0}, 1024, 1024, (bf16_t*)(lw + LW_WOUT), scr, gw, NGW, lane, troff);
            tr_matrix(TrSrc{in.mla_w_uq + (size_t)l * 256 * 384, nullptr, 384, 384, 0}, 256, 512, (bf16_t*)(lw + LW_WUQ), scr, gw, NGW, lane, troff);
            tr_matrix(TrSrc{in.mla_w_ukv + (size_t)l * 128 * 512, nullptr, 512, 512, 0}, 128, 512, (bf16_t*)(lw + LW_WUKV), scr, gw, NGW, lane, troff);
            for (int kv = 0; kv < 2; ++kv)
                tr_matrix(TrSrc{in.nsa_cmp_w1 + (size_t)(l * 2 + kv) * 2048 * 256, nullptr, 256, 256, 0}, 2048, 256, (bf16_t*)(lw + LW_CW1) + (size_t)kv * 256 * 2048, scr, gw, NGW, lane, troff);
        }
        tr_matrix(TrSrc{in.dense_w_gate, in.dense_w_up, DFF, DFF, 2}, 1024, 2 * DFF, (bf16_t*)(wsl + WS_DGU), scr, gw, NGW, lane, troff);
        tr_matrix(TrSrc{in.dense_w_down, nullptr, 1024, 1024, 0}, DFF, 1024, (bf16_t*)(wsl + WS_DDN), scr, gw, NGW, lane, troff);
        const int gt = vcu * 512 + tid, NT = G * 512;
        for (int i = gt; i < S * 16; i += NT) {
            const int pos = i >> 4, fi = i & 15; const float inv = powf(10000.f, -(float)fi / 16.f); const float ang = (float)pos * inv;
            const double rev = (double)ang * 0.15915494309189535; const float fr = (float)(rev - rint(rev));
            ROPE[i] = __builtin_amdgcn_cosf(fr); ROPE[S * 16 + i] = __builtin_amdgcn_sinf(fr); }
        for (int i = gt; i < 1024 * 8; i += NT) LUT8[i] = in.bias_table[t5_bucket(i >> 3) * 8 + (i & 7)] * LOG2E;
        if (gw == 0) {
            float bm = 0.f; for (int i = lane; i < 256; i += 64) bm = fmaxf(bm, fabsf(in.bias_table[i]));
            bm = fmaxf(bm, sx<1>(bm)); bm = fmaxf(bm, sx<2>(bm)); bm = fmaxf(bm, sx<4>(bm)); bm = fmaxf(bm, sx<8>(bm)); bm = fmaxf(bm, sx<16>(bm)); bm = fmaxf(bm, sx32(bm, lane >> 5));
            if (lane == 0) CONS[0] = bm * LOG2E;
            for (int ll = 0; ll < 2; ++ll) { float gm = 0.f; for (int i = lane; i < 192; i += 64) gm = fmaxf(gm, fabsf(in.nsa_k_norm[ll * 192 + i]));
                gm = fmaxf(gm, sx<1>(gm)); gm = fmaxf(gm, sx<2>(gm)); gm = fmaxf(gm, sx<4>(gm)); gm = fmaxf(gm, sx<8>(gm)); gm = fmaxf(gm, sx<16>(gm)); gm = fmaxf(gm, sx32(gm, lane >> 5));
                if (lane == 0) CONS[1 + ll] = gm;
                float km = 0.f; for (int i = lane; i < 96; i += 64) km = fmaxf(km, fabsf(in.mla_k_norm[ll * 96 + i]));
                km = fmaxf(km, sx<1>(km)); km = fmaxf(km, sx<2>(km)); km = fmaxf(km, sx<4>(km)); km = fmaxf(km, sx<8>(km)); km = fmaxf(km, sx<16>(km)); km = fmaxf(km, sx32(km, lane >> 5));
                if (lane == 0) CONS[3 + ll] = km; }
        }
        for (int it = gw; it < 512; it += NGW) {
            const int kc = it & 31, cb = (it >> 5) & 3, lk = it >> 7; const float* pos = in.nsa_cmp_pos + (size_t)lk * 2048; const float* w1 = in.nsa_cmp_w1 + (size_t)lk * 2048 * 256;
            float wv_[64];
#pragma unroll
            for (int k = 0; k < 64; ++k) wv_[k] = w1[(size_t)(64 * kc + k) * 256 + 64 * cb + lane];
            float a = 0.f;
#pragma unroll
            for (int k = 0; k < 64; ++k) a += pos[64 * kc + k] * wv_[k];
            B1P[(lk * 32 + kc) * 256 + 64 * cb + lane] = a; }
        for (int i = gt; i < 2 * 2 * 32 * 64 / 8; i += NT) { const int z = i / 256, r = i % 256; bf16_t* p = (z >> 1 ? VC : KC) + ((size_t)(z & 1) * KC_ROWS + S) * 64 + r * 8; *(u32x4*)p = (u32x4){0u, 0u, 0u, 0u}; }
        for (int m = gw; m < S; m += NGW) { f32x4 v[4]; rms_row(in.x + (size_t)m * 1024, in.mix_norm, Hb + (size_t)m * 1024, lane, v); }
            }
            TP_END(36, TPCTR);
        SEAM(0);
    }

    for (int l = 0; l < 2; ++l) {
        const int pb = 1 + PH_PER_LAYER * l;
        const float* x_in = (l == 0) ? in.x : args.out; float* x_out = args.out;
        if (l > 0 && PHON(0) && IN(pb + 0)) { PHASE_LOCALS TP_BEGIN(20) for (int rep_ = 0; rep_ < REPN(0); ++rep_) {
            for (int m = gw; m < S; m += NGW) { f32x4 v[4]; rms_row(x_in + (size_t)m * 1024, in.mix_norm + l * 1024, Hb + (size_t)m * 1024, lane, v); }
            }
            TP_END(20, TPCTR);
            SEAM(pb + 0);
        }
        if (PHON(1) && IN(pb + 1)) { PHASE_LOCALS TP_BEGIN(21) for (int rep_ = 0; rep_ < REPN(1); ++rep_) {
            pg8::StaticOrder So; So.init(Hb, (const bf16_t*)(lw + LW_WIN), 1024, 1024, S, NPROJ - 512, G, bid);
            pg8::EpiStore E{PROJ, NPROJ, nullptr, QK_SCALE64, 0};
            pg8::gemm_phase<pg8::EpiStore, pg8::StaticOrder, true, false>(lds, 1024, 1024, 1024, So, E, wave);
#if GREP & 1
            pg8::gemm_phase<pg8::EpiStore, pg8::StaticOrder, true, false>(lds, 1024, 1024, 1024, So, E, wave);
#endif
            }
            TP_END(21, TPCTR);
            SEAM(pb + 1);
        }
        if (PHON(2) && IN(pb + 2)) { PHASE_LOCALS TP_BEGIN(22) for (int rep_ = 0; rep_ < REPN(2); ++rep_) {
            if (l == 0 && bid < 2) { const int i = bid * 512 + tid; float pv_[32];
#pragma unroll
                for (int kc = 0; kc < 32; ++kc) pv_[kc] = B1P[((i >> 8) * 32 + kc) * 256 + (i & 255)];
                float a = 0.f;
#pragma unroll
                for (int kc = 0; kc < 32; ++kc) a += pv_[kc];
                B1[i] = a; }
            for (int t = gw; t < S; t += NGW) {
                bf16_t* pr = PROJ + (size_t)t * NPROJ;
                {
                    const u32x4 w = *(const u32x4*)(pr + PC_NQ + lane * 8); float v[8] = {bflo(w.x), bfhi(w.x), bflo(w.y), bfhi(w.y), bflo(w.z), bfhi(w.z), bflo(w.w), bfhi(w.w)};
                    float ss = 0.f;
#pragma unroll
                    for (int e = 0; e < 8; ++e) ss += v[e] * v[e];
                    ss += sx<1>(ss); ss += sx<2>(ss); ss += sx<4>(ss);
                    const float rs = QK_SCALE64 / sqrtf(ss * (1.f / 64.f) + EPS); const float* gq = in.nsa_q_norm + l * 64 + 8 * (lane & 7);
                    u32x4 o; o.x = cvtpk(v[0] * rs * gq[0], v[1] * rs * gq[1]); o.y = cvtpk(v[2] * rs * gq[2], v[3] * rs * gq[3]); o.z = cvtpk(v[4] * rs * gq[4], v[5] * rs * gq[5]); o.w = cvtpk(v[6] * rs * gq[6], v[7] * rs * gq[7]);
                    *(u32x4*)(pr + PC_NQ + lane * 8) = o;
                }
                {
                    const int sec = lane >> 4, gg = (lane >> 3) & 1, d8 = 8 * (lane & 7);
                    const int col = (sec == 0 ? PC_NKS : sec == 1 ? PC_NKW : sec == 2 ? PC_NKC : PC_NVC) + (lane & 15) * 8;
                    const u32x4 w = *(const u32x4*)(pr + col); float v[8] = {bflo(w.x), bfhi(w.x), bflo(w.y), bfhi(w.y), bflo(w.z), bfhi(w.z), bflo(w.w), bfhi(w.w)};
                    float ss = 0.f;
#pragma unroll
                    for (int e = 0; e < 8; ++e) ss += v[e] * v[e];
                    ss += sx<1>(ss); ss += sx<2>(ss); ss += sx<4>(ss);
                    const float rs = 1.f / sqrtf(ss * (1.f / 64.f) + EPS);
                    u32x4 o = w;
                    if (sec < 2) { const float* gk = in.nsa_k_norm + (l * 3 + 1 + sec) * 64 + d8;
                        o.x = cvtpk(v[0] * rs * gk[0], v[1] * rs * gk[1]); o.y = cvtpk(v[2] * rs * gk[2], v[3] * rs * gk[3]); o.z = cvtpk(v[4] * rs * gk[4], v[5] * rs * gk[5]); o.w = cvtpk(v[6] * rs * gk[6], v[7] * rs * gk[7]); }
                    const int c8 = lane & 7; const size_t ksf = ((((size_t)(gg * 256 + (t >> 6)) * 2 + ((t >> 5) & 1)) * 4 + (c8 >> 1)) * 64 + (c8 & 1) * 32 + (t & 31)) * 8;
                    bf16_t* dst = (sec == 0 ? KS + ksf : (sec == 1 ? KW + ((size_t)gg * S + t) * 64 : sec == 2 ? KC + ((size_t)gg * KC_ROWS + t) * 64 : VC + ((size_t)gg * KC_ROWS + t) * 64) + d8);
                    *(u32x4*)dst = o;
                }
                {
                    const u32x2 w = *(const u32x2*)(pr + PC_CQ + lane * 4); float v[4] = {bflo(w.x), bfhi(w.x), bflo(w.y), bfhi(w.y)};
                    const float rs = 1.f / sqrtf(wave_sum((v[0] * v[0] + v[1] * v[1]) + (v[2] * v[2] + v[3] * v[3])) * (1.f / 256.f) + EPS); const float* ga = in.mla_q_a_norm + l * 256 + lane * 4;
                    u32x2 o; o.x = cvtpk(v[0] * rs * ga[0], v[1] * rs * ga[1]); o.y = cvtpk(v[2] * rs * ga[2], v[3] * rs * ga[3]); *(u32x2*)(pr + PC_CQ + lane * 4) = o;
                    const unsigned w2 = *(const unsigned*)(pr + PC_CKV + lane * 2); const float a = bflo(w2), b = bfhi(w2);
                    const float rs2 = 1.f / sqrtf(wave_sum(a * a + b * b) * (1.f / 128.f) + EPS); const float* gb = in.mla_kv_a_norm + l * 128 + lane * 2;
                    *(unsigned*)(pr + PC_CKV + lane * 2) = cvtpk(a * rs2 * gb[0], b * rs2 * gb[1]);
                }
                if (lane < 24) GN[(size_t)t * 24 + lane] = sigmoidf_(bf2f(pr[PC_NG + lane]));
            }
            for (int it = gw; it < 4096; it += NGW) {
                const int gg = it >> 11, blk = (it >> 3) & 255, s8 = it & 7; const bf16_t* src = PROJ + (size_t)(blk * 64) * NPROJ + PC_NVS + gg * 64 + lane; bf16_t* dstb = VTS + (size_t)(gg * 256 + blk) * 4096;
                unsigned short e[8];
#pragma unroll
                for (int j = 0; j < 8; ++j) { const int k = att::vts_key_of_slot(8 * s8 + j); e[j] = src[(size_t)k * NPROJ]; }
                u32x4 o; o.x = e[0] | ((unsigned)e[1] << 16); o.y = e[2] | ((unsigned)e[3] << 16); o.z = e[4] | ((unsigned)e[5] << 16); o.w = e[6] | ((unsigned)e[7] << 16);
                const int hh = s8 >> 2, ss = (s8 >> 1) & 1, h = s8 & 1;
                *(u32x4*)(dstb + ((((hh * 2 + (lane >> 5)) * 2 + ss) * 64) + h * 32 + (lane & 31)) * 8) = o;
            }
            }
            TP_END(22, TPCTR);
            SEAM(pb + 2);
        }
        if (PHON(3) && IN(pb + 3)) { PHASE_LOCALS TP_BEGIN(23) for (int rep_ = 0; rep_ < REPN(3); ++rep_) {
            const bool wide = (G >= 256);
            for (int job = 0; job < 3; ++job) {
                pg8::StaticOrder So; pg8::EpiStore E; int lda, ldb, K;
                if (job == 2) { lda = 1024; ldb = 1024; K = 1024; So.init(Hb, (const bf16_t*)(lw + LW_WIN) + (size_t)(NPROJ - 512) * 1024, lda, ldb, S, 512, wide ? 128 : G, wide ? (bid < 64 ? bid : (bid >= 192 && bid < 256 ? bid - 128 : -1)) : bid); E = pg8::EpiStore{PROJ + (NPROJ - 512), NPROJ, nullptr, 1.f, 0}; }
                else if (job == 0) { lda = NPROJ; ldb = 256; K = 256; So.init(PROJ + PC_CQ, (const bf16_t*)(lw + LW_WUQ), lda, ldb, S, 512, wide ? 128 : G, wide ? (bid < 128 ? bid : -1) : bid); E = pg8::EpiStore{QRAW, 512, nullptr, 1.f, 0}; }
                else { lda = NPROJ; ldb = 128; K = 128; So.init(PROJ + PC_CKV, (const bf16_t*)(lw + LW_WUKV), lda, ldb, S, 512, wide ? 128 : G, wide ? (bid >= 128 && bid < 256 ? bid - 128 : -1) : bid); E = pg8::EpiStore{KVRAW, 512, nullptr, 1.f, 0}; }
                pg8::gemm_phase<pg8::EpiStore, pg8::StaticOrder, true, false>(lds, lda, ldb, K, So, E, wave);
#if GREP & 16
                pg8::gemm_phase<pg8::EpiStore, pg8::StaticOrder, true, false>(lds, lda, ldb, K, So, E, wave);
#endif
            }
            for (int jz = 0; jz < 16; ++jz) {
                const int z = jz >> 2, ks = jz & 3, kv = z >> 1, gg = z & 1;
                pg8::StaticOrder So; So.init((kv ? VC : KC) + (size_t)gg * KC_ROWS * 64 + ks * 512, (const bf16_t*)(lw + LW_CW1) + (size_t)kv * 256 * 2048 + ks * 512, 1024, 2048, 1024, 256, wide ? 4 : G, wide ? ((bid >= 128 + 4 * jz && bid < 132 + 4 * jz) ? bid - 128 - 4 * jz : -1) : bid);
                pg8::EpiF32 E{HIDP + (size_t)jz * 1024 * 256, 256};
                pg8::gemm_phase<pg8::EpiF32, pg8::StaticOrder, true, false>(lds, 1024, 2048, 512, So, E, wave);
            }
            }
            TP_END(23, TPCTR);
            SEAM(pb + 3);
        }
        if (PHON(4) && IN(pb + 4)) { PHASE_LOCALS TP_BEGIN(24) for (int rep_ = 0; rep_ < REPN(4); ++rep_) {
            const int kvb = (2 * vcu >= G) ? 1 : 0;
            { const float* w2g = in.nsa_cmp_w2 + (size_t)(l * 2 + kvb) * 256 * 64; LAS f32x4* w2l = (LAS f32x4*)lds;
#pragma unroll
              for (int i = 0; i < 8; ++i) w2l[tid + 512 * i] = *(const f32x4*)(w2g + (size_t)(tid + 512 * i) * 4); }
            __syncthreads();
            LAS unsigned short* ws16 = (LAS unsigned short*)(lds + 65536 + wave * 4096);
            for (int t = gw; t < S; t += NGW) {
                if (lane < 48) *(LAS u32x4*)(ws16 + 8 * lane) = *(const u32x4*)(QRAW + (size_t)t * 512 + 8 * lane);
                if (lane < 32) *(LAS u32x4*)(ws16 + 384 + (lane >> 3) * 96 + (lane & 7) * 8) = *(const u32x4*)(KVRAW + (size_t)t * 512 + (lane >> 3) * 128 + (lane & 7) * 8);
                else if (lane < 48) { const int hh_ = (lane - 32) >> 2, c_ = lane & 3; *(LAS u32x4*)(ws16 + 384 + hh_ * 96 + 64 + c_ * 8) = *(const u32x4*)(PROJ + (size_t)t * NPROJ + PC_KR + c_ * 8); }
                LDS_WAIT(); asm volatile("" ::: "memory");
                const int hd = lane >> 4, i = lane & 15; const float c = ROPE[t * 16 + i], s = ROPE[S * 16 + t * 16 + i];
                {   LAS unsigned short* src = ws16 + hd * 96 + i; float v[6]; float ss = 0.f;
#pragma unroll
                    for (int e = 0; e < 6; ++e) { v[e] = bf2f(src[16 * e]); ss += v[e] * v[e]; }
                    ss += sx<1>(ss); ss += sx<2>(ss); ss += sx<4>(ss); ss += sx<8>(ss);
                    const float rs = 1.f / sqrtf(ss * (1.f / 96.f) + EPS); const float* gq = in.mla_q_norm + l * 96 + i;
#pragma unroll
                    for (int e = 0; e < 6; ++e) v[e] = v[e] * rs * gq[16 * e];
                    const float x1 = v[4], x2 = v[5]; v[4] = x1 * c - x2 * s; v[5] = x2 * c + x1 * s;
#pragma unroll
                    for (int e = 0; e < 6; ++e) src[16 * e] = f2bf(v[e] * QK_SCALE96); }
                {   LAS unsigned short* src = ws16 + 384 + hd * 96 + i; float v[6]; float ss = 0.f;
#pragma unroll
                    for (int e = 0; e < 6; ++e) { v[e] = bf2f(src[16 * e]); ss += v[e] * v[e]; }
                    ss += sx<1>(ss); ss += sx<2>(ss); ss += sx<4>(ss); ss += sx<8>(ss);
                    const float rs = 1.f / sqrtf(ss * (1.f / 96.f) + EPS); const float* gk = in.mla_k_norm + l * 96 + i;
#pragma unroll
                    for (int e = 0; e < 6; ++e) v[e] = v[e] * rs * gk[16 * e];
                    const float x1 = v[4], x2 = v[5]; v[4] = x1 * c - x2 * s; v[5] = x2 * c + x1 * s;
#pragma unroll
                    for (int e = 0; e < 6; ++e) src[16 * e] = f2bf(v[e]); }
                LDS_WAIT(); asm volatile("" ::: "memory");
                if (lane < 48) { *(u32x4*)(QM + (size_t)t * 384 + 8 * lane) = *(const LAS u32x4*)(ws16 + 8 * lane); *(u32x4*)(KM + (size_t)t * 384 + 8 * lane) = *(const LAS u32x4*)(ws16 + 384 + 8 * lane); }
                LDS_WAIT(); asm volatile("" ::: "memory");
            }
            {
                LAS float* hs = (LAS float*)(lds + 65536 + wave * 4096); const LAS float* w2l = (const LAS float*)lds;
                const int hw = (kvb ? vcu - G / 2 : vcu) * NWAVES + wave, nhw = (kvb ? G - G / 2 : G / 2) * NWAVES;
                for (int it = hw; it < 2048; it += nhw) {
                    const int gg = it >> 10, n = it & 1023, z = kvb * 2 + gg;
                    { f32x4 hsum = *(const f32x4*)(B1 + (l * 2 + kvb) * 256 + lane * 4);
#pragma unroll
                      for (int ks = 0; ks < 4; ++ks) hsum += *(const f32x4*)(HIDP + ((size_t)(z * 4 + ks) * 1024 + n) * 256 + lane * 4);
                      *(LAS f32x4*)(hs + lane * 4) = (f32x4){siluf_(hsum.x), siluf_(hsum.y), siluf_(hsum.z), siluf_(hsum.w)}; }
                    LDS_WAIT(); asm volatile("" ::: "memory");
                    float a0 = 0.f, a1 = 0.f, a2 = 0.f, a3 = 0.f;
#pragma unroll 4
                    for (int j = 0; j < 256; j += 4) { const f32x4 h4 = *(const LAS f32x4*)(hs + j);
                        a0 += h4.x * w2l[j * 64 + lane]; a1 += h4.y * w2l[(j + 1) * 64 + lane]; a2 += h4.z * w2l[(j + 2) * 64 + lane]; a3 += h4.w * w2l[(j + 3) * 64 + lane]; }
                    const float a = (a0 + a1) + (a2 + a3);
                    if (kvb == 0) { const float rs = 1.f / sqrtf(wave_sum(a * a) * (1.f / 64.f) + EPS); KCMP[((size_t)gg * 1024 + n) * 64 + lane] = f2bf(a * rs * in.nsa_k_norm[(l * 3) * 64 + lane]); }
                    else VCMP[((size_t)gg * 1024 + n) * 64 + lane] = f2bf(a);
                    LDS_WAIT(); asm volatile("" ::: "memory");
                }
            }
            __syncthreads();
            }
            TP_END(24, TPCTR);
            SEAM(pb + 4);
        }
        if (PHON(5) && IN(pb + 5)) { PHASE_LOCALS TP_BEGIN(25) for (int rep_ = 0; rep_ < REPN(5); ++rep_) {
            __syncthreads();
            for (int r2_ = 0; r2_ < REPN(17); ++r2_) for (int u = vcu; u < 256; u += G) att::sb_unit((LAS char*)lds, PROJ, ATT, u >> 6, u & 63, wave);
            for (int r2_ = 0; r2_ < REPN(18); ++r2_) for (int p = vcu; p < 256; p += G) { const float mkb = 9.9f * CONS[3 + l]; att::mla_unit((LAS char*)lds, QM, KM, KVRAW, ATT, p >> 6, 127 - (p & 63), mkb, wave, TPCTR); att::mla_unit((LAS char*)lds, QM, KM, KVRAW, ATT, p >> 6, p & 63, mkb, wave, TPCTR); }
            att::NsaT T{PROJ, KCMP, VCMP, KS, VTS, KW, GN, LUT8, ATT, 8.08f * CONS[1 + l], CONS[0], (unsigned long long*)(ctl + 20480)};
            for (int r2_ = 0; r2_ < REPN(19); ++r2_) { volatile LAS int* qslot = (volatile LAS int*)(lds + MISC_OFF + 192); const int qg = (2 * vcu >= G) ? 1 : 0;
                __syncthreads(); att::nsa_load_lut((LAS char*)lds, LUT8, qg, tid);
                for (;;) { __syncthreads(); if (tid == 0) *qslot = (int)__hip_atomic_fetch_add(ctl + CW_NSAQ + 64 * (4 * l + 2 * r2_ + qg), 1u, RLX_AGENT); __syncthreads();
                    const int u = *qslot; if (u >= 256) break; att::nsa_unit((LAS char*)lds, T, qg, 255 - u, wave); } }
            }
            TP_END(25, TPCTR);
            SEAM(pb + 5);
        }
        if (PHON(6) && IN(pb + 6)) { PHASE_LOCALS TP_BEGIN(26) for (int rep_ = 0; rep_ < REPN(6); ++rep_) {
            for (int mix = 0; mix < 3; ++mix) {
                const int K = (mix == 1) ? 512 : 256; const int acol = (mix == 0) ? 0 : (mix == 1) ? 256 : 768;
                const bf16_t* Bt = (const bf16_t*)(lw + (mix == 0 ? LW_SBO : mix == 1 ? LW_NSAO : LW_MLAO));
                pg8::StaticOrder So; So.init(ATT + acol, Bt, 1024, K, S, 1024, G, bid);
                pg8::EpiGate E{MRG, PROJ + PC_GATE + mix * 1024, NPROJ, in.b_gate + l * 3072 + mix * 1024, mix == 0 ? 1 : 0};
                pg8::gemm_phase<pg8::EpiGate, pg8::StaticOrder, true, false>(lds, 1024, K, K, So, E, wave);
            }
            }
            TP_END(26, TPCTR);
            SEAM(pb + 6);
        }
        if (PHON(7) && IN(pb + 7)) { PHASE_LOCALS TP_BEGIN(27) for (int rep_ = 0; rep_ < REPN(7); ++rep_) {
            pg8::StaticOrder So; So.init(MRG, (const bf16_t*)(lw + LW_WOUT), 1024, 1024, S, 1024, G, bid);
            pg8::EpiResid E{x_in, x_out};
            pg8::gemm_phase<pg8::EpiResid, pg8::StaticOrder, true, false>(lds, 1024, 1024, 1024, So, E, wave);
            }
            TP_END(27, TPCTR);
            SEAM(pb + 7);
        }
        if (PHON(8) && IN(pb + 8)) { PHASE_LOCALS TP_BEGIN(28) for (int rep_ = 0; rep_ < REPN(8); ++rep_) {
            if (l == 1) {
                int troff = 0;
                tr_batch(in.moe_w_gate, in.moe_w_up, (size_t)1024 * EFF, EFF, EFF, 2, 1024, 2 * EFF, (bf16_t*)(wsl + WS_MGU), (size_t)7168 * 1024, 8, scr, gw, NGW, lane, troff);
                tr_batch(in.moe_w_down, nullptr, (size_t)EFF * 1024, 1024, 1024, 0, EFF, 1024, (bf16_t*)(wsl + WS_MDN), (size_t)1024 * EFF, 8, scr, gw, NGW, lane, troff);
            }
            for (int m = gw; m < S; m += NGW) {
                f32x4 v[4]; rms_row(x_out + (size_t)m * 1024, in.ffn_norm + l * 1024, Hb + (size_t)m * 1024, lane, v);
                if (l == 1) {
                    float lg[8];
#pragma unroll
                    for (int e = 0; e < 8; ++e) lg[e] = 0.f;
#pragma unroll
                    for (int j = 0; j < 4; ++j)
#pragma unroll
                        for (int q = 0; q < 4; ++q) { const float* wr = in.moe_router + (size_t)(4 * lane + 256 * j + q) * 8; const f32x4 wa = *(const f32x4*)wr, wb = *(const f32x4*)(wr + 4); const float hv = v[j][q];
                            lg[0] += hv * wa.x; lg[1] += hv * wa.y; lg[2] += hv * wa.z; lg[3] += hv * wa.w; lg[4] += hv * wb.x; lg[5] += hv * wb.y; lg[6] += hv * wb.z; lg[7] += hv * wb.w; }
#pragma unroll
                    for (int e = 0; e < 8; ++e) lg[e] = wave_sum(lg[e]);
                    int e0 = 0; float v0 = lg[0];
#pragma unroll
                    for (int e = 1; e < 8; ++e) if (lg[e] > v0) { v0 = lg[e]; e0 = e; }
                    int e1 = -1; float v1 = -INFINITY;
#pragma unroll
                    for (int e = 0; e < 8; ++e) if (e != e0 && lg[e] > v1) { v1 = lg[e]; e1 = e; }
                    if (lane == 0) { const float w0 = 1.f / (1.f + __expf(v1 - v0)), w1 = 1.f - w0;
                        const int p0 = (int)__hip_atomic_fetch_add(ctl + CW_MOECNT + 64 * e0, 1u, RLX_AGENT), p1 = (int)__hip_atomic_fetch_add(ctl + CW_MOECNT + 64 * e1, 1u, RLX_AGENT);
                        ROWTOK[e0 * S + p0] = m; ROWTOK[e1 * S + p1] = m;
                        int* r = ROUTE + (size_t)m * 8; r[0] = e0; r[1] = e1; r[2] = p0; r[3] = p1; r[4] = __float_as_int(w0); r[5] = __float_as_int(w1); }
                }
            }
            }
            TP_END(28, TPCTR);
            SEAM(pb + 8);
        }
        if (l == 0) {
#define ACT0 ((bf16_t*)(wsl + WS_R1))
            if (PHON(9) && IN(pb + 9)) { PHASE_LOCALS TP_BEGIN(29) for (int rep_ = 0; rep_ < REPN(9); ++rep_) {
                pg8::StaticOrder So; So.init(Hb, (const bf16_t*)(wsl + WS_DGU), 1024, 1024, S, 2 * DFF, G, bid);
                pg8::EpiSwiglu E{ACT0, DFF};
                pg8::gemm_phase<pg8::EpiSwiglu, pg8::StaticOrder, true, false>(lds, 1024, 1024, 1024, So, E, wave);
#if GREP & 2
                pg8::gemm_phase<pg8::EpiSwiglu, pg8::StaticOrder, true, false>(lds, 1024, 1024, 1024, So, E, wave);
#endif
            }
            TP_END(29, TPCTR);
                SEAM(pb + 9);
            }
            if (PHON(10) && IN(pb + 10)) { PHASE_LOCALS TP_BEGIN(30) for (int rep_ = 0; rep_ < REPN(10); ++rep_) {
                pg8::StaticOrder So; So.init(ACT0, (const bf16_t*)(wsl + WS_DDN), DFF, DFF, S, 1024, G, bid);
                pg8::EpiResid E{x_out, x_out};
                pg8::gemm_phase<pg8::EpiResid, pg8::StaticOrder, true, false>(lds, DFF, DFF, DFF, So, E, wave);
            }
            TP_END(30, TPCTR);
                SEAM(pb + 10);
            }
        } else {
#define ACT1 ((bf16_t*)(wsl + WS_R2))
#define YB ((bf16_t*)(wsl + WS_Y))
            for (int ps = 0; ps < 2; ++ps) {
                if (PHON(11) && IN(pb + 9 + 2 * ps)) { PHASE_LOCALS TP_BEGIN(31) for (int rep_ = 0; rep_ < REPN(11); ++rep_) {
                    if (tid == 0) { int tb = 0; for (int e = 0; e < 8; ++e) { const int c = (int)__hip_atomic_load(ctl + CW_MOECNT + 64 * e, RLX_AGENT); MTAB[e] = c; MTAB[8 + e] = tb; tb += (c + 255) >> 8; } MTAB[16] = tb; }
                    __syncthreads();
                    const int T = MTAB[16], tlo = 64 * ps, thi = (ps == 1) ? T : (T < 64 ? T : 64);
                    MoeGU So{MTAB, Hb, (const bf16_t*)(wsl + WS_MGU), ROWTOK, tlo, thi, G, bid};
                    pg8::EpiSwiglu E{ACT1, EFF};
                    pg8::gemm_phase<pg8::EpiSwiglu, MoeGU, true, true>(lds, 1024, 1024, 1024, So, E, wave);
#if GREP & 4
                    pg8::gemm_phase<pg8::EpiSwiglu, MoeGU, true, true>(lds, 1024, 1024, 1024, So, E, wave);
#endif
            }
            TP_END(31, TPCTR);
                    SEAM(pb + 9 + 2 * ps);
                }
                if (PHON(12) && IN(pb + 10 + 2 * ps)) { PHASE_LOCALS TP_BEGIN(32) for (int rep_ = 0; rep_ < REPN(12); ++rep_) {
                    if (tid == 0) { int tb = 0; for (int e = 0; e < 8; ++e) { const int c = (int)__hip_atomic_load(ctl + CW_MOECNT + 64 * e, RLX_AGENT); MTAB[e] = c; MTAB[8 + e] = tb; tb += (c + 255) >> 8; } MTAB[16] = tb; }
                    __syncthreads();
                    const int T = MTAB[16], tlo = 64 * ps, thi = (ps == 1) ? T : (T < 64 ? T : 64);
                    MoeDN So{MTAB, ACT1, (const bf16_t*)(wsl + WS_MDN), tlo, thi, G, bid};
                    pg8::EpiStore E{YB, 1024, nullptr, 1.f, 0};
                    pg8::gemm_phase<pg8::EpiStore, MoeDN, true, false>(lds, EFF, EFF, EFF, So, E, wave);
#if GREP & 8
                    pg8::gemm_phase<pg8::EpiStore, MoeDN, true, false>(lds, EFF, EFF, EFF, So, E, wave);
#endif
            }
            TP_END(32, TPCTR);
                    SEAM(pb + 10 + 2 * ps);
                }
            }
            if (PHON(15) && IN(pb + 15)) { PHASE_LOCALS TP_BEGIN(35) for (int rep_ = 0; rep_ < REPN(15); ++rep_) {
                if (tid == 0) { int tb = 0; for (int e = 0; e < 8; ++e) { const int c = (int)__hip_atomic_load(ctl + CW_MOECNT + 64 * e, RLX_AGENT); MTAB[e] = c; MTAB[8 + e] = tb; tb += (c + 255) >> 8; } MTAB[16] = tb; }
                __syncthreads();
                for (int m = gw; m < S; m += NGW) {
                    const int* r = ROUTE + (size_t)m * 8; const int e0 = r[0], e1 = r[1]; const float w0 = __int_as_float(r[4]), w1 = __int_as_float(r[5]);
                    const bf16_t* y0 = YB + ((size_t)MTAB[8 + e0] * 256 + r[2]) * 1024; const bf16_t* y1 = YB + ((size_t)MTAB[8 + e1] * 256 + r[3]) * 1024;
                    float* xo = x_out + (size_t)m * 1024;
#pragma unroll
                    for (int j = 0; j < 4; ++j) { const int c = 4 * lane + 256 * j; f32x4 xv = *(const f32x4*)(xo + c); const u32x2 a = *(const u32x2*)(y0 + c), b = *(const u32x2*)(y1 + c);
                        xv.x += w0 * bflo(a.x) + w1 * bflo(b.x); xv.y += w0 * bfhi(a.x) + w1 * bfhi(b.x); xv.z += w0 * bflo(a.y) + w1 * bflo(b.y); xv.w += w0 * bfhi(a.y) + w1 * bfhi(b.y);
                        *(f32x4*)(xo + c) = xv; }
                }
            }
            TP_END(35, TPCTR);
                if (l == 0) SEAM(pb + 15);
            }
        }
    }
#if TPROBE != 0 && !MK_MULTI
    xcd_barrier(bar);
    if (bid == 0 && wave == 0 && lane_id() == 0) { const unsigned long long tot = __hip_atomic_load((unsigned long long*)(ctl + 20480), RLX_AGENT) / (unsigned long long)(G * NWAVES); const unsigned long long t0 = tp_now(); while (tp_now() - t0 < tot) __builtin_amdgcn_s_sleep(8); }
#endif
#undef IN
#undef SEAM
}

extern "C" void kernel_launch(void* const* d_in, const int* in_sizes, int n_in, void* d_out, int out_size, void* d_ws, size_t ws_size, hipStream_t stream) {
    static int grid = 0;
    if (grid == 0) {
        if (n_in != 28 || in_sizes[0] != S * DM || out_size != S * DM || ws_size < WS_END) { fprintf(stderr, "kernel_launch: unexpected problem (n_in %d, in0 %d, out %d, ws %zu < %zu); nothing launched\n", n_in, n_in > 0 ? in_sizes[0] : -1, out_size, ws_size, (size_t)WS_END); grid = -1; return; }
        int dev = 0, cus = 0, per_cu = 0;
        if (hipGetDevice(&dev) != hipSuccess || hipDeviceGetAttribute(&cus, hipDeviceAttributeMultiprocessorCount, dev) != hipSuccess) { grid = -1; return; }
        if (hipFuncSetAttribute((const void*)fwd_kernel, hipFuncAttributeMaxDynamicSharedMemorySize, LDS_BYTES) != hipSuccess) { fprintf(stderr, "kernel_launch: hipFuncSetAttribute failed\n"); grid = -1; return; }
        if (hipOccupancyMaxActiveBlocksPerMultiprocessor(&per_cu, (const void*)fwd_kernel, NWAVES * 64, LDS_BYTES) != hipSuccess || per_cu < 1) { fprintf(stderr, "kernel_launch: occupancy query reports %d blocks per CU\n", per_cu); (void)hipGetLastError(); }
        grid = cus;
    }
    if (grid < 0) return;
    if (hipMemsetAsync((char*)d_ws + WS_CTL, 0, CTL_ZERO_BYTES, stream) != hipSuccess) return;
    Args a{};
    const float** ip = (const float**)&a.in;
    for (int i = 0; i < 28; ++i) ip[i] = (const float*)d_in[i];
    a.out = (float*)d_out; a.ws = (unsigned char*)d_ws;
#if MK_MULTI
    for (int ph = 0; ph < NPHASES; ++ph) {
        if (ph >= 1 + 11 && ph < 1 + PH_PER_LAYER) continue;
        a.ph_lo = ph; a.ph_hi = ph + 1;
        hipLaunchKernelGGL(fwd_kernel, dim3(grid), dim3(NWAVES * 64), LDS_BYTES, stream, a);
    }
#else
    a.ph_lo = 0; a.ph_hi = NPHASES;
    hipLaunchKernelGGL(fwd_kernel, dim3(grid), dim3(NWAVES * 64), LDS_BYTES, stream, a);
#endif
    const hipError_t le = hipPeekAtLastError();
    if (le != hipSuccess) fprintf(stderr, "kernel_launch: launch failed: %s\n", hipGetErrorName(le));
}
```

```cpp
#include <hip/hip_runtime.h>
#include <cstdio>
#include <cstdint>
#include <cmath>

#define LAS __attribute__((address_space(3)))
#define GAS __attribute__((address_space(1)))
typedef unsigned short bf16_t;
typedef short bf16x8 __attribute__((ext_vector_type(8)));
typedef short s16x4 __attribute__((ext_vector_type(4)));
typedef float f32x2 __attribute__((ext_vector_type(2)));
typedef float f32x4 __attribute__((ext_vector_type(4)));
typedef float f32x16 __attribute__((ext_vector_type(16)));
typedef unsigned u32x2 __attribute__((ext_vector_type(2)));
typedef unsigned u32x4 __attribute__((ext_vector_type(4)));
typedef __bf16 bf16x2_t __attribute__((ext_vector_type(2)));
typedef GAS unsigned gu32;
#define RLX_AGENT __ATOMIC_RELAXED, __HIP_MEMORY_SCOPE_AGENT
#define DI __device__ __forceinline__

DI unsigned cvtpk(float lo, float hi) { f32x2 v = {lo, hi}; bf16x2_t b = __builtin_convertvector(v, bf16x2_t); return __builtin_bit_cast(unsigned, b); }
DI float bf2f(bf16_t b) { return __uint_as_float(((unsigned)b) << 16); }
DI float bflo(unsigned w) { return __uint_as_float(w << 16); }
DI float bfhi(unsigned w) { return __uint_as_float(w & 0xffff0000u); }
DI bf16_t f2bf(float f) { return (bf16_t)(cvtpk(f, 0.f) & 0xffffu); }
DI float fast_exp2(float x) { return __builtin_amdgcn_exp2f(x); }
DI float fast_log2(float x) { return __builtin_amdgcn_logf(x); }
DI float fast_rcp(float x) { return __builtin_amdgcn_rcpf(x); }
constexpr float LOG2E = 1.4426950408889634f;
DI float sigmoidf_(float x) { return fast_rcp(1.f + fast_exp2(-x * LOG2E)); }
DI float siluf_(float x) { return x * sigmoidf_(x); }
template <int K> DI unsigned sxu(unsigned v) { return (unsigned)__builtin_amdgcn_ds_swizzle((int)v, (K << 10) | 0x1f); }
template <int K> DI float sx(float v) { return __uint_as_float(sxu<K>(__float_as_uint(v))); }
DI unsigned sx32u(unsigned v, int hi) { auto rr = __builtin_amdgcn_permlane32_swap(v, v, false, false); return hi ? rr[0] : rr[1]; }
DI float sx32(float v, int hi) { return __uint_as_float(sx32u(__float_as_uint(v), hi)); }
DI float sum32sym(float v) { auto rr = __builtin_amdgcn_permlane32_swap(__float_as_uint(v), __float_as_uint(v), false, false); return __uint_as_float(rr[0]) + __uint_as_float(rr[1]); }

#ifndef TPROBE
#define TPROBE 0
#endif
DI int lane_id() { int l_; asm volatile("v_mbcnt_lo_u32_b32 %0, -1, 0\n\tv_mbcnt_hi_u32_b32 %0, -1, %0" : "=v"(l_)); return l_; }
DI unsigned long long tp_now() { return __builtin_amdgcn_s_memrealtime(); }
#define TP_BEGIN(id) unsigned long long tp_t0_ = 0; if (TPROBE == (id)) tp_t0_ = tp_now();
#define TP_END(id, ctr) do { if (TPROBE == (id)) { const unsigned long long d_ = tp_now() - tp_t0_; if (lane_id() == 0) atomicAdd((unsigned long long*)(ctr), d_); } } while (0)

namespace pg8 {
constexpr int BM = 256, BK = 64, HALF = 128, HTB = HALF * BK * 2, STAGE_BYTES = 8 * HTB, NXCD = 8, WGM = 8;
__host__ __device__ __forceinline__ int lds_byte(int r, int c) { const int st = (r >> 4) * 2 + (c >> 5), rr = r & 15, cc = c & 31, ob = rr * 64 + cc * 2; return st * 1024 + (ob ^ (((ob >> 9) & 1) << 5)); }
__host__ __device__ __forceinline__ void stage_rc(int b, int& R, int& C) { const int st = b / 1024, sb = b % 1024, swz = sb ^ (((sb >> 9) & 1) << 5); R = (st >> 1) * 16 + swz / 64; C = (st & 1) * 32 + (swz % 64) / 2; }
__host__ __device__ __forceinline__ int perm32(int rho) { const int n = rho >> 4, i = rho & 15; return 8 * (i >> 2) + 4 * n + (i & 3); }

struct Unit { const bf16_t* a; const bf16_t* b; const int* rows; int nvalid, pm, pn; };

struct StaticOrder {
    const bf16_t* A; const bf16_t* Bt; int lda, ldb, nM, nN, nwg, G, c;
    DI void init(const bf16_t* A_, const bf16_t* Bt_, int lda_, int ldb_, int M, int N, int G_, int c_) { A = A_; Bt = Bt_; lda = lda_; ldb = ldb_; nM = M / BM; nN = N / BM; nwg = nM * nN; G = G_; c = c_; }
    DI bool next(int i, Unit& u) const {
        if (c < 0 || c >= G) return false;
        const long L = (long)i * G + c; if (L >= nwg) return false;
        int wgid = (int)L; { const int q = nwg / NXCD, r = nwg % NXCD, xcd = wgid % NXCD, off = wgid / NXCD; wgid = (xcd < r ? xcd * (q + 1) : r * (q + 1) + (xcd - r) * q) + off; }
        const int nig = WGM * nN, gid = wgid / nig, fm = gid * WGM, gsz = (nM - fm) < WGM ? (nM - fm) : WGM;
        u.pm = fm + ((wgid % nig) % gsz); u.pn = (wgid % nig) / gsz;
        u.a = A + (size_t)u.pm * BM * lda; u.b = Bt + (size_t)u.pn * BM * ldb; u.rows = nullptr; u.nvalid = BM; return true;
    }
};

struct EpiStore {
    static constexpr bool PERM = true;
    bf16_t* O; int ldc; const float* bias; float scale0; int act;
    DI void operator()(const f32x4 (&acc)[2][2][4][2], const Unit& u, int wr, int wc, int fr, int fq) const {
        const int row0 = u.pm * BM + wr * 64 + fr, col0 = u.pn * BM + wc * 32 + 8 * fq;
        const float sc = (u.pn == 0) ? scale0 : 1.f;
        f32x4 bv[2][2];
#pragma unroll
        for (int bj = 0; bj < 2; ++bj)
#pragma unroll
            for (int n = 0; n < 2; ++n) bv[bj][n] = bias ? *(const f32x4*)(bias + col0 + bj * HALF + 4 * n) : (f32x4){0.f, 0.f, 0.f, 0.f};
#pragma unroll
        for (int ai = 0; ai < 2; ++ai)
#pragma unroll
            for (int m = 0; m < 4; ++m) { bf16_t* rowp = O + (size_t)(row0 + ai * HALF + m * 16) * ldc + col0;
#pragma unroll
                for (int bj = 0; bj < 2; ++bj) { f32x4 v0 = (acc[ai][bj][m][0] + bv[bj][0]) * sc, v1 = (acc[ai][bj][m][1] + bv[bj][1]) * sc;
                    if (act) {
#pragma unroll
                        for (int e = 0; e < 4; ++e) { v0[e] = siluf_(v0[e]); v1[e] = siluf_(v1[e]); } }
                    u32x4 w; w.x = cvtpk(v0[0], v0[1]); w.y = cvtpk(v0[2], v0[3]); w.z = cvtpk(v1[0], v1[1]); w.w = cvtpk(v1[2], v1[3]);
                    *(u32x4*)(rowp + bj * HALF) = w; } }
    }
};
struct EpiGate {
    static constexpr bool PERM = true;
    bf16_t* Mg; const bf16_t* glog; int ldg; const float* bg; int first;
    DI void operator()(const f32x4 (&acc)[2][2][4][2], const Unit& u, int wr, int wc, int fr, int fq) const {
        const int row0 = u.pm * BM + wr * 64 + fr, col0 = u.pn * BM + wc * 32 + 8 * fq;
        f32x4 bv[2][2];
#pragma unroll
        for (int bj = 0; bj < 2; ++bj)
#pragma unroll
            for (int n = 0; n < 2; ++n) bv[bj][n] = *(const f32x4*)(bg + col0 + bj * HALF + 4 * n);
#pragma unroll
        for (int ai = 0; ai < 2; ++ai)
#pragma unroll
            for (int m = 0; m < 4; ++m) { const size_t row = (size_t)(row0 + ai * HALF + m * 16);
#pragma unroll
                for (int bj = 0; bj < 2; ++bj) { const int col = col0 + bj * HALF;
                    const u32x4 gl = *(const u32x4*)(glog + row * ldg + col);
                    u32x4 old = (u32x4){0u, 0u, 0u, 0u}; if (!first) old = *(const u32x4*)(Mg + row * 1024 + col);
                    float g[8] = {bflo(gl.x), bfhi(gl.x), bflo(gl.y), bfhi(gl.y), bflo(gl.z), bfhi(gl.z), bflo(gl.w), bfhi(gl.w)};
                    float o[8] = {bflo(old.x), bfhi(old.x), bflo(old.y), bfhi(old.y), bflo(old.z), bfhi(old.z), bflo(old.w), bfhi(old.w)};
#pragma unroll
                    for (int e = 0; e < 4; ++e) { o[e] += sigmoidf_(g[e] + bv[bj][0][e]) * acc[ai][bj][m][0][e]; o[4 + e] += sigmoidf_(g[4 + e] + bv[bj][1][e]) * acc[ai][bj][m][1][e]; }
                    u32x4 w; w.x = cvtpk(o[0], o[1]); w.y = cvtpk(o[2], o[3]); w.z = cvtpk(o[4], o[5]); w.w = cvtpk(o[6], o[7]);
                    *(u32x4*)(Mg + row * 1024 + col) = w; } }
    }
};
struct EpiResid {
    static constexpr bool PERM = false;
    const float* xin; float* out;
    DI void operator()(const f32x4 (&acc)[2][2][4][2], const Unit& u, int wr, int wc, int fr, int fq) const {
        const int row0 = u.pm * BM + wr * 64 + fr, col0 = u.pn * BM + wc * 32 + 4 * fq;
#pragma unroll
        for (int ai = 0; ai < 2; ++ai)
#pragma unroll
            for (int m = 0; m < 4; ++m) { const size_t off = (size_t)(row0 + ai * HALF + m * 16) * 1024 + col0;
#pragma unroll
                for (int bj = 0; bj < 2; ++bj)
#pragma unroll
                    for (int n = 0; n < 2; ++n) { const f32x4 b = *(const f32x4*)(xin + off + bj * HALF + n * 16); *(f32x4*)(out + off + bj * HALF + n * 16) = b + acc[ai][bj][m][n]; }
                if (m & 1) asm volatile("" ::: "memory"); }
    }
};
struct EpiF32 {
    static constexpr bool PERM = false;
    float* O; int ldc;
    DI void operator()(const f32x4 (&acc)[2][2][4][2], const Unit& u, int wr, int wc, int fr_in, int fq_in) const {
        int fr = fr_in, fq = fq_in; asm volatile("" : "+v"(fr), "+v"(fq));
        const int row0 = u.pm * BM + wr * 64 + fr, col0 = u.pn * BM + wc * 32 + 4 * fq;
#pragma unroll
        for (int ai = 0; ai < 2; ++ai)
#pragma unroll
            for (int m = 0; m < 4; ++m) { float* rowp = O + (size_t)(row0 + ai * HALF + m * 16) * ldc + col0;
#pragma unroll
                for (int bj = 0; bj < 2; ++bj)
#pragma unroll
                    for (int n = 0; n < 2; ++n) *(f32x4*)(rowp + bj * HALF + n * 16) = acc[ai][bj][m][n]; }
    }
};
struct EpiSwiglu {
    static constexpr bool PERM = true;
    bf16_t* act; int ldact;
    DI void operator()(const f32x4 (&acc)[2][2][4][2], const Unit& u, int wr, int wc, int fr, int fq) const {
        const int row0 = u.pm * BM + wr * 64 + fr, col0 = u.pn * HALF + wc * 32 + 8 * fq;
#pragma unroll
        for (int ai = 0; ai < 2; ++ai)
#pragma unroll
            for (int m = 0; m < 4; ++m) { bf16_t* rowp = act + (size_t)(row0 + ai * HALF + m * 16) * ldact + col0;
                float o[8];
#pragma unroll
                for (int e = 0; e < 4; ++e) { o[e] = siluf_(acc[ai][0][m][0][e]) * acc[ai][1][m][0][e]; o[4 + e] = siluf_(acc[ai][0][m][1][e]) * acc[ai][1][m][1][e]; }
                u32x4 w; w.x = cvtpk(o[0], o[1]); w.y = cvtpk(o[2], o[3]); w.z = cvtpk(o[4], o[5]); w.w = cvtpk(o[6], o[7]);
                *(u32x4*)rowp = w; }
    }
};

template <class Epi, class Sched, bool ALIGN_EPI, bool GATHER>
__device__ __forceinline__ void gemm_phase(LAS unsigned char* lds, const int lda, const int ldb, const int K, const Sched& S, const Epi& E, const int wave_id) {
    int tid_l = wave_id * 64 + lane_id(); asm volatile("" : "+v"(tid_l));
    const int tid = tid_l, wid = __builtin_amdgcn_readfirstlane(tid >> 6), lane = tid & 63, wr = wid >> 2, wc = wid & 3, fr = lane & 15, fq = lane >> 4;
    const int nt = K / BK;
    unsigned voffB[2], vc0[2], vc1[2], vn0[2], vn1[2];
#pragma unroll
    for (int i = 0; i < 2; ++i) { int R, C; stage_rc(tid * 16 + i * 8192, R, C); const int Rb = Epi::PERM ? ((R & ~31) + perm32(R & 31)) : R;
        voffB[i] = (unsigned)(Rb * ldb + C) * 2u; vc0[i] = (unsigned)(R * lda + C) * 2u; vc1[i] = vc0[i]; vn0[i] = vc0[i]; vn1[i] = vc0[i]; }
    const size_t hsA = GATHER ? (size_t)0 : (size_t)HALF * lda * 2, hsB = (size_t)HALF * ldb * 2;
    const size_t kstep = (size_t)(BK * 2);
    const unsigned ldsw = (unsigned)wid * 1024u;
    const int aoff = lds_byte(wr * 64 + fr, fq * 8), boff = lds_byte(wc * 32 + fr, fq * 8);
#define PG8_SA(b, h) (((b) * 2 + (h)) * HTB)
#define PG8_SB(b, h) ((4 + (b) * 2 + (h)) * HTB)
#define PG8_STAGE(bufoff, gbase, voff) do { _Pragma("unroll") for (int _i = 0; _i < 2; ++_i) \
        __builtin_amdgcn_global_load_lds((const unsigned*)((const char*)(gbase) + (voff)[_i]), (LAS unsigned*)(lds + (bufoff) + ldsw + _i * 8192), 16, 0, 0); } while (0)
#define PG8_LDA(dst, b, h) do { _Pragma("unroll") for (int m = 0; m < 4; ++m) _Pragma("unroll") for (int k = 0; k < 2; ++k) dst[m][k] = *(const LAS bf16x8*)(lds + PG8_SA(b, h) + aoff + m * 2048 + k * 1024); } while (0)
#define PG8_LDB(dst, b, h) do { _Pragma("unroll") for (int n = 0; n < 2; ++n) _Pragma("unroll") for (int k = 0; k < 2; ++k) dst[n][k] = *(const LAS bf16x8*)(lds + PG8_SB(b, h) + boff + n * 2048 + k * 1024); } while (0)
#define PG8_MMA(ai, bj, At, Bt) do { __builtin_amdgcn_s_setprio(1); _Pragma("unroll") for (int m = 0; m < 4; ++m) _Pragma("unroll") for (int n = 0; n < 2; ++n) _Pragma("unroll") for (int k = 0; k < 2; ++k) \
        acc[ai][bj][m][n] = __builtin_amdgcn_mfma_f32_16x16x32_bf16(Bt[n][k], At[m][k], acc[ai][bj][m][n], 0, 0, 0); __builtin_amdgcn_s_setprio(0); } while (0)
#define PG8_WAIT_V(n) asm volatile("s_waitcnt vmcnt(" #n ")" ::: "memory")
#define PG8_WAIT_L(n) asm volatile("s_waitcnt lgkmcnt(" #n ")" ::: "memory")
#define PG8_BAR __builtin_amdgcn_s_barrier()
#define PG8_SCHED __builtin_amdgcn_sched_barrier(0)
#define PG8_GVOFF(U, o0, o1) do { if constexpr (GATHER) { _Pragma("unroll") for (int _i = 0; _i < 2; ++_i) { int R_, C_; stage_rc(tid * 16 + _i * 8192, R_, C_); \
        const int r0_ = R_, r1_ = R_ + HALF; const int t0_ = (U).rows[r0_ < (U).nvalid ? r0_ : 0], t1_ = (U).rows[r1_ < (U).nvalid ? r1_ : 0]; \
        o0[_i] = (unsigned)(t0_ * lda + C_) * 2u; o1[_i] = (unsigned)(t1_ * lda + C_) * 2u; } } } while (0)
    Unit cur, nxt; int ui = 0;
    if (!S.next(0, cur)) return;
    PG8_GVOFF(cur, vc0, vc1);
    f32x4 acc[2][2][4][2];
#pragma unroll
    for (int a = 0; a < 2; ++a)
#pragma unroll
        for (int b = 0; b < 2; ++b)
#pragma unroll
            for (int m = 0; m < 4; ++m)
#pragma unroll
                for (int n = 0; n < 2; ++n) acc[a][b][m][n] = (f32x4){0.f, 0.f, 0.f, 0.f};
    bf16x8 At[4][2], B0[2][2], B1[2][2];
    const char* cA = (const char*)cur.a; const char* cB = (const char*)cur.b;
    PG8_STAGE(PG8_SB(0, 0), cB, voffB); PG8_STAGE(PG8_SB(0, 1), cB + hsB, voffB); PG8_STAGE(PG8_SA(0, 0), cA, vc0); PG8_STAGE(PG8_SA(0, 1), cA + hsA, vc1);
    if (wr == 1) PG8_BAR;
    PG8_WAIT_V(2); PG8_BAR;
    PG8_STAGE(PG8_SB(1, 0), cB + kstep, voffB); PG8_STAGE(PG8_SA(1, 0), cA + kstep, vc0); PG8_STAGE(PG8_SB(1, 1), cB + hsB + kstep, voffB);
    PG8_WAIT_V(6); PG8_BAR;
    for (;;) {
        const bool has_next = S.next(ui + 1, nxt);
        const char* nA = has_next ? (const char*)nxt.a : cA; const char* nB = has_next ? (const char*)nxt.b : cB;
        if constexpr (GATHER) { if (has_next) { PG8_GVOFF(nxt, vn0, vn1); } else {
#pragma unroll
            for (int i = 0; i < 2; ++i) { vn0[i] = vc0[i]; vn1[i] = vc1[i]; } } }
        for (int t = 0; t < nt; t += 2) {
            const bool last = (t == nt - 2);
            const char* a1 = cA + (size_t)(t + 1) * kstep;
            const char* a2 = last ? nA : cA + (size_t)(t + 2) * kstep; const char* b2 = last ? nB : cB + (size_t)(t + 2) * kstep;
            const char* a3 = a2 + kstep; const char* b3 = b2 + kstep;
            unsigned v20[2], v21[2];
#pragma unroll
            for (int i = 0; i < 2; ++i) { v20[i] = (GATHER && last) ? vn0[i] : vc0[i]; v21[i] = GATHER ? (last ? vn1[i] : vc1[i]) : vc0[i]; }
            PG8_LDB(B0, 0, 0); PG8_LDB(B1, 0, 1); PG8_SCHED; PG8_LDA(At, 0, 0); PG8_STAGE(PG8_SA(1, 1), a1 + hsA, vc1);
            PG8_WAIT_V(8); PG8_WAIT_L(0); PG8_BAR; PG8_MMA(0, 0, At, B0); PG8_MMA(0, 1, At, B1); PG8_BAR; PG8_SCHED;
            PG8_LDA(At, 0, 1); PG8_STAGE(PG8_SB(0, 0), b2, voffB); PG8_STAGE(PG8_SB(0, 1), b2 + hsB, voffB); PG8_STAGE(PG8_SA(0, 0), a2, v20);
            PG8_WAIT_V(8); PG8_WAIT_L(0); PG8_BAR; PG8_MMA(1, 0, At, B0); PG8_MMA(1, 1, At, B1); PG8_BAR; PG8_SCHED;
            PG8_LDB(B0, 1, 0); PG8_LDB(B1, 1, 1); PG8_SCHED; PG8_LDA(At, 1, 0); PG8_STAGE(PG8_SA(0, 1), a2 + hsA, v21);
            PG8_WAIT_V(8); PG8_WAIT_L(0); PG8_BAR; PG8_MMA(0, 0, At, B0); PG8_MMA(0, 1, At, B1); PG8_BAR; PG8_SCHED;
            PG8_LDA(At, 1, 1); PG8_STAGE(PG8_SB(1, 0), b3, voffB); PG8_STAGE(PG8_SB(1, 1), b3 + hsB, voffB); PG8_STAGE(PG8_SA(1, 0), a3, v20);
            PG8_WAIT_V(8); PG8_WAIT_L(0); PG8_BAR; PG8_MMA(1, 0, At, B0); PG8_MMA(1, 1, At, B1); PG8_BAR; PG8_SCHED;
        }
        if constexpr (ALIGN_EPI) { if (wr == 0) PG8_BAR; }
        E(acc, cur, wr, wc, fr, fq);
        if (!has_next) break;
#pragma unroll
        for (int a = 0; a < 2; ++a)
#pragma unroll
            for (int b = 0; b < 2; ++b)
#pragma unroll
                for (int m = 0; m < 4; ++m)
#pragma unroll
                    for (int n = 0; n < 2; ++n) acc[a][b][m][n] = (f32x4){0.f, 0.f, 0.f, 0.f};
        cur = nxt; cA = nA; cB = nB; ++ui;
        if constexpr (GATHER) {
#pragma unroll
            for (int i = 0; i < 2; ++i) { vc0[i] = vn0[i]; vc1[i] = vn1[i]; } }
        if constexpr (ALIGN_EPI) { if (wr == 1) PG8_BAR; }
    }
    PG8_WAIT_V(0);
    if constexpr (!ALIGN_EPI) { if (wr == 0) PG8_BAR; }
    PG8_BAR;
#undef PG8_SA
#undef PG8_SB
#undef PG8_STAGE
#undef PG8_LDA
#undef PG8_LDB
#undef PG8_MMA
#undef PG8_WAIT_V
#undef PG8_WAIT_L
#undef PG8_BAR
#undef PG8_SCHED
#undef PG8_GVOFF
}
}
#define XB_TMO      128
#define XB_XCNT(j)  (256  + 64 * (j))
#define XB_XSUB(j)  (1280 + 64 * (j))
#define XB_XGEN(j)  (2304 + 64 * (j))
#define XB_TOP      3328
#define XB_TOPGEN   3392
#define XCD_BAR_WORDS 3456
#define XB_SPIN_CAP (1u << 18)

__device__ __forceinline__ unsigned xb_ld(unsigned* p)              { return __hip_atomic_load(p, __ATOMIC_RELAXED, __HIP_MEMORY_SCOPE_AGENT); }
__device__ __forceinline__ unsigned xb_add(unsigned* p, unsigned v) { return __hip_atomic_fetch_add(p, v, __ATOMIC_RELAXED, __HIP_MEMORY_SCOPE_AGENT); }
__device__ __forceinline__ unsigned xb_xcc_id() { return (unsigned)__builtin_amdgcn_s_getreg((3 << 11) | 20) & 0xFu; }
#define XB_SPIN(cond, bar) do { unsigned _sp = 0; while (cond) { __builtin_amdgcn_s_sleep(1); \
    if ((++_sp & 255u) == 0u) { if (xb_ld(&(bar)[XB_TMO])) break; if (_sp > XB_SPIN_CAP) { atomicAdd(&(bar)[XB_TMO], 1u); break; } } } } while (0)

struct XcdBarrier {
    unsigned* bar; unsigned x;
    volatile LAS unsigned* st;
};

__device__ __forceinline__ XcdBarrier xcd_barrier_post(unsigned* bar, volatile LAS unsigned* st) {
    XcdBarrier b; b.bar = bar; b.x = xb_xcc_id(); b.st = st;
    if (threadIdx.x == 0) (void)xb_add(&bar[XB_XCNT(b.x)], 1u);
    return b;
}
__device__ __forceinline__ void xcd_barrier_complete(unsigned* bar, unsigned x, unsigned& nloc, unsigned& nx) {
    const unsigned G = gridDim.x * gridDim.y * gridDim.z;
    unsigned sum, cnt, mine, sp = 0u;
    for (;;) {
        sum = 0u; cnt = 0u; mine = 0u;
#pragma unroll
        for (unsigned j = 0; j < 16; ++j) { const unsigned c = xb_ld(&bar[XB_XCNT(j)]); sum += c; cnt += (c > 0u) ? 1u : 0u; mine = (j == x) ? c : mine; }
        if (sum == G) break;
        __builtin_amdgcn_s_sleep(1);
        if ((++sp & 255u) == 0u) { if (xb_ld(&bar[XB_TMO])) break; if (sp > XB_SPIN_CAP) { atomicAdd(&bar[XB_TMO], 1u); break; } }
    }
    nloc = mine > 0u ? mine : 1u; nx = cnt > 0u ? cnt : 1u;
}

__device__ __forceinline__ void xcd_barrier(const XcdBarrier& b) {
    asm volatile("s_waitcnt vmcnt(0)" ::: "memory");
    __syncthreads();
    if (threadIdx.x == 0) {
        unsigned* bar = b.bar;
        __builtin_amdgcn_s_waitcnt(0);
        unsigned nloc = b.st[0], nx = b.st[1];
        if (nloc == 0u) { xcd_barrier_complete(bar, b.x, nloc, nx); b.st[0] = nloc; b.st[1] = nx; }
        const unsigned old = xb_add(&bar[XB_XSUB(b.x)], 1u);
        const unsigned gen = old / nloc;
        if (old + 1u == (gen + 1u) * nloc) {
            __builtin_amdgcn_fence(__ATOMIC_RELEASE, "agent");
            asm volatile("s_waitcnt vmcnt(0)" ::: "memory");
            const unsigned og = xb_add(&bar[XB_TOP], 1u);
            const unsigned tg = og / nx;
            if (og + 1u == (tg + 1u) * nx) xb_add(&bar[XB_TOPGEN], 1u);
            else XB_SPIN(xb_ld(&bar[XB_TOPGEN]) == tg, bar);
            __builtin_amdgcn_fence(__ATOMIC_ACQUIRE, "agent");
            xb_add(&bar[XB_XGEN(b.x)], 1u);
            asm volatile("s_waitcnt vmcnt(0)" ::: "memory");
        } else {
            XB_SPIN(xb_ld(&bar[XB_XGEN(b.x)]) == gen, bar);
            __builtin_amdgcn_fence(__ATOMIC_ACQUIRE, "agent");
            asm volatile("s_waitcnt vmcnt(0)" ::: "memory");
        }
    }
    __syncthreads();
}
namespace att {
typedef short v4i16_t __attribute__((ext_vector_type(4)));
DI f32x16 mfma32(bf16x8 a, bf16x8 b, f32x16 c) { return __builtin_amdgcn_mfma_f32_32x32x16_bf16(a, b, c, 0, 0, 0); }
DI f32x4 mfma16(bf16x8 a, bf16x8 b, f32x4 c) { return __builtin_amdgcn_mfma_f32_16x16x32_bf16(a, b, c, 0, 0, 0); }
DI int crow(int r, int hi) { return (r & 3) + 8 * (r >> 2) + 4 * hi; }
DI s16x4 vtr(const LAS char* p) { return __builtin_bit_cast(s16x4, __builtin_amdgcn_ds_read_tr16_b64_v4i16((LAS v4i16_t*)p)); }
DI int rfl(int x) { return __builtin_amdgcn_readfirstlane(x); }
constexpr float NEGBIG = -1e30f;
#define LDS_BAR() asm volatile("s_waitcnt lgkmcnt(0)\n\ts_barrier" ::: "memory")

template <int D, int KS> DI f32x16 qk32(const LAS char* kp, const bf16x8* qf, float init = 0.f) {
    f32x16 acc;
#pragma unroll
    for (int i = 0; i < 16; ++i) acc[i] = init;
    bf16x8 kfr[D / 16];
#pragma unroll
    for (int d0 = 0; d0 < D / 16; ++d0) kfr[d0] = *(const LAS bf16x8*)(kp + d0 * 32);
    asm volatile("" ::: "memory");
#pragma unroll
    for (int d0 = 0; d0 < D / 16; ++d0) acc = mfma32(kfr[d0], qf[d0], acc);
    return acc;
}
template <int D, int KS> DI void qk64(f32x16& a0, f32x16& a1, const LAS char* kp, const bf16x8* qf, float init = 0.f) {
#pragma unroll
    for (int i = 0; i < 16; ++i) { a0[i] = init; a1[i] = init; }
    bf16x8 k0[D / 16], k1[D / 16];
#pragma unroll
    for (int d0 = 0; d0 < D / 16; ++d0) { k0[d0] = *(const LAS bf16x8*)(kp + d0 * 32); k1[d0] = *(const LAS bf16x8*)(kp + 32 * KS + d0 * 32); }
    asm volatile("" ::: "memory");
#pragma unroll
    for (int d0 = 0; d0 < D / 16; ++d0) { a0 = mfma32(k0[d0], qf[d0], a0); a1 = mfma32(k1[d0], qf[d0], a1); }
}
template <int VS> DI void pv32(f32x16 (&o)[2], const LAS char* vp, bf16x8 pf0, bf16x8 pf1) {
    s16x4 t[2][4];
#pragma unroll
    for (int dh = 0; dh < 2; ++dh) { t[dh][0] = vtr(vp + dh * 64); t[dh][1] = vtr(vp + 8 * VS + dh * 64); t[dh][2] = vtr(vp + 16 * VS + dh * 64); t[dh][3] = vtr(vp + 24 * VS + dh * 64); }
    asm volatile("" ::: "memory");
#pragma unroll
    for (int dh = 0; dh < 2; ++dh) {
        const bf16x8 v0 = __builtin_shufflevector(t[dh][0], t[dh][1], 0, 1, 2, 3, 4, 5, 6, 7), v1 = __builtin_shufflevector(t[dh][2], t[dh][3], 0, 1, 2, 3, 4, 5, 6, 7);
        o[dh] = mfma32(v0, pf0, o[dh]); o[dh] = mfma32(v1, pf1, o[dh]);
    }
}
template <int VS> DI void pv64(f32x16 (&o)[2], const LAS char* vp, const f32x16& p0, const f32x16& p1);
DI bf16x8 pack8(const f32x16& p, int s) {
    u32x4 w; w.x = cvtpk(p[8 * s], p[8 * s + 1]); w.y = cvtpk(p[8 * s + 2], p[8 * s + 3]); w.z = cvtpk(p[8 * s + 4], p[8 * s + 5]); w.w = cvtpk(p[8 * s + 6], p[8 * s + 7]);
    return __builtin_bit_cast(bf16x8, w);
}
template <int VS> DI void pv64(f32x16 (&o)[2], const LAS char* vp, const f32x16& p0, const f32x16& p1) {
    s16x4 t[2][2][4];
#pragma unroll
    for (int hh = 0; hh < 2; ++hh)
#pragma unroll
        for (int dh = 0; dh < 2; ++dh)
#pragma unroll
            for (int k = 0; k < 4; ++k) t[hh][dh][k] = vtr(vp + (32 * hh + 8 * k) * VS + dh * 64);
    const bf16x8 pa0 = pack8(p0, 0), pa1 = pack8(p0, 1), pb0 = pack8(p1, 0), pb1 = pack8(p1, 1);
    asm volatile("" ::: "memory");
#pragma unroll
    for (int dh = 0; dh < 2; ++dh) {
        o[dh] = mfma32(__builtin_shufflevector(t[0][dh][0], t[0][dh][1], 0, 1, 2, 3, 4, 5, 6, 7), pa0, o[dh]);
        o[dh] = mfma32(__builtin_shufflevector(t[0][dh][2], t[0][dh][3], 0, 1, 2, 3, 4, 5, 6, 7), pa1, o[dh]);
        o[dh] = mfma32(__builtin_shufflevector(t[1][dh][0], t[1][dh][1], 0, 1, 2, 3, 4, 5, 6, 7), pb0, o[dh]);
        o[dh] = mfma32(__builtin_shufflevector(t[1][dh][2], t[1][dh][3], 0, 1, 2, 3, 4, 5, 6, 7), pb1, o[dh]);
    }
}
DI float max16(const f32x16& p) { float a = fmaxf(fmaxf(p[0], p[1]), fmaxf(p[2], p[3]));
#pragma unroll
    for (int r = 4; r < 16; r += 4) a = fmaxf(a, fmaxf(fmaxf(p[r], p[r + 1]), fmaxf(p[r + 2], p[r + 3]))); return a; }
DI void store_ot(bf16_t* dst, const f32x16 (&o)[2], int hi) {
#pragma unroll
    for (int dh = 0; dh < 2; ++dh)
#pragma unroll
        for (int g4 = 0; g4 < 4; ++g4) { u32x2 w; w.x = cvtpk(o[dh][4 * g4], o[dh][4 * g4 + 1]); w.y = cvtpk(o[dh][4 * g4 + 2], o[dh][4 * g4 + 3]); *(u32x2*)(dst + 32 * dh + 8 * g4 + 4 * hi) = w; }
}

#define ATT_SB() __builtin_amdgcn_sched_barrier(0)
template <int D, int KS, int VS> DI void step64(f32x16 (&o)[2], float& l, const LAS char* kp, const LAS char* vp, const bf16x8* qf, float init) {
    bf16x8 k0[D / 16], k1[D / 16];
#pragma unroll
    for (int d0 = 0; d0 < D / 16; ++d0) { k0[d0] = *(const LAS bf16x8*)(kp + d0 * 32); k1[d0] = *(const LAS bf16x8*)(kp + 32 * KS + d0 * 32); }
    s16x4 t[2][2][4];
#pragma unroll
    for (int hh = 0; hh < 2; ++hh)
#pragma unroll
        for (int dh = 0; dh < 2; ++dh)
#pragma unroll
            for (int k = 0; k < 4; ++k) t[hh][dh][k] = vtr(vp + (32 * hh + 8 * k) * VS + dh * 64);
    f32x16 a0, a1;
#pragma unroll
    for (int i = 0; i < 16; ++i) { a0[i] = init; a1[i] = init; }
    ATT_SB();
#pragma unroll
    for (int d0 = 0; d0 < D / 16; ++d0) a0 = mfma32(k0[d0], qf[d0], a0);
#pragma unroll
    for (int d0 = 0; d0 < D / 16 - 4; ++d0) a1 = mfma32(k1[d0], qf[d0], a1);
    ATT_SB();
    float ls = 0.f;
#pragma unroll
    for (int g = 0; g < 4; ++g) {
        a1 = mfma32(k1[D / 16 - 4 + g], qf[D / 16 - 4 + g], a1);
#pragma unroll
        for (int e = 0; e < 4; ++e) { a0[4 * g + e] = fast_exp2(a0[4 * g + e]); ls += a0[4 * g + e]; }
        asm volatile("" : "+v"(a0), "+v"(ls)); ATT_SB();
    }
    const bf16x8 pa0 = pack8(a0, 0), pa1 = pack8(a0, 1);
    ATT_SB();
#pragma unroll
    for (int g = 0; g < 4; ++g) {
        const int dh = g & 1, s = g >> 1;
        o[dh] = mfma32(__builtin_shufflevector(t[0][dh][2 * s], t[0][dh][2 * s + 1], 0, 1, 2, 3, 4, 5, 6, 7), s ? pa1 : pa0, o[dh]);
#pragma unroll
        for (int e = 0; e < 4; ++e) { a1[4 * g + e] = fast_exp2(a1[4 * g + e]); ls += a1[4 * g + e]; }
        asm volatile("" : "+v"(a1), "+v"(ls)); ATT_SB();
    }
    const bf16x8 pb0 = pack8(a1, 0), pb1 = pack8(a1, 1);
    ATT_SB();
#pragma unroll
    for (int g = 0; g < 4; ++g) { const int dh = g & 1, s = g >> 1;
        o[dh] = mfma32(__builtin_shufflevector(t[1][dh][2 * s], t[1][dh][2 * s + 1], 0, 1, 2, 3, 4, 5, 6, 7), s ? pb1 : pb0, o[dh]); }
    l += ls;
}

constexpr int MLA_KS = 208, MLA_VS = 144, MLA_KB = 128 * MLA_KS, MLA_VB = 128 * MLA_VS, MLA_BUF = MLA_KB + MLA_VB;
DI void mla_unit(LAS char* lds, const bf16_t* QM, const bf16_t* KM, const bf16_t* KV, bf16_t* ATT, int head, int qb, float kb, int wave_id, unsigned long long* tp) {
    TP_BEGIN(7) unsigned long long tpacc_ = 0, tpa_ = 0;
    int tid_l = wave_id * 64 + lane_id(); asm volatile("" : "+v"(tid_l));
    const int tid = tid_l, lane = tid & 63, wid = rfl(tid >> 6), r32 = lane & 31, hi = lane >> 5, half = wid >> 2, wq = wid & 3;
    const int q0 = qb * 128, qpos = q0 + 32 * wq + r32, nsuper = qb + 1;
    bf16x8 qf[6];
    { const bf16_t* qp = QM + (size_t)qpos * 384 + head * 96 + hi * 8;
#pragma unroll
      for (int d0 = 0; d0 < 6; ++d0) qf[d0] = *(const bf16x8*)(qp + d0 * 16); }
    float nref;
    { float qs = 0.f;
#pragma unroll
      for (int d0 = 0; d0 < 6; ++d0)
#pragma unroll
          for (int e = 0; e < 8; ++e) { const float v = __uint_as_float(((unsigned)(unsigned short)qf[d0][e]) << 16); qs += v * v; }
      qs += sx32(qs, hi); nref = -sqrtf(qs) * kb; }
    u32x4 kr[3], vr[2];
#define MLA_LOAD(i) do { _Pragma("unroll") for (int j = 0; j < 3; ++j) { const int c = tid + 512 * j, row = c / 12, ch = c % 12; kr[j] = *(const u32x4*)(KM + (size_t)(128 * (i) + row) * 384 + head * 96 + ch * 8); } \
        _Pragma("unroll") for (int j = 0; j < 2; ++j) { const int c = tid + 512 * j, row = c >> 3, ch = c & 7; vr[j] = *(const u32x4*)(KV + (size_t)(128 * (i) + row) * 512 + head * 128 + 64 + ch * 8); } } while (0)
#define MLA_STORE(b) do { LAS char* kb_ = lds + (b) * MLA_BUF; _Pragma("unroll") for (int j = 0; j < 3; ++j) { const int c = tid + 512 * j, row = c / 12, ch = c % 12; *(LAS u32x4*)(kb_ + row * MLA_KS + ch * 16) = kr[j]; } \
        _Pragma("unroll") for (int j = 0; j < 2; ++j) { const int c = tid + 512 * j, row = c >> 3, ch = c & 7; *(LAS u32x4*)(kb_ + MLA_KB + row * MLA_VS + ch * 16) = vr[j]; } } while (0)
    MLA_LOAD(0); MLA_STORE(0); __syncthreads();
    float l = 0.f; f32x16 o[2];
#pragma unroll
    for (int i = 0; i < 16; ++i) { o[0][i] = 0.f; o[1][i] = 0.f; }
    const int vlane = (4 * hi + ((lane & 15) >> 2)) * MLA_VS + 2 * (16 * ((lane >> 4) & 1) + 4 * (lane & 3));
    for (int i = 0; i < nsuper; ++i) {
        const bool more = i + 1 < nsuper;
        if (more) MLA_LOAD(i + 1);
        const LAS char* kb_ = lds + (i & 1) * MLA_BUF; const LAS char* vb = kb_ + MLA_KB;
        const bool diag = (i == nsuper - 1);
        if (TPROBE == 14 || TPROBE == 15 || TPROBE == 16) tpa_ = tp_now();
        if (!(diag && half == 1 && wq < 2)) {
            const int koff = 64 * half;
            if (!diag) step64<96, MLA_KS, MLA_VS>(o, l, kb_ + (koff + r32) * MLA_KS + hi * 16, vb + koff * MLA_VS + vlane, qf, nref);
            else {
            f32x16 p0, p1; qk64<96, MLA_KS>(p0, p1, kb_ + (koff + r32) * MLA_KS + hi * 16, qf, nref);
            { const int kbase = 128 * i + koff;
#pragma unroll
                for (int r = 0; r < 16; ++r) { const int k0 = kbase + crow(r, hi); p0[r] = (k0 > qpos) ? 0.f : fast_exp2(p0[r]); p1[r] = (k0 + 32 > qpos) ? 0.f : fast_exp2(p1[r]); } }
#pragma unroll
            for (int r = 0; r < 16; ++r) l += p0[r] + p1[r];
            pv64<MLA_VS>(o, vb + koff * MLA_VS + vlane, p0, p1);
            }
        }
        if (TPROBE == 15) tpacc_ += tp_now() - tpa_;
        if (TPROBE == 16) tpa_ = tp_now();
        if (more) MLA_STORE((i + 1) & 1);
        if (TPROBE == 16) tpacc_ += tp_now() - tpa_;
        if (TPROBE == 14) tpa_ = tp_now();
        __syncthreads();
        if (TPROBE == 14) tpacc_ += tp_now() - tpa_;
    }
#undef MLA_LOAD
#undef MLA_STORE
    l = sum32sym(l);
    LAS float* mrg = (LAS float*)lds + (wq * 64 + lane) * 34;
    if (half == 1) { mrg[1] = l;
#pragma unroll
        for (int r = 0; r < 16; ++r) { mrg[2 + r] = o[0][r]; mrg[18 + r] = o[1][r]; } }
    __syncthreads();
    if (half == 0) {
        const float inv = 1.f / (l + mrg[1]);
#pragma unroll
        for (int r = 0; r < 16; ++r) { o[0][r] = (o[0][r] + mrg[2 + r]) * inv; o[1][r] = (o[1][r] + mrg[18 + r]) * inv; }
        store_ot(ATT + (size_t)qpos * 1024 + 768 + head * 64, o, hi);
    }
    __syncthreads();
    TP_END(7, tp);
    if ((TPROBE == 14 || TPROBE == 15 || TPROBE == 16) && lane == 0) atomicAdd(tp, tpacc_);
}

constexpr int T_KS = 144, T_KB = 64 * T_KS, T_BUF = 2 * T_KB;
DI void sb_half(f32x16 (&o)[2], float& R, const LAS char* ktile, const LAS char* vtile, const bf16x8* qf, int kb, int hh, int qpos, int r32, int hi, int vlane) {
    f32x16 z = qk32<64, T_KS>(ktile + (32 * hh + r32) * T_KS + hi * 16, qf);
    float ls[16];
#pragma unroll
    for (int r = 0; r < 16; ++r) { const bool valid = (kb + crow(r, hi)) < qpos; const float az = fabsf(z[r]);
        const float sp = fmaxf(z[r], 0.f) + fast_log2(1.f + fast_exp2(-az)); ls[r] = valid ? -sp : 0.f; }
    float T[4], U[4];
#pragma unroll
    for (int g = 0; g < 4; ++g) { ls[4 * g + 2] += ls[4 * g + 3]; ls[4 * g + 1] += ls[4 * g + 2]; ls[4 * g] += ls[4 * g + 1]; T[g] = ls[4 * g]; }
#pragma unroll
    for (int g = 0; g < 4; ++g) U[g] = sx32(T[g], hi);
    float H[4]; float sp = 0.f;
#pragma unroll
    for (int g = 3; g >= 0; --g) { H[g] = sp + (hi == 0 ? U[g] : 0.f); sp += T[g] + U[g]; }
#pragma unroll
    for (int r = 0; r < 16; ++r) { const bool valid = (kb + crow(r, hi)) < qpos; const float lw = z[r] + R + H[r >> 2] + ls[r]; z[r] = valid ? fast_exp2(lw) : 0.f; }
    R += sp;
    pv32<T_KS>(o, vtile + (32 * hh) * T_KS + vlane, pack8(z, 0), pack8(z, 1));
}
DI void sb_unit(LAS char* lds, const bf16_t* PROJ, bf16_t* ATT, int head, int qb, int wave_id) {
    int tid_l = wave_id * 64 + lane_id(); asm volatile("" : "+v"(tid_l));
    const int tid = tid_l, lane = tid & 63, wid = rfl(tid >> 6), r32 = lane & 31, hi = lane >> 5;
    const int q0 = qb * 256, wq0 = q0 + 32 * wid, qpos = wq0 + r32;
    bf16x8 qf[4];
    { const bf16_t* qp = PROJ + (size_t)qpos * 5632 + head * 64 + hi * 8;
#pragma unroll
      for (int d0 = 0; d0 < 4; ++d0) qf[d0] = *(const bf16x8*)(qp + d0 * 16); }
    const int srow = tid >> 3, sch = tid & 7;
    u32x4 kr, vr;
#define SB_LOAD(t) do { const bf16_t* p_ = PROJ + (size_t)(64 * (t) + srow) * 5632 + head * 64 + sch * 8; kr = *(const u32x4*)(p_ + 256); vr = *(const u32x4*)(p_ + 512); } while (0)
#define SB_STORE(b) do { LAS char* d_ = lds + (b) * T_BUF + srow * T_KS + sch * 16; *(LAS u32x4*)d_ = kr; *(LAS u32x4*)(d_ + T_KB) = vr; } while (0)
    volatile LAS int* flags = (volatile LAS int*)(lds + 2 * T_BUF);
    int t = 4 * qb + 3;
    SB_LOAD(t); SB_STORE(0); __syncthreads();
    float R = 0.f; f32x16 o[2];
#pragma unroll
    for (int i = 0; i < 16; ++i) { o[0][i] = 0.f; o[1][i] = 0.f; }
    const int vlane = (4 * hi + ((lane & 15) >> 2)) * T_KS + 2 * (16 * ((lane >> 4) & 1) + 4 * (lane & 3));
    bool done = false;
    for (int it = 0;; ++it) {
        const bool more = t > 0;
        if (more) SB_LOAD(t - 1);
        const LAS char* kt = lds + (it & 1) * T_BUF; const LAS char* vt = kt + T_KB;
        if (!done && 64 * t <= wq0 + 30) {
            if (64 * t + 32 <= wq0 + 30) sb_half(o, R, kt, vt, qf, 64 * t + 32, 1, qpos, r32, hi, vlane);
            sb_half(o, R, kt, vt, qf, 64 * t, 0, qpos, r32, hi, vlane);
            done = __all(R < -150.f) != 0;
        }
        if (lane == 0) flags[(it & 1) * 8 + wid] = done ? 0 : 1;
        if (more) SB_STORE((it + 1) & 1);
        __syncthreads();
        int any = 0;
#pragma unroll
        for (int w = 0; w < 8; ++w) any |= flags[(it & 1) * 8 + w];
        if (!more || !any) break;
        --t;
    }
#undef SB_LOAD
#undef SB_STORE
    store_ot(ATT + (size_t)qpos * 1024 + head * 64, o, hi);
    __syncthreads();
}

#ifndef NSAREP
#define NSAREP 0
#endif
#define NSA_NREP(bit) (((NSAREP >> (bit)) & 1) ? 2 : 1)
constexpr int N_LUT = 2 * T_BUF, N_IMP = N_LUT + 16384, N_OSTR = 68, N_BLKQ = N_IMP + 256 * N_OSTR * 4, N_L = N_BLKQ + 2048, N_REF = N_L + 1280, N_END = N_REF + 1024 + 64;
constexpr int N_QS = 144;
struct NsaT {
    const bf16_t* PROJ;
    const bf16_t* KCMP; const bf16_t* VCMP;
    const bf16_t* KS; const bf16_t* VTS;
    const bf16_t* KW;
    const float* GN;
    const float* LUT8;
    bf16_t* ATT;
    float kb, bmax;
    unsigned long long* tp;
};
__host__ __device__ __forceinline__ int vts_key_of_slot(int slot) { const int hh = slot >> 5, s5 = slot & 31, s = s5 >> 4, h = (s5 >> 3) & 1, j = s5 & 7; return 32 * hh + 16 * s + 8 * (j >> 2) + 4 * h + (j & 3); }

DI void nsa_load_lut(LAS char* lds, const float* LUT8, int g, int tid) { LAS float* lut = (LAS float*)(lds + N_LUT); for (int i = tid; i < 4096; i += 512) lut[i] = LUT8[(i >> 2) * 8 + g * 4 + (i & 3)]; }
DI void nsa_unit(LAS char* lds, const NsaT& T, int g, int qblk, int wave_id) {
    int tid_l = wave_id * 64 + lane_id(); asm volatile("" : "+v"(tid_l));
    const int tid = tid_l, lane = tid & 63, wid = rfl(tid >> 6), r32 = lane & 31, hi = lane >> 5;
    const int q0 = qblk * 64;
    TP_BEGIN(6)
    LAS float* lut = (LAS float*)(lds + N_LUT);
    LAS float* imp = (LAS float*)(lds + N_IMP);
    LAS unsigned* bq32 = (LAS unsigned*)(lds + N_BLKQ);
    LAS float* refl = (LAS float*)(lds + N_REF);
    for (int i = tid; i < 16384; i += 512) imp[i] = 0.f;
    bq32[tid] = 0u;
    const int ql = r32 >> 2, hd = r32 & 3, h8 = g * 4 + hd, tq = q0 + 8 * wid + ql;
    bf16x8 qf[4];
    { const bf16_t* qp = T.PROJ + (size_t)tq * 5632 + 768 + h8 * 64 + hi * 8;
#pragma unroll
      for (int d0 = 0; d0 < 4; ++d0) qf[d0] = *(const bf16x8*)(qp + d0 * 16); }
    float ref;
    { float qs = 0.f;
#pragma unroll
      for (int d0 = 0; d0 < 4; ++d0)
#pragma unroll
          for (int e = 0; e < 8; ++e) { const float v = __uint_as_float(((unsigned)(unsigned short)qf[d0][e]) << 16); qs += v * v; }
      qs += sx32(qs, hi); ref = sqrtf(qs) * T.kb + T.bmax; }
    if (hi == 0) refl[(8 * wid + ql) * 4 + hd] = ref;
    const float gc = T.GN[(size_t)tq * 24 + 3 * h8], gs = T.GN[(size_t)tq * 24 + 3 * h8 + 1], gw = T.GN[(size_t)tq * 24 + 3 * h8 + 2];
    const int srow = tid >> 3, sch = tid & 7;
    const int vlane = (4 * hi + ((lane & 15) >> 2)) * T_KS + 2 * (16 * ((lane >> 4) & 1) + 4 * (lane & 3));
    u32x4 kr, vr;
    __syncthreads();
    const float cfar = lut[1023 * 4 + hd] - ref;
    const int nmax = (q0 + 32) / 16 + 1;
    const int ntc = (nmax + 63) >> 6;
    const bf16_t* kc = T.KCMP + (size_t)g * 1024 * 64; const bf16_t* vc = T.VCMP + (size_t)g * 1024 * 64;
    const int relq = tq - 31;
    const int relw = q0 + 8 * wid - 31;
    float l = 0.f; float inv_l = 0.f; f32x16 oa[2];
    { TP_BEGIN(4)
    for (int rp_ = 0; rp_ < NSA_NREP(0); ++rp_) { l = 0.f;
    u32x4 kq, vq;
    u32x4 v2a = *(const u32x4*)(vc + (size_t)srow * 64 + sch * 8), v2b = v2a; if (1 < ntc) v2b = *(const u32x4*)(vc + (size_t)(64 + srow) * 64 + sch * 8);
    kr = *(const u32x4*)(kc + (size_t)srow * 64 + sch * 8);
    *(LAS u32x4*)(lds + srow * T_KS + sch * 16) = kr; kq = kr;
    if (1 < ntc) kq = *(const u32x4*)(kc + (size_t)(64 + srow) * 64 + sch * 8);
    LDS_BAR();
    for (int j = 0; j < ntc; ++j) {
        const bool more = j + 1 < ntc;
        if (j + 2 < ntc) kr = *(const u32x4*)(kc + (size_t)(64 * (j + 2) + srow) * 64 + sch * 8);
        const LAS char* kt = lds + (j & 1) * T_BUF;
#pragma unroll
        for (int hh = 0; hh < 2; ++hh) {
            f32x16 s = qk32<64, T_KS>(kt + (32 * hh + r32) * T_KS + hi * 16, qf);
            const int n0 = 64 * j + 32 * hh;
            if (relw - 16 * (n0 + 31) >= 790) {
#pragma unroll
                for (int r = 0; r < 16; ++r) l += fast_exp2(s[r] + cfar);
            } else {
#pragma unroll
                for (int r = 0; r < 16; ++r) { const int rel = relq - 16 * (n0 + crow(r, hi)); l += (rel >= 0) ? fast_exp2(s[r] + lut[(rel < 1023 ? rel : 1023) * 4 + hd] - ref) : 0.f; }
            }
        }
        if (more) *(LAS u32x4*)(lds + ((j + 1) & 1) * T_BUF + srow * T_KS + sch * 16) = kq;
        kq = kr;
        LDS_BAR();
    }
    l = sum32sym(l);
    inv_l = l > 0.f ? 1.f / l : 0.f;
#pragma unroll
    for (int i = 0; i < 16; ++i) { oa[0][i] = 0.f; oa[1][i] = 0.f; }
    float cprev = 0.f;
    kr = *(const u32x4*)(kc + (size_t)srow * 64 + sch * 8); vr = v2a;
    { LAS char* d_ = lds + srow * T_KS + sch * 16; *(LAS u32x4*)d_ = kr; *(LAS u32x4*)(d_ + T_KB) = vr; } kq = kr; vq = vr;
    if (1 < ntc) { kq = *(const u32x4*)(kc + (size_t)(64 + srow) * 64 + sch * 8); vq = v2b; }
    LDS_BAR();
    for (int j = 0; j < ntc; ++j) {
        const bool more = j + 1 < ntc;
        if (j + 2 < ntc) { kr = *(const u32x4*)(kc + (size_t)(64 * (j + 2) + srow) * 64 + sch * 8); vr = *(const u32x4*)(vc + (size_t)(64 * (j + 2) + srow) * 64 + sch * 8); }
        const LAS char* kt = lds + (j & 1) * T_BUF; const LAS char* vt = kt + T_KB;
#pragma unroll
        for (int hh = 0; hh < 2; ++hh) {
            f32x16 s = qk32<64, T_KS>(kt + (32 * hh + r32) * T_KS + hi * 16, qf);
            const int n0 = 64 * j + 32 * hh;
            if (relw - 16 * (n0 + 31) >= 790) {
#pragma unroll
                for (int r = 0; r < 16; ++r) s[r] = fast_exp2(s[r] + cfar) * inv_l;
            } else {
#pragma unroll
                for (int r = 0; r < 16; ++r) { const int rel = relq - 16 * (n0 + crow(r, hi)); s[r] = (rel >= 0) ? fast_exp2(s[r] + lut[(rel < 1023 ? rel : 1023) * 4 + hd] - ref) * inv_l : 0.f; }
            }
            float gsm[4], c3[4], pc3[4];
#pragma unroll
            for (int gi = 0; gi < 4; ++gi) { float a = (s[4 * gi] + s[4 * gi + 1]) + (s[4 * gi + 2] + s[4 * gi + 3]), b = s[4 * gi + 3];
                a += sx<1>(a); a += sx<2>(a); b += sx<1>(b); b += sx<2>(b); gsm[gi] = a; c3[gi] = b; }
#pragma unroll
            for (int gi = 0; gi < 4; ++gi) pc3[gi] = sx32(c3[gi], hi);
            const int b0 = 16 * j + 8 * hh + hi;
            if (hd == 0) {
                LAS float* ip = imp + (8 * wid + ql) * 256 + b0;
                if (hi == 1) {
#pragma unroll
                    for (int gi = 0; gi < 4; ++gi) ip[2 * gi] = gsm[gi] + pc3[gi];
                } else { ip[0] = gsm[0] + cprev; ip[2] = gsm[1] + pc3[0]; ip[4] = gsm[2] + pc3[1]; ip[6] = gsm[3] + pc3[2]; }
            }
            cprev = pc3[3];
            pv32<T_KS>(oa, vt + (32 * hh) * T_KS + vlane, pack8(s, 0), pack8(s, 1));
        }
        if (more) { LAS char* d_ = lds + ((j + 1) & 1) * T_BUF + srow * T_KS + sch * 16; *(LAS u32x4*)d_ = kq; *(LAS u32x4*)(d_ + T_KB) = vq; }
        kq = kr; vq = vr;
        LDS_BAR();
    }
    }
    TP_END(4, T.tp); }
#pragma unroll
    for (int i = 0; i < 16; ++i) { oa[0][i] *= gc; oa[1][i] *= gc; }
    store_ot(T.ATT + (size_t)tq * 1024 + 256 + h8 * 64, oa, hi);
    { TP_BEGIN(3)
    for (int rp_ = 0; rp_ < NSA_NREP(1); ++rp_) {
    unsigned ones = 0xffffffffu; asm volatile("" : "+v"(ones));
    if (qblk < 16) {
        if (tid <= qblk) { bq32[2 * tid] = ones; bq32[2 * tid + 1] = ones; }
    } else {
        if (tid == 0) { bq32[0] = ones; bq32[1] = ones; bq32[2 * qblk] = ones; bq32[2 * qblk + 1] = ones; bq32[2 * qblk - 2] = ones; bq32[2 * qblk - 1] = ones; }
        unsigned kv[8][4];
#pragma unroll
        for (int q = 0; q < 8; ++q)
#pragma unroll
            for (int i = 0; i < 4; ++i) { const int b = lane + 64 * i; kv[q][i] = (b >= 1 && b <= qblk - 2) ? __float_as_uint(imp[(8 * wid + q) * 256 + b]) + 1u : 0u; }
        unsigned T8[8];
#pragma unroll
        for (int q = 0; q < 8; ++q) T8[q] = 0u;
        for (int bit = 31; bit >= 0; --bit) {
#pragma unroll
            for (int q = 0; q < 8; ++q) { const unsigned t2 = T8[q] | (1u << bit);
                const int cnt = __builtin_popcountll(__builtin_amdgcn_ballot_w64(kv[q][0] >= t2)) + __builtin_popcountll(__builtin_amdgcn_ballot_w64(kv[q][1] >= t2))
                              + __builtin_popcountll(__builtin_amdgcn_ballot_w64(kv[q][2] >= t2)) + __builtin_popcountll(__builtin_amdgcn_ballot_w64(kv[q][3] >= t2));
                T8[q] = (cnt >= 13) ? t2 : T8[q]; }
        }
#pragma unroll
        for (int q = 0; q < 8; ++q) { const unsigned Tq = T8[q];
            int quota = 13 - (__builtin_popcountll(__builtin_amdgcn_ballot_w64(kv[q][0] > Tq)) + __builtin_popcountll(__builtin_amdgcn_ballot_w64(kv[q][1] > Tq))
                            + __builtin_popcountll(__builtin_amdgcn_ballot_w64(kv[q][2] > Tq)) + __builtin_popcountll(__builtin_amdgcn_ballot_w64(kv[q][3] > Tq)));
            const int qi = 8 * wid + q;
#pragma unroll
            for (int i = 0; i < 4; ++i) {
                const unsigned long long me = __builtin_amdgcn_ballot_w64(kv[q][i] == Tq); const int pe = __builtin_popcountll(me); const int take = pe < quota ? pe : quota;
                unsigned long long km = 0ull, mm = me; for (int t_ = 0; t_ < take; ++t_) { km |= mm & (0ull - mm); mm &= mm - 1ull; }
                quota -= take;
                const bool tie = (lane < 32 ? (unsigned)km >> lane : (unsigned)(km >> 32) >> (lane - 32)) & 1u;
                if (kv[q][i] > Tq || (kv[q][i] == Tq && tie)) (void)__hip_atomic_fetch_or(bq32 + 2 * (lane + 64 * i) + (qi >> 5), 1u << (qi & 31), __ATOMIC_RELAXED, __HIP_MEMORY_SCOPE_WORKGROUP);
            }
        }
    }
    }
    TP_END(3, T.tp); }
    __syncthreads();
    {
        LAS float* slot = (LAS float*)(lds + N_IMP);
        LAS unsigned short* items = (LAS unsigned short*)(lds + N_L);
        volatile LAS int* nitems = (volatile LAS int*)(lds + N_L + 768);
        LAS unsigned* smask = (LAS unsigned*)(lds + N_L + 832);
        LAS unsigned char* npv = (LAS unsigned char*)(lds + N_L + 896);
        LAS int* part = (LAS int*)(lds + N_REF + 1024);
        if (tid < 256) { int np = 0; if (qblk >= 16 && tid >= 1 && tid <= qblk - 2) { const unsigned long long mk = ((unsigned long long)bq32[2 * tid + 1] << 32) | bq32[2 * tid]; np = (__builtin_popcountll(mk) + 7) >> 3; } npv[tid] = (unsigned char)np; }
        __syncthreads();
        if (tid < 16) { int sm = 0;
#pragma unroll
            for (int k = 0; k < 16; ++k) sm += npv[16 * tid + k]; part[tid] = sm; }
        __syncthreads();
        if (tid == 0) { int run = 0;
#pragma unroll
            for (int k = 0; k < 16; ++k) { const int v = part[k]; part[k] = run; run += v; } *nitems = run; }
        __syncthreads();
        if (tid < 256) { int st = part[tid >> 4]; for (int k = 0; k < (tid & 15); ++k) st += npv[(tid & ~15) + k]; const int np = npv[tid]; for (int pp = 0; pp < np; ++pp) items[st + pp] = (unsigned short)(tid | (pp << 8)); }
        { const int q = tid >> 3, c8 = tid & 7; const bf16_t* src = T.PROJ + (size_t)(q0 + q) * 5632 + 768 + g * 256 + c8 * 32; LAS char* dst = lds + (q * 4 + (c8 >> 1)) * N_QS + (c8 & 1) * 64;
#pragma unroll
          for (int i = 0; i < 4; ++i) *(LAS u32x4*)(dst + 16 * i) = *(const u32x4*)(src + 8 * i); }
        __syncthreads();
        const bf16_t* ksg = T.KS + (size_t)g * 256 * 4096 + lane * 8;
        const bf16_t* vtg = T.VTS + (size_t)g * 256 * 4096 + lane * 8;
        const int jslot = r32 >> 2;
        const int myq = 8 * wid + ql; const unsigned qmlo = myq < 32 ? ((1u << myq) - 1u) : 0xffffffffu, qmhi = myq < 32 ? 0u : ((1u << (myq - 32)) - 1u);
        const float biasfar = lut[1023 * 4 + hd];
        float lpart = 0.f, lfull = 0.f; f32x16 os[2];
        for (int rp_ = 0; rp_ < NSA_NREP(2); ++rp_) { lpart = 0.f; lfull = 0.f;
#pragma unroll
        for (int i = 0; i < 16; ++i) { os[0][i] = 0.f; os[1][i] = 0.f; }
        bf16x8 kf[2][4], vf[2][2][2];
#define NSA_LDK(B) do { const bf16_t* p_ = ksg + (size_t)(B) * 4096; _Pragma("unroll") for (int hh = 0; hh < 2; ++hh) _Pragma("unroll") for (int d0 = 0; d0 < 4; ++d0) kf[hh][d0] = *(const bf16x8*)(p_ + (hh * 4 + d0) * 512); } while (0)
#define NSA_LDV(B) do { const bf16_t* p_ = vtg + (size_t)(B) * 4096; _Pragma("unroll") for (int hh = 0; hh < 2; ++hh) _Pragma("unroll") for (int dh = 0; dh < 2; ++dh) _Pragma("unroll") for (int s = 0; s < 2; ++s) vf[hh][dh][s] = *(const bf16x8*)(p_ + ((hh * 2 + dh) * 2 + s) * 512); } while (0)
#define NSA_SCORE(B, QF, INI, TS, OK, LS) do { \
            _Pragma("unroll") for (int hh = 0; hh < 2; ++hh) { _Pragma("unroll") for (int i = 0; i < 16; ++i) sc[hh][i] = (INI); \
                _Pragma("unroll") for (int d0 = 0; d0 < 4; ++d0) sc[hh] = mfma32(kf[hh][d0], (QF)[d0], sc[hh]); } \
            if (q0 - (64 * (B) + 63) >= 790) { _Pragma("unroll") for (int hh = 0; hh < 2; ++hh) _Pragma("unroll") for (int r = 0; r < 16; ++r) { const float p = (OK) ? fast_exp2(sc[hh][r]) : 0.f; sc[hh][r] = p; LS += p; } } \
            else { _Pragma("unroll") for (int hh = 0; hh < 2; ++hh) _Pragma("unroll") for (int r = 0; r < 16; ++r) { const int rel = (TS) - (64 * (B) + 32 * hh + crow(r, hi)); const int rc = rel < 0 ? 0 : (rel < 1023 ? rel : 1023); \
                const float p = ((OK) && rel >= 0) ? fast_exp2(sc[hh][r] + lut[rc * 4 + hd]) : 0.f; sc[hh][r] = p; LS += p; } } } while (0)
#define NSA_PV(O) do { _Pragma("unroll") for (int hh = 0; hh < 2; ++hh) { const bf16x8 p0 = pack8(sc[hh], 0), p1 = pack8(sc[hh], 1); \
            _Pragma("unroll") for (int dh = 0; dh < 2; ++dh) { (O)[dh] = mfma32(vf[hh][dh][0], p0, (O)[dh]); (O)[dh] = mfma32(vf[hh][dh][1], p1, (O)[dh]); } } } while (0)
        f32x16 sc[2];
        { TP_BEGIN(2) const int nf = qblk < 16 ? qblk + 1 : 3;
          { const int fb0 = 0; NSA_LDK(fb0); NSA_LDV(fb0); }
          for (int fi = 0; fi < nf; ++fi) { const int fb = qblk < 16 ? fi : (fi == 0 ? 0 : qblk - 2 + fi); const int fn = qblk < 16 ? fi + 1 : qblk - 1 + fi;
            const float ini = ((q0 - (64 * fb + 63) >= 790) ? biasfar : 0.f) - ref;
            NSA_SCORE(fb, qf, ini, tq, true, lpart);
            if (fi + 1 < nf) NSA_LDK(fn);
            NSA_PV(os);
            if (fi + 1 < nf) NSA_LDV(fn); } TP_END(2, T.tp); }
        TP_BEGIN(1)
        const int ni = *nitems; unsigned long long tpacc_ = 0;
        int it_b = -1, it_p = 0;
        if (wid < ni) { const int e = items[wid]; it_b = e & 255; it_p = e >> 8; NSA_LDK(it_b); NSA_LDV(it_b); }
        for (int i0 = 0; i0 < ni; i0 += 8) {
            const int inext = i0 + 8 + wid; int nb_ = -1, np_ = 0;
            if (inext < ni) { const int e = items[inext]; nb_ = e & 255; np_ = e >> 8; }
            unsigned long long msk = 0ull;
            unsigned long long tpa_ = 0; if (TPROBE == 11 || TPROBE == 12 || TPROBE == 13) tpa_ = tp_now();
            if (it_b >= 0) {
                unsigned long long m_ = ((unsigned long long)(unsigned)rfl((int)bq32[2 * it_b + 1]) << 32) | (unsigned)rfl((int)bq32[2 * it_b]);
                for (int i_ = 0; i_ < 8 * it_p; ++i_) m_ &= m_ - 1ull;
                unsigned long long t_ = m_; for (int i_ = 0; i_ < 8; ++i_) t_ &= t_ - 1ull;
                msk = m_ & ~t_;
                int qsel = -1; { unsigned long long mm = msk;
#pragma unroll
                    for (int j = 0; j < 8; ++j) { const int qj = mm ? (int)__builtin_ctzll(mm) : -1; mm &= mm - 1ull; if (jslot == j) qsel = qj; } }
                const bool valid = qsel >= 0; const int row = (valid ? qsel : 0) * 4 + hd, ts = q0 + (valid ? qsel : 0);
                const float ini = ((q0 - (64 * it_b + 63) >= 790) ? biasfar : 0.f) - refl[row];
                bf16x8 qv[4];
#pragma unroll
                for (int d0 = 0; d0 < 4; ++d0) qv[d0] = *(const LAS bf16x8*)(lds + row * N_QS + d0 * 32 + hi * 16);
                float ls = 0.f;
                NSA_SCORE(it_b, qv, ini, ts, valid, ls);
                if (nb_ >= 0) NSA_LDK(nb_);
                f32x16 ot[2];
#pragma unroll
                for (int i = 0; i < 16; ++i) { ot[0][i] = 0.f; ot[1][i] = 0.f; }
                NSA_PV(ot);
                if (nb_ >= 0) NSA_LDV(nb_);
                ls = sum32sym(ls);
                LAS float* sp = slot + (wid * 32 + r32) * N_OSTR;
#pragma unroll
                for (int dh = 0; dh < 2; ++dh)
#pragma unroll
                    for (int g4 = 0; g4 < 4; ++g4) *(LAS f32x4*)(sp + 32 * dh + 8 * g4 + 4 * hi) = (f32x4){ot[dh][4 * g4], ot[dh][4 * g4 + 1], ot[dh][4 * g4 + 2], ot[dh][4 * g4 + 3]};
                if (hi == 0) sp[64] = ls;
            }
            if (lane == 0) { smask[2 * wid] = (unsigned)msk; smask[2 * wid + 1] = (unsigned)(msk >> 32); }
            if (TPROBE == 11) tpacc_ += tp_now() - tpa_;
            if (TPROBE == 12 || TPROBE == 13) tpa_ = tp_now();
            LDS_BAR();
            if (TPROBE == 12) tpacc_ += tp_now() - tpa_;
            if (TPROBE == 13) tpa_ = tp_now();
            const unsigned smv = smask[lane & 15];
#pragma unroll
            for (int w = 0; w < 8; ++w) {
                const unsigned mlo = (unsigned)__builtin_amdgcn_readlane((int)smv, 2 * w), mhi = (unsigned)__builtin_amdgcn_readlane((int)smv, 2 * w + 1);
                const unsigned long long mw = ((unsigned long long)mhi << 32) | mlo;
                if ((unsigned)(mw >> (8 * wid)) & 0xffu) {
                    const bool has = (myq < 32 ? (mlo >> myq) : (mhi >> (myq - 32))) & 1u;
                    const int j = __builtin_popcount(mlo & qmlo) + __builtin_popcount(mhi & qmhi);
                    const LAS float* sp = slot + (w * 32 + (has ? j : 0) * 4 + hd) * N_OSTR;
                    f32x4 v[2][4];
#pragma unroll
                    for (int dh = 0; dh < 2; ++dh)
#pragma unroll
                        for (int g4 = 0; g4 < 4; ++g4) v[dh][g4] = *(const LAS f32x4*)(sp + 32 * dh + 8 * g4 + 4 * hi);
                    const float lv = sp[64];
                    if (has) {
#pragma unroll
                        for (int dh = 0; dh < 2; ++dh)
#pragma unroll
                            for (int g4 = 0; g4 < 4; ++g4) { os[dh][4 * g4] += v[dh][g4].x; os[dh][4 * g4 + 1] += v[dh][g4].y; os[dh][4 * g4 + 2] += v[dh][g4].z; os[dh][4 * g4 + 3] += v[dh][g4].w; }
                        lfull += lv; }
                }
            }
            if (TPROBE == 13) tpacc_ += tp_now() - tpa_;
            LDS_BAR();
            it_b = nb_; it_p = np_;
        }
        TP_END(1, T.tp);
        if ((TPROBE == 11 || TPROBE == 12 || TPROBE == 13) && lane == 0) atomicAdd(T.tp, tpacc_);
#undef NSA_LDK
#undef NSA_LDV
#undef NSA_SCORE
#undef NSA_PV
        }
        { const float f = gs / (sum32sym(lpart) + lfull);
#pragma unroll
          for (int i = 0; i < 16; ++i) { oa[0][i] = f * os[0][i]; oa[1][i] = f * os[1][i]; } }
        { const bf16_t* qp = T.PROJ + (size_t)tq * 5632 + 768 + h8 * 64 + hi * 8;
#pragma unroll
          for (int d0 = 0; d0 < 4; ++d0) qf[d0] = *(const bf16x8*)(qp + d0 * 16); }
        __syncthreads();
    }
    {
        const bf16_t* kw = T.KW + (size_t)g * 16384 * 64; const bf16_t* vw = T.PROJ + 1920 + g * 64;
        const int kt0 = qblk > 8 ? qblk - 8 : 0, ntw = qblk - kt0 + 1;
        float lw = 0.f; f32x16 ow[2];
        TP_BEGIN(5)
        for (int rp_ = 0; rp_ < NSA_NREP(3); ++rp_) { lw = 0.f;
#pragma unroll
        for (int i = 0; i < 16; ++i) { ow[0][i] = 0.f; ow[1][i] = 0.f; }
#define WIN_LD(t, K_, V_) do { K_ = *(const u32x4*)(kw + (size_t)(64 * (t) + srow) * 64 + sch * 8); V_ = *(const u32x4*)(vw + (size_t)(64 * (t) + srow) * 5632 + sch * 8); } while (0)
        u32x4 kq, vq;
        WIN_LD(kt0, kr, vr);
        { LAS char* d_ = lds + srow * T_KS + sch * 16; *(LAS u32x4*)d_ = kr; *(LAS u32x4*)(d_ + T_KB) = vr; }
        kq = kr; vq = vr;
        if (1 < ntw) WIN_LD(kt0 + 1, kq, vq);
        LDS_BAR();
        for (int j = 0; j < ntw; ++j) {
            const bool more = j + 1 < ntw;
            if (j + 2 < ntw) WIN_LD(kt0 + j + 2, kr, vr);
            const LAS char* kt = lds + (j & 1) * T_BUF; const LAS char* vt = kt + T_KB;
            f32x16 p[2];
#pragma unroll
            for (int hh = 0; hh < 2; ++hh) { p[hh] = qk32<64, T_KS>(kt + (32 * hh + r32) * T_KS + hi * 16, qf);
#pragma unroll
                for (int r = 0; r < 16; ++r) { const int rel = tq - (64 * (kt0 + j) + 32 * hh + crow(r, hi)); const bool valid = rel >= 0 && rel < 512;
                    const float e = valid ? fast_exp2(p[hh][r] + lut[(rel < 0 ? 0 : rel) * 4 + hd] - ref) : 0.f; p[hh][r] = e; lw += e; } }
            pv64<T_KS>(ow, vt + vlane, p[0], p[1]);
            if (more) { LAS char* d_ = lds + ((j + 1) & 1) * T_BUF + srow * T_KS + sch * 16; *(LAS u32x4*)d_ = kq; *(LAS u32x4*)(d_ + T_KB) = vq; }
            kq = kr; vq = vr;
            LDS_BAR();
        }
#undef WIN_LD
        }
        TP_END(5, T.tp);
        lw = sum32sym(lw);
        const float f = gw / lw;
#pragma unroll
        for (int i = 0; i < 16; ++i) { oa[0][i] += f * ow[0][i]; oa[1][i] += f * ow[1][i]; }
        { const bf16_t* ap = T.ATT + (size_t)tq * 1024 + 256 + h8 * 64;
#pragma unroll
          for (int dh = 0; dh < 2; ++dh)
#pragma unroll
              for (int g4 = 0; g4 < 4; ++g4) { const u32x2 w = *(const u32x2*)(ap + 32 * dh + 8 * g4 + 4 * hi); oa[dh][4 * g4] += bflo(w.x); oa[dh][4 * g4 + 1] += bfhi(w.x); oa[dh][4 * g4 + 2] += bflo(w.y); oa[dh][4 * g4 + 3] += bfhi(w.y); } }
        store_ot(T.ATT + (size_t)tq * 1024 + 256 + h8 * 64, oa, hi);
    }
    __syncthreads();
    TP_END(6, T.tp);
}
}
constexpr int S = 16384, DM = 1024, NPROJ = 5632, INC = 5560, DFF = 2816, EFF = 3584, NEXP = 8;
constexpr int NWAVES = 8;
constexpr float EPS = 1e-6f;
constexpr float QK_SCALE64 = 0.125f * LOG2E;
constexpr float QK_SCALE96 = 0.10206207261596575f * LOG2E;
#ifndef MK_MULTI
#define MK_MULTI 0
#endif
constexpr int PC_SBQ = 0, PC_SBK = 256, PC_SBV = 512, PC_NQ = 768, PC_NKC = 1280, PC_NVC = 1408, PC_NKS = 1536, PC_NVS = 1664, PC_NKW = 1792, PC_NVW = 1920,
              PC_CQ = 2048, PC_CKV = 2304, PC_KR = 2432, PC_NG = 2464, PC_GATE = 2560;
__host__ __device__ __forceinline__ int win_oldcol(int c) {
    if (c < 2048) return c; if (c < 2464) return c + 24; if (c < 2488) return 2048 + (c - 2464); if (c < 2560) return -1; return c - 72; }

constexpr size_t MiB = 1u << 20;
constexpr size_t WS_CTL = 0, CTL_ZERO_BYTES = 1 * MiB;
constexpr size_t WS_LW = 1 * MiB, LW_STRIDE = 18 * MiB;
constexpr size_t LW_WIN = 0, LW_SBO = 11 * MiB, LW_NSAO = LW_SBO + MiB / 2, LW_MLAO = LW_NSAO + MiB, LW_WOUT = LW_MLAO + MiB / 2, LW_WUQ = LW_WOUT + 2 * MiB, LW_WUKV = LW_WUQ + MiB / 4, LW_CW1 = LW_WUKV + MiB / 4;
constexpr size_t WS_DGU = 37 * MiB, WS_DDN = 48 * MiB;
constexpr size_t WS_Y = 1 * MiB;
constexpr size_t WS_H = 74 * MiB;
constexpr size_t WS_ROPE = 106 * MiB;
constexpr size_t WS_LUT8 = 108 * MiB, WS_B1P = WS_LUT8 + 256 * 1024, WS_B1 = WS_LUT8 + 512 * 1024, WS_ROUTE = 109 * MiB, WS_ROWTOK = WS_ROUTE + 512 * 1024;
constexpr size_t WS_R1 = 110 * MiB;
constexpr size_t WS_MGU = WS_R1, WS_MDN = WS_R1 + 112 * MiB;
constexpr size_t WS_R2 = 296 * MiB;
constexpr size_t R2_KC = 0, R2_VC = R2_KC + 4 * MiB + MiB / 4, R2_KS = R2_VC + 4 * MiB + MiB / 4, R2_VTS = R2_KS + 4 * MiB, R2_KW = R2_VTS + 4 * MiB, R2_GN = R2_KW + 4 * MiB,
                 R2_QM = R2_GN + 2 * MiB, R2_KM = R2_QM + 12 * MiB, R2_HID = R2_KM + 12 * MiB, R2_KCMP = R2_HID + 2 * MiB, R2_VCMP = R2_KCMP + MiB / 4, R2_ATT = R2_VCMP + MiB / 4 + MiB / 2,
                 R2_MRG = R2_ATT + 32 * MiB, R2_QRAW = R2_MRG, R2_KVRAW = R2_MRG + 16 * MiB, R2_HIDP = R2_MRG + 32 * MiB  , R2_END = R2_HIDP + 16 * MiB;
static_assert(R2_END <= 136 * MiB, "attention scratch");
constexpr size_t WS_END = 432 * MiB;
constexpr int KC_ROWS = S + 32;
constexpr int CW_TMO = 0, CW_BAR = 4096, CW_MOECNT = 16384, CW_NSAQ = 17408, CW_SPLIT = 18432;
constexpr int RING_BYTES = 131072, LDSCTL_OFF = RING_BYTES, MISC_OFF = LDSCTL_OFF + 320, LDS_BYTES = 147456;


#define LDS_WAIT() asm volatile("s_waitcnt lgkmcnt(0)" ::: "memory")
#define VM_WAIT() asm volatile("s_waitcnt vmcnt(0)" ::: "memory")
DI float wave_sum(float v) { v += sx<1>(v); v += sx<2>(v); v += sx<4>(v); v += sx<8>(v); v += sx<16>(v); return sum32sym(v); }

struct TrSrc { const float* a; const float* b; int ldn; int nsrc; int mode; };
DI f32x4 tr_fetch4(const TrSrc& s, int k, int n) {
    const f32x4 z = {0.f, 0.f, 0.f, 0.f};
    if (s.mode == 0) return n < s.nsrc ? *(const f32x4*)(s.a + (size_t)k * s.ldn + n) : z;
    if (s.mode == 1) { const int oc = win_oldcol(n); return oc >= 0 ? *(const f32x4*)(s.a + (size_t)k * s.ldn + oc) : z; }
    const int tile = n >> 8, w = n & 255; const long d = (w < 128) ? 0l : (long)((const char*)s.b - (const char*)s.a);
    return *(const f32x4*)((const float*)((const char*)s.a + d) + (size_t)k * s.ldn + 128 * tile + (w & 127));
}
DI void tr_load(const TrSrc& s, int kb, int nb, int lane, f32x4 (&v)[8]) {
    const int k0 = 64 * kb, n0 = 32 * nb, r8 = lane >> 3, n4 = (lane & 7) * 4;
#pragma unroll
    for (int i = 0; i < 8; ++i) v[i] = tr_fetch4(s, k0 + r8 + 8 * i, n0 + n4);
}
DI void tr_store(const f32x4 (&v)[8], int K, bf16_t* WT, LAS float* scr, int kb, int nb, int lane) {
    const int k0 = 64 * kb, n0 = 32 * nb, r8 = lane >> 3, n4 = (lane & 7) * 4;
#pragma unroll
    for (int i = 0; i < 8; ++i) { LAS float* d = scr + (r8 + 8 * i) * 33 + n4; d[0] = v[i].x; d[1] = v[i].y; d[2] = v[i].z; d[3] = v[i].w; }
    LDS_WAIT(); asm volatile("" ::: "memory");
    const int c = lane & 7;
#pragma unroll
    for (int j = 0; j < 4; ++j) { const int n = (lane >> 3) + 8 * j; const LAS float* p = scr + (8 * c) * 33 + n;
        u32x4 o; o.x = cvtpk(p[0 * 33], p[1 * 33]); o.y = cvtpk(p[2 * 33], p[3 * 33]); o.z = cvtpk(p[4 * 33], p[5 * 33]); o.w = cvtpk(p[6 * 33], p[7 * 33]);
        *(u32x4*)(WT + (size_t)(n0 + n) * K + k0 + 8 * c) = o; }
    LDS_WAIT(); asm volatile("" ::: "memory");
}
DI void tr_item(const TrSrc& s, int K, bf16_t* WT, LAS float* scr, int kb, int nb, int lane) { f32x4 v[8]; tr_load(s, kb, nb, lane, v); tr_store(v, K, WT, scr, kb, nb, lane); }
DI void tr_matrix(const TrSrc& s, int K, int ndst, bf16_t* WT, LAS float* scr, int gw, int ngw, int lane, int& off) {
    const int nblk = ndst / 32, nitems = (K / 64) * nblk;
    int st = gw - off; if (st < 0) st += ngw;
    if (st < nitems) { f32x4 v[8], w[8]; tr_load(s, st / nblk, st % nblk, lane, v);
        for (int it = st; it < nitems; it += ngw) { const int nx = it + ngw; if (nx < nitems) tr_load(s, nx / nblk, nx % nblk, lane, w);
            tr_store(v, K, WT, scr, it / nblk, it % nblk, lane);
#pragma unroll
            for (int i = 0; i < 8; ++i) v[i] = w[i]; } }
    off = (off + nitems) % ngw;
}

DI void tr_batch(const float* a, const float* b, size_t sstride, int ldn, int nsrc, int mode, int K, int ndst, bf16_t* WT, size_t dstride, int nexp, LAS float* scr, int gw, int ngw, int lane, int& off) {
    const int nblk = ndst / 32, per = (K / 64) * nblk, nitems = nexp * per;
    int st = gw - off; if (st < 0) st += ngw;
    if (st < nitems) { f32x4 v[8], w[8];
        { const int e = st / per, r = st % per; tr_load(TrSrc{a + (size_t)e * sstride, b ? b + (size_t)e * sstride : nullptr, ldn, nsrc, mode}, r / nblk, r % nblk, lane, v); }
        for (int it = st; it < nitems; it += ngw) { const int nx = it + ngw;
            if (nx < nitems) { const int e = nx / per, r = nx % per; tr_load(TrSrc{a + (size_t)e * sstride, b ? b + (size_t)e * sstride : nullptr, ldn, nsrc, mode}, r / nblk, r % nblk, lane, w); }
            { const int e = it / per, r = it % per; tr_store(v, K, WT + (size_t)e * dstride, scr, r / nblk, r % nblk, lane); }
#pragma unroll
            for (int i = 0; i < 8; ++i) v[i] = w[i]; } }
    off = (off + nitems) % ngw;
}

struct In {
    const float *x, *bias_table, *mix_norm, *w_in, *b_gate, *sb_w_o, *nsa_q_norm, *nsa_k_norm, *nsa_cmp_pos, *nsa_cmp_w1, *nsa_cmp_w2, *nsa_w_o, *mla_q_a_norm, *mla_kv_a_norm,
        *mla_w_uq, *mla_w_ukv, *mla_q_norm, *mla_k_norm, *mla_w_o, *w_out, *ffn_norm, *dense_w_gate, *dense_w_up, *dense_w_down, *moe_router, *moe_w_gate, *moe_w_up, *moe_w_down;
};
struct Args { In in; float* out; unsigned char* ws; int ph_lo, ph_hi; };

DI void rms_row(const float* xrow, const float* gain, bf16_t* orow, int lane, f32x4 (&v)[4]) {
    const f32x4* xr = (const f32x4*)xrow + lane; float s = 0.f;
#pragma unroll
    for (int j = 0; j < 4; ++j) { v[j] = xr[64 * j]; s += (v[j].x * v[j].x + v[j].y * v[j].y) + (v[j].z * v[j].z + v[j].w * v[j].w); }
    const float rstd = 1.f / sqrtf(wave_sum(s) * (1.f / 1024.f) + EPS);
    u32x2* o8 = (u32x2*)orow + lane;
#pragma unroll
    for (int j = 0; j < 4; ++j) { const f32x4 g = ((const f32x4*)gain)[lane + 64 * j]; v[j] = v[j] * rstd * g; u32x2 w; w.x = cvtpk(v[j].x, v[j].y); w.y = cvtpk(v[j].z, v[j].w); o8[64 * j] = w; }
}

DI void rms_row2(const float* x0, const float* x1, const float* gain, bf16_t* o0, bf16_t* o1, int lane) {
    const f32x4* xa = (const f32x4*)x0 + lane; const f32x4* xb = (const f32x4*)x1 + lane; f32x4 a[4], b[4]; float sa = 0.f, sb = 0.f;
#pragma unroll
    for (int j = 0; j < 4; ++j) { a[j] = xa[64 * j]; b[j] = xb[64 * j]; }
#pragma unroll
    for (int j = 0; j < 4; ++j) { sa += (a[j].x * a[j].x + a[j].y * a[j].y) + (a[j].z * a[j].z + a[j].w * a[j].w); sb += (b[j].x * b[j].x + b[j].y * b[j].y) + (b[j].z * b[j].z + b[j].w * b[j].w); }
    const float ra = 1.f / sqrtf(wave_sum(sa) * (1.f / 1024.f) + EPS), rb = 1.f / sqrtf(wave_sum(sb) * (1.f / 1024.f) + EPS);
    u32x2* pa = (u32x2*)o0 + lane; u32x2* pb = (u32x2*)o1 + lane;
#pragma unroll
    for (int j = 0; j < 4; ++j) { const f32x4 g = ((const f32x4*)gain)[lane + 64 * j]; const f32x4 va = a[j] * ra * g, vb = b[j] * rb * g;
        u32x2 w; w.x = cvtpk(va.x, va.y); w.y = cvtpk(va.z, va.w); pa[64 * j] = w; w.x = cvtpk(vb.x, vb.y); w.y = cvtpk(vb.z, vb.w); pb[64 * j] = w; }
}

DI int t5_bucket(int n) {
    if (n < 16) return n;
    int b = 16;
    b += n >= 21; b += n >= 27; b += n >= 35; b += n >= 46; b += n >= 59; b += n >= 77; b += n >= 99; b += n >= 128; b += n >= 166; b += n >= 216; b += n >= 280; b += n >= 363; b += n >= 470; b += n >= 609; b += n >= 790;
    return b;
}

struct MoeTab { int cnt[8]; int tb[9]; };
struct MoeGU {
    const volatile LAS int* tab; const bf16_t* Hb; const bf16_t* W; const int* rowtok; int t_lo, t_hi, G, c;
    DI bool next(int i, pg8::Unit& u) const {
        const int nrt = t_hi - t_lo; if (nrt <= 0) return false;
        const long L = (long)i * G + c; if (L >= (long)nrt * 28) return false;
        const int rt = t_lo + (int)(L % nrt), pn = (int)(L / nrt);
        int e = 0;
#pragma unroll
        for (int k = 1; k < 8; ++k) e += (tab[8 + k] <= rt) ? 1 : 0;
        const int j = rt - tab[8 + e], cnt = tab[e];
        u.a = Hb; u.b = W + ((size_t)e * 7168 + 256 * pn) * 1024; u.rows = rowtok + e * S + 256 * j; u.nvalid = (cnt - 256 * j) < 256 ? (cnt - 256 * j) : 256; u.pm = rt - t_lo; u.pn = pn; return true;
    }
};
struct MoeDN {
    const volatile LAS int* tab; const bf16_t* ACT; const bf16_t* W; int t_lo, t_hi, G, c;
    DI bool next(int i, pg8::Unit& u) const {
        const int nrt = t_hi - t_lo; if (nrt <= 0) return false;
        const long L = (long)i * G + c; if (L >= (long)nrt * 4) return false;
        const int rt = t_lo + (int)(L % nrt), pn = (int)(L / nrt);
        int e = 0;
#pragma unroll
        for (int k = 1; k < 8; ++k) e += (tab[8 + k] <= rt) ? 1 : 0;
        u.a = ACT + (size_t)(rt - t_lo) * 256 * EFF; u.b = W + ((size_t)e * 1024 + 256 * pn) * EFF; u.rows = nullptr; u.nvalid = 256; u.pm = rt; u.pn = pn; return true;
    }
};
constexpr int PH_PER_LAYER = 16, NPHASES = 1 + 2 * PH_PER_LAYER;
__global__ void __launch_bounds__(NWAVES * 64, 2) fwd_kernel(Args args) {
    extern __shared__ __attribute__((aligned(16))) unsigned char lds_raw[];
    LAS unsigned char* lds = (LAS unsigned char*)lds_raw;
    volatile LAS unsigned* MISC = (volatile LAS unsigned*)(lds + MISC_OFF);
    volatile LAS int* MTAB = (volatile LAS int*)(lds + MISC_OFF + 64);
    const int tid0 = threadIdx.x, wave = __builtin_amdgcn_readfirstlane(tid0 >> 6);
    const int G = gridDim.x, bid = blockIdx.x, vcu = (G % 8 == 0) ? (bid % 8) * (G / 8) + bid / 8 : bid;
    const int gw0 = vcu * NWAVES + wave, NGW = G * NWAVES;
    unsigned char* ws = args.ws; const In in = args.in;
    gu32* ctl = (gu32*)(ws + WS_CTL);
    for (int u = tid0; u < (LDS_BYTES - LDSCTL_OFF) / 4; u += NWAVES * 64) ((LAS unsigned*)(lds + LDSCTL_OFF))[u] = 0u;
    __syncthreads();
#if MK_MULTI
#define GRID_BAR() do { } while (0)
#else
    XcdBarrier bar = xcd_barrier_post((unsigned*)(ctl + CW_BAR), MISC + 8);
#define TPCTR ((unsigned long long*)(ctl + 20480))
#define GRID_BAR() do { TP_BEGIN(9) xcd_barrier(bar); TP_END(9, TPCTR); } while (0)
#endif
    const int lo = args.ph_lo, hi = args.ph_hi;
#ifndef ONLY_PHASE
#define ONLY_PHASE -1
#endif
#ifndef PHMASK
#define PHMASK 0x1ffff
#endif
#define PHON(n) ((ONLY_PHASE < 0 || ONLY_PHASE == (n)) && ((PHMASK >> ((n) == 99 ? 16 : (n))) & 1))
#ifndef REPMASK
#define REPMASK 0
#endif
#ifndef GREP
#define GREP 0
#endif
#define REPN(n) (((REPMASK >> ((n) == 99 ? 16 : (n))) & 1) ? 2 : 1)
#define IN(k) (lo <= (k) && (k) < hi)
#define SEAM(k) do { if (IN((k) + 1)) { unsigned long long tq0_ = 0; const bool tpk_ = (TPROBE >= 100) && (TPROBE - 100 == ((k) == 0 ? 16 : ((k) - 1) % 16)); if (tpk_) tq0_ = tp_now(); GRID_BAR(); if (tpk_ && lane_id() == 0) atomicAdd(TPCTR, tp_now() - tq0_); } } while (0)
#define PHASE_LOCALS int tid = wave * 64 + lane_id(); asm volatile("" : "+v"(tid)); const int lane = tid & 63; int gw = gw0; asm volatile("" : "+s"(gw)); unsigned char* wsl = ws; asm volatile("" : "+s"(wsl)); (void)lane; (void)gw; (void)wsl;

#define lw (wsl + WS_LW + (size_t)l * LW_STRIDE)
#define Hb ((bf16_t*)(wsl + WS_H))
#define PROJ ((bf16_t*)(wsl + WS_R1))
#define R2P(off) (wsl + WS_R2 + (off))
#define KC ((bf16_t*)R2P(R2_KC))
#define VC ((bf16_t*)R2P(R2_VC))
#define KS ((bf16_t*)R2P(R2_KS))
#define VTS ((bf16_t*)R2P(R2_VTS))
#define KW ((bf16_t*)R2P(R2_KW))
#define GN ((float*)R2P(R2_GN))
#define QM ((bf16_t*)R2P(R2_QM))
#define KM ((bf16_t*)R2P(R2_KM))
#define HID ((bf16_t*)R2P(R2_HID))
#define KCMP ((bf16_t*)R2P(R2_KCMP))
#define VCMP ((bf16_t*)R2P(R2_VCMP))
#define ATT ((bf16_t*)R2P(R2_ATT))
#define MRG ((bf16_t*)R2P(R2_MRG))
#define QRAW ((bf16_t*)R2P(R2_QRAW))
#define KVRAW ((bf16_t*)R2P(R2_KVRAW))
#define HIDP ((float*)R2P(R2_HIDP))
#define ROPE ((float*)(wsl + WS_ROPE))
#define LUT8 ((float*)(wsl + WS_LUT8))
#define B1P ((float*)(wsl + WS_B1P))
#define B1 ((float*)(wsl + WS_B1))
#define CONS (B1 + 2048)
#define ROUTE ((int*)(wsl + WS_ROUTE))
#define ROWTOK ((int*)(wsl + WS_ROWTOK))
    LAS float* scr = (LAS float*)(lds + wave * 16384);

    if (PHON(99) && IN(0)) { PHASE_LOCALS TP_BEGIN(36) for (int rep_ = 0; rep_ < REPN(99); ++rep_) {
        int troff = 0;
        for (int l = 0; l < 2; ++l) {
            tr_matrix(TrSrc{in.w_in + (size_t)l * 1024 * INC, nullptr, INC, INC, 1}, 1024, NPROJ, (bf16_t*)(lw + LW_WIN), scr, gw, NGW, lane, troff);
            tr_matrix(TrSrc{in.sb_w_o + (size_t)l * 256 * 1024, nullptr, 1024, 1024, 0}, 256, 1024, (bf16_t*)(lw + LW_SBO), scr, gw, NGW, lane, troff);
            tr_matrix(TrSrc{in.nsa_w_o + (size_t)l * 512 * 1024, nullptr, 1024, 1024, 0}, 512, 1024, (bf16_t*)(lw + LW_NSAO), scr, gw, NGW, lane, troff);
            tr_matrix(TrSrc{in.mla_w_o + (size_t)l * 256 * 1024, nullptr, 1024, 1024, 0}, 256, 1024, (bf16_t*)(lw + LW_MLAO), scr, gw, NGW, lane, troff);
            tr_matrix(TrSrc{in.w_out + (size_t)l * 1024 * 1024, nullptr, 1024, 1024, 0}, 1024, 1024, (bf16_t*)(lw + LW_WOUT), scr, gw, NGW, lane, troff);
            tr_matrix(TrSrc{in.mla_w_uq + (size_t)l * 256 * 384, nullptr, 384, 384, 0}, 256, 512, (bf16_t*)(lw + LW_WUQ), scr, gw, NGW, lane, troff);
            tr_matrix(TrSrc{in.mla_w_ukv + (size_t)l * 128 * 512, nullptr, 512, 512, 0}, 128, 512, (bf16_t*)(lw + LW_WUKV), scr, gw, NGW, lane, troff);
            for (int kv = 0; kv < 2; ++kv)
                tr_matrix(TrSrc{in.nsa_cmp_w1 + (size_t)(l * 2 + kv) * 2048 * 256, nullptr, 256, 256, 0}, 2048, 256, (bf16_t*)(lw + LW_CW1) + (size_t)kv * 256 * 2048, scr, gw, NGW, lane, troff);
        }
        tr_matrix(TrSrc{in.dense_w_gate, in.dense_w_up, DFF, DFF, 2}, 1024, 2 * DFF, (bf16_t*)(wsl + WS_DGU), scr, gw, NGW, lane, troff);
        tr_matrix(TrSrc{in.dense_w_down, nullptr, 1024, 1024, 0}, DFF, 1024, (bf16_t*)(wsl + WS_DDN), scr, gw, NGW, lane, troff);
        const int gt = vcu * 512 + tid, NT = G * 512;
        for (int i = gt; i < S * 16; i += NT) {
            const int pos = i >> 4, fi = i & 15; const float inv = powf(10000.f, -(float)fi / 16.f); const float ang = (float)pos * inv;
            const double rev = (double)ang * 0.15915494309189535; const float fr = (float)(rev - rint(rev));
            ROPE[i] = __builtin_amdgcn_cosf(fr); ROPE[S * 16 + i] = __builtin_amdgcn_sinf(fr); }
        for (int i = gt; i < 1024 * 8; i += NT) LUT8[i] = in.bias_table[t5_bucket(i >> 3) * 8 + (i & 7)] * LOG2E;
        if (gw == 0) {
            float bm = 0.f; for (int i = lane; i < 256; i += 64) bm = fmaxf(bm, fabsf(in.bias_table[i]));
            bm = fmaxf(bm, sx<1>(bm)); bm = fmaxf(bm, sx<2>(bm)); bm = fmaxf(bm, sx<4>(bm)); bm = fmaxf(bm, sx<8>(bm)); bm = fmaxf(bm, sx<16>(bm)); bm = fmaxf(bm, sx32(bm, lane >> 5));
            if (lane == 0) CONS[0] = bm * LOG2E;
            for (int ll = 0; ll < 2; ++ll) { float gm = 0.f; for (int i = lane; i < 192; i += 64) gm = fmaxf(gm, fabsf(in.nsa_k_norm[ll * 192 + i]));
                gm = fmaxf(gm, sx<1>(gm)); gm = fmaxf(gm, sx<2>(gm)); gm = fmaxf(gm, sx<4>(gm)); gm = fmaxf(gm, sx<8>(gm)); gm = fmaxf(gm, sx<16>(gm)); gm = fmaxf(gm, sx32(gm, lane >> 5));
                if (lane == 0) CONS[1 + ll] = gm;
                float km = 0.f; for (int i = lane; i < 96; i += 64) km = fmaxf(km, fabsf(in.mla_k_norm[ll * 96 + i]));
                km = fmaxf(km, sx<1>(km)); km = fmaxf(km, sx<2>(km)); km = fmaxf(km, sx<4>(km)); km = fmaxf(km, sx<8>(km)); km = fmaxf(km, sx<16>(km)); km = fmaxf(km, sx32(km, lane >> 5));
                if (lane == 0) CONS[3 + ll] = km; }
        }
        for (int it = gw; it < 512; it += NGW) {
            const int kc = it & 31, cb = (it >> 5) & 3, lk = it >> 7; const float* pos = in.nsa_cmp_pos + (size_t)lk * 2048; const float* w1 = in.nsa_cmp_w1 + (size_t)lk * 2048 * 256;
            float wv_[64];
#pragma unroll
            for (int k = 0; k < 64; ++k) wv_[k] = w1[(size_t)(64 * kc + k) * 256 + 64 * cb + lane];
            float a = 0.f;
#pragma unroll
            for (int k = 0; k < 64; ++k) a += pos[64 * kc + k] * wv_[k];
            B1P[(lk * 32 + kc) * 256 + 64 * cb + lane] = a; }
        for (int i = gt; i < 2 * 2 * 32 * 64 / 8; i += NT) { const int z = i / 256, r = i % 256; bf16_t* p = (z >> 1 ? VC : KC) + ((size_t)(z & 1) * KC_ROWS + S) * 64 + r * 8; *(u32x4*)p = (u32x4){0u, 0u, 0u, 0u}; }
        { int m = gw; for (; m + NGW < S; m += 2 * NGW) rms_row2(in.x + (size_t)m * 1024, in.x + (size_t)(m + NGW) * 1024, in.mix_norm, Hb + (size_t)m * 1024, Hb + (size_t)(m + NGW) * 1024, lane);
          for (; m < S; m += NGW) { f32x4 v[4]; rms_row(in.x + (size_t)m * 1024, in.mix_norm, Hb + (size_t)m * 1024, lane, v); } }
            }
            TP_END(36, TPCTR);
        SEAM(0);
    }

    for (int l = 0; l < 2; ++l) {
        const int pb = 1 + PH_PER_LAYER * l;
        const float* x_in = (l == 0) ? in.x : args.out; float* x_out = args.out;
        if (l > 0 && PHON(0) && IN(pb + 0)) { PHASE_LOCALS TP_BEGIN(20) for (int rep_ = 0; rep_ < REPN(0); ++rep_) {
            { int m = gw; for (; m + NGW < S; m += 2 * NGW) rms_row2(x_in + (size_t)m * 1024, x_in + (size_t)(m + NGW) * 1024, in.mix_norm + l * 1024, Hb + (size_t)m * 1024, Hb + (size_t)(m + NGW) * 1024, lane);
              for (; m < S; m += NGW) { f32x4 v[4]; rms_row(x_in + (size_t)m * 1024, in.mix_norm + l * 1024, Hb + (size_t)m * 1024, lane, v); } }
            }
            TP_END(20, TPCTR);
            SEAM(pb + 0);
        }
        if (PHON(1) && IN(pb + 1)) { PHASE_LOCALS TP_BEGIN(21) for (int rep_ = 0; rep_ < REPN(1); ++rep_) {
            pg8::StaticOrder So; So.init(Hb, (const bf16_t*)(lw + LW_WIN), 1024, 1024, S, NPROJ - 512, G, bid);
            pg8::EpiStore E{PROJ, NPROJ, nullptr, QK_SCALE64, 0};
            pg8::gemm_phase<pg8::EpiStore, pg8::StaticOrder, true, false>(lds, 1024, 1024, 1024, So, E, wave);
#if GREP & 1
            pg8::gemm_phase<pg8::EpiStore, pg8::StaticOrder, true, false>(lds, 1024, 1024, 1024, So, E, wave);
#endif
            }
            TP_END(21, TPCTR);
            SEAM(pb + 1);
        }
        if (PHON(2) && IN(pb + 2)) { PHASE_LOCALS TP_BEGIN(22) for (int rep_ = 0; rep_ < REPN(2); ++rep_) {
            if (l == 0 && bid < 2) { const int i = bid * 512 + tid; float pv_[32];
#pragma unroll
                for (int kc = 0; kc < 32; ++kc) pv_[kc] = B1P[((i >> 8) * 32 + kc) * 256 + (i & 255)];
                float a = 0.f;
#pragma unroll
                for (int kc = 0; kc < 32; ++kc) a += pv_[kc];
                B1[i] = a; }
            float gq_[8], gk_[8], ga_[4], gb_[2];
            { const int sec_ = lane >> 4, d8_ = 8 * (lane & 7);
#pragma unroll
              for (int e = 0; e < 8; ++e) { gq_[e] = in.nsa_q_norm[l * 64 + 8 * (lane & 7) + e]; gk_[e] = in.nsa_k_norm[(l * 3 + 1 + (sec_ & 1)) * 64 + d8_ + e]; }
#pragma unroll
              for (int e = 0; e < 4; ++e) ga_[e] = in.mla_q_a_norm[l * 256 + lane * 4 + e];
              gb_[0] = in.mla_kv_a_norm[l * 128 + lane * 2]; gb_[1] = in.mla_kv_a_norm[l * 128 + lane * 2 + 1]; }
            auto a3_token = [&](const int t) __attribute__((always_inline)) {
                bf16_t* pr = PROJ + (size_t)t * NPROJ;
                {
                    const u32x4 w = *(const u32x4*)(pr + PC_NQ + lane * 8); float v[8] = {bflo(w.x), bfhi(w.x), bflo(w.y), bfhi(w.y), bflo(w.z), bfhi(w.z), bflo(w.w), bfhi(w.w)};
                    float ss = 0.f;
#pragma unroll
                    for (int e = 0; e < 8; ++e) ss += v[e] * v[e];
                    ss += sx<1>(ss); ss += sx<2>(ss); ss += sx<4>(ss);
                    const float rs = QK_SCALE64 / sqrtf(ss * (1.f / 64.f) + EPS); const float* gq = gq_;
                    u32x4 o; o.x = cvtpk(v[0] * rs * gq[0], v[1] * rs * gq[1]); o.y = cvtpk(v[2] * rs * gq[2], v[3] * rs * gq[3]); o.z = cvtpk(v[4] * rs * gq[4], v[5] * rs * gq[5]); o.w = cvtpk(v[6] * rs * gq[6], v[7] * rs * gq[7]);
                    *(u32x4*)(pr + PC_NQ + lane * 8) = o;
                }
                {
                    const int sec = lane >> 4, gg = (lane >> 3) & 1, d8 = 8 * (lane & 7);
                    const int col = (sec == 0 ? PC_NKS : sec == 1 ? PC_NKW : sec == 2 ? PC_NKC : PC_NVC) + (lane & 15) * 8;
                    const u32x4 w = *(const u32x4*)(pr + col); float v[8] = {bflo(w.x), bfhi(w.x), bflo(w.y), bfhi(w.y), bflo(w.z), bfhi(w.z), bflo(w.w), bfhi(w.w)};
                    float ss = 0.f;
#pragma unroll
                    for (int e = 0; e < 8; ++e) ss += v[e] * v[e];
                    ss += sx<1>(ss); ss += sx<2>(ss); ss += sx<4>(ss);
                    const float rs = 1.f / sqrtf(ss * (1.f / 64.f) + EPS);
                    u32x4 o = w;
                    if (sec < 2) { const float* gk = gk_;
                        o.x = cvtpk(v[0] * rs * gk[0], v[1] * rs * gk[1]); o.y = cvtpk(v[2] * rs * gk[2], v[3] * rs * gk[3]); o.z = cvtpk(v[4] * rs * gk[4], v[5] * rs * gk[5]); o.w = cvtpk(v[6] * rs * gk[6], v[7] * rs * gk[7]); }
                    const int c8 = lane & 7; const size_t ksf = ((((size_t)(gg * 256 + (t >> 6)) * 2 + ((t >> 5) & 1)) * 4 + (c8 >> 1)) * 64 + (c8 & 1) * 32 + (t & 31)) * 8;
                    bf16_t* dst = (sec == 0 ? KS + ksf : (sec == 1 ? KW + ((size_t)gg * S + t) * 64 : sec == 2 ? KC + ((size_t)gg * KC_ROWS + t) * 64 : VC + ((size_t)gg * KC_ROWS + t) * 64) + d8);
                    *(u32x4*)dst = o;
                }
                {
                    const u32x2 w = *(const u32x2*)(pr + PC_CQ + lane * 4); float v[4] = {bflo(w.x), bfhi(w.x), bflo(w.y), bfhi(w.y)};
                    const float rs = 1.f / sqrtf(wave_sum((v[0] * v[0] + v[1] * v[1]) + (v[2] * v[2] + v[3] * v[3])) * (1.f / 256.f) + EPS); const float* ga = ga_;
                    u32x2 o; o.x = cvtpk(v[0] * rs * ga[0], v[1] * rs * ga[1]); o.y = cvtpk(v[2] * rs * ga[2], v[3] * rs * ga[3]); *(u32x2*)(pr + PC_CQ + lane * 4) = o;
                    const unsigned w2 = *(const unsigned*)(pr + PC_CKV + lane * 2); const float a = bflo(w2), b = bfhi(w2);
                    const float rs2 = 1.f / sqrtf(wave_sum(a * a + b * b) * (1.f / 128.f) + EPS); const float* gb = gb_;
                    *(unsigned*)(pr + PC_CKV + lane * 2) = cvtpk(a * rs2 * gb[0], b * rs2 * gb[1]);
                }
                if (lane < 24) GN[(size_t)t * 24 + lane] = sigmoidf_(bf2f(pr[PC_NG + lane]));

            };
            { int t0 = gw; for (; t0 + NGW < S; t0 += 2 * NGW) { a3_token(t0); a3_token(t0 + NGW); } for (; t0 < S; t0 += NGW) a3_token(t0); }
            for (int it = gw; it < 4096; it += NGW) {
                const int gg = it >> 11, blk = (it >> 3) & 255, s8 = it & 7; const bf16_t* src = PROJ + (size_t)(blk * 64) * NPROJ + PC_NVS + gg * 64 + lane; bf16_t* dstb = VTS + (size_t)(gg * 256 + blk) * 4096;
                unsigned short e[8];
#pragma unroll
                for (int j = 0; j < 8; ++j) { const int k = att::vts_key_of_slot(8 * s8 + j); e[j] = src[(size_t)k * NPROJ]; }
                u32x4 o; o.x = e[0] | ((unsigned)e[1] << 16); o.y = e[2] | ((unsigned)e[3] << 16); o.z = e[4] | ((unsigned)e[5] << 16); o.w = e[6] | ((unsigned)e[7] << 16);
                const int hh = s8 >> 2, ss = (s8 >> 1) & 1, h = s8 & 1;
                *(u32x4*)(dstb + ((((hh * 2 + (lane >> 5)) * 2 + ss) * 64) + h * 32 + (lane & 31)) * 8) = o;
            }
            }
            TP_END(22, TPCTR);
            SEAM(pb + 2);
        }
        if (PHON(3) && IN(pb + 3)) { PHASE_LOCALS TP_BEGIN(23) for (int rep_ = 0; rep_ < REPN(3); ++rep_) {
            const bool wide = (G >= 256);
            for (int job = 0; job < 3; ++job) {
                pg8::StaticOrder So; pg8::EpiStore E; int lda, ldb, K;
                if (job == 2) { lda = 1024; ldb = 1024; K = 1024; So.init(Hb, (const bf16_t*)(lw + LW_WIN) + (size_t)(NPROJ - 512) * 1024, lda, ldb, S, 512, wide ? 128 : G, wide ? (bid < 64 ? bid : (bid >= 192 && bid < 256 ? bid - 128 : -1)) : bid); E = pg8::EpiStore{PROJ + (NPROJ - 512), NPROJ, nullptr, 1.f, 0}; }
                else if (job == 0) { lda = NPROJ; ldb = 256; K = 256; So.init(PROJ + PC_CQ, (const bf16_t*)(lw + LW_WUQ), lda, ldb, S, 512, wide ? 128 : G, wide ? (bid < 128 ? bid : -1) : bid); E = pg8::EpiStore{QRAW, 512, nullptr, 1.f, 0}; }
                else { lda = NPROJ; ldb = 128; K = 128; So.init(PROJ + PC_CKV, (const bf16_t*)(lw + LW_WUKV), lda, ldb, S, 512, wide ? 128 : G, wide ? (bid >= 128 && bid < 256 ? bid - 128 : -1) : bid); E = pg8::EpiStore{KVRAW, 512, nullptr, 1.f, 0}; }
                pg8::gemm_phase<pg8::EpiStore, pg8::StaticOrder, true, false>(lds, lda, ldb, K, So, E, wave);
#if GREP & 16
                pg8::gemm_phase<pg8::EpiStore, pg8::StaticOrder, true, false>(lds, lda, ldb, K, So, E, wave);
#endif
            }
            for (int jz = 0; jz < 16; ++jz) {
                const int z = jz >> 2, ks = jz & 3, kv = z >> 1, gg = z & 1;
                pg8::StaticOrder So; So.init((kv ? VC : KC) + (size_t)gg * KC_ROWS * 64 + ks * 512, (const bf16_t*)(lw + LW_CW1) + (size_t)kv * 256 * 2048 + ks * 512, 1024, 2048, 1024, 256, wide ? 4 : G, wide ? ((bid >= 128 + 4 * jz && bid < 132 + 4 * jz) ? bid - 128 - 4 * jz : -1) : bid);
                pg8::EpiF32 E{HIDP + (size_t)jz * 1024 * 256, 256};
                pg8::gemm_phase<pg8::EpiF32, pg8::StaticOrder, true, false>(lds, 1024, 2048, 512, So, E, wave);
            }
            }
            TP_END(23, TPCTR);
            SEAM(pb + 3);
        }
        if (PHON(4) && IN(pb + 4)) { PHASE_LOCALS TP_BEGIN(24) for (int rep_ = 0; rep_ < REPN(4); ++rep_) {
            const int kvb = (2 * vcu >= G) ? 1 : 0;
            { const float* w2g = in.nsa_cmp_w2 + (size_t)(l * 2 + kvb) * 256 * 64; LAS f32x4* w2l = (LAS f32x4*)lds;
#pragma unroll
              for (int i = 0; i < 8; ++i) w2l[tid + 512 * i] = *(const f32x4*)(w2g + (size_t)(tid + 512 * i) * 4); }
            __syncthreads();
            LAS unsigned short* ws16 = (LAS unsigned short*)(lds + 65536 + wave * 4096);
            float g5q_[6], g5k_[6];
#pragma unroll
            for (int e = 0; e < 6; ++e) { g5q_[e] = in.mla_q_norm[l * 96 + (lane & 15) + 16 * e]; g5k_[e] = in.mla_k_norm[l * 96 + (lane & 15) + 16 * e]; }
            for (int t = gw; t < S; t += NGW) {
                if (lane < 48) *(LAS u32x4*)(ws16 + 8 * lane) = *(const u32x4*)(QRAW + (size_t)t * 512 + 8 * lane);
                if (lane < 32) *(LAS u32x4*)(ws16 + 384 + (lane >> 3) * 96 + (lane & 7) * 8) = *(const u32x4*)(KVRAW + (size_t)t * 512 + (lane >> 3) * 128 + (lane & 7) * 8);
                else if (lane < 48) { const int hh_ = (lane - 32) >> 2, c_ = lane & 3; *(LAS u32x4*)(ws16 + 384 + hh_ * 96 + 64 + c_ * 8) = *(const u32x4*)(PROJ + (size_t)t * NPROJ + PC_KR + c_ * 8); }
                LDS_WAIT(); asm volatile("" ::: "memory");
                const int hd = lane >> 4, i = lane & 15; const float c = ROPE[t * 16 + i], s = ROPE[S * 16 + t * 16 + i];
                {   LAS unsigned short* src = ws16 + hd * 96 + i; float v[6]; float ss = 0.f;
#pragma unroll
                    for (int e = 0; e < 6; ++e) { v[e] = bf2f(src[16 * e]); ss += v[e] * v[e]; }
                    ss += sx<1>(ss); ss += sx<2>(ss); ss += sx<4>(ss); ss += sx<8>(ss);
                    const float rs = 1.f / sqrtf(ss * (1.f / 96.f) + EPS);
#pragma unroll
                    for (int e = 0; e < 6; ++e) v[e] = v[e] * rs * g5q_[e];
                    const float x1 = v[4], x2 = v[5]; v[4] = x1 * c - x2 * s; v[5] = x2 * c + x1 * s;
#pragma unroll
                    for (int e = 0; e < 6; ++e) src[16 * e] = f2bf(v[e] * QK_SCALE96); }
                {   LAS unsigned short* src = ws16 + 384 + hd * 96 + i; float v[6]; float ss = 0.f;
#pragma unroll
                    for (int e = 0; e < 6; ++e) { v[e] = bf2f(src[16 * e]); ss += v[e] * v[e]; }
                    ss += sx<1>(ss); ss += sx<2>(ss); ss += sx<4>(ss); ss += sx<8>(ss);
                    const float rs = 1.f / sqrtf(ss * (1.f / 96.f) + EPS);
#pragma unroll
                    for (int e = 0; e < 6; ++e) v[e] = v[e] * rs * g5k_[e];
                    const float x1 = v[4], x2 = v[5]; v[4] = x1 * c - x2 * s; v[5] = x2 * c + x1 * s;
#pragma unroll
                    for (int e = 0; e < 6; ++e) src[16 * e] = f2bf(v[e]); }
                LDS_WAIT(); asm volatile("" ::: "memory");
                if (lane < 48) { *(u32x4*)(QM + (size_t)t * 384 + 8 * lane) = *(const LAS u32x4*)(ws16 + 8 * lane); *(u32x4*)(KM + (size_t)t * 384 + 8 * lane) = *(const LAS u32x4*)(ws16 + 384 + 8 * lane); }
                LDS_WAIT(); asm volatile("" ::: "memory");
            }
            {
                LAS float* hs = (LAS float*)(lds + 65536 + wave * 4096); const LAS float* w2l = (const LAS float*)lds;
                const int hw = (kvb ? vcu - G / 2 : vcu) * NWAVES + wave, nhw = (kvb ? G - G / 2 : G / 2) * NWAVES;
                for (int it = hw; it < 2048; it += nhw) {
                    const int gg = it >> 10, n = it & 1023, z = kvb * 2 + gg;
                    { f32x4 hsum = *(const f32x4*)(B1 + (l * 2 + kvb) * 256 + lane * 4);
#pragma unroll
                      for (int ks = 0; ks < 4; ++ks) hsum += *(const f32x4*)(HIDP + ((size_t)(z * 4 + ks) * 1024 + n) * 256 + lane * 4);
                      *(LAS f32x4*)(hs + lane * 4) = (f32x4){siluf_(hsum.x), siluf_(hsum.y), siluf_(hsum.z), siluf_(hsum.w)}; }
                    LDS_WAIT(); asm volatile("" ::: "memory");
                    float a0 = 0.f, a1 = 0.f, a2 = 0.f, a3 = 0.f;
#pragma unroll 4
                    for (int j = 0; j < 256; j += 4) { const f32x4 h4 = *(const LAS f32x4*)(hs + j);
                        a0 += h4.x * w2l[j * 64 + lane]; a1 += h4.y * w2l[(j + 1) * 64 + lane]; a2 += h4.z * w2l[(j + 2) * 64 + lane]; a3 += h4.w * w2l[(j + 3) * 64 + lane]; }
                    const float a = (a0 + a1) + (a2 + a3);
                    if (kvb == 0) { const float rs = 1.f / sqrtf(wave_sum(a * a) * (1.f / 64.f) + EPS); KCMP[((size_t)gg * 1024 + n) * 64 + lane] = f2bf(a * rs * in.nsa_k_norm[(l * 3) * 64 + lane]); }
                    else VCMP[((size_t)gg * 1024 + n) * 64 + lane] = f2bf(a);
                    LDS_WAIT(); asm volatile("" ::: "memory");
                }
            }
            __syncthreads();
            }
            TP_END(24, TPCTR);
            SEAM(pb + 4);
        }
        if (PHON(5) && IN(pb + 5)) { PHASE_LOCALS TP_BEGIN(25) for (int rep_ = 0; rep_ < REPN(5); ++rep_) {
            __syncthreads();
            for (int r2_ = 0; r2_ < REPN(17); ++r2_) for (int u = vcu; u < 256; u += G) att::sb_unit((LAS char*)lds, PROJ, ATT, u >> 6, u & 63, wave);
            for (int r2_ = 0; r2_ < REPN(18); ++r2_) for (int p = vcu; p < 256; p += G) { const float mkb = 9.9f * CONS[3 + l]; att::mla_unit((LAS char*)lds, QM, KM, KVRAW, ATT, p >> 6, 127 - (p & 63), mkb, wave, TPCTR); att::mla_unit((LAS char*)lds, QM, KM, KVRAW, ATT, p >> 6, p & 63, mkb, wave, TPCTR); }
            att::NsaT T{PROJ, KCMP, VCMP, KS, VTS, KW, GN, LUT8, ATT, 8.08f * CONS[1 + l], CONS[0], (unsigned long long*)(ctl + 20480)};
            for (int r2_ = 0; r2_ < REPN(19); ++r2_) { volatile LAS int* qslot = (volatile LAS int*)(lds + MISC_OFF + 192); const int qg = (2 * vcu >= G) ? 1 : 0;
                __syncthreads(); att::nsa_load_lut((LAS char*)lds, LUT8, qg, tid);
                for (;;) { __syncthreads(); if (tid == 0) *qslot = (int)__hip_atomic_fetch_add(ctl + CW_NSAQ + 64 * (4 * l + 2 * r2_ + qg), 1u, RLX_AGENT); __syncthreads();
                    const int u = *qslot; if (u >= 256) break; att::nsa_unit((LAS char*)lds, T, qg, 255 - u, wave); } }
            }
            TP_END(25, TPCTR);
            SEAM(pb + 5);
        }
        if (PHON(6) && IN(pb + 6)) { PHASE_LOCALS TP_BEGIN(26) for (int rep_ = 0; rep_ < REPN(6); ++rep_) {
            for (int mix = 0; mix < 3; ++mix) {
                const int K = (mix == 1) ? 512 : 256; const int acol = (mix == 0) ? 0 : (mix == 1) ? 256 : 768;
                const bf16_t* Bt = (const bf16_t*)(lw + (mix == 0 ? LW_SBO : mix == 1 ? LW_NSAO : LW_MLAO));
                pg8::StaticOrder So; So.init(ATT + acol, Bt, 1024, K, S, 1024, G, bid);
                pg8::EpiGate E{MRG, PROJ + PC_GATE + mix * 1024, NPROJ, in.b_gate + l * 3072 + mix * 1024, mix == 0 ? 1 : 0};
                pg8::gemm_phase<pg8::EpiGate, pg8::StaticOrder, true, false>(lds, 1024, K, K, So, E, wave);
            }
            }
            TP_END(26, TPCTR);
            SEAM(pb + 6);
        }
        if (PHON(7) && IN(pb + 7)) { PHASE_LOCALS TP_BEGIN(27) for (int rep_ = 0; rep_ < REPN(7); ++rep_) {
            pg8::StaticOrder So; So.init(MRG, (const bf16_t*)(lw + LW_WOUT), 1024, 1024, S, 1024, G, bid);
            pg8::EpiResid E{x_in, x_out};
            pg8::gemm_phase<pg8::EpiResid, pg8::StaticOrder, true, false>(lds, 1024, 1024, 1024, So, E, wave);
            }
            TP_END(27, TPCTR);
            SEAM(pb + 7);
        }
        if (PHON(8) && IN(pb + 8)) { PHASE_LOCALS TP_BEGIN(28) for (int rep_ = 0; rep_ < REPN(8); ++rep_) {
            if (l == 1) {
                int troff = 0;
                tr_batch(in.moe_w_gate, in.moe_w_up, (size_t)1024 * EFF, EFF, EFF, 2, 1024, 2 * EFF, (bf16_t*)(wsl + WS_MGU), (size_t)7168 * 1024, 8, scr, gw, NGW, lane, troff);
                tr_batch(in.moe_w_down, nullptr, (size_t)EFF * 1024, 1024, 1024, 0, EFF, 1024, (bf16_t*)(wsl + WS_MDN), (size_t)1024 * EFF, 8, scr, gw, NGW, lane, troff);
            }
            LAS float* rtl = (LAS float*)(lds + 65536); LAS unsigned* lcnt = (LAS unsigned*)(lds + 98304); LAS int* rec = (LAS int*)(lds + 98304 + 64);
            if (l == 1) { __syncthreads();
#pragma unroll
                for (int i = 0; i < 4; ++i) ((LAS f32x4*)rtl)[tid + 512 * i] = *(const f32x4*)(in.moe_router + (size_t)(tid + 512 * i) * 4);
                if (tid < 16) lcnt[tid] = 0u;
                __syncthreads(); }
            f32x4 gn_[4];
#pragma unroll
            for (int j = 0; j < 4; ++j) gn_[j] = ((const f32x4*)(in.ffn_norm + l * 1024))[lane + 64 * j];
            int nrec = 0;
            for (int m = gw; m < S; m += NGW, ++nrec) {
                f32x4 v[4];
                { const f32x4* xr = (const f32x4*)(x_out + (size_t)m * 1024) + lane; float ssq = 0.f;
#pragma unroll
                  for (int j = 0; j < 4; ++j) { v[j] = xr[64 * j]; ssq += (v[j].x * v[j].x + v[j].y * v[j].y) + (v[j].z * v[j].z + v[j].w * v[j].w); }
                  const float rstd = 1.f / sqrtf(wave_sum(ssq) * (1.f / 1024.f) + EPS); u32x2* o8 = (u32x2*)(Hb + (size_t)m * 1024) + lane;
#pragma unroll
                  for (int j = 0; j < 4; ++j) { v[j] = v[j] * rstd * gn_[j]; u32x2 w; w.x = cvtpk(v[j].x, v[j].y); w.y = cvtpk(v[j].z, v[j].w); o8[64 * j] = w; } }
                if (l == 1) {
                    float lg[8];
#pragma unroll
                    for (int e = 0; e < 8; ++e) lg[e] = 0.f;
#pragma unroll
                    for (int j = 0; j < 4; ++j)
#pragma unroll
                        for (int q = 0; q < 4; ++q) { const LAS float* wr = rtl + (4 * lane + 256 * j + q) * 8; const f32x4 wa = *(const LAS f32x4*)wr, wb = *(const LAS f32x4*)(wr + 4); const float hv = v[j][q];
                            lg[0] += hv * wa.x; lg[1] += hv * wa.y; lg[2] += hv * wa.z; lg[3] += hv * wa.w; lg[4] += hv * wb.x; lg[5] += hv * wb.y; lg[6] += hv * wb.z; lg[7] += hv * wb.w; }
#pragma unroll
                    for (int e = 0; e < 8; ++e) lg[e] = wave_sum(lg[e]);
                    int e0 = 0; float v0 = lg[0];
#pragma unroll
                    for (int e = 1; e < 8; ++e) if (lg[e] > v0) { v0 = lg[e]; e0 = e; }
                    int e1 = -1; float v1 = -INFINITY;
#pragma unroll
                    for (int e = 0; e < 8; ++e) if (e != e0 && lg[e] > v1) { v1 = lg[e]; e1 = e; }
                    if (lane == 0 && nrec < 64) { const float w0 = 1.f / (1.f + __expf(v1 - v0)), w1 = 1.f - w0;
                        const int lp0 = (int)__hip_atomic_fetch_add(lcnt + e0, 1u, __ATOMIC_RELAXED, __HIP_MEMORY_SCOPE_WORKGROUP), lp1 = (int)__hip_atomic_fetch_add(lcnt + e1, 1u, __ATOMIC_RELAXED, __HIP_MEMORY_SCOPE_WORKGROUP);
                        LAS int* r = rec + (wave * 64 + nrec) * 8; r[0] = e0; r[1] = e1; r[2] = lp0; r[3] = lp1; r[4] = __float_as_int(w0); r[5] = __float_as_int(w1); }
                }
            }
            if (l == 1) {
                __syncthreads();
                if (tid < 8) lcnt[8 + tid] = __hip_atomic_fetch_add(ctl + CW_MOECNT + 64 * tid, lcnt[tid], RLX_AGENT);
                __syncthreads();
                if (lane < nrec && lane < 64) { const LAS int* r = rec + (wave * 64 + lane) * 8; const int m = gw + lane * NGW, e0 = r[0], e1 = r[1], p0 = (int)lcnt[8 + e0] + r[2], p1 = (int)lcnt[8 + e1] + r[3];
                    ROWTOK[e0 * S + p0] = m; ROWTOK[e1 * S + p1] = m;
                    int* g_ = ROUTE + (size_t)m * 8; g_[0] = e0; g_[1] = e1; g_[2] = p0; g_[3] = p1; g_[4] = r[4]; g_[5] = r[5]; }
            }
            }
            TP_END(28, TPCTR);
            SEAM(pb + 8);
        }
        if (l == 0) {
#define ACT0 ((bf16_t*)(wsl + WS_R1))
            if (PHON(9) && IN(pb + 9)) { PHASE_LOCALS TP_BEGIN(29) for (int rep_ = 0; rep_ < REPN(9); ++rep_) {
                pg8::StaticOrder So; So.init(Hb, (const bf16_t*)(wsl + WS_DGU), 1024, 1024, S, 2 * DFF, G, bid);
                pg8::EpiSwiglu E{ACT0, DFF};
                pg8::gemm_phase<pg8::EpiSwiglu, pg8::StaticOrder, true, false>(lds, 1024, 1024, 1024, So, E, wave);
#if GREP & 2
                pg8::gemm_phase<pg8::EpiSwiglu, pg8::StaticOrder, true, false>(lds, 1024, 1024, 1024, So, E, wave);
#endif
            }
            TP_END(29, TPCTR);
                SEAM(pb + 9);
            }
            if (PHON(10) && IN(pb + 10)) { PHASE_LOCALS TP_BEGIN(30) for (int rep_ = 0; rep_ < REPN(10); ++rep_) {
                pg8::StaticOrder So; So.init(ACT0, (const bf16_t*)(wsl + WS_DDN), DFF, DFF, S, 1024, G, bid);
                pg8::EpiResid E{x_out, x_out};
                pg8::gemm_phase<pg8::EpiResid, pg8::StaticOrder, true, false>(lds, DFF, DFF, DFF, So, E, wave);
            }
            TP_END(30, TPCTR);
                SEAM(pb + 10);
            }
        } else {
#define ACT1 ((bf16_t*)(wsl + WS_R2))
#define YB ((bf16_t*)(wsl + WS_Y))
            for (int ps = 0; ps < 2; ++ps) {
                if (PHON(11) && IN(pb + 9 + 2 * ps)) { PHASE_LOCALS TP_BEGIN(31) for (int rep_ = 0; rep_ < REPN(11); ++rep_) {
                    if (tid == 0) { int tb = 0; for (int e = 0; e < 8; ++e) { const int c = (int)__hip_atomic_load(ctl + CW_MOECNT + 64 * e, RLX_AGENT); MTAB[e] = c; MTAB[8 + e] = tb; tb += (c + 255) >> 8; } MTAB[16] = tb; }
                    __syncthreads();
                    const int T = MTAB[16], tlo = 64 * ps, thi = (ps == 1) ? T : (T < 64 ? T : 64);
                    MoeGU So{MTAB, Hb, (const bf16_t*)(wsl + WS_MGU), ROWTOK, tlo, thi, G, bid};
                    pg8::EpiSwiglu E{ACT1, EFF};
                    pg8::gemm_phase<pg8::EpiSwiglu, MoeGU, true, true>(lds, 1024, 1024, 1024, So, E, wave);
#if GREP & 4
                    pg8::gemm_phase<pg8::EpiSwiglu, MoeGU, true, true>(lds, 1024, 1024, 1024, So, E, wave);
#endif
            }
            TP_END(31, TPCTR);
                    SEAM(pb + 9 + 2 * ps);
                }
                if (PHON(12) && IN(pb + 10 + 2 * ps)) { PHASE_LOCALS TP_BEGIN(32) for (int rep_ = 0; rep_ < REPN(12); ++rep_) {
                    if (tid == 0) { int tb = 0; for (int e = 0; e < 8; ++e) { const int c = (int)__hip_atomic_load(ctl + CW_MOECNT + 64 * e, RLX_AGENT); MTAB[e] = c; MTAB[8 + e] = tb; tb += (c + 255) >> 8; } MTAB[16] = tb; }
                    __syncthreads();
                    const int T = MTAB[16], tlo = 64 * ps, thi = (ps == 1) ? T : (T < 64 ? T : 64);
                    MoeDN So{MTAB, ACT1, (const bf16_t*)(wsl + WS_MDN), tlo, thi, G, bid};
                    pg8::EpiStore E{YB, 1024, nullptr, 1.f, 0};
                    pg8::gemm_phase<pg8::EpiStore, MoeDN, true, false>(lds, EFF, EFF, EFF, So, E, wave);
#if GREP & 8
                    pg8::gemm_phase<pg8::EpiStore, MoeDN, true, false>(lds, EFF, EFF, EFF, So, E, wave);
#endif
            }
            TP_END(32, TPCTR);
                    SEAM(pb + 10 + 2 * ps);
                }
            }
            if (PHON(15) && IN(pb + 15)) { PHASE_LOCALS TP_BEGIN(35) for (int rep_ = 0; rep_ < REPN(15); ++rep_) {
                if (tid == 0) { int tb = 0; for (int e = 0; e < 8; ++e) { const int c = (int)__hip_atomic_load(ctl + CW_MOECNT + 64 * e, RLX_AGENT); MTAB[e] = c; MTAB[8 + e] = tb; tb += (c + 255) >> 8; } MTAB[16] = tb; }
                __syncthreads();
                for (int m = gw; m < S; m += NGW) {
                    const int* r = ROUTE + (size_t)m * 8; const int e0 = r[0], e1 = r[1]; const float w0 = __int_as_float(r[4]), w1 = __int_as_float(r[5]);
                    const bf16_t* y0 = YB + ((size_t)MTAB[8 + e0] * 256 + r[2]) * 1024; const bf16_t* y1 = YB + ((size_t)MTAB[8 + e1] * 256 + r[3]) * 1024;
                    float* xo = x_out + (size_t)m * 1024;
#pragma unroll
                    for (int j = 0; j < 4; ++j) { const int c = 4 * lane + 256 * j; f32x4 xv = *(const f32x4*)(xo + c); const u32x2 a = *(const u32x2*)(y0 + c), b = *(const u32x2*)(y1 + c);
                        xv.x += w0 * bflo(a.x) + w1 * bflo(b.x); xv.y += w0 * bfhi(a.x) + w1 * bfhi(b.x); xv.z += w0 * bflo(a.y) + w1 * bflo(b.y); xv.w += w0 * bfhi(a.y) + w1 * bfhi(b.y);
                        *(f32x4*)(xo + c) = xv; }
                }
            }
            TP_END(35, TPCTR);
                if (l == 0) SEAM(pb + 15);
            }
        }
    }
#if TPROBE != 0 && !MK_MULTI
    xcd_barrier(bar);
    if (bid == 0 && wave == 0 && lane_id() == 0) { const unsigned long long tot = __hip_atomic_load((unsigned long long*)(ctl + 20480), RLX_AGENT) / (unsigned long long)(G * NWAVES); const unsigned long long t0 = tp_now(); while (tp_now() - t0 < tot) __builtin_amdgcn_s_sleep(8); }
#endif
#undef IN
#undef SEAM
}

extern "C" void kernel_launch(void* const* d_in, const int* in_sizes, int n_in, void* d_out, int out_size, void* d_ws, size_t ws_size, hipStream_t stream) {
    static int grid = 0;
    if (grid == 0) {
        if (n_in != 28 || in_sizes[0] != S * DM || out_size != S * DM || ws_size < WS_END) { fprintf(stderr, "kernel_launch: unexpected problem (n_in %d, in0 %d, out %d, ws %zu < %zu); nothing launched\n", n_in, n_in > 0 ? in_sizes[0] : -1, out_size, ws_size, (size_t)WS_END); grid = -1; return; }
        int dev = 0, cus = 0, per_cu = 0;
        if (hipGetDevice(&dev) != hipSuccess || hipDeviceGetAttribute(&cus, hipDeviceAttributeMultiprocessorCount, dev) != hipSuccess) { grid = -1; return; }
        if (hipFuncSetAttribute((const void*)fwd_kernel, hipFuncAttributeMaxDynamicSharedMemorySize, LDS_BYTES) != hipSuccess) { fprintf(stderr, "kernel_launch: hipFuncSetAttribute failed\n"); grid = -1; return; }
        if (hipOccupancyMaxActiveBlocksPerMultiprocessor(&per_cu, (const void*)fwd_kernel, NWAVES * 64, LDS_BYTES) != hipSuccess || per_cu < 1) { fprintf(stderr, "kernel_launch: occupancy query reports %d blocks per CU\n", per_cu); (void)hipGetLastError(); }
        grid = cus;
    }
    if (grid < 0) return;
    if (hipMemsetAsync((char*)d_ws + WS_CTL, 0, CTL_ZERO_BYTES, stream) != hipSuccess) return;
    Args a{};
    const float** ip = (const float**)&a.in;
    for (int i = 0; i < 28; ++i) ip[i] = (const float*)d_in[i];
    a.out = (float*)d_out; a.ws = (unsigned char*)d_ws;
#if MK_MULTI
    for (int ph = 0; ph < NPHASES; ++ph) {
        if (ph >= 1 + 11 && ph < 1 + PH_PER_LAYER) continue;
        a.ph_lo = ph; a.ph_hi = ph + 1;
        hipLaunchKernelGGL(fwd_kernel, dim3(grid), dim3(NWAVES * 64), LDS_BYTES, stream, a);
    }
#else
    a.ph_lo = 0; a.ph_hi = NPHASES;
    hipLaunchKernelGGL(fwd_kernel, dim3(grid), dim3(NWAVES * 64), LDS_BYTES, stream, a);
#endif
    const hipError_t le = hipPeekAtLastError();
    if (le != hipSuccess) fprintf(stderr, "kernel_launch: launch failed: %s\n", hipGetErrorName(le));
}
```

```cpp
#include <hip/hip_runtime.h>
#include <cstdio>
#include <cstdint>
#include <cmath>

#define LAS __attribute__((address_space(3)))
#define GAS __attribute__((address_space(1)))
typedef unsigned short bf16_t;
typedef short bf16x8 __attribute__((ext_vector_type(8)));
typedef short s16x4 __attribute__((ext_vector_type(4)));
typedef float f32x2 __attribute__((ext_vector_type(2)));
typedef float f32x4 __attribute__((ext_vector_type(4)));
typedef float f32x16 __attribute__((ext_vector_type(16)));
typedef unsigned u32x2 __attribute__((ext_vector_type(2)));
typedef unsigned u32x4 __attribute__((ext_vector_type(4)));
typedef __bf16 bf16x2_t __attribute__((ext_vector_type(2)));
typedef GAS unsigned gu32;
#define RLX_AGENT __ATOMIC_RELAXED, __HIP_MEMORY_SCOPE_AGENT
#define DI __device__ __forceinline__

DI unsigned cvtpk(float lo, float hi) { f32x2 v = {lo, hi}; bf16x2_t b = __builtin_convertvector(v, bf16x2_t); return __builtin_bit_cast(unsigned, b); }
DI float bf2f(bf16_t b) { return __uint_as_float(((unsigned)b) << 16); }
DI float bflo(unsigned w) { return __uint_as_float(w << 16); }
DI float bfhi(unsigned w) { return __uint_as_float(w & 0xffff0000u); }
DI bf16_t f2bf(float f) { return (bf16_t)(cvtpk(f, 0.f) & 0xffffu); }
DI float fast_exp2(float x) { return __builtin_amdgcn_exp2f(x); }
DI float fast_log2(float x) { return __builtin_amdgcn_logf(x); }
DI float fast_rcp(float x) { return __builtin_amdgcn_rcpf(x); }
constexpr float LOG2E = 1.4426950408889634f;
DI float sigmoidf_(float x) { return fast_rcp(1.f + fast_exp2(-x * LOG2E)); }
DI float siluf_(float x) { return x * sigmoidf_(x); }
template <int K> DI unsigned sxu(unsigned v) { return (unsigned)__builtin_amdgcn_ds_swizzle((int)v, (K << 10) | 0x1f); }
template <int K> DI float sx(float v) { return __uint_as_float(sxu<K>(__float_as_uint(v))); }
DI unsigned sx32u(unsigned v, int hi) { auto rr = __builtin_amdgcn_permlane32_swap(v, v, false, false); return hi ? rr[0] : rr[1]; }
DI float sx32(float v, int hi) { return __uint_as_float(sx32u(__float_as_uint(v), hi)); }
DI float sum32sym(float v) { auto rr = __builtin_amdgcn_permlane32_swap(__float_as_uint(v), __float_as_uint(v), false, false); return __uint_as_float(rr[0]) + __uint_as_float(rr[1]); }

#ifndef TPROBE
#define TPROBE 0
#endif
DI int lane_id() { int l_; asm volatile("v_mbcnt_lo_u32_b32 %0, -1, 0\n\tv_mbcnt_hi_u32_b32 %0, -1, %0" : "=v"(l_)); return l_; }
DI unsigned long long tp_now() { return __builtin_amdgcn_s_memrealtime(); }
#define TP_BEGIN(id) unsigned long long tp_t0_ = 0; if (TPROBE == (id)) tp_t0_ = tp_now();
#define TP_END(id, ctr) do { if (TPROBE == (id)) { const unsigned long long d_ = tp_now() - tp_t0_; if (lane_id() == 0) atomicAdd((unsigned long long*)(ctr), d_); } } while (0)

namespace pg8 {
constexpr int BM = 256, BK = 64, HALF = 128, HTB = HALF * BK * 2, STAGE_BYTES = 8 * HTB, NXCD = 8, WGM = 8;
__host__ __device__ __forceinline__ int lds_byte(int r, int c) { const int st = (r >> 4) * 2 + (c >> 5), rr = r & 15, cc = c & 31, ob = rr * 64 + cc * 2; return st * 1024 + (ob ^ (((ob >> 9) & 1) << 5)); }
__host__ __device__ __forceinline__ void stage_rc(int b, int& R, int& C) { const int st = b / 1024, sb = b % 1024, swz = sb ^ (((sb >> 9) & 1) << 5); R = (st >> 1) * 16 + swz / 64; C = (st & 1) * 32 + (swz % 64) / 2; }
__host__ __device__ __forceinline__ int perm32(int rho) { const int n = rho >> 4, i = rho & 15; return 8 * (i >> 2) + 4 * n + (i & 3); }

struct Unit { const bf16_t* a; const bf16_t* b; const int* rows; int nvalid, pm, pn; };

struct StaticOrder {
    const bf16_t* A; const bf16_t* Bt; int lda, ldb, nM, nN, nwg, G, c;
    DI void init(const bf16_t* A_, const bf16_t* Bt_, int lda_, int ldb_, int M, int N, int G_, int c_) { A = A_; Bt = Bt_; lda = lda_; ldb = ldb_; nM = M / BM; nN = N / BM; nwg = nM * nN; G = G_; c = c_; }
    DI bool next(int i, Unit& u) const {
        if (c < 0 || c >= G) return false;
        const long L = (long)i * G + c; if (L >= nwg) return false;
        int wgid = (int)L; { const int q = nwg / NXCD, r = nwg % NXCD, xcd = wgid % NXCD, off = wgid / NXCD; wgid = (xcd < r ? xcd * (q + 1) : r * (q + 1) + (xcd - r) * q) + off; }
        const int nig = WGM * nN, gid = wgid / nig, fm = gid * WGM, gsz = (nM - fm) < WGM ? (nM - fm) : WGM;
        u.pm = fm + ((wgid % nig) % gsz); u.pn = (wgid % nig) / gsz;
        u.a = A + (size_t)u.pm * BM * lda; u.b = Bt + (size_t)u.pn * BM * ldb; u.rows = nullptr; u.nvalid = BM; return true;
    }
};

struct EpiStore {
    static constexpr bool PERM = true;
    bf16_t* O; int ldc; const float* bias; float scale0; int act;
    DI void operator()(const f32x4 (&acc)[2][2][4][2], const Unit& u, int wr, int wc, int fr, int fq) const {
        const int row0 = u.pm * BM + wr * 64 + fr, col0 = u.pn * BM + wc * 32 + 8 * fq;
        const float sc = (u.pn == 0) ? scale0 : 1.f;
        f32x4 bv[2][2];
#pragma unroll
        for (int bj = 0; bj < 2; ++bj)
#pragma unroll
            for (int n = 0; n < 2; ++n) bv[bj][n] = bias ? *(const f32x4*)(bias + col0 + bj * HALF + 4 * n) : (f32x4){0.f, 0.f, 0.f, 0.f};
#pragma unroll
        for (int ai = 0; ai < 2; ++ai)
#pragma unroll
            for (int m = 0; m < 4; ++m) { bf16_t* rowp = O + (size_t)(row0 + ai * HALF + m * 16) * ldc + col0;
#pragma unroll
                for (int bj = 0; bj < 2; ++bj) { f32x4 v0 = (acc[ai][bj][m][0] + bv[bj][0]) * sc, v1 = (acc[ai][bj][m][1] + bv[bj][1]) * sc;
                    if (act) {
#pragma unroll
                        for (int e = 0; e < 4; ++e) { v0[e] = siluf_(v0[e]); v1[e] = siluf_(v1[e]); } }
                    u32x4 w; w.x = cvtpk(v0[0], v0[1]); w.y = cvtpk(v0[2], v0[3]); w.z = cvtpk(v1[0], v1[1]); w.w = cvtpk(v1[2], v1[3]);
                    *(u32x4*)(rowp + bj * HALF) = w; } }
    }
};
struct EpiGate {
    static constexpr bool PERM = true;
    bf16_t* Mg; const bf16_t* glog; int ldg; const float* bg; int first;
    DI void operator()(const f32x4 (&acc)[2][2][4][2], const Unit& u, int wr, int wc, int fr, int fq) const {
        const int row0 = u.pm * BM + wr * 64 + fr, col0 = u.pn * BM + wc * 32 + 8 * fq;
        f32x4 bv[2][2];
#pragma unroll
        for (int bj = 0; bj < 2; ++bj)
#pragma unroll
            for (int n = 0; n < 2; ++n) bv[bj][n] = *(const f32x4*)(bg + col0 + bj * HALF + 4 * n);
#pragma unroll
        for (int ai = 0; ai < 2; ++ai)
#pragma unroll
            for (int m = 0; m < 4; ++m) { const size_t row = (size_t)(row0 + ai * HALF + m * 16);
#pragma unroll
                for (int bj = 0; bj < 2; ++bj) { const int col = col0 + bj * HALF;
                    const u32x4 gl = *(const u32x4*)(glog + row * ldg + col);
                    u32x4 old = (u32x4){0u, 0u, 0u, 0u}; if (!first) old = *(const u32x4*)(Mg + row * 1024 + col);
                    float g[8] = {bflo(gl.x), bfhi(gl.x), bflo(gl.y), bfhi(gl.y), bflo(gl.z), bfhi(gl.z), bflo(gl.w), bfhi(gl.w)};
                    float o[8] = {bflo(old.x), bfhi(old.x), bflo(old.y), bfhi(old.y), bflo(old.z), bfhi(old.z), bflo(old.w), bfhi(old.w)};
#pragma unroll
                    for (int e = 0; e < 4; ++e) { o[e] += sigmoidf_(g[e] + bv[bj][0][e]) * acc[ai][bj][m][0][e]; o[4 + e] += sigmoidf_(g[4 + e] + bv[bj][1][e]) * acc[ai][bj][m][1][e]; }
                    u32x4 w; w.x = cvtpk(o[0], o[1]); w.y = cvtpk(o[2], o[3]); w.z = cvtpk(o[4], o[5]); w.w = cvtpk(o[6], o[7]);
                    *(u32x4*)(Mg + row * 1024 + col) = w; } }
    }
};
struct EpiResid {
    static constexpr bool PERM = false;
    const float* xin; float* out;
    DI void operator()(const f32x4 (&acc)[2][2][4][2], const Unit& u, int wr, int wc, int fr, int fq) const {
        const int row0 = u.pm * BM + wr * 64 + fr, col0 = u.pn * BM + wc * 32 + 4 * fq;
#pragma unroll
        for (int ai = 0; ai < 2; ++ai)
#pragma unroll
            for (int m = 0; m < 4; ++m) { const size_t off = (size_t)(row0 + ai * HALF + m * 16) * 1024 + col0;
#pragma unroll
                for (int bj = 0; bj < 2; ++bj)
#pragma unroll
                    for (int n = 0; n < 2; ++n) { const f32x4 b = *(const f32x4*)(xin + off + bj * HALF + n * 16); *(f32x4*)(out + off + bj * HALF + n * 16) = b + acc[ai][bj][m][n]; }
                if (m & 1) asm volatile("" ::: "memory"); }
    }
};
struct EpiF32 {
    static constexpr bool PERM = false;
    float* O; int ldc;
    DI void operator()(const f32x4 (&acc)[2][2][4][2], const Unit& u, int wr, int wc, int fr_in, int fq_in) const {
        int fr = fr_in, fq = fq_in; asm volatile("" : "+v"(fr), "+v"(fq));
        const int row0 = u.pm * BM + wr * 64 + fr, col0 = u.pn * BM + wc * 32 + 4 * fq;
#pragma unroll
        for (int ai = 0; ai < 2; ++ai)
#pragma unroll
            for (int m = 0; m < 4; ++m) { float* rowp = O + (size_t)(row0 + ai * HALF + m * 16) * ldc + col0;
#pragma unroll
                for (int bj = 0; bj < 2; ++bj)
#pragma unroll
                    for (int n = 0; n < 2; ++n) *(f32x4*)(rowp + bj * HALF + n * 16) = acc[ai][bj][m][n]; }
    }
};
struct EpiSwiglu {
    static constexpr bool PERM = true;
    bf16_t* act; int ldact;
    DI void operator()(const f32x4 (&acc)[2][2][4][2], const Unit& u, int wr, int wc, int fr, int fq) const {
        const int row0 = u.pm * BM + wr * 64 + fr, col0 = u.pn * HALF + wc * 32 + 8 * fq;
#pragma unroll
        for (int ai = 0; ai < 2; ++ai)
#pragma unroll
            for (int m = 0; m < 4; ++m) { bf16_t* rowp = act + (size_t)(row0 + ai * HALF + m * 16) * ldact + col0;
                float o[8];
#pragma unroll
                for (int e = 0; e < 4; ++e) { o[e] = siluf_(acc[ai][0][m][0][e]) * acc[ai][1][m][0][e]; o[4 + e] = siluf_(acc[ai][0][m][1][e]) * acc[ai][1][m][1][e]; }
                u32x4 w; w.x = cvtpk(o[0], o[1]); w.y = cvtpk(o[2], o[3]); w.z = cvtpk(o[4], o[5]); w.w = cvtpk(o[6], o[7]);
                *(u32x4*)rowp = w; }
    }
};

template <class Epi, class Sched, bool ALIGN_EPI, bool GATHER>
__device__ __forceinline__ void gemm_phase(LAS unsigned char* lds, const int lda, const int ldb, const int K, const Sched& S, const Epi& E, const int wave_id) {
    int tid_l = wave_id * 64 + lane_id(); asm volatile("" : "+v"(tid_l));
    const int tid = tid_l, wid = __builtin_amdgcn_readfirstlane(tid >> 6), lane = tid & 63, wr = wid >> 2, wc = wid & 3, fr = lane & 15, fq = lane >> 4;
    const int nt = K / BK;
    unsigned voffB[2], vc0[2], vc1[2], vn0[2], vn1[2];
#pragma unroll
    for (int i = 0; i < 2; ++i) { int R, C; stage_rc(tid * 16 + i * 8192, R, C); const int Rb = Epi::PERM ? ((R & ~31) + perm32(R & 31)) : R;
        voffB[i] = (unsigned)(Rb * ldb + C) * 2u; vc0[i] = (unsigned)(R * lda + C) * 2u; vc1[i] = vc0[i]; vn0[i] = vc0[i]; vn1[i] = vc0[i]; }
    const size_t hsA = GATHER ? (size_t)0 : (size_t)HALF * lda * 2, hsB = (size_t)HALF * ldb * 2;
    const size_t kstep = (size_t)(BK * 2);
    const unsigned ldsw = (unsigned)wid * 1024u;
    const int aoff = lds_byte(wr * 64 + fr, fq * 8), boff = lds_byte(wc * 32 + fr, fq * 8);
#define PG8_SA(b, h) (((b) * 2 + (h)) * HTB)
#define PG8_SB(b, h) ((4 + (b) * 2 + (h)) * HTB)
#define PG8_STAGE(bufoff, gbase, voff) do { _Pragma("unroll") for (int _i = 0; _i < 2; ++_i) \
        __builtin_amdgcn_global_load_lds((const unsigned*)((const char*)(gbase) + (voff)[_i]), (LAS unsigned*)(lds + (bufoff) + ldsw + _i * 8192), 16, 0, 0); } while (0)
#define PG8_LDA(dst, b, h) do { _Pragma("unroll") for (int m = 0; m < 4; ++m) _Pragma("unroll") for (int k = 0; k < 2; ++k) dst[m][k] = *(const LAS bf16x8*)(lds + PG8_SA(b, h) + aoff + m * 2048 + k * 1024); } while (0)
#define PG8_LDB(dst, b, h) do { _Pragma("unroll") for (int n = 0; n < 2; ++n) _Pragma("unroll") for (int k = 0; k < 2; ++k) dst[n][k] = *(const LAS bf16x8*)(lds + PG8_SB(b, h) + boff + n * 2048 + k * 1024); } while (0)
#define PG8_MMA(ai, bj, At, Bt) do { __builtin_amdgcn_s_setprio(1); _Pragma("unroll") for (int m = 0; m < 4; ++m) _Pragma("unroll") for (int n = 0; n < 2; ++n) _Pragma("unroll") for (int k = 0; k < 2; ++k) \
        acc[ai][bj][m][n] = __builtin_amdgcn_mfma_f32_16x16x32_bf16(Bt[n][k], At[m][k], acc[ai][bj][m][n], 0, 0, 0); __builtin_amdgcn_s_setprio(0); } while (0)
#define PG8_WAIT_V(n) asm volatile("s_waitcnt vmcnt(" #n ")" ::: "memory")
#define PG8_WAIT_L(n) asm volatile("s_waitcnt lgkmcnt(" #n ")" ::: "memory")
#define PG8_BAR __builtin_amdgcn_s_barrier()
#define PG8_SCHED __builtin_amdgcn_sched_barrier(0)
#define PG8_GVOFF(U, o0, o1) do { if constexpr (GATHER) { _Pragma("unroll") for (int _i = 0; _i < 2; ++_i) { int R_, C_; stage_rc(tid * 16 + _i * 8192, R_, C_); \
        const int r0_ = R_, r1_ = R_ + HALF; const int t0_ = (U).rows[r0_ < (U).nvalid ? r0_ : 0], t1_ = (U).rows[r1_ < (U).nvalid ? r1_ : 0]; \
        o0[_i] = (unsigned)(t0_ * lda + C_) * 2u; o1[_i] = (unsigned)(t1_ * lda + C_) * 2u; } } } while (0)
    Unit cur, nxt; int ui = 0;
    if (!S.next(0, cur)) return;
    PG8_GVOFF(cur, vc0, vc1);
    f32x4 acc[2][2][4][2];
#pragma unroll
    for (int a = 0; a < 2; ++a)
#pragma unroll
        for (int b = 0; b < 2; ++b)
#pragma unroll
            for (int m = 0; m < 4; ++m)
#pragma unroll
                for (int n = 0; n < 2; ++n) acc[a][b][m][n] = (f32x4){0.f, 0.f, 0.f, 0.f};
    bf16x8 At[4][2], B0[2][2], B1[2][2];
    const char* cA = (const char*)cur.a; const char* cB = (const char*)cur.b;
    PG8_STAGE(PG8_SB(0, 0), cB, voffB); PG8_STAGE(PG8_SB(0, 1), cB + hsB, voffB); PG8_STAGE(PG8_SA(0, 0), cA, vc0); PG8_STAGE(PG8_SA(0, 1), cA + hsA, vc1);
    if (wr == 1) PG8_BAR;
    PG8_WAIT_V(2); PG8_BAR;
    PG8_STAGE(PG8_SB(1, 0), cB + kstep, voffB); PG8_STAGE(PG8_SA(1, 0), cA + kstep, vc0); PG8_STAGE(PG8_SB(1, 1), cB + hsB + kstep, voffB);
    PG8_WAIT_V(6); PG8_BAR;
    for (;;) {
        const bool has_next = S.next(ui + 1, nxt);
        const char* nA = has_next ? (const char*)nxt.a : cA; const char* nB = has_next ? (const char*)nxt.b : cB;
        if constexpr (GATHER) { if (has_next) { PG8_GVOFF(nxt, vn0, vn1); } else {
#pragma unroll
            for (int i = 0; i < 2; ++i) { vn0[i] = vc0[i]; vn1[i] = vc1[i]; } } }
        for (int t = 0; t < nt; t += 2) {
            const bool last = (t == nt - 2);
            const char* a1 = cA + (size_t)(t + 1) * kstep;
            const char* a2 = last ? nA : cA + (size_t)(t + 2) * kstep; const char* b2 = last ? nB : cB + (size_t)(t + 2) * kstep;
            const char* a3 = a2 + kstep; const char* b3 = b2 + kstep;
            unsigned v20[2], v21[2];
#pragma unroll
            for (int i = 0; i < 2; ++i) { v20[i] = (GATHER && last) ? vn0[i] : vc0[i]; v21[i] = GATHER ? (last ? vn1[i] : vc1[i]) : vc0[i]; }
            PG8_LDB(B0, 0, 0); PG8_LDB(B1, 0, 1); PG8_SCHED; PG8_LDA(At, 0, 0); PG8_STAGE(PG8_SA(1, 1), a1 + hsA, vc1);
            PG8_WAIT_V(8); PG8_WAIT_L(0); PG8_BAR; PG8_MMA(0, 0, At, B0); PG8_MMA(0, 1, At, B1); PG8_BAR; PG8_SCHED;
            PG8_LDA(At, 0, 1); PG8_STAGE(PG8_SB(0, 0), b2, voffB); PG8_STAGE(PG8_SB(0, 1), b2 + hsB, voffB); PG8_STAGE(PG8_SA(0, 0), a2, v20);
            PG8_WAIT_V(8); PG8_WAIT_L(0); PG8_BAR; PG8_MMA(1, 0, At, B0); PG8_MMA(1, 1, At, B1); PG8_BAR; PG8_SCHED;
            PG8_LDB(B0, 1, 0); PG8_LDB(B1, 1, 1); PG8_SCHED; PG8_LDA(At, 1, 0); PG8_STAGE(PG8_SA(0, 1), a2 + hsA, v21);
            PG8_WAIT_V(8); PG8_WAIT_L(0); PG8_BAR; PG8_MMA(0, 0, At, B0); PG8_MMA(0, 1, At, B1); PG8_BAR; PG8_SCHED;
            PG8_LDA(At, 1, 1); PG8_STAGE(PG8_SB(1, 0), b3, voffB); PG8_STAGE(PG8_SB(1, 1), b3 + hsB, voffB); PG8_STAGE(PG8_SA(1, 0), a3, v20);
            PG8_WAIT_V(8); PG8_WAIT_L(0); PG8_BAR; PG8_MMA(1, 0, At, B0); PG8_MMA(1, 1, At, B1); PG8_BAR; PG8_SCHED;
        }
        if constexpr (ALIGN_EPI) { if (wr == 0) PG8_BAR; }
        E(acc, cur, wr, wc, fr, fq);
        if (!has_next) break;
#pragma unroll
        for (int a = 0; a < 2; ++a)
#pragma unroll
            for (int b = 0; b < 2; ++b)
#pragma unroll
                for (int m = 0; m < 4; ++m)
#pragma unroll
                    for (int n = 0; n < 2; ++n) acc[a][b][m][n] = (f32x4){0.f, 0.f, 0.f, 0.f};
        cur = nxt; cA = nA; cB = nB; ++ui;
        if constexpr (GATHER) {
#pragma unroll
            for (int i = 0; i < 2; ++i) { vc0[i] = vn0[i]; vc1[i] = vn1[i]; } }
        if constexpr (ALIGN_EPI) { if (wr == 1) PG8_BAR; }
    }
    PG8_WAIT_V(0);
    if constexpr (!ALIGN_EPI) { if (wr == 0) PG8_BAR; }
    PG8_BAR;
#undef PG8_SA
#undef PG8_SB
#undef PG8_STAGE
#undef PG8_LDA
#undef PG8_LDB
#undef PG8_MMA
#undef PG8_WAIT_V
#undef PG8_WAIT_L
#undef PG8_BAR
#undef PG8_SCHED
#undef PG8_GVOFF
}
}
#define XB_TMO      128
#define XB_XCNT(j)  (256  + 64 * (j))
#define XB_XSUB(j)  (1280 + 64 * (j))
#define XB_XGEN(j)  (2304 + 64 * (j))
#define XB_TOP      3328
#define XB_TOPGEN   3392
#define XCD_BAR_WORDS 3456
#define XB_SPIN_CAP (1u << 18)

__device__ __forceinline__ unsigned xb_ld(unsigned* p)              { return __hip_atomic_load(p, __ATOMIC_RELAXED, __HIP_MEMORY_SCOPE_AGENT); }
__device__ __forceinline__ unsigned xb_add(unsigned* p, unsigned v) { return __hip_atomic_fetch_add(p, v, __ATOMIC_RELAXED, __HIP_MEMORY_SCOPE_AGENT); }
__device__ __forceinline__ unsigned xb_xcc_id() { return (unsigned)__builtin_amdgcn_s_getreg((3 << 11) | 20) & 0xFu; }
#define XB_SPIN(cond, bar) do { unsigned _sp = 0; while (cond) { __builtin_amdgcn_s_sleep(1); \
    if ((++_sp & 255u) == 0u) { if (xb_ld(&(bar)[XB_TMO])) break; if (_sp > XB_SPIN_CAP) { atomicAdd(&(bar)[XB_TMO], 1u); break; } } } } while (0)

struct XcdBarrier {
    unsigned* bar; unsigned x;
    volatile LAS unsigned* st;
};

__device__ __forceinline__ XcdBarrier xcd_barrier_post(unsigned* bar, volatile LAS unsigned* st) {
    XcdBarrier b; b.bar = bar; b.x = xb_xcc_id(); b.st = st;
    if (threadIdx.x == 0) (void)xb_add(&bar[XB_XCNT(b.x)], 1u);
    return b;
}
__device__ __forceinline__ void xcd_barrier_complete(unsigned* bar, unsigned x, unsigned& nloc, unsigned& nx) {
    const unsigned G = gridDim.x * gridDim.y * gridDim.z;
    unsigned sum, cnt, mine, sp = 0u;
    for (;;) {
        sum = 0u; cnt = 0u; mine = 0u;
#pragma unroll
        for (unsigned j = 0; j < 16; ++j) { const unsigned c = xb_ld(&bar[XB_XCNT(j)]); sum += c; cnt += (c > 0u) ? 1u : 0u; mine = (j == x) ? c : mine; }
        if (sum == G) break;
        __builtin_amdgcn_s_sleep(1);
        if ((++sp & 255u) == 0u) { if (xb_ld(&bar[XB_TMO])) break; if (sp > XB_SPIN_CAP) { atomicAdd(&bar[XB_TMO], 1u); break; } }
    }
    nloc = mine > 0u ? mine : 1u; nx = cnt > 0u ? cnt : 1u;
}

__device__ __forceinline__ void xcd_barrier(const XcdBarrier& b) {
    asm volatile("s_waitcnt vmcnt(0)" ::: "memory");
    __syncthreads();
    if (threadIdx.x == 0) {
        unsigned* bar = b.bar;
        __builtin_amdgcn_s_waitcnt(0);
        unsigned nloc = b.st[0], nx = b.st[1];
        if (nloc == 0u) { xcd_barrier_complete(bar, b.x, nloc, nx); b.st[0] = nloc; b.st[1] = nx; }
        const unsigned old = xb_add(&bar[XB_XSUB(b.x)], 1u);
        const unsigned gen = old / nloc;
        if (old + 1u == (gen + 1u) * nloc) {
            __builtin_amdgcn_fence(__ATOMIC_RELEASE, "agent");
            asm volatile("s_waitcnt vmcnt(0)" ::: "memory");
            const unsigned og = xb_add(&bar[XB_TOP], 1u);
            const unsigned tg = og / nx;
            if (og + 1u == (tg + 1u) * nx) xb_add(&bar[XB_TOPGEN], 1u);
            else XB_SPIN(xb_ld(&bar[XB_TOPGEN]) == tg, bar);
            __builtin_amdgcn_fence(__ATOMIC_ACQUIRE, "agent");
            xb_add(&bar[XB_XGEN(b.x)], 1u);
            asm volatile("s_waitcnt vmcnt(0)" ::: "memory");
        } else {
            XB_SPIN(xb_ld(&bar[XB_XGEN(b.x)]) == gen, bar);
            __builtin_amdgcn_fence(__ATOMIC_ACQUIRE, "agent");
            asm volatile("s_waitcnt vmcnt(0)" ::: "memory");
        }
    }
    __syncthreads();
}
namespace att {
typedef short v4i16_t __attribute__((ext_vector_type(4)));
DI f32x16 mfma32(bf16x8 a, bf16x8 b, f32x16 c) { return __builtin_amdgcn_mfma_f32_32x32x16_bf16(a, b, c, 0, 0, 0); }
DI f32x4 mfma16(bf16x8 a, bf16x8 b, f32x4 c) { return __builtin_amdgcn_mfma_f32_16x16x32_bf16(a, b, c, 0, 0, 0); }
DI int crow(int r, int hi) { return (r & 3) + 8 * (r >> 2) + 4 * hi; }
DI s16x4 vtr(const LAS char* p) { return __builtin_bit_cast(s16x4, __builtin_amdgcn_ds_read_tr16_b64_v4i16((LAS v4i16_t*)p)); }
DI int rfl(int x) { return __builtin_amdgcn_readfirstlane(x); }
constexpr float NEGBIG = -1e30f;
#define LDS_BAR() asm volatile("s_waitcnt lgkmcnt(0)\n\ts_barrier" ::: "memory")

template <int D, int KS> DI f32x16 qk32(const LAS char* kp, const bf16x8* qf, float init = 0.f) {
    f32x16 acc;
#pragma unroll
    for (int i = 0; i < 16; ++i) acc[i] = init;
    bf16x8 kfr[D / 16];
#pragma unroll
    for (int d0 = 0; d0 < D / 16; ++d0) kfr[d0] = *(const LAS bf16x8*)(kp + d0 * 32);
    asm volatile("" ::: "memory");
#pragma unroll
    for (int d0 = 0; d0 < D / 16; ++d0) acc = mfma32(kfr[d0], qf[d0], acc);
    return acc;
}
template <int D, int KS> DI void qk64(f32x16& a0, f32x16& a1, const LAS char* kp, const bf16x8* qf, float init = 0.f) {
#pragma unroll
    for (int i = 0; i < 16; ++i) { a0[i] = init; a1[i] = init; }
    bf16x8 k0[D / 16], k1[D / 16];
#pragma unroll
    for (int d0 = 0; d0 < D / 16; ++d0) { k0[d0] = *(const LAS bf16x8*)(kp + d0 * 32); k1[d0] = *(const LAS bf16x8*)(kp + 32 * KS + d0 * 32); }
    asm volatile("" ::: "memory");
#pragma unroll
    for (int d0 = 0; d0 < D / 16; ++d0) { a0 = mfma32(k0[d0], qf[d0], a0); a1 = mfma32(k1[d0], qf[d0], a1); }
}
template <int VS> DI void pv32(f32x16 (&o)[2], const LAS char* vp, bf16x8 pf0, bf16x8 pf1) {
    s16x4 t[2][4];
#pragma unroll
    for (int dh = 0; dh < 2; ++dh) { t[dh][0] = vtr(vp + dh * 64); t[dh][1] = vtr(vp + 8 * VS + dh * 64); t[dh][2] = vtr(vp + 16 * VS + dh * 64); t[dh][3] = vtr(vp + 24 * VS + dh * 64); }
    asm volatile("" ::: "memory");
#pragma unroll
    for (int dh = 0; dh < 2; ++dh) {
        const bf16x8 v0 = __builtin_shufflevector(t[dh][0], t[dh][1], 0, 1, 2, 3, 4, 5, 6, 7), v1 = __builtin_shufflevector(t[dh][2], t[dh][3], 0, 1, 2, 3, 4, 5, 6, 7);
        o[dh] = mfma32(v0, pf0, o[dh]); o[dh] = mfma32(v1, pf1, o[dh]);
    }
}
template <int VS> DI void pv64(f32x16 (&o)[2], const LAS char* vp, const f32x16& p0, const f32x16& p1);
DI bf16x8 pack8(const f32x16& p, int s) {
    u32x4 w; w.x = cvtpk(p[8 * s], p[8 * s + 1]); w.y = cvtpk(p[8 * s + 2], p[8 * s + 3]); w.z = cvtpk(p[8 * s + 4], p[8 * s + 5]); w.w = cvtpk(p[8 * s + 6], p[8 * s + 7]);
    return __builtin_bit_cast(bf16x8, w);
}
template <int VS> DI void pv64(f32x16 (&o)[2], const LAS char* vp, const f32x16& p0, const f32x16& p1) {
    s16x4 t[2][2][4];
#pragma unroll
    for (int hh = 0; hh < 2; ++hh)
#pragma unroll
        for (int dh = 0; dh < 2; ++dh)
#pragma unroll
            for (int k = 0; k < 4; ++k) t[hh][dh][k] = vtr(vp + (32 * hh + 8 * k) * VS + dh * 64);
    const bf16x8 pa0 = pack8(p0, 0), pa1 = pack8(p0, 1), pb0 = pack8(p1, 0), pb1 = pack8(p1, 1);
    asm volatile("" ::: "memory");
#pragma unroll
    for (int dh = 0; dh < 2; ++dh) {
        o[dh] = mfma32(__builtin_shufflevector(t[0][dh][0], t[0][dh][1], 0, 1, 2, 3, 4, 5, 6, 7), pa0, o[dh]);
        o[dh] = mfma32(__builtin_shufflevector(t[0][dh][2], t[0][dh][3], 0, 1, 2, 3, 4, 5, 6, 7), pa1, o[dh]);
        o[dh] = mfma32(__builtin_shufflevector(t[1][dh][0], t[1][dh][1], 0, 1, 2, 3, 4, 5, 6, 7), pb0, o[dh]);
        o[dh] = mfma32(__builtin_shufflevector(t[1][dh][2], t[1][dh][3], 0, 1, 2, 3, 4, 5, 6, 7), pb1, o[dh]);
    }
}
DI float max16(const f32x16& p) { float a = fmaxf(fmaxf(p[0], p[1]), fmaxf(p[2], p[3]));
#pragma unroll
    for (int r = 4; r < 16; r += 4) a = fmaxf(a, fmaxf(fmaxf(p[r], p[r + 1]), fmaxf(p[r + 2], p[r + 3]))); return a; }
DI void store_ot(bf16_t* dst, const f32x16 (&o)[2], int hi) {
#pragma unroll
    for (int dh = 0; dh < 2; ++dh)
#pragma unroll
        for (int g4 = 0; g4 < 4; ++g4) { u32x2 w; w.x = cvtpk(o[dh][4 * g4], o[dh][4 * g4 + 1]); w.y = cvtpk(o[dh][4 * g4 + 2], o[dh][4 * g4 + 3]); *(u32x2*)(dst + 32 * dh + 8 * g4 + 4 * hi) = w; }
}

#define ATT_SB() __builtin_amdgcn_sched_barrier(0)
template <int D, int KS, int VS> DI void step64(f32x16 (&o)[2], float& l, const LAS char* kp, const LAS char* vp, const bf16x8* qf, float init) {
    bf16x8 k0[D / 16], k1[D / 16];
#pragma unroll
    for (int d0 = 0; d0 < D / 16; ++d0) { k0[d0] = *(const LAS bf16x8*)(kp + d0 * 32); k1[d0] = *(const LAS bf16x8*)(kp + 32 * KS + d0 * 32); }
    s16x4 t[2][2][4];
#pragma unroll
    for (int hh = 0; hh < 2; ++hh)
#pragma unroll
        for (int dh = 0; dh < 2; ++dh)
#pragma unroll
            for (int k = 0; k < 4; ++k) t[hh][dh][k] = vtr(vp + (32 * hh + 8 * k) * VS + dh * 64);
    f32x16 a0, a1;
#pragma unroll
    for (int i = 0; i < 16; ++i) { a0[i] = init; a1[i] = init; }
    ATT_SB();
#pragma unroll
    for (int d0 = 0; d0 < D / 16; ++d0) a0 = mfma32(k0[d0], qf[d0], a0);
#pragma unroll
    for (int d0 = 0; d0 < D / 16 - 4; ++d0) a1 = mfma32(k1[d0], qf[d0], a1);
    ATT_SB();
    float ls = 0.f;
#pragma unroll
    for (int g = 0; g < 4; ++g) {
        a1 = mfma32(k1[D / 16 - 4 + g], qf[D / 16 - 4 + g], a1);
#pragma unroll
        for (int e = 0; e < 4; ++e) { a0[4 * g + e] = fast_exp2(a0[4 * g + e]); ls += a0[4 * g + e]; }
        asm volatile("" : "+v"(a0), "+v"(ls)); ATT_SB();
    }
    const bf16x8 pa0 = pack8(a0, 0), pa1 = pack8(a0, 1);
    ATT_SB();
#pragma unroll
    for (int g = 0; g < 4; ++g) {
        const int dh = g & 1, s = g >> 1;
        o[dh] = mfma32(__builtin_shufflevector(t[0][dh][2 * s], t[0][dh][2 * s + 1], 0, 1, 2, 3, 4, 5, 6, 7), s ? pa1 : pa0, o[dh]);
#pragma unroll
        for (int e = 0; e < 4; ++e) { a1[4 * g + e] = fast_exp2(a1[4 * g + e]); ls += a1[4 * g + e]; }
        asm volatile("" : "+v"(a1), "+v"(ls)); ATT_SB();
    }
    const bf16x8 pb0 = pack8(a1, 0), pb1 = pack8(a1, 1);
    ATT_SB();
#pragma unroll
    for (int g = 0; g < 4; ++g) { const int dh = g & 1, s = g >> 1;
        o[dh] = mfma32(__builtin_shufflevector(t[1][dh][2 * s], t[1][dh][2 * s + 1], 0, 1, 2, 3, 4, 5, 6, 7), s ? pb1 : pb0, o[dh]); }
    l += ls;
}

constexpr int MLA_KS = 208, MLA_VS = 144, MLA_KB = 128 * MLA_KS, MLA_VB = 128 * MLA_VS, MLA_BUF = MLA_KB + MLA_VB;
DI void mla_unit(LAS char* lds, const bf16_t* QM, const bf16_t* KM, const bf16_t* KV, bf16_t* ATT, int head, int qb, float kb, int wave_id, unsigned long long* tp) {
    TP_BEGIN(7) unsigned long long tpacc_ = 0, tpa_ = 0;
    int tid_l = wave_id * 64 + lane_id(); asm volatile("" : "+v"(tid_l));
    const int tid = tid_l, lane = tid & 63, wid = rfl(tid >> 6), r32 = lane & 31, hi = lane >> 5, half = wid >> 2, wq = wid & 3;
    const int q0 = qb * 128, qpos = q0 + 32 * wq + r32, nsuper = qb + 1;
    bf16x8 qf[6];
    { const bf16_t* qp = QM + (size_t)qpos * 384 + head * 96 + hi * 8;
#pragma unroll
      for (int d0 = 0; d0 < 6; ++d0) qf[d0] = *(const bf16x8*)(qp + d0 * 16); }
    float nref;
    { float qs = 0.f;
#pragma unroll
      for (int d0 = 0; d0 < 6; ++d0)
#pragma unroll
          for (int e = 0; e < 8; ++e) { const float v = __uint_as_float(((unsigned)(unsigned short)qf[d0][e]) << 16); qs += v * v; }
      qs += sx32(qs, hi); nref = -sqrtf(qs) * kb; }
    u32x4 kr[3], vr[2];
#define MLA_LOAD(i) do { _Pragma("unroll") for (int j = 0; j < 3; ++j) { const int c = tid + 512 * j, row = c / 12, ch = c % 12; kr[j] = *(const u32x4*)(KM + (size_t)(128 * (i) + row) * 384 + head * 96 + ch * 8); } \
        _Pragma("unroll") for (int j = 0; j < 2; ++j) { const int c = tid + 512 * j, row = c >> 3, ch = c & 7; vr[j] = *(const u32x4*)(KV + (size_t)(128 * (i) + row) * 512 + head * 128 + 64 + ch * 8); } } while (0)
#define MLA_STORE(b) do { LAS char* kb_ = lds + (b) * MLA_BUF; _Pragma("unroll") for (int j = 0; j < 3; ++j) { const int c = tid + 512 * j, row = c / 12, ch = c % 12; *(LAS u32x4*)(kb_ + row * MLA_KS + ch * 16) = kr[j]; } \
        _Pragma("unroll") for (int j = 0; j < 2; ++j) { const int c = tid + 512 * j, row = c >> 3, ch = c & 7; *(LAS u32x4*)(kb_ + MLA_KB + row * MLA_VS + ch * 16) = vr[j]; } } while (0)
    MLA_LOAD(0); MLA_STORE(0); __syncthreads();
    float l = 0.f; f32x16 o[2];
#pragma unroll
    for (int i = 0; i < 16; ++i) { o[0][i] = 0.f; o[1][i] = 0.f; }
    const int vlane = (4 * hi + ((lane & 15) >> 2)) * MLA_VS + 2 * (16 * ((lane >> 4) & 1) + 4 * (lane & 3));
    for (int i = 0; i < nsuper; ++i) {
        const bool more = i + 1 < nsuper;
        if (more) MLA_LOAD(i + 1);
        const LAS char* kb_ = lds + (i & 1) * MLA_BUF; const LAS char* vb = kb_ + MLA_KB;
        const bool diag = (i == nsuper - 1);
        if (TPROBE == 14 || TPROBE == 15 || TPROBE == 16) tpa_ = tp_now();
        if (!(diag && half == 1 && wq < 2)) {
            const int koff = 64 * half;
            if (!diag) step64<96, MLA_KS, MLA_VS>(o, l, kb_ + (koff + r32) * MLA_KS + hi * 16, vb + koff * MLA_VS + vlane, qf, nref);
            else {
            f32x16 p0, p1; qk64<96, MLA_KS>(p0, p1, kb_ + (koff + r32) * MLA_KS + hi * 16, qf, nref);
            { const int kbase = 128 * i + koff;
#pragma unroll
                for (int r = 0; r < 16; ++r) { const int k0 = kbase + crow(r, hi); p0[r] = (k0 > qpos) ? 0.f : fast_exp2(p0[r]); p1[r] = (k0 + 32 > qpos) ? 0.f : fast_exp2(p1[r]); } }
#pragma unroll
            for (int r = 0; r < 16; ++r) l += p0[r] + p1[r];
            pv64<MLA_VS>(o, vb + koff * MLA_VS + vlane, p0, p1);
            }
        }
        if (TPROBE == 15) tpacc_ += tp_now() - tpa_;
        if (TPROBE == 16) tpa_ = tp_now();
        if (more) MLA_STORE((i + 1) & 1);
        if (TPROBE == 16) tpacc_ += tp_now() - tpa_;
        if (TPROBE == 14) tpa_ = tp_now();
        __syncthreads();
        if (TPROBE == 14) tpacc_ += tp_now() - tpa_;
    }
#undef MLA_LOAD
#undef MLA_STORE
    l = sum32sym(l);
    LAS float* mrg = (LAS float*)lds + (wq * 64 + lane) * 34;
    if (half == 1) { mrg[1] = l;
#pragma unroll
        for (int r = 0; r < 16; ++r) { mrg[2 + r] = o[0][r]; mrg[18 + r] = o[1][r]; } }
    __syncthreads();
    if (half == 0) {
        const float inv = 1.f / (l + mrg[1]);
#pragma unroll
        for (int r = 0; r < 16; ++r) { o[0][r] = (o[0][r] + mrg[2 + r]) * inv; o[1][r] = (o[1][r] + mrg[18 + r]) * inv; }
        store_ot(ATT + (size_t)qpos * 1024 + 768 + head * 64, o, hi);
    }
    __syncthreads();
    TP_END(7, tp);
    if ((TPROBE == 14 || TPROBE == 15 || TPROBE == 16) && lane == 0) atomicAdd(tp, tpacc_);
}

constexpr int T_KS = 144, T_KB = 64 * T_KS, T_BUF = 2 * T_KB;
DI void sb_half(f32x16 (&o)[2], float& R, const LAS char* ktile, const LAS char* vtile, const bf16x8* qf, int kb, int hh, int qpos, int r32, int hi, int vlane) {
    f32x16 z = qk32<64, T_KS>(ktile + (32 * hh + r32) * T_KS + hi * 16, qf);
    float ls[16];
#pragma unroll
    for (int r = 0; r < 16; ++r) { const bool valid = (kb + crow(r, hi)) < qpos; const float az = fabsf(z[r]);
        const float sp = fmaxf(z[r], 0.f) + fast_log2(1.f + fast_exp2(-az)); ls[r] = valid ? -sp : 0.f; }
    float T[4], U[4];
#pragma unroll
    for (int g = 0; g < 4; ++g) { ls[4 * g + 2] += ls[4 * g + 3]; ls[4 * g + 1] += ls[4 * g + 2]; ls[4 * g] += ls[4 * g + 1]; T[g] = ls[4 * g]; }
#pragma unroll
    for (int g = 0; g < 4; ++g) U[g] = sx32(T[g], hi);
    float H[4]; float sp = 0.f;
#pragma unroll
    for (int g = 3; g >= 0; --g) { H[g] = sp + (hi == 0 ? U[g] : 0.f); sp += T[g] + U[g]; }
#pragma unroll
    for (int r = 0; r < 16; ++r) { const bool valid = (kb + crow(r, hi)) < qpos; const float lw = z[r] + R + H[r >> 2] + ls[r]; z[r] = valid ? fast_exp2(lw) : 0.f; }
    R += sp;
    pv32<T_KS>(o, vtile + (32 * hh) * T_KS + vlane, pack8(z, 0), pack8(z, 1));
}
DI void sb_unit(LAS char* lds, const bf16_t* PROJ, bf16_t* ATT, int head, int qb, int wave_id) {
    int tid_l = wave_id * 64 + lane_id(); asm volatile("" : "+v"(tid_l));
    const int tid = tid_l, lane = tid & 63, wid = rfl(tid >> 6), r32 = lane & 31, hi = lane >> 5;
    const int q0 = qb * 256, wq0 = q0 + 32 * wid, qpos = wq0 + r32;
    bf16x8 qf[4];
    { const bf16_t* qp = PROJ + (size_t)qpos * 5632 + head * 64 + hi * 8;
#pragma unroll
      for (int d0 = 0; d0 < 4; ++d0) qf[d0] = *(const bf16x8*)(qp + d0 * 16); }
    const int srow = tid >> 3, sch = tid & 7;
    u32x4 kr, vr;
#define SB_LOAD(t) do { const bf16_t* p_ = PROJ + (size_t)(64 * (t) + srow) * 5632 + head * 64 + sch * 8; kr = *(const u32x4*)(p_ + 256); vr = *(const u32x4*)(p_ + 512); } while (0)
#define SB_STORE(b) do { LAS char* d_ = lds + (b) * T_BUF + srow * T_KS + sch * 16; *(LAS u32x4*)d_ = kr; *(LAS u32x4*)(d_ + T_KB) = vr; } while (0)
    volatile LAS int* flags = (volatile LAS int*)(lds + 2 * T_BUF);
    int t = 4 * qb + 3;
    SB_LOAD(t); SB_STORE(0); __syncthreads();
    float R = 0.f; f32x16 o[2];
#pragma unroll
    for (int i = 0; i < 16; ++i) { o[0][i] = 0.f; o[1][i] = 0.f; }
    const int vlane = (4 * hi + ((lane & 15) >> 2)) * T_KS + 2 * (16 * ((lane >> 4) & 1) + 4 * (lane & 3));
    bool done = false;
    for (int it = 0;; ++it) {
        const bool more = t > 0;
        if (more) SB_LOAD(t - 1);
        const LAS char* kt = lds + (it & 1) * T_BUF; const LAS char* vt = kt + T_KB;
        if (!done && 64 * t <= wq0 + 30) {
            if (64 * t + 32 <= wq0 + 30) sb_half(o, R, kt, vt, qf, 64 * t + 32, 1, qpos, r32, hi, vlane);
            sb_half(o, R, kt, vt, qf, 64 * t, 0, qpos, r32, hi, vlane);
            done = __all(R < -150.f) != 0;
        }
        if (lane == 0) flags[(it & 1) * 8 + wid] = done ? 0 : 1;
        if (more) SB_STORE((it + 1) & 1);
        __syncthreads();
        int any = 0;
#pragma unroll
        for (int w = 0; w < 8; ++w) any |= flags[(it & 1) * 8 + w];
        if (!more || !any) break;
        --t;
    }
#undef SB_LOAD
#undef SB_STORE
    store_ot(ATT + (size_t)qpos * 1024 + head * 64, o, hi);
    __syncthreads();
}

#ifndef NSAREP
#define NSAREP 0
#endif
#define NSA_NREP(bit) (((NSAREP >> (bit)) & 1) ? 2 : 1)
constexpr int N_LUT = 2 * T_BUF, N_IMP = N_LUT + 16384, N_OSTR = 68, N_BLKQ = N_IMP + 256 * N_OSTR * 4, N_L = N_BLKQ + 2048, N_REF = N_L + 1280, N_END = N_REF + 1024 + 64;
constexpr int N_QS = 144;
struct NsaT {
    const bf16_t* PROJ;
    const bf16_t* KCMP; const bf16_t* VCMP;
    const bf16_t* KS; const bf16_t* VTS;
    const bf16_t* KW;
    const float* GN;
    const float* LUT8;
    bf16_t* ATT;
    float kb, bmax;
    unsigned long long* tp;
};
__host__ __device__ __forceinline__ int vts_key_of_slot(int slot) { const int hh = slot >> 5, s5 = slot & 31, s = s5 >> 4, h = (s5 >> 3) & 1, j = s5 & 7; return 32 * hh + 16 * s + 8 * (j >> 2) + 4 * h + (j & 3); }

DI void nsa_load_lut(LAS char* lds, const float* LUT8, int g, int tid) { LAS float* lut = (LAS float*)(lds + N_LUT); for (int i = tid; i < 4096; i += 512) lut[i] = LUT8[(i >> 2) * 8 + g * 4 + (i & 3)]; }
DI void nsa_unit(LAS char* lds, const NsaT& T, int g, int qblk, int wave_id) {
    int tid_l = wave_id * 64 + lane_id(); asm volatile("" : "+v"(tid_l));
    const int tid = tid_l, lane = tid & 63, wid = rfl(tid >> 6), r32 = lane & 31, hi = lane >> 5;
    const int q0 = qblk * 64;
    TP_BEGIN(6)
    LAS float* lut = (LAS float*)(lds + N_LUT);
    LAS float* imp = (LAS float*)(lds + N_IMP);
    LAS unsigned* bq32 = (LAS unsigned*)(lds + N_BLKQ);
    LAS float* refl = (LAS float*)(lds + N_REF);
    bq32[tid] = 0u;
    const int ql = r32 >> 2, hd = r32 & 3, h8 = g * 4 + hd, tq = q0 + 8 * wid + ql;
    bf16x8 qf[4];
    { const bf16_t* qp = T.PROJ + (size_t)tq * 5632 + 768 + h8 * 64 + hi * 8;
#pragma unroll
      for (int d0 = 0; d0 < 4; ++d0) qf[d0] = *(const bf16x8*)(qp + d0 * 16); }
    float ref;
    { float qs = 0.f;
#pragma unroll
      for (int d0 = 0; d0 < 4; ++d0)
#pragma unroll
          for (int e = 0; e < 8; ++e) { const float v = __uint_as_float(((unsigned)(unsigned short)qf[d0][e]) << 16); qs += v * v; }
      qs += sx32(qs, hi); ref = sqrtf(qs) * T.kb + T.bmax; }
    if (hi == 0) refl[(8 * wid + ql) * 4 + hd] = ref;
    const float gc = T.GN[(size_t)tq * 24 + 3 * h8], gs = T.GN[(size_t)tq * 24 + 3 * h8 + 1], gw = T.GN[(size_t)tq * 24 + 3 * h8 + 2];
    const int srow = tid >> 3, sch = tid & 7;
    const int vlane = (4 * hi + ((lane & 15) >> 2)) * T_KS + 2 * (16 * ((lane >> 4) & 1) + 4 * (lane & 3));
    u32x4 kr, vr;
    __syncthreads();
    const float cfar = lut[1023 * 4 + hd] - ref;
    const int nmax = (q0 + 32) / 16 + 1;
    const int ntc = (nmax + 63) >> 6;
    const bf16_t* kc = T.KCMP + (size_t)g * 1024 * 64; const bf16_t* vc = T.VCMP + (size_t)g * 1024 * 64;
    const int relq = tq - 31;
    const int relw = q0 + 8 * wid - 31;
    float l = 0.f; float inv_l = 0.f; f32x16 oa[2];
    { TP_BEGIN(4)
    for (int rp_ = 0; rp_ < NSA_NREP(0); ++rp_) { l = 0.f;
    u32x4 kq, vq;
    u32x4 v2a = *(const u32x4*)(vc + (size_t)srow * 64 + sch * 8), v2b = v2a; if (1 < ntc) v2b = *(const u32x4*)(vc + (size_t)(64 + srow) * 64 + sch * 8);
    kr = *(const u32x4*)(kc + (size_t)srow * 64 + sch * 8);
    *(LAS u32x4*)(lds + srow * T_KS + sch * 16) = kr; kq = kr;
    if (1 < ntc) kq = *(const u32x4*)(kc + (size_t)(64 + srow) * 64 + sch * 8);
    LDS_BAR();
    for (int j = 0; j < ntc; ++j) {
        const bool more = j + 1 < ntc;
        if (j + 2 < ntc) kr = *(const u32x4*)(kc + (size_t)(64 * (j + 2) + srow) * 64 + sch * 8);
        const LAS char* kt = lds + (j & 1) * T_BUF;
#pragma unroll
        for (int hh = 0; hh < 2; ++hh) {
            f32x16 s = qk32<64, T_KS>(kt + (32 * hh + r32) * T_KS + hi * 16, qf);
            const int n0 = 64 * j + 32 * hh;
            if (relw - 16 * (n0 + 31) >= 790) {
#pragma unroll
                for (int r = 0; r < 16; ++r) l += fast_exp2(s[r] + cfar);
            } else {
#pragma unroll
                for (int r = 0; r < 16; ++r) { const int rel = relq - 16 * (n0 + crow(r, hi)); l += (rel >= 0) ? fast_exp2(s[r] + lut[(rel < 1023 ? rel : 1023) * 4 + hd] - ref) : 0.f; }
            }
        }
        if (more) *(LAS u32x4*)(lds + ((j + 1) & 1) * T_BUF + srow * T_KS + sch * 16) = kq;
        kq = kr;
        LDS_BAR();
    }
    l = sum32sym(l);
    inv_l = l > 0.f ? 1.f / l : 0.f;
#pragma unroll
    for (int i = 0; i < 16; ++i) { oa[0][i] = 0.f; oa[1][i] = 0.f; }
    float cprev = 0.f;
    kr = *(const u32x4*)(kc + (size_t)srow * 64 + sch * 8); vr = v2a;
    { LAS char* d_ = lds + srow * T_KS + sch * 16; *(LAS u32x4*)d_ = kr; *(LAS u32x4*)(d_ + T_KB) = vr; } kq = kr; vq = vr;
    if (1 < ntc) { kq = *(const u32x4*)(kc + (size_t)(64 + srow) * 64 + sch * 8); vq = v2b; }
    LDS_BAR();
    for (int j = 0; j < ntc; ++j) {
        const bool more = j + 1 < ntc;
        if (j + 2 < ntc) { kr = *(const u32x4*)(kc + (size_t)(64 * (j + 2) + srow) * 64 + sch * 8); vr = *(const u32x4*)(vc + (size_t)(64 * (j + 2) + srow) * 64 + sch * 8); }
        const LAS char* kt = lds + (j & 1) * T_BUF; const LAS char* vt = kt + T_KB;
#pragma unroll
        for (int hh = 0; hh < 2; ++hh) {
            f32x16 s = qk32<64, T_KS>(kt + (32 * hh + r32) * T_KS + hi * 16, qf);
            const int n0 = 64 * j + 32 * hh;
            if (relw - 16 * (n0 + 31) >= 790) {
#pragma unroll
                for (int r = 0; r < 16; ++r) s[r] = fast_exp2(s[r] + cfar) * inv_l;
            } else {
#pragma unroll
                for (int r = 0; r < 16; ++r) { const int rel = relq - 16 * (n0 + crow(r, hi)); s[r] = (rel >= 0) ? fast_exp2(s[r] + lut[(rel < 1023 ? rel : 1023) * 4 + hd] - ref) * inv_l : 0.f; }
            }
            float gsm[4], c3[4], pc3[4];
#pragma unroll
            for (int gi = 0; gi < 4; ++gi) { float a = (s[4 * gi] + s[4 * gi + 1]) + (s[4 * gi + 2] + s[4 * gi + 3]), b = s[4 * gi + 3];
                a += sx<1>(a); a += sx<2>(a); b += sx<1>(b); b += sx<2>(b); gsm[gi] = a; c3[gi] = b; }
#pragma unroll
            for (int gi = 0; gi < 4; ++gi) pc3[gi] = sx32(c3[gi], hi);
            const int b0 = 16 * j + 8 * hh + hi;
            if (hd == 0) {
                LAS float* ip = imp + (8 * wid + ql) * 256 + b0;
                if (hi == 1) {
#pragma unroll
                    for (int gi = 0; gi < 4; ++gi) ip[2 * gi] = gsm[gi] + pc3[gi];
                } else { ip[0] = gsm[0] + cprev; ip[2] = gsm[1] + pc3[0]; ip[4] = gsm[2] + pc3[1]; ip[6] = gsm[3] + pc3[2]; }
            }
            cprev = pc3[3];
            pv32<T_KS>(oa, vt + (32 * hh) * T_KS + vlane, pack8(s, 0), pack8(s, 1));
        }
        if (more) { LAS char* d_ = lds + ((j + 1) & 1) * T_BUF + srow * T_KS + sch * 16; *(LAS u32x4*)d_ = kq; *(LAS u32x4*)(d_ + T_KB) = vq; }
        kq = kr; vq = vr;
        LDS_BAR();
    }
    }
    TP_END(4, T.tp); }
#pragma unroll
    for (int i = 0; i < 16; ++i) { oa[0][i] *= gc; oa[1][i] *= gc; }
    store_ot(T.ATT + (size_t)tq * 1024 + 256 + h8 * 64, oa, hi);
    { TP_BEGIN(3)
    for (int rp_ = 0; rp_ < NSA_NREP(1); ++rp_) {
    unsigned ones = 0xffffffffu; asm volatile("" : "+v"(ones));
    if (qblk < 16) {
        if (tid <= qblk) { bq32[2 * tid] = ones; bq32[2 * tid + 1] = ones; }
    } else {
        if (tid == 0) { bq32[0] = ones; bq32[1] = ones; bq32[2 * qblk] = ones; bq32[2 * qblk + 1] = ones; bq32[2 * qblk - 2] = ones; bq32[2 * qblk - 1] = ones; }
        unsigned kv[8][4];
#pragma unroll
        for (int q = 0; q < 8; ++q)
#pragma unroll
            for (int i = 0; i < 4; ++i) { const int b = lane + 64 * i; kv[q][i] = (b >= 1 && b <= qblk - 2) ? __float_as_uint(imp[(8 * wid + q) * 256 + b]) + 1u : 0u; }
        unsigned T8[8];
#pragma unroll
        for (int q = 0; q < 8; ++q) T8[q] = 0u;
        for (int bit = 31; bit >= 0; --bit) {
#pragma unroll
            for (int q = 0; q < 8; ++q) { const unsigned t2 = T8[q] | (1u << bit);
                const int cnt = __builtin_popcountll(__builtin_amdgcn_ballot_w64(kv[q][0] >= t2)) + __builtin_popcountll(__builtin_amdgcn_ballot_w64(kv[q][1] >= t2))
                              + __builtin_popcountll(__builtin_amdgcn_ballot_w64(kv[q][2] >= t2)) + __builtin_popcountll(__builtin_amdgcn_ballot_w64(kv[q][3] >= t2));
                T8[q] = (cnt >= 13) ? t2 : T8[q]; }
        }
#pragma unroll
        for (int q = 0; q < 8; ++q) { const unsigned Tq = T8[q];
            int quota = 13 - (__builtin_popcountll(__builtin_amdgcn_ballot_w64(kv[q][0] > Tq)) + __builtin_popcountll(__builtin_amdgcn_ballot_w64(kv[q][1] > Tq))
                            + __builtin_popcountll(__builtin_amdgcn_ballot_w64(kv[q][2] > Tq)) + __builtin_popcountll(__builtin_amdgcn_ballot_w64(kv[q][3] > Tq)));
            const int qi = 8 * wid + q;
#pragma unroll
            for (int i = 0; i < 4; ++i) {
                const unsigned long long me = __builtin_amdgcn_ballot_w64(kv[q][i] == Tq); const int pe = __builtin_popcountll(me); const int take = pe < quota ? pe : quota;
                unsigned long long km = 0ull, mm = me; for (int t_ = 0; t_ < take; ++t_) { km |= mm & (0ull - mm); mm &= mm - 1ull; }
                quota -= take;
                const bool tie = (lane < 32 ? (unsigned)km >> lane : (unsigned)(km >> 32) >> (lane - 32)) & 1u;
                if (kv[q][i] > Tq || (kv[q][i] == Tq && tie)) (void)__hip_atomic_fetch_or(bq32 + 2 * (lane + 64 * i) + (qi >> 5), 1u << (qi & 31), __ATOMIC_RELAXED, __HIP_MEMORY_SCOPE_WORKGROUP);
            }
        }
    }
    }
    TP_END(3, T.tp); }
    __syncthreads();
    {
        LAS float* slot = (LAS float*)(lds + N_IMP);
        LAS unsigned short* items = (LAS unsigned short*)(lds + N_L);
        volatile LAS int* nitems = (volatile LAS int*)(lds + N_L + 768);
        LAS unsigned* smask = (LAS unsigned*)(lds + N_L + 832);
        LAS unsigned char* npv = (LAS unsigned char*)(lds + N_L + 896);
        LAS int* part = (LAS int*)(lds + N_REF + 1024);
        if (tid < 256) { int np = 0; if (qblk >= 16 && tid >= 1 && tid <= qblk - 2) { const unsigned long long mk = ((unsigned long long)bq32[2 * tid + 1] << 32) | bq32[2 * tid]; np = (__builtin_popcountll(mk) + 7) >> 3; } npv[tid] = (unsigned char)np; }
        __syncthreads();
        if (tid < 16) { int sm = 0;
#pragma unroll
            for (int k = 0; k < 16; ++k) sm += npv[16 * tid + k]; part[tid] = sm; }
        __syncthreads();
        if (tid == 0) { int run = 0;
#pragma unroll
            for (int k = 0; k < 16; ++k) { const int v = part[k]; part[k] = run; run += v; } *nitems = run; }
        __syncthreads();
        if (tid < 256) { int st = part[tid >> 4]; for (int k = 0; k < (tid & 15); ++k) st += npv[(tid & ~15) + k]; const int np = npv[tid]; for (int pp = 0; pp < np; ++pp) items[st + pp] = (unsigned short)(tid | (pp << 8)); }
        { const int q = tid >> 3, c8 = tid & 7; const bf16_t* src = T.PROJ + (size_t)(q0 + q) * 5632 + 768 + g * 256 + c8 * 32; LAS char* dst = lds + (q * 4 + (c8 >> 1)) * N_QS + (c8 & 1) * 64;
#pragma unroll
          for (int i = 0; i < 4; ++i) *(LAS u32x4*)(dst + 16 * i) = *(const u32x4*)(src + 8 * i); }
        __syncthreads();
        const bf16_t* ksg = T.KS + (size_t)g * 256 * 4096 + lane * 8;
        const bf16_t* vtg = T.VTS + (size_t)g * 256 * 4096 + lane * 8;
        const int jslot = r32 >> 2;
        const int myq = 8 * wid + ql; const unsigned qmlo = myq < 32 ? ((1u << myq) - 1u) : 0xffffffffu, qmhi = myq < 32 ? 0u : ((1u << (myq - 32)) - 1u);
        const float biasfar = lut[1023 * 4 + hd];
        float lpart = 0.f, lfull = 0.f; f32x16 os[2];
        for (int rp_ = 0; rp_ < NSA_NREP(2); ++rp_) { lpart = 0.f; lfull = 0.f;
#pragma unroll
        for (int i = 0; i < 16; ++i) { os[0][i] = 0.f; os[1][i] = 0.f; }
        bf16x8 kf[2][4], vf[2][2][2];
#define NSA_LDK(B) do { const bf16_t* p_ = ksg + (size_t)(B) * 4096; _Pragma("unroll") for (int hh = 0; hh < 2; ++hh) _Pragma("unroll") for (int d0 = 0; d0 < 4; ++d0) kf[hh][d0] = *(const bf16x8*)(p_ + (hh * 4 + d0) * 512); } while (0)
#define NSA_LDV(B) do { const bf16_t* p_ = vtg + (size_t)(B) * 4096; _Pragma("unroll") for (int hh = 0; hh < 2; ++hh) _Pragma("unroll") for (int dh = 0; dh < 2; ++dh) _Pragma("unroll") for (int s = 0; s < 2; ++s) vf[hh][dh][s] = *(const bf16x8*)(p_ + ((hh * 2 + dh) * 2 + s) * 512); } while (0)
#define NSA_SCORE(B, QF, INI, TS, OK, LS) do { \
            _Pragma("unroll") for (int hh = 0; hh < 2; ++hh) { _Pragma("unroll") for (int i = 0; i < 16; ++i) sc[hh][i] = (INI); \
                _Pragma("unroll") for (int d0 = 0; d0 < 4; ++d0) sc[hh] = mfma32(kf[hh][d0], (QF)[d0], sc[hh]); } \
            if (q0 - (64 * (B) + 63) >= 790) { _Pragma("unroll") for (int hh = 0; hh < 2; ++hh) _Pragma("unroll") for (int r = 0; r < 16; ++r) { const float p = (OK) ? fast_exp2(sc[hh][r]) : 0.f; sc[hh][r] = p; LS += p; } } \
            else { _Pragma("unroll") for (int hh = 0; hh < 2; ++hh) _Pragma("unroll") for (int r = 0; r < 16; ++r) { const int rel = (TS) - (64 * (B) + 32 * hh + crow(r, hi)); const int rc = rel < 0 ? 0 : (rel < 1023 ? rel : 1023); \
                const float p = ((OK) && rel >= 0) ? fast_exp2(sc[hh][r] + lut[rc * 4 + hd]) : 0.f; sc[hh][r] = p; LS += p; } } } while (0)
#define NSA_PV(O) do { _Pragma("unroll") for (int hh = 0; hh < 2; ++hh) { const bf16x8 p0 = pack8(sc[hh], 0), p1 = pack8(sc[hh], 1); \
            _Pragma("unroll") for (int dh = 0; dh < 2; ++dh) { (O)[dh] = mfma32(vf[hh][dh][0], p0, (O)[dh]); (O)[dh] = mfma32(vf[hh][dh][1], p1, (O)[dh]); } } } while (0)
        f32x16 sc[2];
        { TP_BEGIN(2) const int nf = qblk < 16 ? qblk + 1 : 3;
          { const int fb0 = 0; NSA_LDK(fb0); NSA_LDV(fb0); }
          for (int fi = 0; fi < nf; ++fi) { const int fb = qblk < 16 ? fi : (fi == 0 ? 0 : qblk - 2 + fi); const int fn = qblk < 16 ? fi + 1 : qblk - 1 + fi;
            const float ini = ((q0 - (64 * fb + 63) >= 790) ? biasfar : 0.f) - ref;
            NSA_SCORE(fb, qf, ini, tq, true, lpart);
            if (fi + 1 < nf) NSA_LDK(fn);
            NSA_PV(os);
            if (fi + 1 < nf) NSA_LDV(fn); } TP_END(2, T.tp); }
        TP_BEGIN(1)
        const int ni = *nitems; unsigned long long tpacc_ = 0;
        int it_b = -1, it_p = 0;
        if (wid < ni) { const int e = items[wid]; it_b = e & 255; it_p = e >> 8; NSA_LDK(it_b); NSA_LDV(it_b); }
        for (int i0 = 0; i0 < ni; i0 += 8) {
            const int inext = i0 + 8 + wid; int nb_ = -1, np_ = 0;
            if (inext < ni) { const int e = items[inext]; nb_ = e & 255; np_ = e >> 8; }
            unsigned long long msk = 0ull;
            unsigned long long tpa_ = 0; if (TPROBE == 11 || TPROBE == 12 || TPROBE == 13) tpa_ = tp_now();
            if (it_b >= 0) {
                unsigned long long m_ = ((unsigned long long)(unsigned)rfl((int)bq32[2 * it_b + 1]) << 32) | (unsigned)rfl((int)bq32[2 * it_b]);
                for (int i_ = 0; i_ < 8 * it_p; ++i_) m_ &= m_ - 1ull;
                unsigned long long t_ = m_; for (int i_ = 0; i_ < 8; ++i_) t_ &= t_ - 1ull;
                msk = m_ & ~t_;
                int qsel = -1; { unsigned long long mm = msk;
#pragma unroll
                    for (int j = 0; j < 8; ++j) { const int qj = mm ? (int)__builtin_ctzll(mm) : -1; mm &= mm - 1ull; if (jslot == j) qsel = qj; } }
                const bool valid = qsel >= 0; const int row = (valid ? qsel : 0) * 4 + hd, ts = q0 + (valid ? qsel : 0);
                const float ini = ((q0 - (64 * it_b + 63) >= 790) ? biasfar : 0.f) - refl[row];
                bf16x8 qv[4];
#pragma unroll
                for (int d0 = 0; d0 < 4; ++d0) qv[d0] = *(const LAS bf16x8*)(lds + row * N_QS + d0 * 32 + hi * 16);
                float ls = 0.f;
                NSA_SCORE(it_b, qv, ini, ts, valid, ls);
                if (nb_ >= 0) NSA_LDK(nb_);
                f32x16 ot[2];
#pragma unroll
                for (int i = 0; i < 16; ++i) { ot[0][i] = 0.f; ot[1][i] = 0.f; }
                NSA_PV(ot);
                if (nb_ >= 0) NSA_LDV(nb_);
                ls = sum32sym(ls);
                LAS float* sp = slot + (wid * 32 + r32) * N_OSTR;
#pragma unroll
                for (int dh = 0; dh < 2; ++dh)
#pragma unroll
                    for (int g4 = 0; g4 < 4; ++g4) *(LAS f32x4*)(sp + 32 * dh + 8 * g4 + 4 * hi) = (f32x4){ot[dh][4 * g4], ot[dh][4 * g4 + 1], ot[dh][4 * g4 + 2], ot[dh][4 * g4 + 3]};
                if (hi == 0) sp[64] = ls;
            }
            if (lane == 0) { smask[2 * wid] = (unsigned)msk; smask[2 * wid + 1] = (unsigned)(msk >> 32); }
            if (TPROBE == 11) tpacc_ += tp_now() - tpa_;
            if (TPROBE == 12 || TPROBE == 13) tpa_ = tp_now();
            LDS_BAR();
            if (TPROBE == 12) tpacc_ += tp_now() - tpa_;
            if (TPROBE == 13) tpa_ = tp_now();
            const unsigned smv = smask[lane & 15];
#pragma unroll
            for (int w = 0; w < 8; ++w) {
                const unsigned mlo = (unsigned)__builtin_amdgcn_readlane((int)smv, 2 * w), mhi = (unsigned)__builtin_amdgcn_readlane((int)smv, 2 * w + 1);
                const unsigned long long mw = ((unsigned long long)mhi << 32) | mlo;
                if ((unsigned)(mw >> (8 * wid)) & 0xffu) {
                    const bool has = (myq < 32 ? (mlo >> myq) : (mhi >> (myq - 32))) & 1u;
                    const int j = __builtin_popcount(mlo & qmlo) + __builtin_popcount(mhi & qmhi);
                    const LAS float* sp = slot + (w * 32 + (has ? j : 0) * 4 + hd) * N_OSTR;
                    f32x4 v[2][4];
#pragma unroll
                    for (int dh = 0; dh < 2; ++dh)
#pragma unroll
                        for (int g4 = 0; g4 < 4; ++g4) v[dh][g4] = *(const LAS f32x4*)(sp + 32 * dh + 8 * g4 + 4 * hi);
                    const float lv = sp[64];
                    if (has) {
#pragma unroll
                        for (int dh = 0; dh < 2; ++dh)
#pragma unroll
                            for (int g4 = 0; g4 < 4; ++g4) { os[dh][4 * g4] += v[dh][g4].x; os[dh][4 * g4 + 1] += v[dh][g4].y; os[dh][4 * g4 + 2] += v[dh][g4].z; os[dh][4 * g4 + 3] += v[dh][g4].w; }
                        lfull += lv; }
                }
            }
            if (TPROBE == 13) tpacc_ += tp_now() - tpa_;
            LDS_BAR();
            it_b = nb_; it_p = np_;
        }
        TP_END(1, T.tp);
        if ((TPROBE == 11 || TPROBE == 12 || TPROBE == 13) && lane == 0) atomicAdd(T.tp, tpacc_);
#undef NSA_LDK
#undef NSA_LDV
#undef NSA_SCORE
#undef NSA_PV
        }
        { const float f = gs / (sum32sym(lpart) + lfull);
#pragma unroll
          for (int i = 0; i < 16; ++i) { oa[0][i] = f * os[0][i]; oa[1][i] = f * os[1][i]; } }
        { const bf16_t* qp = T.PROJ + (size_t)tq * 5632 + 768 + h8 * 64 + hi * 8;
#pragma unroll
          for (int d0 = 0; d0 < 4; ++d0) qf[d0] = *(const bf16x8*)(qp + d0 * 16); }
        __syncthreads();
    }
    {
        const bf16_t* kw = T.KW + (size_t)g * 16384 * 64; const bf16_t* vw = T.PROJ + 1920 + g * 64;
        const int kt0 = qblk > 8 ? qblk - 8 : 0, ntw = qblk - kt0 + 1;
        float lw = 0.f; f32x16 ow[2];
        TP_BEGIN(5)
        for (int rp_ = 0; rp_ < NSA_NREP(3); ++rp_) { lw = 0.f;
#pragma unroll
        for (int i = 0; i < 16; ++i) { ow[0][i] = 0.f; ow[1][i] = 0.f; }
#define WIN_LD(t, K_, V_) do { K_ = *(const u32x4*)(kw + (size_t)(64 * (t) + srow) * 64 + sch * 8); V_ = *(const u32x4*)(vw + (size_t)(64 * (t) + srow) * 5632 + sch * 8); } while (0)
        u32x4 kq, vq;
        WIN_LD(kt0, kr, vr);
        { LAS char* d_ = lds + srow * T_KS + sch * 16; *(LAS u32x4*)d_ = kr; *(LAS u32x4*)(d_ + T_KB) = vr; }
        kq = kr; vq = vr;
        if (1 < ntw) WIN_LD(kt0 + 1, kq, vq);
        LDS_BAR();
        for (int j = 0; j < ntw; ++j) {
            const bool more = j + 1 < ntw;
            if (j + 2 < ntw) WIN_LD(kt0 + j + 2, kr, vr);
            const LAS char* kt = lds + (j & 1) * T_BUF; const LAS char* vt = kt + T_KB;
            f32x16 p[2];
#pragma unroll
            for (int hh = 0; hh < 2; ++hh) { p[hh] = qk32<64, T_KS>(kt + (32 * hh + r32) * T_KS + hi * 16, qf);
#pragma unroll
                for (int r = 0; r < 16; ++r) { const int rel = tq - (64 * (kt0 + j) + 32 * hh + crow(r, hi)); const bool valid = rel >= 0 && rel < 512;
                    const float e = valid ? fast_exp2(p[hh][r] + lut[(rel < 0 ? 0 : rel) * 4 + hd] - ref) : 0.f; p[hh][r] = e; lw += e; } }
            pv64<T_KS>(ow, vt + vlane, p[0], p[1]);
            if (more) { LAS char* d_ = lds + ((j + 1) & 1) * T_BUF + srow * T_KS + sch * 16; *(LAS u32x4*)d_ = kq; *(LAS u32x4*)(d_ + T_KB) = vq; }
            kq = kr; vq = vr;
            LDS_BAR();
        }
#undef WIN_LD
        }
        TP_END(5, T.tp);
        lw = sum32sym(lw);
        const float f = gw / lw;
#pragma unroll
        for (int i = 0; i < 16; ++i) { oa[0][i] += f * ow[0][i]; oa[1][i] += f * ow[1][i]; }
        { const bf16_t* ap = T.ATT + (size_t)tq * 1024 + 256 + h8 * 64;
#pragma unroll
          for (int dh = 0; dh < 2; ++dh)
#pragma unroll
              for (int g4 = 0; g4 < 4; ++g4) { const u32x2 w = *(const u32x2*)(ap + 32 * dh + 8 * g4 + 4 * hi); oa[dh][4 * g4] += bflo(w.x); oa[dh][4 * g4 + 1] += bfhi(w.x); oa[dh][4 * g4 + 2] += bflo(w.y); oa[dh][4 * g4 + 3] += bfhi(w.y); } }
        store_ot(T.ATT + (size_t)tq * 1024 + 256 + h8 * 64, oa, hi);
    }
    __syncthreads();
    TP_END(6, T.tp);
}
}
constexpr int S = 16384, DM = 1024, NPROJ = 5632, INC = 5560, DFF = 2816, EFF = 3584, NEXP = 8;
constexpr int NWAVES = 8;
constexpr float EPS = 1e-6f;
constexpr float QK_SCALE64 = 0.125f * LOG2E;
constexpr float QK_SCALE96 = 0.10206207261596575f * LOG2E;
#ifndef MK_MULTI
#define MK_MULTI 0
#endif
constexpr int PC_SBQ = 0, PC_SBK = 256, PC_SBV = 512, PC_NQ = 768, PC_NKC = 1280, PC_NVC = 1408, PC_NKS = 1536, PC_NVS = 1664, PC_NKW = 1792, PC_NVW = 1920,
              PC_CQ = 2048, PC_CKV = 2304, PC_KR = 2432, PC_NG = 2464, PC_GATE = 2560;
__host__ __device__ __forceinline__ int win_oldcol(int c) {
    if (c < 2048) return c; if (c < 2464) return c + 24; if (c < 2488) return 2048 + (c - 2464); if (c < 2560) return -1; return c - 72; }

constexpr size_t MiB = 1u << 20;
constexpr size_t WS_CTL = 0, CTL_ZERO_BYTES = 1 * MiB;
constexpr size_t WS_LW = 1 * MiB, LW_STRIDE = 18 * MiB;
constexpr size_t LW_WIN = 0, LW_SBO = 11 * MiB, LW_NSAO = LW_SBO + MiB / 2, LW_MLAO = LW_NSAO + MiB, LW_WOUT = LW_MLAO + MiB / 2, LW_WUQ = LW_WOUT + 2 * MiB, LW_WUKV = LW_WUQ + MiB / 4, LW_CW1 = LW_WUKV + MiB / 4;
constexpr size_t WS_DGU = 37 * MiB, WS_DDN = 48 * MiB;
constexpr size_t WS_Y = 1 * MiB;
constexpr size_t WS_H = 74 * MiB;
constexpr size_t WS_ROPE = 106 * MiB;
constexpr size_t WS_LUT8 = 108 * MiB, WS_B1P = WS_LUT8 + 256 * 1024, WS_B1 = WS_LUT8 + 512 * 1024, WS_ROUTE = 109 * MiB, WS_ROWTOK = WS_ROUTE + 512 * 1024;
constexpr size_t WS_R1 = 110 * MiB;
constexpr size_t WS_MGU = WS_R1, WS_MDN = WS_R1 + 112 * MiB;
constexpr size_t WS_R2 = 296 * MiB;
constexpr size_t R2_KC = 0, R2_VC = R2_KC + 4 * MiB + MiB / 4, R2_KS = R2_VC + 4 * MiB + MiB / 4, R2_VTS = R2_KS + 4 * MiB, R2_KW = R2_VTS + 4 * MiB, R2_GN = R2_KW + 4 * MiB,
                 R2_QM = R2_GN + 2 * MiB, R2_KM = R2_QM + 12 * MiB, R2_HID = R2_KM + 12 * MiB, R2_KCMP = R2_HID + 2 * MiB, R2_VCMP = R2_KCMP + MiB / 4, R2_ATT = R2_VCMP + MiB / 4 + MiB / 2,
                 R2_MRG = R2_ATT + 32 * MiB, R2_QRAW = R2_MRG, R2_KVRAW = R2_MRG + 16 * MiB, R2_HIDP = R2_MRG + 32 * MiB  , R2_END = R2_HIDP + 16 * MiB;
static_assert(R2_END <= 136 * MiB, "attention scratch");
constexpr size_t WS_END = 432 * MiB;
constexpr int KC_ROWS = S + 32;
constexpr int CW_TMO = 0, CW_BAR = 4096, CW_MOECNT = 16384, CW_NSAQ = 17408, CW_SPLIT = 18432;
constexpr int RING_BYTES = 131072, LDSCTL_OFF = RING_BYTES, MISC_OFF = LDSCTL_OFF + 320, LDS_BYTES = 147456;


#define LDS_WAIT() asm volatile("s_waitcnt lgkmcnt(0)" ::: "memory")
#define VM_WAIT() asm volatile("s_waitcnt vmcnt(0)" ::: "memory")
DI float wave_sum(float v) { v += sx<1>(v); v += sx<2>(v); v += sx<4>(v); v += sx<8>(v); v += sx<16>(v); return sum32sym(v); }

struct TrSrc { const float* a; const float* b; int ldn; int nsrc; int mode; };
DI f32x4 tr_fetch4(const TrSrc& s, int k, int n) {
    const f32x4 z = {0.f, 0.f, 0.f, 0.f};
    if (s.mode == 0) return n < s.nsrc ? *(const f32x4*)(s.a + (size_t)k * s.ldn + n) : z;
    if (s.mode == 1) { const int oc = win_oldcol(n); return oc >= 0 ? *(const f32x4*)(s.a + (size_t)k * s.ldn + oc) : z; }
    const int tile = n >> 8, w = n & 255; const long d = (w < 128) ? 0l : (long)((const char*)s.b - (const char*)s.a);
    return *(const f32x4*)((const float*)((const char*)s.a + d) + (size_t)k * s.ldn + 128 * tile + (w & 127));
}
DI void tr_load(const TrSrc& s, int kb, int nb, int lane, f32x4 (&v)[8]) {
    const int k0 = 64 * kb, n0 = 32 * nb, r8 = lane >> 3, n4 = (lane & 7) * 4;
#pragma unroll
    for (int i = 0; i < 8; ++i) v[i] = tr_fetch4(s, k0 + r8 + 8 * i, n0 + n4);
}
DI void tr_store(const f32x4 (&v)[8], int K, bf16_t* WT, LAS float* scr, int kb, int nb, int lane) {
    const int k0 = 64 * kb, n0 = 32 * nb, r8 = lane >> 3, n4 = (lane & 7) * 4;
#pragma unroll
    for (int i = 0; i < 8; ++i) { LAS float* d = scr + (r8 + 8 * i) * 33 + n4; d[0] = v[i].x; d[1] = v[i].y; d[2] = v[i].z; d[3] = v[i].w; }
    LDS_WAIT(); asm volatile("" ::: "memory");
    const int c = lane & 7;
#pragma unroll
    for (int j = 0; j < 4; ++j) { const int n = (lane >> 3) + 8 * j; const LAS float* p = scr + (8 * c) * 33 + n;
        u32x4 o; o.x = cvtpk(p[0 * 33], p[1 * 33]); o.y = cvtpk(p[2 * 33], p[3 * 33]); o.z = cvtpk(p[4 * 33], p[5 * 33]); o.w = cvtpk(p[6 * 33], p[7 * 33]);
        *(u32x4*)(WT + (size_t)(n0 + n) * K + k0 + 8 * c) = o; }
    LDS_WAIT(); asm volatile("" ::: "memory");
}
DI void tr_item(const TrSrc& s, int K, bf16_t* WT, LAS float* scr, int kb, int nb, int lane) { f32x4 v[8]; tr_load(s, kb, nb, lane, v); tr_store(v, K, WT, scr, kb, nb, lane); }
DI void tr_matrix(const TrSrc& s, int K, int ndst, bf16_t* WT, LAS float* scr, int gw, int ngw, int lane, int& off) {
    const int nblk = ndst / 32, nitems = (K / 64) * nblk;
    int st = gw - off; if (st < 0) st += ngw;
    if (st < nitems) { f32x4 v[8], w[8]; tr_load(s, st / nblk, st % nblk, lane, v);
        for (int it = st; it < nitems; it += ngw) { const int nx = it + ngw; if (nx < nitems) tr_load(s, nx / nblk, nx % nblk, lane, w);
            tr_store(v, K, WT, scr, it / nblk, it % nblk, lane);
#pragma unroll
            for (int i = 0; i < 8; ++i) v[i] = w[i]; } }
    off = (off + nitems) % ngw;
}

DI void tr_batch(const float* a, const float* b, size_t sstride, int ldn, int nsrc, int mode, int K, int ndst, bf16_t* WT, size_t dstride, int nexp, LAS float* scr, int gw, int ngw, int lane, int& off) {
    const int nblk = ndst / 32, per = (K / 64) * nblk, nitems = nexp * per;
    int st = gw - off; if (st < 0) st += ngw;
    if (st < nitems) { f32x4 v[8], w[8];
        { const int e = st / per, r = st % per; tr_load(TrSrc{a + (size_t)e * sstride, b ? b + (size_t)e * sstride : nullptr, ldn, nsrc, mode}, r / nblk, r % nblk, lane, v); }
        for (int it = st; it < nitems; it += ngw) { const int nx = it + ngw;
            if (nx < nitems) { const int e = nx / per, r = nx % per; tr_load(TrSrc{a + (size_t)e * sstride, b ? b + (size_t)e * sstride : nullptr, ldn, nsrc, mode}, r / nblk, r % nblk, lane, w); }
            { const int e = it / per, r = it % per; tr_store(v, K, WT + (size_t)e * dstride, scr, r / nblk, r % nblk, lane); }
#pragma unroll
            for (int i = 0; i < 8; ++i) v[i] = w[i]; } }
    off = (off + nitems) % ngw;
}

struct In {
    const float *x, *bias_table, *mix_norm, *w_in, *b_gate, *sb_w_o, *nsa_q_norm, *nsa_k_norm, *nsa_cmp_pos, *nsa_cmp_w1, *nsa_cmp_w2, *nsa_w_o, *mla_q_a_norm, *mla_kv_a_norm,
        *mla_w_uq, *mla_w_ukv, *mla_q_norm, *mla_k_norm, *mla_w_o, *w_out, *ffn_norm, *dense_w_gate, *dense_w_up, *dense_w_down, *moe_router, *moe_w_gate, *moe_w_up, *moe_w_down;
};
struct Args { In in; float* out; unsigned char* ws; int ph_lo, ph_hi; };

DI void rms_row(const float* xrow, const float* gain, bf16_t* orow, int lane, f32x4 (&v)[4]) {
    const f32x4* xr = (const f32x4*)xrow + lane; float s = 0.f;
#pragma unroll
    for (int j = 0; j < 4; ++j) { v[j] = xr[64 * j]; s += (v[j].x * v[j].x + v[j].y * v[j].y) + (v[j].z * v[j].z + v[j].w * v[j].w); }
    const float rstd = 1.f / sqrtf(wave_sum(s) * (1.f / 1024.f) + EPS);
    u32x2* o8 = (u32x2*)orow + lane;
#pragma unroll
    for (int j = 0; j < 4; ++j) { const f32x4 g = ((const f32x4*)gain)[lane + 64 * j]; v[j] = v[j] * rstd * g; u32x2 w; w.x = cvtpk(v[j].x, v[j].y); w.y = cvtpk(v[j].z, v[j].w); o8[64 * j] = w; }
}

DI void rms_row2(const float* x0, const float* x1, const f32x4 (&gn)[4], bf16_t* o0, bf16_t* o1, int lane) {
    const f32x4* xa = (const f32x4*)x0 + lane; const f32x4* xb = (const f32x4*)x1 + lane; f32x4 a[4], b[4]; float sa = 0.f, sb = 0.f;
#pragma unroll
    for (int j = 0; j < 4; ++j) { a[j] = xa[64 * j]; b[j] = xb[64 * j]; }
#pragma unroll
    for (int j = 0; j < 4; ++j) { sa += (a[j].x * a[j].x + a[j].y * a[j].y) + (a[j].z * a[j].z + a[j].w * a[j].w); sb += (b[j].x * b[j].x + b[j].y * b[j].y) + (b[j].z * b[j].z + b[j].w * b[j].w); }
    const float ra = 1.f / sqrtf(wave_sum(sa) * (1.f / 1024.f) + EPS), rb = 1.f / sqrtf(wave_sum(sb) * (1.f / 1024.f) + EPS);
    u32x2* pa = (u32x2*)o0 + lane; u32x2* pb = (u32x2*)o1 + lane;
#pragma unroll
    for (int j = 0; j < 4; ++j) { const f32x4 g = gn[j]; const f32x4 va = a[j] * ra * g, vb = b[j] * rb * g;
        u32x2 w; w.x = cvtpk(va.x, va.y); w.y = cvtpk(va.z, va.w); pa[64 * j] = w; w.x = cvtpk(vb.x, vb.y); w.y = cvtpk(vb.z, vb.w); pb[64 * j] = w; }
}

DI int t5_bucket(int n) {
    if (n < 16) return n;
    int b = 16;
    b += n >= 21; b += n >= 27; b += n >= 35; b += n >= 46; b += n >= 59; b += n >= 77; b += n >= 99; b += n >= 128; b += n >= 166; b += n >= 216; b += n >= 280; b += n >= 363; b += n >= 470; b += n >= 609; b += n >= 790;
    return b;
}

struct MoeTab { int cnt[8]; int tb[9]; };
struct MoeGU {
    const volatile LAS int* tab; const bf16_t* Hb; const bf16_t* W; const int* rowtok; int t_lo, t_hi, G, c;
    DI bool next(int i, pg8::Unit& u) const {
        const int nrt = t_hi - t_lo; if (nrt <= 0) return false;
        const long L = (long)i * G + c; if (L >= (long)nrt * 28) return false;
        const int rt = t_lo + (int)(L % nrt), pn = (int)(L / nrt);
        int e = 0;
#pragma unroll
        for (int k = 1; k < 8; ++k) e += (tab[8 + k] <= rt) ? 1 : 0;
        const int j = rt - tab[8 + e], cnt = tab[e];
        u.a = Hb; u.b = W + ((size_t)e * 7168 + 256 * pn) * 1024; u.rows = rowtok + e * S + 256 * j; u.nvalid = (cnt - 256 * j) < 256 ? (cnt - 256 * j) : 256; u.pm = rt - t_lo; u.pn = pn; return true;
    }
};
struct MoeDN {
    const volatile LAS int* tab; const bf16_t* ACT; const bf16_t* W; int t_lo, t_hi, G, c;
    DI bool next(int i, pg8::Unit& u) const {
        const int nrt = t_hi - t_lo; if (nrt <= 0) return false;
        const long L = (long)i * G + c; if (L >= (long)nrt * 4) return false;
        const int rt = t_lo + (int)(L % nrt), pn = (int)(L / nrt);
        int e = 0;
#pragma unroll
        for (int k = 1; k < 8; ++k) e += (tab[8 + k] <= rt) ? 1 : 0;
        u.a = ACT + (size_t)(rt - t_lo) * 256 * EFF; u.b = W + ((size_t)e * 1024 + 256 * pn) * EFF; u.rows = nullptr; u.nvalid = 256; u.pm = rt; u.pn = pn; return true;
    }
};
constexpr int PH_PER_LAYER = 16, NPHASES = 1 + 2 * PH_PER_LAYER;
__global__ void __launch_bounds__(NWAVES * 64, 2) fwd_kernel(Args args) {
    extern __shared__ __attribute__((aligned(16))) unsigned char lds_raw[];
    LAS unsigned char* lds = (LAS unsigned char*)lds_raw;
    volatile LAS unsigned* MISC = (volatile LAS unsigned*)(lds + MISC_OFF);
    volatile LAS int* MTAB = (volatile LAS int*)(lds + MISC_OFF + 64);
    const int tid0 = threadIdx.x, wave = __builtin_amdgcn_readfirstlane(tid0 >> 6);
    const int G = gridDim.x, bid = blockIdx.x, vcu = (G % 8 == 0) ? (bid % 8) * (G / 8) + bid / 8 : bid;
    const int gw0 = vcu * NWAVES + wave, NGW = G * NWAVES;
    unsigned char* ws = args.ws; const In in = args.in;
    gu32* ctl = (gu32*)(ws + WS_CTL);
    for (int u = tid0; u < (LDS_BYTES - LDSCTL_OFF) / 4; u += NWAVES * 64) ((LAS unsigned*)(lds + LDSCTL_OFF))[u] = 0u;
    __syncthreads();
#if MK_MULTI
#define GRID_BAR() do { } while (0)
#else
    XcdBarrier bar = xcd_barrier_post((unsigned*)(ctl + CW_BAR), MISC + 8);
#define TPCTR ((unsigned long long*)(ctl + 20480))
#define GRID_BAR() do { TP_BEGIN(9) xcd_barrier(bar); TP_END(9, TPCTR); } while (0)
#endif
    const int lo = args.ph_lo, hi = args.ph_hi;
#ifndef ONLY_PHASE
#define ONLY_PHASE -1
#endif
#ifndef PHMASK
#define PHMASK 0x1ffff
#endif
#define PHON(n) ((ONLY_PHASE < 0 || ONLY_PHASE == (n)) && ((PHMASK >> ((n) == 99 ? 16 : (n))) & 1))
#ifndef REPMASK
#define REPMASK 0
#endif
#ifndef GREP
#define GREP 0
#endif
#define REPN(n) (((REPMASK >> ((n) == 99 ? 16 : (n))) & 1) ? 2 : 1)
#define IN(k) (lo <= (k) && (k) < hi)
#define SEAM(k) do { if (IN((k) + 1)) { unsigned long long tq0_ = 0; const bool tpk_ = (TPROBE >= 100) && (TPROBE - 100 == ((k) == 0 ? 16 : ((k) - 1) % 16)); if (tpk_) tq0_ = tp_now(); GRID_BAR(); if (tpk_ && lane_id() == 0) atomicAdd(TPCTR, tp_now() - tq0_); } } while (0)
#define PHASE_LOCALS int tid = wave * 64 + lane_id(); asm volatile("" : "+v"(tid)); const int lane = tid & 63; int gw = gw0; asm volatile("" : "+s"(gw)); unsigned char* wsl = ws; asm volatile("" : "+s"(wsl)); (void)lane; (void)gw; (void)wsl;

#define lw (wsl + WS_LW + (size_t)l * LW_STRIDE)
#define Hb ((bf16_t*)(wsl + WS_H))
#define PROJ ((bf16_t*)(wsl + WS_R1))
#define R2P(off) (wsl + WS_R2 + (off))
#define KC ((bf16_t*)R2P(R2_KC))
#define VC ((bf16_t*)R2P(R2_VC))
#define KS ((bf16_t*)R2P(R2_KS))
#define VTS ((bf16_t*)R2P(R2_VTS))
#define KW ((bf16_t*)R2P(R2_KW))
#define GN ((float*)R2P(R2_GN))
#define QM ((bf16_t*)R2P(R2_QM))
#define KM ((bf16_t*)R2P(R2_KM))
#define HID ((bf16_t*)R2P(R2_HID))
#define KCMP ((bf16_t*)R2P(R2_KCMP))
#define VCMP ((bf16_t*)R2P(R2_VCMP))
#define ATT ((bf16_t*)R2P(R2_ATT))
#define MRG ((bf16_t*)R2P(R2_MRG))
#define QRAW ((bf16_t*)R2P(R2_QRAW))
#define KVRAW ((bf16_t*)R2P(R2_KVRAW))
#define HIDP ((float*)R2P(R2_HIDP))
#define ROPE ((float*)(wsl + WS_ROPE))
#define LUT8 ((float*)(wsl + WS_LUT8))
#define B1P ((float*)(wsl + WS_B1P))
#define B1 ((float*)(wsl + WS_B1))
#define CONS (B1 + 2048)
#define ROUTE ((int*)(wsl + WS_ROUTE))
#define ROWTOK ((int*)(wsl + WS_ROWTOK))
    LAS float* scr = (LAS float*)(lds + wave * 16384);

    if (PHON(99) && IN(0)) { PHASE_LOCALS TP_BEGIN(36) for (int rep_ = 0; rep_ < REPN(99); ++rep_) {
        int troff = 0;
        for (int l = 0; l < 2; ++l) {
            tr_matrix(TrSrc{in.w_in + (size_t)l * 1024 * INC, nullptr, INC, INC, 1}, 1024, NPROJ, (bf16_t*)(lw + LW_WIN), scr, gw, NGW, lane, troff);
            tr_matrix(TrSrc{in.sb_w_o + (size_t)l * 256 * 1024, nullptr, 1024, 1024, 0}, 256, 1024, (bf16_t*)(lw + LW_SBO), scr, gw, NGW, lane, troff);
            tr_matrix(TrSrc{in.nsa_w_o + (size_t)l * 512 * 1024, nullptr, 1024, 1024, 0}, 512, 1024, (bf16_t*)(lw + LW_NSAO), scr, gw, NGW, lane, troff);
            tr_matrix(TrSrc{in.mla_w_o + (size_t)l * 256 * 1024, nullptr, 1024, 1024, 0}, 256, 1024, (bf16_t*)(lw + LW_MLAO), scr, gw, NGW, lane, troff);
            tr_matrix(TrSrc{in.w_out + (size_t)l * 1024 * 1024, nullptr, 1024, 1024, 0}, 1024, 1024, (bf16_t*)(lw + LW_WOUT), scr, gw, NGW, lane, troff);
            tr_matrix(TrSrc{in.mla_w_uq + (size_t)l * 256 * 384, nullptr, 384, 384, 0}, 256, 512, (bf16_t*)(lw + LW_WUQ), scr, gw, NGW, lane, troff);
            tr_matrix(TrSrc{in.mla_w_ukv + (size_t)l * 128 * 512, nullptr, 512, 512, 0}, 128, 512, (bf16_t*)(lw + LW_WUKV), scr, gw, NGW, lane, troff);
            for (int kv = 0; kv < 2; ++kv)
                tr_matrix(TrSrc{in.nsa_cmp_w1 + (size_t)(l * 2 + kv) * 2048 * 256, nullptr, 256, 256, 0}, 2048, 256, (bf16_t*)(lw + LW_CW1) + (size_t)kv * 256 * 2048, scr, gw, NGW, lane, troff);
        }
        tr_matrix(TrSrc{in.dense_w_gate, in.dense_w_up, DFF, DFF, 2}, 1024, 2 * DFF, (bf16_t*)(wsl + WS_DGU), scr, gw, NGW, lane, troff);
        tr_matrix(TrSrc{in.dense_w_down, nullptr, 1024, 1024, 0}, DFF, 1024, (bf16_t*)(wsl + WS_DDN), scr, gw, NGW, lane, troff);
        const int gt = vcu * 512 + tid, NT = G * 512;
        for (int i = gt; i < S * 16; i += NT) {
            const int pos = i >> 4, fi = i & 15; const float inv = powf(10000.f, -(float)fi / 16.f); const float ang = (float)pos * inv;
            const double rev = (double)ang * 0.15915494309189535; const float fr = (float)(rev - rint(rev));
            ROPE[i] = __builtin_amdgcn_cosf(fr); ROPE[S * 16 + i] = __builtin_amdgcn_sinf(fr); }
        for (int i = gt; i < 1024 * 8; i += NT) LUT8[i] = in.bias_table[t5_bucket(i >> 3) * 8 + (i & 7)] * LOG2E;
        if (gw == 0) {
            float bm = 0.f; for (int i = lane; i < 256; i += 64) bm = fmaxf(bm, fabsf(in.bias_table[i]));
            bm = fmaxf(bm, sx<1>(bm)); bm = fmaxf(bm, sx<2>(bm)); bm = fmaxf(bm, sx<4>(bm)); bm = fmaxf(bm, sx<8>(bm)); bm = fmaxf(bm, sx<16>(bm)); bm = fmaxf(bm, sx32(bm, lane >> 5));
            if (lane == 0) CONS[0] = bm * LOG2E;
            for (int ll = 0; ll < 2; ++ll) { float gm = 0.f; for (int i = lane; i < 192; i += 64) gm = fmaxf(gm, fabsf(in.nsa_k_norm[ll * 192 + i]));
                gm = fmaxf(gm, sx<1>(gm)); gm = fmaxf(gm, sx<2>(gm)); gm = fmaxf(gm, sx<4>(gm)); gm = fmaxf(gm, sx<8>(gm)); gm = fmaxf(gm, sx<16>(gm)); gm = fmaxf(gm, sx32(gm, lane >> 5));
                if (lane == 0) CONS[1 + ll] = gm;
                float km = 0.f; for (int i = lane; i < 96; i += 64) km = fmaxf(km, fabsf(in.mla_k_norm[ll * 96 + i]));
                km = fmaxf(km, sx<1>(km)); km = fmaxf(km, sx<2>(km)); km = fmaxf(km, sx<4>(km)); km = fmaxf(km, sx<8>(km)); km = fmaxf(km, sx<16>(km)); km = fmaxf(km, sx32(km, lane >> 5));
                if (lane == 0) CONS[3 + ll] = km; }
        }
        for (int it = gw; it < 512; it += NGW) {
            const int kc = it & 31, cb = (it >> 5) & 3, lk = it >> 7; const float* pos = in.nsa_cmp_pos + (size_t)lk * 2048; const float* w1 = in.nsa_cmp_w1 + (size_t)lk * 2048 * 256;
            float wv_[64];
#pragma unroll
            for (int k = 0; k < 64; ++k) wv_[k] = w1[(size_t)(64 * kc + k) * 256 + 64 * cb + lane];
            float a = 0.f;
#pragma unroll
            for (int k = 0; k < 64; ++k) a += pos[64 * kc + k] * wv_[k];
            B1P[(lk * 32 + kc) * 256 + 64 * cb + lane] = a; }
        for (int i = gt; i < 2 * 2 * 32 * 64 / 8; i += NT) { const int z = i / 256, r = i % 256; bf16_t* p = (z >> 1 ? VC : KC) + ((size_t)(z & 1) * KC_ROWS + S) * 64 + r * 8; *(u32x4*)p = (u32x4){0u, 0u, 0u, 0u}; }
        { f32x4 gn1_[4];
#pragma unroll
          for (int j = 0; j < 4; ++j) gn1_[j] = ((const f32x4*)in.mix_norm)[lane + 64 * j];
          int m = gw; for (; m + NGW < S; m += 2 * NGW) rms_row2(in.x + (size_t)m * 1024, in.x + (size_t)(m + NGW) * 1024, gn1_, Hb + (size_t)m * 1024, Hb + (size_t)(m + NGW) * 1024, lane);
          for (; m < S; m += NGW) { f32x4 v[4]; rms_row(in.x + (size_t)m * 1024, in.mix_norm, Hb + (size_t)m * 1024, lane, v); } }
            }
            TP_END(36, TPCTR);
        SEAM(0);
    }

    for (int l = 0; l < 2; ++l) {
        const int pb = 1 + PH_PER_LAYER * l;
        const float* x_in = (l == 0) ? in.x : args.out; float* x_out = args.out;
        if (l > 0 && PHON(0) && IN(pb + 0)) { PHASE_LOCALS TP_BEGIN(20) for (int rep_ = 0; rep_ < REPN(0); ++rep_) {
            { f32x4 gn1_[4];
#pragma unroll
              for (int j = 0; j < 4; ++j) gn1_[j] = ((const f32x4*)(in.mix_norm + l * 1024))[lane + 64 * j];
              int m = gw; for (; m + NGW < S; m += 2 * NGW) rms_row2(x_in + (size_t)m * 1024, x_in + (size_t)(m + NGW) * 1024, gn1_, Hb + (size_t)m * 1024, Hb + (size_t)(m + NGW) * 1024, lane);
              for (; m < S; m += NGW) { f32x4 v[4]; rms_row(x_in + (size_t)m * 1024, in.mix_norm + l * 1024, Hb + (size_t)m * 1024, lane, v); } }
            }
            TP_END(20, TPCTR);
            SEAM(pb + 0);
        }
        if (PHON(1) && IN(pb + 1)) { PHASE_LOCALS TP_BEGIN(21) for (int rep_ = 0; rep_ < REPN(1); ++rep_) {
            pg8::StaticOrder So; So.init(Hb, (const bf16_t*)(lw + LW_WIN), 1024, 1024, S, NPROJ - 512, G, bid);
            pg8::EpiStore E{PROJ, NPROJ, nullptr, QK_SCALE64, 0};
            pg8::gemm_phase<pg8::EpiStore, pg8::StaticOrder, true, false>(lds, 1024, 1024, 1024, So, E, wave);
#if GREP & 1
            pg8::gemm_phase<pg8::EpiStore, pg8::StaticOrder, true, false>(lds, 1024, 1024, 1024, So, E, wave);
#endif
            }
            TP_END(21, TPCTR);
            SEAM(pb + 1);
        }
        if (PHON(2) && IN(pb + 2)) { PHASE_LOCALS TP_BEGIN(22) for (int rep_ = 0; rep_ < REPN(2); ++rep_) {
            if (l == 0 && bid < 2) { const int i = bid * 512 + tid; float pv_[32];
#pragma unroll
                for (int kc = 0; kc < 32; ++kc) pv_[kc] = B1P[((i >> 8) * 32 + kc) * 256 + (i & 255)];
                float a = 0.f;
#pragma unroll
                for (int kc = 0; kc < 32; ++kc) a += pv_[kc];
                B1[i] = a; }
            float gq_[8], gk_[8], ga_[4], gb_[2];
            { const int sec_ = lane >> 4, d8_ = 8 * (lane & 7);
#pragma unroll
              for (int e = 0; e < 8; ++e) { gq_[e] = in.nsa_q_norm[l * 64 + 8 * (lane & 7) + e]; gk_[e] = in.nsa_k_norm[(l * 3 + 1 + (sec_ & 1)) * 64 + d8_ + e]; }
#pragma unroll
              for (int e = 0; e < 4; ++e) ga_[e] = in.mla_q_a_norm[l * 256 + lane * 4 + e];
              gb_[0] = in.mla_kv_a_norm[l * 128 + lane * 2]; gb_[1] = in.mla_kv_a_norm[l * 128 + lane * 2 + 1]; }
            auto a3_token = [&](const int t) __attribute__((always_inline)) {
                bf16_t* pr = PROJ + (size_t)t * NPROJ;
                {
                    const u32x4 w = *(const u32x4*)(pr + PC_NQ + lane * 8); float v[8] = {bflo(w.x), bfhi(w.x), bflo(w.y), bfhi(w.y), bflo(w.z), bfhi(w.z), bflo(w.w), bfhi(w.w)};
                    float ss = 0.f;
#pragma unroll
                    for (int e = 0; e < 8; ++e) ss += v[e] * v[e];
                    ss += sx<1>(ss); ss += sx<2>(ss); ss += sx<4>(ss);
                    const float rs = QK_SCALE64 / sqrtf(ss * (1.f / 64.f) + EPS); const float* gq = gq_;
                    u32x4 o; o.x = cvtpk(v[0] * rs * gq[0], v[1] * rs * gq[1]); o.y = cvtpk(v[2] * rs * gq[2], v[3] * rs * gq[3]); o.z = cvtpk(v[4] * rs * gq[4], v[5] * rs * gq[5]); o.w = cvtpk(v[6] * rs * gq[6], v[7] * rs * gq[7]);
                    *(u32x4*)(pr + PC_NQ + lane * 8) = o;
                }
                {
                    const int sec = lane >> 4, gg = (lane >> 3) & 1, d8 = 8 * (lane & 7);
                    const int col = (sec == 0 ? PC_NKS : sec == 1 ? PC_NKW : sec == 2 ? PC_NKC : PC_NVC) + (lane & 15) * 8;
                    const u32x4 w = *(const u32x4*)(pr + col); float v[8] = {bflo(w.x), bfhi(w.x), bflo(w.y), bfhi(w.y), bflo(w.z), bfhi(w.z), bflo(w.w), bfhi(w.w)};
                    float ss = 0.f;
#pragma unroll
                    for (int e = 0; e < 8; ++e) ss += v[e] * v[e];
                    ss += sx<1>(ss); ss += sx<2>(ss); ss += sx<4>(ss);
                    const float rs = 1.f / sqrtf(ss * (1.f / 64.f) + EPS);
                    u32x4 o = w;
                    if (sec < 2) { const float* gk = gk_;
                        o.x = cvtpk(v[0] * rs * gk[0], v[1] * rs * gk[1]); o.y = cvtpk(v[2] * rs * gk[2], v[3] * rs * gk[3]); o.z = cvtpk(v[4] * rs * gk[4], v[5] * rs * gk[5]); o.w = cvtpk(v[6] * rs * gk[6], v[7] * rs * gk[7]); }
                    const int c8 = lane & 7; const size_t ksf = ((((size_t)(gg * 256 + (t >> 6)) * 2 + ((t >> 5) & 1)) * 4 + (c8 >> 1)) * 64 + (c8 & 1) * 32 + (t & 31)) * 8;
                    bf16_t* dst = (sec == 0 ? KS + ksf : (sec == 1 ? KW + ((size_t)gg * S + t) * 64 : sec == 2 ? KC + ((size_t)gg * KC_ROWS + t) * 64 : VC + ((size_t)gg * KC_ROWS + t) * 64) + d8);
                    *(u32x4*)dst = o;
                }
                {
                    const u32x2 w = *(const u32x2*)(pr + PC_CQ + lane * 4); float v[4] = {bflo(w.x), bfhi(w.x), bflo(w.y), bfhi(w.y)};
                    const float rs = 1.f / sqrtf(wave_sum((v[0] * v[0] + v[1] * v[1]) + (v[2] * v[2] + v[3] * v[3])) * (1.f / 256.f) + EPS); const float* ga = ga_;
                    u32x2 o; o.x = cvtpk(v[0] * rs * ga[0], v[1] * rs * ga[1]); o.y = cvtpk(v[2] * rs * ga[2], v[3] * rs * ga[3]); *(u32x2*)(pr + PC_CQ + lane * 4) = o;
                    const unsigned w2 = *(const unsigned*)(pr + PC_CKV + lane * 2); const float a = bflo(w2), b = bfhi(w2);
                    const float rs2 = 1.f / sqrtf(wave_sum(a * a + b * b) * (1.f / 128.f) + EPS); const float* gb = gb_;
                    *(unsigned*)(pr + PC_CKV + lane * 2) = cvtpk(a * rs2 * gb[0], b * rs2 * gb[1]);
                }
                if (lane < 24) GN[(size_t)t * 24 + lane] = sigmoidf_(bf2f(pr[PC_NG + lane]));

            };
            { int t0 = gw; for (; t0 + NGW < S; t0 += 2 * NGW) { a3_token(t0); a3_token(t0 + NGW); } for (; t0 < S; t0 += NGW) a3_token(t0); }
            for (int it = gw; it < 4096; it += NGW) {
                const int gg = it >> 11, blk = (it >> 3) & 255, s8 = it & 7; const bf16_t* src = PROJ + (size_t)(blk * 64) * NPROJ + PC_NVS + gg * 64 + lane; bf16_t* dstb = VTS + (size_t)(gg * 256 + blk) * 4096;
                unsigned short e[8];
#pragma unroll
                for (int j = 0; j < 8; ++j) { const int k = att::vts_key_of_slot(8 * s8 + j); e[j] = src[(size_t)k * NPROJ]; }
                u32x4 o; o.x = e[0] | ((unsigned)e[1] << 16); o.y = e[2] | ((unsigned)e[3] << 16); o.z = e[4] | ((unsigned)e[5] << 16); o.w = e[6] | ((unsigned)e[7] << 16);
                const int hh = s8 >> 2, ss = (s8 >> 1) & 1, h = s8 & 1;
                *(u32x4*)(dstb + ((((hh * 2 + (lane >> 5)) * 2 + ss) * 64) + h * 32 + (lane & 31)) * 8) = o;
            }
            }
            TP_END(22, TPCTR);
            SEAM(pb + 2);
        }
        if (PHON(3) && IN(pb + 3)) { PHASE_LOCALS TP_BEGIN(23) for (int rep_ = 0; rep_ < REPN(3); ++rep_) {
            const bool wide = (G >= 256);
            for (int job = 0; job < 3; ++job) {
                pg8::StaticOrder So; pg8::EpiStore E; int lda, ldb, K;
                if (job == 2) { lda = 1024; ldb = 1024; K = 1024; So.init(Hb, (const bf16_t*)(lw + LW_WIN) + (size_t)(NPROJ - 512) * 1024, lda, ldb, S, 512, wide ? 128 : G, wide ? (bid < 64 ? bid : (bid >= 192 && bid < 256 ? bid - 128 : -1)) : bid); E = pg8::EpiStore{PROJ + (NPROJ - 512), NPROJ, nullptr, 1.f, 0}; }
                else if (job == 0) { lda = NPROJ; ldb = 256; K = 256; So.init(PROJ + PC_CQ, (const bf16_t*)(lw + LW_WUQ), lda, ldb, S, 512, wide ? 128 : G, wide ? (bid < 128 ? bid : -1) : bid); E = pg8::EpiStore{QRAW, 512, nullptr, 1.f, 0}; }
                else { lda = NPROJ; ldb = 128; K = 128; So.init(PROJ + PC_CKV, (const bf16_t*)(lw + LW_WUKV), lda, ldb, S, 512, wide ? 128 : G, wide ? (bid >= 128 && bid < 256 ? bid - 128 : -1) : bid); E = pg8::EpiStore{KVRAW, 512, nullptr, 1.f, 0}; }
                pg8::gemm_phase<pg8::EpiStore, pg8::StaticOrder, true, false>(lds, lda, ldb, K, So, E, wave);
#if GREP & 16
                pg8::gemm_phase<pg8::EpiStore, pg8::StaticOrder, true, false>(lds, lda, ldb, K, So, E, wave);
#endif
            }
            for (int jz = 0; jz < 16; ++jz) {
                const int z = jz >> 2, ks = jz & 3, kv = z >> 1, gg = z & 1;
                pg8::StaticOrder So; So.init((kv ? VC : KC) + (size_t)gg * KC_ROWS * 64 + ks * 512, (const bf16_t*)(lw + LW_CW1) + (size_t)kv * 256 * 2048 + ks * 512, 1024, 2048, 1024, 256, wide ? 4 : G, wide ? ((bid >= 128 + 4 * jz && bid < 132 + 4 * jz) ? bid - 128 - 4 * jz : -1) : bid);
                pg8::EpiF32 E{HIDP + (size_t)jz * 1024 * 256, 256};
                pg8::gemm_phase<pg8::EpiF32, pg8::StaticOrder, true, false>(lds, 1024, 2048, 512, So, E, wave);
            }
            }
            TP_END(23, TPCTR);
            SEAM(pb + 3);
        }
        if (PHON(4) && IN(pb + 4)) { PHASE_LOCALS TP_BEGIN(24) for (int rep_ = 0; rep_ < REPN(4); ++rep_) {
            const int kvb = (2 * vcu >= G) ? 1 : 0;
            { const float* w2g = in.nsa_cmp_w2 + (size_t)(l * 2 + kvb) * 256 * 64; LAS f32x4* w2l = (LAS f32x4*)lds;
#pragma unroll
              for (int i = 0; i < 8; ++i) w2l[tid + 512 * i] = *(const f32x4*)(w2g + (size_t)(tid + 512 * i) * 4); }
            __syncthreads();
            LAS unsigned short* ws16 = (LAS unsigned short*)(lds + 65536 + wave * 4096);
            float g5q_[6], g5k_[6];
#pragma unroll
            for (int e = 0; e < 6; ++e) { g5q_[e] = in.mla_q_norm[l * 96 + (lane & 15) + 16 * e]; g5k_[e] = in.mla_k_norm[l * 96 + (lane & 15) + 16 * e]; }
            for (int t = gw; t < S; t += NGW) {
                if (lane < 48) *(LAS u32x4*)(ws16 + 8 * lane) = *(const u32x4*)(QRAW + (size_t)t * 512 + 8 * lane);
                if (lane < 32) *(LAS u32x4*)(ws16 + 384 + (lane >> 3) * 96 + (lane & 7) * 8) = *(const u32x4*)(KVRAW + (size_t)t * 512 + (lane >> 3) * 128 + (lane & 7) * 8);
                else if (lane < 48) { const int hh_ = (lane - 32) >> 2, c_ = lane & 3; *(LAS u32x4*)(ws16 + 384 + hh_ * 96 + 64 + c_ * 8) = *(const u32x4*)(PROJ + (size_t)t * NPROJ + PC_KR + c_ * 8); }
                LDS_WAIT(); asm volatile("" ::: "memory");
                const int hd = lane >> 4, i = lane & 15; const float c = ROPE[t * 16 + i], s = ROPE[S * 16 + t * 16 + i];
                {   LAS unsigned short* src = ws16 + hd * 96 + i; float v[6]; float ss = 0.f;
#pragma unroll
                    for (int e = 0; e < 6; ++e) { v[e] = bf2f(src[16 * e]); ss += v[e] * v[e]; }
                    ss += sx<1>(ss); ss += sx<2>(ss); ss += sx<4>(ss); ss += sx<8>(ss);
                    const float rs = 1.f / sqrtf(ss * (1.f / 96.f) + EPS);
#pragma unroll
                    for (int e = 0; e < 6; ++e) v[e] = v[e] * rs * g5q_[e];
                    const float x1 = v[4], x2 = v[5]; v[4] = x1 * c - x2 * s; v[5] = x2 * c + x1 * s;
#pragma unroll
                    for (int e = 0; e < 6; ++e) src[16 * e] = f2bf(v[e] * QK_SCALE96); }
                {   LAS unsigned short* src = ws16 + 384 + hd * 96 + i; float v[6]; float ss = 0.f;
#pragma unroll
                    for (int e = 0; e < 6; ++e) { v[e] = bf2f(src[16 * e]); ss += v[e] * v[e]; }
                    ss += sx<1>(ss); ss += sx<2>(ss); ss += sx<4>(ss); ss += sx<8>(ss);
                    const float rs = 1.f / sqrtf(ss * (1.f / 96.f) + EPS);
#pragma unroll
                    for (int e = 0; e < 6; ++e) v[e] = v[e] * rs * g5k_[e];
                    const float x1 = v[4], x2 = v[5]; v[4] = x1 * c - x2 * s; v[5] = x2 * c + x1 * s;
#pragma unroll
                    for (int e = 0; e < 6; ++e) src[16 * e] = f2bf(v[e]); }
                LDS_WAIT(); asm volatile("" ::: "memory");
                if (lane < 48) { *(u32x4*)(QM + (size_t)t * 384 + 8 * lane) = *(const LAS u32x4*)(ws16 + 8 * lane); *(u32x4*)(KM + (size_t)t * 384 + 8 * lane) = *(const LAS u32x4*)(ws16 + 384 + 8 * lane); }
                LDS_WAIT(); asm volatile("" ::: "memory");
            }
            {
                LAS float* hs = (LAS float*)(lds + 65536 + wave * 4096); const LAS float* w2l = (const LAS float*)lds;
                const int hw = (kvb ? vcu - G / 2 : vcu) * NWAVES + wave, nhw = (kvb ? G - G / 2 : G / 2) * NWAVES;
                for (int it = hw; it < 2048; it += nhw) {
                    const int gg = it >> 10, n = it & 1023, z = kvb * 2 + gg;
                    { f32x4 hsum = *(const f32x4*)(B1 + (l * 2 + kvb) * 256 + lane * 4);
#pragma unroll
                      for (int ks = 0; ks < 4; ++ks) hsum += *(const f32x4*)(HIDP + ((size_t)(z * 4 + ks) * 1024 + n) * 256 + lane * 4);
                      *(LAS f32x4*)(hs + lane * 4) = (f32x4){siluf_(hsum.x), siluf_(hsum.y), siluf_(hsum.z), siluf_(hsum.w)}; }
                    LDS_WAIT(); asm volatile("" ::: "memory");
                    float a0 = 0.f, a1 = 0.f, a2 = 0.f, a3 = 0.f;
#pragma unroll 4
                    for (int j = 0; j < 256; j += 4) { const f32x4 h4 = *(const LAS f32x4*)(hs + j);
                        a0 += h4.x * w2l[j * 64 + lane]; a1 += h4.y * w2l[(j + 1) * 64 + lane]; a2 += h4.z * w2l[(j + 2) * 64 + lane]; a3 += h4.w * w2l[(j + 3) * 64 + lane]; }
                    const float a = (a0 + a1) + (a2 + a3);
                    if (kvb == 0) { const float rs = 1.f / sqrtf(wave_sum(a * a) * (1.f / 64.f) + EPS); KCMP[((size_t)gg * 1024 + n) * 64 + lane] = f2bf(a * rs * in.nsa_k_norm[(l * 3) * 64 + lane]); }
                    else VCMP[((size_t)gg * 1024 + n) * 64 + lane] = f2bf(a);
                    LDS_WAIT(); asm volatile("" ::: "memory");
                }
            }
            __syncthreads();
            }
            TP_END(24, TPCTR);
            SEAM(pb + 4);
        }
        if (PHON(5) && IN(pb + 5)) { PHASE_LOCALS TP_BEGIN(25) for (int rep_ = 0; rep_ < REPN(5); ++rep_) {
            __syncthreads();
            for (int r2_ = 0; r2_ < REPN(17); ++r2_) for (int u = vcu; u < 256; u += G) att::sb_unit((LAS char*)lds, PROJ, ATT, u >> 6, u & 63, wave);
            for (int r2_ = 0; r2_ < REPN(18); ++r2_) for (int p = vcu; p < 256; p += G) { const float mkb = 9.9f * CONS[3 + l]; att::mla_unit((LAS char*)lds, QM, KM, KVRAW, ATT, p >> 6, 127 - (p & 63), mkb, wave, TPCTR); att::mla_unit((LAS char*)lds, QM, KM, KVRAW, ATT, p >> 6, p & 63, mkb, wave, TPCTR); }
            att::NsaT T{PROJ, KCMP, VCMP, KS, VTS, KW, GN, LUT8, ATT, 8.08f * CONS[1 + l], CONS[0], (unsigned long long*)(ctl + 20480)};
            for (int r2_ = 0; r2_ < REPN(19); ++r2_) { volatile LAS int* qslot = (volatile LAS int*)(lds + MISC_OFF + 192); const int qg = (2 * vcu >= G) ? 1 : 0;
                __syncthreads(); att::nsa_load_lut((LAS char*)lds, LUT8, qg, tid);
                for (;;) { __syncthreads(); if (tid == 0) *qslot = (int)__hip_atomic_fetch_add(ctl + CW_NSAQ + 64 * (4 * l + 2 * r2_ + qg), 1u, RLX_AGENT); __syncthreads();
                    const int u = *qslot; if (u >= 256) break; att::nsa_unit((LAS char*)lds, T, qg, 255 - u, wave); } }
            }
            TP_END(25, TPCTR);
            SEAM(pb + 5);
        }
        if (PHON(6) && IN(pb + 6)) { PHASE_LOCALS TP_BEGIN(26) for (int rep_ = 0; rep_ < REPN(6); ++rep_) {
            for (int mix = 0; mix < 3; ++mix) {
                const int K = (mix == 1) ? 512 : 256; const int acol = (mix == 0) ? 0 : (mix == 1) ? 256 : 768;
                const bf16_t* Bt = (const bf16_t*)(lw + (mix == 0 ? LW_SBO : mix == 1 ? LW_NSAO : LW_MLAO));
                pg8::StaticOrder So; So.init(ATT + acol, Bt, 1024, K, S, 1024, G, bid);
                pg8::EpiGate E{MRG, PROJ + PC_GATE + mix * 1024, NPROJ, in.b_gate + l * 3072 + mix * 1024, mix == 0 ? 1 : 0};
                pg8::gemm_phase<pg8::EpiGate, pg8::StaticOrder, true, false>(lds, 1024, K, K, So, E, wave);
            }
            }
            TP_END(26, TPCTR);
            SEAM(pb + 6);
        }
        if (PHON(7) && IN(pb + 7)) { PHASE_LOCALS TP_BEGIN(27) for (int rep_ = 0; rep_ < REPN(7); ++rep_) {
            pg8::StaticOrder So; So.init(MRG, (const bf16_t*)(lw + LW_WOUT), 1024, 1024, S, 1024, G, bid);
            pg8::EpiResid E{x_in, x_out};
            pg8::gemm_phase<pg8::EpiResid, pg8::StaticOrder, true, false>(lds, 1024, 1024, 1024, So, E, wave);
            }
            TP_END(27, TPCTR);
            SEAM(pb + 7);
        }
        if (PHON(8) && IN(pb + 8)) { PHASE_LOCALS TP_BEGIN(28) for (int rep_ = 0; rep_ < REPN(8); ++rep_) {
            if (l == 1) {
                int troff = 0;
                tr_batch(in.moe_w_gate, in.moe_w_up, (size_t)1024 * EFF, EFF, EFF, 2, 1024, 2 * EFF, (bf16_t*)(wsl + WS_MGU), (size_t)7168 * 1024, 8, scr, gw, NGW, lane, troff);
                tr_batch(in.moe_w_down, nullptr, (size_t)EFF * 1024, 1024, 1024, 0, EFF, 1024, (bf16_t*)(wsl + WS_MDN), (size_t)1024 * EFF, 8, scr, gw, NGW, lane, troff);
            }
            LAS float* rtl = (LAS float*)(lds + 65536); LAS unsigned* lcnt = (LAS unsigned*)(lds + 98304); LAS int* rec = (LAS int*)(lds + 98304 + 64);
            if (l == 1) { __syncthreads();
#pragma unroll
                for (int i = 0; i < 4; ++i) ((LAS f32x4*)rtl)[tid + 512 * i] = *(const f32x4*)(in.moe_router + (size_t)(tid + 512 * i) * 4);
                if (tid < 16) lcnt[tid] = 0u;
                __syncthreads(); }
            f32x4 gn_[4];
#pragma unroll
            for (int j = 0; j < 4; ++j) gn_[j] = ((const f32x4*)(in.ffn_norm + l * 1024))[lane + 64 * j];
            int nrec = 0;
            for (int m = gw; m < S; m += NGW, ++nrec) {
                f32x4 v[4];
                { const f32x4* xr = (const f32x4*)(x_out + (size_t)m * 1024) + lane; float ssq = 0.f;
#pragma unroll
                  for (int j = 0; j < 4; ++j) { v[j] = xr[64 * j]; ssq += (v[j].x * v[j].x + v[j].y * v[j].y) + (v[j].z * v[j].z + v[j].w * v[j].w); }
                  const float rstd = 1.f / sqrtf(wave_sum(ssq) * (1.f / 1024.f) + EPS); u32x2* o8 = (u32x2*)(Hb + (size_t)m * 1024) + lane;
#pragma unroll
                  for (int j = 0; j < 4; ++j) { v[j] = v[j] * rstd * gn_[j]; u32x2 w; w.x = cvtpk(v[j].x, v[j].y); w.y = cvtpk(v[j].z, v[j].w); o8[64 * j] = w; } }
                if (l == 1) {
                    float lg[8];
#pragma unroll
                    for (int e = 0; e < 8; ++e) lg[e] = 0.f;
#pragma unroll
                    for (int j = 0; j < 4; ++j)
#pragma unroll
                        for (int q = 0; q < 4; ++q) { const LAS float* wr = rtl + (4 * lane + 256 * j + q) * 8; const f32x4 wa = *(const LAS f32x4*)wr, wb = *(const LAS f32x4*)(wr + 4); const float hv = v[j][q];
                            lg[0] += hv * wa.x; lg[1] += hv * wa.y; lg[2] += hv * wa.z; lg[3] += hv * wa.w; lg[4] += hv * wb.x; lg[5] += hv * wb.y; lg[6] += hv * wb.z; lg[7] += hv * wb.w; }
#pragma unroll
                    for (int e = 0; e < 8; ++e) lg[e] = wave_sum(lg[e]);
                    int e0 = 0; float v0 = lg[0];
#pragma unroll
                    for (int e = 1; e < 8; ++e) if (lg[e] > v0) { v0 = lg[e]; e0 = e; }
                    int e1 = -1; float v1 = -INFINITY;
#pragma unroll
                    for (int e = 0; e < 8; ++e) if (e != e0 && lg[e] > v1) { v1 = lg[e]; e1 = e; }
                    if (lane == 0 && nrec < 64) { const float w0 = 1.f / (1.f + __expf(v1 - v0)), w1 = 1.f - w0;
                        const int lp0 = (int)__hip_atomic_fetch_add(lcnt + e0, 1u, __ATOMIC_RELAXED, __HIP_MEMORY_SCOPE_WORKGROUP), lp1 = (int)__hip_atomic_fetch_add(lcnt + e1, 1u, __ATOMIC_RELAXED, __HIP_MEMORY_SCOPE_WORKGROUP);
                        LAS int* r = rec + (wave * 64 + nrec) * 8; r[0] = e0; r[1] = e1; r[2] = lp0; r[3] = lp1; r[4] = __float_as_int(w0); r[5] = __float_as_int(w1); }
                }
            }
            if (l == 1) {
                __syncthreads();
                if (tid < 8) lcnt[8 + tid] = __hip_atomic_fetch_add(ctl + CW_MOECNT + 64 * tid, lcnt[tid], RLX_AGENT);
                __syncthreads();
                if (lane < nrec && lane < 64) { const LAS int* r = rec + (wave * 64 + lane) * 8; const int m = gw + lane * NGW, e0 = r[0], e1 = r[1], p0 = (int)lcnt[8 + e0] + r[2], p1 = (int)lcnt[8 + e1] + r[3];
                    ROWTOK[e0 * S + p0] = m; ROWTOK[e1 * S + p1] = m;
                    int* g_ = ROUTE + (size_t)m * 8; g_[0] = e0; g_[1] = e1; g_[2] = p0; g_[3] = p1; g_[4] = r[4]; g_[5] = r[5]; }
            }
            }
            TP_END(28, TPCTR);
            SEAM(pb + 8);
        }
        if (l == 0) {
#define ACT0 ((bf16_t*)(wsl + WS_R1))
            if (PHON(9) && IN(pb + 9)) { PHASE_LOCALS TP_BEGIN(29) for (int rep_ = 0; rep_ < REPN(9); ++rep_) {
                pg8::StaticOrder So; So.init(Hb, (const bf16_t*)(wsl + WS_DGU), 1024, 1024, S, 2 * DFF, G, bid);
                pg8::EpiSwiglu E{ACT0, DFF};
                pg8::gemm_phase<pg8::EpiSwiglu, pg8::StaticOrder, true, false>(lds, 1024, 1024, 1024, So, E, wave);
#if GREP & 2
                pg8::gemm_phase<pg8::EpiSwiglu, pg8::StaticOrder, true, false>(lds, 1024, 1024, 1024, So, E, wave);
#endif
            }
            TP_END(29, TPCTR);
                SEAM(pb + 9);
            }
            if (PHON(10) && IN(pb + 10)) { PHASE_LOCALS TP_BEGIN(30) for (int rep_ = 0; rep_ < REPN(10); ++rep_) {
                pg8::StaticOrder So; So.init(ACT0, (const bf16_t*)(wsl + WS_DDN), DFF, DFF, S, 1024, G, bid);
                pg8::EpiResid E{x_out, x_out};
                pg8::gemm_phase<pg8::EpiResid, pg8::StaticOrder, true, false>(lds, DFF, DFF, DFF, So, E, wave);
            }
            TP_END(30, TPCTR);
                SEAM(pb + 10);
            }
        } else {
#define ACT1 ((bf16_t*)(wsl + WS_R2))
#define YB ((bf16_t*)(wsl + WS_Y))
            for (int ps = 0; ps < 2; ++ps) {
                if (PHON(11) && IN(pb + 9 + 2 * ps)) { PHASE_LOCALS TP_BEGIN(31) for (int rep_ = 0; rep_ < REPN(11); ++rep_) {
                    if (tid == 0) { int tb = 0; for (int e = 0; e < 8; ++e) { const int c = (int)__hip_atomic_load(ctl + CW_MOECNT + 64 * e, RLX_AGENT); MTAB[e] = c; MTAB[8 + e] = tb; tb += (c + 255) >> 8; } MTAB[16] = tb; }
                    __syncthreads();
                    const int T = MTAB[16], tlo = 64 * ps, thi = (ps == 1) ? T : (T < 64 ? T : 64);
                    MoeGU So{MTAB, Hb, (const bf16_t*)(wsl + WS_MGU), ROWTOK, tlo, thi, G, bid};
                    pg8::EpiSwiglu E{ACT1, EFF};
                    pg8::gemm_phase<pg8::EpiSwiglu, MoeGU, true, true>(lds, 1024, 1024, 1024, So, E, wave);
#if GREP & 4
                    pg8::gemm_phase<pg8::EpiSwiglu, MoeGU, true, true>(lds, 1024, 1024, 1024, So, E, wave);
#endif
            }
            TP_END(31, TPCTR);
                    SEAM(pb + 9 + 2 * ps);
                }
                if (PHON(12) && IN(pb + 10 + 2 * ps)) { PHASE_LOCALS TP_BEGIN(32) for (int rep_ = 0; rep_ < REPN(12); ++rep_) {
                    if (tid == 0) { int tb = 0; for (int e = 0; e < 8; ++e) { const int c = (int)__hip_atomic_load(ctl + CW_MOECNT + 64 * e, RLX_AGENT); MTAB[e] = c; MTAB[8 + e] = tb; tb += (c + 255) >> 8; } MTAB[16] = tb; }
                    __syncthreads();
                    const int T = MTAB[16], tlo = 64 * ps, thi = (ps == 1) ? T : (T < 64 ? T : 64);
                    MoeDN So{MTAB, ACT1, (const bf16_t*)(wsl + WS_MDN), tlo, thi, G, bid};
                    pg8::EpiStore E{YB, 1024, nullptr, 1.f, 0};
                    pg8::gemm_phase<pg8::EpiStore, MoeDN, true, false>(lds, EFF, EFF, EFF, So, E, wave);
#if GREP & 8
                    pg8::gemm_phase<pg8::EpiStore, MoeDN, true, false>(lds, EFF, EFF, EFF, So, E, wave);
#endif
            }
            TP_END(32, TPCTR);
                    SEAM(pb + 10 + 2 * ps);
                }
            }
            if (PHON(15) && IN(pb + 15)) { PHASE_LOCALS TP_BEGIN(35) for (int rep_ = 0; rep_ < REPN(15); ++rep_) {
                if (tid == 0) { int tb = 0; for (int e = 0; e < 8; ++e) { const int c = (int)__hip_atomic_load(ctl + CW_MOECNT + 64 * e, RLX_AGENT); MTAB[e] = c; MTAB[8 + e] = tb; tb += (c + 255) >> 8; } MTAB[16] = tb; }
                __syncthreads();
                for (int m = gw; m < S; m += NGW) {
                    const int* r = ROUTE + (size_t)m * 8; const int e0 = r[0], e1 = r[1]; const float w0 = __int_as_float(r[4]), w1 = __int_as_float(r[5]);
                    const bf16_t* y0 = YB + ((size_t)MTAB[8 + e0] * 256 + r[2]) * 1024; const bf16_t* y1 = YB + ((size_t)MTAB[8 + e1] * 256 + r[3]) * 1024;
                    float* xo = x_out + (size_t)m * 1024;
#pragma unroll
                    for (int j = 0; j < 4; ++j) { const int c = 4 * lane + 256 * j; f32x4 xv = *(const f32x4*)(xo + c); const u32x2 a = *(const u32x2*)(y0 + c), b = *(const u32x2*)(y1 + c);
                        xv.x += w0 * bflo(a.x) + w1 * bflo(b.x); xv.y += w0 * bfhi(a.x) + w1 * bfhi(b.x); xv.z += w0 * bflo(a.y) + w1 * bflo(b.y); xv.w += w0 * bfhi(a.y) + w1 * bfhi(b.y);
                        *(f32x4*)(xo + c) = xv; }
                }
            }
            TP_END(35, TPCTR);
                if (l == 0) SEAM(pb + 15);
            }
        }
    }
#if TPROBE != 0 && !MK_MULTI
    xcd_barrier(bar);
    if (bid == 0 && wave == 0 && lane_id() == 0) { const unsigned long long tot = __hip_atomic_load((unsigned long long*)(ctl + 20480), RLX_AGENT) / (unsigned long long)(G * NWAVES); const unsigned long long t0 = tp_now(); while (tp_now() - t0 < tot) __builtin_amdgcn_s_sleep(8); }
#endif
#undef IN
#undef SEAM
}

extern "C" void kernel_launch(void* const* d_in, const int* in_sizes, int n_in, void* d_out, int out_size, void* d_ws, size_t ws_size, hipStream_t stream) {
    static int grid = 0;
    if (grid == 0) {
        if (n_in != 28 || in_sizes[0] != S * DM || out_size != S * DM || ws_size < WS_END) { fprintf(stderr, "kernel_launch: unexpected problem (n_in %d, in0 %d, out %d, ws %zu < %zu); nothing launched\n", n_in, n_in > 0 ? in_sizes[0] : -1, out_size, ws_size, (size_t)WS_END); grid = -1; return; }
        int dev = 0, cus = 0, per_cu = 0;
        if (hipGetDevice(&dev) != hipSuccess || hipDeviceGetAttribute(&cus, hipDeviceAttributeMultiprocessorCount, dev) != hipSuccess) { grid = -1; return; }
        if (hipFuncSetAttribute((const void*)fwd_kernel, hipFuncAttributeMaxDynamicSharedMemorySize, LDS_BYTES) != hipSuccess) { fprintf(stderr, "kernel_launch: hipFuncSetAttribute failed\n"); grid = -1; return; }
        if (hipOccupancyMaxActiveBlocksPerMultiprocessor(&per_cu, (const void*)fwd_kernel, NWAVES * 64, LDS_BYTES) != hipSuccess || per_cu < 1) { fprintf(stderr, "kernel_launch: occupancy query reports %d blocks per CU\n", per_cu); (void)hipGetLastError(); }
        grid = cus;
    }
    if (grid < 0) return;
    if (hipMemsetAsync((char*)d_ws + WS_CTL, 0, CTL_ZERO_BYTES, stream) != hipSuccess) return;
    Args a{};
    const float** ip = (const float**)&a.in;
    for (int i = 0; i < 28; ++i) ip[i] = (const float*)d_in[i];
    a.out = (float*)d_out; a.ws = (unsigned char*)d_ws;
#if MK_MULTI
    for (int ph = 0; ph < NPHASES; ++ph) {
        if (ph >= 1 + 11 && ph < 1 + PH_PER_LAYER) continue;
        a.ph_lo = ph; a.ph_hi = ph + 1;
        hipLaunchKernelGGL(fwd_kernel, dim3(grid), dim3(NWAVES * 64), LDS_BYTES, stream, a);
    }
#else
    a.ph_lo = 0; a.ph_hi = NPHASES;
    hipLaunchKernelGGL(fwd_kernel, dim3(grid), dim3(NWAVES * 64), LDS_BYTES, stream, a);
#endif
    const hipError_t le = hipPeekAtLastError();
    if (le != hipSuccess) fprintf(stderr, "kernel_launch: launch failed: %s\n", hipGetErrorName(le));
}
```

```cpp
#include <hip/hip_runtime.h>
#include <cstdio>
#include <cstdint>
#include <cmath>

#define LAS __attribute__((address_space(3)))
#define GAS __attribute__((address_space(1)))
typedef unsigned short bf16_t;
typedef short bf16x8 __attribute__((ext_vector_type(8)));
typedef short s16x4 __attribute__((ext_vector_type(4)));
typedef float f32x2 __attribute__((ext_vector_type(2)));
typedef float f32x4 __attribute__((ext_vector_type(4)));
typedef float f32x16 __attribute__((ext_vector_type(16)));
typedef unsigned u32x2 __attribute__((ext_vector_type(2)));
typedef unsigned u32x4 __attribute__((ext_vector_type(4)));
typedef __bf16 bf16x2_t __attribute__((ext_vector_type(2)));
typedef GAS unsigned gu32;
#define RLX_AGENT __ATOMIC_RELAXED, __HIP_MEMORY_SCOPE_AGENT
#define DI __device__ __forceinline__

DI unsigned cvtpk(float lo, float hi) { f32x2 v = {lo, hi}; bf16x2_t b = __builtin_convertvector(v, bf16x2_t); return __builtin_bit_cast(unsigned, b); }
DI float bf2f(bf16_t b) { return __uint_as_float(((unsigned)b) << 16); }
DI float bflo(unsigned w) { return __uint_as_float(w << 16); }
DI float bfhi(unsigned w) { return __uint_as_float(w & 0xffff0000u); }
DI bf16_t f2bf(float f) { return (bf16_t)(cvtpk(f, 0.f) & 0xffffu); }
DI float fast_exp2(float x) { return __builtin_amdgcn_exp2f(x); }
DI float fast_log2(float x) { return __builtin_amdgcn_logf(x); }
DI float fast_rcp(float x) { return __builtin_amdgcn_rcpf(x); }
constexpr float LOG2E = 1.4426950408889634f;
DI float sigmoidf_(float x) { return fast_rcp(1.f + fast_exp2(-x * LOG2E)); }
DI float siluf_(float x) { return x * sigmoidf_(x); }
template <int K> DI unsigned sxu(unsigned v) {
    if constexpr (K == 1) return (unsigned)__builtin_amdgcn_update_dpp(0, (int)v, 0xB1, 0xf, 0xf, true);
    else if constexpr (K == 2) return (unsigned)__builtin_amdgcn_update_dpp(0, (int)v, 0x4E, 0xf, 0xf, true);
    else if constexpr (K == 8) return (unsigned)__builtin_amdgcn_update_dpp(0, (int)v, 0x128, 0xf, 0xf, true);
    else return (unsigned)__builtin_amdgcn_ds_swizzle((int)v, (K << 10) | 0x1f); }
template <int K> DI float sx(float v) { return __uint_as_float(sxu<K>(__float_as_uint(v))); }
DI unsigned sx32u(unsigned v, int hi) { auto rr = __builtin_amdgcn_permlane32_swap(v, v, false, false); return hi ? rr[0] : rr[1]; }
DI float sx32(float v, int hi) { return __uint_as_float(sx32u(__float_as_uint(v), hi)); }
DI float sum32sym(float v) { auto rr = __builtin_amdgcn_permlane32_swap(__float_as_uint(v), __float_as_uint(v), false, false); return __uint_as_float(rr[0]) + __uint_as_float(rr[1]); }

#ifndef TPROBE
#define TPROBE 0
#endif
DI int lane_id() { int l_; asm volatile("v_mbcnt_lo_u32_b32 %0, -1, 0\n\tv_mbcnt_hi_u32_b32 %0, -1, %0" : "=v"(l_)); return l_; }
DI unsigned long long tp_now() { return __builtin_amdgcn_s_memrealtime(); }
#define TP_BEGIN(id) unsigned long long tp_t0_ = 0; if (TPROBE == (id)) tp_t0_ = tp_now();
#define TP_END(id, ctr) do { if (TPROBE == (id)) { const unsigned long long d_ = tp_now() - tp_t0_; if (lane_id() == 0) atomicAdd((unsigned long long*)(ctr), d_); } } while (0)

namespace pg8 {
constexpr int BM = 256, BK = 64, HALF = 128, HTB = HALF * BK * 2, STAGE_BYTES = 8 * HTB, NXCD = 8, WGM = 8;
__host__ __device__ __forceinline__ int lds_byte(int r, int c) { const int st = (r >> 4) * 2 + (c >> 5), rr = r & 15, cc = c & 31, ob = rr * 64 + cc * 2; return st * 1024 + (ob ^ (((ob >> 9) & 1) << 5)); }
__host__ __device__ __forceinline__ void stage_rc(int b, int& R, int& C) { const int st = b / 1024, sb = b % 1024, swz = sb ^ (((sb >> 9) & 1) << 5); R = (st >> 1) * 16 + swz / 64; C = (st & 1) * 32 + (swz % 64) / 2; }
__host__ __device__ __forceinline__ int perm32(int rho) { const int n = rho >> 4, i = rho & 15; return 8 * (i >> 2) + 4 * n + (i & 3); }

struct Unit { const bf16_t* a; const bf16_t* b; const int* rows; int nvalid, pm, pn; };

struct StaticOrder {
    const bf16_t* A; const bf16_t* Bt; int lda, ldb, nM, nN, nwg, G, c;
    DI void init(const bf16_t* A_, const bf16_t* Bt_, int lda_, int ldb_, int M, int N, int G_, int c_) { A = A_; Bt = Bt_; lda = lda_; ldb = ldb_; nM = M / BM; nN = N / BM; nwg = nM * nN; G = G_; c = c_; }
    DI bool next(int i, Unit& u) const {
        if (c < 0 || c >= G) return false;
        const long L = (long)i * G + c; if (L >= nwg) return false;
        int wgid = (int)L; { const int q = nwg / NXCD, r = nwg % NXCD, xcd = wgid % NXCD, off = wgid / NXCD; wgid = (xcd < r ? xcd * (q + 1) : r * (q + 1) + (xcd - r) * q) + off; }
        const int nig = WGM * nN, gid = wgid / nig, fm = gid * WGM, gsz = (nM - fm) < WGM ? (nM - fm) : WGM;
        u.pm = fm + ((wgid % nig) % gsz); u.pn = (wgid % nig) / gsz;
        u.a = A + (size_t)u.pm * BM * lda; u.b = Bt + (size_t)u.pn * BM * ldb; u.rows = nullptr; u.nvalid = BM; return true;
    }
};

struct EpiStore {
    static constexpr bool PERM = true;
    bf16_t* O; int ldc; const float* bias; float scale0; int act;
    DI void operator()(const f32x4 (&acc)[2][2][4][2], const Unit& u, int wr, int wc, int fr, int fq) const {
        const int row0 = u.pm * BM + wr * 64 + fr, col0 = u.pn * BM + wc * 32 + 8 * fq;
        const float sc = (u.pn == 0) ? scale0 : 1.f;
        f32x4 bv[2][2];
#pragma unroll
        for (int bj = 0; bj < 2; ++bj)
#pragma unroll
            for (int n = 0; n < 2; ++n) bv[bj][n] = bias ? *(const f32x4*)(bias + col0 + bj * HALF + 4 * n) : (f32x4){0.f, 0.f, 0.f, 0.f};
#pragma unroll
        for (int ai = 0; ai < 2; ++ai)
#pragma unroll
            for (int m = 0; m < 4; ++m) { bf16_t* rowp = O + (size_t)(row0 + ai * HALF + m * 16) * ldc + col0;
#pragma unroll
                for (int bj = 0; bj < 2; ++bj) { f32x4 v0 = (acc[ai][bj][m][0] + bv[bj][0]) * sc, v1 = (acc[ai][bj][m][1] + bv[bj][1]) * sc;
                    if (act) {
#pragma unroll
                        for (int e = 0; e < 4; ++e) { v0[e] = siluf_(v0[e]); v1[e] = siluf_(v1[e]); } }
                    u32x4 w; w.x = cvtpk(v0[0], v0[1]); w.y = cvtpk(v0[2], v0[3]); w.z = cvtpk(v1[0], v1[1]); w.w = cvtpk(v1[2], v1[3]);
                    *(u32x4*)(rowp + bj * HALF) = w; } }
    }
};
struct EpiGate {
    static constexpr bool PERM = true;
    bf16_t* Mg; const bf16_t* glog; int ldg; const float* bg; int first;
    DI void operator()(const f32x4 (&acc)[2][2][4][2], const Unit& u, int wr, int wc, int fr, int fq) const {
        const int row0 = u.pm * BM + wr * 64 + fr, col0 = u.pn * BM + wc * 32 + 8 * fq;
        f32x4 bv[2][2];
#pragma unroll
        for (int bj = 0; bj < 2; ++bj)
#pragma unroll
            for (int n = 0; n < 2; ++n) bv[bj][n] = *(const f32x4*)(bg + col0 + bj * HALF + 4 * n);
#pragma unroll
        for (int ai = 0; ai < 2; ++ai)
#pragma unroll
            for (int m = 0; m < 4; ++m) { const size_t row = (size_t)(row0 + ai * HALF + m * 16);
#pragma unroll
                for (int bj = 0; bj < 2; ++bj) { const int col = col0 + bj * HALF;
                    const u32x4 gl = *(const u32x4*)(glog + row * ldg + col);
                    u32x4 old = (u32x4){0u, 0u, 0u, 0u}; if (!first) old = *(const u32x4*)(Mg + row * 1024 + col);
                    float g[8] = {bflo(gl.x), bfhi(gl.x), bflo(gl.y), bfhi(gl.y), bflo(gl.z), bfhi(gl.z), bflo(gl.w), bfhi(gl.w)};
                    float o[8] = {bflo(old.x), bfhi(old.x), bflo(old.y), bfhi(old.y), bflo(old.z), bfhi(old.z), bflo(old.w), bfhi(old.w)};
#pragma unroll
                    for (int e = 0; e < 4; ++e) { o[e] += sigmoidf_(g[e] + bv[bj][0][e]) * acc[ai][bj][m][0][e]; o[4 + e] += sigmoidf_(g[4 + e] + bv[bj][1][e]) * acc[ai][bj][m][1][e]; }
                    u32x4 w; w.x = cvtpk(o[0], o[1]); w.y = cvtpk(o[2], o[3]); w.z = cvtpk(o[4], o[5]); w.w = cvtpk(o[6], o[7]);
                    *(u32x4*)(Mg + row * 1024 + col) = w; } }
    }
};
struct EpiResid {
    static constexpr bool PERM = false;
    const float* xf; bf16_t* out;
    DI void operator()(const f32x4 (&acc)[2][2][4][2], const Unit& u, int wr, int wc, int fr, int fq) const {
        const int row0 = u.pm * BM + wr * 64 + fr, col0 = u.pn * BM + wc * 32 + 4 * fq;
        if (xf != nullptr) {
#pragma unroll
        for (int ai = 0; ai < 2; ++ai)
#pragma unroll
            for (int m = 0; m < 4; ++m) { const size_t off = (size_t)(row0 + ai * HALF + m * 16) * 1024 + col0;
#pragma unroll
                for (int bj = 0; bj < 2; ++bj)
#pragma unroll
                    for (int n = 0; n < 2; ++n) { const f32x4 b = *(const f32x4*)(xf + off + bj * HALF + n * 16) + acc[ai][bj][m][n]; u32x2 w; w.x = cvtpk(b.x, b.y); w.y = cvtpk(b.z, b.w); *(u32x2*)(out + off + bj * HALF + n * 16) = w; }
                if (m & 1) asm volatile("" ::: "memory"); }
        } else {
#pragma unroll
        for (int ai = 0; ai < 2; ++ai)
#pragma unroll
            for (int m = 0; m < 4; ++m) { const size_t off = (size_t)(row0 + ai * HALF + m * 16) * 1024 + col0;
#pragma unroll
                for (int bj = 0; bj < 2; ++bj)
#pragma unroll
                    for (int n = 0; n < 2; ++n) { bf16_t* p = out + off + bj * HALF + n * 16; const u32x2 r = *(const u32x2*)p; const f32x4 a = acc[ai][bj][m][n];
                        u32x2 w; w.x = cvtpk(bflo(r.x) + a.x, bfhi(r.x) + a.y); w.y = cvtpk(bflo(r.y) + a.z, bfhi(r.y) + a.w); *(u32x2*)p = w; }
                if (m & 1) asm volatile("" ::: "memory"); }
        }
    }
};
struct EpiF32 {
    static constexpr bool PERM = false;
    float* O; int ldc;
    DI void operator()(const f32x4 (&acc)[2][2][4][2], const Unit& u, int wr, int wc, int fr_in, int fq_in) const {
        int fr = fr_in, fq = fq_in; asm volatile("" : "+v"(fr), "+v"(fq));
        const int row0 = u.pm * BM + wr * 64 + fr, col0 = u.pn * BM + wc * 32 + 4 * fq;
#pragma unroll
        for (int ai = 0; ai < 2; ++ai)
#pragma unroll
            for (int m = 0; m < 4; ++m) { float* rowp = O + (size_t)(row0 + ai * HALF + m * 16) * ldc + col0;
#pragma unroll
                for (int bj = 0; bj < 2; ++bj)
#pragma unroll
                    for (int n = 0; n < 2; ++n) *(f32x4*)(rowp + bj * HALF + n * 16) = acc[ai][bj][m][n]; }
    }
};
struct EpiSwiglu {
    static constexpr bool PERM = true;
    bf16_t* act; int ldact;
    DI void operator()(const f32x4 (&acc)[2][2][4][2], const Unit& u, int wr, int wc, int fr, int fq) const {
        const int row0 = u.pm * BM + wr * 64 + fr, col0 = u.pn * HALF + wc * 32 + 8 * fq;
#pragma unroll
        for (int ai = 0; ai < 2; ++ai)
#pragma unroll
            for (int m = 0; m < 4; ++m) { bf16_t* rowp = act + (size_t)(row0 + ai * HALF + m * 16) * ldact + col0;
                float o[8];
#pragma unroll
                for (int e = 0; e < 4; ++e) { o[e] = siluf_(acc[ai][0][m][0][e]) * acc[ai][1][m][0][e]; o[4 + e] = siluf_(acc[ai][0][m][1][e]) * acc[ai][1][m][1][e]; }
                u32x4 w; w.x = cvtpk(o[0], o[1]); w.y = cvtpk(o[2], o[3]); w.z = cvtpk(o[4], o[5]); w.w = cvtpk(o[6], o[7]);
                *(u32x4*)rowp = w; }
    }
};

template <class Epi, class Sched, bool ALIGN_EPI, bool GATHER>
__device__ __forceinline__ void gemm_phase(LAS unsigned char* lds, const int lda, const int ldb, const int K, const Sched& S, const Epi& E, const int wave_id) {
    int tid_l = wave_id * 64 + lane_id(); asm volatile("" : "+v"(tid_l));
    const int tid = tid_l, wid = __builtin_amdgcn_readfirstlane(tid >> 6), lane = tid & 63, wr = wid >> 2, wc = wid & 3, fr = lane & 15, fq = lane >> 4;
    const int nt = K / BK;
    unsigned voffB[2], vc0[2], vc1[2], vn0[2], vn1[2];
#pragma unroll
    for (int i = 0; i < 2; ++i) { int R, C; stage_rc(tid * 16 + i * 8192, R, C); const int Rb = Epi::PERM ? ((R & ~31) + perm32(R & 31)) : R;
        voffB[i] = (unsigned)(Rb * ldb + C) * 2u; vc0[i] = (unsigned)(R * lda + C) * 2u; vc1[i] = vc0[i]; vn0[i] = vc0[i]; vn1[i] = vc0[i]; }
    const size_t hsA = GATHER ? (size_t)0 : (size_t)HALF * lda * 2, hsB = (size_t)HALF * ldb * 2;
    const size_t kstep = (size_t)(BK * 2);
    const unsigned ldsw = (unsigned)wid * 1024u;
    const int aoff = lds_byte(wr * 64 + fr, fq * 8), boff = lds_byte(wc * 32 + fr, fq * 8);
#define PG8_SA(b, h) (((b) * 2 + (h)) * HTB)
#define PG8_SB(b, h) ((4 + (b) * 2 + (h)) * HTB)
#define PG8_STAGE(bufoff, gbase, voff) do { _Pragma("unroll") for (int _i = 0; _i < 2; ++_i) \
        __builtin_amdgcn_global_load_lds((const unsigned*)((const char*)(gbase) + (voff)[_i]), (LAS unsigned*)(lds + (bufoff) + ldsw + _i * 8192), 16, 0, 0); } while (0)
#define PG8_LDA(dst, b, h) do { _Pragma("unroll") for (int m = 0; m < 4; ++m) _Pragma("unroll") for (int k = 0; k < 2; ++k) dst[m][k] = *(const LAS bf16x8*)(lds + PG8_SA(b, h) + aoff + m * 2048 + k * 1024); } while (0)
#define PG8_LDB(dst, b, h) do { _Pragma("unroll") for (int n = 0; n < 2; ++n) _Pragma("unroll") for (int k = 0; k < 2; ++k) dst[n][k] = *(const LAS bf16x8*)(lds + PG8_SB(b, h) + boff + n * 2048 + k * 1024); } while (0)
#define PG8_MMA(ai, bj, At, Bt) do { __builtin_amdgcn_s_setprio(1); _Pragma("unroll") for (int m = 0; m < 4; ++m) _Pragma("unroll") for (int n = 0; n < 2; ++n) _Pragma("unroll") for (int k = 0; k < 2; ++k) \
        acc[ai][bj][m][n] = __builtin_amdgcn_mfma_f32_16x16x32_bf16(Bt[n][k], At[m][k], acc[ai][bj][m][n], 0, 0, 0); __builtin_amdgcn_s_setprio(0); } while (0)
#define PG8_WAIT_V(n) asm volatile("s_waitcnt vmcnt(" #n ")" ::: "memory")
#define PG8_WAIT_L(n) asm volatile("s_waitcnt lgkmcnt(" #n ")" ::: "memory")
#define PG8_BAR __builtin_amdgcn_s_barrier()
#define PG8_SCHED __builtin_amdgcn_sched_barrier(0)
#define PG8_GVOFF(U, o0, o1) do { if constexpr (GATHER) { _Pragma("unroll") for (int _i = 0; _i < 2; ++_i) { int R_, C_; stage_rc(tid * 16 + _i * 8192, R_, C_); \
        const int r0_ = R_, r1_ = R_ + HALF; const int t0_ = (U).rows[r0_ < (U).nvalid ? r0_ : 0], t1_ = (U).rows[r1_ < (U).nvalid ? r1_ : 0]; \
        o0[_i] = (unsigned)(t0_ * lda + C_) * 2u; o1[_i] = (unsigned)(t1_ * lda + C_) * 2u; } } } while (0)
    Unit cur, nxt; int ui = 0;
    if (!S.next(0, cur)) return;
    PG8_GVOFF(cur, vc0, vc1);
    f32x4 acc[2][2][4][2];
#pragma unroll
    for (int a = 0; a < 2; ++a)
#pragma unroll
        for (int b = 0; b < 2; ++b)
#pragma unroll
            for (int m = 0; m < 4; ++m)
#pragma unroll
                for (int n = 0; n < 2; ++n) acc[a][b][m][n] = (f32x4){0.f, 0.f, 0.f, 0.f};
    bf16x8 At[4][2], B0[2][2], B1[2][2];
    const char* cA = (const char*)cur.a; const char* cB = (const char*)cur.b;
    PG8_STAGE(PG8_SB(0, 0), cB, voffB); PG8_STAGE(PG8_SB(0, 1), cB + hsB, voffB); PG8_STAGE(PG8_SA(0, 0), cA, vc0); PG8_STAGE(PG8_SA(0, 1), cA + hsA, vc1);
    if (wr == 1) PG8_BAR;
    PG8_WAIT_V(2); PG8_BAR;
    PG8_STAGE(PG8_SB(1, 0), cB + kstep, voffB); PG8_STAGE(PG8_SA(1, 0), cA + kstep, vc0); PG8_STAGE(PG8_SB(1, 1), cB + hsB + kstep, voffB);
    PG8_WAIT_V(6); PG8_BAR;
    for (;;) {
        const bool has_next = S.next(ui + 1, nxt);
        const char* nA = has_next ? (const char*)nxt.a : cA; const char* nB = has_next ? (const char*)nxt.b : cB;
        if constexpr (GATHER) { if (has_next) { PG8_GVOFF(nxt, vn0, vn1); } else {
#pragma unroll
            for (int i = 0; i < 2; ++i) { vn0[i] = vc0[i]; vn1[i] = vc1[i]; } } }
        for (int t = 0; t < nt; t += 2) {
            const bool last = (t == nt - 2);
            const char* a1 = cA + (size_t)(t + 1) * kstep;
            const char* a2 = last ? nA : cA + (size_t)(t + 2) * kstep; const char* b2 = last ? nB : cB + (size_t)(t + 2) * kstep;
            const char* a3 = a2 + kstep; const char* b3 = b2 + kstep;
            unsigned v20[2], v21[2];
#pragma unroll
            for (int i = 0; i < 2; ++i) { v20[i] = (GATHER && last) ? vn0[i] : vc0[i]; v21[i] = GATHER ? (last ? vn1[i] : vc1[i]) : vc0[i]; }
            PG8_LDB(B0, 0, 0); PG8_LDB(B1, 0, 1); PG8_SCHED; PG8_LDA(At, 0, 0); PG8_STAGE(PG8_SA(1, 1), a1 + hsA, vc1);
            PG8_WAIT_V(8); PG8_WAIT_L(0); PG8_BAR; PG8_MMA(0, 0, At, B0); PG8_MMA(0, 1, At, B1); PG8_BAR; PG8_SCHED;
            PG8_LDA(At, 0, 1); PG8_STAGE(PG8_SB(0, 0), b2, voffB); PG8_STAGE(PG8_SB(0, 1), b2 + hsB, voffB); PG8_STAGE(PG8_SA(0, 0), a2, v20);
            PG8_WAIT_V(8); PG8_WAIT_L(0); PG8_BAR; PG8_MMA(1, 0, At, B0); PG8_MMA(1, 1, At, B1); PG8_BAR; PG8_SCHED;
            PG8_LDB(B0, 1, 0); PG8_LDB(B1, 1, 1); PG8_SCHED; PG8_LDA(At, 1, 0); PG8_STAGE(PG8_SA(0, 1), a2 + hsA, v21);
            PG8_WAIT_V(8); PG8_WAIT_L(0); PG8_BAR; PG8_MMA(0, 0, At, B0); PG8_MMA(0, 1, At, B1); PG8_BAR; PG8_SCHED;
            PG8_LDA(At, 1, 1); PG8_STAGE(PG8_SB(1, 0), b3, voffB); PG8_STAGE(PG8_SB(1, 1), b3 + hsB, voffB); PG8_STAGE(PG8_SA(1, 0), a3, v20);
            PG8_WAIT_V(8); PG8_WAIT_L(0); PG8_BAR; PG8_MMA(1, 0, At, B0); PG8_MMA(1, 1, At, B1); PG8_BAR; PG8_SCHED;
        }
        if constexpr (ALIGN_EPI) { if (wr == 0) PG8_BAR; }
        E(acc, cur, wr, wc, fr, fq);
        if (!has_next) break;
#pragma unroll
        for (int a = 0; a < 2; ++a)
#pragma unroll
            for (int b = 0; b < 2; ++b)
#pragma unroll
                for (int m = 0; m < 4; ++m)
#pragma unroll
                    for (int n = 0; n < 2; ++n) acc[a][b][m][n] = (f32x4){0.f, 0.f, 0.f, 0.f};
        cur = nxt; cA = nA; cB = nB; ++ui;
        if constexpr (GATHER) {
#pragma unroll
            for (int i = 0; i < 2; ++i) { vc0[i] = vn0[i]; vc1[i] = vn1[i]; } }
        if constexpr (ALIGN_EPI) { if (wr == 1) PG8_BAR; }
    }
    PG8_WAIT_V(0);
    if constexpr (!ALIGN_EPI) { if (wr == 0) PG8_BAR; }
    PG8_BAR;
#undef PG8_SA
#undef PG8_SB
#undef PG8_STAGE
#undef PG8_LDA
#undef PG8_LDB
#undef PG8_MMA
#undef PG8_WAIT_V
#undef PG8_WAIT_L
#undef PG8_BAR
#undef PG8_SCHED
#undef PG8_GVOFF
}
}
#define XB_TMO      128
#define XB_XCNT(j)  (256  + 64 * (j))
#define XB_XSUB(j)  (1280 + 64 * (j))
#define XB_XGEN(j)  (2304 + 64 * (j))
#define XB_TOP      3328
#define XB_TOPGEN   3392
#define XCD_BAR_WORDS 3456
#define XB_SPIN_CAP (1u << 18)

__device__ __forceinline__ unsigned xb_ld(unsigned* p)              { return __hip_atomic_load(p, __ATOMIC_RELAXED, __HIP_MEMORY_SCOPE_AGENT); }
__device__ __forceinline__ unsigned xb_add(unsigned* p, unsigned v) { return __hip_atomic_fetch_add(p, v, __ATOMIC_RELAXED, __HIP_MEMORY_SCOPE_AGENT); }
__device__ __forceinline__ unsigned xb_xcc_id() { return (unsigned)__builtin_amdgcn_s_getreg((3 << 11) | 20) & 0xFu; }
#define XB_SPIN(cond, bar) do { unsigned _sp = 0; while (cond) { __builtin_amdgcn_s_sleep(1); \
    if ((++_sp & 255u) == 0u) { if (xb_ld(&(bar)[XB_TMO])) break; if (_sp > XB_SPIN_CAP) { atomicAdd(&(bar)[XB_TMO], 1u); break; } } } } while (0)

struct XcdBarrier {
    unsigned* bar; unsigned x;
    volatile LAS unsigned* st;
};

__device__ __forceinline__ XcdBarrier xcd_barrier_post(unsigned* bar, volatile LAS unsigned* st) {
    XcdBarrier b; b.bar = bar; b.x = xb_xcc_id(); b.st = st;
    if (threadIdx.x == 0) (void)xb_add(&bar[XB_XCNT(b.x)], 1u);
    return b;
}
__device__ __forceinline__ void xcd_barrier_complete(unsigned* bar, unsigned x, unsigned& nloc, unsigned& nx) {
    const unsigned G = gridDim.x * gridDim.y * gridDim.z;
    unsigned sum, cnt, mine, sp = 0u;
    for (;;) {
        sum = 0u; cnt = 0u; mine = 0u;
#pragma unroll
        for (unsigned j = 0; j < 16; ++j) { const unsigned c = xb_ld(&bar[XB_XCNT(j)]); sum += c; cnt += (c > 0u) ? 1u : 0u; mine = (j == x) ? c : mine; }
        if (sum == G) break;
        __builtin_amdgcn_s_sleep(1);
        if ((++sp & 255u) == 0u) { if (xb_ld(&bar[XB_TMO])) break; if (sp > XB_SPIN_CAP) { atomicAdd(&bar[XB_TMO], 1u); break; } }
    }
    nloc = mine > 0u ? mine : 1u; nx = cnt > 0u ? cnt : 1u;
}

__device__ __forceinline__ void xcd_barrier(const XcdBarrier& b) {
    asm volatile("s_waitcnt vmcnt(0)" ::: "memory");
    __syncthreads();
    if (threadIdx.x == 0) {
        unsigned* bar = b.bar;
        __builtin_amdgcn_s_waitcnt(0);
        unsigned nloc = b.st[0], nx = b.st[1];
        if (nloc == 0u) { xcd_barrier_complete(bar, b.x, nloc, nx); b.st[0] = nloc; b.st[1] = nx; }
        const unsigned old = xb_add(&bar[XB_XSUB(b.x)], 1u);
        const unsigned gen = old / nloc;
        if (old + 1u == (gen + 1u) * nloc) {
            __builtin_amdgcn_fence(__ATOMIC_RELEASE, "agent");
            asm volatile("s_waitcnt vmcnt(0)" ::: "memory");
            const unsigned og = xb_add(&bar[XB_TOP], 1u);
            const unsigned tg = og / nx;
            if (og + 1u == (tg + 1u) * nx) xb_add(&bar[XB_TOPGEN], 1u);
            else XB_SPIN(xb_ld(&bar[XB_TOPGEN]) == tg, bar);
            __builtin_amdgcn_fence(__ATOMIC_ACQUIRE, "agent");
            xb_add(&bar[XB_XGEN(b.x)], 1u);
            asm volatile("s_waitcnt vmcnt(0)" ::: "memory");
        } else {
            XB_SPIN(xb_ld(&bar[XB_XGEN(b.x)]) == gen, bar);
            __builtin_amdgcn_fence(__ATOMIC_ACQUIRE, "agent");
            asm volatile("s_waitcnt vmcnt(0)" ::: "memory");
        }
    }
    __syncthreads();
}
namespace att {
typedef short v4i16_t __attribute__((ext_vector_type(4)));
DI f32x16 mfma32(bf16x8 a, bf16x8 b, f32x16 c) { return __builtin_amdgcn_mfma_f32_32x32x16_bf16(a, b, c, 0, 0, 0); }
DI f32x4 mfma16(bf16x8 a, bf16x8 b, f32x4 c) { return __builtin_amdgcn_mfma_f32_16x16x32_bf16(a, b, c, 0, 0, 0); }
DI int crow(int r, int hi) { return (r & 3) + 8 * (r >> 2) + 4 * hi; }
DI s16x4 vtr(const LAS char* p) { return __builtin_bit_cast(s16x4, __builtin_amdgcn_ds_read_tr16_b64_v4i16((LAS v4i16_t*)p)); }
DI int rfl(int x) { return __builtin_amdgcn_readfirstlane(x); }
template <int OFF> DI s16x4 vtr_raw(unsigned addr) { s16x4 r; asm volatile("ds_read_b64_tr_b16 %0, %1 offset:%2" : "=v"(r) : "v"(addr), "n"(OFF)); return r; }
constexpr float NEGBIG = -1e30f;
#define LDS_BAR() asm volatile("s_waitcnt lgkmcnt(0)\n\ts_barrier" ::: "memory")

template <int D, int KS> DI f32x16 qk32(const LAS char* kp, const bf16x8* qf, float init = 0.f) {
    f32x16 acc;
#pragma unroll
    for (int i = 0; i < 16; ++i) acc[i] = init;
    bf16x8 kfr[D / 16];
#pragma unroll
    for (int d0 = 0; d0 < D / 16; ++d0) kfr[d0] = *(const LAS bf16x8*)(kp + d0 * 32);
    asm volatile("" ::: "memory");
#pragma unroll
    for (int d0 = 0; d0 < D / 16; ++d0) acc = mfma32(kfr[d0], qf[d0], acc);
    return acc;
}
template <int D, int KS> DI void qk64(f32x16& a0, f32x16& a1, const LAS char* kp, const bf16x8* qf, float init = 0.f) {
#pragma unroll
    for (int i = 0; i < 16; ++i) { a0[i] = init; a1[i] = init; }
    bf16x8 k0[D / 16], k1[D / 16];
#pragma unroll
    for (int d0 = 0; d0 < D / 16; ++d0) { k0[d0] = *(const LAS bf16x8*)(kp + d0 * 32); k1[d0] = *(const LAS bf16x8*)(kp + 32 * KS + d0 * 32); }
    asm volatile("" ::: "memory");
#pragma unroll
    for (int d0 = 0; d0 < D / 16; ++d0) { a0 = mfma32(k0[d0], qf[d0], a0); a1 = mfma32(k1[d0], qf[d0], a1); }
}
template <int VS> DI void pv32(f32x16 (&o)[2], const LAS char* vp, bf16x8 pf0, bf16x8 pf1) {
    s16x4 t[2][4];
#pragma unroll
    for (int dh = 0; dh < 2; ++dh) { t[dh][0] = vtr(vp + dh * 64); t[dh][1] = vtr(vp + 8 * VS + dh * 64); t[dh][2] = vtr(vp + 16 * VS + dh * 64); t[dh][3] = vtr(vp + 24 * VS + dh * 64); }
    asm volatile("" ::: "memory");
#pragma unroll
    for (int dh = 0; dh < 2; ++dh) {
        const bf16x8 v0 = __builtin_shufflevector(t[dh][0], t[dh][1], 0, 1, 2, 3, 4, 5, 6, 7), v1 = __builtin_shufflevector(t[dh][2], t[dh][3], 0, 1, 2, 3, 4, 5, 6, 7);
        o[dh] = mfma32(v0, pf0, o[dh]); o[dh] = mfma32(v1, pf1, o[dh]);
    }
}
template <int VS> DI void pv64(f32x16 (&o)[2], const LAS char* vp, const f32x16& p0, const f32x16& p1);
DI bf16x8 pack8(const f32x16& p, int s) {
    u32x4 w; w.x = cvtpk(p[8 * s], p[8 * s + 1]); w.y = cvtpk(p[8 * s + 2], p[8 * s + 3]); w.z = cvtpk(p[8 * s + 4], p[8 * s + 5]); w.w = cvtpk(p[8 * s + 6], p[8 * s + 7]);
    return __builtin_bit_cast(bf16x8, w);
}
template <int VS> DI void pv64(f32x16 (&o)[2], const LAS char* vp, const f32x16& p0, const f32x16& p1) {
    s16x4 t[2][2][4];
#pragma unroll
    for (int hh = 0; hh < 2; ++hh)
#pragma unroll
        for (int dh = 0; dh < 2; ++dh)
#pragma unroll
            for (int k = 0; k < 4; ++k) t[hh][dh][k] = vtr(vp + (32 * hh + 8 * k) * VS + dh * 64);
    const bf16x8 pa0 = pack8(p0, 0), pa1 = pack8(p0, 1), pb0 = pack8(p1, 0), pb1 = pack8(p1, 1);
    asm volatile("" ::: "memory");
#pragma unroll
    for (int dh = 0; dh < 2; ++dh) {
        o[dh] = mfma32(__builtin_shufflevector(t[0][dh][0], t[0][dh][1], 0, 1, 2, 3, 4, 5, 6, 7), pa0, o[dh]);
        o[dh] = mfma32(__builtin_shufflevector(t[0][dh][2], t[0][dh][3], 0, 1, 2, 3, 4, 5, 6, 7), pa1, o[dh]);
        o[dh] = mfma32(__builtin_shufflevector(t[1][dh][0], t[1][dh][1], 0, 1, 2, 3, 4, 5, 6, 7), pb0, o[dh]);
        o[dh] = mfma32(__builtin_shufflevector(t[1][dh][2], t[1][dh][3], 0, 1, 2, 3, 4, 5, 6, 7), pb1, o[dh]);
    }
}
DI float max16(const f32x16& p) { float a = fmaxf(fmaxf(p[0], p[1]), fmaxf(p[2], p[3]));
#pragma unroll
    for (int r = 4; r < 16; r += 4) a = fmaxf(a, fmaxf(fmaxf(p[r], p[r + 1]), fmaxf(p[r + 2], p[r + 3]))); return a; }
DI void store_ot(bf16_t* dst, const f32x16 (&o)[2], int hi) {
#pragma unroll
    for (int dh = 0; dh < 2; ++dh)
#pragma unroll
        for (int g4 = 0; g4 < 4; ++g4) { u32x2 w; w.x = cvtpk(o[dh][4 * g4], o[dh][4 * g4 + 1]); w.y = cvtpk(o[dh][4 * g4 + 2], o[dh][4 * g4 + 3]); *(u32x2*)(dst + 32 * dh + 8 * g4 + 4 * hi) = w; }
}

#define ATT_SB() __builtin_amdgcn_sched_barrier(0)
template <int D, int KS, int VS> DI void step64(f32x16 (&o)[2], float& l, const LAS char* kp, const LAS char* vp, const bf16x8* qf, float init) {
    bf16x8 k0[D / 16], k1[D / 16];
#pragma unroll
    for (int d0 = 0; d0 < D / 16; ++d0) { k0[d0] = *(const LAS bf16x8*)(kp + d0 * 32); k1[d0] = *(const LAS bf16x8*)(kp + 32 * KS + d0 * 32); }
    s16x4 t[2][2][4];
#pragma unroll
    for (int hh = 0; hh < 2; ++hh)
#pragma unroll
        for (int dh = 0; dh < 2; ++dh)
#pragma unroll
            for (int k = 0; k < 4; ++k) t[hh][dh][k] = vtr(vp + (32 * hh + 8 * k) * VS + dh * 64);
    f32x16 a0, a1;
#pragma unroll
    for (int i = 0; i < 16; ++i) { a0[i] = init; a1[i] = init; }
    ATT_SB();
#pragma unroll
    for (int d0 = 0; d0 < D / 16; ++d0) a0 = mfma32(k0[d0], qf[d0], a0);
#pragma unroll
    for (int d0 = 0; d0 < D / 16 - 4; ++d0) a1 = mfma32(k1[d0], qf[d0], a1);
    ATT_SB();
    float ls = 0.f;
#pragma unroll
    for (int g = 0; g < 4; ++g) {
        a1 = mfma32(k1[D / 16 - 4 + g], qf[D / 16 - 4 + g], a1);
#pragma unroll
        for (int e = 0; e < 4; ++e) { a0[4 * g + e] = fast_exp2(a0[4 * g + e]); ls += a0[4 * g + e]; }
        asm volatile("" : "+v"(a0), "+v"(ls)); ATT_SB();
    }
    const bf16x8 pa0 = pack8(a0, 0), pa1 = pack8(a0, 1);
    ATT_SB();
#pragma unroll
    for (int g = 0; g < 4; ++g) {
        const int dh = g & 1, s = g >> 1;
        o[dh] = mfma32(__builtin_shufflevector(t[0][dh][2 * s], t[0][dh][2 * s + 1], 0, 1, 2, 3, 4, 5, 6, 7), s ? pa1 : pa0, o[dh]);
#pragma unroll
        for (int e = 0; e < 4; ++e) { a1[4 * g + e] = fast_exp2(a1[4 * g + e]); ls += a1[4 * g + e]; }
        asm volatile("" : "+v"(a1), "+v"(ls)); ATT_SB();
    }
    const bf16x8 pb0 = pack8(a1, 0), pb1 = pack8(a1, 1);
    ATT_SB();
#pragma unroll
    for (int g = 0; g < 4; ++g) { const int dh = g & 1, s = g >> 1;
        o[dh] = mfma32(__builtin_shufflevector(t[1][dh][2 * s], t[1][dh][2 * s + 1], 0, 1, 2, 3, 4, 5, 6, 7), s ? pb1 : pb0, o[dh]); }
    l += ls;
}

template <int D> DI void step64r(f32x16 (&o)[2], float& l, const bf16x8 (&k0)[D / 16], const bf16x8 (&k1)[D / 16], const s16x4 (&t)[2][2][4], const bf16x8* qf, float init) {
    f32x16 a0, a1;
#pragma unroll
    for (int i = 0; i < 16; ++i) { a0[i] = init; a1[i] = init; }
    ATT_SB();
#pragma unroll
    for (int d0 = 0; d0 < D / 16; ++d0) a0 = mfma32(k0[d0], qf[d0], a0);
#pragma unroll
    for (int d0 = 0; d0 < D / 16 - 4; ++d0) a1 = mfma32(k1[d0], qf[d0], a1);
    ATT_SB();
    float ls = 0.f;
#pragma unroll
    for (int g = 0; g < 4; ++g) {
        a1 = mfma32(k1[D / 16 - 4 + g], qf[D / 16 - 4 + g], a1);
#pragma unroll
        for (int e = 0; e < 4; ++e) { a0[4 * g + e] = fast_exp2(a0[4 * g + e]); ls += a0[4 * g + e]; }
        asm volatile("" : "+v"(a0), "+v"(ls)); ATT_SB();
    }
    const bf16x8 pa0 = pack8(a0, 0), pa1 = pack8(a0, 1);
    ATT_SB();
#pragma unroll
    for (int g = 0; g < 4; ++g) {
        const int dh = g & 1, s = g >> 1;
        o[dh] = mfma32(__builtin_shufflevector(t[0][dh][2 * s], t[0][dh][2 * s + 1], 0, 1, 2, 3, 4, 5, 6, 7), s ? pa1 : pa0, o[dh]);
#pragma unroll
        for (int e = 0; e < 4; ++e) { a1[4 * g + e] = fast_exp2(a1[4 * g + e]); ls += a1[4 * g + e]; }
        asm volatile("" : "+v"(a1), "+v"(ls)); ATT_SB();
    }
    const bf16x8 pb0 = pack8(a1, 0), pb1 = pack8(a1, 1);
    ATT_SB();
#pragma unroll
    for (int g = 0; g < 4; ++g) { const int dh = g & 1, s = g >> 1;
        o[dh] = mfma32(__builtin_shufflevector(t[1][dh][2 * s], t[1][dh][2 * s + 1], 0, 1, 2, 3, 4, 5, 6, 7), s ? pb1 : pb0, o[dh]); }
    l += ls;
}

constexpr int MLA_KS = 208, MLA_VS = 144, MLA_KB = 64 * MLA_KS, MLA_VB = 64 * MLA_VS, MLA_BUF = MLA_KB + MLA_VB, MLA_HALF = 3 * MLA_BUF;
DI void mla_unit(LAS char* lds, const bf16_t* QM, const bf16_t* KM, const bf16_t* KV, bf16_t* ATT, int head, int qb, float kb, int wave_id, unsigned long long* tp) {
    TP_BEGIN(7) unsigned long long tpacc_ = 0, tpa_ = 0;
    int tid_l = wave_id * 64 + lane_id(); asm volatile("" : "+v"(tid_l));
    const int tid = tid_l, lane = tid & 63, wid = rfl(tid >> 6), r32 = lane & 31, hi = lane >> 5, half = wid >> 2, wq = wid & 3;
    const int q0 = qb * 128, qpos = q0 + 32 * wq + r32, nsuper = qb + 1;
    bf16x8 qf[6];
    { const bf16_t* qp = QM + (size_t)qpos * 384 + head * 96 + hi * 8;
#pragma unroll
      for (int d0 = 0; d0 < 6; ++d0) qf[d0] = *(const bf16x8*)(qp + d0 * 16); }
    float nref;
    { float qs = 0.f;
#pragma unroll
      for (int d0 = 0; d0 < 6; ++d0)
#pragma unroll
          for (int e = 0; e < 8; ++e) { const float v = __uint_as_float(((unsigned)(unsigned short)qf[d0][e]) << 16); qs += v * v; }
      qs += sx32(qs, hi); nref = -sqrtf(qs) * kb; }
    LAS char* hb = lds + half * MLA_HALF;
    unsigned voff[6];
#pragma unroll
    for (int m = 0; m < 6; ++m) { const int j = wq + 4 * m; const int P = j * 64 + lane;
        if (j < 13) { const int row = P / 13, pc = P - row * 13; voff[m] = (unsigned)(row * 384 + (pc < 12 ? pc : 0) * 8) * 2u; }
        else { const int P2 = P - 832; const int row = P2 / 9, pc = P2 - row * 9; voff[m] = (unsigned)((row & 63) * 512 + (pc < 8 ? pc : 0) * 8) * 2u; } }
    const char* kbase = (const char*)(KM + (size_t)(64 * half) * 384 + head * 96);
    const char* vbase = (const char*)(KV + (size_t)(64 * half) * 512 + head * 128 + 64);
    const int np = wq < 2 ? 6 : 5;
#define MLA_DMA(i, b) do { _Pragma("unroll") for (int m = 0; m < 6; ++m) { const int j = wq + 4 * m; if (j < 22) { \
        const char* src_ = (j < 13 ? kbase + (size_t)(i) * (128 * 384 * 2) : vbase + (size_t)(i) * (128 * 512 * 2)) + voff[m]; \
        __builtin_amdgcn_global_load_lds((const unsigned*)src_, (LAS unsigned*)(hb + (b) * MLA_BUF + j * 1024), 16, 0, 0); } } } while (0)
    MLA_DMA(0, 0);
    if (1 < nsuper) { MLA_DMA(1, 1); if (np == 6) asm volatile("s_waitcnt vmcnt(6)" ::: "memory"); else asm volatile("s_waitcnt vmcnt(5)" ::: "memory"); }
    else asm volatile("s_waitcnt vmcnt(0)" ::: "memory");
    LDS_BAR();
    float l = 0.f; f32x16 o[2];
#pragma unroll
    for (int i = 0; i < 16; ++i) { o[0][i] = 0.f; o[1][i] = 0.f; }
    const int vlane = (4 * hi + ((lane & 15) >> 2)) * MLA_VS + 2 * (16 * ((lane >> 4) & 1) + 4 * (lane & 3));
    if (half == 1) __builtin_amdgcn_s_barrier();
    int b3 = 0;
    for (int i = 0; i < nsuper; ++i) {
        const LAS char* kb_ = hb + b3 * MLA_BUF; const LAS char* vb = kb_ + MLA_KB;
        if (TPROBE == 16) tpa_ = tp_now();
        bf16x8 k0[6], k1[6]; s16x4 t[2][2][4];
        { const LAS char* kp = kb_ + r32 * MLA_KS + hi * 16;
#pragma unroll
          for (int d0 = 0; d0 < 6; ++d0) { k0[d0] = *(const LAS bf16x8*)(kp + d0 * 32); k1[d0] = *(const LAS bf16x8*)(kp + 32 * MLA_KS + d0 * 32); }
          const unsigned va = (unsigned)(__UINTPTR_TYPE__)(vb + vlane);
#define MLA_VT(hh, dh, k) t[hh][dh][k] = vtr_raw<(32 * hh + 8 * k) * MLA_VS + dh * 64>(va)
#define MLA_VT4(hh, dh) MLA_VT(hh, dh, 0); MLA_VT(hh, dh, 1); MLA_VT(hh, dh, 2); MLA_VT(hh, dh, 3)
          MLA_VT4(0, 0); MLA_VT4(0, 1); MLA_VT4(1, 0); MLA_VT4(1, 1);
#undef MLA_VT4
#undef MLA_VT
        }
        if (i + 2 < nsuper) { const int b2 = b3 == 0 ? 2 : b3 - 1; MLA_DMA(i + 2, b2);
            if (np == 6) asm volatile("s_waitcnt vmcnt(6)" ::: "memory"); else asm volatile("s_waitcnt vmcnt(5)" ::: "memory"); }
        else asm volatile("s_waitcnt vmcnt(0)" ::: "memory");
        if (TPROBE == 16) tpacc_ += tp_now() - tpa_;
        if (TPROBE == 14) tpa_ = tp_now();
        LDS_BAR();
#pragma unroll
        for (int hh = 0; hh < 2; ++hh)
#pragma unroll
            for (int dh = 0; dh < 2; ++dh)
#pragma unroll
                for (int k = 0; k < 4; ++k) asm volatile("" : "+v"(t[hh][dh][k]));
        if (TPROBE == 14) tpacc_ += tp_now() - tpa_;
        const bool diag = (i == nsuper - 1);
        if (TPROBE == 15) tpa_ = tp_now();
        if (!(diag && half == 1 && wq < 2)) {
            if (!diag) step64r<96>(o, l, k0, k1, t, qf, nref);
            else {
            f32x16 p0, p1;
#pragma unroll
            for (int r = 0; r < 16; ++r) { p0[r] = nref; p1[r] = nref; }
#pragma unroll
            for (int d0 = 0; d0 < 6; ++d0) { p0 = mfma32(k0[d0], qf[d0], p0); p1 = mfma32(k1[d0], qf[d0], p1); }
            { const int kbase_ = 128 * i + 64 * half;
#pragma unroll
                for (int r = 0; r < 16; ++r) { const int kk = kbase_ + crow(r, hi); p0[r] = (kk > qpos) ? 0.f : fast_exp2(p0[r]); p1[r] = (kk + 32 > qpos) ? 0.f : fast_exp2(p1[r]); } }
#pragma unroll
            for (int r = 0; r < 16; ++r) l += p0[r] + p1[r];
            const bf16x8 pa0 = pack8(p0, 0), pa1 = pack8(p0, 1), pb0 = pack8(p1, 0), pb1 = pack8(p1, 1);
#pragma unroll
            for (int dh = 0; dh < 2; ++dh) {
                o[dh] = mfma32(__builtin_shufflevector(t[0][dh][0], t[0][dh][1], 0, 1, 2, 3, 4, 5, 6, 7), pa0, o[dh]);
                o[dh] = mfma32(__builtin_shufflevector(t[0][dh][2], t[0][dh][3], 0, 1, 2, 3, 4, 5, 6, 7), pa1, o[dh]);
                o[dh] = mfma32(__builtin_shufflevector(t[1][dh][0], t[1][dh][1], 0, 1, 2, 3, 4, 5, 6, 7), pb0, o[dh]);
                o[dh] = mfma32(__builtin_shufflevector(t[1][dh][2], t[1][dh][3], 0, 1, 2, 3, 4, 5, 6, 7), pb1, o[dh]);
            }
            }
        }
        if (TPROBE == 15) tpacc_ += tp_now() - tpa_;
        if (TPROBE == 14) tpa_ = tp_now();
        ATT_SB();
        asm volatile("s_barrier" ::: "memory");
        if (TPROBE == 14) tpacc_ += tp_now() - tpa_;
        b3 = b3 == 2 ? 0 : b3 + 1;
    }
    if (half == 0) __builtin_amdgcn_s_barrier();
#undef MLA_DMA
    l = sum32sym(l);
    __syncthreads();
    LAS float* mrg = (LAS float*)lds + (wq * 64 + lane) * 34;
    if (half == 1) { mrg[1] = l;
#pragma unroll
        for (int r = 0; r < 16; ++r) { mrg[2 + r] = o[0][r]; mrg[18 + r] = o[1][r]; } }
    __syncthreads();
    if (half == 0) {
        const float inv = 1.f / (l + mrg[1]);
#pragma unroll
        for (int r = 0; r < 16; ++r) { o[0][r] = (o[0][r] + mrg[2 + r]) * inv; o[1][r] = (o[1][r] + mrg[18 + r]) * inv; }
        store_ot(ATT + (size_t)qpos * 1024 + 768 + head * 64, o, hi);
    }
    __syncthreads();
    TP_END(7, tp);
    if ((TPROBE == 14 || TPROBE == 15 || TPROBE == 16) && lane == 0) atomicAdd(tp, tpacc_);
}

constexpr int T_KS = 144, T_KB = 64 * T_KS, T_BUF = 2 * T_KB;
template <bool MASK> DI void sb_half(f32x16 (&o)[2], float& R, const LAS char* ktile, const LAS char* vtile, const bf16x8* qf, int kb, int hh, int qpos, int r32, int hi, int vlane) {
    f32x16 z = qk32<64, T_KS>(ktile + (32 * hh + r32) * T_KS + hi * 16, qf);
    float ls[16];
#pragma unroll
    for (int r = 0; r < 16; ++r) { const bool valid = !MASK || (kb + crow(r, hi)) < qpos; const float az = fabsf(z[r]);
        const float sp = fmaxf(z[r], 0.f) + fast_log2(1.f + fast_exp2(-az)); ls[r] = valid ? -sp : 0.f; }
    float T[4], U[4];
#pragma unroll
    for (int g = 0; g < 4; ++g) { ls[4 * g + 2] += ls[4 * g + 3]; ls[4 * g + 1] += ls[4 * g + 2]; ls[4 * g] += ls[4 * g + 1]; T[g] = ls[4 * g]; }
#pragma unroll
    for (int g = 0; g < 4; ++g) U[g] = sx32(T[g], hi);
    float H[4]; float sp = 0.f;
#pragma unroll
    for (int g = 3; g >= 0; --g) { H[g] = sp + (hi == 0 ? U[g] : 0.f); sp += T[g] + U[g]; }
#pragma unroll
    for (int r = 0; r < 16; ++r) { const bool valid = !MASK || (kb + crow(r, hi)) < qpos; const float lw = z[r] + R + H[r >> 2] + ls[r]; z[r] = valid ? fast_exp2(lw) : 0.f; }
    R += sp;
    pv32<T_KS>(o, vtile + (32 * hh) * T_KS + vlane, pack8(z, 0), pack8(z, 1));
}
DI void sb_unit(LAS char* lds, const bf16_t* PROJ, bf16_t* ATT, int head, int qb, int wave_id) {
    int tid_l = wave_id * 64 + lane_id(); asm volatile("" : "+v"(tid_l));
    const int tid = tid_l, lane = tid & 63, wid = rfl(tid >> 6), r32 = lane & 31, hi = lane >> 5;
    const int q0 = qb * 256, wq0 = q0 + 32 * wid, qpos = wq0 + r32;
    bf16x8 qf[4];
    { const bf16_t* qp = PROJ + (size_t)qpos * 5632 + head * 64 + hi * 8;
#pragma unroll
      for (int d0 = 0; d0 < 4; ++d0) qf[d0] = *(const bf16x8*)(qp + d0 * 16); }
    const int srow = tid >> 3, sch = tid & 7;
    u32x4 kr, vr;
#define SB_LOAD(t) do { const bf16_t* p_ = PROJ + (size_t)(64 * (t) + srow) * 5632 + head * 64 + sch * 8; kr = *(const u32x4*)(p_ + 256); vr = *(const u32x4*)(p_ + 512); } while (0)
#define SB_STORE(b) do { LAS char* d_ = lds + (b) * T_BUF + srow * T_KS + sch * 16; *(LAS u32x4*)d_ = kr; *(LAS u32x4*)(d_ + T_KB) = vr; } while (0)
    volatile LAS int* flags = (volatile LAS int*)(lds + 2 * T_BUF);
    int t = 4 * qb + 3;
    SB_LOAD(t); SB_STORE(0); __syncthreads();
    float R = 0.f; f32x16 o[2];
#pragma unroll
    for (int i = 0; i < 16; ++i) { o[0][i] = 0.f; o[1][i] = 0.f; }
    const int vlane = (4 * hi + ((lane & 15) >> 2)) * T_KS + 2 * (16 * ((lane >> 4) & 1) + 4 * (lane & 3));
    bool done = false;
    for (int it = 0;; ++it) {
        const bool more = t > 0;
        if (more) SB_LOAD(t - 1);
        const LAS char* kt = lds + (it & 1) * T_BUF; const LAS char* vt = kt + T_KB;
        if (!done && 64 * t <= wq0 + 30) {
            if (64 * t + 64 <= wq0) { sb_half<false>(o, R, kt, vt, qf, 64 * t + 32, 1, qpos, r32, hi, vlane); sb_half<false>(o, R, kt, vt, qf, 64 * t, 0, qpos, r32, hi, vlane); }
            else {
            if (64 * t + 32 <= wq0 + 30) sb_half<true>(o, R, kt, vt, qf, 64 * t + 32, 1, qpos, r32, hi, vlane);
            sb_half<true>(o, R, kt, vt, qf, 64 * t, 0, qpos, r32, hi, vlane); }
            done = __all(R < -150.f) != 0;
        }
        if (lane == 0) flags[(it & 1) * 8 + wid] = done ? 0 : 1;
        if (more) SB_STORE((it + 1) & 1);
        __syncthreads();
        int any = 0;
#pragma unroll
        for (int w = 0; w < 8; ++w) any |= flags[(it & 1) * 8 + w];
        if (!more || !any) break;
        --t;
    }
#undef SB_LOAD
#undef SB_STORE
    store_ot(ATT + (size_t)qpos * 1024 + head * 64, o, hi);
    __syncthreads();
}

#ifndef NSAREP
#define NSAREP 0
#endif
#define NSA_NREP(bit) (((NSAREP >> (bit)) & 1) ? 2 : 1)
constexpr int N_LUTN = 1344;
constexpr int N_LUT = 2 * T_BUF, N_IMP = N_LUT + N_LUTN * 16, N_OSTR = 68, N_BLKQ = N_IMP + 256 * N_OSTR * 4, N_L = N_BLKQ + 2048, N_REF = N_L + 1280, N_END = N_REF + 1024 + 64;
constexpr int N_QS = 144;
struct NsaT {
    const bf16_t* PROJ;
    const bf16_t* KCMP; const bf16_t* VCMP;
    const bf16_t* KS; const bf16_t* VTS;
    const bf16_t* KW; const bf16_t* VWF;
    const float* GN;
    const float* LUT8;
    bf16_t* ATT;
    float kb, bmax;
    unsigned long long* tp;
};
__host__ __device__ __forceinline__ int vts_key_of_slot(int slot) { const int hh = slot >> 5, s5 = slot & 31, s = s5 >> 4, h = (s5 >> 3) & 1, j = s5 & 7; return 32 * hh + 16 * s + 8 * (j >> 2) + 4 * h + (j & 3); }

DI void nsa_load_lut(LAS char* lds, const float* LUT8, int g, int tid) { LAS float* lut = (LAS float*)(lds + N_LUT); for (int i = tid; i < N_LUTN * 4; i += 512) { const int d = (i >> 2) < 1023 ? (i >> 2) : 1023; lut[i] = LUT8[d * 8 + g * 4 + (i & 3)]; } }
DI void nsa_unit(LAS char* lds, const NsaT& T, int g, int qblk, int wave_id) {
    int tid_l = wave_id * 64 + lane_id(); asm volatile("" : "+v"(tid_l));
    const int tid = tid_l, lane = tid & 63, wid = rfl(tid >> 6), r32 = lane & 31, hi = lane >> 5;
    const int q0 = qblk * 64;
    TP_BEGIN(6)
    LAS float* lut = (LAS float*)(lds + N_LUT);
    LAS float* imp = (LAS float*)(lds + N_IMP);
    LAS unsigned* bq32 = (LAS unsigned*)(lds + N_BLKQ);
    LAS float* refl = (LAS float*)(lds + N_REF);
    bq32[tid] = 0u;
    const int ql = r32 >> 2, hd = r32 & 3, h8 = g * 4 + hd, tq = q0 + 8 * wid + ql;
    bf16x8 qf[4];
    { const bf16_t* qp = T.PROJ + (size_t)tq * 5632 + 768 + h8 * 64 + hi * 8;
#pragma unroll
      for (int d0 = 0; d0 < 4; ++d0) qf[d0] = *(const bf16x8*)(qp + d0 * 16); }
    float ref;
    { float qs = 0.f;
#pragma unroll
      for (int d0 = 0; d0 < 4; ++d0)
#pragma unroll
          for (int e = 0; e < 8; ++e) { const float v = __uint_as_float(((unsigned)(unsigned short)qf[d0][e]) << 16); qs += v * v; }
      qs += sx32(qs, hi); ref = sqrtf(qs) * T.kb + T.bmax; }
    if (hi == 0) refl[(8 * wid + ql) * 4 + hd] = ref;
    const float gc = T.GN[(size_t)tq * 24 + 3 * h8], gs = T.GN[(size_t)tq * 24 + 3 * h8 + 1], gw = T.GN[(size_t)tq * 24 + 3 * h8 + 2];
    __syncthreads();
    const float cfar = lut[1023 * 4 + hd] - ref;
    const int nmax = (q0 + 32) / 16 + 1;
    const int ntc = (nmax + 63) >> 6;
    const bf16_t* kcf = T.KCMP + (size_t)g * 16 * 4096 + lane * 8; const bf16_t* vcf = T.VCMP + (size_t)g * 16 * 4096 + lane * 8;
    const int relq = tq - 31;
    const int relw = q0 + 8 * wid - 31;
    float l = 0.f; float inv_l = 0.f; f32x16 oa[2];
    { TP_BEGIN(4)
    for (int rp_ = 0; rp_ < NSA_NREP(0); ++rp_) { l = 0.f;
    bf16x8 kf[2][4], vf[2][2][2];
#define CMP_LDK(J) do { const bf16_t* p_ = kcf + (size_t)(J) * 4096; _Pragma("unroll") for (int hh = 0; hh < 2; ++hh) _Pragma("unroll") for (int d0 = 0; d0 < 4; ++d0) kf[hh][d0] = *(const bf16x8*)(p_ + (hh * 4 + d0) * 512); } while (0)
#define CMP_LDV(J) do { const bf16_t* p_ = vcf + (size_t)(J) * 4096; _Pragma("unroll") for (int hh = 0; hh < 2; ++hh) _Pragma("unroll") for (int dh = 0; dh < 2; ++dh) _Pragma("unroll") for (int s_ = 0; s_ < 2; ++s_) vf[hh][dh][s_] = *(const bf16x8*)(p_ + ((hh * 2 + dh) * 2 + s_) * 512); } while (0)
    CMP_LDK(0);
    for (int j = 0; j < ntc; ++j) {
        f32x16 sc[2];
#pragma unroll
        for (int hh = 0; hh < 2; ++hh) { const float ini_ = (relw - 16 * (64 * j + 32 * hh + 31) >= 790) ? cfar : -ref;
#pragma unroll
            for (int i = 0; i < 16; ++i) sc[hh][i] = ini_;
#pragma unroll
            for (int d0 = 0; d0 < 4; ++d0) sc[hh] = mfma32(kf[hh][d0], qf[d0], sc[hh]); }
        if (j + 1 < ntc) CMP_LDK(j + 1); else CMP_LDK(0);
#pragma unroll
        for (int hh = 0; hh < 2; ++hh) {
            const int n0 = 64 * j + 32 * hh;
            if (relw - 16 * (n0 + 31) >= 790) {
#pragma unroll
                for (int r = 0; r < 16; ++r) l += fast_exp2(sc[hh][r]);
            } else if (relw - 16 * (n0 + 31) >= 0) {
                const LAS float* lb = lut + (relq - 16 * n0 - 64 * hi - 432) * 4 + hd;
#pragma unroll
                for (int r = 0; r < 16; ++r) l += fast_exp2(sc[hh][r] + lb[(27 - ((r & 3) + 8 * (r >> 2))) * 64]);
            } else {
#pragma unroll
                for (int r = 0; r < 16; ++r) { const int rel = relq - 16 * (n0 + crow(r, hi)); l += (rel >= 0) ? fast_exp2(sc[hh][r] + lut[rel * 4 + hd]) : 0.f; }
            }
        }
    }
    CMP_LDV(0);
    l = sum32sym(l);
    inv_l = l > 0.f ? 1.f / l : 0.f;
    const float nlg = l > 0.f ? -__builtin_amdgcn_logf(l) : NEGBIG;
#pragma unroll
    for (int i = 0; i < 16; ++i) { oa[0][i] = 0.f; oa[1][i] = 0.f; }
    float cprev = 0.f;
    for (int j = 0; j < ntc; ++j) {
        f32x16 sc[2];
#pragma unroll
        for (int hh = 0; hh < 2; ++hh) { const float ini_ = ((relw - 16 * (64 * j + 32 * hh + 31) >= 790) ? cfar : -ref) + nlg;
#pragma unroll
            for (int i = 0; i < 16; ++i) sc[hh][i] = ini_;
#pragma unroll
            for (int d0 = 0; d0 < 4; ++d0) sc[hh] = mfma32(kf[hh][d0], qf[d0], sc[hh]); }
        if (j + 1 < ntc) CMP_LDK(j + 1);
#pragma unroll
        for (int hh = 0; hh < 2; ++hh) {
            f32x16& s = sc[hh];
            const int n0 = 64 * j + 32 * hh;
            if (relw - 16 * (n0 + 31) >= 790) {
#pragma unroll
                for (int r = 0; r < 16; ++r) s[r] = fast_exp2(s[r]);
            } else if (relw - 16 * (n0 + 31) >= 0) {
                const LAS float* lb = lut + (relq - 16 * n0 - 64 * hi - 432) * 4 + hd;
#pragma unroll
                for (int r = 0; r < 16; ++r) s[r] = fast_exp2(s[r] + lb[(27 - ((r & 3) + 8 * (r >> 2))) * 64]);
            } else {
#pragma unroll
                for (int r = 0; r < 16; ++r) { const int rel = relq - 16 * (n0 + crow(r, hi)); s[r] = (rel >= 0) ? fast_exp2(s[r] + lut[rel * 4 + hd]) : 0.f; }
            }
            float gsm[4], c3[4], pc3[4];
#pragma unroll
            for (int gi = 0; gi < 4; ++gi) { float a = (s[4 * gi] + s[4 * gi + 1]) + (s[4 * gi + 2] + s[4 * gi + 3]), b = s[4 * gi + 3];
                a += sx<1>(a); a += sx<2>(a); b += sx<1>(b); b += sx<2>(b); gsm[gi] = a; c3[gi] = b; }
#pragma unroll
            for (int gi = 0; gi < 4; ++gi) pc3[gi] = sx32(c3[gi], hi);
            const int b0 = 16 * j + 8 * hh + hi;
            if (hd == 0) {
                LAS float* ip = imp + (8 * wid + ql) * 256 + b0;
                if (hi == 1) {
#pragma unroll
                    for (int gi = 0; gi < 4; ++gi) ip[2 * gi] = gsm[gi] + pc3[gi];
                } else { ip[0] = gsm[0] + cprev; ip[2] = gsm[1] + pc3[0]; ip[4] = gsm[2] + pc3[1]; ip[6] = gsm[3] + pc3[2]; }
            }
            cprev = pc3[3];
            const bf16x8 p0 = pack8(s, 0), p1 = pack8(s, 1);
#pragma unroll
            for (int dh = 0; dh < 2; ++dh) { oa[dh] = mfma32(vf[hh][dh][0], p0, oa[dh]); oa[dh] = mfma32(vf[hh][dh][1], p1, oa[dh]); }
        }
        if (j + 1 < ntc) CMP_LDV(j + 1);
    }
#undef CMP_LDK
#undef CMP_LDV
    }
    TP_END(4, T.tp); }
#pragma unroll
    for (int i = 0; i < 16; ++i) { oa[0][i] *= gc; oa[1][i] *= gc; }
    store_ot(T.ATT + (size_t)tq * 1024 + 256 + h8 * 64, oa, hi);
    { TP_BEGIN(3)
    for (int rp_ = 0; rp_ < NSA_NREP(1); ++rp_) {
    unsigned ones = 0xffffffffu; asm volatile("" : "+v"(ones));
    if (qblk < 16) {
        if (tid <= qblk) { bq32[2 * tid] = ones; bq32[2 * tid + 1] = ones; }
    } else {
        if (tid == 0) { bq32[0] = ones; bq32[1] = ones; bq32[2 * qblk] = ones; bq32[2 * qblk + 1] = ones; bq32[2 * qblk - 2] = ones; bq32[2 * qblk - 1] = ones; }
        unsigned kv[8][4];
#pragma unroll
        for (int q = 0; q < 8; ++q)
#pragma unroll
            for (int i = 0; i < 4; ++i) { const int b = lane + 64 * i; kv[q][i] = (b >= 1 && b <= qblk - 2) ? __float_as_uint(imp[(8 * wid + q) * 256 + b]) + 1u : 0u; }
        unsigned T8[8];
#pragma unroll
        for (int q = 0; q < 8; ++q) T8[q] = 0u;
        auto search = [&](auto ni_) __attribute__((always_inline)) { constexpr int NI = decltype(ni_)::value;
            for (int bit = 30; bit >= 0; --bit) {
#pragma unroll
                for (int q = 0; q < 8; ++q) { const unsigned t2 = T8[q] | (1u << bit);
                    unsigned long long mk[NI];
#pragma unroll
                    for (int i = 0; i < NI; ++i) asm("v_cmp_le_u32_e64 %0, %1, %2" : "=s"(mk[i]) : "s"(t2), "v"(kv[q][i]));
                    int cnt = __builtin_popcountll(mk[0]);
#pragma unroll
                    for (int i = 1; i < NI; ++i) cnt += __builtin_popcountll(mk[i]);
                    T8[q] = (cnt >= 13) ? t2 : T8[q]; }
            } };
        { const int ni = ((qblk - 2) >> 6) + 1;
          if (ni == 1) search(std::integral_constant<int, 1>{}); else if (ni == 2) search(std::integral_constant<int, 2>{}); else if (ni == 3) search(std::integral_constant<int, 3>{}); else search(std::integral_constant<int, 4>{}); }
        unsigned sel[4] = {0u, 0u, 0u, 0u};
#pragma unroll
        for (int q = 0; q < 8; ++q) { const unsigned Tq = T8[q];
            const int cge = __builtin_popcountll(__builtin_amdgcn_ballot_w64(kv[q][0] >= Tq)) + __builtin_popcountll(__builtin_amdgcn_ballot_w64(kv[q][1] >= Tq))
                          + __builtin_popcountll(__builtin_amdgcn_ballot_w64(kv[q][2] >= Tq)) + __builtin_popcountll(__builtin_amdgcn_ballot_w64(kv[q][3] >= Tq));
            if (cge == 13) {
#pragma unroll
                for (int i = 0; i < 4; ++i) sel[i] |= (kv[q][i] >= Tq) ? (1u << q) : 0u;
            } else {
                int quota = 13 - (__builtin_popcountll(__builtin_amdgcn_ballot_w64(kv[q][0] > Tq)) + __builtin_popcountll(__builtin_amdgcn_ballot_w64(kv[q][1] > Tq))
                                + __builtin_popcountll(__builtin_amdgcn_ballot_w64(kv[q][2] > Tq)) + __builtin_popcountll(__builtin_amdgcn_ballot_w64(kv[q][3] > Tq)));
#pragma unroll
                for (int i = 0; i < 4; ++i) {
                    const unsigned long long me = __builtin_amdgcn_ballot_w64(kv[q][i] == Tq); const int pe = __builtin_popcountll(me); const int take = pe < quota ? pe : quota;
                    unsigned long long km = 0ull, mm = me; for (int t_ = 0; t_ < take; ++t_) { km |= mm & (0ull - mm); mm &= mm - 1ull; }
                    quota -= take;
                    const bool tie = (lane < 32 ? (unsigned)km >> lane : (unsigned)(km >> 32) >> (lane - 32)) & 1u;
                    sel[i] |= (kv[q][i] > Tq || (kv[q][i] == Tq && tie)) ? (1u << q) : 0u;
                }
            }
        }
#pragma unroll
        for (int i = 0; i < 4; ++i)
            if (sel[i]) (void)__hip_atomic_fetch_or(bq32 + 2 * (lane + 64 * i) + (wid >> 2), sel[i] << (8 * (wid & 3)), __ATOMIC_RELAXED, __HIP_MEMORY_SCOPE_WORKGROUP);
    }
    }
    TP_END(3, T.tp); }
    __syncthreads();
    {
        LAS char* slotb = lds + N_IMP;
        LAS unsigned short* items = (LAS unsigned short*)(lds + N_L);
        volatile LAS int* nitems = (volatile LAS int*)(lds + N_L + 768);
        LAS unsigned* smask = (LAS unsigned*)(lds + N_L + 832);
        LAS unsigned char* npv = (LAS unsigned char*)(lds + N_L + 896);
        LAS int* part = (LAS int*)(lds + N_REF + 1024);
        if (tid < 256) { int np = 0; if (qblk >= 16 && tid >= 1 && tid <= qblk - 2) { const unsigned long long mk = ((unsigned long long)bq32[2 * tid + 1] << 32) | bq32[2 * tid]; np = (__builtin_popcountll(mk) + 7) >> 3; } npv[tid] = (unsigned char)np; }
        __syncthreads();
        if (tid < 16) { int sm = 0;
#pragma unroll
            for (int k = 0; k < 16; ++k) sm += npv[16 * tid + k]; part[tid] = sm; }
        __syncthreads();
        if (tid == 0) { int run = 0;
#pragma unroll
            for (int k = 0; k < 16; ++k) { const int v = part[k]; part[k] = run; run += v; } *nitems = run; }
        __syncthreads();
        if (tid < 256) { int st = part[tid >> 4]; for (int k = 0; k < (tid & 15); ++k) st += npv[(tid & ~15) + k]; const int np = npv[tid]; for (int pp = 0; pp < np; ++pp) items[st + pp] = (unsigned short)(tid | (pp << 8)); }
        { const int q = tid >> 3, c8 = tid & 7; const bf16_t* src = T.PROJ + (size_t)(q0 + q) * 5632 + 768 + g * 256 + c8 * 32; LAS char* dst = lds + (q * 4 + (c8 >> 1)) * N_QS + (c8 & 1) * 64;
#pragma unroll
          for (int i = 0; i < 4; ++i) *(LAS u32x4*)(dst + 16 * i) = *(const u32x4*)(src + 8 * i); }
        __syncthreads();
        const bf16_t* ksg = T.KS + (size_t)g * 256 * 4096 + lane * 8;
        const bf16_t* vtg = T.VTS + (size_t)g * 256 * 4096 + lane * 8;
        const int jslot = r32 >> 2;
        const int myq = 8 * wid + ql; const unsigned qmlo = myq < 32 ? ((1u << myq) - 1u) : 0xffffffffu, qmhi = myq < 32 ? 0u : ((1u << (myq - 32)) - 1u);
        const float biasfar = lut[1023 * 4 + hd];
        float lpart = 0.f, lfull = 0.f; f32x16 os[2];
        for (int rp_ = 0; rp_ < NSA_NREP(2); ++rp_) { lpart = 0.f; lfull = 0.f;
#pragma unroll
        for (int i = 0; i < 16; ++i) { os[0][i] = 0.f; os[1][i] = 0.f; }
        bf16x8 kf[2][4], vf[2][2][2];
#define NSA_LDK(B) do { const bf16_t* p_ = ksg + (size_t)(B) * 4096; _Pragma("unroll") for (int hh = 0; hh < 2; ++hh) _Pragma("unroll") for (int d0 = 0; d0 < 4; ++d0) kf[hh][d0] = *(const bf16x8*)(p_ + (hh * 4 + d0) * 512); } while (0)
#define NSA_LDV(B) do { const bf16_t* p_ = vtg + (size_t)(B) * 4096; _Pragma("unroll") for (int hh = 0; hh < 2; ++hh) _Pragma("unroll") for (int dh = 0; dh < 2; ++dh) _Pragma("unroll") for (int s = 0; s < 2; ++s) vf[hh][dh][s] = *(const bf16x8*)(p_ + ((hh * 2 + dh) * 2 + s) * 512); } while (0)
#define NSA_SCORE(B, QF, INI, TS, OK, LS) do { \
            _Pragma("unroll") for (int hh = 0; hh < 2; ++hh) { _Pragma("unroll") for (int i = 0; i < 16; ++i) sc[hh][i] = (INI); \
                _Pragma("unroll") for (int d0 = 0; d0 < 4; ++d0) sc[hh] = mfma32(kf[hh][d0], (QF)[d0], sc[hh]); } \
            if (q0 - (64 * (B) + 63) >= 790) { _Pragma("unroll") for (int hh = 0; hh < 2; ++hh) _Pragma("unroll") for (int r = 0; r < 16; ++r) { const float p = fast_exp2(sc[hh][r]); sc[hh][r] = p; LS += p; } } \
            else if ((B) < qblk) { const LAS float* lb_ = lut + ((TS) - 64 * (B) - 4 * hi - 59) * 4 + hd;        \
                _Pragma("unroll") for (int hh = 0; hh < 2; ++hh) _Pragma("unroll") for (int r = 0; r < 16; ++r) { const float p = fast_exp2(sc[hh][r] + lb_[(59 - 32 * hh - ((r & 3) + 8 * (r >> 2))) * 4]); sc[hh][r] = p; LS += p; } } \
            else { _Pragma("unroll") for (int hh = 0; hh < 2; ++hh) _Pragma("unroll") for (int r = 0; r < 16; ++r) { const int rel = (TS) - (64 * (B) + 32 * hh + crow(r, hi)); const int rc = rel < 0 ? 0 : rel; \
                const float p = (rel >= 0) ? fast_exp2(sc[hh][r] + lut[rc * 4 + hd]) : 0.f; sc[hh][r] = p; LS += p; } } } while (0)
#define NSA_PV(O) do { _Pragma("unroll") for (int hh = 0; hh < 2; ++hh) { const bf16x8 p0 = pack8(sc[hh], 0), p1 = pack8(sc[hh], 1); \
            _Pragma("unroll") for (int dh = 0; dh < 2; ++dh) { (O)[dh] = mfma32(vf[hh][dh][0], p0, (O)[dh]); (O)[dh] = mfma32(vf[hh][dh][1], p1, (O)[dh]); } } } while (0)
        f32x16 sc[2];
        { TP_BEGIN(2) const int nf = qblk < 16 ? qblk + 1 : 3;
          { const int fb0 = 0; NSA_LDK(fb0); NSA_LDV(fb0); }
          for (int fi = 0; fi < nf; ++fi) { const int fb = qblk < 16 ? fi : (fi == 0 ? 0 : qblk - 2 + fi); const int fn = qblk < 16 ? fi + 1 : qblk - 1 + fi;
            const float ini = ((q0 - (64 * fb + 63) >= 790) ? biasfar : 0.f) - ref;
            NSA_SCORE(fb, qf, ini, tq, true, lpart);
            if (fi + 1 < nf) NSA_LDK(fn);
            NSA_PV(os);
            if (fi + 1 < nf) NSA_LDV(fn); } TP_END(2, T.tp); }
        TP_BEGIN(1)
        const int ni = *nitems; unsigned long long tpacc_ = 0;
        int it_b = -1, it_p = 0;
        if (wid < ni) { const int e = items[wid]; it_b = e & 255; it_p = e >> 8; NSA_LDK(it_b); NSA_LDV(it_b); }
        int rb = 0;
        for (int i0 = 0; i0 < ni; i0 += 8, rb ^= 1) {
            const int inext = i0 + 8 + wid; int nb_ = -1, np_ = 0;
            if (inext < ni) { const int e = items[inext]; nb_ = e & 255; np_ = e >> 8; }
            unsigned long long msk = 0ull;
            unsigned long long tpa_ = 0; if (TPROBE == 11 || TPROBE == 12 || TPROBE == 13) tpa_ = tp_now();
            if (it_b >= 0) {
                unsigned long long m_ = ((unsigned long long)(unsigned)rfl((int)bq32[2 * it_b + 1]) << 32) | (unsigned)rfl((int)bq32[2 * it_b]);
                for (int i_ = 0; i_ < 8 * it_p; ++i_) m_ &= m_ - 1ull;
                unsigned long long t_ = m_; for (int i_ = 0; i_ < 8; ++i_) t_ &= t_ - 1ull;
                msk = m_ & ~t_;
                int qsel = -1; { unsigned long long mm = msk;
#pragma unroll
                    for (int j = 0; j < 8; ++j) { const int qj = mm ? (int)__builtin_ctzll(mm) : -1; mm &= mm - 1ull; if (jslot == j) qsel = qj; } }
                const bool valid = qsel >= 0; const int row = (valid ? qsel : 0) * 4 + hd, ts = q0 + (valid ? qsel : 0);
                const float ini = valid ? ((q0 - (64 * it_b + 63) >= 790) ? biasfar : 0.f) - refl[row] : NEGBIG;
                bf16x8 qv[4];
#pragma unroll
                for (int d0 = 0; d0 < 4; ++d0) qv[d0] = *(const LAS bf16x8*)(lds + row * N_QS + d0 * 32 + hi * 16);
                float ls = 0.f;
                NSA_SCORE(it_b, qv, ini, ts, valid, ls);
                if (nb_ >= 0) NSA_LDK(nb_);
                f32x16 ot[2];
#pragma unroll
                for (int i = 0; i < 16; ++i) { ot[0][i] = 0.f; ot[1][i] = 0.f; }
                NSA_PV(ot);
                if (nb_ >= 0) NSA_LDV(nb_);
                ls = sum32sym(ls);
                LAS char* sp = slotb + rb * 34816 + (wid * 32 + r32) * 136;
#pragma unroll
                for (int dh = 0; dh < 2; ++dh)
#pragma unroll
                    for (int g4 = 0; g4 < 4; ++g4) { u32x2 w_; w_.x = cvtpk(ot[dh][4 * g4], ot[dh][4 * g4 + 1]); w_.y = cvtpk(ot[dh][4 * g4 + 2], ot[dh][4 * g4 + 3]); *(LAS u32x2*)(sp + (32 * dh + 8 * g4 + 4 * hi) * 2) = w_; }
                if (hi == 0) *(LAS float*)(sp + 128) = ls;
            }
            if (lane == 0) { smask[rb * 16 + 2 * wid] = (unsigned)msk; smask[rb * 16 + 2 * wid + 1] = (unsigned)(msk >> 32); }
            if (TPROBE == 11) tpacc_ += tp_now() - tpa_;
            if (TPROBE == 12 || TPROBE == 13) tpa_ = tp_now();
            LDS_BAR();
            if (TPROBE == 12) tpacc_ += tp_now() - tpa_;
            if (TPROBE == 13) tpa_ = tp_now();
            const unsigned smv = smask[rb * 16 + (lane & 15)];
#pragma unroll
            for (int w = 0; w < 8; ++w) {
                const unsigned mlo = (unsigned)__builtin_amdgcn_readlane((int)smv, 2 * w), mhi = (unsigned)__builtin_amdgcn_readlane((int)smv, 2 * w + 1);
                const unsigned long long mw = ((unsigned long long)mhi << 32) | mlo;
                if ((unsigned)(mw >> (8 * wid)) & 0xffu) {
                    const bool has = (myq < 32 ? (mlo >> myq) : (mhi >> (myq - 32))) & 1u;
                    const int j = __builtin_popcount(mlo & qmlo) + __builtin_popcount(mhi & qmhi);
                    const LAS char* sp = slotb + rb * 34816 + (w * 32 + (has ? j : 0) * 4 + hd) * 136;
                    u32x2 v[2][4];
#pragma unroll
                    for (int dh = 0; dh < 2; ++dh)
#pragma unroll
                        for (int g4 = 0; g4 < 4; ++g4) v[dh][g4] = *(const LAS u32x2*)(sp + (32 * dh + 8 * g4 + 4 * hi) * 2);
                    const float lv = *(const LAS float*)(sp + 128);
                    if (has) {
#pragma unroll
                        for (int dh = 0; dh < 2; ++dh)
#pragma unroll
                            for (int g4 = 0; g4 < 4; ++g4) { os[dh][4 * g4] += bflo(v[dh][g4].x); os[dh][4 * g4 + 1] += bfhi(v[dh][g4].x); os[dh][4 * g4 + 2] += bflo(v[dh][g4].y); os[dh][4 * g4 + 3] += bfhi(v[dh][g4].y); }
                        lfull += lv; }
                }
            }
            if (TPROBE == 13) tpacc_ += tp_now() - tpa_;
            it_b = nb_; it_p = np_;
        }
        TP_END(1, T.tp);
        if ((TPROBE == 11 || TPROBE == 12 || TPROBE == 13) && lane == 0) atomicAdd(T.tp, tpacc_);
#undef NSA_LDK
#undef NSA_LDV
#undef NSA_SCORE
#undef NSA_PV
        }
        { const float f = gs / (sum32sym(lpart) + lfull);
#pragma unroll
          for (int i = 0; i < 16; ++i) { oa[0][i] = f * os[0][i]; oa[1][i] = f * os[1][i]; } }
        { const bf16_t* qp = T.PROJ + (size_t)tq * 5632 + 768 + h8 * 64 + hi * 8;
#pragma unroll
          for (int d0 = 0; d0 < 4; ++d0) qf[d0] = *(const bf16x8*)(qp + d0 * 16); }
    }
    {
        const bf16_t* kwf = T.KW + (size_t)g * 256 * 4096 + lane * 8; const bf16_t* vwf = T.VWF + (size_t)g * 256 * 4096 + lane * 8;
        const int kt0 = qblk > 8 ? qblk - 8 : 0, ntw = qblk - kt0 + 1;
        float lw = 0.f; f32x16 ow[2];
        TP_BEGIN(5)
        for (int rp_ = 0; rp_ < NSA_NREP(3); ++rp_) { lw = 0.f;
#pragma unroll
        for (int i = 0; i < 16; ++i) { ow[0][i] = 0.f; ow[1][i] = 0.f; }
        bf16x8 kf[2][4], vf[2][2][2];
#define WIN_LDK(B) do { const bf16_t* p_ = kwf + (size_t)(B) * 4096; _Pragma("unroll") for (int hh = 0; hh < 2; ++hh) _Pragma("unroll") for (int d0 = 0; d0 < 4; ++d0) kf[hh][d0] = *(const bf16x8*)(p_ + (hh * 4 + d0) * 512); } while (0)
#define WIN_LDV(B) do { const bf16_t* p_ = vwf + (size_t)(B) * 4096; _Pragma("unroll") for (int hh = 0; hh < 2; ++hh) _Pragma("unroll") for (int dh = 0; dh < 2; ++dh) _Pragma("unroll") for (int s_ = 0; s_ < 2; ++s_) vf[hh][dh][s_] = *(const bf16x8*)(p_ + ((hh * 2 + dh) * 2 + s_) * 512); } while (0)
        WIN_LDK(kt0); WIN_LDV(kt0);
        for (int j = 0; j < ntw; ++j) {
            f32x16 p[2];
#pragma unroll
            for (int hh = 0; hh < 2; ++hh) {
#pragma unroll
                for (int i = 0; i < 16; ++i) p[hh][i] = -ref;
#pragma unroll
                for (int d0 = 0; d0 < 4; ++d0) p[hh] = mfma32(kf[hh][d0], qf[d0], p[hh]); }
            if (j + 1 < ntw) WIN_LDK(kt0 + j + 1);
            if (kt0 + j < qblk && kt0 + j > qblk - 8) {
                const LAS float* lb = lut + (tq - 64 * (kt0 + j) - 4 * hi - 59) * 4 + hd;
#pragma unroll
                for (int hh = 0; hh < 2; ++hh)
#pragma unroll
                    for (int r = 0; r < 16; ++r) { const float e = fast_exp2(p[hh][r] + lb[(59 - 32 * hh - ((r & 3) + 8 * (r >> 2))) * 4]); p[hh][r] = e; lw += e; }
            } else {
#pragma unroll
            for (int hh = 0; hh < 2; ++hh)
#pragma unroll
                for (int r = 0; r < 16; ++r) { const int rel = tq - (64 * (kt0 + j) + 32 * hh + crow(r, hi)); const bool valid = rel >= 0 && rel < 512;
                    const float e = valid ? fast_exp2(p[hh][r] + lut[(rel < 0 ? 0 : rel) * 4 + hd]) : 0.f; p[hh][r] = e; lw += e; }
            }
#pragma unroll
            for (int hh = 0; hh < 2; ++hh) { const bf16x8 p0 = pack8(p[hh], 0), p1 = pack8(p[hh], 1);
#pragma unroll
                for (int dh = 0; dh < 2; ++dh) { ow[dh] = mfma32(vf[hh][dh][0], p0, ow[dh]); ow[dh] = mfma32(vf[hh][dh][1], p1, ow[dh]); } }
            if (j + 1 < ntw) WIN_LDV(kt0 + j + 1);
        }
#undef WIN_LDK
#undef WIN_LDV
        }
        TP_END(5, T.tp);
        lw = sum32sym(lw);
        const float f = gw / lw;
#pragma unroll
        for (int i = 0; i < 16; ++i) { oa[0][i] += f * ow[0][i]; oa[1][i] += f * ow[1][i]; }
        { const bf16_t* ap = T.ATT + (size_t)tq * 1024 + 256 + h8 * 64;
#pragma unroll
          for (int dh = 0; dh < 2; ++dh)
#pragma unroll
              for (int g4 = 0; g4 < 4; ++g4) { const u32x2 w = *(const u32x2*)(ap + 32 * dh + 8 * g4 + 4 * hi); oa[dh][4 * g4] += bflo(w.x); oa[dh][4 * g4 + 1] += bfhi(w.x); oa[dh][4 * g4 + 2] += bflo(w.y); oa[dh][4 * g4 + 3] += bfhi(w.y); } }
        store_ot(T.ATT + (size_t)tq * 1024 + 256 + h8 * 64, oa, hi);
    }
    __syncthreads();
    TP_END(6, T.tp);
}
}
constexpr int S = 16384, DM = 1024, NPROJ = 5632, INC = 5560, DFF = 2816, EFF = 3584, NEXP = 8;
constexpr int NWAVES = 8;
constexpr float EPS = 1e-6f;
constexpr float QK_SCALE64 = 0.125f * LOG2E;
constexpr float QK_SCALE96 = 0.10206207261596575f * LOG2E;
#ifndef MK_MULTI
#define MK_MULTI 0
#endif
constexpr int PC_SBQ = 0, PC_SBK = 256, PC_SBV = 512, PC_NQ = 768, PC_NKC = 1280, PC_NVC = 1408, PC_NKS = 1536, PC_NVS = 1664, PC_NKW = 1792, PC_NVW = 1920,
              PC_CQ = 2048, PC_CKV = 2304, PC_KR = 2432, PC_NG = 2464, PC_GATE = 2560;
__host__ __device__ __forceinline__ int win_oldcol(int c) {
    if (c < 2048) return c; if (c < 2464) return c + 24; if (c < 2488) return 2048 + (c - 2464); if (c < 2560) return -1; return c - 72; }

constexpr size_t MiB = 1u << 20;
constexpr size_t WS_CTL = 0, CTL_ZERO_BYTES = 1 * MiB;
constexpr size_t WS_LW = 1 * MiB, LW_STRIDE = 18 * MiB;
constexpr size_t LW_WIN = 0, LW_SBO = 11 * MiB, LW_NSAO = LW_SBO + MiB / 2, LW_MLAO = LW_NSAO + MiB, LW_WOUT = LW_MLAO + MiB / 2, LW_WUQ = LW_WOUT + 2 * MiB, LW_WUKV = LW_WUQ + MiB / 4, LW_CW1 = LW_WUKV + MiB / 4;
constexpr size_t WS_DGU = 37 * MiB, WS_DDN = 48 * MiB;
constexpr size_t WS_Y = 1 * MiB;
constexpr size_t WS_H = 74 * MiB;
constexpr size_t WS_ROPE = 106 * MiB;
constexpr size_t WS_LUT8 = 108 * MiB, WS_B1P = WS_LUT8 + 256 * 1024, WS_B1 = WS_LUT8 + 512 * 1024, WS_ROUTE = 109 * MiB, WS_ROWTOK = WS_ROUTE + 512 * 1024;
constexpr size_t WS_R1 = 110 * MiB;
constexpr size_t WS_MGU = WS_R1, WS_MDN = WS_R1 + 112 * MiB;
constexpr size_t WS_R2 = 296 * MiB;
constexpr size_t R2_KC = 0, R2_VC = R2_KC + 4 * MiB + MiB / 4, R2_KS = R2_VC + 4 * MiB + MiB / 4, R2_VTS = R2_KS + 4 * MiB, R2_KW = R2_VTS + 4 * MiB, R2_GN = R2_KW + 4 * MiB,
                 R2_QM = R2_GN + 2 * MiB, R2_KM = R2_QM + 12 * MiB, R2_HID = R2_KM + 12 * MiB, R2_KCMP = R2_HID + 2 * MiB, R2_VCMP = R2_KCMP + MiB / 4, R2_ATT = R2_VCMP + MiB / 4 + MiB / 2,
                 R2_MRG = R2_ATT + 32 * MiB, R2_QRAW = R2_MRG, R2_KVRAW = R2_MRG + 16 * MiB, R2_HIDP = R2_MRG + 32 * MiB  , R2_VWF = R2_HIDP + 16 * MiB, R2_END = R2_VWF + 4 * MiB;
static_assert(R2_END <= 136 * MiB, "attention scratch");
constexpr size_t WS_XB = 432 * MiB;
constexpr size_t WS_END = 464 * MiB;
constexpr int KC_ROWS = S + 32;
constexpr int CW_TMO = 0, CW_BAR = 4096, CW_MOECNT = 16384, CW_NSAQ = 17408, CW_SPLIT = 18432;
constexpr int RING_BYTES = 131072, LDSCTL_OFF = 135168  , MISC_OFF = LDSCTL_OFF + 320, LDS_BYTES = 147456;


#define LDS_WAIT() asm volatile("s_waitcnt lgkmcnt(0)" ::: "memory")
#define VM_WAIT() asm volatile("s_waitcnt vmcnt(0)" ::: "memory")
DI float wave_sum(float v) { v += sx<1>(v); v += sx<2>(v); v += sx<4>(v); v += sx<8>(v); v += sx<16>(v); return sum32sym(v); }

struct TrSrc { const float* a; const float* b; int ldn; int nsrc; int mode; };
DI f32x4 tr_fetch4(const TrSrc& s, int k, int n) {
    const f32x4 z = {0.f, 0.f, 0.f, 0.f};
    if (s.mode == 0) return n < s.nsrc ? *(const f32x4*)(s.a + (size_t)k * s.ldn + n) : z;
    if (s.mode == 1) { const int oc = win_oldcol(n); return oc >= 0 ? *(const f32x4*)(s.a + (size_t)k * s.ldn + oc) : z; }
    const int tile = n >> 8, w = n & 255; const long d = (w < 128) ? 0l : (long)((const char*)s.b - (const char*)s.a);
    return *(const f32x4*)((const float*)((const char*)s.a + d) + (size_t)k * s.ldn + 128 * tile + (w & 127));
}
DI void tr_load(const TrSrc& s, int kb, int nb, int lane, f32x4 (&v)[8]) {
    const int k0 = 64 * kb, n0 = 32 * nb, r8 = lane >> 3, n4 = (lane & 7) * 4;
#pragma unroll
    for (int i = 0; i < 8; ++i) v[i] = tr_fetch4(s, k0 + r8 + 8 * i, n0 + n4);
}
DI void tr_store(const f32x4 (&v)[8], int K, bf16_t* WT, LAS float* scr, int kb, int nb, int lane) {
    const int k0 = 64 * kb, n0 = 32 * nb, r8 = lane >> 3, n4 = (lane & 7) * 4;
#pragma unroll
    for (int i = 0; i < 8; ++i) { LAS float* d = scr + (r8 + 8 * i) * 33 + n4; d[0] = v[i].x; d[1] = v[i].y; d[2] = v[i].z; d[3] = v[i].w; }
    LDS_WAIT(); asm volatile("" ::: "memory");
    const int c = lane & 7;
#pragma unroll
    for (int j = 0; j < 4; ++j) { const int n = (lane >> 3) + 8 * j; const LAS float* p = scr + (8 * c) * 33 + n;
        u32x4 o; o.x = cvtpk(p[0 * 33], p[1 * 33]); o.y = cvtpk(p[2 * 33], p[3 * 33]); o.z = cvtpk(p[4 * 33], p[5 * 33]); o.w = cvtpk(p[6 * 33], p[7 * 33]);
        *(u32x4*)(WT + (size_t)(n0 + n) * K + k0 + 8 * c) = o; }
    LDS_WAIT(); asm volatile("" ::: "memory");
}
DI void tr_item(const TrSrc& s, int K, bf16_t* WT, LAS float* scr, int kb, int nb, int lane) { f32x4 v[8]; tr_load(s, kb, nb, lane, v); tr_store(v, K, WT, scr, kb, nb, lane); }
DI void tr_matrix(const TrSrc& s, int K, int ndst, bf16_t* WT, LAS float* scr, int gw, int ngw, int lane, int& off) {
    const int nblk = ndst / 32, nitems = (K / 64) * nblk;
    int st = gw - off; if (st < 0) st += ngw;
    if (st < nitems) { f32x4 v[8], w[8]; tr_load(s, st / nblk, st % nblk, lane, v);
        for (int it = st; it < nitems; it += ngw) { const int nx = it + ngw; if (nx < nitems) tr_load(s, nx / nblk, nx % nblk, lane, w);
            tr_store(v, K, WT, scr, it / nblk, it % nblk, lane);
#pragma unroll
            for (int i = 0; i < 8; ++i) v[i] = w[i]; } }
    off = (off + nitems) % ngw;
}

DI void tr_batch(const float* a, const float* b, size_t sstride, int ldn, int nsrc, int mode, int K, int ndst, bf16_t* WT, size_t dstride, int nexp, LAS float* scr, int gw, int ngw, int lane, int& off) {
    const int nblk = ndst / 32, per = (K / 64) * nblk, nitems = nexp * per;
    int st = gw - off; if (st < 0) st += ngw;
    if (st < nitems) { f32x4 v[8], w[8];
        { const int e = st / per, r = st % per; tr_load(TrSrc{a + (size_t)e * sstride, b ? b + (size_t)e * sstride : nullptr, ldn, nsrc, mode}, r / nblk, r % nblk, lane, v); }
        for (int it = st; it < nitems; it += ngw) { const int nx = it + ngw;
            if (nx < nitems) { const int e = nx / per, r = nx % per; tr_load(TrSrc{a + (size_t)e * sstride, b ? b + (size_t)e * sstride : nullptr, ldn, nsrc, mode}, r / nblk, r % nblk, lane, w); }
            { const int e = it / per, r = it % per; tr_store(v, K, WT + (size_t)e * dstride, scr, r / nblk, r % nblk, lane); }
#pragma unroll
            for (int i = 0; i < 8; ++i) v[i] = w[i]; } }
    off = (off + nitems) % ngw;
}

struct In {
    const float *x, *bias_table, *mix_norm, *w_in, *b_gate, *sb_w_o, *nsa_q_norm, *nsa_k_norm, *nsa_cmp_pos, *nsa_cmp_w1, *nsa_cmp_w2, *nsa_w_o, *mla_q_a_norm, *mla_kv_a_norm,
        *mla_w_uq, *mla_w_ukv, *mla_q_norm, *mla_k_norm, *mla_w_o, *w_out, *ffn_norm, *dense_w_gate, *dense_w_up, *dense_w_down, *moe_router, *moe_w_gate, *moe_w_up, *moe_w_down;
};
struct Args { In in; float* out; unsigned char* ws; int ph_lo, ph_hi; };

DI void rms_row(const float* xrow, const float* gain, bf16_t* orow, int lane, f32x4 (&v)[4]) {
    const f32x4* xr = (const f32x4*)xrow + lane; float s = 0.f;
#pragma unroll
    for (int j = 0; j < 4; ++j) { v[j] = xr[64 * j]; s += (v[j].x * v[j].x + v[j].y * v[j].y) + (v[j].z * v[j].z + v[j].w * v[j].w); }
    const float rstd = 1.f / sqrtf(wave_sum(s) * (1.f / 1024.f) + EPS);
    u32x2* o8 = (u32x2*)orow + lane;
#pragma unroll
    for (int j = 0; j < 4; ++j) { const f32x4 g = ((const f32x4*)gain)[lane + 64 * j]; v[j] = v[j] * rstd * g; u32x2 w; w.x = cvtpk(v[j].x, v[j].y); w.y = cvtpk(v[j].z, v[j].w); o8[64 * j] = w; }
}

DI void rms_row2(const float* x0, const float* x1, const f32x4 (&gn)[4], bf16_t* o0, bf16_t* o1, int lane) {
    const f32x4* xa = (const f32x4*)x0 + lane; const f32x4* xb = (const f32x4*)x1 + lane; f32x4 a[4], b[4]; float sa = 0.f, sb = 0.f;
#pragma unroll
    for (int j = 0; j < 4; ++j) { a[j] = xa[64 * j]; b[j] = xb[64 * j]; }
#pragma unroll
    for (int j = 0; j < 4; ++j) { sa += (a[j].x * a[j].x + a[j].y * a[j].y) + (a[j].z * a[j].z + a[j].w * a[j].w); sb += (b[j].x * b[j].x + b[j].y * b[j].y) + (b[j].z * b[j].z + b[j].w * b[j].w); }
    const float ra = 1.f / sqrtf(wave_sum(sa) * (1.f / 1024.f) + EPS), rb = 1.f / sqrtf(wave_sum(sb) * (1.f / 1024.f) + EPS);
    u32x2* pa = (u32x2*)o0 + lane; u32x2* pb = (u32x2*)o1 + lane;
#pragma unroll
    for (int j = 0; j < 4; ++j) { const f32x4 g = gn[j]; const f32x4 va = a[j] * ra * g, vb = b[j] * rb * g;
        u32x2 w; w.x = cvtpk(va.x, va.y); w.y = cvtpk(va.z, va.w); pa[64 * j] = w; w.x = cvtpk(vb.x, vb.y); w.y = cvtpk(vb.z, vb.w); pb[64 * j] = w; }
}

DI void rms_row2b(const bf16_t* x0, const bf16_t* x1, const f32x4 (&gn)[4], bf16_t* o0, bf16_t* o1, int lane) {
    const u32x2* xa = (const u32x2*)x0 + lane; const u32x2* xb = (const u32x2*)x1 + lane; u32x2 ra_[4], rb_[4]; f32x4 a[4], b[4]; float sa = 0.f, sb = 0.f;
#pragma unroll
    for (int j = 0; j < 4; ++j) { ra_[j] = xa[64 * j]; rb_[j] = xb[64 * j]; }
#pragma unroll
    for (int j = 0; j < 4; ++j) { a[j] = (f32x4){bflo(ra_[j].x), bfhi(ra_[j].x), bflo(ra_[j].y), bfhi(ra_[j].y)}; b[j] = (f32x4){bflo(rb_[j].x), bfhi(rb_[j].x), bflo(rb_[j].y), bfhi(rb_[j].y)};
        sa += (a[j].x * a[j].x + a[j].y * a[j].y) + (a[j].z * a[j].z + a[j].w * a[j].w); sb += (b[j].x * b[j].x + b[j].y * b[j].y) + (b[j].z * b[j].z + b[j].w * b[j].w); }
    const float ra = 1.f / sqrtf(wave_sum(sa) * (1.f / 1024.f) + EPS), rb = 1.f / sqrtf(wave_sum(sb) * (1.f / 1024.f) + EPS);
    u32x2* pa = (u32x2*)o0 + lane; u32x2* pb = (u32x2*)o1 + lane;
#pragma unroll
    for (int j = 0; j < 4; ++j) { const f32x4 g = gn[j]; const f32x4 va = a[j] * ra * g, vb = b[j] * rb * g;
        u32x2 w; w.x = cvtpk(va.x, va.y); w.y = cvtpk(va.z, va.w); pa[64 * j] = w; w.x = cvtpk(vb.x, vb.y); w.y = cvtpk(vb.z, vb.w); pb[64 * j] = w; }
}

DI int t5_bucket(int n) {
    if (n < 16) return n;
    int b = 16;
    b += n >= 21; b += n >= 27; b += n >= 35; b += n >= 46; b += n >= 59; b += n >= 77; b += n >= 99; b += n >= 128; b += n >= 166; b += n >= 216; b += n >= 280; b += n >= 363; b += n >= 470; b += n >= 609; b += n >= 790;
    return b;
}

struct MoeTab { int cnt[8]; int tb[9]; };
struct MoeGU {
    const volatile LAS int* tab; const bf16_t* Hb; const bf16_t* W; const int* rowtok; int t_lo, t_hi, G, c;
    DI bool next(int i, pg8::Unit& u) const {
        const int nrt = t_hi - t_lo; if (nrt <= 0) return false;
        const long L = (long)i * G + c; if (L >= (long)nrt * 28) return false;
        const int rt = t_lo + (int)(L % nrt), pn = (int)(L / nrt);
        int e = 0;
#pragma unroll
        for (int k = 1; k < 8; ++k) e += (tab[8 + k] <= rt) ? 1 : 0;
        const int j = rt - tab[8 + e], cnt = tab[e];
        u.a = Hb; u.b = W + ((size_t)e * 7168 + 256 * pn) * 1024; u.rows = rowtok + e * S + 256 * j; u.nvalid = (cnt - 256 * j) < 256 ? (cnt - 256 * j) : 256; u.pm = rt - t_lo; u.pn = pn; return true;
    }
};
struct MoeDN {
    const volatile LAS int* tab; const bf16_t* ACT; const bf16_t* W; int t_lo, t_hi, G, c, lmax;
    DI bool next(int i, pg8::Unit& u) const {
        const int nrt = t_hi - t_lo; if (nrt <= 0) return false;
        const long L = (long)i * G + c; if (L >= (long)nrt * 4 || L >= lmax) return false;
        const int rt = t_lo + (int)(L % nrt), pn = (int)(L / nrt);
        int e = 0;
#pragma unroll
        for (int k = 1; k < 8; ++k) e += (tab[8 + k] <= rt) ? 1 : 0;
        u.a = ACT + (size_t)(rt - t_lo) * 256 * EFF; u.b = W + ((size_t)e * 1024 + 256 * pn) * EFF; u.rows = nullptr; u.nvalid = 256; u.pm = rt; u.pn = pn; return true;
    }
};
struct MoeDNS {
    const volatile LAS int* tab; const bf16_t* ACT; const bf16_t* W; int t_lo, t_hi, full, G, c;
    DI bool next(int i, pg8::Unit& u) const {
        const int nrt = t_hi - t_lo; if (nrt <= 0) return false;
        const long L2 = (long)i * G + c; const int left = nrt * 4 - full; if (L2 >= (long)left * 2) return false;
        const int lu = (int)(L2 >> 1), ks = (int)(L2 & 1), L = full + lu;
        const int rt = t_lo + L % nrt, pn = L / nrt;
        int e = 0;
#pragma unroll
        for (int k = 1; k < 8; ++k) e += (tab[8 + k] <= rt) ? 1 : 0;
        u.a = ACT + (size_t)(rt - t_lo) * 256 * EFF + ks * (EFF / 2); u.b = W + ((size_t)e * 1024 + 256 * pn) * EFF + ks * (EFF / 2); u.rows = nullptr; u.nvalid = 256; u.pm = lu * 2 + ks; u.pn = 0; return true;
    }
};
constexpr int PH_PER_LAYER = 16, NPHASES = 1 + 2 * PH_PER_LAYER;
__global__ void __launch_bounds__(NWAVES * 64, 2) fwd_kernel(Args args) {
    extern __shared__ __attribute__((aligned(16))) unsigned char lds_raw[];
    LAS unsigned char* lds = (LAS unsigned char*)lds_raw;
    volatile LAS unsigned* MISC = (volatile LAS unsigned*)(lds + MISC_OFF);
    volatile LAS int* MTAB = (volatile LAS int*)(lds + MISC_OFF + 64);
    const int tid0 = threadIdx.x, wave = __builtin_amdgcn_readfirstlane(tid0 >> 6);
    const int G = gridDim.x, bid = blockIdx.x, vcu = (G % 8 == 0) ? (bid % 8) * (G / 8) + bid / 8 : bid;
    const int gw0 = vcu * NWAVES + wave, NGW = G * NWAVES;
    unsigned char* ws = args.ws; const In in = args.in;
    gu32* ctl = (gu32*)(ws + WS_CTL);
    for (int u = tid0; u < (LDS_BYTES - LDSCTL_OFF) / 4; u += NWAVES * 64) ((LAS unsigned*)(lds + LDSCTL_OFF))[u] = 0u;
    __syncthreads();
#if MK_MULTI
#define GRID_BAR() do { } while (0)
#else
    XcdBarrier bar = xcd_barrier_post((unsigned*)(ctl + CW_BAR), MISC + 8);
#define TPCTR ((unsigned long long*)(ctl + 20480))
#define GRID_BAR() do { TP_BEGIN(9) xcd_barrier(bar); TP_END(9, TPCTR); } while (0)
#endif
    const int lo = args.ph_lo, hi = args.ph_hi;
#ifndef ONLY_PHASE
#define ONLY_PHASE -1
#endif
#ifndef PHMASK
#define PHMASK 0x1ffff
#endif
#define PHON(n) ((ONLY_PHASE < 0 || ONLY_PHASE == (n)) && ((PHMASK >> ((n) == 99 ? 16 : (n))) & 1))
#ifndef REPMASK
#define REPMASK 0
#endif
#ifndef GREP
#define GREP 0
#endif
#define REPN(n) (((REPMASK >> ((n) == 99 ? 16 : (n))) & 1) ? 2 : 1)
#define IN(k) (lo <= (k) && (k) < hi)
#define SEAM(k) do { if (IN((k) + 1)) { unsigned long long tq0_ = 0; const bool tpk_ = (TPROBE >= 100) && (TPROBE - 100 == ((k) == 0 ? 16 : ((k) - 1) % 16)); if (tpk_) tq0_ = tp_now(); GRID_BAR(); if (tpk_ && lane_id() == 0) atomicAdd(TPCTR, tp_now() - tq0_); } } while (0)
#define PHASE_LOCALS int tid = wave * 64 + lane_id(); asm volatile("" : "+v"(tid)); const int lane = tid & 63; int gw = gw0; asm volatile("" : "+s"(gw)); unsigned char* wsl = ws; asm volatile("" : "+s"(wsl)); (void)lane; (void)gw; (void)wsl;

#define lw (wsl + WS_LW + (size_t)l * LW_STRIDE)
#define Hb ((bf16_t*)(wsl + WS_H))
#define PROJ ((bf16_t*)(wsl + WS_R1))
#define R2P(off) (wsl + WS_R2 + (off))
#define KC ((bf16_t*)R2P(R2_KC))
#define VC ((bf16_t*)R2P(R2_VC))
#define KS ((bf16_t*)R2P(R2_KS))
#define VTS ((bf16_t*)R2P(R2_VTS))
#define KW ((bf16_t*)R2P(R2_KW))
#define VWF ((bf16_t*)R2P(R2_VWF))
#define GN ((float*)R2P(R2_GN))
#define QM ((bf16_t*)R2P(R2_QM))
#define KM ((bf16_t*)R2P(R2_KM))
#define HID ((bf16_t*)R2P(R2_HID))
#define KCMP ((bf16_t*)R2P(R2_KCMP))
#define VCMP ((bf16_t*)R2P(R2_VCMP))
#define ATT ((bf16_t*)R2P(R2_ATT))
#define MRG ((bf16_t*)R2P(R2_MRG))
#define QRAW ((bf16_t*)R2P(R2_QRAW))
#define KVRAW ((bf16_t*)R2P(R2_KVRAW))
#define HIDP ((float*)R2P(R2_HIDP))
#define XB ((bf16_t*)(wsl + WS_XB))
#define ROPE ((float*)(wsl + WS_ROPE))
#define LUT8 ((float*)(wsl + WS_LUT8))
#define B1P ((float*)(wsl + WS_B1P))
#define B1 ((float*)(wsl + WS_B1))
#define CONS (B1 + 2048)
#define ROUTE ((int*)(wsl + WS_ROUTE))
#define ROWTOK ((int*)(wsl + WS_ROWTOK))
    LAS float* scr = (LAS float*)(lds + wave * 16384);

    if (PHON(99) && IN(0)) { PHASE_LOCALS TP_BEGIN(36) for (int rep_ = 0; rep_ < REPN(99); ++rep_) {
#define CONV_SMALL(GW_, NGW_) do { \
            tr_matrix(TrSrc{in.w_in + (size_t)l * 1024 * INC, nullptr, INC, INC, 1}, 1024, NPROJ, (bf16_t*)(lw + LW_WIN), scr, GW_, NGW_, lane, troff); \
            tr_matrix(TrSrc{in.sb_w_o + (size_t)l * 256 * 1024, nullptr, 1024, 1024, 0}, 256, 1024, (bf16_t*)(lw + LW_SBO), scr, GW_, NGW_, lane, troff); \
            tr_matrix(TrSrc{in.nsa_w_o + (size_t)l * 512 * 1024, nullptr, 1024, 1024, 0}, 512, 1024, (bf16_t*)(lw + LW_NSAO), scr, GW_, NGW_, lane, troff); \
            tr_matrix(TrSrc{in.mla_w_o + (size_t)l * 256 * 1024, nullptr, 1024, 1024, 0}, 256, 1024, (bf16_t*)(lw + LW_MLAO), scr, GW_, NGW_, lane, troff); \
            tr_matrix(TrSrc{in.w_out + (size_t)l * 1024 * 1024, nullptr, 1024, 1024, 0}, 1024, 1024, (bf16_t*)(lw + LW_WOUT), scr, GW_, NGW_, lane, troff); \
            tr_matrix(TrSrc{in.mla_w_uq + (size_t)l * 256 * 384, nullptr, 384, 384, 0}, 256, 512, (bf16_t*)(lw + LW_WUQ), scr, GW_, NGW_, lane, troff); \
            tr_matrix(TrSrc{in.mla_w_ukv + (size_t)l * 128 * 512, nullptr, 512, 512, 0}, 128, 512, (bf16_t*)(lw + LW_WUKV), scr, GW_, NGW_, lane, troff); \
            for (int kv = 0; kv < 2; ++kv) \
                tr_matrix(TrSrc{in.nsa_cmp_w1 + (size_t)(l * 2 + kv) * 2048 * 256, nullptr, 256, 256, 0}, 2048, 256, (bf16_t*)(lw + LW_CW1) + (size_t)kv * 256 * 2048, scr, GW_, NGW_, lane, troff); } while (0)
        { int troff = 0; const int l = 0; CONV_SMALL(gw, NGW); }
        const int gt = vcu * 512 + tid, NT = G * 512;
        for (int i = gt; i < S * 16; i += NT) {
            const int pos = i >> 4, fi = i & 15; const float inv = powf(10000.f, -(float)fi / 16.f); const float ang = (float)pos * inv;
            const double rev = (double)ang * 0.15915494309189535; const float fr = (float)(rev - rint(rev));
            ROPE[i] = __builtin_amdgcn_cosf(fr); ROPE[S * 16 + i] = __builtin_amdgcn_sinf(fr); }
        for (int i = gt; i < 1024 * 8; i += NT) LUT8[i] = in.bias_table[t5_bucket(i >> 3) * 8 + (i & 7)] * LOG2E;
        if (gw == 0) {
            float bm = 0.f; for (int i = lane; i < 256; i += 64) bm = fmaxf(bm, fabsf(in.bias_table[i]));
            bm = fmaxf(bm, sx<1>(bm)); bm = fmaxf(bm, sx<2>(bm)); bm = fmaxf(bm, sx<4>(bm)); bm = fmaxf(bm, sx<8>(bm)); bm = fmaxf(bm, sx<16>(bm)); bm = fmaxf(bm, sx32(bm, lane >> 5));
            if (lane == 0) CONS[0] = bm * LOG2E;
            for (int ll = 0; ll < 2; ++ll) { float gm = 0.f; for (int i = lane; i < 192; i += 64) gm = fmaxf(gm, fabsf(in.nsa_k_norm[ll * 192 + i]));
                gm = fmaxf(gm, sx<1>(gm)); gm = fmaxf(gm, sx<2>(gm)); gm = fmaxf(gm, sx<4>(gm)); gm = fmaxf(gm, sx<8>(gm)); gm = fmaxf(gm, sx<16>(gm)); gm = fmaxf(gm, sx32(gm, lane >> 5));
                if (lane == 0) CONS[1 + ll] = gm;
                float km = 0.f; for (int i = lane; i < 96; i += 64) km = fmaxf(km, fabsf(in.mla_k_norm[ll * 96 + i]));
                km = fmaxf(km, sx<1>(km)); km = fmaxf(km, sx<2>(km)); km = fmaxf(km, sx<4>(km)); km = fmaxf(km, sx<8>(km)); km = fmaxf(km, sx<16>(km)); km = fmaxf(km, sx32(km, lane >> 5));
                if (lane == 0) CONS[3 + ll] = km; }
        }
        for (int it = gw; it < 512; it += NGW) {
            const int kc = it & 31, cb = (it >> 5) & 3, lk = it >> 7; const float* pos = in.nsa_cmp_pos + (size_t)lk * 2048; const float* w1 = in.nsa_cmp_w1 + (size_t)lk * 2048 * 256;
            float wv_[64];
#pragma unroll
            for (int k = 0; k < 64; ++k) wv_[k] = w1[(size_t)(64 * kc + k) * 256 + 64 * cb + lane];
            float a = 0.f;
#pragma unroll
            for (int k = 0; k < 64; ++k) a += pos[64 * kc + k] * wv_[k];
            B1P[(lk * 32 + kc) * 256 + 64 * cb + lane] = a; }
        for (int i = gt; i < 2 * 2 * 32 * 64 / 8; i += NT) { const int z = i / 256, r = i % 256; bf16_t* p = (z >> 1 ? VC : KC) + ((size_t)(z & 1) * KC_ROWS + S) * 64 + r * 8; *(u32x4*)p = (u32x4){0u, 0u, 0u, 0u}; }
        { f32x4 gn1_[4];
#pragma unroll
          for (int j = 0; j < 4; ++j) gn1_[j] = ((const f32x4*)in.mix_norm)[lane + 64 * j];
          int m = gw; for (; m + NGW < S; m += 2 * NGW) rms_row2(in.x + (size_t)m * 1024, in.x + (size_t)(m + NGW) * 1024, gn1_, Hb + (size_t)m * 1024, Hb + (size_t)(m + NGW) * 1024, lane);
          for (; m < S; m += NGW) { f32x4 v[4]; rms_row(in.x + (size_t)m * 1024, in.mix_norm, Hb + (size_t)m * 1024, lane, v); } }
            }
            TP_END(36, TPCTR);
        SEAM(0);
    }

    for (int l = 0; l < 2; ++l) {
        const int pb = 1 + PH_PER_LAYER * l;
        if (l > 0 && PHON(0) && IN(pb + 0)) { PHASE_LOCALS TP_BEGIN(20) for (int rep_ = 0; rep_ < REPN(0); ++rep_) {
            { f32x4 gn1_[4];
#pragma unroll
              for (int j = 0; j < 4; ++j) gn1_[j] = ((const f32x4*)(in.mix_norm + l * 1024))[lane + 64 * j];
              int m = gw; for (; m + NGW < S; m += 2 * NGW) rms_row2b(XB + (size_t)m * 1024, XB + (size_t)(m + NGW) * 1024, gn1_, Hb + (size_t)m * 1024, Hb + (size_t)(m + NGW) * 1024, lane);
              for (; m < S; m += NGW) rms_row2b(XB + (size_t)m * 1024, XB + (size_t)m * 1024, gn1_, Hb + (size_t)m * 1024, Hb + (size_t)m * 1024, lane); }
            }
            TP_END(20, TPCTR);
            SEAM(pb + 0);
        }
        if (PHON(1) && IN(pb + 1)) { PHASE_LOCALS TP_BEGIN(21) for (int rep_ = 0; rep_ < REPN(1); ++rep_) {
            pg8::StaticOrder So; So.init(Hb, (const bf16_t*)(lw + LW_WIN), 1024, 1024, S, NPROJ - 512, G, bid);
            pg8::EpiStore E{PROJ, NPROJ, nullptr, QK_SCALE64, 0};
            pg8::gemm_phase<pg8::EpiStore, pg8::StaticOrder, true, false>(lds, 1024, 1024, 1024, So, E, wave);
#if GREP & 1
            pg8::gemm_phase<pg8::EpiStore, pg8::StaticOrder, true, false>(lds, 1024, 1024, 1024, So, E, wave);
#endif
            }
            TP_END(21, TPCTR);
            SEAM(pb + 1);
        }
        if (PHON(2) && IN(pb + 2)) { PHASE_LOCALS TP_BEGIN(22) for (int rep_ = 0; rep_ < REPN(2); ++rep_) {
            if (l == 0 && bid < 2) { const int i = bid * 512 + tid; float pv_[32];
#pragma unroll
                for (int kc = 0; kc < 32; ++kc) pv_[kc] = B1P[((i >> 8) * 32 + kc) * 256 + (i & 255)];
                float a = 0.f;
#pragma unroll
                for (int kc = 0; kc < 32; ++kc) a += pv_[kc];
                B1[i] = a; }
            float gq_[8], gk_[8], ga_[4], gb_[2];
            { const int sec_ = lane >> 4, d8_ = 8 * (lane & 7);
#pragma unroll
              for (int e = 0; e < 8; ++e) { gq_[e] = in.nsa_q_norm[l * 64 + 8 * (lane & 7) + e]; gk_[e] = in.nsa_k_norm[(l * 3 + 1 + (sec_ & 1)) * 64 + d8_ + e]; }
#pragma unroll
              for (int e = 0; e < 4; ++e) ga_[e] = in.mla_q_a_norm[l * 256 + lane * 4 + e];
              gb_[0] = in.mla_kv_a_norm[l * 128 + lane * 2]; gb_[1] = in.mla_kv_a_norm[l * 128 + lane * 2 + 1]; }
            auto a3_token = [&](const int t) __attribute__((always_inline)) {
                bf16_t* pr = PROJ + (size_t)t * NPROJ;
                {
                    const u32x4 w = *(const u32x4*)(pr + PC_NQ + lane * 8); float v[8] = {bflo(w.x), bfhi(w.x), bflo(w.y), bfhi(w.y), bflo(w.z), bfhi(w.z), bflo(w.w), bfhi(w.w)};
                    float ss = 0.f;
#pragma unroll
                    for (int e = 0; e < 8; ++e) ss += v[e] * v[e];
                    ss += sx<1>(ss); ss += sx<2>(ss); ss += sx<4>(ss);
                    const float rs = QK_SCALE64 / sqrtf(ss * (1.f / 64.f) + EPS); const float* gq = gq_;
                    u32x4 o; o.x = cvtpk(v[0] * rs * gq[0], v[1] * rs * gq[1]); o.y = cvtpk(v[2] * rs * gq[2], v[3] * rs * gq[3]); o.z = cvtpk(v[4] * rs * gq[4], v[5] * rs * gq[5]); o.w = cvtpk(v[6] * rs * gq[6], v[7] * rs * gq[7]);
                    *(u32x4*)(pr + PC_NQ + lane * 8) = o;
                }
                {
                    const int sec = lane >> 4, gg = (lane >> 3) & 1, d8 = 8 * (lane & 7);
                    const int col = (sec == 0 ? PC_NKS : sec == 1 ? PC_NKW : sec == 2 ? PC_NKC : PC_NVC) + (lane & 15) * 8;
                    const u32x4 w = *(const u32x4*)(pr + col); float v[8] = {bflo(w.x), bfhi(w.x), bflo(w.y), bfhi(w.y), bflo(w.z), bfhi(w.z), bflo(w.w), bfhi(w.w)};
                    float ss = 0.f;
#pragma unroll
                    for (int e = 0; e < 8; ++e) ss += v[e] * v[e];
                    ss += sx<1>(ss); ss += sx<2>(ss); ss += sx<4>(ss);
                    const float rs = 1.f / sqrtf(ss * (1.f / 64.f) + EPS);
                    u32x4 o = w;
                    if (sec < 2) { const float* gk = gk_;
                        o.x = cvtpk(v[0] * rs * gk[0], v[1] * rs * gk[1]); o.y = cvtpk(v[2] * rs * gk[2], v[3] * rs * gk[3]); o.z = cvtpk(v[4] * rs * gk[4], v[5] * rs * gk[5]); o.w = cvtpk(v[6] * rs * gk[6], v[7] * rs * gk[7]); }
                    const int c8 = lane & 7; const size_t ksf = ((((size_t)(gg * 256 + (t >> 6)) * 2 + ((t >> 5) & 1)) * 4 + (c8 >> 1)) * 64 + (c8 & 1) * 32 + (t & 31)) * 8;
                    bf16_t* dst = (sec == 0 ? KS + ksf : sec == 1 ? KW + ksf : (sec == 2 ? KC + ((size_t)gg * KC_ROWS + t) * 64 : VC + ((size_t)gg * KC_ROWS + t) * 64) + d8);
                    *(u32x4*)dst = o;
                }
                {
                    const u32x2 w = *(const u32x2*)(pr + PC_CQ + lane * 4); float v[4] = {bflo(w.x), bfhi(w.x), bflo(w.y), bfhi(w.y)};
                    const float rs = 1.f / sqrtf(wave_sum((v[0] * v[0] + v[1] * v[1]) + (v[2] * v[2] + v[3] * v[3])) * (1.f / 256.f) + EPS); const float* ga = ga_;
                    u32x2 o; o.x = cvtpk(v[0] * rs * ga[0], v[1] * rs * ga[1]); o.y = cvtpk(v[2] * rs * ga[2], v[3] * rs * ga[3]); *(u32x2*)(pr + PC_CQ + lane * 4) = o;
                    const unsigned w2 = *(const unsigned*)(pr + PC_CKV + lane * 2); const float a = bflo(w2), b = bfhi(w2);
                    const float rs2 = 1.f / sqrtf(wave_sum(a * a + b * b) * (1.f / 128.f) + EPS); const float* gb = gb_;
                    *(unsigned*)(pr + PC_CKV + lane * 2) = cvtpk(a * rs2 * gb[0], b * rs2 * gb[1]);
                }
                if (lane < 24) GN[(size_t)t * 24 + lane] = sigmoidf_(bf2f(pr[PC_NG + lane]));

            };
            { int t0 = gw; for (; t0 + NGW < S; t0 += 2 * NGW) { a3_token(t0); a3_token(t0 + NGW); } for (; t0 < S; t0 += NGW) a3_token(t0); }
            for (int it = gw; it < 8192; it += NGW) {
                const int wn = it >> 12, gg = (it >> 11) & 1, blk = (it >> 3) & 255, s8 = it & 7; const bf16_t* src = PROJ + (size_t)(blk * 64) * NPROJ + (wn ? PC_NVW : PC_NVS) + gg * 64 + lane; bf16_t* dstb = (wn ? VWF : VTS) + (size_t)(gg * 256 + blk) * 4096;
                unsigned short e[8];
#pragma unroll
                for (int j = 0; j < 8; ++j) { const int k = att::vts_key_of_slot(8 * s8 + j); e[j] = src[(size_t)k * NPROJ]; }
                u32x4 o; o.x = e[0] | ((unsigned)e[1] << 16); o.y = e[2] | ((unsigned)e[3] << 16); o.z = e[4] | ((unsigned)e[5] << 16); o.w = e[6] | ((unsigned)e[7] << 16);
                const int hh = s8 >> 2, ss = (s8 >> 1) & 1, h = s8 & 1;
                *(u32x4*)(dstb + ((((hh * 2 + (lane >> 5)) * 2 + ss) * 64) + h * 32 + (lane & 31)) * 8) = o;
            }
            }
            TP_END(22, TPCTR);
            SEAM(pb + 2);
        }
        if (PHON(3) && IN(pb + 3)) { PHASE_LOCALS TP_BEGIN(23) for (int rep_ = 0; rep_ < REPN(3); ++rep_) {
            const bool wide = (G >= 256);
            for (int job = 0; job < 3; ++job) {
                pg8::StaticOrder So; pg8::EpiStore E; int lda, ldb, K;
                if (job == 2) { lda = 1024; ldb = 1024; K = 1024; So.init(Hb, (const bf16_t*)(lw + LW_WIN) + (size_t)(NPROJ - 512) * 1024, lda, ldb, S, 512, wide ? 128 : G, wide ? (bid < 64 ? bid : (bid >= 192 && bid < 256 ? bid - 128 : -1)) : bid); E = pg8::EpiStore{PROJ + (NPROJ - 512), NPROJ, nullptr, 1.f, 0}; }
                else if (job == 0) { lda = NPROJ; ldb = 256; K = 256; So.init(PROJ + PC_CQ, (const bf16_t*)(lw + LW_WUQ), lda, ldb, S, 512, wide ? 128 : G, wide ? (bid < 128 ? bid : -1) : bid); E = pg8::EpiStore{QRAW, 512, nullptr, 1.f, 0}; }
                else { lda = NPROJ; ldb = 128; K = 128; So.init(PROJ + PC_CKV, (const bf16_t*)(lw + LW_WUKV), lda, ldb, S, 512, wide ? 128 : G, wide ? (bid >= 128 && bid < 256 ? bid - 128 : -1) : bid); E = pg8::EpiStore{KVRAW, 512, nullptr, 1.f, 0}; }
                pg8::gemm_phase<pg8::EpiStore, pg8::StaticOrder, true, false>(lds, lda, ldb, K, So, E, wave);
#if GREP & 16
                pg8::gemm_phase<pg8::EpiStore, pg8::StaticOrder, true, false>(lds, lda, ldb, K, So, E, wave);
#endif
            }
            for (int jz = 0; jz < 16; ++jz) {
                const int z = jz >> 2, ks = jz & 3, kv = z >> 1, gg = z & 1;
                pg8::StaticOrder So; So.init((kv ? VC : KC) + (size_t)gg * KC_ROWS * 64 + ks * 512, (const bf16_t*)(lw + LW_CW1) + (size_t)kv * 256 * 2048 + ks * 512, 1024, 2048, 1024, 256, wide ? 4 : G, wide ? ((bid >= 128 + 4 * jz && bid < 132 + 4 * jz) ? bid - 128 - 4 * jz : -1) : bid);
                pg8::EpiF32 E{HIDP + (size_t)jz * 1024 * 256, 256};
                pg8::gemm_phase<pg8::EpiF32, pg8::StaticOrder, true, false>(lds, 1024, 2048, 512, So, E, wave);
            }
            }
            TP_END(23, TPCTR);
            SEAM(pb + 3);
        }
        if (PHON(4) && IN(pb + 4)) { PHASE_LOCALS TP_BEGIN(24) for (int rep_ = 0; rep_ < REPN(4); ++rep_) {
            const int kvb = (2 * vcu >= G) ? 1 : 0;
            { const float* w2g = in.nsa_cmp_w2 + (size_t)(l * 2 + kvb) * 256 * 64; LAS f32x4* w2l = (LAS f32x4*)lds;
#pragma unroll
              for (int i = 0; i < 8; ++i) w2l[tid + 512 * i] = *(const f32x4*)(w2g + (size_t)(tid + 512 * i) * 4); }
            __syncthreads();
            LAS unsigned short* ws16 = (LAS unsigned short*)(lds + 65536 + wave * 4096);
            float g5q_[6], g5k_[6];
#pragma unroll
            for (int e = 0; e < 6; ++e) { g5q_[e] = in.mla_q_norm[l * 96 + (lane & 15) + 16 * e]; g5k_[e] = in.mla_k_norm[l * 96 + (lane & 15) + 16 * e]; }
            for (int t = gw; t < S; t += NGW) {
                if (lane < 48) *(LAS u32x4*)(ws16 + 8 * lane) = *(const u32x4*)(QRAW + (size_t)t * 512 + 8 * lane);
                if (lane < 32) *(LAS u32x4*)(ws16 + 384 + (lane >> 3) * 96 + (lane & 7) * 8) = *(const u32x4*)(KVRAW + (size_t)t * 512 + (lane >> 3) * 128 + (lane & 7) * 8);
                else if (lane < 48) { const int hh_ = (lane - 32) >> 2, c_ = lane & 3; *(LAS u32x4*)(ws16 + 384 + hh_ * 96 + 64 + c_ * 8) = *(const u32x4*)(PROJ + (size_t)t * NPROJ + PC_KR + c_ * 8); }
                LDS_WAIT(); asm volatile("" ::: "memory");
                const int hd = lane >> 4, i = lane & 15; const float c = ROPE[t * 16 + i], s = ROPE[S * 16 + t * 16 + i];
                {   LAS unsigned short* src = ws16 + hd * 96 + i; float v[6]; float ss = 0.f;
#pragma unroll
                    for (int e = 0; e < 6; ++e) { v[e] = bf2f(src[16 * e]); ss += v[e] * v[e]; }
                    ss += sx<1>(ss); ss += sx<2>(ss); ss += sx<4>(ss); ss += sx<8>(ss);
                    const float rs = 1.f / sqrtf(ss * (1.f / 96.f) + EPS);
#pragma unroll
                    for (int e = 0; e < 6; ++e) v[e] = v[e] * rs * g5q_[e];
                    const float x1 = v[4], x2 = v[5]; v[4] = x1 * c - x2 * s; v[5] = x2 * c + x1 * s;
#pragma unroll
                    for (int e = 0; e < 6; ++e) src[16 * e] = f2bf(v[e] * QK_SCALE96); }
                {   LAS unsigned short* src = ws16 + 384 + hd * 96 + i; float v[6]; float ss = 0.f;
#pragma unroll
                    for (int e = 0; e < 6; ++e) { v[e] = bf2f(src[16 * e]); ss += v[e] * v[e]; }
                    ss += sx<1>(ss); ss += sx<2>(ss); ss += sx<4>(ss); ss += sx<8>(ss);
                    const float rs = 1.f / sqrtf(ss * (1.f / 96.f) + EPS);
#pragma unroll
                    for (int e = 0; e < 6; ++e) v[e] = v[e] * rs * g5k_[e];
                    const float x1 = v[4], x2 = v[5]; v[4] = x1 * c - x2 * s; v[5] = x2 * c + x1 * s;
#pragma unroll
                    for (int e = 0; e < 6; ++e) src[16 * e] = f2bf(v[e]); }
                LDS_WAIT(); asm volatile("" ::: "memory");
                if (lane < 48) { *(u32x4*)(QM + (size_t)t * 384 + 8 * lane) = *(const LAS u32x4*)(ws16 + 8 * lane); *(u32x4*)(KM + (size_t)t * 384 + 8 * lane) = *(const LAS u32x4*)(ws16 + 384 + 8 * lane); }
                LDS_WAIT(); asm volatile("" ::: "memory");
            }
            {
                LAS float* hs = (LAS float*)(lds + 65536 + wave * 4096); const LAS float* w2l = (const LAS float*)lds;
                const int hw = (kvb ? vcu - G / 2 : vcu) * NWAVES + wave, nhw = (kvb ? G - G / 2 : G / 2) * NWAVES;
                for (int it = hw; it < 2048; it += nhw) {
                    const int gg = it >> 10, n = it & 1023, z = kvb * 2 + gg;
                    { f32x4 hsum = *(const f32x4*)(B1 + (l * 2 + kvb) * 256 + lane * 4);
#pragma unroll
                      for (int ks = 0; ks < 4; ++ks) hsum += *(const f32x4*)(HIDP + ((size_t)(z * 4 + ks) * 1024 + n) * 256 + lane * 4);
                      *(LAS f32x4*)(hs + lane * 4) = (f32x4){siluf_(hsum.x), siluf_(hsum.y), siluf_(hsum.z), siluf_(hsum.w)}; }
                    LDS_WAIT(); asm volatile("" ::: "memory");
                    float a0 = 0.f, a1 = 0.f, a2 = 0.f, a3 = 0.f;
#pragma unroll 4
                    for (int j = 0; j < 256; j += 4) { const f32x4 h4 = *(const LAS f32x4*)(hs + j);
                        a0 += h4.x * w2l[j * 64 + lane]; a1 += h4.y * w2l[(j + 1) * 64 + lane]; a2 += h4.z * w2l[(j + 2) * 64 + lane]; a3 += h4.w * w2l[(j + 3) * 64 + lane]; }
                    const float a = (a0 + a1) + (a2 + a3);
                    if (kvb == 0) { const float rs = 1.f / sqrtf(wave_sum(a * a) * (1.f / 64.f) + EPS);
                        KCMP[(size_t)(gg * 16 + (n >> 6)) * 4096 + ((((n >> 5) & 1) * 4 + (lane >> 4)) * 64 + ((lane >> 3) & 1) * 32 + (n & 31)) * 8 + (lane & 7)] = f2bf(a * rs * in.nsa_k_norm[(l * 3) * 64 + lane]); }
                    else { const int k4 = n & 15;
                        VCMP[(size_t)(gg * 16 + (n >> 6)) * 4096 + ((((((n >> 5) & 1) * 2 + (lane >> 5)) * 2 + ((n >> 4) & 1)) * 64) + ((k4 >> 2) & 1) * 32 + (lane & 31)) * 8 + (((k4 >> 3) << 2) | (k4 & 3))] = f2bf(a); }
                    LDS_WAIT(); asm volatile("" ::: "memory");
                }
            }
            __syncthreads();
            }
            TP_END(24, TPCTR);
            SEAM(pb + 4);
        }
        if (PHON(5) && IN(pb + 5)) { PHASE_LOCALS TP_BEGIN(25) for (int rep_ = 0; rep_ < REPN(5); ++rep_) {
            __syncthreads();
            for (int r2_ = 0; r2_ < REPN(18); ++r2_) for (int p = vcu; p < 256; p += G) { const float mkb = 9.9f * CONS[3 + l]; att::mla_unit((LAS char*)lds, QM, KM, KVRAW, ATT, p >> 6, 127 - (p & 63), mkb, wave, TPCTR); att::mla_unit((LAS char*)lds, QM, KM, KVRAW, ATT, p >> 6, p & 63, mkb, wave, TPCTR); }
            att::NsaT T{PROJ, KCMP, VCMP, KS, VTS, KW, VWF, GN, LUT8, ATT, 8.08f * CONS[1 + l], CONS[0], (unsigned long long*)(ctl + 20480)};
            for (int r2_ = 0; r2_ < REPN(19); ++r2_) { volatile LAS int* qslot = (volatile LAS int*)(lds + MISC_OFF + 192); const int qg = (2 * vcu >= G) ? 1 : 0;
                __syncthreads(); att::nsa_load_lut((LAS char*)lds, LUT8, qg, tid);
                for (;;) { __syncthreads(); if (tid == 0) *qslot = (int)__hip_atomic_fetch_add(ctl + CW_NSAQ + 64 * (4 * l + 2 * r2_ + qg), 1u, RLX_AGENT); __syncthreads();
                    const int u = *qslot; if (u >= 256) break; att::nsa_unit((LAS char*)lds, T, qg, 255 - u, wave); } }
            for (int r2_ = 0; r2_ < REPN(17); ++r2_) { volatile LAS int* qslot = (volatile LAS int*)(lds + MISC_OFF + 192);
                for (;;) { __syncthreads(); if (tid == 0) *qslot = (int)__hip_atomic_fetch_add(ctl + CW_NSAQ + 64 * (8 + 2 * l + r2_), 1u, RLX_AGENT); __syncthreads();
                    const int u = *qslot; if (u >= 256) break; att::sb_unit((LAS char*)lds, PROJ, ATT, u >> 6, 63 - (u & 63), wave); } }
            if (l == 0) { PHASE_LOCALS volatile LAS int* qslot = (volatile LAS int*)(lds + MISC_OFF + 192); constexpr int NCH = 512;
                for (;;) { __syncthreads(); if (tid == 0) *qslot = (int)__hip_atomic_fetch_add(ctl + CW_NSAQ + 64 * 12, 1u, RLX_AGENT); __syncthreads();
                    const int ch = *qslot; if (ch >= NCH) break;
                    { int troff = 0; const int gwv = ch * NWAVES + wave, ngwv = NCH * NWAVES;
                      tr_matrix(TrSrc{in.dense_w_gate, in.dense_w_up, DFF, DFF, 2}, 1024, 2 * DFF, (bf16_t*)(wsl + WS_DGU), scr, gwv, ngwv, lane, troff);
                      tr_matrix(TrSrc{in.dense_w_down, nullptr, 1024, 1024, 0}, DFF, 1024, (bf16_t*)(wsl + WS_DDN), scr, gwv, ngwv, lane, troff); } } }
            }
            TP_END(25, TPCTR);
            SEAM(pb + 5);
        }
        if (PHON(6) && IN(pb + 6)) { PHASE_LOCALS TP_BEGIN(26) for (int rep_ = 0; rep_ < REPN(6); ++rep_) {
            for (int mix = 0; mix < 3; ++mix) {
                const int K = (mix == 1) ? 512 : 256; const int acol = (mix == 0) ? 0 : (mix == 1) ? 256 : 768;
                const bf16_t* Bt = (const bf16_t*)(lw + (mix == 0 ? LW_SBO : mix == 1 ? LW_NSAO : LW_MLAO));
                pg8::StaticOrder So; So.init(ATT + acol, Bt, 1024, K, S, 1024, G, bid);
                pg8::EpiGate E{MRG, PROJ + PC_GATE + mix * 1024, NPROJ, in.b_gate + l * 3072 + mix * 1024, mix == 0 ? 1 : 0};
                pg8::gemm_phase<pg8::EpiGate, pg8::StaticOrder, true, false>(lds, 1024, K, K, So, E, wave);
            }
            }
            TP_END(26, TPCTR);
            SEAM(pb + 6);
        }
        if (PHON(7) && IN(pb + 7)) { PHASE_LOCALS TP_BEGIN(27) for (int rep_ = 0; rep_ < REPN(7); ++rep_) {
            pg8::StaticOrder So; So.init(MRG, (const bf16_t*)(lw + LW_WOUT), 1024, 1024, S, 1024, G, bid);
            pg8::EpiResid E{l == 0 ? in.x : nullptr, XB};
            pg8::gemm_phase<pg8::EpiResid, pg8::StaticOrder, true, false>(lds, 1024, 1024, 1024, So, E, wave);
            }
            TP_END(27, TPCTR);
            SEAM(pb + 7);
        }
        if (PHON(8) && IN(pb + 8)) { PHASE_LOCALS TP_BEGIN(28) for (int rep_ = 0; rep_ < REPN(8); ++rep_) {
            if (l == 1) {
                int troff = 0;
                tr_batch(in.moe_w_gate, in.moe_w_up, (size_t)1024 * EFF, EFF, EFF, 2, 1024, 2 * EFF, (bf16_t*)(wsl + WS_MGU), (size_t)7168 * 1024, 8, scr, gw, NGW, lane, troff);
                tr_batch(in.moe_w_down, nullptr, (size_t)EFF * 1024, 1024, 1024, 0, EFF, 1024, (bf16_t*)(wsl + WS_MDN), (size_t)1024 * EFF, 8, scr, gw, NGW, lane, troff);
            }
            LAS float* rtl = (LAS float*)(lds + 65536); LAS unsigned* lcnt = (LAS unsigned*)(lds + 98304); LAS int* rec = (LAS int*)(lds + 98304 + 64);
            if (l == 1) { __syncthreads();
#pragma unroll
                for (int i = 0; i < 4; ++i) ((LAS f32x4*)rtl)[tid + 512 * i] = *(const f32x4*)(in.moe_router + (size_t)(tid + 512 * i) * 4);
                if (tid < 16) lcnt[tid] = 0u;
                __syncthreads(); }
            f32x4 gn_[4];
#pragma unroll
            for (int j = 0; j < 4; ++j) gn_[j] = ((const f32x4*)(in.ffn_norm + l * 1024))[lane + 64 * j];
            int nrec = 0;
            u32x2 nx_[4] = {{0u, 0u}, {0u, 0u}, {0u, 0u}, {0u, 0u}};
            if (gw < S) {
#pragma unroll
                for (int j = 0; j < 4; ++j) nx_[j] = ((const u32x2*)(XB + (size_t)gw * 1024) + lane)[64 * j]; }
            for (int m = gw; m < S; m += NGW, ++nrec) {
                f32x4 v[4];
                { float ssq = 0.f; u32x2 xr_[4];
#pragma unroll
                  for (int j = 0; j < 4; ++j) xr_[j] = nx_[j];
                  if (m + NGW < S) {
#pragma unroll
                      for (int j = 0; j < 4; ++j) nx_[j] = ((const u32x2*)(XB + (size_t)(m + NGW) * 1024) + lane)[64 * j]; }
#pragma unroll
                  for (int j = 0; j < 4; ++j) { v[j] = (f32x4){bflo(xr_[j].x), bfhi(xr_[j].x), bflo(xr_[j].y), bfhi(xr_[j].y)}; ssq += (v[j].x * v[j].x + v[j].y * v[j].y) + (v[j].z * v[j].z + v[j].w * v[j].w); }
                  const float rstd = 1.f / sqrtf(wave_sum(ssq) * (1.f / 1024.f) + EPS); u32x2* o8 = (u32x2*)(Hb + (size_t)m * 1024) + lane;
#pragma unroll
                  for (int j = 0; j < 4; ++j) { v[j] = v[j] * rstd * gn_[j]; u32x2 w; w.x = cvtpk(v[j].x, v[j].y); w.y = cvtpk(v[j].z, v[j].w); o8[64 * j] = w; } }
                if (l == 1) {
                    float lg[8];
#pragma unroll
                    for (int e = 0; e < 8; ++e) lg[e] = 0.f;
#pragma unroll
                    for (int j = 0; j < 4; ++j)
#pragma unroll
                        for (int q = 0; q < 4; ++q) { const LAS float* wr = rtl + (4 * lane + 256 * j + q) * 8; const f32x4 wa = *(const LAS f32x4*)wr, wb = *(const LAS f32x4*)(wr + 4); const float hv = v[j][q];
                            lg[0] += hv * wa.x; lg[1] += hv * wa.y; lg[2] += hv * wa.z; lg[3] += hv * wa.w; lg[4] += hv * wb.x; lg[5] += hv * wb.y; lg[6] += hv * wb.z; lg[7] += hv * wb.w; }
#pragma unroll
                    for (int e = 0; e < 8; ++e) lg[e] = wave_sum(lg[e]);
                    int e0 = 0; float v0 = lg[0];
#pragma unroll
                    for (int e = 1; e < 8; ++e) if (lg[e] > v0) { v0 = lg[e]; e0 = e; }
                    int e1 = -1; float v1 = -INFINITY;
#pragma unroll
                    for (int e = 0; e < 8; ++e) if (e != e0 && lg[e] > v1) { v1 = lg[e]; e1 = e; }
                    if (lane == 0 && nrec < 64) { const float w0 = 1.f / (1.f + __expf(v1 - v0)), w1 = 1.f - w0;
                        const int lp0 = (int)__hip_atomic_fetch_add(lcnt + e0, 1u, __ATOMIC_RELAXED, __HIP_MEMORY_SCOPE_WORKGROUP), lp1 = (int)__hip_atomic_fetch_add(lcnt + e1, 1u, __ATOMIC_RELAXED, __HIP_MEMORY_SCOPE_WORKGROUP);
                        LAS int* r = rec + (wave * 64 + nrec) * 8; r[0] = e0; r[1] = e1; r[2] = lp0; r[3] = lp1; r[4] = __float_as_int(w0); r[5] = __float_as_int(w1); }
                }
            }
            if (l == 1) {
                __syncthreads();
                if (tid < 8) lcnt[8 + tid] = __hip_atomic_fetch_add(ctl + CW_MOECNT + 64 * tid, lcnt[tid], RLX_AGENT);
                __syncthreads();
                if (lane < nrec && lane < 64) { const LAS int* r = rec + (wave * 64 + lane) * 8; const int m = gw + lane * NGW, e0 = r[0], e1 = r[1], p0 = (int)lcnt[8 + e0] + r[2], p1 = (int)lcnt[8 + e1] + r[3];
                    ROWTOK[e0 * S + p0] = m; ROWTOK[e1 * S + p1] = m;
                    int* g_ = ROUTE + (size_t)m * 8; g_[0] = e0; g_[1] = e1; g_[2] = p0; g_[3] = p1; g_[4] = r[4]; g_[5] = r[5]; }
            }
            }
            TP_END(28, TPCTR);
            SEAM(pb + 8);
        }
        if (l == 0) {
#define ACT0 ((bf16_t*)(wsl + WS_R1))
            if (PHON(9) && IN(pb + 9)) { PHASE_LOCALS TP_BEGIN(29) for (int rep_ = 0; rep_ < REPN(9); ++rep_) {
                pg8::StaticOrder So; So.init(Hb, (const bf16_t*)(wsl + WS_DGU), 1024, 1024, S, 2 * DFF, G, bid);
                pg8::EpiSwiglu E{ACT0, DFF};
                pg8::gemm_phase<pg8::EpiSwiglu, pg8::StaticOrder, true, false>(lds, 1024, 1024, 1024, So, E, wave);
#if GREP & 2
                pg8::gemm_phase<pg8::EpiSwiglu, pg8::StaticOrder, true, false>(lds, 1024, 1024, 1024, So, E, wave);
#endif
                if (((64 * 22 - 1) / G) * G + bid >= 64 * 22 || (64 * 22) % G == 0) { PHASE_LOCALS volatile LAS int* qslot = (volatile LAS int*)(lds + MISC_OFF + 192); constexpr int NCH = 512;
                  for (;;) { __syncthreads(); if (tid == 0) *qslot = (int)__hip_atomic_fetch_add(ctl + CW_NSAQ + 64 * 13, 1u, RLX_AGENT); __syncthreads();
                      const int ch = *qslot; if (ch >= NCH) break;
                      { int troff = 0; const int gwv = ch * NWAVES + wave, ngwv = NCH * NWAVES; const int l = 1; CONV_SMALL(gwv, ngwv); } } }
            }
            TP_END(29, TPCTR);
                SEAM(pb + 9);
            }
            if (PHON(10) && IN(pb + 10)) { PHASE_LOCALS TP_BEGIN(30) for (int rep_ = 0; rep_ < REPN(10); ++rep_) {
                pg8::StaticOrder So; So.init(ACT0, (const bf16_t*)(wsl + WS_DDN), DFF, DFF, S, 1024, G, bid);
                pg8::EpiResid E{nullptr, XB};
                pg8::gemm_phase<pg8::EpiResid, pg8::StaticOrder, true, false>(lds, DFF, DFF, DFF, So, E, wave);
            }
            TP_END(30, TPCTR);
                SEAM(pb + 10);
            }
        } else {
#define ACT1 ((bf16_t*)(wsl + WS_R2))
#define YB ((bf16_t*)(wsl + WS_Y))
            for (int ps = 0; ps < 2; ++ps) {
                if (PHON(11) && IN(pb + 9 + 2 * ps)) { PHASE_LOCALS TP_BEGIN(31) for (int rep_ = 0; rep_ < REPN(11); ++rep_) {
                    if (tid == 0) { int tb = 0; for (int e = 0; e < 8; ++e) { const int c = (int)__hip_atomic_load(ctl + CW_MOECNT + 64 * e, RLX_AGENT); MTAB[e] = c; MTAB[8 + e] = tb; tb += (c + 255) >> 8; } MTAB[16] = tb; }
                    __syncthreads();
                    const int T = MTAB[16], tlo = 64 * ps, thi = (ps == 1) ? T : (T < 64 ? T : 64);
                    MoeGU So{MTAB, Hb, (const bf16_t*)(wsl + WS_MGU), ROWTOK, tlo, thi, G, bid};
                    pg8::EpiSwiglu E{ACT1, EFF};
                    pg8::gemm_phase<pg8::EpiSwiglu, MoeGU, true, true>(lds, 1024, 1024, 1024, So, E, wave);
#if GREP & 4
                    pg8::gemm_phase<pg8::EpiSwiglu, MoeGU, true, true>(lds, 1024, 1024, 1024, So, E, wave);
#endif
            }
            TP_END(31, TPCTR);
                    SEAM(pb + 9 + 2 * ps);
                }
                if (PHON(12) && IN(pb + 10 + 2 * ps)) { PHASE_LOCALS TP_BEGIN(32) for (int rep_ = 0; rep_ < REPN(12); ++rep_) {
                    if (tid == 0) { int tb = 0; for (int e = 0; e < 8; ++e) { const int c = (int)__hip_atomic_load(ctl + CW_MOECNT + 64 * e, RLX_AGENT); MTAB[e] = c; MTAB[8 + e] = tb; tb += (c + 255) >> 8; } MTAB[16] = tb; }
                    __syncthreads();
                    const int T = MTAB[16], tlo = 64 * ps, thi = (ps == 1) ? T : (T < 64 ? T : 64);
                    const int dn_units = 4 * (thi > tlo ? thi - tlo : 0); int dn_full = dn_units; if (ps == 1 && dn_units > G && dn_units - (dn_units / G) * G <= 32) dn_full = (dn_units / G) * G;
                    MoeDN So{MTAB, ACT1, (const bf16_t*)(wsl + WS_MDN), tlo, thi, G, bid, dn_full};
                    pg8::EpiStore E{YB, 1024, nullptr, 1.f, 0};
                    pg8::gemm_phase<pg8::EpiStore, MoeDN, true, false>(lds, EFF, EFF, EFF, So, E, wave);
                    { MoeDNS So2{MTAB, ACT1, (const bf16_t*)(wsl + WS_MDN), tlo, thi, dn_full, G, bid};
                      pg8::EpiF32 E2{(float*)(wsl + WS_H), 256};
                      pg8::gemm_phase<pg8::EpiF32, MoeDNS, true, false>(lds, EFF, EFF, EFF / 2, So2, E2, wave); }
#if GREP & 8
                    pg8::gemm_phase<pg8::EpiStore, MoeDN, true, false>(lds, EFF, EFF, EFF, So, E, wave);
#endif
            }
            TP_END(32, TPCTR);
                    SEAM(pb + 10 + 2 * ps);
                }
            }
            if (PHON(15) && IN(pb + 15)) { PHASE_LOCALS TP_BEGIN(35) for (int rep_ = 0; rep_ < REPN(15); ++rep_) {
                if (tid == 0) { int tb = 0; for (int e = 0; e < 8; ++e) { const int c = (int)__hip_atomic_load(ctl + CW_MOECNT + 64 * e, RLX_AGENT); MTAB[e] = c; MTAB[8 + e] = tb; tb += (c + 255) >> 8; } MTAB[16] = tb; }
                __syncthreads();
                const int c_T = MTAB[16], c_nrt = c_T - 64, c_units = 4 * (c_nrt > 0 ? c_nrt : 0); int c_full = c_units; if (c_units > G && c_units - (c_units / G) * G <= 32) c_full = (c_units / G) * G;
                const float* PART = (const float*)(wsl + WS_H);
                for (int m = gw; m < S; m += NGW) {
                    const int* r = ROUTE + (size_t)m * 8; const int e0 = r[0], e1 = r[1]; const float w0 = __int_as_float(r[4]), w1 = __int_as_float(r[5]);
                    const int R0 = MTAB[8 + e0] * 256 + r[2], R1 = MTAB[8 + e1] * 256 + r[3];
                    const bf16_t* y0 = YB + (size_t)R0 * 1024; const bf16_t* y1 = YB + (size_t)R1 * 1024;
                    float* xo = args.out + (size_t)m * 1024; const bf16_t* xi = XB + (size_t)m * 1024;
#pragma unroll
                    for (int j = 0; j < 4; ++j) { const int c = 4 * lane + 256 * j; const u32x2 xw = *(const u32x2*)(xi + c); f32x4 xv = {bflo(xw.x), bfhi(xw.x), bflo(xw.y), bfhi(xw.y)}; f32x4 ya, yb;
                        { const int rt = R0 >> 8, L = j * c_nrt + (rt - 64);
                          if (rt >= 64 && L >= c_full) { const float* pp = PART + ((size_t)(L - c_full) * 2 * 256 + (R0 & 255)) * 256 + 4 * lane; ya = *(const f32x4*)pp + *(const f32x4*)(pp + 65536); }
                          else { const u32x2 a = *(const u32x2*)(y0 + c); ya = (f32x4){bflo(a.x), bfhi(a.x), bflo(a.y), bfhi(a.y)}; } }
                        { const int rt = R1 >> 8, L = j * c_nrt + (rt - 64);
                          if (rt >= 64 && L >= c_full) { const float* pp = PART + ((size_t)(L - c_full) * 2 * 256 + (R1 & 255)) * 256 + 4 * lane; yb = *(const f32x4*)pp + *(const f32x4*)(pp + 65536); }
                          else { const u32x2 b = *(const u32x2*)(y1 + c); yb = (f32x4){bflo(b.x), bfhi(b.x), bflo(b.y), bfhi(b.y)}; } }
                        xv.x += w0 * ya.x + w1 * yb.x; xv.y += w0 * ya.y + w1 * yb.y; xv.z += w0 * ya.z + w1 * yb.z; xv.w += w0 * ya.w + w1 * yb.w;
                        *(f32x4*)(xo + c) = xv; }
                }
            }
            TP_END(35, TPCTR);
                if (l == 0) SEAM(pb + 15);
            }
        }
    }
#if TPROBE != 0 && !MK_MULTI
    xcd_barrier(bar);
    if (bid == 0 && wave == 0 && lane_id() == 0) { const unsigned long long tot = __hip_atomic_load((unsigned long long*)(ctl + 20480), RLX_AGENT) / (unsigned long long)(G * NWAVES); const unsigned long long t0 = tp_now(); while (tp_now() - t0 < tot) __builtin_amdgcn_s_sleep(8); }
#endif
#undef IN
#undef SEAM
}

extern "C" void kernel_launch(void* const* d_in, const int* in_sizes, int n_in, void* d_out, int out_size, void* d_ws, size_t ws_size, hipStream_t stream) {
    static int grid = 0;
    if (grid == 0) {
        if (n_in != 28 || in_sizes[0] != S * DM || out_size != S * DM || ws_size < WS_END) { fprintf(stderr, "kernel_launch: unexpected problem (n_in %d, in0 %d, out %d, ws %zu < %zu); nothing launched\n", n_in, n_in > 0 ? in_sizes[0] : -1, out_size, ws_size, (size_t)WS_END); grid = -1; return; }
        int dev = 0, cus = 0, per_cu = 0;
        if (hipGetDevice(&dev) != hipSuccess || hipDeviceGetAttribute(&cus, hipDeviceAttributeMultiprocessorCount, dev) != hipSuccess) { grid = -1; return; }
        if (hipFuncSetAttribute((const void*)fwd_kernel, hipFuncAttributeMaxDynamicSharedMemorySize, LDS_BYTES) != hipSuccess) { fprintf(stderr, "kernel_launch: hipFuncSetAttribute failed\n"); grid = -1; return; }
        if (hipOccupancyMaxActiveBlocksPerMultiprocessor(&per_cu, (const void*)fwd_kernel, NWAVES * 64, LDS_BYTES) != hipSuccess || per_cu < 1) { fprintf(stderr, "kernel_launch: occupancy query reports %d blocks per CU\n", per_cu); (void)hipGetLastError(); }
        grid = cus;
    }
    if (grid < 0) return;
    if (hipMemsetAsync((char*)d_ws + WS_CTL, 0, CTL_ZERO_BYTES, stream) != hipSuccess) return;
    Args a{};
    const float** ip = (const float**)&a.in;
    for (int i = 0; i < 28; ++i) ip[i] = (const float*)d_in[i];
    a.out = (float*)d_out; a.ws = (unsigned char*)d_ws;
#if MK_MULTI
    for (int ph = 0; ph < NPHASES; ++ph) {
        if (ph >= 1 + 11 && ph < 1 + PH_PER_LAYER) continue;
        a.ph_lo = ph; a.ph_hi = ph + 1;
        hipLaunchKernelGGL(fwd_kernel, dim3(grid), dim3(NWAVES * 64), LDS_BYTES, stream, a);
    }
#else
    a.ph_lo = 0; a.ph_hi = NPHASES;
    hipLaunchKernelGGL(fwd_kernel, dim3(grid), dim3(NWAVES * 64), LDS_BYTES, stream, a);
#endif
    const hipError_t le = hipPeekAtLastError();
    if (le != hipSuccess) fprintf(stderr, "kernel_launch: launch failed: %s\n", hipGetErrorName(le));
}
```
